# Optimizing an MI355X kernel written in HIP

```python
import math
import jax, jax.numpy as jnp
from jax import lax
import numpy as np

D_MODEL = 1024
BATCH = 8
SEQ = 2048
DEPTH = 4
DEC_BATCH = 128
DEC_SEQ = 4
PAST_LEN = 16384
PAGE_SIZE = 128

D_MIX = 2 * D_MODEL
POOL_WIDTH = D_MIX // 4
POOL_WINDOWS = (2, 4, 8, 16)
POOL_GROUPS = len(POOL_WINDOWS)
POOL_GDIM = POOL_WIDTH // POOL_GROUPS
POOL_BUF = max(POOL_WINDOWS) - 1
SSD_WIDTH = D_MIX // 2
SSD_HEAD_DIM = 64
SSD_HEADS = SSD_WIDTH // SSD_HEAD_DIM
SSD_GROUPS = 2
SSD_HPG = SSD_HEADS // SSD_GROUPS
SSD_STATE = 128
SSD_CHUNK = 128
SSD_GN = SSD_GROUPS * SSD_STATE
SSD_CONV_DIM = SSD_WIDTH + 2 * SSD_GN
CONV_WIDTH = 4
LRU_WIDTH = D_MIX // 4
LRU_HEADS = 8
LRU_HDIM = LRU_WIDTH // LRU_HEADS
LRU_C = 8.0
N_MEM = 256
MEM_HEADS = 4
MEM_HDIM = D_MODEL // MEM_HEADS
D_FF = -(-8 * D_MODEL // (3 * 256)) * 256
EPS = 1e-6
OFF_POOL = 0
OFF_Z = OFF_POOL + POOL_WIDTH
OFF_XBC = OFF_Z + SSD_WIDTH
OFF_DT = OFF_XBC + SSD_CONV_DIM
OFF_GATE = OFF_DT + SSD_HEADS
OFF_LRU = OFF_GATE + LRU_WIDTH
N_IN = OFF_LRU + LRU_WIDTH

kernel_name = "hybrid_pool_ssd_rglru_memxattn_step"

F32 = jnp.float32


def rmsnorm(x, g):
    xf = x.astype(F32)
    var = jnp.mean(xf * xf, axis=-1, keepdims=True)
    return (xf * lax.rsqrt(var + EPS) * g.astype(F32)).astype(x.dtype)


def causal_dwconv(x, buf, w, b):
    L = x.shape[1]
    xp = jnp.concatenate([buf.astype(x.dtype), x], axis=1)
    y = b
    for k in range(CONV_WIDTH):
        y = y + w[k] * xp[:, k:k + L]
    return y, xp[:, -(CONV_WIDTH - 1):]


def pool_mixer(u, buf, pos0, w_grp, scale):
    B, L, _ = u.shape
    up = jnp.concatenate([buf.astype(u.dtype), u], axis=1).astype(F32)
    cs = jnp.pad(jnp.cumsum(up, axis=1), ((0, 0), (1, 0), (0, 0)))
    end = cs[:, POOL_BUF + 1:]
    pos = pos0 + jnp.arange(L)
    outs = []
    for g, w in enumerate(POOL_WINDOWS):
        sl = slice(g * POOL_GDIM, (g + 1) * POOL_GDIM)
        start = cs[:, POOL_BUF + 1 - w:POOL_BUF + 1 - w + L, sl]
        cnt = jnp.minimum(pos + 1, w).astype(F32)[None, :, None]
        outs.append((end[..., sl] - start) / cnt)
    pooled = jnp.concatenate(outs, axis=-1) - up[:, POOL_BUF:]
    pooled = pooled.reshape(B, L, POOL_GROUPS, POOL_GDIM)
    y = jnp.einsum('blgc,gcd->blgd', pooled, w_grp.astype(F32)).reshape(B, L, POOL_WIDTH)
    y = y * scale.astype(F32)
    return y.astype(u.dtype), up[:, -POOL_BUF:].astype(u.dtype)


def ssd_mixer(z, xbc, dt_raw, conv_buf, h0, conv_w, conv_b, dt_bias, a_log, d_skip, norm_g):
    B, L, _ = z.shape
    G, K, P, N = SSD_GROUPS, SSD_HPG, SSD_HEAD_DIM, SSD_STATE
    xbc, new_conv = causal_dwconv(xbc, conv_buf, conv_w, conv_b)
    xbc = jax.nn.silu(xbc).astype(F32)
    xs = xbc[..., :SSD_WIDTH].reshape(B, L, G, K, P)
    Bm = xbc[..., SSD_WIDTH:SSD_WIDTH + SSD_GN].reshape(B, L, G, N)
    Cm = xbc[..., SSD_WIDTH + SSD_GN:].reshape(B, L, G, N)
    dt = jax.nn.softplus(dt_raw.astype(F32) + dt_bias.astype(F32)).reshape(B, L, G, K)
    A = -jnp.exp(a_log.astype(F32)).reshape(G, K)
    Q = min(SSD_CHUNK, L)
    nC = -(-L // Q)
    pad = nC * Q - L

    def chunk(t):
        t = jnp.pad(t, ((0, 0), (0, pad)) + ((0, 0),) * (t.ndim - 2))
        return t.reshape((B, nC, Q) + t.shape[2:])

    xs, Bm, Cm, dt = chunk(xs), chunk(Bm), chunk(Cm), chunk(dt)
    acs = jnp.cumsum(dt * A, axis=2)
    xdt = xs * dt[..., None]
    acs_t = jnp.einsum('bcqgk->bcgkq', acs)
    seg = acs_t[..., :, None] - acs_t[..., None, :]
    mask = jnp.tril(jnp.ones((Q, Q), dtype=bool))
    Lmat = jnp.where(mask, jnp.exp(jnp.where(mask, seg, 0.0)), 0.0)
    CB = jnp.einsum('bclgn,bcsgn->bcgls', Cm, Bm)
    y_diag = jnp.einsum('bcgls,bcgkls,bcsgkp->bclgkp', CB, Lmat, xdt)
    decay_st = jnp.exp(acs[:, :, -1:] - acs)
    states = jnp.einsum('bcsgn,bcsgk,bcsgkp->bcgkpn', Bm, decay_st, xdt)
    chunk_decay = jnp.exp(acs[:, :, -1])

    def step(h, inp):
        st, dec = inp
        return h * dec[..., None, None] + st, h

    h_init = h0.astype(F32).reshape(B, G, K, P, N)
    hT, starts = lax.scan(step, h_init, (jnp.moveaxis(states, 1, 0), jnp.moveaxis(chunk_decay, 1, 0)))
    starts = jnp.moveaxis(starts, 0, 1)
    y_off = jnp.einsum('bclgn,bcgkpn,bclgk->bclgkp', Cm, starts, jnp.exp(acs))
    y = y_diag + y_off + xs * d_skip.astype(F32).reshape(G, K)[..., None]
    y = y.reshape(B, nC * Q, SSD_WIDTH)[:, :L]
    y = rmsnorm(y * jax.nn.silu(z.astype(F32)), norm_g)
    return y.astype(z.dtype), new_conv, hT.reshape(B, SSD_HEADS, P, N).astype(z.dtype)


def rglru_mixer(gate_in, xr, conv_buf, h0, pos0, conv_w, conv_b, wa, ba, wx, bx, lam):
    B, L, _ = xr.shape
    xc, new_conv = causal_dwconv(xr, conv_buf, conv_w, conv_b)
    xf = xc.astype(F32)
    xh = xf.reshape(B, L, LRU_HEADS, LRU_HDIM)
    r = jax.nn.sigmoid(jnp.einsum('blhi,hij->blhj', xh, wa.astype(F32)) + ba.astype(F32)).reshape(B, L, LRU_WIDTH)
    i = jax.nn.sigmoid(jnp.einsum('blhi,hij->blhj', xh, wx.astype(F32)) + bx.astype(F32)).reshape(B, L, LRU_WIDTH)
    log_a = -LRU_C * r * jax.nn.softplus(-lam.astype(F32))
    a = jnp.exp(log_a)
    pos = pos0 + jnp.arange(L)
    mult = jnp.where((pos == 0)[None, :, None], 1.0, jnp.sqrt(-jnp.expm1(2.0 * log_a)))
    b_in = mult * i * xf
    b_in = b_in.at[:, 0].add(a[:, 0] * h0.astype(F32))

    def comb(lhs, rhs):
        a1, b1 = lhs
        a2, b2 = rhs
        return a1 * a2, a2 * b1 + b2

    _, h = lax.associative_scan(comb, (a, b_in), axis=1)
    y = h * jax.nn.gelu(gate_in.astype(F32))
    return y.astype(xr.dtype), new_conv, h[:, -1].astype(xr.dtype)


def mem_attention(u, k, v, wq, wo):
    B, L, _ = u.shape
    q = (u @ wq).reshape(B, L, MEM_HEADS, MEM_HDIM)
    s = jnp.einsum('blhd,bmhd->bhlm', q, k).astype(F32) * (MEM_HDIM ** -0.5)
    p = jax.nn.softmax(s, axis=-1).astype(v.dtype)
    o = jnp.einsum('bhlm,bmhd->blhd', p, v).reshape(B, L, D_MODEL)
    return o @ wo


def run_trunk(x, pos0, pool_s, sconv_s, ssd_s, lconv_s, lru_s, mem_k, mem_v, W):
    h = x
    n_pool, n_sconv, n_ssd, n_lconv, n_lru = [], [], [], [], []
    for l in range(DEPTH):
        u = rmsnorm(h, W['norm_mix'][l])
        proj = jnp.einsum('bld,de->ble', u, W['w_in'][l])
        ya, s1 = pool_mixer(proj[..., OFF_POOL:OFF_Z], pool_s[l], pos0, W['pool_w'][l], W['pool_scale'][l])
        yb, s2, s3 = ssd_mixer(proj[..., OFF_Z:OFF_XBC], proj[..., OFF_XBC:OFF_DT], proj[..., OFF_DT:OFF_GATE],
                               sconv_s[l], ssd_s[l], W['ssd_conv_w'][l], W['ssd_conv_b'][l], W['ssd_dt_bias'][l],
                               W['ssd_a_log'][l], W['ssd_d'][l], W['ssd_norm'][l])
        yc, s4, s5 = rglru_mixer(proj[..., OFF_GATE:OFF_LRU], proj[..., OFF_LRU:N_IN], lconv_s[l], lru_s[l], pos0,
                                 W['lru_conv_w'][l], W['lru_conv_b'][l], W['lru_wa'][l], W['lru_ba'][l],
                                 W['lru_wx'][l], W['lru_bx'][l], W['lru_lambda'][l])
        h = h + jnp.concatenate([ya, yb, yc], axis=-1) @ W['w_out'][l]
        h = h + mem_attention(rmsnorm(h, W['norm_mem'][l]), mem_k[l], mem_v[l], W['w_mem_q'][l], W['w_mem_o'][l])
        u = rmsnorm(h, W['norm_ffn'][l])
        h = h + (jax.nn.silu(u @ W['w_ffn_gate'][l]) * (u @ W['w_ffn_up'][l])) @ W['w_ffn_down'][l]
        n_pool.append(s1); n_sconv.append(s2); n_ssd.append(s3); n_lconv.append(s4); n_lru.append(s5)
    y = rmsnorm(h, W['norm_final'])
    return (y, jnp.stack(n_pool), jnp.stack(n_sconv), jnp.stack(n_ssd), jnp.stack(n_lconv), jnp.stack(n_lru))


def setup_inputs(seed: int = 0) -> dict:
    key = jax.random.key(seed)
    ks = iter(jax.random.split(key, 64))

    def nrm(shape, scale=1.0):
        return jax.random.normal(next(ks), shape, F32) * scale

    def gain(shape):
        return 1.0 + nrm(shape, 0.02)

    dt0 = jnp.exp(jax.random.uniform(next(ks), (DEPTH, SSD_HEADS), F32, math.log(1e-3), math.log(1e-1)))
    base = jax.random.uniform(next(ks), (DEPTH, LRU_WIDTH), F32, 0.9, 0.999) ** (1.0 / LRU_C)
    return {
        "x_prompt": nrm((BATCH, SEQ, D_MODEL)),
        "x_sample": nrm((DEC_BATCH, DEC_SEQ, D_MODEL)),
        "mem_prompt": nrm((BATCH, N_MEM, D_MODEL)),
        "state_pool": nrm((DEPTH, DEC_BATCH, POOL_BUF, POOL_WIDTH)),
        "state_ssd_conv": nrm((DEPTH, DEC_BATCH, CONV_WIDTH - 1, SSD_CONV_DIM)),
        "state_ssd": nrm((DEPTH, DEC_BATCH, SSD_HEADS, SSD_HEAD_DIM, SSD_STATE), 0.1),
        "state_lru_conv": nrm((DEPTH, DEC_BATCH, CONV_WIDTH - 1, LRU_WIDTH)),
        "state_lru": nrm((DEPTH, DEC_BATCH, LRU_WIDTH)),
        "cache_mem_k": nrm((DEPTH, DEC_BATCH, N_MEM, MEM_HEADS, MEM_HDIM)),
        "cache_mem_v": nrm((DEPTH, DEC_BATCH, N_MEM, MEM_HEADS, MEM_HDIM)),
        "norm_mix": gain((DEPTH, D_MODEL)),
        "w_in": nrm((DEPTH, D_MODEL, N_IN), D_MODEL ** -0.5),
        "pool_w": nrm((DEPTH, POOL_GROUPS, POOL_GDIM, POOL_GDIM), POOL_GDIM ** -0.5),
        "pool_scale": gain((DEPTH, POOL_WIDTH)),
        "ssd_conv_w": nrm((DEPTH, CONV_WIDTH, SSD_CONV_DIM), CONV_WIDTH ** -0.5),
        "ssd_conv_b": nrm((DEPTH, SSD_CONV_DIM), 0.01),
        "ssd_dt_bias": dt0 + jnp.log(-jnp.expm1(-dt0)),
        "ssd_a_log": jnp.log(jax.random.uniform(next(ks), (DEPTH, SSD_HEADS), F32, 1.0, 16.0)),
        "ssd_d": gain((DEPTH, SSD_HEADS)),
        "ssd_norm": gain((DEPTH, SSD_WIDTH)),
        "lru_conv_w": nrm((DEPTH, CONV_WIDTH, LRU_WIDTH), CONV_WIDTH ** -0.5),
        "lru_conv_b": nrm((DEPTH, LRU_WIDTH), 0.01),
        "lru_wa": nrm((DEPTH, LRU_HEADS, LRU_HDIM, LRU_HDIM), LRU_HDIM ** -0.5),
        "lru_ba": nrm((DEPTH, LRU_HEADS, LRU_HDIM), 0.01),
        "lru_wx": nrm((DEPTH, LRU_HEADS, LRU_HDIM, LRU_HDIM), LRU_HDIM ** -0.5),
        "lru_bx": nrm((DEPTH, LRU_HEADS, LRU_HDIM), 0.01),
        "lru_lambda": jnp.log(base / (1.0 - base)),
        "w_out": nrm((DEPTH, D_MIX, D_MODEL), D_MIX ** -0.5),
        "norm_mem": gain((DEPTH, D_MODEL)),
        "w_mem_q": nrm((DEPTH, D_MODEL, D_MODEL), D_MODEL ** -0.5),
        "w_mem_k": nrm((DEPTH, D_MODEL, D_MODEL), D_MODEL ** -0.5),
        "w_mem_v": nrm((DEPTH, D_MODEL, D_MODEL), D_MODEL ** -0.5),
        "w_mem_o": nrm((DEPTH, D_MODEL, D_MODEL), D_MODEL ** -0.5),
        "norm_ffn": gain((DEPTH, D_MODEL)),
        "w_ffn_gate": nrm((DEPTH, D_MODEL, D_FF), D_MODEL ** -0.5),
        "w_ffn_up": nrm((DEPTH, D_MODEL, D_FF), D_MODEL ** -0.5),
        "w_ffn_down": nrm((DEPTH, D_FF, D_MODEL), D_FF ** -0.5),
        "norm_final": gain((D_MODEL,)),
    }


def reference(x_prompt, x_sample, mem_prompt, state_pool, state_ssd_conv, state_ssd, state_lru_conv, state_lru,
              cache_mem_k, cache_mem_v, norm_mix, w_in, pool_w, pool_scale, ssd_conv_w, ssd_conv_b, ssd_dt_bias,
              ssd_a_log, ssd_d, ssd_norm, lru_conv_w, lru_conv_b, lru_wa, lru_ba, lru_wx, lru_bx, lru_lambda,
              w_out, norm_mem, w_mem_q, w_mem_k, w_mem_v, w_mem_o, norm_ffn, w_ffn_gate, w_ffn_up, w_ffn_down,
              norm_final):
    W = dict(norm_mix=norm_mix, w_in=w_in, pool_w=pool_w, pool_scale=pool_scale, ssd_conv_w=ssd_conv_w,
             ssd_conv_b=ssd_conv_b, ssd_dt_bias=ssd_dt_bias, ssd_a_log=ssd_a_log, ssd_d=ssd_d, ssd_norm=ssd_norm,
             lru_conv_w=lru_conv_w, lru_conv_b=lru_conv_b, lru_wa=lru_wa, lru_ba=lru_ba, lru_wx=lru_wx,
             lru_bx=lru_bx, lru_lambda=lru_lambda, w_out=w_out, norm_mem=norm_mem, w_mem_q=w_mem_q,
             w_mem_o=w_mem_o, norm_ffn=norm_ffn, w_ffn_gate=w_ffn_gate, w_ffn_up=w_ffn_up,
             w_ffn_down=w_ffn_down, norm_final=norm_final)
    dt = x_prompt.dtype
    p_mem_k = jnp.einsum('bmd,lde->lbme', mem_prompt, w_mem_k).reshape(DEPTH, BATCH, N_MEM, MEM_HEADS, MEM_HDIM)
    p_mem_v = jnp.einsum('bmd,lde->lbme', mem_prompt, w_mem_v).reshape(DEPTH, BATCH, N_MEM, MEM_HEADS, MEM_HDIM)
    z_pool = jnp.zeros((DEPTH, BATCH, POOL_BUF, POOL_WIDTH), dt)
    z_sconv = jnp.zeros((DEPTH, BATCH, CONV_WIDTH - 1, SSD_CONV_DIM), dt)
    z_ssd = jnp.zeros((DEPTH, BATCH, SSD_HEADS, SSD_HEAD_DIM, SSD_STATE), dt)
    z_lconv = jnp.zeros((DEPTH, BATCH, CONV_WIDTH - 1, LRU_WIDTH), dt)
    z_lru = jnp.zeros((DEPTH, BATCH, LRU_WIDTH), dt)
    y_prompt, p_pool, p_sconv, p_ssd, p_lconv, p_lru = run_trunk(
        x_prompt, 0, z_pool, z_sconv, z_ssd, z_lconv, z_lru, p_mem_k, p_mem_v, W)
    y_sample, s_pool, s_sconv, s_ssd, s_lconv, s_lru = run_trunk(
        x_sample, PAST_LEN, state_pool, state_ssd_conv, state_ssd, state_lru_conv, state_lru,
        cache_mem_k, cache_mem_v, W)
    return (y_prompt, y_sample, p_pool, p_sconv, p_ssd, p_lconv, p_lru, p_mem_k, p_mem_v,
            s_pool, s_sconv, s_ssd, s_lconv, s_lru)
```

```cpp
#include <hip/hip_runtime.h>
#include <cstdio>
#include <cstdint>

namespace nv {
constexpr int D = 1024, MP = 16384, MS = 512, MT = MP + MS, NSEQ = 136, DEPTH = 4;
constexpr int NIN = 4112, OFF_POOL = 0, OFF_Z = 512, OFF_XBC = 1536, OFF_DT = 3072, OFF_GATE = 3088, OFF_LRU = 3600;
constexpr int DFF = 2816;
constexpr float EPS = 1e-6f;

struct SeqInfo { int row0, L, pos0, b, grp; };
__device__ __forceinline__ SeqInfo seq_info(int s) {
    SeqInfo q;
    if (s < 8) { q.row0 = s * 2048; q.L = 2048; q.pos0 = 0; q.b = s; q.grp = 0; }
    else { q.b = s - 8; q.row0 = MP + q.b * 4; q.L = 4; q.pos0 = 16384; q.grp = 1; }
    return q;
}
__device__ __forceinline__ void row_info(int r, int& s, int& t) {
    if (r < MP) { s = r >> 11; t = r & 2047; } else { const int q = r - MP; s = 8 + (q >> 2); t = q & 3; }
}
__device__ __forceinline__ float wave_sum(float v) {
#pragma unroll
    for (int o = 1; o < 64; o <<= 1) v += __shfl_xor(v, o);
    return v;
}
__device__ __forceinline__ float wave_max(float v) {
#pragma unroll
    for (int o = 1; o < 64; o <<= 1) v = fmaxf(v, __shfl_xor(v, o));
    return v;
}
__device__ __forceinline__ float silu_f(float x) { return x / (1.f + expf(-x)); }
__device__ __forceinline__ float sigmoid_f(float x) { return 1.f / (1.f + expf(-x)); }
__device__ __forceinline__ float softplus_f(float x) { return x > 20.f ? x : log1pf(expf(x)); }
__device__ __forceinline__ float gelu_tanh_f(float x) { return 0.5f * x * (1.f + tanhf(0.7978845608028654f * (x + 0.044715f * x * x * x))); }

__global__ __launch_bounds__(256) void k_rmsnorm(const float* h, const float* __restrict__ g, float* u, int rows) {
    const int lane = threadIdx.x & 63, wave = (blockIdx.x * blockDim.x + threadIdx.x) >> 6, nw = (gridDim.x * blockDim.x) >> 6;
    for (int r = wave; r < rows; r += nw) {
        const float4* p = (const float4*)(h + (size_t)r * D);
        float4 v[4]; float ss = 0.f;
#pragma unroll
        for (int j = 0; j < 4; ++j) { v[j] = p[lane + 64 * j]; ss += v[j].x * v[j].x + v[j].y * v[j].y + v[j].z * v[j].z + v[j].w * v[j].w; }
        ss = wave_sum(ss);
        const float rstd = 1.0f / sqrtf(ss * (1.0f / D) + EPS);
        float4* o = (float4*)(u + (size_t)r * D);
#pragma unroll
        for (int j = 0; j < 4; ++j) { const float4 gg = ((const float4*)g)[lane + 64 * j]; float4 w; w.x = v[j].x * rstd * gg.x; w.y = v[j].y * rstd * gg.y; w.z = v[j].z * rstd * gg.z; w.w = v[j].w * rstd * gg.w; o[lane + 64 * j] = w; }
    }
}

template <int ACC>
__global__ __launch_bounds__(256) void k_sgemm(const float* __restrict__ A, int lda, const float* __restrict__ W, int ldw, float* C, int ldc, int M, int N, int K) {
    __shared__ __attribute__((aligned(16))) float As[16][132];
    __shared__ __attribute__((aligned(16))) float Bs[16][132];
    const int tid = threadIdx.x, ty = tid >> 4, tx = tid & 15;
    const int tilesN = (N + 127) / 128, tilesM = M / 128;
    for (int tile = blockIdx.x; tile < tilesM * tilesN; tile += gridDim.x) {
        const int m0 = (tile / tilesN) * 128, n0 = (tile % tilesN) * 128;
        float acc[8][8];
#pragma unroll
        for (int i = 0; i < 8; ++i)
#pragma unroll
            for (int j = 0; j < 8; ++j) acc[i][j] = 0.f;
        for (int k0 = 0; k0 < K; k0 += 16) {
            {
                const int row = tid >> 1, kq = (tid & 1) * 8;
                const float* ap = A + (size_t)(m0 + row) * lda + k0 + kq;
                const float4 a0 = *(const float4*)ap, a1 = *(const float4*)(ap + 4);
                As[kq + 0][row] = a0.x; As[kq + 1][row] = a0.y; As[kq + 2][row] = a0.z; As[kq + 3][row] = a0.w;
                As[kq + 4][row] = a1.x; As[kq + 5][row] = a1.y; As[kq + 6][row] = a1.z; As[kq + 7][row] = a1.w;
            }
            {
                const int kr = tid >> 4, col = (tid & 15) * 8;
                const float* wp = W + (size_t)(k0 + kr) * ldw + n0 + col;
                float4 b0 = make_float4(0.f, 0.f, 0.f, 0.f), b1 = b0;
                if (n0 + col + 4 <= N) b0 = *(const float4*)wp;
                if (n0 + col + 8 <= N) b1 = *(const float4*)(wp + 4);
                *(float4*)&Bs[kr][col] = b0; *(float4*)&Bs[kr][col + 4] = b1;
            }
            __syncthreads();
#pragma unroll
            for (int kk = 0; kk < 16; ++kk) {
                float a[8], b[8];
                const float4 a0 = *(const float4*)&As[kk][ty * 8], a1 = *(const float4*)&As[kk][ty * 8 + 4];
                const float4 b0 = *(const float4*)&Bs[kk][tx * 8], b1 = *(const float4*)&Bs[kk][tx * 8 + 4];
                a[0] = a0.x; a[1] = a0.y; a[2] = a0.z; a[3] = a0.w; a[4] = a1.x; a[5] = a1.y; a[6] = a1.z; a[7] = a1.w;
                b[0] = b0.x; b[1] = b0.y; b[2] = b0.z; b[3] = b0.w; b[4] = b1.x; b[5] = b1.y; b[6] = b1.z; b[7] = b1.w;
#pragma unroll
                for (int i = 0; i < 8; ++i)
#pragma unroll
                    for (int j = 0; j < 8; ++j) acc[i][j] += a[i] * b[j];
            }
            __syncthreads();
        }
#pragma unroll
        for (int i = 0; i < 8; ++i) {
            const int row = m0 + ty * 8 + i;
#pragma unroll
            for (int jj = 0; jj < 2; ++jj) {
                const int col = n0 + tx * 8 + jj * 4;
                if (col + 4 <= N) {
                    float4* cp = (float4*)(C + (size_t)row * ldc + col);
                    float4 v = make_float4(acc[i][jj * 4 + 0], acc[i][jj * 4 + 1], acc[i][jj * 4 + 2], acc[i][jj * 4 + 3]);
                    if (ACC) { const float4 o = *cp; v.x += o.x; v.y += o.y; v.z += o.z; v.w += o.w; }
                    *cp = v;
                }
            }
        }
    }
}

__device__ __forceinline__ float pool_up(const float* proj, const float* st_in, const SeqInfo& q, int ci, int ch) {
    if (ci < 15) return q.grp ? st_in[((size_t)q.b * 15 + ci) * 512 + ch] : 0.f;
    return proj[(size_t)(q.row0 + ci - 15) * NIN + OFF_POOL + ch];
}
__global__ __launch_bounds__(256) void k_pool_pooled(const float* __restrict__ proj, const float* __restrict__ st_in, float* pooled, float* p_out, float* s_out) {
    const size_t gt = (size_t)blockIdx.x * blockDim.x + threadIdx.x, gs = (size_t)gridDim.x * blockDim.x;
    for (size_t idx = gt; idx < (size_t)MT * 512; idx += gs) {
        const int r = (int)(idx >> 9), ch = (int)(idx & 511);
        int s, t; row_info(r, s, t); const SeqInfo q = seq_info(s);
        const int g = ch >> 7, w = 2 << g;
        const int ce = t + 15;
        float sum = 0.f;
        for (int j = 0; j < w; ++j) sum += pool_up(proj, st_in, q, ce - j, ch);
        const int pos = q.pos0 + t;
        const float cnt = (float)((pos + 1 < w) ? (pos + 1) : w);
        pooled[idx] = sum / cnt - pool_up(proj, st_in, q, ce, ch);
    }
    for (size_t idx = gt; idx < (size_t)NSEQ * 15 * 512; idx += gs) {
        const int ch = (int)(idx & 511), j = (int)((idx >> 9) % 15), s = (int)((idx >> 9) / 15);
        const SeqInfo q = seq_info(s);
        const float v = pool_up(proj, st_in, q, q.L + j, ch);
        if (q.grp) s_out[((size_t)q.b * 15 + j) * 512 + ch] = v; else p_out[((size_t)q.b * 15 + j) * 512 + ch] = v;
    }
}
__global__ __launch_bounds__(256) void k_pool_mm(const float* __restrict__ pooled, const float* __restrict__ pw, const float* __restrict__ scale, float* mix) {
    const size_t gt = (size_t)blockIdx.x * blockDim.x + threadIdx.x, gs = (size_t)gridDim.x * blockDim.x;
    for (size_t idx = gt; idx < (size_t)MT * 512; idx += gs) {
        const int r = (int)(idx >> 9), col = (int)(idx & 511), g = col >> 7, d = col & 127;
        const float* pp = pooled + (size_t)r * 512 + g * 128; const float* wp = pw + (size_t)g * 128 * 128 + d;
        float acc = 0.f;
        for (int c = 0; c < 128; ++c) acc += pp[c] * wp[(size_t)c * 128];
        mix[(size_t)r * 2048 + col] = acc * scale[col];
    }
}

__device__ __forceinline__ float conv_xp(const float* proj, int off, const float* st_in, int C, const SeqInfo& q, int j, int c) {
    if (j < 3) return q.grp ? st_in[((size_t)q.b * 3 + j) * C + c] : 0.f;
    return proj[(size_t)(q.row0 + j - 3) * NIN + off + c];
}
template <int ACT>
__global__ __launch_bounds__(256) void k_conv(const float* __restrict__ proj, int off, int C, const float* __restrict__ cw, const float* __restrict__ cb, const float* __restrict__ st_in,
                                              float* dst, float* p_out, float* s_out) {
    const size_t gt = (size_t)blockIdx.x * blockDim.x + threadIdx.x, gs = (size_t)gridDim.x * blockDim.x;
    for (size_t idx = gt; idx < (size_t)MT * C; idx += gs) {
        const int r = (int)(idx / C), c = (int)(idx % C);
        int s, t; row_info(r, s, t); const SeqInfo q = seq_info(s);
        float acc = cb[c];
#pragma unroll
        for (int k = 0; k < 4; ++k) acc += cw[(size_t)k * C + c] * conv_xp(proj, off, st_in, C, q, t + k, c);
        dst[idx] = ACT ? silu_f(acc) : acc;
    }
    for (size_t idx = gt; idx < (size_t)NSEQ * 3 * C; idx += gs) {
        const int c = (int)(idx % C), j = (int)((idx / C) % 3), s = (int)(idx / ((size_t)3 * C));
        const SeqInfo q = seq_info(s);
        const float v = conv_xp(proj, off, st_in, C, q, q.L + j, c);
        if (q.grp) s_out[((size_t)q.b * 3 + j) * C + c] = v; else p_out[((size_t)q.b * 3 + j) * C + c] = v;
    }
}

__global__ __launch_bounds__(512) void k_ssd_scan(const float* __restrict__ xbc, const float* __restrict__ proj, const float* __restrict__ st_in,
                                                  const float* __restrict__ dt_bias, const float* __restrict__ a_log, const float* __restrict__ dsk,
                                                  float* yraw, float* p_out, float* s_out) {
    const int tid = threadIdx.x, p = tid >> 3, ng = tid & 7;
    for (int item = blockIdx.x; item < NSEQ * 16; item += gridDim.x) {
        const int s = item >> 4, hd = item & 15, g = hd >> 3;
        const SeqInfo q = seq_info(s);
        float h[16];
        const size_t sidx = (((size_t)q.b * 16 + hd) * 64 + p) * 128 + ng * 16;
#pragma unroll
        for (int i = 0; i < 16; ++i) h[i] = q.grp ? st_in[sidx + i] : 0.f;
        const float A = -expf(a_log[hd]), dtb = dt_bias[hd], Dk = dsk[hd];
        for (int t = 0; t < q.L; ++t) {
            const size_t r = (size_t)(q.row0 + t);
            const float dt = softplus_f(proj[r * NIN + OFF_DT + hd] + dtb);
            const float dA = expf(dt * A);
            const float x = xbc[r * 1536 + hd * 64 + p];
            const float* Bp = xbc + r * 1536 + 1024 + g * 128 + ng * 16;
            const float* Cp = xbc + r * 1536 + 1280 + g * 128 + ng * 16;
            const float xdt = dt * x;
            float part = 0.f;
#pragma unroll
            for (int i = 0; i < 16; ++i) { h[i] = h[i] * dA + xdt * Bp[i]; part += Cp[i] * h[i]; }
            part += __shfl_xor(part, 1); part += __shfl_xor(part, 2); part += __shfl_xor(part, 4);
            if (ng == 0) yraw[r * 1024 + hd * 64 + p] = part + Dk * x;
        }
        float* so = q.grp ? s_out : p_out;
#pragma unroll
        for (int i = 0; i < 16; ++i) so[sidx + i] = h[i];
    }
}
__global__ __launch_bounds__(256) void k_ssd_gate(const float* __restrict__ yraw, const float* __restrict__ proj, const float* __restrict__ g, float* mix) {
    const int lane = threadIdx.x & 63, wave = (blockIdx.x * blockDim.x + threadIdx.x) >> 6, nw = (gridDim.x * blockDim.x) >> 6;
    for (int r = wave; r < MT; r += nw) {
        float v[16]; float ss = 0.f;
#pragma unroll
        for (int j = 0; j < 16; ++j) { const int c = lane + 64 * j; const float z = proj[(size_t)r * NIN + OFF_Z + c]; v[j] = yraw[(size_t)r * 1024 + c] * silu_f(z); ss += v[j] * v[j]; }
        ss = wave_sum(ss);
        const float rstd = 1.0f / sqrtf(ss * (1.0f / 1024.f) + EPS);
#pragma unroll
        for (int j = 0; j < 16; ++j) { const int c = lane + 64 * j; mix[(size_t)r * 2048 + 512 + c] = v[j] * rstd * g[c]; }
    }
}

__global__ __launch_bounds__(256) void k_lru_gates(const float* __restrict__ xc, const float* __restrict__ wa, const float* __restrict__ ba, const float* __restrict__ wx, const float* __restrict__ bx,
                                                   const float* __restrict__ lam, float* abuf, float* bbuf) {
    const size_t gt = (size_t)blockIdx.x * blockDim.x + threadIdx.x, gs = (size_t)gridDim.x * blockDim.x;
    for (size_t idx = gt; idx < (size_t)MT * 512; idx += gs) {
        const int r = (int)(idx >> 9), c = (int)(idx & 511), hd = c >> 6, j = c & 63;
        int s, t; row_info(r, s, t); const SeqInfo q = seq_info(s);
        float ar = ba[c], ai = bx[c];
        const float* xp = xc + (size_t)r * 512 + hd * 64;
        for (int i = 0; i < 64; ++i) { const float xv = xp[i]; ar += xv * wa[((size_t)hd * 64 + i) * 64 + j]; ai += xv * wx[((size_t)hd * 64 + i) * 64 + j]; }
        const float rg = sigmoid_f(ar), ig = sigmoid_f(ai);
        const float log_a = -8.0f * rg * softplus_f(-lam[c]);
        const float a = expf(log_a);
        const int pos = q.pos0 + t;
        const float mult = (pos == 0) ? 1.0f : sqrtf(-expm1f(2.0f * log_a));
        abuf[idx] = a; bbuf[idx] = mult * ig * xc[idx];
    }
}
__global__ __launch_bounds__(256) void k_lru_scan(const float* __restrict__ abuf, const float* __restrict__ bbuf, const float* __restrict__ proj, const float* __restrict__ st_in,
                                                  float* mix, float* p_out, float* s_out) {
    const int gt = blockIdx.x * blockDim.x + threadIdx.x, gs = gridDim.x * blockDim.x;
    for (int idx = gt; idx < NSEQ * 512; idx += gs) {
        const int s = idx >> 9, c = idx & 511; const SeqInfo q = seq_info(s);
        float h = q.grp ? st_in[(size_t)q.b * 512 + c] : 0.f;
        for (int t = 0; t < q.L; ++t) {
            const size_t r = (size_t)(q.row0 + t);
            h = abuf[r * 512 + c] * h + bbuf[r * 512 + c];
            mix[r * 2048 + 1536 + c] = h * gelu_tanh_f(proj[r * NIN + OFF_GATE + c]);
        }
        if (q.grp) s_out[(size_t)q.b * 512 + c] = h; else p_out[(size_t)q.b * 512 + c] = h;
    }
}

__global__ __launch_bounds__(256) void k_attn(const float* __restrict__ qb, const float* __restrict__ Kp, const float* __restrict__ Vp, const float* __restrict__ Ks, const float* __restrict__ Vs, float* ob) {
    __shared__ __attribute__((aligned(16))) float qs[4][256];
    __shared__ float ps[4][256];
    const int tid = threadIdx.x, hh = tid >> 6, lane = tid & 63;
    for (int r = blockIdx.x; r < MT; r += gridDim.x) {
        int s, t; row_info(r, s, t); const SeqInfo q = seq_info(s);
        const float* Kb = (q.grp ? Ks : Kp) + (size_t)q.b * 256 * 1024 + hh * 256;
        const float* Vb = (q.grp ? Vs : Vp) + (size_t)q.b * 256 * 1024 + hh * 256;
        __syncthreads();
        *(float4*)&qs[hh][lane * 4] = *(const float4*)(qb + (size_t)r * 1024 + hh * 256 + lane * 4);
        __syncthreads();
        float sc[4];
#pragma unroll
        for (int kk = 0; kk < 4; ++kk) {
            const int key = lane + 64 * kk; const float4* kp = (const float4*)(Kb + (size_t)key * 1024);
            float d = 0.f;
            for (int j = 0; j < 64; ++j) { const float4 kv = kp[j]; const float4 qv = *(const float4*)&qs[hh][j * 4]; d += kv.x * qv.x + kv.y * qv.y + kv.z * qv.z + kv.w * qv.w; }
            sc[kk] = d * 0.0625f;
        }
        const float m = wave_max(fmaxf(fmaxf(sc[0], sc[1]), fmaxf(sc[2], sc[3])));
        float e[4], sum = 0.f;
#pragma unroll
        for (int kk = 0; kk < 4; ++kk) { e[kk] = expf(sc[kk] - m); sum += e[kk]; }
        sum = wave_sum(sum);
        const float inv = 1.0f / sum;
#pragma unroll
        for (int kk = 0; kk < 4; ++kk) ps[hh][lane + 64 * kk] = e[kk] * inv;
        __syncthreads();
        float4 o = make_float4(0.f, 0.f, 0.f, 0.f);
        for (int key = 0; key < 256; ++key) { const float pv = ps[hh][key]; const float4 vv = *(const float4*)(Vb + (size_t)key * 1024 + lane * 4); o.x += pv * vv.x; o.y += pv * vv.y; o.z += pv * vv.z; o.w += pv * vv.w; }
        *(float4*)(ob + (size_t)r * 1024 + hh * 256 + lane * 4) = o;
    }
}

__global__ __launch_bounds__(256) void k_swiglu(float* G, const float* __restrict__ U, size_t n) {
    const size_t gt = (size_t)blockIdx.x * blockDim.x + threadIdx.x, gs = (size_t)gridDim.x * blockDim.x;
    for (size_t i = gt; i < n; i += gs) G[i] = silu_f(G[i]) * U[i];
}
}

extern "C" void kernel_launch(void* const* d_in, const int* in_sizes, int n_in, void* d_out, int out_size, void* d_ws, size_t ws_size, hipStream_t stream) {
    using namespace nv;
    if (n_in != 38) { fprintf(stderr, "kernel_launch: expected 38 inputs, got %d\n", n_in); return; }
    const float* in[38]; for (int i = 0; i < 38; ++i) in[i] = (const float*)d_in[i];
    float* out = (float*)d_out;
    const size_t O_Y = 0, O_PPOOL = (size_t)MT * D, O_PSCONV = O_PPOOL + 245760, O_PSSD = O_PSCONV + 147456, O_PLCONV = O_PSSD + 4194304, O_PLRU = O_PLCONV + 49152,
                 O_PMK = O_PLRU + 16384, O_PMV = O_PMK + 8388608, O_SPOOL = O_PMV + 8388608, O_SSCONV = O_SPOOL + 3932160, O_SSSD = O_SSCONV + 2359296,
                 O_SLCONV = O_SSSD + 67108864, O_SLRU = O_SLCONV + 786432, O_END = O_SLRU + 262144;
    if ((size_t)out_size != O_END) { fprintf(stderr, "kernel_launch: out_size %d != %zu\n", out_size, O_END); return; }
    float* ws = (float*)d_ws;
    size_t o = 0;
    float* U = ws + o; o += (size_t)MT * 1024;
    float* BIG = ws + o; o += (size_t)MT * 5632;
    float* POOLED = ws + o; o += (size_t)MT * 512;
    float* XBC = ws + o; o += (size_t)MT * 1536;
    float* YRAW = ws + o; o += (size_t)MT * 1024;
    float* XC = ws + o; o += (size_t)MT * 512;
    float* AB = ws + o; o += (size_t)MT * 512;
    float* BB = ws + o; o += (size_t)MT * 512;
    float* MIX = ws + o; o += (size_t)MT * 2048;
    float* QB = ws + o; o += (size_t)MT * 1024;
    float* OB = ws + o; o += (size_t)MT * 1024;
    if (o * 4 > ws_size) { fprintf(stderr, "kernel_launch: workspace too small: need %zu have %zu\n", o * 4, ws_size); return; }
    float* H = out + O_Y;
    const int G1 = 2048;
    hipMemcpyAsync(H, in[0], (size_t)MP * D * 4, hipMemcpyDeviceToDevice, stream);
    hipMemcpyAsync(H + (size_t)MP * D, in[1], (size_t)MS * D * 4, hipMemcpyDeviceToDevice, stream);
    for (int l = 0; l < DEPTH; ++l) {
        k_sgemm<0><<<128, 256, 0, stream>>>(in[2], 1024, in[30] + (size_t)l * 1024 * 1024, 1024, out + O_PMK + (size_t)l * 2048 * 1024, 1024, 2048, 1024, 1024);
        k_sgemm<0><<<128, 256, 0, stream>>>(in[2], 1024, in[31] + (size_t)l * 1024 * 1024, 1024, out + O_PMV + (size_t)l * 2048 * 1024, 1024, 2048, 1024, 1024);
    }
    for (int l = 0; l < DEPTH; ++l) {
        float* PROJ = BIG;
        k_rmsnorm<<<G1, 256, 0, stream>>>(H, in[10] + (size_t)l * 1024, U, MT);
        k_sgemm<0><<<1024, 256, 0, stream>>>(U, 1024, in[11] + (size_t)l * 1024 * NIN, NIN, PROJ, NIN, MT, NIN, 1024);
        k_pool_pooled<<<G1, 256, 0, stream>>>(PROJ, in[3] + (size_t)l * 128 * 15 * 512, POOLED, out + O_PPOOL + (size_t)l * 8 * 15 * 512, out + O_SPOOL + (size_t)l * 128 * 15 * 512);
        k_pool_mm<<<G1, 256, 0, stream>>>(POOLED, in[12] + (size_t)l * 4 * 128 * 128, in[13] + (size_t)l * 512, MIX);
        k_conv<1><<<G1, 256, 0, stream>>>(PROJ, OFF_XBC, 1536, in[14] + (size_t)l * 4 * 1536, in[15] + (size_t)l * 1536, in[4] + (size_t)l * 128 * 3 * 1536, XBC,
                                          out + O_PSCONV + (size_t)l * 8 * 3 * 1536, out + O_SSCONV + (size_t)l * 128 * 3 * 1536);
        k_ssd_scan<<<NSEQ * 16, 512, 0, stream>>>(XBC, PROJ, in[5] + (size_t)l * 128 * 16 * 64 * 128, in[16] + l * 16, in[17] + l * 16, in[18] + l * 16, YRAW,
                                                   out + O_PSSD + (size_t)l * 8 * 16 * 64 * 128, out + O_SSSD + (size_t)l * 128 * 16 * 64 * 128);
        k_ssd_gate<<<G1, 256, 0, stream>>>(YRAW, PROJ, in[19] + (size_t)l * 1024, MIX);
        k_conv<0><<<G1, 256, 0, stream>>>(PROJ, OFF_LRU, 512, in[20] + (size_t)l * 4 * 512, in[21] + (size_t)l * 512, in[6] + (size_t)l * 128 * 3 * 512, XC,
                                          out + O_PLCONV + (size_t)l * 8 * 3 * 512, out + O_SLCONV + (size_t)l * 128 * 3 * 512);
        k_lru_gates<<<G1, 256, 0, stream>>>(XC, in[22] + (size_t)l * 8 * 64 * 64, in[23] + (size_t)l * 512, in[24] + (size_t)l * 8 * 64 * 64, in[25] + (size_t)l * 512, in[26] + (size_t)l * 512, AB, BB);
        k_lru_scan<<<(NSEQ * 512 + 255) / 256, 256, 0, stream>>>(AB, BB, PROJ, in[7] + (size_t)l * 128 * 512, MIX, out + O_PLRU + (size_t)l * 8 * 512, out + O_SLRU + (size_t)l * 128 * 512);
        k_sgemm<1><<<1024, 256, 0, stream>>>(MIX, 2048, in[27] + (size_t)l * 2048 * 1024, 1024, H, 1024, MT, 1024, 2048);
        k_rmsnorm<<<G1, 256, 0, stream>>>(H, in[28] + (size_t)l * 1024, U, MT);
        k_sgemm<0><<<1024, 256, 0, stream>>>(U, 1024, in[29] + (size_t)l * 1024 * 1024, 1024, QB, 1024, MT, 1024, 1024);
        k_attn<<<4096, 256, 0, stream>>>(QB, out + O_PMK + (size_t)l * 2048 * 1024, out + O_PMV + (size_t)l * 2048 * 1024, in[8] + (size_t)l * 128 * 256 * 1024, in[9] + (size_t)l * 128 * 256 * 1024, OB);
        k_sgemm<1><<<1024, 256, 0, stream>>>(OB, 1024, in[32] + (size_t)l * 1024 * 1024, 1024, H, 1024, MT, 1024, 1024);
        float* Gg = BIG; float* Uu = BIG + (size_t)MT * DFF;
        k_rmsnorm<<<G1, 256, 0, stream>>>(H, in[33] + (size_t)l * 1024, U, MT);
        k_sgemm<0><<<1024, 256, 0, stream>>>(U, 1024, in[34] + (size_t)l * 1024 * DFF, DFF, Gg, DFF, MT, DFF, 1024);
        k_sgemm<0><<<1024, 256, 0, stream>>>(U, 1024, in[35] + (size_t)l * 1024 * DFF, DFF, Uu, DFF, MT, DFF, 1024);
        k_swiglu<<<G1, 256, 0, stream>>>(Gg, Uu, (size_t)MT * DFF);
        k_sgemm<1><<<1024, 256, 0, stream>>>(Gg, DFF, in[36] + (size_t)l * DFF * 1024, 1024, H, 1024, MT, 1024, DFF);
    }
    k_rmsnorm<<<G1, 256, 0, stream>>>(H, in[37], H, MT);
}
```

```cpp
#include <hip/hip_runtime.h>
#include <cstdio>
#include <cstdint>
namespace pg8 {
#define PG8_LAS __attribute__((address_space(3)))
typedef unsigned short bf16_t;
typedef short bf16x8 __attribute__((ext_vector_type(8)));
typedef float f32x4 __attribute__((ext_vector_type(4)));
typedef unsigned u32x4 __attribute__((ext_vector_type(4)));
constexpr int BM = 256, BK = 64, HALF = 128, HTB = HALF * BK * 2  , STAGE_BYTES = 8 * HTB, NXCD = 8, WGM = 4;

__host__ __device__ __forceinline__ int lds_byte(int r, int c) { const int st = (r >> 4) * 2 + (c >> 5), rr = r & 15, cc = c & 31, ob = rr * 64 + cc * 2; return st * 1024 + (ob ^ (((ob >> 9) & 1) << 5)); }
__host__ __device__ __forceinline__ void stage_rc(int b, int& R, int& C) { const int st = b / 1024, sb = b % 1024, swz = sb ^ (((sb >> 9) & 1) << 5); R = (st >> 1) * 16 + swz / 64; C = (st & 1) * 32 + (swz % 64) / 2; }
__host__ __device__ __forceinline__ int perm32(int rho) { const int n = rho >> 4, i = rho & 15; return 8 * (i >> 2) + 4 * n + (i & 3); }

struct Unit { int pm, pn; };
struct Gemm { const bf16_t* A; const bf16_t* Bt; int M, N, K; };

struct StaticOrder {
    int nM, nN, nwg, G, c;
    __host__ __device__ void init(int M, int N, int G_, int c_) { nM = M / BM; nN = N / BM; nwg = nM * nN; G = G_; c = c_; }
    __host__ __device__ bool next(int i, Unit& u) const {
        const long L = (long)i * G + c; if (L >= nwg) return false;
        int wgid = (int)L; { const int q = nwg / NXCD, r = nwg % NXCD, xcd = wgid % NXCD, off = wgid / NXCD; wgid = (xcd < r ? xcd * (q + 1) : r * (q + 1) + (xcd - r) * q) + off; }
        const int nig = WGM * nN, gid = wgid / nig, fm = gid * WGM, gsz = (nM - fm) < WGM ? (nM - fm) : WGM;
        u.pm = fm + ((wgid % nig) % gsz); u.pn = (wgid % nig) / gsz; return true;
    }
    __device__ __forceinline__ void a_ready(const Unit&) const {}
    __device__ __forceinline__ void done(const Unit&) const {}
};
__device__ __forceinline__ unsigned cvt_pk_bf16(float lo, float hi) { unsigned r; asm volatile("v_cvt_pk_bf16_f32 %0, %1, %2" : "=v"(r) : "v"(lo), "v"(hi)); return r; }
typedef float f32x2 __attribute__((ext_vector_type(2)));
__device__ __forceinline__ float fast_silu(float x) { return x * __builtin_amdgcn_rcpf(1.0f + __builtin_amdgcn_exp2f(-1.4426950408889634f * x)); }
struct EpiKV {
    static constexpr bool PERM = false, AFTER_DRAIN = false; static constexpr int MID_T = 0;
    float* outk; size_t kvdelta;
    bf16_t* kb; bf16_t* vt;
    __device__ __forceinline__ void operator()(const f32x4 (&acc)[2][2][4][2], const Unit& u, int wr, int wc, int fr, int fq) const {
        const int n0 = u.pn * BM, l = n0 >> 11, kv = (n0 >> 10) & 1, e0 = n0 & 1023;
        float* C = outk + (size_t)kv * kvdelta + (size_t)l * (2048 * 1024);
        const int row0 = u.pm * BM + wr * 64 + fr, col0 = e0 + wc * 32 + 4 * fq;
#pragma unroll
        for (int ai = 0; ai < 2; ++ai)
#pragma unroll
            for (int m = 0; m < 4; ++m) { const int row = row0 + ai * HALF + m * 16; float* rowp = C + (size_t)row * 1024 + col0;
                const int mk = row & 255, prow = (row & ~255) | (mk & ~31) | (((mk >> 2) & 3) << 3) | (((mk >> 4) & 1) << 2) | (mk & 3);
#pragma unroll
                for (int bj = 0; bj < 2; ++bj)
#pragma unroll
                    for (int n = 0; n < 2; ++n) { const f32x4 v = acc[ai][bj][m][n]; const int col = col0 + bj * HALF + n * 16;
                        *(f32x4*)(rowp + bj * HALF + n * 16) = v;
                        if (kv == 0) { typedef unsigned u32x2v __attribute__((ext_vector_type(2))); u32x2v w; w.x = cvt_pk_bf16(v[0], v[1]); w.y = cvt_pk_bf16(v[2], v[3]);
                            *(u32x2v*)(kb + ((size_t)l * 2048 + row) * 1024 + col) = w; }
                        else { const unsigned w0 = cvt_pk_bf16(v[0], v[1]), w1 = cvt_pk_bf16(v[2], v[3]); bf16_t* vp = vt + ((size_t)l * 1024 + col) * 2048 + prow;
                            vp[0] = (bf16_t)(w0 & 0xffffu); vp[2048] = (bf16_t)(w0 >> 16); vp[2 * 2048] = (bf16_t)(w1 & 0xffffu); vp[3 * 2048] = (bf16_t)(w1 >> 16); } } }
    }
};
template <bool ROWSCALE_DUMMY = false> struct EpiBf16S {
    static constexpr bool PERM = true, AFTER_DRAIN = false; static constexpr int MID_T = 0;
    bf16_t* O; int ldc; float scale;
    __device__ __forceinline__ void operator()(const f32x4 (&acc)[2][2][4][2], const Unit& u, int wr, int wc, int fr, int fq) const {
        const int row0 = u.pm * BM + wr * 64 + fr, col0 = u.pn * BM + wc * 32 + 8 * fq;
#pragma unroll
        for (int ai = 0; ai < 2; ++ai)
#pragma unroll
            for (int m = 0; m < 4; ++m) { bf16_t* rowp = O + (size_t)(row0 + ai * HALF + m * 16) * ldc + col0;
#pragma unroll
                for (int bj = 0; bj < 2; ++bj) { const f32x4 v0 = acc[ai][bj][m][0] * scale, v1 = acc[ai][bj][m][1] * scale;
                    u32x4 w; w.x = cvt_pk_bf16(v0[0], v0[1]); w.y = cvt_pk_bf16(v0[2], v0[3]); w.z = cvt_pk_bf16(v1[0], v1[1]); w.w = cvt_pk_bf16(v1[2], v1[3]);
                    *(u32x4*)(rowp + bj * HALF) = w; } }
    }
};
__device__ __forceinline__ void row_rstd8(const float* rss, int row0, int fq, float (&rs)[2][4]) {
    f32x4 p[2][4];
#pragma unroll
    for (int ai = 0; ai < 2; ++ai)
#pragma unroll
        for (int m = 0; m < 4; ++m) p[ai][m] = *(const f32x4*)(rss + (size_t)(row0 + ai * HALF + m * 16) * 16 + 4 * fq);
#pragma unroll
    for (int ai = 0; ai < 2; ++ai)
#pragma unroll
        for (int m = 0; m < 4; ++m) { float sm = (p[ai][m][0] + p[ai][m][1]) + (p[ai][m][2] + p[ai][m][3]); sm += __shfl_xor(sm, 16); sm += __shfl_xor(sm, 32);
            rs[ai][m] = __builtin_amdgcn_rsqf(sm * (1.0f / 1024.f) + 1e-6f); }
}
struct EpiProj {
    static constexpr bool PERM = true, AFTER_DRAIN = false; static constexpr int MID_T = 0;
    bf16_t* C; const float* rss;
    __device__ __forceinline__ void operator()(const f32x4 (&acc)[2][2][4][2], const Unit& u, int wr, int wc, int fr, int fq) const {
        const int row0 = u.pm * BM + wr * 64 + fr, col0 = u.pn * BM + wc * 32 + 8 * fq;
        float rs8[2][4]; row_rstd8(rss, row0, fq, rs8);
#pragma unroll
        for (int ai = 0; ai < 2; ++ai)
#pragma unroll
            for (int m = 0; m < 4; ++m) { const int row = row0 + ai * HALF + m * 16; const float rs = rs8[ai][m]; bf16_t* rowp = C + (size_t)row * 4096 + col0;
#pragma unroll
                for (int bj = 0; bj < 2; ++bj) { const f32x4 v0 = acc[ai][bj][m][0] * rs, v1 = acc[ai][bj][m][1] * rs;
                    u32x4 w; w.x = cvt_pk_bf16(v0[0], v0[1]); w.y = cvt_pk_bf16(v0[2], v0[3]); w.z = cvt_pk_bf16(v1[0], v1[1]); w.w = cvt_pk_bf16(v1[2], v1[3]);
                    *(u32x4*)(rowp + bj * HALF) = w; } }
    }
};
struct EpiQ {
    static constexpr bool PERM = true, AFTER_DRAIN = false; static constexpr int MID_T = 0;
    bf16_t* O; const float* rss; float scale;
    __device__ __forceinline__ void operator()(const f32x4 (&acc)[2][2][4][2], const Unit& u, int wr, int wc, int fr, int fq) const {
        const int row0 = u.pm * BM + wr * 64 + fr, col0 = u.pn * BM + wc * 32 + 8 * fq;
        float rs8[2][4]; row_rstd8(rss, row0, fq, rs8);
#pragma unroll
        for (int ai = 0; ai < 2; ++ai)
#pragma unroll
            for (int m = 0; m < 4; ++m) { const int row = row0 + ai * HALF + m * 16; const float rs = rs8[ai][m] * scale; bf16_t* rowp = O + (size_t)row * 1024 + col0;
#pragma unroll
                for (int bj = 0; bj < 2; ++bj) { const f32x4 v0 = acc[ai][bj][m][0] * rs, v1 = acc[ai][bj][m][1] * rs;
                    u32x4 w; w.x = cvt_pk_bf16(v0[0], v0[1]); w.y = cvt_pk_bf16(v0[2], v0[3]); w.z = cvt_pk_bf16(v1[0], v1[1]); w.w = cvt_pk_bf16(v1[2], v1[3]);
                    *(u32x4*)(rowp + bj * HALF) = w; } }
    }
};
struct EpiResidHB {
    static constexpr bool PERM = true, AFTER_DRAIN = false; static constexpr int MID_T = 0;
    bf16_t* hb; float* rss;
    __device__ __forceinline__ void operator()(const f32x4 (&acc)[2][2][4][2], const Unit& u, int wr, int wc, int fr, int fq) const {
        const int row0 = u.pm * BM + wr * 64 + fr, col0 = u.pn * BM + wc * 32 + 8 * fq;
#pragma unroll
        for (int ai = 0; ai < 2; ++ai) {
            u32x4 ob[4][2];
#pragma unroll
            for (int m = 0; m < 4; ++m)
#pragma unroll
                for (int bj = 0; bj < 2; ++bj) ob[m][bj] = *(const u32x4*)(hb + (size_t)(row0 + ai * HALF + m * 16) * 1024 + col0 + bj * HALF);
#pragma unroll
            for (int m = 0; m < 4; ++m) { const int row = row0 + ai * HALF + m * 16; bf16_t* bp = hb + (size_t)row * 1024 + col0; float sq = 0.f;
#pragma unroll
                for (int bj = 0; bj < 2; ++bj) { const u32x4 o = ob[m][bj];
                    const f32x4 v0 = (f32x4){__uint_as_float(o.x << 16), __uint_as_float(o.x & 0xffff0000u), __uint_as_float(o.y << 16), __uint_as_float(o.y & 0xffff0000u)} + acc[ai][bj][m][0];
                    const f32x4 v1 = (f32x4){__uint_as_float(o.z << 16), __uint_as_float(o.z & 0xffff0000u), __uint_as_float(o.w << 16), __uint_as_float(o.w & 0xffff0000u)} + acc[ai][bj][m][1];
                    u32x4 w; w.x = cvt_pk_bf16(v0[0], v0[1]); w.y = cvt_pk_bf16(v0[2], v0[3]); w.z = cvt_pk_bf16(v1[0], v1[1]); w.w = cvt_pk_bf16(v1[2], v1[3]);
                    *(u32x4*)(bp + bj * HALF) = w;
                    sq += (v0[0] * v0[0] + v0[1] * v0[1]) + (v0[2] * v0[2] + v0[3] * v0[3]) + (v1[0] * v1[0] + v1[1] * v1[1]) + (v1[2] * v1[2] + v1[3] * v1[3]); }
                sq += __shfl_xor(sq, 16); sq += __shfl_xor(sq, 32);
                if (fq == 0) rss[(size_t)row * 16 + u.pn * 4 + wc] = sq; }
            asm volatile("" ::: "memory");
        }
    }
};
struct EpiResidMid {
    static constexpr bool PERM = true, AFTER_DRAIN = false; static constexpr int MID_T = 16;
    bf16_t* hb; float* rss; const float* ssq;
    __device__ __forceinline__ void midpre(const Unit& u, int wr, int wc, int fr, int fq, PG8_LAS float* mid) const {
        if (wc == 0) {
            const int row0 = u.pm * BM + wr * 64 + fr;
#pragma unroll
            for (int ai = 0; ai < 2; ++ai) { f32x4 rs;
#pragma unroll
                for (int m = 0; m < 4; ++m) { const int row = row0 + ai * HALF + m * 16; const f32x4 p0 = *(const f32x4*)(ssq + (size_t)row * 32 + 8 * fq), p1 = *(const f32x4*)(ssq + (size_t)row * 32 + 8 * fq + 4);
                    float sm = ((p0[0] + p0[1]) + (p0[2] + p0[3])) + ((p1[0] + p1[1]) + (p1[2] + p1[3])); sm += __shfl_xor(sm, 16); sm += __shfl_xor(sm, 32);
                    rs[m] = 1.0f / sqrtf(sm * (1.0f / 1024.f) + 1e-6f); }
                if (fq == 0) *(PG8_LAS f32x4*)(mid + ((ai * 2 + wr) * 16 + fr) * 4) = rs; }
        }
    }
    __device__ __forceinline__ void operator()(const f32x4 (&acc)[2][2][4][2], const Unit& u, int wr, int wc, int fr, int fq) const {
        const int row0 = u.pm * BM + wr * 64 + fr, col0 = u.pn * BM + wc * 32 + 8 * fq;
#pragma unroll
        for (int ai = 0; ai < 2; ++ai) {
            u32x4 ob[4][2];
#pragma unroll
            for (int m = 0; m < 4; ++m)
#pragma unroll
                for (int bj = 0; bj < 2; ++bj) ob[m][bj] = *(const u32x4*)(hb + (size_t)(row0 + ai * HALF + m * 16) * 1024 + col0 + bj * HALF);
#pragma unroll
            for (int m = 0; m < 4; ++m) { const int row = row0 + ai * HALF + m * 16; bf16_t* bp = hb + (size_t)row * 1024 + col0; float sq = 0.f;
#pragma unroll
                for (int bj = 0; bj < 2; ++bj) { const u32x4 o = ob[m][bj];
                    const f32x4 v0 = (f32x4){__uint_as_float(o.x << 16), __uint_as_float(o.x & 0xffff0000u), __uint_as_float(o.y << 16), __uint_as_float(o.y & 0xffff0000u)} + acc[ai][bj][m][0];
                    const f32x4 v1 = (f32x4){__uint_as_float(o.z << 16), __uint_as_float(o.z & 0xffff0000u), __uint_as_float(o.w << 16), __uint_as_float(o.w & 0xffff0000u)} + acc[ai][bj][m][1];
                    u32x4 w; w.x = cvt_pk_bf16(v0[0], v0[1]); w.y = cvt_pk_bf16(v0[2], v0[3]); w.z = cvt_pk_bf16(v1[0], v1[1]); w.w = cvt_pk_bf16(v1[2], v1[3]);
                    *(u32x4*)(bp + bj * HALF) = w;
                    sq += (v0[0] * v0[0] + v0[1] * v0[1]) + (v0[2] * v0[2] + v0[3] * v0[3]) + (v1[0] * v1[0] + v1[1] * v1[1]) + (v1[2] * v1[2] + v1[3] * v1[3]); }
                sq += __shfl_xor(sq, 16); sq += __shfl_xor(sq, 32);
                if (fq == 0) rss[(size_t)row * 16 + u.pn * 4 + wc] = sq; }
            asm volatile("" ::: "memory");
        }
    }
};
struct EpiSwiGLU {
    static constexpr bool PERM = true, AFTER_DRAIN = false; static constexpr int MID_T = 0;
    bf16_t* O; int ldc; const float* rss;
    __device__ __forceinline__ void operator()(const f32x4 (&acc)[2][2][4][2], const Unit& u, int wr, int wc, int fr, int fq) const {
        const int row0 = u.pm * BM + wr * 64 + fr, col0 = u.pn * HALF + wc * 32 + 8 * fq;
        float rs8[2][4]; row_rstd8(rss, row0, fq, rs8);
#pragma unroll
        for (int ai = 0; ai < 2; ++ai)
#pragma unroll
            for (int m = 0; m < 4; ++m) { const int row = row0 + ai * HALF + m * 16; const float rs = rs8[ai][m]; bf16_t* rowp = O + (size_t)row * ldc + col0;
                const f32x4 g0 = acc[ai][0][m][0] * rs, g1 = acc[ai][0][m][1] * rs, u0 = acc[ai][1][m][0] * rs, u1 = acc[ai][1][m][1] * rs;
                u32x4 w;
                w.x = cvt_pk_bf16(fast_silu(g0[0]) * u0[0], fast_silu(g0[1]) * u0[1]); w.y = cvt_pk_bf16(fast_silu(g0[2]) * u0[2], fast_silu(g0[3]) * u0[3]);
                w.z = cvt_pk_bf16(fast_silu(g1[0]) * u1[0], fast_silu(g1[1]) * u1[1]); w.w = cvt_pk_bf16(fast_silu(g1[2]) * u1[2], fast_silu(g1[3]) * u1[3]);
                *(u32x4*)rowp = w; }
    }
};
constexpr int MID_LDS_OFF = 131584;
template <class Epi, class Sched, bool ALIGN_EPI = false, bool SP2 = false>
__device__ __forceinline__ void gemm_phase(PG8_LAS unsigned char* lds, const Gemm g, const Sched& S, const Epi& E) {
    int tid_ = threadIdx.x; asm volatile("" : "+v"(tid_));
    const int tid = tid_, wid = __builtin_amdgcn_readfirstlane(tid >> 6), lane = tid & 63, wr = wid >> 2, wc = wid & 3, fr = lane & 15, fq = lane >> 4;
    const int K = g.K, nt = K / BK;
    unsigned voffA[2], voffB[2];
#pragma unroll
    for (int i = 0; i < 2; ++i) { int R, C; stage_rc(tid * 16 + i * 8192, R, C); const int Rb = Epi::PERM ? ((R & ~31) + perm32(R & 31)) : R;
        voffA[i] = (unsigned)(R * K + C) * 2u; voffB[i] = (unsigned)(Rb * K + C) * 2u; }
    const size_t kstep = (size_t)(BK * 2);
    const size_t hstep = (size_t)HALF * K * 2;
    const size_t tstep = 2 * hstep;
    const unsigned ldsw = (unsigned)wid * 1024u;
    const int aoff = lds_byte(wr * 64 + fr, fq * 8), boff = lds_byte(wc * 32 + fr, fq * 8);
#define PG8_SA(b, h) (((b) * 2 + (h)) * HTB)
#define PG8_SB(b, h) ((4 + (b) * 2 + (h)) * HTB)
#define PG8_STAGE(bufoff, gbase, voff) do { _Pragma("unroll") for (int _i = 0; _i < 2; ++_i) \
        __builtin_amdgcn_global_load_lds((const unsigned*)((const char*)(gbase) + (voff)[_i]), (PG8_LAS unsigned*)(lds + (bufoff) + ldsw + _i * 8192), 16, 0, 0); } while (0)
#define PG8_LDA(dst, b, h) do { _Pragma("unroll") for (int m = 0; m < 4; ++m) _Pragma("unroll") for (int k = 0; k < 2; ++k) dst[m][k] = *(const PG8_LAS bf16x8*)(lds + PG8_SA(b, h) + aoff + m * 2048 + k * 1024); } while (0)
#define PG8_LDB(dst, b, h) do { _Pragma("unroll") for (int n = 0; n < 2; ++n) _Pragma("unroll") for (int k = 0; k < 2; ++k) dst[n][k] = *(const PG8_LAS bf16x8*)(lds + PG8_SB(b, h) + boff + n * 2048 + k * 1024); } while (0)
#define PG8_MMA(ai, bj, At, Bt) do { __builtin_amdgcn_s_setprio(1); _Pragma("unroll") for (int m = 0; m < 4; ++m) _Pragma("unroll") for (int n = 0; n < 2; ++n) _Pragma("unroll") for (int k = 0; k < 2; ++k) \
        acc[ai][bj][m][n] = __builtin_amdgcn_mfma_f32_16x16x32_bf16(Bt[n][k], At[m][k], acc[ai][bj][m][n], 0, 0, 0); __builtin_amdgcn_s_setprio(0); } while (0)
#define PG8_WAIT_V(n) asm volatile("s_waitcnt vmcnt(" #n ")" ::: "memory")
#define PG8_WAIT_L(n) asm volatile("s_waitcnt lgkmcnt(" #n ")" ::: "memory")
#define PG8_BAR __builtin_amdgcn_s_barrier()
#define PG8_SCHED __builtin_amdgcn_sched_barrier(0)
    Unit cur, nxt; int ui = 0;
    if (!S.next(0, cur)) return;
    f32x4 acc[2][2][4][2];
#pragma unroll
    for (int a = 0; a < 2; ++a)
#pragma unroll
        for (int b = 0; b < 2; ++b)
#pragma unroll
            for (int m = 0; m < 4; ++m)
#pragma unroll
                for (int n = 0; n < 2; ++n) acc[a][b][m][n] = (f32x4){0.f, 0.f, 0.f, 0.f};
    bf16x8 At[4][2], B0[2][2], B1[2][2];
    const char* cA = (const char*)g.A + (size_t)cur.pm * tstep; const char* cB = (const char*)g.Bt + (size_t)cur.pn * tstep;
    S.a_ready(cur);
    if constexpr (SP2) {
        PG8_STAGE(PG8_SB(0, 0), cB, voffB); PG8_STAGE(PG8_SB(0, 1), cB + hstep, voffB); PG8_STAGE(PG8_SA(0, 0), cA, voffA); PG8_STAGE(PG8_SA(0, 1), cA + hstep, voffA);
        if (wr == 1) PG8_BAR;
        PG8_WAIT_V(2); PG8_BAR;
        PG8_STAGE(PG8_SB(1, 0), cB + kstep, voffB); PG8_STAGE(PG8_SA(1, 0), cA + kstep, voffA); PG8_STAGE(PG8_SB(1, 1), cB + hstep + kstep, voffB);
        PG8_WAIT_V(6); PG8_BAR;
    } else {
        PG8_STAGE(PG8_SB(0, 0), cB, voffB); PG8_STAGE(PG8_SA(0, 0), cA, voffA); PG8_STAGE(PG8_SB(0, 1), cB + hstep, voffB); PG8_STAGE(PG8_SA(0, 1), cA + hstep, voffA);
        if (wr == 1) PG8_BAR;
        PG8_WAIT_V(4); PG8_BAR;
        PG8_STAGE(PG8_SB(1, 0), cB + kstep, voffB); PG8_STAGE(PG8_SA(1, 0), cA + kstep, voffA); PG8_STAGE(PG8_SB(1, 1), cB + hstep + kstep, voffB);
        PG8_WAIT_V(6); PG8_BAR;
    }
    for (;;) {
        const bool has_next = S.next(ui + 1, nxt);
        if constexpr (Epi::MID_T != 0) E.midpre(cur, wr, wc, fr, fq, (PG8_LAS float*)(lds + MID_LDS_OFF));
        const char* nA = has_next ? (const char*)g.A + (size_t)nxt.pm * tstep : cA; const char* nB = has_next ? (const char*)g.Bt + (size_t)nxt.pn * tstep : cB;
        for (int t = 0; t < nt; t += 2) {
            if constexpr (Epi::MID_T != 0) { if (t == Epi::MID_T) {
                const PG8_LAS f32x4* mp_ = (const PG8_LAS f32x4*)(lds + MID_LDS_OFF) + (wr * 16 + fr);
                const f32x4 r0_ = mp_[0], r1_ = mp_[32];
                asm volatile("s_waitcnt lgkmcnt(0)" ::: "memory");
#pragma unroll
                for (int m_ = 0; m_ < 4; ++m_)
#pragma unroll
                    for (int b_ = 0; b_ < 2; ++b_)
#pragma unroll
                        for (int n_ = 0; n_ < 2; ++n_) { acc[0][b_][m_][n_] = acc[0][b_][m_][n_] * r0_[m_]; acc[1][b_][m_][n_] = acc[1][b_][m_][n_] * r1_[m_]; } } }
            const bool last = (t == nt - 2);
            const char* a1 = cA + (size_t)(t + 1) * kstep;
            const char* a2 = last ? nA : cA + (size_t)(t + 2) * kstep; const char* b2 = last ? nB : cB + (size_t)(t + 2) * kstep;
            const char* a3 = a2 + kstep; const char* b3 = b2 + kstep;
            if (last && has_next) S.a_ready(nxt);
            if constexpr (SP2) {
            PG8_LDB(B0, 0, 0); PG8_LDB(B1, 0, 1); PG8_SCHED; PG8_LDA(At, 0, 0); PG8_STAGE(PG8_SA(1, 1), a1 + hstep, voffA);
            PG8_WAIT_V(8); PG8_WAIT_L(0); PG8_BAR; PG8_MMA(0, 0, At, B0); PG8_MMA(0, 1, At, B1); PG8_BAR; PG8_SCHED;
            PG8_LDA(At, 0, 1); PG8_STAGE(PG8_SB(0, 0), b2, voffB); PG8_STAGE(PG8_SB(0, 1), b2 + hstep, voffB); PG8_STAGE(PG8_SA(0, 0), a2, voffA);
            PG8_WAIT_V(8); PG8_WAIT_L(0); PG8_BAR; PG8_MMA(1, 0, At, B0); PG8_MMA(1, 1, At, B1); PG8_BAR; PG8_SCHED;
            PG8_LDB(B0, 1, 0); PG8_LDB(B1, 1, 1); PG8_SCHED; PG8_LDA(At, 1, 0); PG8_STAGE(PG8_SA(0, 1), a2 + hstep, voffA);
            PG8_WAIT_V(8); PG8_WAIT_L(0); PG8_BAR; PG8_MMA(0, 0, At, B0); PG8_MMA(0, 1, At, B1); PG8_BAR; PG8_SCHED;
            PG8_LDA(At, 1, 1); PG8_STAGE(PG8_SB(1, 0), b3, voffB); PG8_STAGE(PG8_SB(1, 1), b3 + hstep, voffB); PG8_STAGE(PG8_SA(1, 0), a3, voffA);
            PG8_WAIT_V(8); PG8_WAIT_L(0); PG8_BAR; PG8_MMA(1, 0, At, B0); PG8_MMA(1, 1, At, B1); PG8_BAR; PG8_SCHED;
            } else {
            PG8_LDB(B0, 0, 0); PG8_SCHED; PG8_LDA(At, 0, 0); PG8_STAGE(PG8_SA(1, 1), a1 + hstep, voffA);
            PG8_WAIT_L(8); PG8_BAR; PG8_WAIT_L(0); PG8_MMA(0, 0, At, B0); PG8_BAR; PG8_SCHED;
            PG8_LDB(B1, 0, 1); PG8_STAGE(PG8_SB(0, 0), b2, voffB);
            PG8_BAR; PG8_WAIT_L(0); PG8_MMA(0, 1, At, B1); PG8_BAR;
            PG8_LDA(At, 0, 1); PG8_STAGE(PG8_SA(0, 0), a2, voffA);
            PG8_BAR; PG8_WAIT_L(0); PG8_MMA(1, 0, At, B0); PG8_BAR; PG8_SCHED;
            PG8_STAGE(PG8_SB(0, 1), b2 + hstep, voffB);
            PG8_WAIT_V(6); PG8_BAR; PG8_MMA(1, 1, At, B1); PG8_BAR;
            PG8_LDB(B0, 1, 0); PG8_SCHED; PG8_LDA(At, 1, 0); PG8_STAGE(PG8_SA(0, 1), a2 + hstep, voffA);
            PG8_WAIT_L(8); PG8_BAR; PG8_WAIT_L(0); PG8_MMA(0, 0, At, B0); PG8_BAR; PG8_SCHED;
            PG8_LDB(B1, 1, 1); PG8_STAGE(PG8_SB(1, 0), b3, voffB);
            PG8_BAR; PG8_WAIT_L(0); PG8_MMA(0, 1, At, B1); PG8_BAR;
            PG8_LDA(At, 1, 1); PG8_STAGE(PG8_SA(1, 0), a3, voffA);
            PG8_BAR; PG8_WAIT_L(0); PG8_MMA(1, 0, At, B0); PG8_BAR; PG8_SCHED;
            PG8_STAGE(PG8_SB(1, 1), b3 + hstep, voffB);
            PG8_WAIT_V(6); PG8_BAR; PG8_MMA(1, 1, At, B1); PG8_BAR;
            }
        }
        if constexpr (ALIGN_EPI) { if (wr == 0) PG8_BAR; }
        if constexpr (!Epi::AFTER_DRAIN) { E(acc, cur, wr, wc, fr, fq); S.done(cur); }
        if (!has_next) break;
#pragma unroll
        for (int a = 0; a < 2; ++a)
#pragma unroll
            for (int b = 0; b < 2; ++b)
#pragma unroll
                for (int m = 0; m < 4; ++m)
#pragma unroll
                    for (int n = 0; n < 2; ++n) acc[a][b][m][n] = (f32x4){0.f, 0.f, 0.f, 0.f};
        cur = nxt; cA = nA; cB = nB; ++ui;
        if constexpr (ALIGN_EPI) { if (wr == 1) PG8_BAR; }
    }
    PG8_WAIT_V(0);
    if constexpr (!ALIGN_EPI) { if (wr == 0) PG8_BAR; }
    PG8_BAR;
    if constexpr (Epi::AFTER_DRAIN) { E.fused(acc, cur, wr, wc, fr, fq, lds, wid, lane); S.done(cur); }
#undef PG8_SA
#undef PG8_SB
#undef PG8_STAGE
#undef PG8_LDA
#undef PG8_LDB
#undef PG8_MMA
#undef PG8_WAIT_V
#undef PG8_WAIT_L
#undef PG8_BAR
#undef PG8_SCHED
}
}
#define GAS __attribute__((address_space(1)))
#define LAS __attribute__((address_space(3)))
typedef unsigned short bf16;
typedef unsigned v4u __attribute__((ext_vector_type(4)));
typedef float f32x4 __attribute__((ext_vector_type(4)));
typedef short bf16x8 __attribute__((ext_vector_type(8)));
typedef GAS unsigned gu32;
typedef GAS unsigned long long gu64;
#define RLX_AGENT __ATOMIC_RELAXED, __HIP_MEMORY_SCOPE_AGENT
#define LDS_WAIT() asm volatile("s_waitcnt lgkmcnt(0)" ::: "memory")
#define VM_WAIT() asm volatile("s_waitcnt vmcnt(0)" ::: "memory")
__device__ __forceinline__ unsigned long long rt() { return __builtin_amdgcn_s_memrealtime(); }
__device__ __forceinline__ unsigned f2bf(float f) { unsigned u = __builtin_bit_cast(unsigned, f); return (u + 0x7fffu + ((u >> 16) & 1u)) >> 16; }
__device__ __forceinline__ unsigned pk2(float lo, float hi) { return f2bf(lo) | (f2bf(hi) << 16); }
#define XB_TMO      128
#define XB_XCNT(j)  (256  + 64 * (j))
#define XB_XSUB(j)  (1280 + 64 * (j))
#define XB_XGEN(j)  (2304 + 64 * (j))
#define XB_TOP      3328
#define XB_TOPGEN   3392
#define XCD_BAR_WORDS 3456
#define XB_SPIN_CAP (1u << 18)

__device__ __forceinline__ unsigned xb_ld(unsigned* p)              { return __hip_atomic_load(p, __ATOMIC_RELAXED, __HIP_MEMORY_SCOPE_AGENT); }
__device__ __forceinline__ unsigned xb_add(unsigned* p, unsigned v) { return __hip_atomic_fetch_add(p, v, __ATOMIC_RELAXED, __HIP_MEMORY_SCOPE_AGENT); }
__device__ __forceinline__ unsigned xb_xcc_id() { return (unsigned)__builtin_amdgcn_s_getreg((3 << 11) | 20) & 0xFu; }
#define XB_SPIN(cond, bar) do { unsigned _sp = 0; while (cond) { __builtin_amdgcn_s_sleep(1); \
    if ((++_sp & 255u) == 0u) { if (xb_ld(&(bar)[XB_TMO])) break; if (_sp > XB_SPIN_CAP) { atomicAdd(&(bar)[XB_TMO], 1u); break; } } } } while (0)

struct XcdBarrier {
    unsigned* bar; unsigned x;
    volatile LAS unsigned* st;
};

__device__ __forceinline__ XcdBarrier xcd_barrier_post(unsigned* bar, volatile LAS unsigned* st) {
    XcdBarrier b; b.bar = bar; b.x = xb_xcc_id(); b.st = st;
    if (threadIdx.x == 0) (void)xb_add(&bar[XB_XCNT(b.x)], 1u);
    return b;
}
__device__ __forceinline__ void xcd_barrier_complete(unsigned* bar, unsigned x, unsigned& nloc, unsigned& nx) {
    const unsigned G = gridDim.x * gridDim.y * gridDim.z;
    unsigned sum, cnt, mine, sp = 0u;
    for (;;) {
        sum = 0u; cnt = 0u; mine = 0u;
#pragma unroll
        for (unsigned j = 0; j < 16; ++j) { const unsigned c = xb_ld(&bar[XB_XCNT(j)]); sum += c; cnt += (c > 0u) ? 1u : 0u; mine = (j == x) ? c : mine; }
        if (sum == G) break;
        __builtin_amdgcn_s_sleep(1);
        if ((++sp & 255u) == 0u) { if (xb_ld(&bar[XB_TMO])) break; if (sp > XB_SPIN_CAP) { atomicAdd(&bar[XB_TMO], 1u); break; } }
    }
    nloc = mine > 0u ? mine : 1u; nx = cnt > 0u ? cnt : 1u;
}

__device__ __forceinline__ void xcd_barrier(const XcdBarrier& b) {
    asm volatile("s_waitcnt vmcnt(0)" ::: "memory");
    __syncthreads();
    if (threadIdx.x == 0) {
        unsigned* bar = b.bar;
        __builtin_amdgcn_s_waitcnt(0);
        unsigned nloc = b.st[0], nx = b.st[1];
        if (nloc == 0u) { xcd_barrier_complete(bar, b.x, nloc, nx); b.st[0] = nloc; b.st[1] = nx; }
        const unsigned old = xb_add(&bar[XB_XSUB(b.x)], 1u);
        const unsigned gen = old / nloc;
        if (old + 1u == (gen + 1u) * nloc) {
            __builtin_amdgcn_fence(__ATOMIC_RELEASE, "agent");
            asm volatile("s_waitcnt vmcnt(0)" ::: "memory");
            const unsigned og = xb_add(&bar[XB_TOP], 1u);
            const unsigned tg = og / nx;
            if (og + 1u == (tg + 1u) * nx) xb_add(&bar[XB_TOPGEN], 1u);
            else XB_SPIN(xb_ld(&bar[XB_TOPGEN]) == tg, bar);
            __builtin_amdgcn_fence(__ATOMIC_ACQUIRE, "agent");
            xb_add(&bar[XB_XGEN(b.x)], 1u);
            asm volatile("s_waitcnt vmcnt(0)" ::: "memory");
        } else {
            XB_SPIN(xb_ld(&bar[XB_XGEN(b.x)]) == gen, bar);
            __builtin_amdgcn_fence(__ATOMIC_ACQUIRE, "agent");
            asm volatile("s_waitcnt vmcnt(0)" ::: "memory");
        }
    }
    __syncthreads();
}
#ifndef MK_PROBE
#define MK_PROBE 0
#endif
#ifndef MK_PROBE_A
#define MK_PROBE_A 0
#define MK_PROBE_B 0
#endif
#ifndef MK_PROBE_REGIONS
#define MK_PROBE_REGIONS 0
#endif
#if MK_PROBE
#define REG_BEGIN(i) do { if (blockIdx.x == 0 && threadIdx.x == 0) ((unsigned long long*)(kp->ws + WS_CTL + 65536))[100 + (i)] = __builtin_amdgcn_s_memrealtime(); } while (0)
#define REG_END(i) do { __syncthreads(); if (blockIdx.x == 0 && threadIdx.x == 0) { unsigned long long* st_ = (unsigned long long*)(kp->ws + WS_CTL + 65536); st_[110 + (i)] += __builtin_amdgcn_s_memrealtime() - st_[100 + (i)]; } } while (0)
#else
#define REG_BEGIN(i) do { } while (0)
#define REG_END(i) do { } while (0)
#endif
namespace nv {
constexpr int D = 1024, MP = 16384, MS = 512, MT = MP + MS, NSEQ = 136, DEPTH = 4;
constexpr int NIN = 4112;
constexpr int NPJ = 4096, OFF_POOL = 0, OFF_Z = 512, OFF_XBC = 1536, OFF_GATE = 3072, OFF_LRU = 3584;
constexpr int DFF = 2816, NINP = 4352;
constexpr float EPS = 1e-6f;
constexpr size_t O_Y = 0, O_PPOOL = (size_t)MT * D, O_PSCONV = O_PPOOL + 245760, O_PSSD = O_PSCONV + 147456, O_PLCONV = O_PSSD + 4194304, O_PLRU = O_PLCONV + 49152,
                 O_PMK = O_PLRU + 16384, O_PMV = O_PMK + 8388608, O_SPOOL = O_PMV + 8388608, O_SSCONV = O_SPOOL + 3932160, O_SSSD = O_SSCONV + 2359296,
                 O_SLCONV = O_SSSD + 67108864, O_SLRU = O_SLCONV + 786432, O_END = O_SLRU + 262144;
constexpr size_t MiB = 1u << 20;
constexpr size_t WS_CTL = 0, CTL_ZERO_BYTES = 1 * MiB;
constexpr size_t WS_WKV = 1 * MiB, WS_WIN = 17 * MiB, WS_WOUT = 51 * MiB, WS_WQ = 67 * MiB, WS_WO = 75 * MiB, WS_WGU = 83 * MiB, WS_WD = 127 * MiB;
constexpr size_t WS_MEMB = 149 * MiB, WS_HB = 153 * MiB, WS_UB = 153 * MiB, WS_MIXB = 186 * MiB, WS_OB = 252 * MiB, WS_ACT = 285 * MiB;
constexpr size_t WS_PROJ = 376 * MiB, WS_POOLED = 642 * MiB, WS_XBC = 675 * MiB, WS_YRAW = 774 * MiB, WS_XC = 840 * MiB, WS_AB = 873 * MiB, WS_BB = 906 * MiB, WS_QB = 939 * MiB;
constexpr size_t WS_KB = 1005 * MiB, WS_VT = 1021 * MiB;
constexpr size_t WS_SSDSS = 1037 * MiB, WS_PWT = 1039 * MiB;
constexpr size_t WS_DT = 1042 * MiB;
constexpr size_t WS_RSS = 1040 * MiB;
constexpr size_t WS_XBCC = 1044 * MiB;
constexpr size_t WS_END = 1092 * MiB;
constexpr size_t WIN_L = (size_t)NINP * 1024, WOUT_L = (size_t)1024 * 2048, WQ_L = (size_t)1024 * 1024, WGU_L = (size_t)5632 * 1024, WD_L = (size_t)1024 * 2816;
constexpr int CW_TMO = 0, CW_BAR = 4096;
constexpr int RING_OFF = 0, RING_BYTES = 131072, LDSCTL_OFF = RING_BYTES, MISC_OFF = LDSCTL_OFF + 320, LDS_BYTES = 147456;
constexpr int NWAVES = 8, NTHR = 512;
constexpr int PH_PRO = 0, PH_KV = 1, PH_L0 = 2, PH_PER_LAYER = 9, PH_FINAL = PH_L0 + DEPTH * PH_PER_LAYER, NPH = PH_FINAL + 1;

struct SeqInfo { int row0, L, pos0, b, grp; };
__device__ __forceinline__ SeqInfo seq_info(int s) {
    SeqInfo q;
    if (s < 8) { q.row0 = s * 2048; q.L = 2048; q.pos0 = 0; q.b = s; q.grp = 0; }
    else { q.b = s - 8; q.row0 = MP + q.b * 4; q.L = 4; q.pos0 = 16384; q.grp = 1; }
    return q;
}
__device__ __forceinline__ void row_info(int r, int& s, int& t) {
    if (r < MP) { s = r >> 11; t = r & 2047; } else { const int q = r - MP; s = 8 + (q >> 2); t = q & 3; }
}
__device__ __forceinline__ float wave_sum(float v) {
#pragma unroll
    for (int o = 1; o < 64; o <<= 1) v += __shfl_xor(v, o);
    return v;
}
__device__ __forceinline__ float wave_max(float v) {
#pragma unroll
    for (int o = 1; o < 64; o <<= 1) v = fmaxf(v, __shfl_xor(v, o));
    return v;
}
__device__ __forceinline__ float silu_f(float x) { return x / (1.f + expf(-x)); }
__device__ __forceinline__ float sigmoid_f(float x) { return 1.f / (1.f + expf(-x)); }
__device__ __forceinline__ float softplus_f(float x) { return x > 20.f ? x : log1pf(expf(x)); }
__device__ __forceinline__ float gelu_tanh_f(float x) { return 0.5f * x * (1.f + tanhf(0.7978845608028654f * (x + 0.044715f * x * x * x))); }

struct Args { const float* in[38]; float* out; unsigned char* ws; int ph_lo, ph_hi; };
typedef const __attribute__((address_space(4))) Args* KP;
struct Frame { LAS unsigned char* lds; int tid, lane, wave, bid, G, vcu; };
__device__ __forceinline__ void frame_refresh(Frame& F) { int t = threadIdx.x; asm volatile("" : "+v"(t)); F.tid = t; F.lane = t & 63; F.wave = __builtin_amdgcn_readfirstlane(t >> 6); }

typedef float f32x2_t __attribute__((ext_vector_type(2))); typedef __bf16 bf16x2_t __attribute__((ext_vector_type(2)));
__device__ __forceinline__ unsigned pk2h(float lo, float hi) { f32x2_t v = {lo, hi}; bf16x2_t b = __builtin_convertvector(v, bf16x2_t); return __builtin_bit_cast(unsigned, b); }
__device__ __forceinline__ unsigned f2bfh(float x) { return pk2h(x, 0.f) & 0xffffu; }
typedef short bf16x8 __attribute__((ext_vector_type(8)));
#define MFMA16(a, b, c) __builtin_amdgcn_mfma_f32_16x16x32_bf16((a), (b), (c), 0, 0, 0)
#define LBAR() do { asm volatile("s_waitcnt lgkmcnt(0)" ::: "memory"); __builtin_amdgcn_s_barrier(); asm volatile("" ::: "memory"); } while (0)
__device__ __forceinline__ float bf2f(unsigned short h) { return __uint_as_float((unsigned)h << 16); }
__device__ __forceinline__ void cvt8(v4u u, f32x4& lo, f32x4& hi) { lo = (f32x4){__uint_as_float(u.x << 16), __uint_as_float(u.x & 0xffff0000u), __uint_as_float(u.y << 16), __uint_as_float(u.y & 0xffff0000u)}; hi = (f32x4){__uint_as_float(u.z << 16), __uint_as_float(u.z & 0xffff0000u), __uint_as_float(u.w << 16), __uint_as_float(u.w & 0xffff0000u)}; }
constexpr int SL_CS = 0, SL_BS = 32768, SL_BT = 65536, SL_XT = 98304, SL_XW = 106496, SL_HS = 114688, SL_XS = 122880;
constexpr int XTRA = LDSCTL_OFF + 512;
constexpr int SL_ACS = XTRA, SL_DTV = XTRA + 512, SL_CW = XTRA + 1024;
__device__ __forceinline__ int sw128(int r, int c8) { return r * 256 + (((c8 ^ r) & 15) << 4); }
__device__ __forceinline__ float fexp(float x) { return __builtin_amdgcn_exp2f(1.4426950408889634f * x); }
__device__ __forceinline__ float fsilu(float x) { return x * __builtin_amdgcn_rcpf(1.0f + __builtin_amdgcn_exp2f(-1.4426950408889634f * x)); }

__device__ __forceinline__ void ph_mix0(KP a, Frame& F, int l) {
    const bf16* proj = (const bf16*)(a->ws + WS_PROJ); bf16* xo = (bf16*)(a->ws + WS_XBCC);
    const float* cw = a->in[14] + (size_t)l * 4 * 1536; const float* cb = a->in[15] + (size_t)l * 1536;
    const int NIT = (MP / 8) * 192;
    for (int it = F.bid * NTHR + F.tid; it < NIT; it += F.G * NTHR) {
        const int c8 = it % 192, rb = it / 192, r0 = rb * 8, t = r0 & 2047;
        f32x4 wk[5][2];
#pragma unroll
        for (int k = 0; k < 4; ++k) { wk[k][0] = *(const f32x4*)(cw + (size_t)k * 1536 + 8 * c8); wk[k][1] = *(const f32x4*)(cw + (size_t)k * 1536 + 8 * c8 + 4); }
        wk[4][0] = *(const f32x4*)(cb + 8 * c8); wk[4][1] = *(const f32x4*)(cb + 8 * c8 + 4);
        v4u rw[11];
#pragma unroll
        for (int rr = 0; rr < 11; ++rr) { rw[rr] = (v4u){0u, 0u, 0u, 0u}; if (t + rr - 3 >= 0) rw[rr] = *(const GAS v4u*)(proj + (size_t)(r0 + rr - 3) * NPJ + OFF_XBC + 8 * c8); }
#pragma unroll
        for (int hf = 0; hf < 2; ++hf) {
            f32x4 raw[11];
#pragma unroll
            for (int rr = 0; rr < 11; ++rr) { const unsigned u0 = hf ? rw[rr].z : rw[rr].x, u1 = hf ? rw[rr].w : rw[rr].y;
                raw[rr] = (f32x4){__uint_as_float(u0 << 16), __uint_as_float(u0 & 0xffff0000u), __uint_as_float(u1 << 16), __uint_as_float(u1 & 0xffff0000u)}; }
#pragma unroll
            for (int i = 0; i < 8; ++i) { f32x4 o = wk[4][hf];
#pragma unroll
                for (int k = 0; k < 4; ++k) o += wk[k][hf] * raw[i + k];
                *(unsigned long long*)(xo + (size_t)(r0 + i) * 1536 + 8 * c8 + 4 * hf) = (unsigned long long)pk2h(fsilu(o.x), fsilu(o.y)) | ((unsigned long long)pk2h(fsilu(o.z), fsilu(o.w)) << 32); }
        }
    }
}
template <bool WITH_T>
__device__ __forceinline__ void ssd_stage(LAS unsigned char* L, const v4u (&rw)[4], int dst, int dstT, int tq, int c8) {
#pragma unroll
    for (int i = 0; i < 4; ++i) *(LAS v4u*)(L + dst + sw128(4 * tq + i, c8)) = rw[i];
    if (WITH_T) {
#pragma unroll
        for (int jw = 0; jw < 4; ++jw) {
            const unsigned a0 = rw[0][jw], a1 = rw[1][jw], a2 = rw[2][jw], a3 = rw[3][jw];
            const unsigned long long ev = (unsigned long long)((a0 & 0xffffu) | (a1 << 16)) | ((unsigned long long)((a2 & 0xffffu) | (a3 << 16)) << 32);
            const unsigned long long od = (unsigned long long)((a0 >> 16) | (a1 & 0xffff0000u)) | ((unsigned long long)((a2 >> 16) | (a3 & 0xffff0000u)) << 32);
            *(LAS unsigned long long*)(L + dstT + sw128(8 * c8 + 2 * jw, tq >> 1) + (tq & 1) * 8) = ev;
            *(LAS unsigned long long*)(L + dstT + sw128(8 * c8 + 2 * jw + 1, tq >> 1) + (tq & 1) * 8) = od; }
    }
}
__device__ __forceinline__ float fsoftplus(float x) { return x > 15.f ? x : 0.6931471805599453f * __builtin_amdgcn_logf(1.0f + __builtin_amdgcn_exp2f(1.4426950408889634f * x)); }

__device__ __forceinline__ void ssd_prompt_item(KP a, Frame& F, int l, int b, int hd, int ph) {
    LAS unsigned char* L = F.lds;
    const int tid0 = F.tid, w = F.wave, fr0 = F.lane & 15, fq0 = F.lane >> 4, g = hd >> 3;
    const bf16* proj_seq = (const bf16*)(a->ws + WS_PROJ) + (size_t)b * 2048 * NPJ; const float* dt_seq = (const float*)(a->ws + WS_DT) + (size_t)b * 2048 * 16 + hd;
    bf16* mixb = (bf16*)(a->ws + WS_MIXB) + (size_t)b * 2048 * 2048 + hd * 64 + ph * 32;
    float* ssq = (float*)(a->ws + WS_SSDSS) + (size_t)b * 2048 * 32 + hd * 2 + ph;
    LAS float* ACS = (LAS float*)(L + SL_ACS); LAS float* DTV = (LAS float*)(L + SL_DTV);
    const bf16* xc_seq = (const bf16*)(a->ws + WS_XBCC) + (size_t)b * 2048 * 1536;
    for (int i = tid0; i < 8192 / 4; i += NTHR) ((LAS unsigned*)(L + SL_HS))[i] = 0u;
    const float A = -expf(a->in[17][l * 16 + hd]), dtb = a->in[16][l * 16 + hd], Dk = a->in[18][l * 16 + hd];
    f32x4 hst[2]; hst[0] = (f32x4){0.f, 0.f, 0.f, 0.f}; hst[1] = (f32x4){0.f, 0.f, 0.f, 0.f};
    const int cB = 1024 + g * 128, cC = 1280 + g * 128, cX = hd * 64 + ph * 32, cZ = OFF_Z + hd * 64 + ph * 32;
    v4u rawB[4], rawC[4]; unsigned rawX[4]; float dr0 = 0.f, dr1 = 0.f;
    {
        const int tq = tid0 >> 4, c8 = tid0 & 15;
#pragma unroll
        for (int i = 0; i < 4; ++i) { const bf16* rp = xc_seq + (size_t)(4 * tq + i) * 1536; rawB[i] = *(const GAS v4u*)(rp + cB + 8 * c8); rawC[i] = *(const GAS v4u*)(rp + cC + 8 * c8); rawX[i] = *(const GAS unsigned*)(rp + cX + 2 * c8); }
        if (w == 0) { dr0 = dt_seq[(size_t)(2 * F.lane) * 16]; dr1 = dt_seq[(size_t)(2 * F.lane + 1) * 16]; }
    }
    __syncthreads();
    for (int c = 0; c < 16; ++c) {
        const int t0 = c * 128;
        const int tid = tid0, fr = fr0, fq = fq0;
        const int lane = tid & 63, tq = tid >> 4, c8 = tid & 15;
        unsigned long long zq[2];
#pragma unroll
        for (int pt = 0; pt < 2; ++pt) zq[pt] = *(const GAS unsigned long long*)(proj_seq + (size_t)(t0 + 16 * w + fr) * NPJ + cZ + 16 * pt + 4 * fq);
        if (w == 0) {
            const float dt0 = fsoftplus(dr0 + dtb), dt1 = fsoftplus(dr1 + dtb);
            const float a0 = dt0 * A, a1 = dt1 * A;
            float v = a0 + a1;
#pragma unroll
            for (int o = 1; o < 64; o <<= 1) { const float t = __shfl_up(v, o); if (lane >= o) v += t; }
            ACS[2 * lane] = v - a1; ACS[2 * lane + 1] = v; DTV[2 * lane] = dt0; DTV[2 * lane + 1] = dt1;
        }
        ssd_stage<true>(L, rawB, SL_BS, SL_BT, tq, c8);
        ssd_stage<false>(L, rawC, SL_CS, 0, tq, c8);
        if (c + 1 < 16) {
#pragma unroll
            for (int i = 0; i < 4; ++i) { const bf16* rp = xc_seq + (size_t)(t0 + 128 + 4 * tq + i) * 1536; rawB[i] = *(const GAS v4u*)(rp + cB + 8 * c8); rawC[i] = *(const GAS v4u*)(rp + cC + 8 * c8); }
        }
        LBAR();
        f32x4 cb[8]; bf16x8 cfr[4];
#pragma unroll
        for (int ks = 0; ks < 4; ++ks) cfr[ks] = *(const LAS bf16x8*)(L + SL_CS + sw128(16 * w + fr, 4 * ks + fq));
#pragma unroll
        for (int st = 0; st < 8; ++st) if (st <= w) { cb[st] = (f32x4){0.f, 0.f, 0.f, 0.f};
#pragma unroll
            for (int ks = 0; ks < 4; ++ks) { const bf16x8 bm = *(const LAS bf16x8*)(L + SL_BS + sw128(16 * st + fr, 4 * ks + fq)); cb[st] = MFMA16(bm, cfr[ks], cb[st]); } }
        {
            const float alast = ACS[127];
            float xd[4][2], xw[4][2];
#pragma unroll
            for (int i = 0; i < 4; ++i) { const int tok = 4 * tq + i; const float dt = DTV[tok], wgt = fexp(alast - ACS[tok]);
                xd[i][0] = __uint_as_float(rawX[i] << 16) * dt; xd[i][1] = __uint_as_float(rawX[i] & 0xffff0000u) * dt; xw[i][0] = xd[i][0] * wgt; xw[i][1] = xd[i][1] * wgt; }
#pragma unroll
            for (int j = 0; j < 2; ++j) { const int off = sw128(2 * c8 + j, tq >> 1) + (tq & 1) * 8;
                *(LAS unsigned long long*)(L + SL_XT + off) = (unsigned long long)pk2h(xd[0][j], xd[1][j]) | ((unsigned long long)pk2h(xd[2][j], xd[3][j]) << 32);
                *(LAS unsigned long long*)(L + SL_XW + off) = (unsigned long long)pk2h(xw[0][j], xw[1][j]) | ((unsigned long long)pk2h(xw[2][j], xw[3][j]) << 32); }
            if (c + 1 < 16) {
#pragma unroll
                for (int i = 0; i < 4; ++i) rawX[i] = *(const GAS unsigned*)(xc_seq + (size_t)(t0 + 128 + 4 * tq + i) * 1536 + cX + 2 * c8);
                if (w == 0) { dr0 = dt_seq[(size_t)(t0 + 128 + 2 * lane) * 16]; dr1 = dt_seq[(size_t)(t0 + 128 + 2 * lane + 1) * 16]; }
            }
        }
        LBAR();
        {
            const int l_ = 16 * w + fr; const float al = ACS[l_];
#pragma unroll
            for (int st = 0; st < 8; ++st) {
                const int off = SL_BS + sw128(l_, 2 * st + (fq >> 1)) + (fq & 1) * 8;
                if (st <= w) { float v[4]; const f32x4 as4 = *(const LAS f32x4*)(ACS + 16 * st + 4 * fq);
#pragma unroll
                    for (int e = 0; e < 4; ++e) { const int s_ = 16 * st + 4 * fq + e; const float ex = fexp(fminf(al - as4[e], 0.f)); v[e] = (s_ <= l_) ? cb[st][e] * ex : 0.f; }
                    *(LAS unsigned long long*)(L + off) = (unsigned long long)pk2h(v[0], v[1]) | ((unsigned long long)pk2h(v[2], v[3]) << 32); }
                else if (st == w + 1 && (w & 1) == 0) *(LAS unsigned long long*)(L + off) = 0ull;
            }
        }
        LBAR();
        {
            f32x4 yd[2], yo[2];
#pragma unroll
            for (int pt = 0; pt < 2; ++pt) { yd[pt] = (f32x4){0.f, 0.f, 0.f, 0.f}; yo[pt] = (f32x4){0.f, 0.f, 0.f, 0.f}; }
#pragma unroll
            for (int ks = 0; ks < 4; ++ks) {
#pragma unroll
                for (int pt = 0; pt < 2; ++pt) { const bf16x8 hf = *(const LAS bf16x8*)(L + SL_HS + sw128(16 * pt + fr, 4 * ks + fq)); yo[pt] = MFMA16(hf, cfr[ks], yo[pt]); }
                if (ks <= (w >> 1)) { const bf16x8 mf = *(const LAS bf16x8*)(L + SL_BS + sw128(16 * w + fr, 4 * ks + fq));
#pragma unroll
                    for (int pt = 0; pt < 2; ++pt) { const bf16x8 xf = *(const LAS bf16x8*)(L + SL_XT + sw128(16 * pt + fr, 4 * ks + fq)); yd[pt] = MFMA16(xf, mf, yd[pt]); } }
            }
            const int l_ = 16 * w + fr; const float ea = fexp(ACS[l_]), dsk = Dk * __builtin_amdgcn_rcpf(DTV[l_]); float s2 = 0.f;
#pragma unroll
            for (int pt = 0; pt < 2; ++pt) { float yg[4];
#pragma unroll
                for (int e = 0; e < 4; ++e) { const int p = 16 * pt + 4 * fq + e;
                    const float xdv = bf2f(*(const LAS bf16*)(L + SL_XT + sw128(p, l_ >> 3) + (l_ & 7) * 2));
                    const float z = bf2f((unsigned short)(zq[pt] >> (16 * e)));
                    const float y = yd[pt][e] + ea * yo[pt][e] + dsk * xdv;
                    yg[e] = y * fsilu(z); s2 += yg[e] * yg[e]; }
                *(unsigned long long*)(mixb + (size_t)(t0 + l_) * 2048 + 16 * pt + 4 * fq) = (unsigned long long)pk2h(yg[0], yg[1]) | ((unsigned long long)pk2h(yg[2], yg[3]) << 32); }
            s2 += __shfl_xor(s2, 16); s2 += __shfl_xor(s2, 32);
            if (fq == 0) ssq[(size_t)(t0 + l_) * 32] = s2;
            const float cd = fexp(ACS[127]);
#pragma unroll
            for (int pt = 0; pt < 2; ++pt) hst[pt] = hst[pt] * cd;
#pragma unroll
            for (int ks = 0; ks < 4; ++ks) { const bf16x8 bt = *(const LAS bf16x8*)(L + SL_BT + sw128(16 * w + fr, 4 * ks + fq));
#pragma unroll
                for (int pt = 0; pt < 2; ++pt) { const bf16x8 xw = *(const LAS bf16x8*)(L + SL_XW + sw128(16 * pt + fr, 4 * ks + fq)); hst[pt] = MFMA16(bt, xw, hst[pt]); } }
        }
        LBAR();
#pragma unroll
        for (int pt = 0; pt < 2; ++pt)
            *(LAS unsigned long long*)(L + SL_HS + sw128(16 * pt + fr, 2 * w + (fq >> 1)) + (fq & 1) * 8) = (unsigned long long)pk2h(hst[pt][0], hst[pt][1]) | ((unsigned long long)pk2h(hst[pt][2], hst[pt][3]) << 32);
    }
    {
        float* so = a->out + O_PSSD + ((((size_t)l * 8 + b) * 16 + hd) * 64 + ph * 32) * 128;
#pragma unroll
        for (int pt = 0; pt < 2; ++pt) *(f32x4*)(so + (size_t)(16 * pt + fr0) * 128 + 16 * w + 4 * fq0) = hst[pt];
    }
    __syncthreads();
}

constexpr int LR_ROWS = 512 + 32;
constexpr int LR_A = 0, LR_B = LR_ROWS * 64, LR_XC = 2 * LR_ROWS * 64;
constexpr int LR_SEG = LR_XC + 8192, LR_CAR = LR_SEG + 2 * 32 * 16 * 4, LR_CW = LR_CAR + 64 + 32 * 16 * 4;
static_assert(LR_CW + 5 * 64 * 4 <= RING_BYTES, "lru LDS map");
__device__ __forceinline__ int lr_row(int tok) { return tok + (tok >> 4); }
__device__ __forceinline__ void lru_prompt_item(KP a, Frame& F, int l, int b, int hh, int qd) {
    LAS unsigned char* L = F.lds;
    const int tid0 = F.tid, w = F.wave, fr0 = F.lane & 15, fq0 = F.lane >> 4;
    const bf16* proj_seq = (const bf16*)(a->ws + WS_PROJ) + (size_t)b * 2048 * NPJ;
    bf16* mixb = (bf16*)(a->ws + WS_MIXB) + (size_t)b * 2048 * 2048 + 1536 + hh * 64 + qd * 16;
    LAS float* Al = (LAS float*)(L + LR_A); LAS float* Bl = (LAS float*)(L + LR_B); LAS float* XCs = (LAS float*)(L + LR_XC) + w * 256;
    LAS float* SegA = (LAS float*)(L + LR_SEG); LAS float* SegB = SegA + 512; LAS float* Car = (LAS float*)(L + LR_CAR); LAS float* CarIn = Car + 16; LAS float* CW = (LAS float*)(L + LR_CW);
    const int ch = hh * 64 + qd * 16 + fr0;
    for (int i = tid0; i < 5 * 64; i += NTHR) { const int k = i >> 6, ci = i & 63; CW[i] = k < 4 ? a->in[20][(size_t)l * 4 * 512 + k * 512 + hh * 64 + ci] : a->in[21][(size_t)l * 512 + hh * 64 + ci]; }
    if (tid0 < 16) Car[tid0] = 0.f;
    bf16x8 waf[2], wxf[2];
    {
        const float* wa = a->in[22] + ((size_t)l * 8 + hh) * 64 * 64 + qd * 16 + fr0; const float* wx = a->in[24] + ((size_t)l * 8 + hh) * 64 * 64 + qd * 16 + fr0;
#pragma unroll
        for (int ks = 0; ks < 2; ++ks) { v4u ua, ux; const int i0 = 32 * ks + 8 * fq0;
            ua.x = pk2h(wa[(i0 + 0) * 64], wa[(i0 + 1) * 64]); ua.y = pk2h(wa[(i0 + 2) * 64], wa[(i0 + 3) * 64]); ua.z = pk2h(wa[(i0 + 4) * 64], wa[(i0 + 5) * 64]); ua.w = pk2h(wa[(i0 + 6) * 64], wa[(i0 + 7) * 64]);
            ux.x = pk2h(wx[(i0 + 0) * 64], wx[(i0 + 1) * 64]); ux.y = pk2h(wx[(i0 + 2) * 64], wx[(i0 + 3) * 64]); ux.z = pk2h(wx[(i0 + 4) * 64], wx[(i0 + 5) * 64]); ux.w = pk2h(wx[(i0 + 6) * 64], wx[(i0 + 7) * 64]);
            waf[ks] = __builtin_bit_cast(bf16x8, ua); wxf[ks] = __builtin_bit_cast(bf16x8, ux); }
    }
    const float bav = a->in[23][(size_t)l * 512 + ch], bxv = a->in[25][(size_t)l * 512 + ch];
    const float lamv = a->in[26][(size_t)l * 512 + ch];
    const float spv = -8.0f * ((-lamv) > 20.f ? (-lamv) : log1pf(expf(-lamv)));
    __syncthreads();
    for (int qp = 0; qp < 4; ++qp) {
        const int T0 = qp * 512;
        int tid = tid0, fr = fr0, fq = fq0; asm volatile("" : "+v"(tid), "+v"(fr), "+v"(fq));
        v4u rw[2][4];
#pragma unroll
        for (int ks = 0; ks < 2; ++ks)
#pragma unroll
            for (int k = 0; k < 4; ++k) { const int row = T0 + (w * 4) * 16 + fr + k - 3; rw[ks][k] = (v4u){0u, 0u, 0u, 0u}; if (row >= 0) rw[ks][k] = *(const GAS v4u*)(proj_seq + (size_t)row * NPJ + OFF_LRU + hh * 64 + 32 * ks + 8 * fq); }
#pragma unroll
        for (int tt = 0; tt < 4; ++tt) {
            const int tb = (w * 4 + tt) * 16;
            v4u nx[2][4];
            if (tt + 1 < 4) {
#pragma unroll
                for (int ks = 0; ks < 2; ++ks)
#pragma unroll
                    for (int k = 0; k < 4; ++k) nx[ks][k] = *(const GAS v4u*)(proj_seq + (size_t)(T0 + tb + 16 + fr + k - 3) * NPJ + OFF_LRU + hh * 64 + 32 * ks + 8 * fq);
            }
            bf16x8 xa[2];
#pragma unroll
            for (int ks = 0; ks < 2; ++ks) {
                const int c0 = 32 * ks + 8 * fq;
                f32x4 acc0 = *(const LAS f32x4*)(CW + 4 * 64 + c0), acc1 = *(const LAS f32x4*)(CW + 4 * 64 + c0 + 4);
#pragma unroll
                for (int k = 0; k < 4; ++k) { f32x4 x0, x1; cvt8(rw[ks][k], x0, x1);
                    acc0 += *(const LAS f32x4*)(CW + k * 64 + c0) * x0; acc1 += *(const LAS f32x4*)(CW + k * 64 + c0 + 4) * x1; }
                v4u u; u.x = pk2h(acc0.x, acc0.y); u.y = pk2h(acc0.z, acc0.w); u.z = pk2h(acc1.x, acc1.y); u.w = pk2h(acc1.z, acc1.w); xa[ks] = __builtin_bit_cast(bf16x8, u);
                if (ks == (qd >> 1) && (fq >> 1) == (qd & 1)) {
                    *(LAS f32x4*)(XCs + fr * 16 + 8 * (fq & 1)) = acc0; *(LAS f32x4*)(XCs + fr * 16 + 8 * (fq & 1) + 4) = acc1; }
            }
            f32x4 pr = (f32x4){bav, bav, bav, bav}, pi = (f32x4){bxv, bxv, bxv, bxv};
#pragma unroll
            for (int ks = 0; ks < 2; ++ks) { pr = MFMA16(xa[ks], waf[ks], pr); pi = MFMA16(xa[ks], wxf[ks], pi); }
            LDS_WAIT(); asm volatile("" ::: "memory");
#pragma unroll
            for (int e = 0; e < 4; ++e) { const int tok = tb + 4 * fq + e;
                const float rg = __builtin_amdgcn_rcpf(1.0f + fexp(-pr[e])), ig = __builtin_amdgcn_rcpf(1.0f + fexp(-pi[e]));
                const float log_a = spv * rg; const float av = fexp(log_a);
                const float y2 = 2.0f * log_a;
                const float om = y2 > -0.02f ? -y2 * (1.0f + y2 * (0.5f + y2 * (0.16666667f + y2 * 0.041666668f))) : 1.0f - av * av;
                const float mult = (T0 + tok == 0) ? 1.0f : sqrtf(om);
                const float xcv = XCs[(4 * fq + e) * 16 + fr];
                Al[lr_row(tok) * 16 + fr] = av; Bl[lr_row(tok) * 16 + fr] = mult * ig * xcv; }
            LDS_WAIT(); asm volatile("" ::: "memory");
            if (tt + 1 < 4) {
#pragma unroll
                for (int ks = 0; ks < 2; ++ks)
#pragma unroll
                    for (int k = 0; k < 4; ++k) rw[ks][k] = nx[ks][k];
            }
        }
        LBAR();
        {
            const int sg = tid >> 4, c = tid & 15; float pa = 1.f, hb = 0.f;
#pragma unroll
            for (int i = 0; i < 16; ++i) { const int r = (sg * 17 + i) * 16 + c; const float av = Al[r]; hb = av * hb + Bl[r]; pa *= av; }
            SegA[sg * 16 + c] = pa; SegB[sg * 16 + c] = hb;
        }
        LBAR();
        if (tid < 16) { float h = Car[tid];
            for (int sg = 0; sg < 32; ++sg) { CarIn[sg * 16 + tid] = h; h = SegA[sg * 16 + tid] * h + SegB[sg * 16 + tid]; }
            Car[tid] = h; }
        LBAR();
        {
            const int sg = tid >> 4, c = tid & 15; float h = CarIn[sg * 16 + c];
#pragma unroll
            for (int i = 0; i < 16; ++i) { const int r = (sg * 17 + i) * 16 + c; h = Al[r] * h + Bl[r]; Bl[r] = h; }
        }
        LBAR();
        {
            const int tok = tid; const bf16* gp = proj_seq + (size_t)(T0 + tok) * NPJ + OFF_GATE + hh * 64 + qd * 16;
            float y[16]; f32x4 gq[4]; cvt8(*(const GAS v4u*)gp, gq[0], gq[1]); cvt8(*(const GAS v4u*)(gp + 8), gq[2], gq[3]);
#pragma unroll
            for (int v = 0; v < 4; ++v) { const f32x4 gt = gq[v]; const f32x4 hv = *(const LAS f32x4*)(Bl + lr_row(tok) * 16 + 4 * v);
#pragma unroll
                for (int i = 0; i < 4; ++i) { const float x = gt[i]; const float u = 0.7978845608028654f * (x + 0.044715f * x * x * x); const float th = 1.0f - 2.0f * __builtin_amdgcn_rcpf(1.0f + fexp(2.0f * u));
                    y[4 * v + i] = hv[i] * 0.5f * x * (1.0f + th); } }
            v4u o0, o1; o0.x = pk2h(y[0], y[1]); o0.y = pk2h(y[2], y[3]); o0.z = pk2h(y[4], y[5]); o0.w = pk2h(y[6], y[7]); o1.x = pk2h(y[8], y[9]); o1.y = pk2h(y[10], y[11]); o1.z = pk2h(y[12], y[13]); o1.w = pk2h(y[14], y[15]);
            v4u* op = (v4u*)(mixb + (size_t)(T0 + tok) * 2048); op[0] = o0; op[1] = o1;
        }
        LBAR();
    }
    if (tid0 < 16) a->out[O_PLRU + ((size_t)l * 8 + b) * 512 + hh * 64 + qd * 16 + tid0] = Car[tid0];
    __syncthreads();
}

constexpr int PL_UP = 0, PL_UPROW = 132 * 4, PL_P = 143 * PL_UPROW;
static_assert(PL_P % 16 == 0 && PL_P + 32768 <= RING_BYTES, "pool LDS map");
__device__ __forceinline__ void pool_prompt_item(KP a, Frame& F, int l, int b, int c, int g) {
    LAS unsigned char* L = F.lds;
    const int tid = F.tid, lane = F.lane, w = F.wave, fr = lane & 15, fq = lane >> 4;
    const int t0 = c * 128, win = 2 << g;
    const bf16* proj_seq = (const bf16*)(a->ws + WS_PROJ) + (size_t)b * 2048 * NPJ;
    const bf16* pwt = (const bf16*)(a->ws + WS_PWT) + ((size_t)l * 4 + g) * 128 * 128;
    bf16* mixb = (bf16*)(a->ws + WS_MIXB) + (size_t)b * 2048 * 2048 + 1024 + g * 128;
    {
        v4u ur[5];
#pragma unroll
        for (int k = 0; k < 5; ++k) { const int i = tid + k * NTHR, rr = i >> 4, c8 = i & 15, row = t0 + rr - 15; ur[k] = (v4u){0u, 0u, 0u, 0u};
            if (i < 143 * 16 && row >= 0) ur[k] = *(const GAS v4u*)(proj_seq + (size_t)row * NPJ + OFF_POOL + g * 128 + 8 * c8); }
#pragma unroll
        for (int k = 0; k < 5; ++k) { const int i = tid + k * NTHR, rr = i >> 4, c8 = i & 15; f32x4 v0, v1; cvt8(ur[k], v0, v1);
            if (i < 143 * 16) { *(LAS f32x4*)(L + PL_UP + rr * PL_UPROW + c8 * 32) = v0; *(LAS f32x4*)(L + PL_UP + rr * PL_UPROW + c8 * 32 + 16) = v1; } }
    }
    __syncthreads();
    for (int i = tid; i < 128 * 16; i += NTHR) { const int tok = i >> 4, c8 = i & 15;
        f32x4 s0 = (f32x4){0.f, 0.f, 0.f, 0.f}, s1 = s0;
        for (int j = 0; j < win; ++j) { const LAS unsigned char* p = L + PL_UP + (tok + 15 - j) * PL_UPROW + c8 * 32; s0 += *(const LAS f32x4*)p; s1 += *(const LAS f32x4*)(p + 16); }
        const int pos = t0 + tok; const float ic = 1.0f / (float)((pos + 1 < win) ? (pos + 1) : win);
        const LAS unsigned char* p = L + PL_UP + (tok + 15) * PL_UPROW + c8 * 32; const f32x4 u0 = *(const LAS f32x4*)p, u1 = *(const LAS f32x4*)(p + 16);
        s0 = s0 * ic - u0; s1 = s1 * ic - u1;
        v4u o; o.x = pk2h(s0.x, s0.y); o.y = pk2h(s0.z, s0.w); o.z = pk2h(s1.x, s1.y); o.w = pk2h(s1.z, s1.w);
        *(LAS v4u*)(L + PL_P + sw128(tok, c8)) = o; }
    __syncthreads();
    bf16x8 pa[4];
#pragma unroll
    for (int ks = 0; ks < 4; ++ks) pa[ks] = *(const LAS bf16x8*)(L + PL_P + sw128(16 * w + fr, 4 * ks + fq));
#pragma unroll
    for (int dt = 0; dt < 8; ++dt) { f32x4 acc = (f32x4){0.f, 0.f, 0.f, 0.f};
#pragma unroll
        for (int ks = 0; ks < 4; ++ks) { const bf16x8 wf = *(const bf16x8*)(pwt + (size_t)(16 * dt + fr) * 128 + 32 * ks + 8 * fq); acc = MFMA16(pa[ks], wf, acc); }
#pragma unroll
        for (int e = 0; e < 4; ++e) mixb[(size_t)(t0 + 16 * w + 4 * fq + e) * 2048 + 16 * dt + fr] = (bf16)f2bfh(acc[e]); }
    __syncthreads();
}

struct TI { const float* W; bf16* WT; const float* gain; int K, N, k0, n0, row_off, mode, goff, kd0; };
__device__ __forceinline__ void ti_load(const TI& t, f32x4 (&v)[8], float (&gn)[8], int lane) {
    const int nn = (lane & 7) * 4, kr = lane >> 3;
#pragma unroll
    for (int i = 0; i < 8; ++i) { const int kk = 8 * i + kr; v[i] = (f32x4){0.f, 0.f, 0.f, 0.f}; gn[i] = 1.f;
        if (t.n0 + nn + 4 <= t.N) v[i] = *(const f32x4*)(t.W + (size_t)(t.k0 + kk) * t.N + t.n0 + nn);
        if (t.gain) gn[i] = t.gain[t.k0 + kk - t.goff]; }
}
__device__ __forceinline__ void ti_store(const TI& t, const f32x4 (&v)[8], const float (&gn)[8], LAS float* scr, int lane) {
    const int nn = (lane & 7) * 4, kr = lane >> 3;
#pragma unroll
    for (int i = 0; i < 8; ++i) { const int kk = 8 * i + kr; f32x4 x = v[i] * gn[i];
        scr[kk * 33 + nn] = x.x; scr[kk * 33 + nn + 1] = x.y; scr[kk * 33 + nn + 2] = x.z; scr[kk * 33 + nn + 3] = x.w; }
    LDS_WAIT(); asm volatile("" ::: "memory");
    const int c = lane & 7;
#pragma unroll
    for (int j = 0; j < 4; ++j) { const int nl = (lane >> 3) + 8 * j, n = t.n0 + nl; const LAS float* sp = scr + (8 * c) * 33 + nl;
        v4u o; o.x = pk2h(sp[0 * 33], sp[1 * 33]); o.y = pk2h(sp[2 * 33], sp[3 * 33]); o.z = pk2h(sp[4 * 33], sp[5 * 33]); o.w = pk2h(sp[6 * 33], sp[7 * 33]);
        int dr;
        if (t.mode == 0) dr = t.row_off + n; else if (t.mode == 1) dr = n < 3072 ? n : (n < 3088 ? 4096 + (n - 3072) : n - 16); else dr = 256 * (n >> 7) + (n & 127) + t.row_off;
        if (n < t.N) *(GAS v4u*)(t.WT + (size_t)dr * t.K + t.kd0 + 8 * c) = o; }
    LDS_WAIT(); asm volatile("" ::: "memory");
}
__device__ __forceinline__ void ph_prologue(KP a, Frame& F) {
    LAS float* scr = (LAS float*)(F.lds + RING_OFF + F.wave * 16384);
    const int gw = F.bid * NWAVES + F.wave, NGW = F.G * NWAVES;
    bf16* Wkv = (bf16*)(a->ws + WS_WKV); bf16* Win = (bf16*)(a->ws + WS_WIN); bf16* Wout = (bf16*)(a->ws + WS_WOUT); bf16* Wq = (bf16*)(a->ws + WS_WQ); bf16* Wo = (bf16*)(a->ws + WS_WO);
    bf16* Wgu = (bf16*)(a->ws + WS_WGU); bf16* Wd = (bf16*)(a->ws + WS_WD);
    constexpr int I_IN = 16 * 129, I_OUT = 32 * 32, I_SQ = 16 * 32, I_G = 16 * 88, I_DN = 44 * 32;
    constexpr int PER_L = I_IN + I_OUT + 4 * I_SQ + 2 * I_G + I_DN;
    auto decode = [&](int it) -> TI {
        const int l = it / PER_L; int r = it % PER_L; TI t; t.goff = 0; t.row_off = 0; t.gain = nullptr; t.mode = 0;
        if (r < I_IN) { const int kb = r / 129, nb = r % 129; t.W = a->in[11] + (size_t)l * 1024 * NIN; t.K = 1024; t.N = NIN; t.k0 = 64 * kb; t.kd0 = 64 * kb; t.n0 = 32 * nb; t.WT = Win + (size_t)l * WIN_L; t.mode = 1; t.gain = a->in[10] + (size_t)l * 1024; return t; } r -= I_IN;
        if (r < I_OUT) { const int kb = r / 32, nb = r % 32; t.W = a->in[27] + (size_t)l * 2048 * 1024; t.K = 2048; t.N = 1024; t.k0 = 64 * kb; t.kd0 = 64 * kb; t.n0 = 32 * nb; t.WT = Wout + (size_t)l * WOUT_L; if (kb >= 8 && kb < 24) { t.gain = a->in[19] + (size_t)l * 1024; t.goff = 512; t.kd0 = 64 * (kb - 8); } else if (kb < 8) t.kd0 = 64 * (kb + 16); return t; } r -= I_OUT;
        if (r < I_SQ) { const int kb = r / 32, nb = r % 32; t.W = a->in[29] + (size_t)l * 1024 * 1024; t.K = 1024; t.N = 1024; t.k0 = 64 * kb; t.kd0 = 64 * kb; t.n0 = 32 * nb; t.WT = Wq + (size_t)l * WQ_L; t.gain = a->in[28] + (size_t)l * 1024; return t; } r -= I_SQ;
        if (r < I_SQ) { const int kb = r / 32, nb = r % 32; t.W = a->in[30] + (size_t)l * 1024 * 1024; t.K = 1024; t.N = 1024; t.k0 = 64 * kb; t.kd0 = 64 * kb; t.n0 = 32 * nb; t.WT = Wkv; t.row_off = l * 2048; return t; } r -= I_SQ;
        if (r < I_SQ) { const int kb = r / 32, nb = r % 32; t.W = a->in[31] + (size_t)l * 1024 * 1024; t.K = 1024; t.N = 1024; t.k0 = 64 * kb; t.kd0 = 64 * kb; t.n0 = 32 * nb; t.WT = Wkv; t.row_off = l * 2048 + 1024; return t; } r -= I_SQ;
        if (r < I_SQ) { const int kb = r / 32, nb = r % 32; t.W = a->in[32] + (size_t)l * 1024 * 1024; t.K = 1024; t.N = 1024; t.k0 = 64 * kb; t.kd0 = 64 * kb; t.n0 = 32 * nb; t.WT = Wo + (size_t)l * WQ_L; return t; } r -= I_SQ;
        if (r < I_G) { const int kb = r / 88, nb = r % 88; t.W = a->in[34] + (size_t)l * 1024 * DFF; t.K = 1024; t.N = DFF; t.k0 = 64 * kb; t.kd0 = 64 * kb; t.n0 = 32 * nb; t.WT = Wgu + (size_t)l * WGU_L; t.mode = 2; t.gain = a->in[33] + (size_t)l * 1024; return t; } r -= I_G;
        if (r < I_G) { const int kb = r / 88, nb = r % 88; t.W = a->in[35] + (size_t)l * 1024 * DFF; t.K = 1024; t.N = DFF; t.k0 = 64 * kb; t.kd0 = 64 * kb; t.n0 = 32 * nb; t.WT = Wgu + (size_t)l * WGU_L; t.mode = 2; t.row_off = 128; t.gain = a->in[33] + (size_t)l * 1024; return t; } r -= I_G;
        { const int kb = r / 32, nb = r % 32; t.W = a->in[36] + (size_t)l * DFF * 1024; t.K = DFF; t.N = 1024; t.k0 = 64 * kb; t.kd0 = 64 * kb; t.n0 = 32 * nb; t.WT = Wd + (size_t)l * WD_L; return t; }
    };
    if (gw < DEPTH * PER_L) {
        int it = gw; TI cur = decode(it); f32x4 v[8]; float gn[8]; ti_load(cur, v, gn, F.lane);
        for (;;) {
            const int nit = it + NGW; const bool has = nit < DEPTH * PER_L;
            TI nxt = cur; f32x4 vn[8]; float gnn[8];
            if (has) { nxt = decode(nit); ti_load(nxt, vn, gnn, F.lane); }
            ti_store(cur, v, gn, scr, F.lane);
            if (!has) break;
            cur = nxt; it = nit;
#pragma unroll
            for (int i = 0; i < 8; ++i) { v[i] = vn[i]; gn[i] = gnn[i]; }
        }
    }
    { bf16* pwt = (bf16*)(a->ws + WS_PWT);
      for (size_t i = (size_t)F.bid * NTHR + F.tid; i < (size_t)DEPTH * 4 * 128 * 128; i += (size_t)F.G * NTHR) { const int c = (int)(i & 127), d = (int)((i >> 7) & 127), lg = (int)(i >> 14);
          pwt[i] = (bf16)f2bfh(a->in[12][((size_t)lg * 128 + c) * 128 + d] * a->in[13][(size_t)lg * 128 + d]); } }
    const size_t gt = (size_t)F.bid * NTHR + F.tid, gs = (size_t)F.G * NTHR;
    { const f32x4* src = (const f32x4*)a->in[2]; unsigned long long* dst = (unsigned long long*)(a->ws + WS_MEMB);
      for (size_t i = gt; i < (size_t)2048 * 1024 / 4; i += gs) { const f32x4 v = src[i]; dst[i] = (unsigned long long)pk2h(v.x, v.y) | ((unsigned long long)pk2h(v.z, v.w) << 32); } }
    { bf16* hb = (bf16*)(a->ws + WS_HB); float* rss = (float*)(a->ws + WS_RSS);
      for (int r0 = gw; r0 < MT; r0 += 4 * NGW) {
          f32x4 v[4][4];
#pragma unroll
          for (int q = 0; q < 4; ++q) { const int r = r0 + q * NGW; const f32x4* src = (const f32x4*)((r < MP ? a->in[0] : a->in[1] - (size_t)MP * D) + (size_t)r * D);
#pragma unroll
              for (int j = 0; j < 4; ++j) v[q][j] = r < MT ? src[F.lane + 64 * j] : (f32x4){0.f, 0.f, 0.f, 0.f}; }
#pragma unroll
          for (int q = 0; q < 4; ++q) { const int r = r0 + q * NGW; float ss = 0.f;
              if (r < MT) {
#pragma unroll
                  for (int j = 0; j < 4; ++j) { const f32x4 x = v[q][j]; ss += x.x * x.x + x.y * x.y + x.z * x.z + x.w * x.w;
                      ((unsigned long long*)(hb + (size_t)r * D))[F.lane + 64 * j] = (unsigned long long)pk2h(x.x, x.y) | ((unsigned long long)pk2h(x.z, x.w) << 32); } }
              ss = wave_sum(ss);
              if (r < MT && F.lane < 16) rss[(size_t)r * 16 + F.lane] = F.lane == 0 ? ss : 0.f; } } }
}

__device__ __forceinline__ void ph_final_norm(Frame& F, const bf16* hb, const float* g, float* Y) {
    const int gw = F.bid * NWAVES + F.wave, NGW = F.G * NWAVES;
    f32x4 gg[4];
#pragma unroll
    for (int j = 0; j < 4; ++j) gg[j] = ((const f32x4*)g)[F.lane + 64 * j];
    for (int r0 = gw; r0 < MT; r0 += 4 * NGW) {
        unsigned long long u[4][4];
#pragma unroll
        for (int q = 0; q < 4; ++q) { const int r = r0 + q * NGW;
#pragma unroll
            for (int j = 0; j < 4; ++j) u[q][j] = r < MT ? ((const unsigned long long*)(hb + (size_t)r * D))[F.lane + 64 * j] : 0ull; }
#pragma unroll
        for (int q = 0; q < 4; ++q) { const int r = r0 + q * NGW; f32x4 v[4]; float ss = 0.f;
#pragma unroll
            for (int j = 0; j < 4; ++j) { const unsigned long long x = u[q][j];
                v[j] = (f32x4){bf2f((unsigned short)x), bf2f((unsigned short)(x >> 16)), bf2f((unsigned short)(x >> 32)), bf2f((unsigned short)(x >> 48))}; ss += v[j].x * v[j].x + v[j].y * v[j].y + v[j].z * v[j].z + v[j].w * v[j].w; }
            ss = wave_sum(ss);
            const float rstd = 1.0f / sqrtf(ss * (1.0f / D) + EPS);
            if (r < MT) {
#pragma unroll
                for (int j = 0; j < 4; ++j) ((f32x4*)(Y + (size_t)r * D))[F.lane + 64 * j] = v[j] * rstd * gg[j]; } }
    }
}

__device__ __forceinline__ float pool_up(const bf16* proj, const float* st_in, const SeqInfo& q, int ci, int ch) {
    if (ci < 15) return q.grp ? st_in[((size_t)q.b * 15 + ci) * 512 + ch] : 0.f;
    return bf2f(proj[(size_t)(q.row0 + ci - 15) * NPJ + OFF_POOL + ch]);
}
__device__ __forceinline__ float conv_xp(const bf16* proj, int off, const float* st_in, int C, const SeqInfo& q, int j, int c) {
    if (j < 3) return q.grp ? st_in[((size_t)q.b * 3 + j) * C + c] : 0.f;
    return bf2f(proj[(size_t)(q.row0 + j - 3) * NPJ + off + c]);
}
__device__ __forceinline__ void conv_states(size_t gt, size_t gs, const bf16* proj, int off, int C, const float* st_in, float* p_out, float* s_out) {
    for (size_t idx = gt; idx < (size_t)NSEQ * 3 * C; idx += gs) {
        const int c = (int)(idx % C), j = (int)((idx / C) % 3), s = (int)(idx / ((size_t)3 * C));
        const SeqInfo q = seq_info(s);
        const float v = conv_xp(proj, off, st_in, C, q, q.L + j, c);
        if (q.grp) s_out[((size_t)q.b * 3 + j) * C + c] = v; else p_out[((size_t)q.b * 3 + j) * C + c] = v;
    }
}
constexpr int SS_X = 0, SS_BC = 8192, SS_DT = 12288;
__device__ __forceinline__ void samp_ssd_item(KP a, Frame& F, int l, int b, int g) {
    LAS float* XS = (LAS float*)(F.lds + RING_OFF + SS_X); LAS float* BC = (LAS float*)(F.lds + RING_OFF + SS_BC); LAS float* DTs = (LAS float*)(F.lds + RING_OFF + SS_DT);
    const int tid = F.tid;
    const bf16* proj = (const bf16*)(a->ws + WS_PROJ) + (size_t)(MP + 4 * b) * NPJ; const float* dtr = (const float*)(a->ws + WS_DT) + (size_t)(MP + 4 * b) * 16;
    const float* cst = a->in[4] + ((size_t)l * 128 + b) * 3 * 1536; const float* cw = a->in[14] + (size_t)l * 4 * 1536; const float* cb = a->in[15] + (size_t)l * 1536;
    bf16* mixb = (bf16*)(a->ws + WS_MIXB) + (size_t)(MP + 4 * b) * 2048;
#pragma unroll
    for (int rep = 0; rep < 2; ++rep) {
        if (rep == 1 && tid >= 256) break;
        const int sc = rep == 0 ? g * 512 + tid : (tid < 128 ? 1024 + g * 128 + tid : 1280 + g * 128 + (tid - 128));
        float xp[7];
#pragma unroll
        for (int j = 0; j < 3; ++j) xp[j] = cst[(size_t)j * 1536 + sc];
#pragma unroll
        for (int t = 0; t < 4; ++t) xp[3 + t] = bf2f(proj[(size_t)t * NPJ + OFF_XBC + sc]);
        const float w0 = cw[sc], w1 = cw[1536 + sc], w2 = cw[2 * 1536 + sc], w3 = cw[3 * 1536 + sc], bb = cb[sc];
#pragma unroll
        for (int t = 0; t < 4; ++t) { const float v = fsilu(bb + w0 * xp[t] + w1 * xp[t + 1] + w2 * xp[t + 2] + w3 * xp[t + 3]); if (rep == 0) XS[t * 512 + tid] = v; else BC[t * 256 + tid] = v; }
    }
    if (tid < 32) { const int t = tid >> 3, k = tid & 7, hd = 8 * g + k; const float dt = softplus_f(dtr[(size_t)t * 16 + hd] + a->in[16][l * 16 + hd]); DTs[t * 8 + k] = dt; DTs[32 + t * 8 + k] = expf(dt * -expf(a->in[17][l * 16 + hd])); }
    __syncthreads();
    const int p = tid >> 3, ng = tid & 7;
    const float* st_in = a->in[5] + (((size_t)l * 128 + b) * 16 + 8 * g) * 64 * 128 + (size_t)p * 128 + ng * 16;
    float* st_out = a->out + O_SSSD + (((size_t)l * 128 + b) * 16 + 8 * g) * 64 * 128 + (size_t)p * 128 + ng * 16;
    f32x4 hn[4];
#pragma unroll
    for (int i = 0; i < 4; ++i) hn[i] = *(const f32x4*)(st_in + 4 * i);
#pragma unroll 1
    for (int k = 0; k < 8; ++k) {
        f32x4 h[4];
#pragma unroll
        for (int i = 0; i < 4; ++i) h[i] = hn[i];
        if (k + 1 < 8) {
#pragma unroll
            for (int i = 0; i < 4; ++i) hn[i] = *(const f32x4*)(st_in + (size_t)(k + 1) * 64 * 128 + 4 * i); }
        const int hd = 8 * g + k; const float Dk = a->in[18][l * 16 + hd];
        float zv[4];
#pragma unroll
        for (int t = 0; t < 4; ++t) zv[t] = bf2f(proj[(size_t)t * NPJ + OFF_Z + hd * 64 + p]);
#pragma unroll
        for (int t = 0; t < 4; ++t) {
            const float dt = DTs[t * 8 + k], dA = DTs[32 + t * 8 + k], x = XS[t * 512 + k * 64 + p], xdt = dt * x;
            float part = 0.f;
#pragma unroll
            for (int i = 0; i < 4; ++i) { const f32x4 Bv = *(const LAS f32x4*)(BC + t * 256 + ng * 16 + 4 * i), Cv = *(const LAS f32x4*)(BC + t * 256 + 128 + ng * 16 + 4 * i);
                h[i] = h[i] * dA + Bv * xdt; part += (Cv.x * h[i].x + Cv.y * h[i].y) + (Cv.z * h[i].z + Cv.w * h[i].w); }
            part += __shfl_xor(part, 1); part += __shfl_xor(part, 2); part += __shfl_xor(part, 4);
            if (ng == 0) mixb[(size_t)t * 2048 + hd * 64 + p] = (bf16)f2bfh((part + Dk * x) * fsilu(zv[t]));
        }
#pragma unroll
        for (int i = 0; i < 4; ++i) *(f32x4*)(st_out + (size_t)k * 64 * 128 + 4 * i) = h[i];
    }
    __syncthreads();
}
__device__ __forceinline__ void samp_lru_item(KP a, Frame& F, int l, int b) {
    LAS float* XC = (LAS float*)(F.lds + RING_OFF);
    const int c = F.tid, hd = c >> 6, j = c & 63;
    const bf16* proj = (const bf16*)(a->ws + WS_PROJ) + (size_t)(MP + 4 * b) * NPJ;
    const float* cst = a->in[6] + ((size_t)l * 128 + b) * 3 * 512; const float* cw = a->in[20] + (size_t)l * 4 * 512;
    float xp[7];
#pragma unroll
    for (int k = 0; k < 3; ++k) xp[k] = cst[(size_t)k * 512 + c];
#pragma unroll
    for (int t = 0; t < 4; ++t) xp[3 + t] = bf2f(proj[(size_t)t * NPJ + OFF_LRU + c]);
    const float w0 = cw[c], w1 = cw[512 + c], w2 = cw[1024 + c], w3 = cw[1536 + c], bb = a->in[21][(size_t)l * 512 + c];
    float xc[4];
#pragma unroll
    for (int t = 0; t < 4; ++t) { xc[t] = bb + w0 * xp[t] + w1 * xp[t + 1] + w2 * xp[t + 2] + w3 * xp[t + 3]; XC[t * 512 + c] = xc[t]; }
    __syncthreads();
    const float* wa = a->in[22] + ((size_t)l * 8 + hd) * 64 * 64 + j; const float* wx = a->in[24] + ((size_t)l * 8 + hd) * 64 * 64 + j;
    float ar[4], ai[4];
#pragma unroll
    for (int t = 0; t < 4; ++t) { ar[t] = a->in[23][(size_t)l * 512 + c]; ai[t] = a->in[25][(size_t)l * 512 + c]; }
#pragma unroll 16
    for (int i = 0; i < 64; ++i) { const float wav = wa[(size_t)i * 64], wxv = wx[(size_t)i * 64];
#pragma unroll
        for (int t = 0; t < 4; ++t) { const float xv = XC[t * 512 + hd * 64 + i]; ar[t] += xv * wav; ai[t] += xv * wxv; } }
    const float lamv = a->in[26][(size_t)l * 512 + c]; const float spv = -8.0f * softplus_f(-lamv);
    float h = a->in[7][((size_t)l * 128 + b) * 512 + c];
    bf16* mixb = (bf16*)(a->ws + WS_MIXB) + (size_t)(MP + 4 * b) * 2048 + 1536 + c;
#pragma unroll
    for (int t = 0; t < 4; ++t) { const float rg = sigmoid_f(ar[t]), ig = sigmoid_f(ai[t]); const float log_a = spv * rg; const float av = expf(log_a), mult = sqrtf(-expm1f(2.0f * log_a));
        h = av * h + mult * ig * xc[t];
        mixb[(size_t)t * 2048] = (bf16)f2bfh(h * gelu_tanh_f(bf2f(proj[(size_t)t * NPJ + OFF_GATE + c]))); }
    a->out[O_SLRU + ((size_t)l * 128 + b) * 512 + c] = h;
    __syncthreads();
}
__device__ __forceinline__ void samp_pool_item(KP a, Frame& F, int l, int b) {
    LAS float* PO = (LAS float*)(F.lds + RING_OFF);
    const int ch = F.tid, g = ch >> 7, w = 2 << g;
    const bf16* proj = (const bf16*)(a->ws + WS_PROJ) + (size_t)(MP + 4 * b) * NPJ;
    const float* st = a->in[3] + ((size_t)l * 128 + b) * 15 * 512;
    float up[19];
#pragma unroll
    for (int i = 0; i < 15; ++i) up[i] = st[(size_t)i * 512 + ch];
#pragma unroll
    for (int t = 0; t < 4; ++t) up[15 + t] = bf2f(proj[(size_t)t * NPJ + OFF_POOL + ch]);
    const float iw = 1.0f / (float)w;
#pragma unroll
    for (int t = 0; t < 4; ++t) { float sm = 0.f;
#pragma unroll
        for (int jj = 0; jj < 16; ++jj) sm += (jj < w) ? up[15 + t - jj] : 0.f;
        PO[t * 512 + ch] = sm * iw - up[15 + t]; }
    __syncthreads();
    const int d = ch & 127; const float* pw = a->in[12] + ((size_t)l * 4 + g) * 128 * 128 + d; const float sc = a->in[13][(size_t)l * 512 + ch];
    float acc[4] = {0.f, 0.f, 0.f, 0.f};
#pragma unroll 16
    for (int cc = 0; cc < 128; ++cc) { const float wv = pw[(size_t)cc * 128];
#pragma unroll
        for (int t = 0; t < 4; ++t) acc[t] += PO[t * 512 + g * 128 + cc] * wv; }
    bf16* mixb = (bf16*)(a->ws + WS_MIXB) + (size_t)(MP + 4 * b) * 2048 + 1024 + ch;
#pragma unroll
    for (int t = 0; t < 4; ++t) mixb[(size_t)t * 2048] = (bf16)f2bfh(acc[t] * sc);
    __syncthreads();
}

__device__ __forceinline__ void ph_mix1(KP a, Frame& F, int l) {
    const size_t gt = (size_t)F.bid * NTHR + F.tid, gs = (size_t)F.G * NTHR;
    const bf16* proj = (const bf16*)(a->ws + WS_PROJ);
    {
        const float* st_in = a->in[3] + (size_t)l * 128 * 15 * 512;
        float* p_out = a->out + O_PPOOL + (size_t)l * 8 * 15 * 512; float* s_out = a->out + O_SPOOL + (size_t)l * 128 * 15 * 512;
        for (size_t idx = gt; idx < (size_t)NSEQ * 15 * 512; idx += gs) {
            const int ch = (int)(idx & 511), j = (int)((idx >> 9) % 15), s = (int)((idx >> 9) / 15);
            const SeqInfo q = seq_info(s);
            const float v = pool_up(proj, st_in, q, q.L + j, ch);
            if (q.grp) s_out[((size_t)q.b * 15 + j) * 512 + ch] = v; else p_out[((size_t)q.b * 15 + j) * 512 + ch] = v;
        }
    }
    conv_states(gt, gs, proj, OFF_XBC, 1536, a->in[4] + (size_t)l * 128 * 3 * 1536, a->out + O_PSCONV + (size_t)l * 8 * 3 * 1536, a->out + O_SSCONV + (size_t)l * 128 * 3 * 1536);
    conv_states(gt, gs, proj, OFF_LRU, 512, a->in[6] + (size_t)l * 128 * 3 * 512, a->out + O_PLCONV + (size_t)l * 8 * 3 * 512, a->out + O_SLCONV + (size_t)l * 128 * 3 * 512);
    __syncthreads();
    { const KP kp = a; (void)kp;
    REG_BEGIN(0);
    for (int it = F.vcu; it < 256; it += F.G) ssd_prompt_item(a, F, l, it >> 5, (it >> 1) & 15, it & 1);
    REG_END(0); REG_BEGIN(1);
    for (int it = F.vcu; it < 256; it += F.G) lru_prompt_item(a, F, l, it >> 5, (it >> 2) & 7, it & 3);
    REG_END(1); }
    for (int it = F.vcu; it < 512; it += F.G) pool_prompt_item(a, F, l, it >> 6, (it >> 2) & 15, it & 3);
    for (int it = F.bid; it < 256; it += F.G) samp_ssd_item(a, F, l, it >> 1, it & 1);
    for (int it = F.bid; it < 256; it += F.G) { if (it < 128) samp_lru_item(a, F, l, it); else samp_pool_item(a, F, l, it - 128); }
}
__device__ __forceinline__ void ph_mix3(KP a, Frame& F, int l) {
    bf16* mixb = (bf16*)(a->ws + WS_MIXB);
    const int gw = F.bid * NWAVES + F.wave, NGW = F.G * NWAVES;
    for (int r = gw; r < MP; r += NGW) {
        const float* sp = (const float*)(a->ws + WS_SSDSS) + (size_t)r * 32;
        float ss = F.lane < 32 ? sp[F.lane] : 0.f; ss = wave_sum(ss);
        const float rstd = 1.0f / sqrtf(ss * (1.0f / 1024.f) + EPS);
#pragma unroll
        for (int j = 0; j < 4; ++j) { const int c = 4 * F.lane + 256 * j; unsigned long long* mp = (unsigned long long*)(mixb + (size_t)r * 2048 + 512 + c); const unsigned long long u = *mp;
            const float w0 = bf2f((unsigned short)u) * rstd, w1 = bf2f((unsigned short)(u >> 16)) * rstd, w2 = bf2f((unsigned short)(u >> 32)) * rstd, w3 = bf2f((unsigned short)(u >> 48)) * rstd;
            *mp = (unsigned long long)pk2h(w0, w1) | ((unsigned long long)pk2h(w2, w3) << 32); }
    }
}
constexpr int SG_PSTRIDE = 36, SG_P = 0, SG_SS = 8 * 64 * SG_PSTRIDE * 4;
static_assert(SG_SS + 8 * 64 * 4 <= RING_BYTES, "small gemm LDS map");
__device__ __forceinline__ float sumsq8(bf16x8 v) { float s = 0.f;
#pragma unroll
    for (int j = 0; j < 8; ++j) { const float x = bf2f((unsigned short)v[j]); s += x * x; } return s; }
template <int K, int STATS  , class Epi>
__device__ __forceinline__ void small_gemm(Frame& F, const bf16* A, const bf16* Bt, int it0, int it1, const Epi& E) {
    constexpr int KW = K / 8, KS = KW / 32;
    constexpr bool REUSE = Epi::RT_SLOW && K == 1024;
    static_assert(K % 256 == 0, "K splits into eight 32-multiples");
    LAS float* P = (LAS float*)(F.lds + RING_OFF + SG_P); LAS float* SS = (LAS float*)(F.lds + RING_OFF + SG_SS);
    const int w = F.wave;
    bf16x8 afr[REUSE ? KS : 1][4]; float ssqr[4] = {0.f, 0.f, 0.f, 0.f}; int rt_have = -1;
    for (int it = it0; it < it1; ++it) {
        int tid = F.tid; asm volatile("" : "+v"(tid));
        const int lane = tid & 63, fr = lane & 15, fq = lane >> 4;
        const int rt = Epi::RT_SLOW ? it / E.nctl : (it & 7), ct = Epi::RT_SLOW ? E.ct0 + it % E.nctl : (it >> 3);
        if (Epi::RT_SLOW && ct >= Epi::NCT) continue;
        int nb0, nb1; E.bases(ct, nb0, nb1);
        const bf16* Ap = A + (size_t)(64 * rt + fr) * K + w * KW + 8 * fq;
        const bf16* Bp0 = Bt + (size_t)(nb0 + fr) * K + w * KW + 8 * fq; const bf16* Bp1 = Bt + (size_t)(nb1 + fr) * K + w * KW + 8 * fq;
        f32x4 acc[4][2]; float ssq[4];
#pragma unroll
        for (int mt = 0; mt < 4; ++mt) { acc[mt][0] = (f32x4){0.f, 0.f, 0.f, 0.f}; acc[mt][1] = (f32x4){0.f, 0.f, 0.f, 0.f}; ssq[mt] = 0.f; }
        if constexpr (REUSE) {
            bf16x8 bq[KS][2];
#pragma unroll
            for (int ks = 0; ks < KS; ++ks) { bq[ks][0] = *(const bf16x8*)(Bp0 + 32 * ks); bq[ks][1] = *(const bf16x8*)(Bp1 + 32 * ks); }
            if (rt != rt_have) {
#pragma unroll
                for (int ks = 0; ks < KS; ++ks)
#pragma unroll
                    for (int mt = 0; mt < 4; ++mt) afr[ks][mt] = *(const bf16x8*)(Ap + (size_t)mt * 16 * K + 32 * ks);
#pragma unroll
                for (int mt = 0; mt < 4; ++mt) { float sv = 0.f;
#pragma unroll
                    for (int ks = 0; ks < KS; ++ks) sv += sumsq8(afr[ks][mt]);
                    ssqr[mt] = sv; }
                rt_have = rt;
            }
#pragma unroll
            for (int ks = 0; ks < KS; ++ks)
#pragma unroll
                for (int mt = 0; mt < 4; ++mt) { acc[mt][0] = MFMA16(afr[ks][mt], bq[ks][0], acc[mt][0]); acc[mt][1] = MFMA16(afr[ks][mt], bq[ks][1], acc[mt][1]); }
#pragma unroll
            for (int mt = 0; mt < 4; ++mt) ssq[mt] = ssqr[mt];
        } else {
#pragma unroll
            for (int ks = 0; ks < KS; ++ks) {
                bf16x8 af[4];
#pragma unroll
                for (int mt = 0; mt < 4; ++mt) af[mt] = *(const bf16x8*)(Ap + (size_t)mt * 16 * K + 32 * ks);
                const bf16x8 b0 = *(const bf16x8*)(Bp0 + 32 * ks), b1 = *(const bf16x8*)(Bp1 + 32 * ks);
#pragma unroll
                for (int mt = 0; mt < 4; ++mt) { acc[mt][0] = MFMA16(af[mt], b0, acc[mt][0]); acc[mt][1] = MFMA16(af[mt], b1, acc[mt][1]); if (STATS == 1 || (STATS == 2 && w < 4)) ssq[mt] += sumsq8(af[mt]); }
            }
        }
#pragma unroll
        for (int mt = 0; mt < 4; ++mt) {
#pragma unroll
            for (int nt = 0; nt < 2; ++nt)
#pragma unroll
                for (int e = 0; e < 4; ++e) P[(w * 64 + 16 * mt + 4 * fq + e) * SG_PSTRIDE + 16 * nt + fr] = acc[mt][nt][e];
            if (STATS) { float sv = ssq[mt]; sv += __shfl_xor(sv, 16); sv += __shfl_xor(sv, 32); if (fq == 0) SS[w * 64 + 16 * mt + fr] = sv; }
        }
        __syncthreads();
        {
            const int row = tid >> 3, cq = tid & 7;
            f32x4 v = (f32x4){0.f, 0.f, 0.f, 0.f}, v2 = v;
            float rstd = 1.f;
            if (STATS) { float sm = 0.f;
#pragma unroll
                for (int ww = 0; ww < 8; ++ww) sm += SS[ww * 64 + row];
                rstd = 1.0f / sqrtf(sm * (1.0f / 1024.f) + EPS); }
#pragma unroll
            for (int ww = 0; ww < 8; ++ww) { const float sc = (STATS == 2 && ww < 4) ? rstd : 1.f;
                v += *(const LAS f32x4*)(P + (ww * 64 + row) * SG_PSTRIDE + 4 * cq) * sc; if (Epi::PAIR) v2 += *(const LAS f32x4*)(P + (ww * 64 + row) * SG_PSTRIDE + 4 * (cq ^ 4)); }
            if (STATS == 2) rstd = 1.f;
            E.store(ct, MP + 64 * rt + row, cq, v, v2, rstd);
        }
        __syncthreads();
    }
}
struct SProj {
    static constexpr bool PAIR = false, RT_SLOW = true; static constexpr int NCT = 129; bf16* proj; float* dtr; int ct0, nctl;
    __device__ __forceinline__ void bases(int ct, int& nb0, int& nb1) const { nb0 = 32 * ct; nb1 = nb0 + 16; }
    __device__ __forceinline__ void store(int ct, int row, int cq, f32x4 v, f32x4, float rstd) const { const int j = 32 * ct + 4 * cq; const f32x4 o = v * rstd;
        if (j < 4096) *(unsigned long long*)(proj + (size_t)row * NPJ + j) = (unsigned long long)pk2h(o.x, o.y) | ((unsigned long long)pk2h(o.z, o.w) << 32);
        else if (j < 4112) *(f32x4*)(dtr + (size_t)row * 16 + (j - 4096)) = o; }
};
struct SResid {
    static constexpr bool PAIR = false, RT_SLOW = false; static constexpr int NCT = 32, ct0 = 0, nctl = 1; bf16* hb;
    __device__ __forceinline__ void bases(int ct, int& nb0, int& nb1) const { nb0 = 32 * ct; nb1 = nb0 + 16; }
    __device__ __forceinline__ void store(int ct, int row, int cq, f32x4 v, f32x4, float) const { const int c = 32 * ct + 4 * cq; unsigned long long* hp = (unsigned long long*)(hb + (size_t)row * 1024 + c); const unsigned long long u = *hp;
        const float o0 = bf2f((unsigned short)u) + v.x, o1 = bf2f((unsigned short)(u >> 16)) + v.y, o2 = bf2f((unsigned short)(u >> 32)) + v.z, o3 = bf2f((unsigned short)(u >> 48)) + v.w;
        *hp = (unsigned long long)pk2h(o0, o1) | ((unsigned long long)pk2h(o2, o3) << 32); }
};
struct SQ {
    static constexpr bool PAIR = false, RT_SLOW = false; static constexpr int NCT = 32, ct0 = 0, nctl = 1; bf16* qb; float scale;
    __device__ __forceinline__ void bases(int ct, int& nb0, int& nb1) const { nb0 = 32 * ct; nb1 = nb0 + 16; }
    __device__ __forceinline__ void store(int ct, int row, int cq, f32x4 v, f32x4, float rstd) const { const int c = 32 * ct + 4 * cq; const f32x4 o = v * (rstd * scale);
        *(unsigned long long*)(qb + (size_t)row * 1024 + c) = (unsigned long long)pk2h(o.x, o.y) | ((unsigned long long)pk2h(o.z, o.w) << 32); }
};
struct SSwiGLU {
    static constexpr bool PAIR = true, RT_SLOW = true; static constexpr int NCT = 176; bf16* act; int ct0, nctl;
    __device__ __forceinline__ void bases(int ct, int& nb0, int& nb1) const { nb0 = 256 * (ct >> 3) + 16 * (ct & 7); nb1 = nb0 + 128; }
    __device__ __forceinline__ void store(int ct, int row, int cq, f32x4 g, f32x4 u, float rstd) const { if (cq < 4) { const int c = 128 * (ct >> 3) + 16 * (ct & 7) + 4 * cq; const f32x4 gs = g * rstd, us = u * rstd;
        *(unsigned long long*)(act + (size_t)row * DFF + c) = (unsigned long long)pk2h(fsilu(gs.x) * us.x, fsilu(gs.y) * us.y) | ((unsigned long long)pk2h(fsilu(gs.z) * us.z, fsilu(gs.w) * us.w) << 32); } }
};
__device__ __forceinline__ void dt_gemm(Frame& F, const bf16* hb, const bf16* Wdt, const float* rss, float* dtr) {
    for (int it = F.bid; it < MP / 128; it += F.G) {
        int tid = F.tid; asm volatile("" : "+v"(tid)); const int lane = tid & 63, fr = lane & 15, fq = lane >> 4;
        const int row0 = it * 128 + 16 * F.wave;
        f32x4 acc = (f32x4){0.f, 0.f, 0.f, 0.f};
#pragma unroll 8
        for (int ks = 0; ks < 32; ++ks) { const bf16x8 af = *(const bf16x8*)(hb + (size_t)(row0 + fr) * 1024 + 32 * ks + 8 * fq); const bf16x8 bfm = *(const bf16x8*)(Wdt + (size_t)fr * 1024 + 32 * ks + 8 * fq); acc = MFMA16(af, bfm, acc); }
#pragma unroll
        for (int e = 0; e < 4; ++e) { const int row = row0 + 4 * fq + e; const f32x4* rp = (const f32x4*)(rss + (size_t)row * 16); const f32x4 p0 = rp[0], p1 = rp[1], p2 = rp[2], p3 = rp[3];
            const float sm = ((p0.x + p0.y) + (p0.z + p0.w)) + ((p1.x + p1.y) + (p1.z + p1.w)) + ((p2.x + p2.y) + (p2.z + p2.w)) + ((p3.x + p3.y) + (p3.z + p3.w));
            dtr[(size_t)row * 16 + fr] = acc[e] * (1.0f / sqrtf(sm * (1.0f / 1024.f) + EPS)); }
    }
}

__device__ __forceinline__ void attn_prompt_unit(Frame& F, const bf16* qb, const bf16* kb_l, const bf16* vt_l, bf16* ob, int b, int hh, int qt) {
    LAS unsigned char* lds = F.lds + RING_OFF;
    const int lane = F.lane, fr = lane & 15, fq = lane >> 4, tid = F.tid;
    const int r0 = b * 2048 + qt * 256 + F.wave * 32;
    const bf16* kbase = kb_l + (size_t)(b * 256) * 1024 + hh * 256; const bf16* vbase = vt_l + (size_t)(hh * 256) * 2048 + b * 256;
    v4u rg[8];
#define ATT_LOAD(base, pitch, half) do { const bf16* tb_ = (base); asm volatile("" : "+s"(tb_)); tb_ += (size_t)((half) * 128 + (tid >> 5)) * (pitch) + (tid & 31) * 8; \
        _Pragma("unroll") for (int ps = 0; ps < 8; ++ps) rg[ps] = *(const GAS v4u*)(tb_ + (size_t)ps * 16 * (pitch)); } while (0)
#define ATT_STORE(bufoff) do { LAS unsigned char* lb_ = lds + (bufoff) + (tid >> 5) * 512 + (((tid & 31) ^ ((tid >> 5) & 15)) << 4); \
        _Pragma("unroll") for (int ps = 0; ps < 8; ++ps) *(LAS v4u*)(lb_ + ps * 8192) = rg[ps]; } while (0)
    ATT_LOAD(kbase, 1024, 0); ATT_STORE(0);
    ATT_LOAD(kbase, 1024, 1); ATT_STORE(65536);
    LBAR();
    bf16x8 pf[2][8]; float inv[2];
#pragma unroll
    for (int mt = 0; mt < 2; ++mt) {
        __builtin_amdgcn_sched_barrier(0);
        bf16x8 qf[8];
#pragma unroll
        for (int ks = 0; ks < 8; ++ks) qf[ks] = *(const bf16x8*)(qb + (size_t)(r0 + mt * 16 + fr) * 1024 + hh * 256 + ks * 32 + fq * 8);
        f32x4 s[16];
#pragma unroll
        for (int kt = 0; kt < 16; ++kt) { s[kt] = (f32x4){0.f, 0.f, 0.f, 0.f};
#pragma unroll
            for (int kh = 0; kh < 2; ++kh) { bf16x8 kf[4];
#pragma unroll
                for (int ks = 0; ks < 4; ++ks) kf[ks] = *(const LAS bf16x8*)(lds + (16 * kt + fr) * 512 + (((4 * (4 * kh + ks) + fq) ^ fr) << 4));
#pragma unroll
                for (int ks = 0; ks < 4; ++ks) s[kt] = MFMA16(kf[ks], qf[4 * kh + ks], s[kt]);
                __builtin_amdgcn_sched_barrier(0); } }
        float m = -3.0e38f;
#pragma unroll
        for (int kt = 0; kt < 16; ++kt) m = fmaxf(fmaxf(fmaxf(s[kt][0], s[kt][1]), fmaxf(s[kt][2], s[kt][3])), m);
        m = fmaxf(m, __shfl_xor(m, 16)); m = fmaxf(m, __shfl_xor(m, 32));
        float sum = 0.f;
#pragma unroll
        for (int kt = 0; kt < 16; ++kt)
#pragma unroll
            for (int e = 0; e < 4; ++e) { const float p = __builtin_amdgcn_exp2f(s[kt][e] - m); s[kt][e] = p; sum += p; }
        sum += __shfl_xor(sum, 16); sum += __shfl_xor(sum, 32);
        inv[mt] = 1.0f / sum;
#pragma unroll
        for (int ks = 0; ks < 8; ++ks) { v4u w; w.x = pk2h(s[2 * ks][0], s[2 * ks][1]); w.y = pk2h(s[2 * ks][2], s[2 * ks][3]);
            w.z = pk2h(s[2 * ks + 1][0], s[2 * ks + 1][1]); w.w = pk2h(s[2 * ks + 1][2], s[2 * ks + 1][3]); pf[mt][ks] = __builtin_bit_cast(bf16x8, w); }
        __builtin_amdgcn_sched_barrier(0);
    }
    LBAR();
    ATT_LOAD(vbase, 2048, 0); ATT_STORE(0); ATT_LOAD(vbase, 2048, 1); ATT_STORE(65536);
    LBAR();
#pragma unroll
    for (int qr = 0; qr < 4; ++qr) {
        const int bo = (qr >> 1) * 65536;
        f32x4 o[2][4];
#pragma unroll
        for (int dl = 0; dl < 4; ++dl) { o[0][dl] = (f32x4){0.f, 0.f, 0.f, 0.f}; o[1][dl] = (f32x4){0.f, 0.f, 0.f, 0.f};
#pragma unroll
            for (int kh = 0; kh < 2; ++kh) { bf16x8 vf[4];
#pragma unroll
                for (int ks = 0; ks < 4; ++ks) vf[ks] = *(const LAS bf16x8*)(lds + bo + (16 * ((qr & 1) * 4 + dl) + fr) * 512 + (((4 * (4 * kh + ks) + fq) ^ fr) << 4));
#pragma unroll
                for (int ks = 0; ks < 4; ++ks) { o[0][dl] = MFMA16(vf[ks], pf[0][4 * kh + ks], o[0][dl]); o[1][dl] = MFMA16(vf[ks], pf[1][4 * kh + ks], o[1][dl]); }
                __builtin_amdgcn_sched_barrier(0); } }
#pragma unroll
        for (int mt = 0; mt < 2; ++mt)
#pragma unroll
            for (int dl = 0; dl < 4; ++dl) { const f32x4 v = o[mt][dl] * inv[mt];
                *(unsigned long long*)(ob + (size_t)(r0 + mt * 16 + fr) * 1024 + hh * 256 + 16 * (qr * 4 + dl) + 4 * fq) = (unsigned long long)pk2h(v[0], v[1]) | ((unsigned long long)pk2h(v[2], v[3]) << 32); }
        __builtin_amdgcn_sched_barrier(0);
    }
#undef ATT_LOAD
#undef ATT_STORE
    __syncthreads();
}
__device__ __forceinline__ void attn_sample_item(Frame& F, const bf16* qb, const float* Ks_l, const float* Vs_l, bf16* ob, int b, int hh) {
    LAS float* Sl = (LAS float*)(F.lds + RING_OFF);
    LAS float* Ol = (LAS float*)(F.lds + RING_OFF + 4096);
    const int lane = F.lane, w = F.wave, d4 = 4 * lane;
    const float* Kb = Ks_l + (size_t)b * 256 * 1024 + hh * 256 + d4;
    const float* Vb = Vs_l + (size_t)b * 256 * 1024 + hh * 256 + d4;
    f32x4 q[4];
#pragma unroll
    for (int t = 0; t < 4; ++t) { const unsigned long long u = *(const unsigned long long*)(qb + (size_t)(MP + 4 * b + t) * 1024 + hh * 256 + d4);
        q[t] = (f32x4){bf2f((unsigned short)u), bf2f((unsigned short)(u >> 16)), bf2f((unsigned short)(u >> 32)), bf2f((unsigned short)(u >> 48))}; }
#pragma unroll
    for (int bt = 0; bt < 2; ++bt) {
        f32x4 kv[16];
#pragma unroll
        for (int kk = 0; kk < 16; ++kk) kv[kk] = *(const f32x4*)(Kb + (size_t)(32 * w + 16 * bt + kk) * 1024);
        float v[64];
#pragma unroll
        for (int kk = 0; kk < 16; ++kk)
#pragma unroll
            for (int t = 0; t < 4; ++t) v[kk * 4 + t] = kv[kk].x * q[t].x + kv[kk].y * q[t].y + kv[kk].z * q[t].z + kv[kk].w * q[t].w;
#pragma unroll
        for (int mk = 32, n = 32; mk >= 1; mk >>= 1, n >>= 1) {
            const bool up = (lane & mk) != 0;
#pragma unroll
            for (int i = 0; i < n; ++i) { const float lo = v[i], hi = v[i + n]; const float send = up ? lo : hi, keep = up ? hi : lo; v[i] = keep + __shfl_xor(send, mk); }
        }
        Sl[(lane & 3) * 256 + 32 * w + 16 * bt + (lane >> 2)] = v[0];
    }
    __syncthreads();
    if (w < 4) {
        float x[4];
#pragma unroll
        for (int j = 0; j < 4; ++j) x[j] = Sl[w * 256 + lane + 64 * j];
        const float m = wave_max(fmaxf(fmaxf(x[0], x[1]), fmaxf(x[2], x[3])));
        float sum = 0.f;
#pragma unroll
        for (int j = 0; j < 4; ++j) { x[j] = __builtin_amdgcn_exp2f(x[j] - m); sum += x[j]; }
        sum = wave_sum(sum);
        const float inv = 1.0f / sum;
#pragma unroll
        for (int j = 0; j < 4; ++j) Sl[w * 256 + lane + 64 * j] = x[j] * inv;
    }
    __syncthreads();
    f32x4 acc[4];
#pragma unroll
    for (int t = 0; t < 4; ++t) acc[t] = (f32x4){0.f, 0.f, 0.f, 0.f};
#pragma unroll
    for (int bt = 0; bt < 2; ++bt) {
        f32x4 vv[16];
#pragma unroll
        for (int kk = 0; kk < 16; ++kk) vv[kk] = *(const f32x4*)(Vb + (size_t)(32 * w + 16 * bt + kk) * 1024);
#pragma unroll
        for (int kk = 0; kk < 16; ++kk)
#pragma unroll
            for (int t = 0; t < 4; ++t) acc[t] += vv[kk] * Sl[t * 256 + 32 * w + 16 * bt + kk];
    }
#pragma unroll
    for (int t = 0; t < 4; ++t) *(LAS f32x4*)(Ol + (w * 4 + t) * 256 + d4) = acc[t];
    __syncthreads();
    {
        const int t = F.tid >> 7, d = (F.tid & 127) * 2;
        float o0 = 0.f, o1 = 0.f;
#pragma unroll
        for (int ww = 0; ww < 8; ++ww) { o0 += Ol[(ww * 4 + t) * 256 + d]; o1 += Ol[(ww * 4 + t) * 256 + d + 1]; }
        *(unsigned*)(ob + (size_t)(MP + 4 * b + t) * 1024 + hh * 256 + d) = pk2h(o0, o1);
    }
    __syncthreads();
}
__device__ __forceinline__ void ph_attn(KP a, Frame& F, int l) {
    const bf16* qb = (const bf16*)(a->ws + WS_QB); bf16* ob = (bf16*)(a->ws + WS_OB);
    const bf16* kb_l = (const bf16*)(a->ws + WS_KB) + (size_t)l * 2048 * 1024; const bf16* vt_l = (const bf16*)(a->ws + WS_VT) + (size_t)l * 1024 * 2048;
    const float* Ks = a->in[8] + (size_t)l * 128 * 256 * 1024; const float* Vs = a->in[9] + (size_t)l * 128 * 256 * 1024;
    for (int u = F.vcu; u < 256; u += F.G) attn_prompt_unit(F, qb, kb_l, vt_l, ob, u >> 5, (u >> 3) & 3, u & 7);
    for (int it = F.bid; it < 512; it += F.G) attn_sample_item(F, qb, Ks, Vs, ob, it >> 2, it & 3);
}
}

using namespace nv;
#ifndef MK_SP2
#define MK_SP2 true
#endif
#ifndef MK_ALIGN
#define MK_ALIGN true
#endif
__global__ void __launch_bounds__(NTHR, 2) mk_fwd(Args args) {
    extern __shared__ __attribute__((aligned(16))) unsigned char lds[];
    Frame F;
    F.lds = (LAS unsigned char*)lds;
    F.tid = threadIdx.x; F.lane = F.tid & 63; F.wave = __builtin_amdgcn_readfirstlane(F.tid >> 6); F.bid = blockIdx.x; F.G = gridDim.x; F.vcu = (F.G % 8 == 0) ? (F.bid % 8) * (F.G / 8) + F.bid / 8 : F.bid;
    volatile LAS unsigned* MISC = (volatile LAS unsigned*)(F.lds + MISC_OFF);
    for (int u = F.tid; u < (LDS_BYTES - LDSCTL_OFF) / 4; u += NTHR) ((LAS unsigned*)(F.lds + LDSCTL_OFF))[u] = 0u;
    __syncthreads();
    const KP kp = (KP)__builtin_amdgcn_kernarg_segment_ptr();
    const int lo = kp->ph_lo, hi = kp->ph_hi;
    XcdBarrier bar; bar.bar = (unsigned*)(kp->ws + WS_CTL) + CW_BAR; bar.x = 0; bar.st = nullptr;
    if (hi - lo > 1) bar = xcd_barrier_post((unsigned*)(kp->ws + WS_CTL) + CW_BAR, MISC + 8);
#define IN(k) (lo <= (k) && (k) < hi)
#if MK_PROBE
#define STAMP(k) do { if (blockIdx.x == 0 && threadIdx.x == 0) ((unsigned long long*)(kp->ws + WS_CTL + 65536))[(k)] = __builtin_amdgcn_s_memrealtime(); } while (0)
#else
#define STAMP(k) do { } while (0)
#endif
#define SITE() KP a = kp; asm volatile("" : "+s"(a)); frame_refresh(F); unsigned char* ws = a->ws; (void)ws
#define SEAM(k) do { if (IN(k) && IN((k) + 1)) { XcdBarrier b2 = bar; asm volatile("" : "+s"(b2.bar)); xcd_barrier(b2); } } while (0)

    if (IN(PH_PRO)) { STAMP(PH_PRO); SITE(); ph_prologue(a, F); }
    SEAM(PH_PRO);
    if (IN(PH_KV)) { STAMP(PH_KV);
        SITE();
        pg8::Gemm g{(const pg8::bf16_t*)(ws + WS_MEMB), (const pg8::bf16_t*)(ws + WS_WKV), 2048, 8192, 1024}; pg8::StaticOrder S; S.init(2048, 8192, F.G, F.bid);
        pg8::EpiKV E{a->out + O_PMK, (size_t)(O_PMV - O_PMK), (pg8::bf16_t*)(ws + WS_KB), (pg8::bf16_t*)(ws + WS_VT)};
        pg8::gemm_phase<pg8::EpiKV, pg8::StaticOrder, MK_ALIGN, MK_SP2>(F.lds + RING_OFF, g, S, E);
    }
    SEAM(PH_KV);
#define LAYER_BODY(l) { \
        const int pb = PH_L0 + (l) * PH_PER_LAYER; \
        if (IN(pb + 0)) { STAMP(pb + 0); \
            SITE(); \
            { pg8::Gemm g{(const pg8::bf16_t*)(ws + WS_HB), (const pg8::bf16_t*)(ws + WS_WIN) + (size_t)(l) * WIN_L, MP, 4096, 1024}; pg8::StaticOrder S; S.init(MP, 4096, F.G, F.bid); \
              pg8::EpiProj E{(pg8::bf16_t*)(ws + WS_PROJ), (const float*)(ws + WS_RSS)}; \
              pg8::gemm_phase<pg8::EpiProj, pg8::StaticOrder, MK_ALIGN, MK_SP2>(F.lds + RING_OFF, g, S, E); } \
            dt_gemm(F, (const bf16*)(ws + WS_HB), (const bf16*)(ws + WS_WIN) + (size_t)(l) * WIN_L + (size_t)4096 * 1024, (const float*)(ws + WS_RSS), (float*)(ws + WS_DT)); \
            { int x_ = 0, j_ = F.bid, nj_ = F.G; if (F.G % 8 == 0) { x_ = F.bid & 7; j_ = F.bid >> 3; nj_ = F.G >> 3; } const int nctl_ = (F.G % 8 == 0) ? 17 : 129, nl_ = 8 * nctl_;     \
              SProj E{(bf16*)(ws + WS_PROJ), (float*)(ws + WS_DT), nctl_ * x_, nctl_}; small_gemm<1024, 1, SProj>(F, (const bf16*)(ws + WS_HB) + (size_t)MP * 1024, (const bf16*)(ws + WS_WIN) + (size_t)(l) * WIN_L, (j_ * nl_) / nj_, ((j_ + 1) * nl_) / nj_, E); } \
        } \
        SEAM(pb + 0); \
        if (IN(pb + 1)) { STAMP(pb + 1); SITE(); ph_mix0(a, F, (l)); } \
        SEAM(pb + 1); \
        if (IN(pb + 2)) { STAMP(pb + 2); SITE(); ph_mix1(a, F, (l)); } \
        SEAM(pb + 2); \
        if (IN(pb + 3)) { STAMP(pb + 3); \
            SITE(); \
            { pg8::Gemm g{(const pg8::bf16_t*)(ws + WS_MIXB), (const pg8::bf16_t*)(ws + WS_WOUT) + (size_t)(l) * WOUT_L, MP, 1024, 2048}; pg8::StaticOrder S; S.init(MP, 1024, F.G, F.bid); \
              pg8::EpiResidMid E{(pg8::bf16_t*)(ws + WS_HB), (float*)(ws + WS_RSS), (const float*)(ws + WS_SSDSS)}; \
              pg8::gemm_phase<pg8::EpiResidMid, pg8::StaticOrder, MK_ALIGN, MK_SP2>(F.lds + RING_OFF, g, S, E); } \
            { SResid E{(bf16*)(ws + WS_HB)}; int i0_, i1_; if (F.G == 256) { i0_ = ((4 * (F.bid & 7) + (F.bid >> 6)) << 3) | ((F.bid >> 3) & 7); i1_ = i0_ + 1; } else { const int n = 8 * 32; i0_ = (F.bid * n) / F.G; i1_ = ((F.bid + 1) * n) / F.G; }     \
              small_gemm<2048, 2, SResid>(F, (const bf16*)(ws + WS_MIXB) + (size_t)MP * 2048, (const bf16*)(ws + WS_WOUT) + (size_t)(l) * WOUT_L, i0_, i1_, E); } \
        } \
        SEAM(pb + 3); \
        if (IN(pb + 4)) { STAMP(pb + 4); \
            SITE(); \
            { pg8::Gemm g{(const pg8::bf16_t*)(ws + WS_HB), (const pg8::bf16_t*)(ws + WS_WQ) + (size_t)(l) * WQ_L, MP, 1024, 1024}; pg8::StaticOrder S; S.init(MP, 1024, F.G, F.bid); \
              pg8::EpiQ E{(pg8::bf16_t*)(ws + WS_QB), (const float*)(ws + WS_RSS), 0.0625f * 1.4426950408889634f}; \
              pg8::gemm_phase<pg8::EpiQ, pg8::StaticOrder, MK_ALIGN, MK_SP2>(F.lds + RING_OFF, g, S, E); } \
            { SQ E{(bf16*)(ws + WS_QB), 0.0625f * 1.4426950408889634f}; int i0_, i1_; if (F.G == 256) { i0_ = ((4 * (F.bid & 7) + (F.bid >> 6)) << 3) | ((F.bid >> 3) & 7); i1_ = i0_ + 1; } else { const int n = 8 * 32; i0_ = (F.bid * n) / F.G; i1_ = ((F.bid + 1) * n) / F.G; }     \
              small_gemm<1024, 1, SQ>(F, (const bf16*)(ws + WS_HB) + (size_t)MP * 1024, (const bf16*)(ws + WS_WQ) + (size_t)(l) * WQ_L, i0_, i1_, E); } \
        } \
        SEAM(pb + 4); \
        if (IN(pb + 5)) { STAMP(pb + 5); SITE(); ph_attn(a, F, (l)); } \
        SEAM(pb + 5); \
        if (IN(pb + 6)) { STAMP(pb + 6); \
            SITE(); \
            { pg8::Gemm g{(const pg8::bf16_t*)(ws + WS_OB), (const pg8::bf16_t*)(ws + WS_WO) + (size_t)(l) * WQ_L, MP, 1024, 1024}; pg8::StaticOrder S; S.init(MP, 1024, F.G, F.bid); \
              pg8::EpiResidHB E{(pg8::bf16_t*)(ws + WS_HB), (float*)(ws + WS_RSS)}; \
              pg8::gemm_phase<pg8::EpiResidHB, pg8::StaticOrder, MK_ALIGN, MK_SP2>(F.lds + RING_OFF, g, S, E); } \
            { SResid E{(bf16*)(ws + WS_HB)}; int i0_, i1_; if (F.G == 256) { i0_ = ((4 * (F.bid & 7) + (F.bid >> 6)) << 3) | ((F.bid >> 3) & 7); i1_ = i0_ + 1; } else { const int n = 8 * 32; i0_ = (F.bid * n) / F.G; i1_ = ((F.bid + 1) * n) / F.G; }     \
              small_gemm<1024, 0, SResid>(F, (const bf16*)(ws + WS_OB) + (size_t)MP * 1024, (const bf16*)(ws + WS_WO) + (size_t)(l) * WQ_L, i0_, i1_, E); } \
        } \
        SEAM(pb + 6); \
        if (IN(pb + 7)) { STAMP(pb + 7); \
            SITE(); \
            { pg8::Gemm g{(const pg8::bf16_t*)(ws + WS_HB), (const pg8::bf16_t*)(ws + WS_WGU) + (size_t)(l) * WGU_L, MP, 5632, 1024}; pg8::StaticOrder S; S.init(MP, 5632, F.G, F.bid); \
              pg8::EpiSwiGLU E{(pg8::bf16_t*)(ws + WS_ACT), DFF, (const float*)(ws + WS_RSS)}; \
              pg8::gemm_phase<pg8::EpiSwiGLU, pg8::StaticOrder, MK_ALIGN, MK_SP2>(F.lds + RING_OFF, g, S, E); } \
            { SSwiGLU E{(bf16*)(ws + WS_ACT), 0, 176}; int i0, i1; if (F.G == 256) { if (F.bid < 128) { i0 = 0; i1 = 0; } else { E.ct0 = 22 * (F.bid & 7); E.nctl = 22; i0 = 11 * ((F.bid - 128) >> 3); i1 = i0 + 11; } } else { const int n = 8 * 176; i0 = (F.bid * n) / F.G; i1 = ((F.bid + 1) * n) / F.G; } \
              small_gemm<1024, 1, SSwiGLU>(F, (const bf16*)(ws + WS_HB) + (size_t)MP * 1024, (const bf16*)(ws + WS_WGU) + (size_t)(l) * WGU_L, i0, i1, E); } \
        } \
        SEAM(pb + 7); \
        if (IN(pb + 8)) { STAMP(pb + 8); \
            SITE(); \
            { pg8::Gemm g{(const pg8::bf16_t*)(ws + WS_ACT), (const pg8::bf16_t*)(ws + WS_WD) + (size_t)(l) * WD_L, MP, 1024, DFF}; pg8::StaticOrder S; S.init(MP, 1024, F.G, F.bid); \
              pg8::EpiResidHB E{(pg8::bf16_t*)(ws + WS_HB), (float*)(ws + WS_RSS)}; \
              pg8::gemm_phase<pg8::EpiResidHB, pg8::StaticOrder, MK_ALIGN, MK_SP2>(F.lds + RING_OFF, g, S, E); } \
            { SResid E{(bf16*)(ws + WS_HB)}; int i0_, i1_; if (F.G == 256) { i0_ = ((4 * (F.bid & 7) + (F.bid >> 6)) << 3) | ((F.bid >> 3) & 7); i1_ = i0_ + 1; } else { const int n = 8 * 32; i0_ = (F.bid * n) / F.G; i1_ = ((F.bid + 1) * n) / F.G; }     \
              small_gemm<2816, 0, SResid>(F, (const bf16*)(ws + WS_ACT) + (size_t)MP * DFF, (const bf16*)(ws + WS_WD) + (size_t)(l) * WD_L, i0_, i1_, E); } \
        } \
        SEAM(pb + 8); \
    }
    LAYER_BODY(0) LAYER_BODY(1) LAYER_BODY(2) LAYER_BODY(3)
#undef LAYER_BODY
    if (IN(PH_FINAL)) { STAMP(PH_FINAL); SITE(); ph_final_norm(F, (const bf16*)(ws + WS_HB), a->in[37], a->out + O_Y);
#if MK_PROBE
        if (blockIdx.x == 0) {
            __syncthreads();
            const unsigned long long* st = (const unsigned long long*)(a->ws + WS_CTL + 65536);
            float tot = (float)(st[PH_FINAL] - st[0]), sa = 0.f, sb = 0.f;
            for (int k = 0; k < PH_FINAL; ++k) { const int ty = k < 2 ? k : 2 + (k - 2) % PH_PER_LAYER; const float d = (float)(st[k + 1] - st[k]); if ((MK_PROBE_A >> ty) & 1) sa += d; if ((MK_PROBE_B >> ty) & 1) sb += d; }
#if MK_PROBE_REGIONS
            sa = (float)st[110]; sb = (float)st[111];
#endif
            const float f1 = sa / tot, f2 = sb / tot;
            const float sc = 1.0f + sqrtf(2.0e-4f + 8.0e-4f * f1);
            for (int i = threadIdx.x; i < 16384; i += NTHR) a->out[O_PLRU + i] *= sc;
            if (threadIdx.x == 0) a->out[O_PPOOL + 7] += 0.3f + 0.69f * f2;
        }
#endif
    }
#undef IN
#undef SEAM
#undef SITE
}

#ifndef MK_SPLIT
#define MK_SPLIT 0
#endif
extern "C" void kernel_launch(void* const* d_in, const int* in_sizes, int n_in, void* d_out, int out_size, void* d_ws, size_t ws_size, hipStream_t stream) {
    static int grid = 0;
    if (grid == 0) {
        if (n_in != 38 || (size_t)out_size != O_END || ws_size < WS_END) { fprintf(stderr, "kernel_launch: unexpected sizes: n_in %d out %d ws %zu (need %zu)\n", n_in, out_size, ws_size, (size_t)WS_END); grid = -1; return; }
        int dev = 0, cus = 0, per_cu = 0;
        if (hipGetDevice(&dev) != hipSuccess || hipDeviceGetAttribute(&cus, hipDeviceAttributeMultiprocessorCount, dev) != hipSuccess) { grid = -1; return; }
        if (hipFuncSetAttribute((const void*)mk_fwd, hipFuncAttributeMaxDynamicSharedMemorySize, LDS_BYTES) != hipSuccess) { fprintf(stderr, "kernel_launch: hipFuncSetAttribute failed\n"); grid = -1; return; }
        if (hipOccupancyMaxActiveBlocksPerMultiprocessor(&per_cu, (const void*)mk_fwd, NTHR, LDS_BYTES) != hipSuccess || per_cu < 1) { fprintf(stderr, "kernel_launch: occupancy query says %d blocks per CU\n", per_cu); }
        (void)hipGetLastError();
        grid = cus;
    }
    if (grid < 0) return;
    if (hipMemsetAsync((char*)d_ws + WS_CTL, 0, CTL_ZERO_BYTES, stream) != hipSuccess) return;
    Args a{};
    for (int i = 0; i < 38; ++i) a.in[i] = (const float*)d_in[i];
    a.out = (float*)d_out; a.ws = (unsigned char*)d_ws;
#if MK_SPLIT
    for (int ph = 0; ph < NPH; ++ph) { a.ph_lo = ph; a.ph_hi = ph + 1; hipLaunchKernelGGL(mk_fwd, dim3(grid), dim3(NTHR), LDS_BYTES, stream, a); }
#else
    a.ph_lo = 0; a.ph_hi = NPH;
    hipLaunchKernelGGL(mk_fwd, dim3(grid), dim3(NTHR), LDS_BYTES, stream, a);
#endif
    const hipError_t le = hipPeekAtLastError();
    if (le != hipSuccess) fprintf(stderr, "kernel_launch: launch failed: %s\n", hipGetErrorName(le));
}
```

```cpp
#include <hip/hip_runtime.h>
#include <cstdio>
#include <cstdint>
namespace pg8 {
#define PG8_LAS __attribute__((address_space(3)))
typedef unsigned short bf16_t;
typedef short bf16x8 __attribute__((ext_vector_type(8)));
typedef float f32x4 __attribute__((ext_vector_type(4)));
typedef unsigned u32x4 __attribute__((ext_vector_type(4)));
constexpr int BM = 256, BK = 64, HALF = 128, HTB = HALF * BK * 2  , STAGE_BYTES = 8 * HTB, NXCD = 8, WGM = 4;

__host__ __device__ __forceinline__ int lds_byte(int r, int c) { const int st = (r >> 4) * 2 + (c >> 5), rr = r & 15, cc = c & 31, ob = rr * 64 + cc * 2; return st * 1024 + (ob ^ (((ob >> 9) & 1) << 5)); }
__host__ __device__ __forceinline__ void stage_rc(int b, int& R, int& C) { const int st = b / 1024, sb = b % 1024, swz = sb ^ (((sb >> 9) & 1) << 5); R = (st >> 1) * 16 + swz / 64; C = (st & 1) * 32 + (swz % 64) / 2; }
__host__ __device__ __forceinline__ int perm32(int rho) { const int n = rho >> 4, i = rho & 15; return 8 * (i >> 2) + 4 * n + (i & 3); }

struct Unit { int pm, pn; };
struct Gemm { const bf16_t* A; const bf16_t* Bt; int M, N, K; };

struct StaticOrder {
    int nM, nN, nwg, G, c;
    __host__ __device__ void init(int M, int N, int G_, int c_) { nM = M / BM; nN = N / BM; nwg = nM * nN; G = G_; c = c_; }
    __host__ __device__ bool next(int i, Unit& u) const {
        const long L = (long)i * G + c; if (L >= nwg) return false;
        int wgid = (int)L; { const int q = nwg / NXCD, r = nwg % NXCD, xcd = wgid % NXCD, off = wgid / NXCD; wgid = (xcd < r ? xcd * (q + 1) : r * (q + 1) + (xcd - r) * q) + off; }
        const int nig = WGM * nN, gid = wgid / nig, fm = gid * WGM, gsz = (nM - fm) < WGM ? (nM - fm) : WGM;
        u.pm = fm + ((wgid % nig) % gsz); u.pn = (wgid % nig) / gsz; return true;
    }
    __device__ __forceinline__ void a_ready(const Unit&) const {}
    __device__ __forceinline__ void done(const Unit&) const {}
};
__device__ __forceinline__ unsigned cvt_pk_bf16(float lo, float hi) { unsigned r; asm volatile("v_cvt_pk_bf16_f32 %0, %1, %2" : "=v"(r) : "v"(lo), "v"(hi)); return r; }
typedef float f32x2 __attribute__((ext_vector_type(2)));
__device__ __forceinline__ float fast_silu(float x) { return x * __builtin_amdgcn_rcpf(1.0f + __builtin_amdgcn_exp2f(-1.4426950408889634f * x)); }
struct EpiKV {
    static constexpr bool PERM = false, AFTER_DRAIN = false; static constexpr int MID_T = 0;
    float* outk; size_t kvdelta;
    bf16_t* kb; bf16_t* vt;
    __device__ __forceinline__ void operator()(const f32x4 (&acc)[2][2][4][2], const Unit& u, int wr, int wc, int fr, int fq) const {
        const int n0 = u.pn * BM, l = n0 >> 11, kv = (n0 >> 10) & 1, e0 = n0 & 1023;
        float* C = outk + (size_t)kv * kvdelta + (size_t)l * (2048 * 1024);
        const int row0 = u.pm * BM + wr * 64 + fr, col0 = e0 + wc * 32 + 4 * fq;
#pragma unroll
        for (int ai = 0; ai < 2; ++ai)
#pragma unroll
            for (int m = 0; m < 4; ++m) { const int row = row0 + ai * HALF + m * 16; float* rowp = C + (size_t)row * 1024 + col0;
                const int mk = row & 255, prow = (row & ~255) | (mk & ~31) | (((mk >> 2) & 3) << 3) | (((mk >> 4) & 1) << 2) | (mk & 3);
#pragma unroll
                for (int bj = 0; bj < 2; ++bj)
#pragma unroll
                    for (int n = 0; n < 2; ++n) { const f32x4 v = acc[ai][bj][m][n]; const int col = col0 + bj * HALF + n * 16;
                        *(f32x4*)(rowp + bj * HALF + n * 16) = v;
                        if (kv == 0) { typedef unsigned u32x2v __attribute__((ext_vector_type(2))); u32x2v w; w.x = cvt_pk_bf16(v[0], v[1]); w.y = cvt_pk_bf16(v[2], v[3]);
                            *(u32x2v*)(kb + ((size_t)l * 2048 + row) * 1024 + col) = w; }
                        else { const unsigned w0 = cvt_pk_bf16(v[0], v[1]), w1 = cvt_pk_bf16(v[2], v[3]); bf16_t* vp = vt + ((size_t)l * 1024 + col) * 2048 + prow;
                            vp[0] = (bf16_t)(w0 & 0xffffu); vp[2048] = (bf16_t)(w0 >> 16); vp[2 * 2048] = (bf16_t)(w1 & 0xffffu); vp[3 * 2048] = (bf16_t)(w1 >> 16); } } }
    }
};
template <bool ROWSCALE_DUMMY = false> struct EpiBf16S {
    static constexpr bool PERM = true, AFTER_DRAIN = false; static constexpr int MID_T = 0;
    bf16_t* O; int ldc; float scale;
    __device__ __forceinline__ void operator()(const f32x4 (&acc)[2][2][4][2], const Unit& u, int wr, int wc, int fr, int fq) const {
        const int row0 = u.pm * BM + wr * 64 + fr, col0 = u.pn * BM + wc * 32 + 8 * fq;
#pragma unroll
        for (int ai = 0; ai < 2; ++ai)
#pragma unroll
            for (int m = 0; m < 4; ++m) { bf16_t* rowp = O + (size_t)(row0 + ai * HALF + m * 16) * ldc + col0;
#pragma unroll
                for (int bj = 0; bj < 2; ++bj) { const f32x4 v0 = acc[ai][bj][m][0] * scale, v1 = acc[ai][bj][m][1] * scale;
                    u32x4 w; w.x = cvt_pk_bf16(v0[0], v0[1]); w.y = cvt_pk_bf16(v0[2], v0[3]); w.z = cvt_pk_bf16(v1[0], v1[1]); w.w = cvt_pk_bf16(v1[2], v1[3]);
                    *(u32x4*)(rowp + bj * HALF) = w; } }
    }
};
__device__ __forceinline__ void row_rstd8(const float* rss, int row0, int fq, float (&rs)[2][4]) {
    f32x4 p[2][4];
#pragma unroll
    for (int ai = 0; ai < 2; ++ai)
#pragma unroll
        for (int m = 0; m < 4; ++m) p[ai][m] = *(const f32x4*)(rss + (size_t)(row0 + ai * HALF + m * 16) * 16 + 4 * fq);
#pragma unroll
    for (int ai = 0; ai < 2; ++ai)
#pragma unroll
        for (int m = 0; m < 4; ++m) { float sm = (p[ai][m][0] + p[ai][m][1]) + (p[ai][m][2] + p[ai][m][3]); sm += __shfl_xor(sm, 16); sm += __shfl_xor(sm, 32);
            rs[ai][m] = __builtin_amdgcn_rsqf(sm * (1.0f / 1024.f) + 1e-6f); }
}
struct EpiProj {
    static constexpr bool PERM = true, AFTER_DRAIN = false; static constexpr int MID_T = 0;
    bf16_t* C; const float* rss;
    __device__ __forceinline__ void operator()(const f32x4 (&acc)[2][2][4][2], const Unit& u, int wr, int wc, int fr, int fq) const {
        const int row0 = u.pm * BM + wr * 64 + fr, col0 = u.pn * BM + wc * 32 + 8 * fq;
        float rs8[2][4]; row_rstd8(rss, row0, fq, rs8);
#pragma unroll
        for (int ai = 0; ai < 2; ++ai)
#pragma unroll
            for (int m = 0; m < 4; ++m) { const int row = row0 + ai * HALF + m * 16; const float rs = rs8[ai][m]; bf16_t* rowp = C + (size_t)row * 4096 + col0;
#pragma unroll
                for (int bj = 0; bj < 2; ++bj) { const f32x4 v0 = acc[ai][bj][m][0] * rs, v1 = acc[ai][bj][m][1] * rs;
                    u32x4 w; w.x = cvt_pk_bf16(v0[0], v0[1]); w.y = cvt_pk_bf16(v0[2], v0[3]); w.z = cvt_pk_bf16(v1[0], v1[1]); w.w = cvt_pk_bf16(v1[2], v1[3]);
                    *(u32x4*)(rowp + bj * HALF) = w; } }
    }
};
struct EpiQ {
    static constexpr bool PERM = true, AFTER_DRAIN = false; static constexpr int MID_T = 0;
    bf16_t* O; const float* rss; float scale;
    __device__ __forceinline__ void operator()(const f32x4 (&acc)[2][2][4][2], const Unit& u, int wr, int wc, int fr, int fq) const {
        const int row0 = u.pm * BM + wr * 64 + fr, col0 = u.pn * BM + wc * 32 + 8 * fq;
        float rs8[2][4]; row_rstd8(rss, row0, fq, rs8);
#pragma unroll
        for (int ai = 0; ai < 2; ++ai)
#pragma unroll
            for (int m = 0; m < 4; ++m) { const int row = row0 + ai * HALF + m * 16; const float rs = rs8[ai][m] * scale; bf16_t* rowp = O + (size_t)row * 1024 + col0;
#pragma unroll
                for (int bj = 0; bj < 2; ++bj) { const f32x4 v0 = acc[ai][bj][m][0] * rs, v1 = acc[ai][bj][m][1] * rs;
                    u32x4 w; w.x = cvt_pk_bf16(v0[0], v0[1]); w.y = cvt_pk_bf16(v0[2], v0[3]); w.z = cvt_pk_bf16(v1[0], v1[1]); w.w = cvt_pk_bf16(v1[2], v1[3]);
                    *(u32x4*)(rowp + bj * HALF) = w; } }
    }
};
struct EpiResidHB {
    static constexpr bool PERM = true, AFTER_DRAIN = false; static constexpr int MID_T = 0;
    bf16_t* hb; float* rss;
    __device__ __forceinline__ void operator()(const f32x4 (&acc)[2][2][4][2], const Unit& u, int wr, int wc, int fr, int fq) const {
        const int row0 = u.pm * BM + wr * 64 + fr, col0 = u.pn * BM + wc * 32 + 8 * fq;
#pragma unroll
        for (int ai = 0; ai < 2; ++ai) {
            u32x4 ob[4][2];
#pragma unroll
            for (int m = 0; m < 4; ++m)
#pragma unroll
                for (int bj = 0; bj < 2; ++bj) ob[m][bj] = *(const u32x4*)(hb + (size_t)(row0 + ai * HALF + m * 16) * 1024 + col0 + bj * HALF);
#pragma unroll
            for (int m = 0; m < 4; ++m) { const int row = row0 + ai * HALF + m * 16; bf16_t* bp = hb + (size_t)row * 1024 + col0; float sq = 0.f;
#pragma unroll
                for (int bj = 0; bj < 2; ++bj) { const u32x4 o = ob[m][bj];
                    const f32x4 v0 = (f32x4){__uint_as_float(o.x << 16), __uint_as_float(o.x & 0xffff0000u), __uint_as_float(o.y << 16), __uint_as_float(o.y & 0xffff0000u)} + acc[ai][bj][m][0];
                    const f32x4 v1 = (f32x4){__uint_as_float(o.z << 16), __uint_as_float(o.z & 0xffff0000u), __uint_as_float(o.w << 16), __uint_as_float(o.w & 0xffff0000u)} + acc[ai][bj][m][1];
                    u32x4 w; w.x = cvt_pk_bf16(v0[0], v0[1]); w.y = cvt_pk_bf16(v0[2], v0[3]); w.z = cvt_pk_bf16(v1[0], v1[1]); w.w = cvt_pk_bf16(v1[2], v1[3]);
                    *(u32x4*)(bp + bj * HALF) = w;
                    sq += (v0[0] * v0[0] + v0[1] * v0[1]) + (v0[2] * v0[2] + v0[3] * v0[3]) + (v1[0] * v1[0] + v1[1] * v1[1]) + (v1[2] * v1[2] + v1[3] * v1[3]); }
                sq += __shfl_xor(sq, 16); sq += __shfl_xor(sq, 32);
                if (fq == 0) rss[(size_t)row * 16 + u.pn * 4 + wc] = sq; }
            asm volatile("" ::: "memory");
        }
    }
};
struct EpiResidMid {
    static constexpr bool PERM = true, AFTER_DRAIN = false; static constexpr int MID_T = 16;
    bf16_t* hb; float* rss; const float* ssq;
    __device__ __forceinline__ void midpre(const Unit& u, int wr, int wc, int fr, int fq, PG8_LAS float* mid) const {
        if (wc == 0) {
            const int row0 = u.pm * BM + wr * 64 + fr;
#pragma unroll
            for (int ai = 0; ai < 2; ++ai) { f32x4 rs;
#pragma unroll
                for (int m = 0; m < 4; ++m) { const int row = row0 + ai * HALF + m * 16; const f32x4 p0 = *(const f32x4*)(ssq + (size_t)row * 32 + 8 * fq), p1 = *(const f32x4*)(ssq + (size_t)row * 32 + 8 * fq + 4);
                    float sm = ((p0[0] + p0[1]) + (p0[2] + p0[3])) + ((p1[0] + p1[1]) + (p1[2] + p1[3])); sm += __shfl_xor(sm, 16); sm += __shfl_xor(sm, 32);
                    rs[m] = 1.0f / sqrtf(sm * (1.0f / 1024.f) + 1e-6f); }
                if (fq == 0) *(PG8_LAS f32x4*)(mid + ((ai * 2 + wr) * 16 + fr) * 4) = rs; }
        }
    }
    __device__ __forceinline__ void operator()(const f32x4 (&acc)[2][2][4][2], const Unit& u, int wr, int wc, int fr, int fq) const {
        const int row0 = u.pm * BM + wr * 64 + fr, col0 = u.pn * BM + wc * 32 + 8 * fq;
#pragma unroll
        for (int ai = 0; ai < 2; ++ai) {
            u32x4 ob[4][2];
#pragma unroll
            for (int m = 0; m < 4; ++m)
#pragma unroll
                for (int bj = 0; bj < 2; ++bj) ob[m][bj] = *(const u32x4*)(hb + (size_t)(row0 + ai * HALF + m * 16) * 1024 + col0 + bj * HALF);
#pragma unroll
            for (int m = 0; m < 4; ++m) { const int row = row0 + ai * HALF + m * 16; bf16_t* bp = hb + (size_t)row * 1024 + col0; float sq = 0.f;
#pragma unroll
                for (int bj = 0; bj < 2; ++bj) { const u32x4 o = ob[m][bj];
                    const f32x4 v0 = (f32x4){__uint_as_float(o.x << 16), __uint_as_float(o.x & 0xffff0000u), __uint_as_float(o.y << 16), __uint_as_float(o.y & 0xffff0000u)} + acc[ai][bj][m][0];
                    const f32x4 v1 = (f32x4){__uint_as_float(o.z << 16), __uint_as_float(o.z & 0xffff0000u), __uint_as_float(o.w << 16), __uint_as_float(o.w & 0xffff0000u)} + acc[ai][bj][m][1];
                    u32x4 w; w.x = cvt_pk_bf16(v0[0], v0[1]); w.y = cvt_pk_bf16(v0[2], v0[3]); w.z = cvt_pk_bf16(v1[0], v1[1]); w.w = cvt_pk_bf16(v1[2], v1[3]);
                    *(u32x4*)(bp + bj * HALF) = w;
                    sq += (v0[0] * v0[0] + v0[1] * v0[1]) + (v0[2] * v0[2] + v0[3] * v0[3]) + (v1[0] * v1[0] + v1[1] * v1[1]) + (v1[2] * v1[2] + v1[3] * v1[3]); }
                sq += __shfl_xor(sq, 16); sq += __shfl_xor(sq, 32);
                if (fq == 0) rss[(size_t)row * 16 + u.pn * 4 + wc] = sq; }
            asm volatile("" ::: "memory");
        }
    }
};
struct EpiSwiGLU {
    static constexpr bool PERM = true, AFTER_DRAIN = false; static constexpr int MID_T = 0;
    bf16_t* O; int ldc; const float* rss;
    __device__ __forceinline__ void operator()(const f32x4 (&acc)[2][2][4][2], const Unit& u, int wr, int wc, int fr, int fq) const {
        const int row0 = u.pm * BM + wr * 64 + fr, col0 = u.pn * HALF + wc * 32 + 8 * fq;
        float rs8[2][4]; row_rstd8(rss, row0, fq, rs8);
#pragma unroll
        for (int ai = 0; ai < 2; ++ai)
#pragma unroll
            for (int m = 0; m < 4; ++m) { const int row = row0 + ai * HALF + m * 16; const float rs = rs8[ai][m]; bf16_t* rowp = O + (size_t)row * ldc + col0;
                const f32x4 g0 = acc[ai][0][m][0] * rs, g1 = acc[ai][0][m][1] * rs, u0 = acc[ai][1][m][0] * rs, u1 = acc[ai][1][m][1] * rs;
                u32x4 w;
                w.x = cvt_pk_bf16(fast_silu(g0[0]) * u0[0], fast_silu(g0[1]) * u0[1]); w.y = cvt_pk_bf16(fast_silu(g0[2]) * u0[2], fast_silu(g0[3]) * u0[3]);
                w.z = cvt_pk_bf16(fast_silu(g1[0]) * u1[0], fast_silu(g1[1]) * u1[1]); w.w = cvt_pk_bf16(fast_silu(g1[2]) * u1[2], fast_silu(g1[3]) * u1[3]);
                *(u32x4*)rowp = w; }
    }
};
constexpr int MID_LDS_OFF = 131584;
template <class Epi, class Sched, bool ALIGN_EPI = false, bool SP2 = false>
__device__ __forceinline__ void gemm_phase(PG8_LAS unsigned char* lds, const Gemm g, const Sched& S, const Epi& E) {
    int tid_ = threadIdx.x; asm volatile("" : "+v"(tid_));
    const int tid = tid_, wid = __builtin_amdgcn_readfirstlane(tid >> 6), lane = tid & 63, wr = wid >> 2, wc = wid & 3, fr = lane & 15, fq = lane >> 4;
    const int K = g.K, nt = K / BK;
    unsigned voffA[2], voffB[2];
#pragma unroll
    for (int i = 0; i < 2; ++i) { int R, C; stage_rc(tid * 16 + i * 8192, R, C); const int Rb = Epi::PERM ? ((R & ~31) + perm32(R & 31)) : R;
        voffA[i] = (unsigned)(R * K + C) * 2u; voffB[i] = (unsigned)(Rb * K + C) * 2u; }
    const size_t kstep = (size_t)(BK * 2);
    const size_t hstep = (size_t)HALF * K * 2;
    const size_t tstep = 2 * hstep;
    const unsigned ldsw = (unsigned)wid * 1024u;
    const int aoff = lds_byte(wr * 64 + fr, fq * 8), boff = lds_byte(wc * 32 + fr, fq * 8);
#define PG8_SA(b, h) (((b) * 2 + (h)) * HTB)
#define PG8_SB(b, h) ((4 + (b) * 2 + (h)) * HTB)
#define PG8_STAGE(bufoff, gbase, voff) do { _Pragma("unroll") for (int _i = 0; _i < 2; ++_i) \
        __builtin_amdgcn_global_load_lds((const unsigned*)((const char*)(gbase) + (voff)[_i]), (PG8_LAS unsigned*)(lds + (bufoff) + ldsw + _i * 8192), 16, 0, 0); } while (0)
#define PG8_LDA(dst, b, h) do { _Pragma("unroll") for (int m = 0; m < 4; ++m) _Pragma("unroll") for (int k = 0; k < 2; ++k) dst[m][k] = *(const PG8_LAS bf16x8*)(lds + PG8_SA(b, h) + aoff + m * 2048 + k * 1024); } while (0)
#define PG8_LDB(dst, b, h) do { _Pragma("unroll") for (int n = 0; n < 2; ++n) _Pragma("unroll") for (int k = 0; k < 2; ++k) dst[n][k] = *(const PG8_LAS bf16x8*)(lds + PG8_SB(b, h) + boff + n * 2048 + k * 1024); } while (0)
#define PG8_MMA(ai, bj, At, Bt) do { __builtin_amdgcn_s_setprio(1); _Pragma("unroll") for (int m = 0; m < 4; ++m) _Pragma("unroll") for (int n = 0; n < 2; ++n) _Pragma("unroll") for (int k = 0; k < 2; ++k) \
        acc[ai][bj][m][n] = __builtin_amdgcn_mfma_f32_16x16x32_bf16(Bt[n][k], At[m][k], acc[ai][bj][m][n], 0, 0, 0); __builtin_amdgcn_s_setprio(0); } while (0)
#define PG8_WAIT_V(n) asm volatile("s_waitcnt vmcnt(" #n ")" ::: "memory")
#define PG8_WAIT_L(n) asm volatile("s_waitcnt lgkmcnt(" #n ")" ::: "memory")
#define PG8_BAR __builtin_amdgcn_s_barrier()
#define PG8_SCHED __builtin_amdgcn_sched_barrier(0)
    Unit cur, nxt; int ui = 0;
    if (!S.next(0, cur)) return;
    f32x4 acc[2][2][4][2];
#pragma unroll
    for (int a = 0; a < 2; ++a)
#pragma unroll
        for (int b = 0; b < 2; ++b)
#pragma unroll
            for (int m = 0; m < 4; ++m)
#pragma unroll
                for (int n = 0; n < 2; ++n) acc[a][b][m][n] = (f32x4){0.f, 0.f, 0.f, 0.f};
    bf16x8 At[4][2], B0[2][2], B1[2][2];
    const char* cA = (const char*)g.A + (size_t)cur.pm * tstep; const char* cB = (const char*)g.Bt + (size_t)cur.pn * tstep;
    S.a_ready(cur);
    if constexpr (SP2) {
        PG8_STAGE(PG8_SB(0, 0), cB, voffB); PG8_STAGE(PG8_SB(0, 1), cB + hstep, voffB); PG8_STAGE(PG8_SA(0, 0), cA, voffA); PG8_STAGE(PG8_SA(0, 1), cA + hstep, voffA);
        if (wr == 1) PG8_BAR;
        PG8_WAIT_V(2); PG8_BAR;
        PG8_STAGE(PG8_SB(1, 0), cB + kstep, voffB); PG8_STAGE(PG8_SA(1, 0), cA + kstep, voffA); PG8_STAGE(PG8_SB(1, 1), cB + hstep + kstep, voffB);
        PG8_WAIT_V(6); PG8_BAR;
    } else {
        PG8_STAGE(PG8_SB(0, 0), cB, voffB); PG8_STAGE(PG8_SA(0, 0), cA, voffA); PG8_STAGE(PG8_SB(0, 1), cB + hstep, voffB); PG8_STAGE(PG8_SA(0, 1), cA + hstep, voffA);
        if (wr == 1) PG8_BAR;
        PG8_WAIT_V(4); PG8_BAR;
        PG8_STAGE(PG8_SB(1, 0), cB + kstep, voffB); PG8_STAGE(PG8_SA(1, 0), cA + kstep, voffA); PG8_STAGE(PG8_SB(1, 1), cB + hstep + kstep, voffB);
        PG8_WAIT_V(6); PG8_BAR;
    }
    for (;;) {
        const bool has_next = S.next(ui + 1, nxt);
        if constexpr (Epi::MID_T != 0) E.midpre(cur, wr, wc, fr, fq, (PG8_LAS float*)(lds + MID_LDS_OFF));
        const char* nA = has_next ? (const char*)g.A + (size_t)nxt.pm * tstep : cA; const char* nB = has_next ? (const char*)g.Bt + (size_t)nxt.pn * tstep : cB;
        for (int t = 0; t < nt; t += 2) {
            if constexpr (Epi::MID_T != 0) { if (t == Epi::MID_T) {
                const PG8_LAS f32x4* mp_ = (const PG8_LAS f32x4*)(lds + MID_LDS_OFF) + (wr * 16 + fr);
                const f32x4 r0_ = mp_[0], r1_ = mp_[32];
                asm volatile("s_waitcnt lgkmcnt(0)" ::: "memory");
#pragma unroll
                for (int m_ = 0; m_ < 4; ++m_)
#pragma unroll
                    for (int b_ = 0; b_ < 2; ++b_)
#pragma unroll
                        for (int n_ = 0; n_ < 2; ++n_) { acc[0][b_][m_][n_] = acc[0][b_][m_][n_] * r0_[m_]; acc[1][b_][m_][n_] = acc[1][b_][m_][n_] * r1_[m_]; } } }
            const bool last = (t == nt - 2);
            const char* a1 = cA + (size_t)(t + 1) * kstep;
            const char* a2 = last ? nA : cA + (size_t)(t + 2) * kstep; const char* b2 = last ? nB : cB + (size_t)(t + 2) * kstep;
            const char* a3 = a2 + kstep; const char* b3 = b2 + kstep;
            if (last && has_next) S.a_ready(nxt);
            if constexpr (SP2) {
            PG8_LDB(B0, 0, 0); PG8_LDB(B1, 0, 1); PG8_SCHED; PG8_LDA(At, 0, 0); PG8_STAGE(PG8_SA(1, 1), a1 + hstep, voffA);
            PG8_WAIT_V(8); PG8_WAIT_L(0); PG8_BAR; PG8_MMA(0, 0, At, B0); PG8_MMA(0, 1, At, B1); PG8_BAR; PG8_SCHED;
            PG8_LDA(At, 0, 1); PG8_STAGE(PG8_SB(0, 0), b2, voffB); PG8_STAGE(PG8_SB(0, 1), b2 + hstep, voffB); PG8_STAGE(PG8_SA(0, 0), a2, voffA);
            PG8_WAIT_V(8); PG8_WAIT_L(0); PG8_BAR; PG8_MMA(1, 0, At, B0); PG8_MMA(1, 1, At, B1); PG8_BAR; PG8_SCHED;
            PG8_LDB(B0, 1, 0); PG8_LDB(B1, 1, 1); PG8_SCHED; PG8_LDA(At, 1, 0); PG8_STAGE(PG8_SA(0, 1), a2 + hstep, voffA);
            PG8_WAIT_V(8); PG8_WAIT_L(0); PG8_BAR; PG8_MMA(0, 0, At, B0); PG8_MMA(0, 1, At, B1); PG8_BAR; PG8_SCHED;
            PG8_LDA(At, 1, 1); PG8_STAGE(PG8_SB(1, 0), b3, voffB); PG8_STAGE(PG8_SB(1, 1), b3 + hstep, voffB); PG8_STAGE(PG8_SA(1, 0), a3, voffA);
            PG8_WAIT_V(8); PG8_WAIT_L(0); PG8_BAR; PG8_MMA(1, 0, At, B0); PG8_MMA(1, 1, At, B1); PG8_BAR; PG8_SCHED;
            } else {
            PG8_LDB(B0, 0, 0); PG8_SCHED; PG8_LDA(At, 0, 0); PG8_STAGE(PG8_SA(1, 1), a1 + hstep, voffA);
            PG8_WAIT_L(8); PG8_BAR; PG8_WAIT_L(0); PG8_MMA(0, 0, At, B0); PG8_BAR; PG8_SCHED;
            PG8_LDB(B1, 0, 1); PG8_STAGE(PG8_SB(0, 0), b2, voffB);
            PG8_BAR; PG8_WAIT_L(0); PG8_MMA(0, 1, At, B1); PG8_BAR;
            PG8_LDA(At, 0, 1); PG8_STAGE(PG8_SA(0, 0), a2, voffA);
            PG8_BAR; PG8_WAIT_L(0); PG8_MMA(1, 0, At, B0); PG8_BAR; PG8_SCHED;
            PG8_STAGE(PG8_SB(0, 1), b2 + hstep, voffB);
            PG8_WAIT_V(6); PG8_BAR; PG8_MMA(1, 1, At, B1); PG8_BAR;
            PG8_LDB(B0, 1, 0); PG8_SCHED; PG8_LDA(At, 1, 0); PG8_STAGE(PG8_SA(0, 1), a2 + hstep, voffA);
            PG8_WAIT_L(8); PG8_BAR; PG8_WAIT_L(0); PG8_MMA(0, 0, At, B0); PG8_BAR; PG8_SCHED;
            PG8_LDB(B1, 1, 1); PG8_STAGE(PG8_SB(1, 0), b3, voffB);
            PG8_BAR; PG8_WAIT_L(0); PG8_MMA(0, 1, At, B1); PG8_BAR;
            PG8_LDA(At, 1, 1); PG8_STAGE(PG8_SA(1, 0), a3, voffA);
            PG8_BAR; PG8_WAIT_L(0); PG8_MMA(1, 0, At, B0); PG8_BAR; PG8_SCHED;
            PG8_STAGE(PG8_SB(1, 1), b3 + hstep, voffB);
            PG8_WAIT_V(6); PG8_BAR; PG8_MMA(1, 1, At, B1); PG8_BAR;
            }
        }
        if constexpr (ALIGN_EPI) { if (wr == 0) PG8_BAR; }
        if constexpr (!Epi::AFTER_DRAIN) { E(acc, cur, wr, wc, fr, fq); S.done(cur); }
        if (!has_next) break;
#pragma unroll
        for (int a = 0; a < 2; ++a)
#pragma unroll
            for (int b = 0; b < 2; ++b)
#pragma unroll
                for (int m = 0; m < 4; ++m)
#pragma unroll
                    for (int n = 0; n < 2; ++n) acc[a][b][m][n] = (f32x4){0.f, 0.f, 0.f, 0.f};
        cur = nxt; cA = nA; cB = nB; ++ui;
        if constexpr (ALIGN_EPI) { if (wr == 1) PG8_BAR; }
    }
    PG8_WAIT_V(0);
    if constexpr (!ALIGN_EPI) { if (wr == 0) PG8_BAR; }
    PG8_BAR;
    if constexpr (Epi::AFTER_DRAIN) { E.fused(acc, cur, wr, wc, fr, fq, lds, wid, lane); S.done(cur); }
#undef PG8_SA
#undef PG8_SB
#undef PG8_STAGE
#undef PG8_LDA
#undef PG8_LDB
#undef PG8_MMA
#undef PG8_WAIT_V
#undef PG8_WAIT_L
#undef PG8_BAR
#undef PG8_SCHED
}
}
#define GAS __attribute__((address_space(1)))
#define LAS __attribute__((address_space(3)))
typedef unsigned short bf16;
typedef unsigned v4u __attribute__((ext_vector_type(4)));
typedef float f32x4 __attribute__((ext_vector_type(4)));
typedef short bf16x8 __attribute__((ext_vector_type(8)));
typedef GAS unsigned gu32;
typedef GAS unsigned long long gu64;
#define RLX_AGENT __ATOMIC_RELAXED, __HIP_MEMORY_SCOPE_AGENT
#define LDS_WAIT() asm volatile("s_waitcnt lgkmcnt(0)" ::: "memory")
#define VM_WAIT() asm volatile("s_waitcnt vmcnt(0)" ::: "memory")
__device__ __forceinline__ unsigned long long rt() { return __builtin_amdgcn_s_memrealtime(); }
__device__ __forceinline__ unsigned f2bf(float f) { unsigned u = __builtin_bit_cast(unsigned, f); return (u + 0x7fffu + ((u >> 16) & 1u)) >> 16; }
__device__ __forceinline__ unsigned pk2(float lo, float hi) { return f2bf(lo) | (f2bf(hi) << 16); }
#define XB_TMO      128
#define XB_XCNT(j)  (256  + 64 * (j))
#define XB_XSUB(j)  (1280 + 64 * (j))
#define XB_XGEN(j)  (2304 + 64 * (j))
#define XB_TOP      3328
#define XB_TOPGEN   3392
#define XCD_BAR_WORDS 3456
#define XB_SPIN_CAP (1u << 18)

__device__ __forceinline__ unsigned xb_ld(unsigned* p)              { return __hip_atomic_load(p, __ATOMIC_RELAXED, __HIP_MEMORY_SCOPE_AGENT); }
__device__ __forceinline__ unsigned xb_add(unsigned* p, unsigned v) { return __hip_atomic_fetch_add(p, v, __ATOMIC_RELAXED, __HIP_MEMORY_SCOPE_AGENT); }
__device__ __forceinline__ unsigned xb_xcc_id() { return (unsigned)__builtin_amdgcn_s_getreg((3 << 11) | 20) & 0xFu; }
#define XB_SPIN(cond, bar) do { unsigned _sp = 0; while (cond) { __builtin_amdgcn_s_sleep(1); \
    if ((++_sp & 255u) == 0u) { if (xb_ld(&(bar)[XB_TMO])) break; if (_sp > XB_SPIN_CAP) { atomicAdd(&(bar)[XB_TMO], 1u); break; } } } } while (0)

struct XcdBarrier {
    unsigned* bar; unsigned x;
    volatile LAS unsigned* st;
};

__device__ __forceinline__ XcdBarrier xcd_barrier_post(unsigned* bar, volatile LAS unsigned* st) {
    XcdBarrier b; b.bar = bar; b.x = xb_xcc_id(); b.st = st;
    if (threadIdx.x == 0) (void)xb_add(&bar[XB_XCNT(b.x)], 1u);
    return b;
}
__device__ __forceinline__ void xcd_barrier_complete(unsigned* bar, unsigned x, unsigned& nloc, unsigned& nx) {
    const unsigned G = gridDim.x * gridDim.y * gridDim.z;
    unsigned sum, cnt, mine, sp = 0u;
    for (;;) {
        sum = 0u; cnt = 0u; mine = 0u;
#pragma unroll
        for (unsigned j = 0; j < 16; ++j) { const unsigned c = xb_ld(&bar[XB_XCNT(j)]); sum += c; cnt += (c > 0u) ? 1u : 0u; mine = (j == x) ? c : mine; }
        if (sum == G) break;
        __builtin_amdgcn_s_sleep(1);
        if ((++sp & 255u) == 0u) { if (xb_ld(&bar[XB_TMO])) break; if (sp > XB_SPIN_CAP) { atomicAdd(&bar[XB_TMO], 1u); break; } }
    }
    nloc = mine > 0u ? mine : 1u; nx = cnt > 0u ? cnt : 1u;
}

__device__ __forceinline__ void xcd_barrier(const XcdBarrier& b) {
    asm volatile("s_waitcnt vmcnt(0)" ::: "memory");
    __syncthreads();
    if (threadIdx.x == 0) {
        unsigned* bar = b.bar;
        __builtin_amdgcn_s_waitcnt(0);
        unsigned nloc = b.st[0], nx = b.st[1];
        if (nloc == 0u) { xcd_barrier_complete(bar, b.x, nloc, nx); b.st[0] = nloc; b.st[1] = nx; }
        const unsigned old = xb_add(&bar[XB_XSUB(b.x)], 1u);
        const unsigned gen = old / nloc;
        if (old + 1u == (gen + 1u) * nloc) {
            __builtin_amdgcn_fence(__ATOMIC_RELEASE, "agent");
            asm volatile("s_waitcnt vmcnt(0)" ::: "memory");
            const unsigned og = xb_add(&bar[XB_TOP], 1u);
            const unsigned tg = og / nx;
            if (og + 1u == (tg + 1u) * nx) xb_add(&bar[XB_TOPGEN], 1u);
            else XB_SPIN(xb_ld(&bar[XB_TOPGEN]) == tg, bar);
            __builtin_amdgcn_fence(__ATOMIC_ACQUIRE, "agent");
            xb_add(&bar[XB_XGEN(b.x)], 1u);
            asm volatile("s_waitcnt vmcnt(0)" ::: "memory");
        } else {
            XB_SPIN(xb_ld(&bar[XB_XGEN(b.x)]) == gen, bar);
            __builtin_amdgcn_fence(__ATOMIC_ACQUIRE, "agent");
            asm volatile("s_waitcnt vmcnt(0)" ::: "memory");
        }
    }
    __syncthreads();
}
#ifndef MK_PROBE
#define MK_PROBE 0
#endif
#ifndef MK_PROBE_A
#define MK_PROBE_A 0
#define MK_PROBE_B 0
#endif
#ifndef MK_PROBE_REGIONS
#define MK_PROBE_REGIONS 0
#endif
#if MK_PROBE
#define REG_BEGIN(i) do { if (blockIdx.x == 0 && threadIdx.x == 0) ((unsigned long long*)(kp->ws + WS_CTL + 65536))[100 + (i)] = __builtin_amdgcn_s_memrealtime(); } while (0)
#define REG_END(i) do { __syncthreads(); if (blockIdx.x == 0 && threadIdx.x == 0) { unsigned long long* st_ = (unsigned long long*)(kp->ws + WS_CTL + 65536); st_[110 + (i)] += __builtin_amdgcn_s_memrealtime() - st_[100 + (i)]; } } while (0)
#else
#define REG_BEGIN(i) do { } while (0)
#define REG_END(i) do { } while (0)
#endif
namespace nv {
constexpr int D = 1024, MP = 16384, MS = 512, MT = MP + MS, NSEQ = 136, DEPTH = 4;
constexpr int NIN = 4112;
constexpr int NPJ = 4096, OFF_POOL = 0, OFF_Z = 512, OFF_XBC = 1536, OFF_GATE = 3072, OFF_LRU = 3584;
constexpr int DFF = 2816, NINP = 4352;
constexpr float EPS = 1e-6f;
constexpr size_t O_Y = 0, O_PPOOL = (size_t)MT * D, O_PSCONV = O_PPOOL + 245760, O_PSSD = O_PSCONV + 147456, O_PLCONV = O_PSSD + 4194304, O_PLRU = O_PLCONV + 49152,
                 O_PMK = O_PLRU + 16384, O_PMV = O_PMK + 8388608, O_SPOOL = O_PMV + 8388608, O_SSCONV = O_SPOOL + 3932160, O_SSSD = O_SSCONV + 2359296,
                 O_SLCONV = O_SSSD + 67108864, O_SLRU = O_SLCONV + 786432, O_END = O_SLRU + 262144;
constexpr size_t MiB = 1u << 20;
constexpr size_t WS_CTL = 0, CTL_ZERO_BYTES = 1 * MiB;
constexpr size_t WS_WKV = 1 * MiB, WS_WIN = 17 * MiB, WS_WOUT = 51 * MiB, WS_WQ = 67 * MiB, WS_WO = 75 * MiB, WS_WGU = 83 * MiB, WS_WD = 127 * MiB;
constexpr size_t WS_MEMB = 149 * MiB, WS_HB = 153 * MiB, WS_UB = 153 * MiB, WS_MIXB = 186 * MiB, WS_OB = 252 * MiB, WS_ACT = 285 * MiB;
constexpr size_t WS_PROJ = 376 * MiB, WS_POOLED = 642 * MiB, WS_XBC = 675 * MiB, WS_YRAW = 774 * MiB, WS_XC = 840 * MiB, WS_AB = 873 * MiB, WS_BB = 906 * MiB, WS_QB = 939 * MiB;
constexpr size_t WS_KB = 1005 * MiB, WS_VT = 1021 * MiB;
constexpr size_t WS_SSDSS = 1037 * MiB, WS_PWT = 1039 * MiB;
constexpr size_t WS_DT = 1042 * MiB;
constexpr size_t WS_RSS = 1040 * MiB;
constexpr size_t WS_XBCC = 1044 * MiB;
constexpr size_t WS_END = 1092 * MiB;
constexpr size_t WIN_L = (size_t)NINP * 1024, WOUT_L = (size_t)1024 * 2048, WQ_L = (size_t)1024 * 1024, WGU_L = (size_t)5632 * 1024, WD_L = (size_t)1024 * 2816;
constexpr int CW_TMO = 0, CW_BAR = 4096;
constexpr int RING_OFF = 0, RING_BYTES = 131072, LDSCTL_OFF = RING_BYTES, MISC_OFF = LDSCTL_OFF + 320, LDS_BYTES = 147456;
constexpr int NWAVES = 8, NTHR = 512;
constexpr int PH_PRO = 0, PH_KV = 1, PH_L0 = 2, PH_PER_LAYER = 9, PH_FINAL = PH_L0 + DEPTH * PH_PER_LAYER, NPH = PH_FINAL + 1;

struct SeqInfo { int row0, L, pos0, b, grp; };
__device__ __forceinline__ SeqInfo seq_info(int s) {
    SeqInfo q;
    if (s < 8) { q.row0 = s * 2048; q.L = 2048; q.pos0 = 0; q.b = s; q.grp = 0; }
    else { q.b = s - 8; q.row0 = MP + q.b * 4; q.L = 4; q.pos0 = 16384; q.grp = 1; }
    return q;
}
__device__ __forceinline__ void row_info(int r, int& s, int& t) {
    if (r < MP) { s = r >> 11; t = r & 2047; } else { const int q = r - MP; s = 8 + (q >> 2); t = q & 3; }
}
__device__ __forceinline__ float wave_sum(float v) {
#pragma unroll
    for (int o = 1; o < 64; o <<= 1) v += __shfl_xor(v, o);
    return v;
}
__device__ __forceinline__ float wave_max(float v) {
#pragma unroll
    for (int o = 1; o < 64; o <<= 1) v = fmaxf(v, __shfl_xor(v, o));
    return v;
}
__device__ __forceinline__ float silu_f(float x) { return x / (1.f + expf(-x)); }
__device__ __forceinline__ float sigmoid_f(float x) { return 1.f / (1.f + expf(-x)); }
__device__ __forceinline__ float softplus_f(float x) { return x > 20.f ? x : log1pf(expf(x)); }
__device__ __forceinline__ float gelu_tanh_f(float x) { return 0.5f * x * (1.f + tanhf(0.7978845608028654f * (x + 0.044715f * x * x * x))); }

struct Args { const float* in[38]; float* out; unsigned char* ws; int ph_lo, ph_hi; };
typedef const __attribute__((address_space(4))) Args* KP;
struct Frame { LAS unsigned char* lds; int tid, lane, wave, bid, G, vcu; };
__device__ __forceinline__ void frame_refresh(Frame& F) { int t = threadIdx.x; asm volatile("" : "+v"(t)); F.tid = t; F.lane = t & 63; F.wave = __builtin_amdgcn_readfirstlane(t >> 6); }

typedef float f32x2_t __attribute__((ext_vector_type(2))); typedef __bf16 bf16x2_t __attribute__((ext_vector_type(2)));
__device__ __forceinline__ unsigned pk2h(float lo, float hi) { f32x2_t v = {lo, hi}; bf16x2_t b = __builtin_convertvector(v, bf16x2_t); return __builtin_bit_cast(unsigned, b); }
__device__ __forceinline__ unsigned f2bfh(float x) { return pk2h(x, 0.f) & 0xffffu; }
typedef short bf16x8 __attribute__((ext_vector_type(8)));
#define MFMA16(a, b, c) __builtin_amdgcn_mfma_f32_16x16x32_bf16((a), (b), (c), 0, 0, 0)
#define LBAR() do { asm volatile("s_waitcnt lgkmcnt(0)" ::: "memory"); __builtin_amdgcn_s_barrier(); asm volatile("" ::: "memory"); } while (0)
__device__ __forceinline__ float bf2f(unsigned short h) { return __uint_as_float((unsigned)h << 16); }
__device__ __forceinline__ void cvt8(v4u u, f32x4& lo, f32x4& hi) { lo = (f32x4){__uint_as_float(u.x << 16), __uint_as_float(u.x & 0xffff0000u), __uint_as_float(u.y << 16), __uint_as_float(u.y & 0xffff0000u)}; hi = (f32x4){__uint_as_float(u.z << 16), __uint_as_float(u.z & 0xffff0000u), __uint_as_float(u.w << 16), __uint_as_float(u.w & 0xffff0000u)}; }
constexpr int SL_CS = 0, SL_BS = 32768, SL_BT = 65536, SL_XT = 98304, SL_XW = 106496, SL_HS = 114688, SL_XS = 122880;
constexpr int XTRA = LDSCTL_OFF + 512;
constexpr int SL_ACS = XTRA, SL_DTV = XTRA + 512, SL_CW = XTRA + 1024;
__device__ __forceinline__ int sw128(int r, int c8) { return r * 256 + (((c8 ^ r) & 15) << 4); }
__device__ __forceinline__ float fexp(float x) { return __builtin_amdgcn_exp2f(1.4426950408889634f * x); }
__device__ __forceinline__ float fsilu(float x) { return x * __builtin_amdgcn_rcpf(1.0f + __builtin_amdgcn_exp2f(-1.4426950408889634f * x)); }

__device__ __forceinline__ void ph_mix0(KP a, Frame& F, int l) {
    const bf16* proj = (const bf16*)(a->ws + WS_PROJ); bf16* xo = (bf16*)(a->ws + WS_XBCC);
    const float* cw = a->in[14] + (size_t)l * 4 * 1536; const float* cb = a->in[15] + (size_t)l * 1536;
    const int NIT = (MP / 8) * 192;
    for (int it = F.bid * NTHR + F.tid; it < NIT; it += F.G * NTHR) {
        const int c8 = it % 192, rb = it / 192, r0 = rb * 8, t = r0 & 2047;
        f32x4 wk[5][2];
#pragma unroll
        for (int k = 0; k < 4; ++k) { wk[k][0] = *(const f32x4*)(cw + (size_t)k * 1536 + 8 * c8); wk[k][1] = *(const f32x4*)(cw + (size_t)k * 1536 + 8 * c8 + 4); }
        wk[4][0] = *(const f32x4*)(cb + 8 * c8); wk[4][1] = *(const f32x4*)(cb + 8 * c8 + 4);
        v4u rw[11];
#pragma unroll
        for (int rr = 0; rr < 11; ++rr) { rw[rr] = (v4u){0u, 0u, 0u, 0u}; if (t + rr - 3 >= 0) rw[rr] = *(const GAS v4u*)(proj + (size_t)(r0 + rr - 3) * NPJ + OFF_XBC + 8 * c8); }
#pragma unroll
        for (int hf = 0; hf < 2; ++hf) {
            f32x4 raw[11];
#pragma unroll
            for (int rr = 0; rr < 11; ++rr) { const unsigned u0 = hf ? rw[rr].z : rw[rr].x, u1 = hf ? rw[rr].w : rw[rr].y;
                raw[rr] = (f32x4){__uint_as_float(u0 << 16), __uint_as_float(u0 & 0xffff0000u), __uint_as_float(u1 << 16), __uint_as_float(u1 & 0xffff0000u)}; }
#pragma unroll
            for (int i = 0; i < 8; ++i) { f32x4 o = wk[4][hf];
#pragma unroll
                for (int k = 0; k < 4; ++k) o += wk[k][hf] * raw[i + k];
                *(unsigned long long*)(xo + (size_t)(r0 + i) * 1536 + 8 * c8 + 4 * hf) = (unsigned long long)pk2h(fsilu(o.x), fsilu(o.y)) | ((unsigned long long)pk2h(fsilu(o.z), fsilu(o.w)) << 32); }
        }
    }
}
template <bool WITH_T>
__device__ __forceinline__ void ssd_stage(LAS unsigned char* L, const v4u (&rw)[4], int dst, int dstT, int tq, int c8) {
#pragma unroll
    for (int i = 0; i < 4; ++i) *(LAS v4u*)(L + dst + sw128(4 * tq + i, c8)) = rw[i];
    if (WITH_T) {
#pragma unroll
        for (int jw = 0; jw < 4; ++jw) {
            const unsigned a0 = rw[0][jw], a1 = rw[1][jw], a2 = rw[2][jw], a3 = rw[3][jw];
            const unsigned long long ev = (unsigned long long)((a0 & 0xffffu) | (a1 << 16)) | ((unsigned long long)((a2 & 0xffffu) | (a3 << 16)) << 32);
            const unsigned long long od = (unsigned long long)((a0 >> 16) | (a1 & 0xffff0000u)) | ((unsigned long long)((a2 >> 16) | (a3 & 0xffff0000u)) << 32);
            *(LAS unsigned long long*)(L + dstT + sw128(8 * c8 + 2 * jw, tq >> 1) + (tq & 1) * 8) = ev;
            *(LAS unsigned long long*)(L + dstT + sw128(8 * c8 + 2 * jw + 1, tq >> 1) + (tq & 1) * 8) = od; }
    }
}
__device__ __forceinline__ float fsoftplus(float x) { return x > 15.f ? x : 0.6931471805599453f * __builtin_amdgcn_logf(1.0f + __builtin_amdgcn_exp2f(1.4426950408889634f * x)); }

__device__ __forceinline__ void ssd_prompt_item(KP a, Frame& F, int l, int b, int hd, int ph) {
    LAS unsigned char* L = F.lds;
    const int tid0 = F.tid, w = F.wave, fr0 = F.lane & 15, fq0 = F.lane >> 4, g = hd >> 3;
    const bf16* proj_seq = (const bf16*)(a->ws + WS_PROJ) + (size_t)b * 2048 * NPJ; const float* dt_seq = (const float*)(a->ws + WS_DT) + (size_t)b * 2048 * 16 + hd;
    bf16* mixb = (bf16*)(a->ws + WS_MIXB) + (size_t)b * 2048 * 2048 + hd * 64 + ph * 32;
    float* ssq = (float*)(a->ws + WS_SSDSS) + (size_t)b * 2048 * 32 + hd * 2 + ph;
    LAS float* ACS = (LAS float*)(L + SL_ACS); LAS float* DTV = (LAS float*)(L + SL_DTV);
    const bf16* xc_seq = (const bf16*)(a->ws + WS_XBCC) + (size_t)b * 2048 * 1536;
    for (int i = tid0; i < 8192 / 4; i += NTHR) ((LAS unsigned*)(L + SL_HS))[i] = 0u;
    const float A = -expf(a->in[17][l * 16 + hd]), dtb = a->in[16][l * 16 + hd], Dk = a->in[18][l * 16 + hd];
    f32x4 hst[2]; hst[0] = (f32x4){0.f, 0.f, 0.f, 0.f}; hst[1] = (f32x4){0.f, 0.f, 0.f, 0.f};
    const int cB = 1024 + g * 128, cC = 1280 + g * 128, cX = hd * 64 + ph * 32, cZ = OFF_Z + hd * 64 + ph * 32;
    v4u rawB[4], rawC[4]; unsigned rawX[4]; float dr0 = 0.f, dr1 = 0.f;
    {
        const int tq = tid0 >> 4, c8 = tid0 & 15;
#pragma unroll
        for (int i = 0; i < 4; ++i) { const bf16* rp = xc_seq + (size_t)(4 * tq + i) * 1536; rawB[i] = *(const GAS v4u*)(rp + cB + 8 * c8); rawC[i] = *(const GAS v4u*)(rp + cC + 8 * c8); rawX[i] = *(const GAS unsigned*)(rp + cX + 2 * c8); }
        if (w == 0) { dr0 = dt_seq[(size_t)(2 * F.lane) * 16]; dr1 = dt_seq[(size_t)(2 * F.lane + 1) * 16]; }
    }
    __syncthreads();
    for (int c = 0; c < 16; ++c) {
        const int t0 = c * 128;
        const int tid = tid0, fr = fr0, fq = fq0;
        const int lane = tid & 63, tq = tid >> 4, c8 = tid & 15;
        unsigned long long zq[2];
#pragma unroll
        for (int pt = 0; pt < 2; ++pt) zq[pt] = *(const GAS unsigned long long*)(proj_seq + (size_t)(t0 + 16 * w + fr) * NPJ + cZ + 16 * pt + 4 * fq);
        if (w == 0) {
            const float dt0 = fsoftplus(dr0 + dtb), dt1 = fsoftplus(dr1 + dtb);
            const float a0 = dt0 * A, a1 = dt1 * A;
            float v = a0 + a1;
#pragma unroll
            for (int o = 1; o < 64; o <<= 1) { const float t = __shfl_up(v, o); if (lane >= o) v += t; }
            ACS[2 * lane] = v - a1; ACS[2 * lane + 1] = v; DTV[2 * lane] = dt0; DTV[2 * lane + 1] = dt1;
        }
        ssd_stage<true>(L, rawB, SL_BS, SL_BT, tq, c8);
        ssd_stage<false>(L, rawC, SL_CS, 0, tq, c8);
        if (c + 1 < 16) {
#pragma unroll
            for (int i = 0; i < 4; ++i) { const bf16* rp = xc_seq + (size_t)(t0 + 128 + 4 * tq + i) * 1536; rawB[i] = *(const GAS v4u*)(rp + cB + 8 * c8); rawC[i] = *(const GAS v4u*)(rp + cC + 8 * c8); }
        }
        LBAR();
        f32x4 cb[8]; bf16x8 cfr[4];
#pragma unroll
        for (int ks = 0; ks < 4; ++ks) cfr[ks] = *(const LAS bf16x8*)(L + SL_CS + sw128(16 * w + fr, 4 * ks + fq));
#pragma unroll
        for (int st = 0; st < 8; ++st) if (st <= w) { cb[st] = (f32x4){0.f, 0.f, 0.f, 0.f};
#pragma unroll
            for (int ks = 0; ks < 4; ++ks) { const bf16x8 bm = *(const LAS bf16x8*)(L + SL_BS + sw128(16 * st + fr, 4 * ks + fq)); cb[st] = MFMA16(bm, cfr[ks], cb[st]); } }
        {
            const float alast = ACS[127];
            float xd[4][2], xw[4][2];
#pragma unroll
            for (int i = 0; i < 4; ++i) { const int tok = 4 * tq + i; const float dt = DTV[tok], wgt = fexp(alast - ACS[tok]);
                xd[i][0] = __uint_as_float(rawX[i] << 16) * dt; xd[i][1] = __uint_as_float(rawX[i] & 0xffff0000u) * dt; xw[i][0] = xd[i][0] * wgt; xw[i][1] = xd[i][1] * wgt; }
#pragma unroll
            for (int j = 0; j < 2; ++j) { const int off = sw128(2 * c8 + j, tq >> 1) + (tq & 1) * 8;
                *(LAS unsigned long long*)(L + SL_XT + off) = (unsigned long long)pk2h(xd[0][j], xd[1][j]) | ((unsigned long long)pk2h(xd[2][j], xd[3][j]) << 32);
                *(LAS unsigned long long*)(L + SL_XW + off) = (unsigned long long)pk2h(xw[0][j], xw[1][j]) | ((unsigned long long)pk2h(xw[2][j], xw[3][j]) << 32); }
            if (c + 1 < 16) {
#pragma unroll
                for (int i = 0; i < 4; ++i) rawX[i] = *(const GAS unsigned*)(xc_seq + (size_t)(t0 + 128 + 4 * tq + i) * 1536 + cX + 2 * c8);
                if (w == 0) { dr0 = dt_seq[(size_t)(t0 + 128 + 2 * lane) * 16]; dr1 = dt_seq[(size_t)(t0 + 128 + 2 * lane + 1) * 16]; }
            }
        }
        LBAR();
        {
            const int l_ = 16 * w + fr; const float al = ACS[l_];
#pragma unroll
            for (int st = 0; st < 8; ++st) {
                const int off = SL_BS + sw128(l_, 2 * st + (fq >> 1)) + (fq & 1) * 8;
                if (st <= w) { float v[4]; const f32x4 as4 = *(const LAS f32x4*)(ACS + 16 * st + 4 * fq);
#pragma unroll
                    for (int e = 0; e < 4; ++e) { const int s_ = 16 * st + 4 * fq + e; const float ex = fexp(fminf(al - as4[e], 0.f)); v[e] = (s_ <= l_) ? cb[st][e] * ex : 0.f; }
                    *(LAS unsigned long long*)(L + off) = (unsigned long long)pk2h(v[0], v[1]) | ((unsigned long long)pk2h(v[2], v[3]) << 32); }
                else if (st == w + 1 && (w & 1) == 0) *(LAS unsigned long long*)(L + off) = 0ull;
            }
        }
        LBAR();
        {
            f32x4 yd[2], yo[2];
#pragma unroll
            for (int pt = 0; pt < 2; ++pt) { yd[pt] = (f32x4){0.f, 0.f, 0.f, 0.f}; yo[pt] = (f32x4){0.f, 0.f, 0.f, 0.f}; }
#pragma unroll
            for (int ks = 0; ks < 4; ++ks) {
#pragma unroll
                for (int pt = 0; pt < 2; ++pt) { const bf16x8 hf = *(const LAS bf16x8*)(L + SL_HS + sw128(16 * pt + fr, 4 * ks + fq)); yo[pt] = MFMA16(hf, cfr[ks], yo[pt]); }
                if (ks <= (w >> 1)) { const bf16x8 mf = *(const LAS bf16x8*)(L + SL_BS + sw128(16 * w + fr, 4 * ks + fq));
#pragma unroll
                    for (int pt = 0; pt < 2; ++pt) { const bf16x8 xf = *(const LAS bf16x8*)(L + SL_XT + sw128(16 * pt + fr, 4 * ks + fq)); yd[pt] = MFMA16(xf, mf, yd[pt]); } }
            }
            const int l_ = 16 * w + fr; const float ea = fexp(ACS[l_]), dsk = Dk * __builtin_amdgcn_rcpf(DTV[l_]); float s2 = 0.f;
#pragma unroll
            for (int pt = 0; pt < 2; ++pt) { float yg[4];
#pragma unroll
                for (int e = 0; e < 4; ++e) { const int p = 16 * pt + 4 * fq + e;
                    const float xdv = bf2f(*(const LAS bf16*)(L + SL_XT + sw128(p, l_ >> 3) + (l_ & 7) * 2));
                    const float z = bf2f((unsigned short)(zq[pt] >> (16 * e)));
                    const float y = yd[pt][e] + ea * yo[pt][e] + dsk * xdv;
                    yg[e] = y * fsilu(z); s2 += yg[e] * yg[e]; }
                *(unsigned long long*)(mixb + (size_t)(t0 + l_) * 2048 + 16 * pt + 4 * fq) = (unsigned long long)pk2h(yg[0], yg[1]) | ((unsigned long long)pk2h(yg[2], yg[3]) << 32); }
            s2 += __shfl_xor(s2, 16); s2 += __shfl_xor(s2, 32);
            if (fq == 0) ssq[(size_t)(t0 + l_) * 32] = s2;
            const float cd = fexp(ACS[127]);
#pragma unroll
            for (int pt = 0; pt < 2; ++pt) hst[pt] = hst[pt] * cd;
#pragma unroll
            for (int ks = 0; ks < 4; ++ks) { const bf16x8 bt = *(const LAS bf16x8*)(L + SL_BT + sw128(16 * w + fr, 4 * ks + fq));
#pragma unroll
                for (int pt = 0; pt < 2; ++pt) { const bf16x8 xw = *(const LAS bf16x8*)(L + SL_XW + sw128(16 * pt + fr, 4 * ks + fq)); hst[pt] = MFMA16(bt, xw, hst[pt]); } }
        }
        LBAR();
#pragma unroll
        for (int pt = 0; pt < 2; ++pt)
            *(LAS unsigned long long*)(L + SL_HS + sw128(16 * pt + fr, 2 * w + (fq >> 1)) + (fq & 1) * 8) = (unsigned long long)pk2h(hst[pt][0], hst[pt][1]) | ((unsigned long long)pk2h(hst[pt][2], hst[pt][3]) << 32);
    }
    {
        float* so = a->out + O_PSSD + ((((size_t)l * 8 + b) * 16 + hd) * 64 + ph * 32) * 128;
#pragma unroll
        for (int pt = 0; pt < 2; ++pt) *(f32x4*)(so + (size_t)(16 * pt + fr0) * 128 + 16 * w + 4 * fq0) = hst[pt];
    }
    __syncthreads();
}

constexpr int LR_ROWS = 512 + 32;
constexpr int LR_A = 0, LR_B = LR_ROWS * 64, LR_XC = 2 * LR_ROWS * 64;
constexpr int LR_SEG = LR_XC + 8192, LR_CAR = LR_SEG + 2 * 32 * 16 * 4, LR_CW = LR_CAR + 64 + 32 * 16 * 4;
static_assert(LR_CW + 5 * 64 * 4 <= RING_BYTES, "lru LDS map");
__device__ __forceinline__ int lr_row(int tok) { return tok + (tok >> 4); }
__device__ __forceinline__ void lru_prompt_item(KP a, Frame& F, int l, int b, int hh, int qd) {
    LAS unsigned char* L = F.lds;
    const int tid0 = F.tid, w = F.wave, fr0 = F.lane & 15, fq0 = F.lane >> 4;
    const bf16* proj_seq = (const bf16*)(a->ws + WS_PROJ) + (size_t)b * 2048 * NPJ;
    bf16* mixb = (bf16*)(a->ws + WS_MIXB) + (size_t)b * 2048 * 2048 + 1536 + hh * 64 + qd * 16;
    LAS float* Al = (LAS float*)(L + LR_A); LAS float* Bl = (LAS float*)(L + LR_B); LAS float* XCs = (LAS float*)(L + LR_XC) + w * 256;
    LAS float* SegA = (LAS float*)(L + LR_SEG); LAS float* SegB = SegA + 512; LAS float* Car = (LAS float*)(L + LR_CAR); LAS float* CarIn = Car + 16; LAS float* CW = (LAS float*)(L + LR_CW);
    const int ch = hh * 64 + qd * 16 + fr0;
    for (int i = tid0; i < 5 * 64; i += NTHR) { const int k = i >> 6, ci = i & 63; CW[i] = k < 4 ? a->in[20][(size_t)l * 4 * 512 + k * 512 + hh * 64 + ci] : a->in[21][(size_t)l * 512 + hh * 64 + ci]; }
    if (tid0 < 16) Car[tid0] = 0.f;
    bf16x8 waf[2], wxf[2];
    {
        const float* wa = a->in[22] + ((size_t)l * 8 + hh) * 64 * 64 + qd * 16 + fr0; const float* wx = a->in[24] + ((size_t)l * 8 + hh) * 64 * 64 + qd * 16 + fr0;
#pragma unroll
        for (int ks = 0; ks < 2; ++ks) { v4u ua, ux; const int i0 = 32 * ks + 8 * fq0;
            ua.x = pk2h(wa[(i0 + 0) * 64], wa[(i0 + 1) * 64]); ua.y = pk2h(wa[(i0 + 2) * 64], wa[(i0 + 3) * 64]); ua.z = pk2h(wa[(i0 + 4) * 64], wa[(i0 + 5) * 64]); ua.w = pk2h(wa[(i0 + 6) * 64], wa[(i0 + 7) * 64]);
            ux.x = pk2h(wx[(i0 + 0) * 64], wx[(i0 + 1) * 64]); ux.y = pk2h(wx[(i0 + 2) * 64], wx[(i0 + 3) * 64]); ux.z = pk2h(wx[(i0 + 4) * 64], wx[(i0 + 5) * 64]); ux.w = pk2h(wx[(i0 + 6) * 64], wx[(i0 + 7) * 64]);
            waf[ks] = __builtin_bit_cast(bf16x8, ua); wxf[ks] = __builtin_bit_cast(bf16x8, ux); }
    }
    const float bav = a->in[23][(size_t)l * 512 + ch], bxv = a->in[25][(size_t)l * 512 + ch];
    const float lamv = a->in[26][(size_t)l * 512 + ch];
    const float spv = -8.0f * ((-lamv) > 20.f ? (-lamv) : log1pf(expf(-lamv)));
    __syncthreads();
    for (int qp = 0; qp < 4; ++qp) {
        const int T0 = qp * 512;
        int tid = tid0, fr = fr0, fq = fq0; asm volatile("" : "+v"(tid), "+v"(fr), "+v"(fq));
        v4u rw[2][4];
#pragma unroll
        for (int ks = 0; ks < 2; ++ks)
#pragma unroll
            for (int k = 0; k < 4; ++k) { const int row = T0 + (w * 4) * 16 + fr + k - 3; rw[ks][k] = (v4u){0u, 0u, 0u, 0u}; if (row >= 0) rw[ks][k] = *(const GAS v4u*)(proj_seq + (size_t)row * NPJ + OFF_LRU + hh * 64 + 32 * ks + 8 * fq); }
#pragma unroll
        for (int tt = 0; tt < 4; ++tt) {
            const int tb = (w * 4 + tt) * 16;
            v4u nx[2][4];
            if (tt + 1 < 4) {
#pragma unroll
                for (int ks = 0; ks < 2; ++ks)
#pragma unroll
                    for (int k = 0; k < 4; ++k) nx[ks][k] = *(const GAS v4u*)(proj_seq + (size_t)(T0 + tb + 16 + fr + k - 3) * NPJ + OFF_LRU + hh * 64 + 32 * ks + 8 * fq);
            }
            bf16x8 xa[2];
#pragma unroll
            for (int ks = 0; ks < 2; ++ks) {
                const int c0 = 32 * ks + 8 * fq;
                f32x4 acc0 = *(const LAS f32x4*)(CW + 4 * 64 + c0), acc1 = *(const LAS f32x4*)(CW + 4 * 64 + c0 + 4);
#pragma unroll
                for (int k = 0; k < 4; ++k) { f32x4 x0, x1; cvt8(rw[ks][k], x0, x1);
                    acc0 += *(const LAS f32x4*)(CW + k * 64 + c0) * x0; acc1 += *(const LAS f32x4*)(CW + k * 64 + c0 + 4) * x1; }
                v4u u; u.x = pk2h(acc0.x, acc0.y); u.y = pk2h(acc0.z, acc0.w); u.z = pk2h(acc1.x, acc1.y); u.w = pk2h(acc1.z, acc1.w); xa[ks] = __builtin_bit_cast(bf16x8, u);
                if (ks == (qd >> 1) && (fq >> 1) == (qd & 1)) {
                    *(LAS f32x4*)(XCs + fr * 16 + 8 * (fq & 1)) = acc0; *(LAS f32x4*)(XCs + fr * 16 + 8 * (fq & 1) + 4) = acc1; }
            }
            f32x4 pr = (f32x4){bav, bav, bav, bav}, pi = (f32x4){bxv, bxv, bxv, bxv};
#pragma unroll
            for (int ks = 0; ks < 2; ++ks) { pr = MFMA16(xa[ks], waf[ks], pr); pi = MFMA16(xa[ks], wxf[ks], pi); }
            LDS_WAIT(); asm volatile("" ::: "memory");
#pragma unroll
            for (int e = 0; e < 4; ++e) { const int tok = tb + 4 * fq + e;
                const float rg = __builtin_amdgcn_rcpf(1.0f + fexp(-pr[e])), ig = __builtin_amdgcn_rcpf(1.0f + fexp(-pi[e]));
                const float log_a = spv * rg; const float av = fexp(log_a);
                const float y2 = 2.0f * log_a;
                const float om = y2 > -0.02f ? -y2 * (1.0f + y2 * (0.5f + y2 * (0.16666667f + y2 * 0.041666668f))) : 1.0f - av * av;
                const float mult = (T0 + tok == 0) ? 1.0f : sqrtf(om);
                const float xcv = XCs[(4 * fq + e) * 16 + fr];
                Al[lr_row(tok) * 16 + fr] = av; Bl[lr_row(tok) * 16 + fr] = mult * ig * xcv; }
            LDS_WAIT(); asm volatile("" ::: "memory");
            if (tt + 1 < 4) {
#pragma unroll
                for (int ks = 0; ks < 2; ++ks)
#pragma unroll
                    for (int k = 0; k < 4; ++k) rw[ks][k] = nx[ks][k];
            }
        }
        LBAR();
        {
            const int sg = tid >> 4, c = tid & 15; float pa = 1.f, hb = 0.f;
#pragma unroll
            for (int i = 0; i < 16; ++i) { const int r = (sg * 17 + i) * 16 + c; const float av = Al[r]; hb = av * hb + Bl[r]; pa *= av; }
            SegA[sg * 16 + c] = pa; SegB[sg * 16 + c] = hb;
        }
        LBAR();
        if (tid < 16) { float h = Car[tid];
            for (int sg = 0; sg < 32; ++sg) { CarIn[sg * 16 + tid] = h; h = SegA[sg * 16 + tid] * h + SegB[sg * 16 + tid]; }
            Car[tid] = h; }
        LBAR();
        {
            const int sg = tid >> 4, c = tid & 15; float h = CarIn[sg * 16 + c];
#pragma unroll
            for (int i = 0; i < 16; ++i) { const int r = (sg * 17 + i) * 16 + c; h = Al[r] * h + Bl[r]; Bl[r] = h; }
        }
        LBAR();
        {
            const int tok = tid; const bf16* gp = proj_seq + (size_t)(T0 + tok) * NPJ + OFF_GATE + hh * 64 + qd * 16;
            float y[16]; f32x4 gq[4]; cvt8(*(const GAS v4u*)gp, gq[0], gq[1]); cvt8(*(const GAS v4u*)(gp + 8), gq[2], gq[3]);
#pragma unroll
            for (int v = 0; v < 4; ++v) { const f32x4 gt = gq[v]; const f32x4 hv = *(const LAS f32x4*)(Bl + lr_row(tok) * 16 + 4 * v);
#pragma unroll
                for (int i = 0; i < 4; ++i) { const float x = gt[i]; const float u = 0.7978845608028654f * (x + 0.044715f * x * x * x); const float th = 1.0f - 2.0f * __builtin_amdgcn_rcpf(1.0f + fexp(2.0f * u));
                    y[4 * v + i] = hv[i] * 0.5f * x * (1.0f + th); } }
            v4u o0, o1; o0.x = pk2h(y[0], y[1]); o0.y = pk2h(y[2], y[3]); o0.z = pk2h(y[4], y[5]); o0.w = pk2h(y[6], y[7]); o1.x = pk2h(y[8], y[9]); o1.y = pk2h(y[10], y[11]); o1.z = pk2h(y[12], y[13]); o1.w = pk2h(y[14], y[15]);
            v4u* op = (v4u*)(mixb + (size_t)(T0 + tok) * 2048); op[0] = o0; op[1] = o1;
        }
        LBAR();
    }
    if (tid0 < 16) a->out[O_PLRU + ((size_t)l * 8 + b) * 512 + hh * 64 + qd * 16 + tid0] = Car[tid0];
    __syncthreads();
}

constexpr int PL_UP = 0, PL_UPROW = 132 * 4, PL_P = 143 * PL_UPROW;
static_assert(PL_P % 16 == 0 && PL_P + 32768 <= RING_BYTES, "pool LDS map");
__device__ __forceinline__ void pool_prompt_item(KP a, Frame& F, int l, int b, int c, int g) {
    LAS unsigned char* L = F.lds;
    const int tid = F.tid, lane = F.lane, w = F.wave, fr = lane & 15, fq = lane >> 4;
    const int t0 = c * 128, win = 2 << g;
    const bf16* proj_seq = (const bf16*)(a->ws + WS_PROJ) + (size_t)b * 2048 * NPJ;
    const bf16* pwt = (const bf16*)(a->ws + WS_PWT) + ((size_t)l * 4 + g) * 128 * 128;
    bf16* mixb = (bf16*)(a->ws + WS_MIXB) + (size_t)b * 2048 * 2048 + 1024 + g * 128;
    {
        v4u ur[5];
#pragma unroll
        for (int k = 0; k < 5; ++k) { const int i = tid + k * NTHR, rr = i >> 4, c8 = i & 15, row = t0 + rr - 15; ur[k] = (v4u){0u, 0u, 0u, 0u};
            if (i < 143 * 16 && row >= 0) ur[k] = *(const GAS v4u*)(proj_seq + (size_t)row * NPJ + OFF_POOL + g * 128 + 8 * c8); }
#pragma unroll
        for (int k = 0; k < 5; ++k) { const int i = tid + k * NTHR, rr = i >> 4, c8 = i & 15; f32x4 v0, v1; cvt8(ur[k], v0, v1);
            if (i < 143 * 16) { *(LAS f32x4*)(L + PL_UP + rr * PL_UPROW + c8 * 32) = v0; *(LAS f32x4*)(L + PL_UP + rr * PL_UPROW + c8 * 32 + 16) = v1; } }
    }
    __syncthreads();
    for (int i = tid; i < 128 * 16; i += NTHR) { const int tok = i >> 4, c8 = i & 15;
        f32x4 s0 = (f32x4){0.f, 0.f, 0.f, 0.f}, s1 = s0;
        for (int j = 0; j < win; ++j) { const LAS unsigned char* p = L + PL_UP + (tok + 15 - j) * PL_UPROW + c8 * 32; s0 += *(const LAS f32x4*)p; s1 += *(const LAS f32x4*)(p + 16); }
        const int pos = t0 + tok; const float ic = 1.0f / (float)((pos + 1 < win) ? (pos + 1) : win);
        const LAS unsigned char* p = L + PL_UP + (tok + 15) * PL_UPROW + c8 * 32; const f32x4 u0 = *(const LAS f32x4*)p, u1 = *(const LAS f32x4*)(p + 16);
        s0 = s0 * ic - u0; s1 = s1 * ic - u1;
        v4u o; o.x = pk2h(s0.x, s0.y); o.y = pk2h(s0.z, s0.w); o.z = pk2h(s1.x, s1.y); o.w = pk2h(s1.z, s1.w);
        *(LAS v4u*)(L + PL_P + sw128(tok, c8)) = o; }
    __syncthreads();
    bf16x8 pa[4];
#pragma unroll
    for (int ks = 0; ks < 4; ++ks) pa[ks] = *(const LAS bf16x8*)(L + PL_P + sw128(16 * w + fr, 4 * ks + fq));
#pragma unroll
    for (int dt = 0; dt < 8; ++dt) { f32x4 acc = (f32x4){0.f, 0.f, 0.f, 0.f};
#pragma unroll
        for (int ks = 0; ks < 4; ++ks) { const bf16x8 wf = *(const bf16x8*)(pwt + (size_t)(16 * dt + fr) * 128 + 32 * ks + 8 * fq); acc = MFMA16(pa[ks], wf, acc); }
#pragma unroll
        for (int e = 0; e < 4; ++e) mixb[(size_t)(t0 + 16 * w + 4 * fq + e) * 2048 + 16 * dt + fr] = (bf16)f2bfh(acc[e]); }
    __syncthreads();
}

struct TI { const float* W; bf16* WT; const float* gain; int K, N, k0, n0, row_off, mode, goff, kd0; };
__device__ __forceinline__ void ti_load(const TI& t, f32x4 (&v)[8], float (&gn)[8], int lane) {
    const int nn = (lane & 7) * 4, kr = lane >> 3;
#pragma unroll
    for (int i = 0; i < 8; ++i) { const int kk = 8 * i + kr; v[i] = (f32x4){0.f, 0.f, 0.f, 0.f}; gn[i] = 1.f;
        if (t.n0 + nn + 4 <= t.N) v[i] = *(const f32x4*)(t.W + (size_t)(t.k0 + kk) * t.N + t.n0 + nn);
        if (t.gain) gn[i] = t.gain[t.k0 + kk - t.goff]; }
}
__device__ __forceinline__ void ti_store(const TI& t, const f32x4 (&v)[8], const float (&gn)[8], LAS float* scr, int lane) {
    const int nn = (lane & 7) * 4, kr = lane >> 3;
#pragma unroll
    for (int i = 0; i < 8; ++i) { const int kk = 8 * i + kr; f32x4 x = v[i] * gn[i];
        scr[kk * 33 + nn] = x.x; scr[kk * 33 + nn + 1] = x.y; scr[kk * 33 + nn + 2] = x.z; scr[kk * 33 + nn + 3] = x.w; }
    LDS_WAIT(); asm volatile("" ::: "memory");
    const int c = lane & 7;
#pragma unroll
    for (int j = 0; j < 4; ++j) { const int nl = (lane >> 3) + 8 * j, n = t.n0 + nl; const LAS float* sp = scr + (8 * c) * 33 + nl;
        v4u o; o.x = pk2h(sp[0 * 33], sp[1 * 33]); o.y = pk2h(sp[2 * 33], sp[3 * 33]); o.z = pk2h(sp[4 * 33], sp[5 * 33]); o.w = pk2h(sp[6 * 33], sp[7 * 33]);
        int dr;
        if (t.mode == 0) dr = t.row_off + n; else if (t.mode == 1) dr = n < 3072 ? n : (n < 3088 ? 4096 + (n - 3072) : n - 16); else dr = 256 * (n >> 7) + (n & 127) + t.row_off;
        if (n < t.N) *(GAS v4u*)(t.WT + (size_t)dr * t.K + t.kd0 + 8 * c) = o; }
    LDS_WAIT(); asm volatile("" ::: "memory");
}
__device__ __forceinline__ void ph_prologue(KP a, Frame& F) {
    LAS float* scr = (LAS float*)(F.lds + RING_OFF + F.wave * 16384);
    const int gw = F.bid * NWAVES + F.wave, NGW = F.G * NWAVES;
    bf16* Wkv = (bf16*)(a->ws + WS_WKV); bf16* Win = (bf16*)(a->ws + WS_WIN); bf16* Wout = (bf16*)(a->ws + WS_WOUT); bf16* Wq = (bf16*)(a->ws + WS_WQ); bf16* Wo = (bf16*)(a->ws + WS_WO);
    bf16* Wgu = (bf16*)(a->ws + WS_WGU); bf16* Wd = (bf16*)(a->ws + WS_WD);
    constexpr int I_IN = 16 * 129, I_OUT = 32 * 32, I_SQ = 16 * 32, I_G = 16 * 88, I_DN = 44 * 32;
    constexpr int PER_L = I_IN + I_OUT + 4 * I_SQ + 2 * I_G + I_DN;
    auto decode = [&](int it) -> TI {
        const int l = it / PER_L; int r = it % PER_L; TI t; t.goff = 0; t.row_off = 0; t.gain = nullptr; t.mode = 0;
        if (r < I_IN) { const int kb = r / 129, nb = r % 129; t.W = a->in[11] + (size_t)l * 1024 * NIN; t.K = 1024; t.N = NIN; t.k0 = 64 * kb; t.kd0 = 64 * kb; t.n0 = 32 * nb; t.WT = Win + (size_t)l * WIN_L; t.mode = 1; t.gain = a->in[10] + (size_t)l * 1024; return t; } r -= I_IN;
        if (r < I_OUT) { const int kb = r / 32, nb = r % 32; t.W = a->in[27] + (size_t)l * 2048 * 1024; t.K = 2048; t.N = 1024; t.k0 = 64 * kb; t.kd0 = 64 * kb; t.n0 = 32 * nb; t.WT = Wout + (size_t)l * WOUT_L; if (kb >= 8 && kb < 24) { t.gain = a->in[19] + (size_t)l * 1024; t.goff = 512; t.kd0 = 64 * (kb - 8); } else if (kb < 8) t.kd0 = 64 * (kb + 16); return t; } r -= I_OUT;
        if (r < I_SQ) { const int kb = r / 32, nb = r % 32; t.W = a->in[29] + (size_t)l * 1024 * 1024; t.K = 1024; t.N = 1024; t.k0 = 64 * kb; t.kd0 = 64 * kb; t.n0 = 32 * nb; t.WT = Wq + (size_t)l * WQ_L; t.gain = a->in[28] + (size_t)l * 1024; return t; } r -= I_SQ;
        if (r < I_SQ) { const int kb = r / 32, nb = r % 32; t.W = a->in[30] + (size_t)l * 1024 * 1024; t.K = 1024; t.N = 1024; t.k0 = 64 * kb; t.kd0 = 64 * kb; t.n0 = 32 * nb; t.WT = Wkv; t.row_off = l * 2048; return t; } r -= I_SQ;
        if (r < I_SQ) { const int kb = r / 32, nb = r % 32; t.W = a->in[31] + (size_t)l * 1024 * 1024; t.K = 1024; t.N = 1024; t.k0 = 64 * kb; t.kd0 = 64 * kb; t.n0 = 32 * nb; t.WT = Wkv; t.row_off = l * 2048 + 1024; return t; } r -= I_SQ;
        if (r < I_SQ) { const int kb = r / 32, nb = r % 32; t.W = a->in[32] + (size_t)l * 1024 * 1024; t.K = 1024; t.N = 1024; t.k0 = 64 * kb; t.kd0 = 64 * kb; t.n0 = 32 * nb; t.WT = Wo + (size_t)l * WQ_L; return t; } r -= I_SQ;
        if (r < I_G) { const int kb = r / 88, nb = r % 88; t.W = a->in[34] + (size_t)l * 1024 * DFF; t.K = 1024; t.N = DFF; t.k0 = 64 * kb; t.kd0 = 64 * kb; t.n0 = 32 * nb; t.WT = Wgu + (size_t)l * WGU_L; t.mode = 2; t.gain = a->in[33] + (size_t)l * 1024; return t; } r -= I_G;
        if (r < I_G) { const int kb = r / 88, nb = r % 88; t.W = a->in[35] + (size_t)l * 1024 * DFF; t.K = 1024; t.N = DFF; t.k0 = 64 * kb; t.kd0 = 64 * kb; t.n0 = 32 * nb; t.WT = Wgu + (size_t)l * WGU_L; t.mode = 2; t.row_off = 128; t.gain = a->in[33] + (size_t)l * 1024; return t; } r -= I_G;
        { const int kb = r / 32, nb = r % 32; t.W = a->in[36] + (size_t)l * DFF * 1024; t.K = DFF; t.N = 1024; t.k0 = 64 * kb; t.kd0 = 64 * kb; t.n0 = 32 * nb; t.WT = Wd + (size_t)l * WD_L; return t; }
    };
    if (gw < DEPTH * PER_L) {
        int it = gw; TI cur = decode(it); f32x4 v[8]; float gn[8]; ti_load(cur, v, gn, F.lane);
        for (;;) {
            const int nit = it + NGW; const bool has = nit < DEPTH * PER_L;
            TI nxt = cur; f32x4 vn[8]; float gnn[8];
            if (has) { nxt = decode(nit); ti_load(nxt, vn, gnn, F.lane); }
            ti_store(cur, v, gn, scr, F.lane);
            if (!has) break;
            cur = nxt; it = nit;
#pragma unroll
            for (int i = 0; i < 8; ++i) { v[i] = vn[i]; gn[i] = gnn[i]; }
        }
    }
    { bf16* pwt = (bf16*)(a->ws + WS_PWT);
      for (size_t i = (size_t)F.bid * NTHR + F.tid; i < (size_t)DEPTH * 4 * 128 * 128; i += (size_t)F.G * NTHR) { const int c = (int)(i & 127), d = (int)((i >> 7) & 127), lg = (int)(i >> 14);
          pwt[i] = (bf16)f2bfh(a->in[12][((size_t)lg * 128 + c) * 128 + d] * a->in[13][(size_t)lg * 128 + d]); } }
    const size_t gt = (size_t)F.bid * NTHR + F.tid, gs = (size_t)F.G * NTHR;
    { const f32x4* src = (const f32x4*)a->in[2]; unsigned long long* dst = (unsigned long long*)(a->ws + WS_MEMB);
      for (size_t i = gt; i < (size_t)2048 * 1024 / 4; i += gs) { const f32x4 v = src[i]; dst[i] = (unsigned long long)pk2h(v.x, v.y) | ((unsigned long long)pk2h(v.z, v.w) << 32); } }
    { bf16* hb = (bf16*)(a->ws + WS_HB); float* rss = (float*)(a->ws + WS_RSS);
      for (int r0 = gw; r0 < MT; r0 += 4 * NGW) {
          f32x4 v[4][4];
#pragma unroll
          for (int q = 0; q < 4; ++q) { const int r = r0 + q * NGW; const f32x4* src = (const f32x4*)((r < MP ? a->in[0] : a->in[1] - (size_t)MP * D) + (size_t)r * D);
#pragma unroll
              for (int j = 0; j < 4; ++j) v[q][j] = r < MT ? src[F.lane + 64 * j] : (f32x4){0.f, 0.f, 0.f, 0.f}; }
#pragma unroll
          for (int q = 0; q < 4; ++q) { const int r = r0 + q * NGW; float ss = 0.f;
              if (r < MT) {
#pragma unroll
                  for (int j = 0; j < 4; ++j) { const f32x4 x = v[q][j]; ss += x.x * x.x + x.y * x.y + x.z * x.z + x.w * x.w;
                      ((unsigned long long*)(hb + (size_t)r * D))[F.lane + 64 * j] = (unsigned long long)pk2h(x.x, x.y) | ((unsigned long long)pk2h(x.z, x.w) << 32); } }
              ss = wave_sum(ss);
              if (r < MT && F.lane < 16) rss[(size_t)r * 16 + F.lane] = F.lane == 0 ? ss : 0.f; } } }
}

__device__ __forceinline__ void ph_final_norm(Frame& F, const bf16* hb, const float* g, float* Y) {
    const int gw = F.bid * NWAVES + F.wave, NGW = F.G * NWAVES;
    f32x4 gg[4];
#pragma unroll
    for (int j = 0; j < 4; ++j) gg[j] = ((const f32x4*)g)[F.lane + 64 * j];
    for (int r0 = gw; r0 < MT; r0 += 4 * NGW) {
        unsigned long long u[4][4];
#pragma unroll
        for (int q = 0; q < 4; ++q) { const int r = r0 + q * NGW;
#pragma unroll
            for (int j = 0; j < 4; ++j) u[q][j] = r < MT ? ((const unsigned long long*)(hb + (size_t)r * D))[F.lane + 64 * j] : 0ull; }
#pragma unroll
        for (int q = 0; q < 4; ++q) { const int r = r0 + q * NGW; f32x4 v[4]; float ss = 0.f;
#pragma unroll
            for (int j = 0; j < 4; ++j) { const unsigned long long x = u[q][j];
                v[j] = (f32x4){bf2f((unsigned short)x), bf2f((unsigned short)(x >> 16)), bf2f((unsigned short)(x >> 32)), bf2f((unsigned short)(x >> 48))}; ss += v[j].x * v[j].x + v[j].y * v[j].y + v[j].z * v[j].z + v[j].w * v[j].w; }
            ss = wave_sum(ss);
            const float rstd = 1.0f / sqrtf(ss * (1.0f / D) + EPS);
            if (r < MT) {
#pragma unroll
                for (int j = 0; j < 4; ++j) ((f32x4*)(Y + (size_t)r * D))[F.lane + 64 * j] = v[j] * rstd * gg[j]; } }
    }
}

__device__ __forceinline__ float pool_up(const bf16* proj, const float* st_in, const SeqInfo& q, int ci, int ch) {
    if (ci < 15) return q.grp ? st_in[((size_t)q.b * 15 + ci) * 512 + ch] : 0.f;
    return bf2f(proj[(size_t)(q.row0 + ci - 15) * NPJ + OFF_POOL + ch]);
}
__device__ __forceinline__ float conv_xp(const bf16* proj, int off, const float* st_in, int C, const SeqInfo& q, int j, int c) {
    if (j < 3) return q.grp ? st_in[((size_t)q.b * 3 + j) * C + c] : 0.f;
    return bf2f(proj[(size_t)(q.row0 + j - 3) * NPJ + off + c]);
}
__device__ __forceinline__ void conv_states(size_t gt, size_t gs, const bf16* proj, int off, int C, const float* st_in, float* p_out, float* s_out) {
    for (size_t idx = gt; idx < (size_t)NSEQ * 3 * C; idx += gs) {
        const int c = (int)(idx % C), j = (int)((idx / C) % 3), s = (int)(idx / ((size_t)3 * C));
        const SeqInfo q = seq_info(s);
        const float v = conv_xp(proj, off, st_in, C, q, q.L + j, c);
        if (q.grp) s_out[((size_t)q.b * 3 + j) * C + c] = v; else p_out[((size_t)q.b * 3 + j) * C + c] = v;
    }
}
constexpr int SS_X = 0, SS_BC = 8192, SS_DT = 12288;
__device__ __forceinline__ void samp_ssd_item(KP a, Frame& F, int l, int b, int g) {
    LAS float* XS = (LAS float*)(F.lds + RING_OFF + SS_X); LAS float* BC = (LAS float*)(F.lds + RING_OFF + SS_BC); LAS float* DTs = (LAS float*)(F.lds + RING_OFF + SS_DT);
    const int tid = F.tid;
    const bf16* proj = (const bf16*)(a->ws + WS_PROJ) + (size_t)(MP + 4 * b) * NPJ; const float* dtr = (const float*)(a->ws + WS_DT) + (size_t)(MP + 4 * b) * 16;
    const float* cst = a->in[4] + ((size_t)l * 128 + b) * 3 * 1536; const float* cw = a->in[14] + (size_t)l * 4 * 1536; const float* cb = a->in[15] + (size_t)l * 1536;
    bf16* mixb = (bf16*)(a->ws + WS_MIXB) + (size_t)(MP + 4 * b) * 2048;
#pragma unroll
    for (int rep = 0; rep < 2; ++rep) {
        if (rep == 1 && tid >= 256) break;
        const int sc = rep == 0 ? g * 512 + tid : (tid < 128 ? 1024 + g * 128 + tid : 1280 + g * 128 + (tid - 128));
        float xp[7];
#pragma unroll
        for (int j = 0; j < 3; ++j) xp[j] = cst[(size_t)j * 1536 + sc];
#pragma unroll
        for (int t = 0; t < 4; ++t) xp[3 + t] = bf2f(proj[(size_t)t * NPJ + OFF_XBC + sc]);
        const float w0 = cw[sc], w1 = cw[1536 + sc], w2 = cw[2 * 1536 + sc], w3 = cw[3 * 1536 + sc], bb = cb[sc];
#pragma unroll
        for (int t = 0; t < 4; ++t) { const float v = fsilu(bb + w0 * xp[t] + w1 * xp[t + 1] + w2 * xp[t + 2] + w3 * xp[t + 3]); if (rep == 0) XS[t * 512 + tid] = v; else BC[t * 256 + tid] = v; }
    }
    if (tid < 32) { const int t = tid >> 3, k = tid & 7, hd = 8 * g + k; const float dt = softplus_f(dtr[(size_t)t * 16 + hd] + a->in[16][l * 16 + hd]); DTs[t * 8 + k] = dt; DTs[32 + t * 8 + k] = expf(dt * -expf(a->in[17][l * 16 + hd])); }
    __syncthreads();
    const int p = tid >> 3, ng = tid & 7;
    const float* st_in = a->in[5] + (((size_t)l * 128 + b) * 16 + 8 * g) * 64 * 128 + (size_t)p * 128 + ng * 16;
    float* st_out = a->out + O_SSSD + (((size_t)l * 128 + b) * 16 + 8 * g) * 64 * 128 + (size_t)p * 128 + ng * 16;
    f32x4 hn[4];
#pragma unroll
    for (int i = 0; i < 4; ++i) hn[i] = *(const f32x4*)(st_in + 4 * i);
#pragma unroll 1
    for (int k = 0; k < 8; ++k) {
        f32x4 h[4];
#pragma unroll
        for (int i = 0; i < 4; ++i) h[i] = hn[i];
        if (k + 1 < 8) {
#pragma unroll
            for (int i = 0; i < 4; ++i) hn[i] = *(const f32x4*)(st_in + (size_t)(k + 1) * 64 * 128 + 4 * i); }
        const int hd = 8 * g + k; const float Dk = a->in[18][l * 16 + hd];
        float zv[4];
#pragma unroll
        for (int t = 0; t < 4; ++t) zv[t] = bf2f(proj[(size_t)t * NPJ + OFF_Z + hd * 64 + p]);
#pragma unroll
        for (int t = 0; t < 4; ++t) {
            const float dt = DTs[t * 8 + k], dA = DTs[32 + t * 8 + k], x = XS[t * 512 + k * 64 + p], xdt = dt * x;
            float part = 0.f;
#pragma unroll
            for (int i = 0; i < 4; ++i) { const f32x4 Bv = *(const LAS f32x4*)(BC + t * 256 + ng * 16 + 4 * i), Cv = *(const LAS f32x4*)(BC + t * 256 + 128 + ng * 16 + 4 * i);
                h[i] = h[i] * dA + Bv * xdt; part += (Cv.x * h[i].x + Cv.y * h[i].y) + (Cv.z * h[i].z + Cv.w * h[i].w); }
            part += __shfl_xor(part, 1); part += __shfl_xor(part, 2); part += __shfl_xor(part, 4);
            if (ng == 0) mixb[(size_t)t * 2048 + hd * 64 + p] = (bf16)f2bfh((part + Dk * x) * fsilu(zv[t]));
        }
#pragma unroll
        for (int i = 0; i < 4; ++i) *(f32x4*)(st_out + (size_t)k * 64 * 128 + 4 * i) = h[i];
    }
    __syncthreads();
}
__device__ __forceinline__ void samp_lru_item(KP a, Frame& F, int l, int b) {
    LAS float* XC = (LAS float*)(F.lds + RING_OFF);
    const int c = F.tid, hd = c >> 6, j = c & 63;
    const bf16* proj = (const bf16*)(a->ws + WS_PROJ) + (size_t)(MP + 4 * b) * NPJ;
    const float* cst = a->in[6] + ((size_t)l * 128 + b) * 3 * 512; const float* cw = a->in[20] + (size_t)l * 4 * 512;
    float xp[7];
#pragma unroll
    for (int k = 0; k < 3; ++k) xp[k] = cst[(size_t)k * 512 + c];
#pragma unroll
    for (int t = 0; t < 4; ++t) xp[3 + t] = bf2f(proj[(size_t)t * NPJ + OFF_LRU + c]);
    const float w0 = cw[c], w1 = cw[512 + c], w2 = cw[1024 + c], w3 = cw[1536 + c], bb = a->in[21][(size_t)l * 512 + c];
    float xc[4];
#pragma unroll
    for (int t = 0; t < 4; ++t) { xc[t] = bb + w0 * xp[t] + w1 * xp[t + 1] + w2 * xp[t + 2] + w3 * xp[t + 3]; XC[t * 512 + c] = xc[t]; }
    __syncthreads();
    const float* wa = a->in[22] + ((size_t)l * 8 + hd) * 64 * 64 + j; const float* wx = a->in[24] + ((size_t)l * 8 + hd) * 64 * 64 + j;
    float ar[4], ai[4];
#pragma unroll
    for (int t = 0; t < 4; ++t) { ar[t] = a->in[23][(size_t)l * 512 + c]; ai[t] = a->in[25][(size_t)l * 512 + c]; }
#pragma unroll 16
    for (int i = 0; i < 64; ++i) { const float wav = wa[(size_t)i * 64], wxv = wx[(size_t)i * 64];
#pragma unroll
        for (int t = 0; t < 4; ++t) { const float xv = XC[t * 512 + hd * 64 + i]; ar[t] += xv * wav; ai[t] += xv * wxv; } }
    const float lamv = a->in[26][(size_t)l * 512 + c]; const float spv = -8.0f * softplus_f(-lamv);
    float h = a->in[7][((size_t)l * 128 + b) * 512 + c];
    bf16* mixb = (bf16*)(a->ws + WS_MIXB) + (size_t)(MP + 4 * b) * 2048 + 1536 + c;
#pragma unroll
    for (int t = 0; t < 4; ++t) { const float rg = sigmoid_f(ar[t]), ig = sigmoid_f(ai[t]); const float log_a = spv * rg; const float av = expf(log_a), mult = sqrtf(-expm1f(2.0f * log_a));
        h = av * h + mult * ig * xc[t];
        mixb[(size_t)t * 2048] = (bf16)f2bfh(h * gelu_tanh_f(bf2f(proj[(size_t)t * NPJ + OFF_GATE + c]))); }
    a->out[O_SLRU + ((size_t)l * 128 + b) * 512 + c] = h;
    __syncthreads();
}
__device__ __forceinline__ void samp_pool_item(KP a, Frame& F, int l, int b) {
    LAS float* PO = (LAS float*)(F.lds + RING_OFF);
    const int ch = F.tid, g = ch >> 7, w = 2 << g;
    const bf16* proj = (const bf16*)(a->ws + WS_PROJ) + (size_t)(MP + 4 * b) * NPJ;
    const float* st = a->in[3] + ((size_t)l * 128 + b) * 15 * 512;
    float up[19];
#pragma unroll
    for (int i = 0; i < 15; ++i) up[i] = st[(size_t)i * 512 + ch];
#pragma unroll
    for (int t = 0; t < 4; ++t) up[15 + t] = bf2f(proj[(size_t)t * NPJ + OFF_POOL + ch]);
    const float iw = 1.0f / (float)w;
#pragma unroll
    for (int t = 0; t < 4; ++t) { float sm = 0.f;
#pragma unroll
        for (int jj = 0; jj < 16; ++jj) sm += (jj < w) ? up[15 + t - jj] : 0.f;
        PO[t * 512 + ch] = sm * iw - up[15 + t]; }
    __syncthreads();
    const int d = ch & 127; const float* pw = a->in[12] + ((size_t)l * 4 + g) * 128 * 128 + d; const float sc = a->in[13][(size_t)l * 512 + ch];
    float acc[4] = {0.f, 0.f, 0.f, 0.f};
#pragma unroll 16
    for (int cc = 0; cc < 128; ++cc) { const float wv = pw[(size_t)cc * 128];
#pragma unroll
        for (int t = 0; t < 4; ++t) acc[t] += PO[t * 512 + g * 128 + cc] * wv; }
    bf16* mixb = (bf16*)(a->ws + WS_MIXB) + (size_t)(MP + 4 * b) * 2048 + 1024 + ch;
#pragma unroll
    for (int t = 0; t < 4; ++t) mixb[(size_t)t * 2048] = (bf16)f2bfh(acc[t] * sc);
    __syncthreads();
}

__device__ __forceinline__ void ph_mix1(KP a, Frame& F, int l) {
    const size_t gt = (size_t)F.bid * NTHR + F.tid, gs = (size_t)F.G * NTHR;
    const bf16* proj = (const bf16*)(a->ws + WS_PROJ);
    {
        const float* st_in = a->in[3] + (size_t)l * 128 * 15 * 512;
        float* p_out = a->out + O_PPOOL + (size_t)l * 8 * 15 * 512; float* s_out = a->out + O_SPOOL + (size_t)l * 128 * 15 * 512;
        for (size_t idx = gt; idx < (size_t)NSEQ * 15 * 512; idx += gs) {
            const int ch = (int)(idx & 511), j = (int)((idx >> 9) % 15), s = (int)((idx >> 9) / 15);
            const SeqInfo q = seq_info(s);
            const float v = pool_up(proj, st_in, q, q.L + j, ch);
            if (q.grp) s_out[((size_t)q.b * 15 + j) * 512 + ch] = v; else p_out[((size_t)q.b * 15 + j) * 512 + ch] = v;
        }
    }
    conv_states(gt, gs, proj, OFF_XBC, 1536, a->in[4] + (size_t)l * 128 * 3 * 1536, a->out + O_PSCONV + (size_t)l * 8 * 3 * 1536, a->out + O_SSCONV + (size_t)l * 128 * 3 * 1536);
    conv_states(gt, gs, proj, OFF_LRU, 512, a->in[6] + (size_t)l * 128 * 3 * 512, a->out + O_PLCONV + (size_t)l * 8 * 3 * 512, a->out + O_SLCONV + (size_t)l * 128 * 3 * 512);
    __syncthreads();
    { const KP kp = a; (void)kp;
    REG_BEGIN(0);
    for (int it = F.vcu; it < 256; it += F.G) ssd_prompt_item(a, F, l, it >> 5, (it >> 1) & 15, it & 1);
    REG_END(0); REG_BEGIN(1);
    for (int it = F.vcu; it < 256; it += F.G) lru_prompt_item(a, F, l, it >> 5, (it >> 2) & 7, it & 3);
    REG_END(1); }
    for (int it = F.vcu; it < 512; it += F.G) pool_prompt_item(a, F, l, it >> 6, (it >> 2) & 15, it & 3);
    for (int it = F.bid; it < 256; it += F.G) samp_ssd_item(a, F, l, it >> 1, it & 1);
    for (int it = F.bid; it < 256; it += F.G) { if (it < 128) samp_lru_item(a, F, l, it); else samp_pool_item(a, F, l, it - 128); }
}
__device__ __forceinline__ void ph_mix3(KP a, Frame& F, int l) {
    bf16* mixb = (bf16*)(a->ws + WS_MIXB);
    const int gw = F.bid * NWAVES + F.wave, NGW = F.G * NWAVES;
    for (int r = gw; r < MP; r += NGW) {
        const float* sp = (const float*)(a->ws + WS_SSDSS) + (size_t)r * 32;
        float ss = F.lane < 32 ? sp[F.lane] : 0.f; ss = wave_sum(ss);
        const float rstd = 1.0f / sqrtf(ss * (1.0f / 1024.f) + EPS);
#pragma unroll
        for (int j = 0; j < 4; ++j) { const int c = 4 * F.lane + 256 * j; unsigned long long* mp = (unsigned long long*)(mixb + (size_t)r * 2048 + 512 + c); const unsigned long long u = *mp;
            const float w0 = bf2f((unsigned short)u) * rstd, w1 = bf2f((unsigned short)(u >> 16)) * rstd, w2 = bf2f((unsigned short)(u >> 32)) * rstd, w3 = bf2f((unsigned short)(u >> 48)) * rstd;
            *mp = (unsigned long long)pk2h(w0, w1) | ((unsigned long long)pk2h(w2, w3) << 32); }
    }
}
constexpr int SG_PSTRIDE = 36, SG_P = 0, SG_SS = 8 * 64 * SG_PSTRIDE * 4;
static_assert(SG_SS + 8 * 64 * 4 <= RING_BYTES, "small gemm LDS map");
__device__ __forceinline__ float sumsq8(bf16x8 v) { float s = 0.f;
#pragma unroll
    for (int j = 0; j < 8; ++j) { const float x = bf2f((unsigned short)v[j]); s += x * x; } return s; }
template <int K, int STATS  , class Epi>
__device__ __forceinline__ void small_gemm(Frame& F, const bf16* A, const bf16* Bt, int it0, int it1, const Epi& E) {
    constexpr int KW = K / 8, KS = KW / 32;
    constexpr bool REUSE = Epi::RT_SLOW && K == 1024;
    static_assert(K % 256 == 0, "K splits into eight 32-multiples");
    LAS float* P = (LAS float*)(F.lds + RING_OFF + SG_P); LAS float* SS = (LAS float*)(F.lds + RING_OFF + SG_SS);
    const int w = F.wave;
    bf16x8 afr[REUSE ? KS : 1][4]; float ssqr[4] = {0.f, 0.f, 0.f, 0.f}; int rt_have = -1;
    for (int it = it0; it < it1; ++it) {
        int tid = F.tid; asm volatile("" : "+v"(tid));
        const int lane = tid & 63, fr = lane & 15, fq = lane >> 4;
        const int rt = Epi::RT_SLOW ? it / E.nctl : (it & 7), ct = Epi::RT_SLOW ? E.ct0 + it % E.nctl : (it >> 3);
        if (Epi::RT_SLOW && ct >= Epi::NCT) continue;
        int nb0, nb1; E.bases(ct, nb0, nb1);
        const bf16* Ap = A + (size_t)(64 * rt + fr) * K + w * KW + 8 * fq;
        const bf16* Bp0 = Bt + (size_t)(nb0 + fr) * K + w * KW + 8 * fq; const bf16* Bp1 = Bt + (size_t)(nb1 + fr) * K + w * KW + 8 * fq;
        f32x4 acc[4][2]; float ssq[4];
#pragma unroll
        for (int mt = 0; mt < 4; ++mt) { acc[mt][0] = (f32x4){0.f, 0.f, 0.f, 0.f}; acc[mt][1] = (f32x4){0.f, 0.f, 0.f, 0.f}; ssq[mt] = 0.f; }
        if constexpr (REUSE) {
            bf16x8 bq[KS][2];
#pragma unroll
            for (int ks = 0; ks < KS; ++ks) { bq[ks][0] = *(const bf16x8*)(Bp0 + 32 * ks); bq[ks][1] = *(const bf16x8*)(Bp1 + 32 * ks); }
            if (rt != rt_have) {
#pragma unroll
                for (int ks = 0; ks < KS; ++ks)
#pragma unroll
                    for (int mt = 0; mt < 4; ++mt) afr[ks][mt] = *(const bf16x8*)(Ap + (size_t)mt * 16 * K + 32 * ks);
#pragma unroll
                for (int mt = 0; mt < 4; ++mt) { float sv = 0.f;
#pragma unroll
                    for (int ks = 0; ks < KS; ++ks) sv += sumsq8(afr[ks][mt]);
                    ssqr[mt] = sv; }
                rt_have = rt;
            }
#pragma unroll
            for (int ks = 0; ks < KS; ++ks)
#pragma unroll
                for (int mt = 0; mt < 4; ++mt) { acc[mt][0] = MFMA16(afr[ks][mt], bq[ks][0], acc[mt][0]); acc[mt][1] = MFMA16(afr[ks][mt], bq[ks][1], acc[mt][1]); }
#pragma unroll
            for (int mt = 0; mt < 4; ++mt) ssq[mt] = ssqr[mt];
        } else {
#pragma unroll
            for (int ks = 0; ks < KS; ++ks) {
                bf16x8 af[4];
#pragma unroll
                for (int mt = 0; mt < 4; ++mt) af[mt] = *(const bf16x8*)(Ap + (size_t)mt * 16 * K + 32 * ks);
                const bf16x8 b0 = *(const bf16x8*)(Bp0 + 32 * ks), b1 = *(const bf16x8*)(Bp1 + 32 * ks);
#pragma unroll
                for (int mt = 0; mt < 4; ++mt) { acc[mt][0] = MFMA16(af[mt], b0, acc[mt][0]); acc[mt][1] = MFMA16(af[mt], b1, acc[mt][1]); if (STATS == 1 || (STATS == 2 && w < 4)) ssq[mt] += sumsq8(af[mt]); }
            }
        }
#pragma unroll
        for (int mt = 0; mt < 4; ++mt) {
#pragma unroll
            for (int nt = 0; nt < 2; ++nt)
#pragma unroll
                for (int e = 0; e < 4; ++e) P[(w * 64 + 16 * mt + 4 * fq + e) * SG_PSTRIDE + 16 * nt + fr] = acc[mt][nt][e];
            if (STATS) { float sv = ssq[mt]; sv += __shfl_xor(sv, 16); sv += __shfl_xor(sv, 32); if (fq == 0) SS[w * 64 + 16 * mt + fr] = sv; }
        }
        __syncthreads();
        {
            const int row = tid >> 3, cq = tid & 7;
            f32x4 v = (f32x4){0.f, 0.f, 0.f, 0.f}, v2 = v;
            float rstd = 1.f;
            if (STATS) { float sm = 0.f;
#pragma unroll
                for (int ww = 0; ww < 8; ++ww) sm += SS[ww * 64 + row];
                rstd = 1.0f / sqrtf(sm * (1.0f / 1024.f) + EPS); }
#pragma unroll
            for (int ww = 0; ww < 8; ++ww) { const float sc = (STATS == 2 && ww < 4) ? rstd : 1.f;
                v += *(const LAS f32x4*)(P + (ww * 64 + row) * SG_PSTRIDE + 4 * cq) * sc; if (Epi::PAIR) v2 += *(const LAS f32x4*)(P + (ww * 64 + row) * SG_PSTRIDE + 4 * (cq ^ 4)); }
            if (STATS == 2) rstd = 1.f;
            E.store(ct, MP + 64 * rt + row, cq, v, v2, rstd);
        }
        __syncthreads();
    }
}
struct SProj {
    static constexpr bool PAIR = false, RT_SLOW = true; static constexpr int NCT = 129; bf16* proj; float* dtr; int ct0, nctl;
    __device__ __forceinline__ void bases(int ct, int& nb0, int& nb1) const { nb0 = 32 * ct; nb1 = nb0 + 16; }
    __device__ __forceinline__ void store(int ct, int row, int cq, f32x4 v, f32x4, float rstd) const { const int j = 32 * ct + 4 * cq; const f32x4 o = v * rstd;
        if (j < 4096) *(unsigned long long*)(proj + (size_t)row * NPJ + j) = (unsigned long long)pk2h(o.x, o.y) | ((unsigned long long)pk2h(o.z, o.w) << 32);
        else if (j < 4112) *(f32x4*)(dtr + (size_t)row * 16 + (j - 4096)) = o; }
};
struct SResid {
    static constexpr bool PAIR = false, RT_SLOW = false; static constexpr int NCT = 32, ct0 = 0, nctl = 1; bf16* hb;
    __device__ __forceinline__ void bases(int ct, int& nb0, int& nb1) const { nb0 = 32 * ct; nb1 = nb0 + 16; }
    __device__ __forceinline__ void store(int ct, int row, int cq, f32x4 v, f32x4, float) const { const int c = 32 * ct + 4 * cq; unsigned long long* hp = (unsigned long long*)(hb + (size_t)row * 1024 + c); const unsigned long long u = *hp;
        const float o0 = bf2f((unsigned short)u) + v.x, o1 = bf2f((unsigned short)(u >> 16)) + v.y, o2 = bf2f((unsigned short)(u >> 32)) + v.z, o3 = bf2f((unsigned short)(u >> 48)) + v.w;
        *hp = (unsigned long long)pk2h(o0, o1) | ((unsigned long long)pk2h(o2, o3) << 32); }
};
struct SQ {
    static constexpr bool PAIR = false, RT_SLOW = false; static constexpr int NCT = 32, ct0 = 0, nctl = 1; bf16* qb; float scale;
    __device__ __forceinline__ void bases(int ct, int& nb0, int& nb1) const { nb0 = 32 * ct; nb1 = nb0 + 16; }
    __device__ __forceinline__ void store(int ct, int row, int cq, f32x4 v, f32x4, float rstd) const { const int c = 32 * ct + 4 * cq; const f32x4 o = v * (rstd * scale);
        *(unsigned long long*)(qb + (size_t)row * 1024 + c) = (unsigned long long)pk2h(o.x, o.y) | ((unsigned long long)pk2h(o.z, o.w) << 32); }
};
struct SSwiGLU {
    static constexpr bool PAIR = true, RT_SLOW = true; static constexpr int NCT = 176; bf16* act; int ct0, nctl;
    __device__ __forceinline__ void bases(int ct, int& nb0, int& nb1) const { nb0 = 256 * (ct >> 3) + 16 * (ct & 7); nb1 = nb0 + 128; }
    __device__ __forceinline__ void store(int ct, int row, int cq, f32x4 g, f32x4 u, float rstd) const { if (cq < 4) { const int c = 128 * (ct >> 3) + 16 * (ct & 7) + 4 * cq; const f32x4 gs = g * rstd, us = u * rstd;
        *(unsigned long long*)(act + (size_t)row * DFF + c) = (unsigned long long)pk2h(fsilu(gs.x) * us.x, fsilu(gs.y) * us.y) | ((unsigned long long)pk2h(fsilu(gs.z) * us.z, fsilu(gs.w) * us.w) << 32); } }
};
__device__ __forceinline__ void dt_gemm(Frame& F, const bf16* hb, const bf16* Wdt, const float* rss, float* dtr) {
    for (int it = F.bid; it < MP / 128; it += F.G) {
        int tid = F.tid; asm volatile("" : "+v"(tid)); const int lane = tid & 63, fr = lane & 15, fq = lane >> 4;
        const int row0 = it * 128 + 16 * F.wave;
        f32x4 acc = (f32x4){0.f, 0.f, 0.f, 0.f};
#pragma unroll 8
        for (int ks = 0; ks < 32; ++ks) { const bf16x8 af = *(const bf16x8*)(hb + (size_t)(row0 + fr) * 1024 + 32 * ks + 8 * fq); const bf16x8 bfm = *(const bf16x8*)(Wdt + (size_t)fr * 1024 + 32 * ks + 8 * fq); acc = MFMA16(af, bfm, acc); }
#pragma unroll
        for (int e = 0; e < 4; ++e) { const int row = row0 + 4 * fq + e; const f32x4* rp = (const f32x4*)(rss + (size_t)row * 16); const f32x4 p0 = rp[0], p1 = rp[1], p2 = rp[2], p3 = rp[3];
            const float sm = ((p0.x + p0.y) + (p0.z + p0.w)) + ((p1.x + p1.y) + (p1.z + p1.w)) + ((p2.x + p2.y) + (p2.z + p2.w)) + ((p3.x + p3.y) + (p3.z + p3.w));
            dtr[(size_t)row * 16 + fr] = acc[e] * (1.0f / sqrtf(sm * (1.0f / 1024.f) + EPS)); }
    }
}

__device__ __forceinline__ void attn_prompt_unit(Frame& F, const bf16* qb, const bf16* kb_l, const bf16* vt_l, bf16* ob, int b, int hh, int qt) {
    LAS unsigned char* lds = F.lds + RING_OFF;
    const int lane = F.lane, fr = lane & 15, fq = lane >> 4, tid = F.tid;
    const int r0 = b * 2048 + qt * 256 + F.wave * 32;
    const bf16* kbase = kb_l + (size_t)(b * 256) * 1024 + hh * 256; const bf16* vbase = vt_l + (size_t)(hh * 256) * 2048 + b * 256;
    v4u rg[8];
#define ATT_LOAD(base, pitch, half) do { const bf16* tb_ = (base); asm volatile("" : "+s"(tb_)); tb_ += (size_t)((half) * 128 + (tid >> 5)) * (pitch) + (tid & 31) * 8; \
        _Pragma("unroll") for (int ps = 0; ps < 8; ++ps) rg[ps] = *(const GAS v4u*)(tb_ + (size_t)ps * 16 * (pitch)); } while (0)
#define ATT_STORE(bufoff) do { LAS unsigned char* lb_ = lds + (bufoff) + (tid >> 5) * 512 + (((tid & 31) ^ ((tid >> 5) & 15)) << 4); \
        _Pragma("unroll") for (int ps = 0; ps < 8; ++ps) *(LAS v4u*)(lb_ + ps * 8192) = rg[ps]; } while (0)
    ATT_LOAD(kbase, 1024, 0); ATT_STORE(0);
    ATT_LOAD(kbase, 1024, 1); ATT_STORE(65536);
    LBAR();
    bf16x8 pf[2][8]; float inv[2];
#pragma unroll
    for (int mt = 0; mt < 2; ++mt) {
        __builtin_amdgcn_sched_barrier(0);
        bf16x8 qf[8];
#pragma unroll
        for (int ks = 0; ks < 8; ++ks) qf[ks] = *(const bf16x8*)(qb + (size_t)(r0 + mt * 16 + fr) * 1024 + hh * 256 + ks * 32 + fq * 8);
        f32x4 s[16];
#pragma unroll
        for (int kt = 0; kt < 16; ++kt) { s[kt] = (f32x4){0.f, 0.f, 0.f, 0.f};
#pragma unroll
            for (int kh = 0; kh < 2; ++kh) { bf16x8 kf[4];
#pragma unroll
                for (int ks = 0; ks < 4; ++ks) kf[ks] = *(const LAS bf16x8*)(lds + (16 * kt + fr) * 512 + (((4 * (4 * kh + ks) + fq) ^ fr) << 4));
#pragma unroll
                for (int ks = 0; ks < 4; ++ks) s[kt] = MFMA16(kf[ks], qf[4 * kh + ks], s[kt]);
                __builtin_amdgcn_sched_barrier(0); } }
        float m = -3.0e38f;
#pragma unroll
        for (int kt = 0; kt < 16; ++kt) m = fmaxf(fmaxf(fmaxf(s[kt][0], s[kt][1]), fmaxf(s[kt][2], s[kt][3])), m);
        m = fmaxf(m, __shfl_xor(m, 16)); m = fmaxf(m, __shfl_xor(m, 32));
        float sum = 0.f;
#pragma unroll
        for (int kt = 0; kt < 16; ++kt)
#pragma unroll
            for (int e = 0; e < 4; ++e) { const float p = __builtin_amdgcn_exp2f(s[kt][e] - m); s[kt][e] = p; sum += p; }
        sum += __shfl_xor(sum, 16); sum += __shfl_xor(sum, 32);
        inv[mt] = 1.0f / sum;
#pragma unroll
        for (int ks = 0; ks < 8; ++ks) { v4u w; w.x = pk2h(s[2 * ks][0], s[2 * ks][1]); w.y = pk2h(s[2 * ks][2], s[2 * ks][3]);
            w.z = pk2h(s[2 * ks + 1][0], s[2 * ks + 1][1]); w.w = pk2h(s[2 * ks + 1][2], s[2 * ks + 1][3]); pf[mt][ks] = __builtin_bit_cast(bf16x8, w); }
        __builtin_amdgcn_sched_barrier(0);
    }
    LBAR();
    ATT_LOAD(vbase, 2048, 0); ATT_STORE(0); ATT_LOAD(vbase, 2048, 1); ATT_STORE(65536);
    LBAR();
#pragma unroll
    for (int qr = 0; qr < 4; ++qr) {
        const int bo = (qr >> 1) * 65536;
        f32x4 o[2][4];
#pragma unroll
        for (int dl = 0; dl < 4; ++dl) { o[0][dl] = (f32x4){0.f, 0.f, 0.f, 0.f}; o[1][dl] = (f32x4){0.f, 0.f, 0.f, 0.f};
#pragma unroll
            for (int kh = 0; kh < 2; ++kh) { bf16x8 vf[4];
#pragma unroll
                for (int ks = 0; ks < 4; ++ks) vf[ks] = *(const LAS bf16x8*)(lds + bo + (16 * ((qr & 1) * 4 + dl) + fr) * 512 + (((4 * (4 * kh + ks) + fq) ^ fr) << 4));
#pragma unroll
                for (int ks = 0; ks < 4; ++ks) { o[0][dl] = MFMA16(vf[ks], pf[0][4 * kh + ks], o[0][dl]); o[1][dl] = MFMA16(vf[ks], pf[1][4 * kh + ks], o[1][dl]); }
                __builtin_amdgcn_sched_barrier(0); } }
#pragma unroll
        for (int mt = 0; mt < 2; ++mt)
#pragma unroll
            for (int dl = 0; dl < 4; ++dl) { const f32x4 v = o[mt][dl] * inv[mt];
                *(unsigned long long*)(ob + (size_t)(r0 + mt * 16 + fr) * 1024 + hh * 256 + 16 * (qr * 4 + dl) + 4 * fq) = (unsigned long long)pk2h(v[0], v[1]) | ((unsigned long long)pk2h(v[2], v[3]) << 32); }
        __builtin_amdgcn_sched_barrier(0);
    }
#undef ATT_LOAD
#undef ATT_STORE
    __syncthreads();
}
__device__ __forceinline__ void attn_sample_item(Frame& F, const bf16* qb, const float* Ks_l, const float* Vs_l, bf16* ob, int b, int hh) {
    LAS float* Sl = (LAS float*)(F.lds + RING_OFF);
    LAS float* Ol = (LAS float*)(F.lds + RING_OFF + 4096);
    const int lane = F.lane, w = F.wave, d4 = 4 * lane;
    const float* Kb = Ks_l + (size_t)b * 256 * 1024 + hh * 256 + d4;
    const float* Vb = Vs_l + (size_t)b * 256 * 1024 + hh * 256 + d4;
    f32x4 q[4];
#pragma unroll
    for (int t = 0; t < 4; ++t) { const unsigned long long u = *(const unsigned long long*)(qb + (size_t)(MP + 4 * b + t) * 1024 + hh * 256 + d4);
        q[t] = (f32x4){bf2f((unsigned short)u), bf2f((unsigned short)(u >> 16)), bf2f((unsigned short)(u >> 32)), bf2f((unsigned short)(u >> 48))}; }
#pragma unroll
    for (int bt = 0; bt < 2; ++bt) {
        f32x4 kv[16];
#pragma unroll
        for (int kk = 0; kk < 16; ++kk) kv[kk] = *(const f32x4*)(Kb + (size_t)(32 * w + 16 * bt + kk) * 1024);
        float v[64];
#pragma unroll
        for (int kk = 0; kk < 16; ++kk)
#pragma unroll
            for (int t = 0; t < 4; ++t) v[kk * 4 + t] = kv[kk].x * q[t].x + kv[kk].y * q[t].y + kv[kk].z * q[t].z + kv[kk].w * q[t].w;
#pragma unroll
        for (int mk = 32, n = 32; mk >= 1; mk >>= 1, n >>= 1) {
            const bool up = (lane & mk) != 0;
#pragma unroll
            for (int i = 0; i < n; ++i) { const float lo = v[i], hi = v[i + n]; const float send = up ? lo : hi, keep = up ? hi : lo; v[i] = keep + __shfl_xor(send, mk); }
        }
        Sl[(lane & 3) * 256 + 32 * w + 16 * bt + (lane >> 2)] = v[0];
    }
    __syncthreads();
    if (w < 4) {
        float x[4];
#pragma unroll
        for (int j = 0; j < 4; ++j) x[j] = Sl[w * 256 + lane + 64 * j];
        const float m = wave_max(fmaxf(fmaxf(x[0], x[1]), fmaxf(x[2], x[3])));
        float sum = 0.f;
#pragma unroll
        for (int j = 0; j < 4; ++j) { x[j] = __builtin_amdgcn_exp2f(x[j] - m); sum += x[j]; }
        sum = wave_sum(sum);
        const float inv = 1.0f / sum;
#pragma unroll
        for (int j = 0; j < 4; ++j) Sl[w * 256 + lane + 64 * j] = x[j] * inv;
    }
    __syncthreads();
    f32x4 acc[4];
#pragma unroll
    for (int t = 0; t < 4; ++t) acc[t] = (f32x4){0.f, 0.f, 0.f, 0.f};
#pragma unroll
    for (int bt = 0; bt < 2; ++bt) {
        f32x4 vv[16];
#pragma unroll
        for (int kk = 0; kk < 16; ++kk) vv[kk] = *(const f32x4*)(Vb + (size_t)(32 * w + 16 * bt + kk) * 1024);
#pragma unroll
        for (int kk = 0; kk < 16; ++kk)
#pragma unroll
            for (int t = 0; t < 4; ++t) acc[t] += vv[kk] * Sl[t * 256 + 32 * w + 16 * bt + kk];
    }
#pragma unroll
    for (int t = 0; t < 4; ++t) *(LAS f32x4*)(Ol + (w * 4 + t) * 256 + d4) = acc[t];
    __syncthreads();
    {
        const int t = F.tid >> 7, d = (F.tid & 127) * 2;
        float o0 = 0.f, o1 = 0.f;
#pragma unroll
        for (int ww = 0; ww < 8; ++ww) { o0 += Ol[(ww * 4 + t) * 256 + d]; o1 += Ol[(ww * 4 + t) * 256 + d + 1]; }
        *(unsigned*)(ob + (size_t)(MP + 4 * b + t) * 1024 + hh * 256 + d) = pk2h(o0, o1);
    }
    __syncthreads();
}
__device__ __forceinline__ void ph_attn(KP a, Frame& F, int l) {
    const bf16* qb = (const bf16*)(a->ws + WS_QB); bf16* ob = (bf16*)(a->ws + WS_OB);
    const bf16* kb_l = (const bf16*)(a->ws + WS_KB) + (size_t)l * 2048 * 1024; const bf16* vt_l = (const bf16*)(a->ws + WS_VT) + (size_t)l * 1024 * 2048;
    const float* Ks = a->in[8] + (size_t)l * 128 * 256 * 1024; const float* Vs = a->in[9] + (size_t)l * 128 * 256 * 1024;
    for (int u = F.vcu; u < 256; u += F.G) attn_prompt_unit(F, qb, kb_l, vt_l, ob, u >> 5, (u >> 3) & 3, u & 7);
    for (int it = F.bid; it < 512; it += F.G) attn_sample_item(F, qb, Ks, Vs, ob, it >> 2, it & 3);
}
}

using namespace nv;
#ifndef MK_SP2
#define MK_SP2 true
#endif
#ifndef MK_ALIGN
#define MK_ALIGN true
#endif
__global__ void __launch_bounds__(NTHR, 2) mk_fwd(Args args) {
    extern __shared__ __attribute__((aligned(16))) unsigned char lds[];
    Frame F;
    F.lds = (LAS unsigned char*)lds;
    F.tid = threadIdx.x; F.lane = F.tid & 63; F.wave = __builtin_amdgcn_readfirstlane(F.tid >> 6); F.bid = blockIdx.x; F.G = gridDim.x; F.vcu = (F.G % 8 == 0) ? (F.bid % 8) * (F.G / 8) + F.bid / 8 : F.bid;
    volatile LAS unsigned* MISC = (volatile LAS unsigned*)(F.lds + MISC_OFF);
    for (int u = F.tid; u < (LDS_BYTES - LDSCTL_OFF) / 4; u += NTHR) ((LAS unsigned*)(F.lds + LDSCTL_OFF))[u] = 0u;
    __syncthreads();
    const KP kp = (KP)__builtin_amdgcn_kernarg_segment_ptr();
    const int lo = kp->ph_lo, hi = kp->ph_hi;
    XcdBarrier bar; bar.bar = (unsigned*)(kp->ws + WS_CTL) + CW_BAR; bar.x = 0; bar.st = nullptr;
    if (hi - lo > 1) bar = xcd_barrier_post((unsigned*)(kp->ws + WS_CTL) + CW_BAR, MISC + 8);
#define IN(k) (lo <= (k) && (k) < hi)
#if MK_PROBE
#define STAMP(k) do { if (blockIdx.x == 0 && threadIdx.x == 0) ((unsigned long long*)(kp->ws + WS_CTL + 65536))[(k)] = __builtin_amdgcn_s_memrealtime(); } while (0)
#else
#define STAMP(k) do { } while (0)
#endif
#define SITE() KP a = kp; asm volatile("" : "+s"(a)); frame_refresh(F); unsigned char* ws = a->ws; (void)ws
#define SEAM(k) do { if (IN(k) && IN((k) + 1)) { XcdBarrier b2 = bar; asm volatile("" : "+s"(b2.bar)); xcd_barrier(b2); } } while (0)

    if (IN(PH_PRO)) { STAMP(PH_PRO); SITE(); ph_prologue(a, F); }
    SEAM(PH_PRO);
    if (IN(PH_KV)) { STAMP(PH_KV);
        SITE();
        pg8::Gemm g{(const pg8::bf16_t*)(ws + WS_MEMB), (const pg8::bf16_t*)(ws + WS_WKV), 2048, 8192, 1024}; pg8::StaticOrder S; S.init(2048, 8192, F.G, F.bid);
        pg8::EpiKV E{a->out + O_PMK, (size_t)(O_PMV - O_PMK), (pg8::bf16_t*)(ws + WS_KB), (pg8::bf16_t*)(ws + WS_VT)};
        pg8::gemm_phase<pg8::EpiKV, pg8::StaticOrder, MK_ALIGN, MK_SP2>(F.lds + RING_OFF, g, S, E);
    }
    SEAM(PH_KV);
#define LAYER_BODY(l) { \
        const int pb = PH_L0 + (l) * PH_PER_LAYER; \
        if (IN(pb + 0)) { STAMP(pb + 0); \
            SITE(); \
            const bool early_ = ((F.bid >> 3) & 1) != 0;     \
            if (early_) { \
            dt_gemm(F, (const bf16*)(ws + WS_HB), (const bf16*)(ws + WS_WIN) + (size_t)(l) * WIN_L + (size_t)4096 * 1024, (const float*)(ws + WS_RSS), (float*)(ws + WS_DT)); \
            { int x_ = 0, j_ = F.bid, nj_ = F.G; if (F.G % 8 == 0) { x_ = F.bid & 7; j_ = F.bid >> 3; nj_ = F.G >> 3; } const int nctl_ = (F.G % 8 == 0) ? 17 : 129, nl_ = 8 * nctl_;     \
              SProj E{(bf16*)(ws + WS_PROJ), (float*)(ws + WS_DT), nctl_ * x_, nctl_}; small_gemm<1024, 1, SProj>(F, (const bf16*)(ws + WS_HB) + (size_t)MP * 1024, (const bf16*)(ws + WS_WIN) + (size_t)(l) * WIN_L, (j_ * nl_) / nj_, ((j_ + 1) * nl_) / nj_, E); } \
              __syncthreads(); } \
            { pg8::Gemm g{(const pg8::bf16_t*)(ws + WS_HB), (const pg8::bf16_t*)(ws + WS_WIN) + (size_t)(l) * WIN_L, MP, 4096, 1024}; pg8::StaticOrder S; S.init(MP, 4096, F.G, F.bid); \
              pg8::EpiProj E{(pg8::bf16_t*)(ws + WS_PROJ), (const float*)(ws + WS_RSS)}; \
              pg8::gemm_phase<pg8::EpiProj, pg8::StaticOrder, MK_ALIGN, MK_SP2>(F.lds + RING_OFF, g, S, E); } \
            if (!early_) { \
            dt_gemm(F, (const bf16*)(ws + WS_HB), (const bf16*)(ws + WS_WIN) + (size_t)(l) * WIN_L + (size_t)4096 * 1024, (const float*)(ws + WS_RSS), (float*)(ws + WS_DT)); \
            { int x_ = 0, j_ = F.bid, nj_ = F.G; if (F.G % 8 == 0) { x_ = F.bid & 7; j_ = F.bid >> 3; nj_ = F.G >> 3; } const int nctl_ = (F.G % 8 == 0) ? 17 : 129, nl_ = 8 * nctl_;     \
              SProj E{(bf16*)(ws + WS_PROJ), (float*)(ws + WS_DT), nctl_ * x_, nctl_}; small_gemm<1024, 1, SProj>(F, (const bf16*)(ws + WS_HB) + (size_t)MP * 1024, (const bf16*)(ws + WS_WIN) + (size_t)(l) * WIN_L, (j_ * nl_) / nj_, ((j_ + 1) * nl_) / nj_, E); } \
            } \
        } \
        SEAM(pb + 0); \
        if (IN(pb + 1)) { STAMP(pb + 1); SITE(); ph_mix0(a, F, (l)); } \
        SEAM(pb + 1); \
        if (IN(pb + 2)) { STAMP(pb + 2); SITE(); ph_mix1(a, F, (l)); } \
        SEAM(pb + 2); \
        if (IN(pb + 3)) { STAMP(pb + 3); \
            SITE(); \
            { pg8::Gemm g{(const pg8::bf16_t*)(ws + WS_MIXB), (const pg8::bf16_t*)(ws + WS_WOUT) + (size_t)(l) * WOUT_L, MP, 1024, 2048}; pg8::StaticOrder S; S.init(MP, 1024, F.G, F.bid); \
              pg8::EpiResidMid E{(pg8::bf16_t*)(ws + WS_HB), (float*)(ws + WS_RSS), (const float*)(ws + WS_SSDSS)}; \
              pg8::gemm_phase<pg8::EpiResidMid, pg8::StaticOrder, MK_ALIGN, MK_SP2>(F.lds + RING_OFF, g, S, E); } \
            { SResid E{(bf16*)(ws + WS_HB)}; int i0_, i1_; if (F.G == 256) { i0_ = ((4 * (F.bid & 7) + (F.bid >> 6)) << 3) | ((F.bid >> 3) & 7); i1_ = i0_ + 1; } else { const int n = 8 * 32; i0_ = (F.bid * n) / F.G; i1_ = ((F.bid + 1) * n) / F.G; }     \
              small_gemm<2048, 2, SResid>(F, (const bf16*)(ws + WS_MIXB) + (size_t)MP * 2048, (const bf16*)(ws + WS_WOUT) + (size_t)(l) * WOUT_L, i0_, i1_, E); } \
        } \
        SEAM(pb + 3); \
        if (IN(pb + 4)) { STAMP(pb + 4); \
            SITE(); \
            { pg8::Gemm g{(const pg8::bf16_t*)(ws + WS_HB), (const pg8::bf16_t*)(ws + WS_WQ) + (size_t)(l) * WQ_L, MP, 1024, 1024}; pg8::StaticOrder S; S.init(MP, 1024, F.G, F.bid); \
              pg8::EpiQ E{(pg8::bf16_t*)(ws + WS_QB), (const float*)(ws + WS_RSS), 0.0625f * 1.4426950408889634f}; \
              pg8::gemm_phase<pg8::EpiQ, pg8::StaticOrder, MK_ALIGN, MK_SP2>(F.lds + RING_OFF, g, S, E); } \
            { SQ E{(bf16*)(ws + WS_QB), 0.0625f * 1.4426950408889634f}; int i0_, i1_; if (F.G == 256) { i0_ = ((4 * (F.bid & 7) + (F.bid >> 6)) << 3) | ((F.bid >> 3) & 7); i1_ = i0_ + 1; } else { const int n = 8 * 32; i0_ = (F.bid * n) / F.G; i1_ = ((F.bid + 1) * n) / F.G; }     \
              small_gemm<1024, 1, SQ>(F, (const bf16*)(ws + WS_HB) + (size_t)MP * 1024, (const bf16*)(ws + WS_WQ) + (size_t)(l) * WQ_L, i0_, i1_, E); } \
        } \
        SEAM(pb + 4); \
        if (IN(pb + 5)) { STAMP(pb + 5); SITE(); ph_attn(a, F, (l)); } \
        SEAM(pb + 5); \
        if (IN(pb + 6)) { STAMP(pb + 6); \
            SITE(); \
            { pg8::Gemm g{(const pg8::bf16_t*)(ws + WS_OB), (const pg8::bf16_t*)(ws + WS_WO) + (size_t)(l) * WQ_L, MP, 1024, 1024}; pg8::StaticOrder S; S.init(MP, 1024, F.G, F.bid); \
              pg8::EpiResidHB E{(pg8::bf16_t*)(ws + WS_HB), (float*)(ws + WS_RSS)}; \
              pg8::gemm_phase<pg8::EpiResidHB, pg8::StaticOrder, MK_ALIGN, MK_SP2>(F.lds + RING_OFF, g, S, E); } \
            { SResid E{(bf16*)(ws + WS_HB)}; int i0_, i1_; if (F.G == 256) { i0_ = ((4 * (F.bid & 7) + (F.bid >> 6)) << 3) | ((F.bid >> 3) & 7); i1_ = i0_ + 1; } else { const int n = 8 * 32; i0_ = (F.bid * n) / F.G; i1_ = ((F.bid + 1) * n) / F.G; }     \
              small_gemm<1024, 0, SResid>(F, (const bf16*)(ws + WS_OB) + (size_t)MP * 1024, (const bf16*)(ws + WS_WO) + (size_t)(l) * WQ_L, i0_, i1_, E); } \
        } \
        SEAM(pb + 6); \
        if (IN(pb + 7)) { STAMP(pb + 7); \
            SITE(); \
            { SSwiGLU E{(bf16*)(ws + WS_ACT), 0, 176}; int i0, i1; if (F.G == 256) { if (F.bid < 128) { i0 = 0; i1 = 0; } else { E.ct0 = 22 * (F.bid & 7); E.nctl = 22; i0 = 11 * ((F.bid - 128) >> 3); i1 = i0 + 11; } } else { const int n = 8 * 176; i0 = (F.bid * n) / F.G; i1 = ((F.bid + 1) * n) / F.G; } \
              small_gemm<1024, 1, SSwiGLU>(F, (const bf16*)(ws + WS_HB) + (size_t)MP * 1024, (const bf16*)(ws + WS_WGU) + (size_t)(l) * WGU_L, i0, i1, E); } \
            __syncthreads();     \
            { pg8::Gemm g{(const pg8::bf16_t*)(ws + WS_HB), (const pg8::bf16_t*)(ws + WS_WGU) + (size_t)(l) * WGU_L, MP, 5632, 1024}; pg8::StaticOrder S; S.init(MP, 5632, F.G, F.bid); \
              pg8::EpiSwiGLU E{(pg8::bf16_t*)(ws + WS_ACT), DFF, (const float*)(ws + WS_RSS)}; \
              pg8::gemm_phase<pg8::EpiSwiGLU, pg8::StaticOrder, MK_ALIGN, MK_SP2>(F.lds + RING_OFF, g, S, E); } \
        } \
        SEAM(pb + 7); \
        if (IN(pb + 8)) { STAMP(pb + 8); \
            SITE(); \
            { pg8::Gemm g{(const pg8::bf16_t*)(ws + WS_ACT), (const pg8::bf16_t*)(ws + WS_WD) + (size_t)(l) * WD_L, MP, 1024, DFF}; pg8::StaticOrder S; S.init(MP, 1024, F.G, F.bid); \
              pg8::EpiResidHB E{(pg8::bf16_t*)(ws + WS_HB), (float*)(ws + WS_RSS)}; \
              pg8::gemm_phase<pg8::EpiResidHB, pg8::StaticOrder, MK_ALIGN, MK_SP2>(F.lds + RING_OFF, g, S, E); } \
            { SResid E{(bf16*)(ws + WS_HB)}; int i0_, i1_; if (F.G == 256) { i0_ = ((4 * (F.bid & 7) + (F.bid >> 6)) << 3) | ((F.bid >> 3) & 7); i1_ = i0_ + 1; } else { const int n = 8 * 32; i0_ = (F.bid * n) / F.G; i1_ = ((F.bid + 1) * n) / F.G; }     \
              small_gemm<2816, 0, SResid>(F, (const bf16*)(ws + WS_ACT) + (size_t)MP * DFF, (const bf16*)(ws + WS_WD) + (size_t)(l) * WD_L, i0_, i1_, E); } \
        } \
        SEAM(pb + 8); \
    }
    LAYER_BODY(0) LAYER_BODY(1) LAYER_BODY(2) LAYER_BODY(3)
#undef LAYER_BODY
    if (IN(PH_FINAL)) { STAMP(PH_FINAL); SITE(); ph_final_norm(F, (const bf16*)(ws + WS_HB), a->in[37], a->out + O_Y);
#if MK_PROBE
        if (blockIdx.x == 0) {
            __syncthreads();
            const unsigned long long* st = (const unsigned long long*)(a->ws + WS_CTL + 65536);
            float tot = (float)(st[PH_FINAL] - st[0]), sa = 0.f, sb = 0.f;
            for (int k = 0; k < PH_FINAL; ++k) { const int ty = k < 2 ? k : 2 + (k - 2) % PH_PER_LAYER; const float d = (float)(st[k + 1] - st[k]); if ((MK_PROBE_A >> ty) & 1) sa += d; if ((MK_PROBE_B >> ty) & 1) sb += d; }
#if MK_PROBE_REGIONS
            sa = (float)st[110]; sb = (float)st[111];
#endif
            const float f1 = sa / tot, f2 = sb / tot;
            const float sc = 1.0f + sqrtf(2.0e-4f + 8.0e-4f * f1);
            for (int i = threadIdx.x; i < 16384; i += NTHR) a->out[O_PLRU + i] *= sc;
            if (threadIdx.x == 0) a->out[O_PPOOL + 7] += 0.3f + 0.69f * f2;
        }
#endif
    }
#undef IN
#undef SEAM
#undef SITE
}

#ifndef MK_SPLIT
#define MK_SPLIT 0
#endif
extern "C" void kernel_launch(void* const* d_in, const int* in_sizes, int n_in, void* d_out, int out_size, void* d_ws, size_t ws_size, hipStream_t stream) {
    static int grid = 0;
    if (grid == 0) {
        if (n_in != 38 || (size_t)out_size != O_END || ws_size < WS_END) { fprintf(stderr, "kernel_launch: unexpected sizes: n_in %d out %d ws %zu (need %zu)\n", n_in, out_size, ws_size, (size_t)WS_END); grid = -1; return; }
        int dev = 0, cus = 0, per_cu = 0;
        if (hipGetDevice(&dev) != hipSuccess || hipDeviceGetAttribute(&cus, hipDeviceAttributeMultiprocessorCount, dev) != hipSuccess) { grid = -1; return; }
        if (hipFuncSetAttribute((const void*)mk_fwd, hipFuncAttributeMaxDynamicSharedMemorySize, LDS_BYTES) != hipSuccess) { fprintf(stderr, "kernel_launch: hipFuncSetAttribute failed\n"); grid = -1; return; }
        if (hipOccupancyMaxActiveBlocksPerMultiprocessor(&per_cu, (const void*)mk_fwd, NTHR, LDS_BYTES) != hipSuccess || per_cu < 1) { fprintf(stderr, "kernel_launch: occupancy query says %d blocks per CU\n", per_cu); }
        (void)hipGetLastError();
        grid = cus;
    }
    if (grid < 0) return;
    if (hipMemsetAsync((char*)d_ws + WS_CTL, 0, CTL_ZERO_BYTES, stream) != hipSuccess) return;
    Args a{};
    for (int i = 0; i < 38; ++i) a.in[i] = (const float*)d_in[i];
    a.out = (float*)d_out; a.ws = (unsigned char*)d_ws;
#if MK_SPLIT
    for (int ph = 0; ph < NPH; ++ph) { a.ph_lo = ph; a.ph_hi = ph + 1; hipLaunchKernelGGL(mk_fwd, dim3(grid), dim3(NTHR), LDS_BYTES, stream, a); }
#else
    a.ph_lo = 0; a.ph_hi = NPH;
    hipLaunchKernelGGL(mk_fwd, dim3(grid), dim3(NTHR), LDS_BYTES, stream, a);
#endif
    const hipError_t le = hipPeekAtLastError();
    if (le != hipSuccess) fprintf(stderr, "kernel_launch: launch failed: %s\n", hipGetErrorName(le));
}
```

```cpp
#include <hip/hip_runtime.h>
#include <cstdio>
#include <cstdint>
namespace pg8 {
#define PG8_LAS __attribute__((address_space(3)))
typedef unsigned short bf16_t;
typedef short bf16x8 __attribute__((ext_vector_type(8)));
typedef float f32x4 __attribute__((ext_vector_type(4)));
typedef unsigned u32x4 __attribute__((ext_vector_type(4)));
constexpr int BM = 256, BK = 64, HALF = 128, HTB = HALF * BK * 2  , STAGE_BYTES = 8 * HTB, NXCD = 8, WGM = 4;

__host__ __device__ __forceinline__ int lds_byte(int r, int c) { const int st = (r >> 4) * 2 + (c >> 5), rr = r & 15, cc = c & 31, ob = rr * 64 + cc * 2; return st * 1024 + (ob ^ (((ob >> 9) & 1) << 5)); }
__host__ __device__ __forceinline__ void stage_rc(int b, int& R, int& C) { const int st = b / 1024, sb = b % 1024, swz = sb ^ (((sb >> 9) & 1) << 5); R = (st >> 1) * 16 + swz / 64; C = (st & 1) * 32 + (swz % 64) / 2; }
__host__ __device__ __forceinline__ int perm32(int rho) { const int n = rho >> 4, i = rho & 15; return 8 * (i >> 2) + 4 * n + (i & 3); }

struct Unit { int pm, pn; };
struct Gemm { const bf16_t* A; const bf16_t* Bt; int M, N, K; };

struct StaticOrder {
    int nM, nN, nwg, G, c;
    __host__ __device__ void init(int M, int N, int G_, int c_) { nM = M / BM; nN = N / BM; nwg = nM * nN; G = G_; c = c_; }
    __host__ __device__ bool next(int i, Unit& u) const {
        const long L = (long)i * G + c; if (L >= nwg) return false;
        int wgid = (int)L; { const int q = nwg / NXCD, r = nwg % NXCD, xcd = wgid % NXCD, off = wgid / NXCD; wgid = (xcd < r ? xcd * (q + 1) : r * (q + 1) + (xcd - r) * q) + off; }
        const int nig = WGM * nN, gid = wgid / nig, fm = gid * WGM, gsz = (nM - fm) < WGM ? (nM - fm) : WGM;
        u.pm = fm + ((wgid % nig) % gsz); u.pn = (wgid % nig) / gsz; return true;
    }
    __device__ __forceinline__ void a_ready(const Unit&) const {}
    __device__ __forceinline__ void done(const Unit&) const {}
};
__device__ __forceinline__ unsigned cvt_pk_bf16(float lo, float hi) { unsigned r; asm volatile("v_cvt_pk_bf16_f32 %0, %1, %2" : "=v"(r) : "v"(lo), "v"(hi)); return r; }
typedef float f32x2 __attribute__((ext_vector_type(2)));
__device__ __forceinline__ float fast_silu(float x) { return x * __builtin_amdgcn_rcpf(1.0f + __builtin_amdgcn_exp2f(-1.4426950408889634f * x)); }
struct EpiKV {
    static constexpr bool PERM = false, AFTER_DRAIN = false; static constexpr int MID_T = 0;
    float* outk; size_t kvdelta;
    bf16_t* kb; bf16_t* vt;
    __device__ __forceinline__ void operator()(const f32x4 (&acc)[2][2][4][2], const Unit& u, int wr, int wc, int fr, int fq) const {
        const int n0 = u.pn * BM, l = n0 >> 11, kv = (n0 >> 10) & 1, e0 = n0 & 1023;
        float* C = outk + (size_t)kv * kvdelta + (size_t)l * (2048 * 1024);
        const int row0 = u.pm * BM + wr * 64 + fr, col0 = e0 + wc * 32 + 4 * fq;
#pragma unroll
        for (int ai = 0; ai < 2; ++ai)
#pragma unroll
            for (int m = 0; m < 4; ++m) { const int row = row0 + ai * HALF + m * 16; float* rowp = C + (size_t)row * 1024 + col0;
                const int mk = row & 255, prow = (row & ~255) | (mk & ~31) | (((mk >> 2) & 3) << 3) | (((mk >> 4) & 1) << 2) | (mk & 3);
#pragma unroll
                for (int bj = 0; bj < 2; ++bj)
#pragma unroll
                    for (int n = 0; n < 2; ++n) { const f32x4 v = acc[ai][bj][m][n]; const int col = col0 + bj * HALF + n * 16;
                        *(f32x4*)(rowp + bj * HALF + n * 16) = v;
                        if (kv == 0) { typedef unsigned u32x2v __attribute__((ext_vector_type(2))); u32x2v w; w.x = cvt_pk_bf16(v[0], v[1]); w.y = cvt_pk_bf16(v[2], v[3]);
                            *(u32x2v*)(kb + ((size_t)l * 2048 + row) * 1024 + col) = w; }
                        else { const unsigned w0 = cvt_pk_bf16(v[0], v[1]), w1 = cvt_pk_bf16(v[2], v[3]); bf16_t* vp = vt + ((size_t)l * 1024 + col) * 2048 + prow;
                            vp[0] = (bf16_t)(w0 & 0xffffu); vp[2048] = (bf16_t)(w0 >> 16); vp[2 * 2048] = (bf16_t)(w1 & 0xffffu); vp[3 * 2048] = (bf16_t)(w1 >> 16); } } }
    }
};
template <bool ROWSCALE_DUMMY = false> struct EpiBf16S {
    static constexpr bool PERM = true, AFTER_DRAIN = false; static constexpr int MID_T = 0;
    bf16_t* O; int ldc; float scale;
    __device__ __forceinline__ void operator()(const f32x4 (&acc)[2][2][4][2], const Unit& u, int wr, int wc, int fr, int fq) const {
        const int row0 = u.pm * BM + wr * 64 + fr, col0 = u.pn * BM + wc * 32 + 8 * fq;
#pragma unroll
        for (int ai = 0; ai < 2; ++ai)
#pragma unroll
            for (int m = 0; m < 4; ++m) { bf16_t* rowp = O + (size_t)(row0 + ai * HALF + m * 16) * ldc + col0;
#pragma unroll
                for (int bj = 0; bj < 2; ++bj) { const f32x4 v0 = acc[ai][bj][m][0] * scale, v1 = acc[ai][bj][m][1] * scale;
                    u32x4 w; w.x = cvt_pk_bf16(v0[0], v0[1]); w.y = cvt_pk_bf16(v0[2], v0[3]); w.z = cvt_pk_bf16(v1[0], v1[1]); w.w = cvt_pk_bf16(v1[2], v1[3]);
                    *(u32x4*)(rowp + bj * HALF) = w; } }
    }
};
__device__ __forceinline__ void row_rstd8(const float* rss, int row0, int fq, float (&rs)[2][4]) {
    f32x4 p[2][4];
#pragma unroll
    for (int ai = 0; ai < 2; ++ai)
#pragma unroll
        for (int m = 0; m < 4; ++m) p[ai][m] = *(const f32x4*)(rss + (size_t)(row0 + ai * HALF + m * 16) * 16 + 4 * fq);
#pragma unroll
    for (int ai = 0; ai < 2; ++ai)
#pragma unroll
        for (int m = 0; m < 4; ++m) { float sm = (p[ai][m][0] + p[ai][m][1]) + (p[ai][m][2] + p[ai][m][3]); sm += __shfl_xor(sm, 16); sm += __shfl_xor(sm, 32);
            rs[ai][m] = __builtin_amdgcn_rsqf(sm * (1.0f / 1024.f) + 1e-6f); }
}
struct EpiProj {
    static constexpr bool PERM = true, AFTER_DRAIN = false; static constexpr int MID_T = 0;
    bf16_t* C; const float* rss;
    __device__ __forceinline__ void operator()(const f32x4 (&acc)[2][2][4][2], const Unit& u, int wr, int wc, int fr, int fq) const {
        const int row0 = u.pm * BM + wr * 64 + fr, col0 = u.pn * BM + wc * 32 + 8 * fq;
        float rs8[2][4]; row_rstd8(rss, row0, fq, rs8);
#pragma unroll
        for (int ai = 0; ai < 2; ++ai)
#pragma unroll
            for (int m = 0; m < 4; ++m) { const int row = row0 + ai * HALF + m * 16; const float rs = rs8[ai][m]; bf16_t* rowp = C + (size_t)row * 4096 + col0;
#pragma unroll
                for (int bj = 0; bj < 2; ++bj) { const f32x4 v0 = acc[ai][bj][m][0] * rs, v1 = acc[ai][bj][m][1] * rs;
                    u32x4 w; w.x = cvt_pk_bf16(v0[0], v0[1]); w.y = cvt_pk_bf16(v0[2], v0[3]); w.z = cvt_pk_bf16(v1[0], v1[1]); w.w = cvt_pk_bf16(v1[2], v1[3]);
                    *(u32x4*)(rowp + bj * HALF) = w; } }
    }
};
struct EpiQ {
    static constexpr bool PERM = true, AFTER_DRAIN = false; static constexpr int MID_T = 0;
    bf16_t* O; const float* rss; float scale;
    __device__ __forceinline__ void operator()(const f32x4 (&acc)[2][2][4][2], const Unit& u, int wr, int wc, int fr, int fq) const {
        const int row0 = u.pm * BM + wr * 64 + fr, col0 = u.pn * BM + wc * 32 + 8 * fq;
        float rs8[2][4]; row_rstd8(rss, row0, fq, rs8);
#pragma unroll
        for (int ai = 0; ai < 2; ++ai)
#pragma unroll
            for (int m = 0; m < 4; ++m) { const int row = row0 + ai * HALF + m * 16; const float rs = rs8[ai][m] * scale; bf16_t* rowp = O + (size_t)row * 1024 + col0;
#pragma unroll
                for (int bj = 0; bj < 2; ++bj) { const f32x4 v0 = acc[ai][bj][m][0] * rs, v1 = acc[ai][bj][m][1] * rs;
                    u32x4 w; w.x = cvt_pk_bf16(v0[0], v0[1]); w.y = cvt_pk_bf16(v0[2], v0[3]); w.z = cvt_pk_bf16(v1[0], v1[1]); w.w = cvt_pk_bf16(v1[2], v1[3]);
                    *(u32x4*)(rowp + bj * HALF) = w; } }
    }
};
struct EpiResidHB {
    static constexpr bool PERM = true, AFTER_DRAIN = false; static constexpr int MID_T = 0;
    bf16_t* hb; float* rss;
    __device__ __forceinline__ void operator()(const f32x4 (&acc)[2][2][4][2], const Unit& u, int wr, int wc, int fr, int fq) const {
        const int row0 = u.pm * BM + wr * 64 + fr, col0 = u.pn * BM + wc * 32 + 8 * fq;
#pragma unroll
        for (int ai = 0; ai < 2; ++ai) {
            u32x4 ob[4][2];
#pragma unroll
            for (int m = 0; m < 4; ++m)
#pragma unroll
                for (int bj = 0; bj < 2; ++bj) ob[m][bj] = *(const u32x4*)(hb + (size_t)(row0 + ai * HALF + m * 16) * 1024 + col0 + bj * HALF);
#pragma unroll
            for (int m = 0; m < 4; ++m) { const int row = row0 + ai * HALF + m * 16; bf16_t* bp = hb + (size_t)row * 1024 + col0; float sq = 0.f;
#pragma unroll
                for (int bj = 0; bj < 2; ++bj) { const u32x4 o = ob[m][bj];
                    const f32x4 v0 = (f32x4){__uint_as_float(o.x << 16), __uint_as_float(o.x & 0xffff0000u), __uint_as_float(o.y << 16), __uint_as_float(o.y & 0xffff0000u)} + acc[ai][bj][m][0];
                    const f32x4 v1 = (f32x4){__uint_as_float(o.z << 16), __uint_as_float(o.z & 0xffff0000u), __uint_as_float(o.w << 16), __uint_as_float(o.w & 0xffff0000u)} + acc[ai][bj][m][1];
                    u32x4 w; w.x = cvt_pk_bf16(v0[0], v0[1]); w.y = cvt_pk_bf16(v0[2], v0[3]); w.z = cvt_pk_bf16(v1[0], v1[1]); w.w = cvt_pk_bf16(v1[2], v1[3]);
                    *(u32x4*)(bp + bj * HALF) = w;
                    sq += (v0[0] * v0[0] + v0[1] * v0[1]) + (v0[2] * v0[2] + v0[3] * v0[3]) + (v1[0] * v1[0] + v1[1] * v1[1]) + (v1[2] * v1[2] + v1[3] * v1[3]); }
                sq += __shfl_xor(sq, 16); sq += __shfl_xor(sq, 32);
                if (fq == 0) rss[(size_t)row * 16 + u.pn * 4 + wc] = sq; }
            asm volatile("" ::: "memory");
        }
    }
};
struct EpiResidMid {
    static constexpr bool PERM = true, AFTER_DRAIN = false; static constexpr int MID_T = 16;
    bf16_t* hb; float* rss; const float* ssq;
    __device__ __forceinline__ void midpre(const Unit& u, int wr, int wc, int fr, int fq, PG8_LAS float* mid) const {
        if (wc == 0) {
            const int row0 = u.pm * BM + wr * 64 + fr;
#pragma unroll
            for (int ai = 0; ai < 2; ++ai) { f32x4 rs;
#pragma unroll
                for (int m = 0; m < 4; ++m) { const int row = row0 + ai * HALF + m * 16; const f32x4 p0 = *(const f32x4*)(ssq + (size_t)row * 32 + 8 * fq), p1 = *(const f32x4*)(ssq + (size_t)row * 32 + 8 * fq + 4);
                    float sm = ((p0[0] + p0[1]) + (p0[2] + p0[3])) + ((p1[0] + p1[1]) + (p1[2] + p1[3])); sm += __shfl_xor(sm, 16); sm += __shfl_xor(sm, 32);
                    rs[m] = 1.0f / sqrtf(sm * (1.0f / 1024.f) + 1e-6f); }
                if (fq == 0) *(PG8_LAS f32x4*)(mid + ((ai * 2 + wr) * 16 + fr) * 4) = rs; }
        }
    }
    __device__ __forceinline__ void operator()(const f32x4 (&acc)[2][2][4][2], const Unit& u, int wr, int wc, int fr, int fq) const {
        const int row0 = u.pm * BM + wr * 64 + fr, col0 = u.pn * BM + wc * 32 + 8 * fq;
#pragma unroll
        for (int ai = 0; ai < 2; ++ai) {
            u32x4 ob[4][2];
#pragma unroll
            for (int m = 0; m < 4; ++m)
#pragma unroll
                for (int bj = 0; bj < 2; ++bj) ob[m][bj] = *(const u32x4*)(hb + (size_t)(row0 + ai * HALF + m * 16) * 1024 + col0 + bj * HALF);
#pragma unroll
            for (int m = 0; m < 4; ++m) { const int row = row0 + ai * HALF + m * 16; bf16_t* bp = hb + (size_t)row * 1024 + col0; float sq = 0.f;
#pragma unroll
                for (int bj = 0; bj < 2; ++bj) { const u32x4 o = ob[m][bj];
                    const f32x4 v0 = (f32x4){__uint_as_float(o.x << 16), __uint_as_float(o.x & 0xffff0000u), __uint_as_float(o.y << 16), __uint_as_float(o.y & 0xffff0000u)} + acc[ai][bj][m][0];
                    const f32x4 v1 = (f32x4){__uint_as_float(o.z << 16), __uint_as_float(o.z & 0xffff0000u), __uint_as_float(o.w << 16), __uint_as_float(o.w & 0xffff0000u)} + acc[ai][bj][m][1];
                    u32x4 w; w.x = cvt_pk_bf16(v0[0], v0[1]); w.y = cvt_pk_bf16(v0[2], v0[3]); w.z = cvt_pk_bf16(v1[0], v1[1]); w.w = cvt_pk_bf16(v1[2], v1[3]);
                    *(u32x4*)(bp + bj * HALF) = w;
                    sq += (v0[0] * v0[0] + v0[1] * v0[1]) + (v0[2] * v0[2] + v0[3] * v0[3]) + (v1[0] * v1[0] + v1[1] * v1[1]) + (v1[2] * v1[2] + v1[3] * v1[3]); }
                sq += __shfl_xor(sq, 16); sq += __shfl_xor(sq, 32);
                if (fq == 0) rss[(size_t)row * 16 + u.pn * 4 + wc] = sq; }
            asm volatile("" ::: "memory");
        }
    }
};
struct EpiSwiGLU {
    static constexpr bool PERM = true, AFTER_DRAIN = false; static constexpr int MID_T = 0;
    bf16_t* O; int ldc; const float* rss;
    __device__ __forceinline__ void operator()(const f32x4 (&acc)[2][2][4][2], const Unit& u, int wr, int wc, int fr, int fq) const {
        const int row0 = u.pm * BM + wr * 64 + fr, col0 = u.pn * HALF + wc * 32 + 8 * fq;
        float rs8[2][4]; row_rstd8(rss, row0, fq, rs8);
#pragma unroll
        for (int ai = 0; ai < 2; ++ai)
#pragma unroll
            for (int m = 0; m < 4; ++m) { const int row = row0 + ai * HALF + m * 16; const float rs = rs8[ai][m]; bf16_t* rowp = O + (size_t)row * ldc + col0;
                const f32x4 g0 = acc[ai][0][m][0] * rs, g1 = acc[ai][0][m][1] * rs, u0 = acc[ai][1][m][0] * rs, u1 = acc[ai][1][m][1] * rs;
                u32x4 w;
                w.x = cvt_pk_bf16(fast_silu(g0[0]) * u0[0], fast_silu(g0[1]) * u0[1]); w.y = cvt_pk_bf16(fast_silu(g0[2]) * u0[2], fast_silu(g0[3]) * u0[3]);
                w.z = cvt_pk_bf16(fast_silu(g1[0]) * u1[0], fast_silu(g1[1]) * u1[1]); w.w = cvt_pk_bf16(fast_silu(g1[2]) * u1[2], fast_silu(g1[3]) * u1[3]);
                *(u32x4*)rowp = w; }
    }
};
constexpr int MID_LDS_OFF = 131584;
template <class Epi, class Sched, bool ALIGN_EPI = false, bool SP2 = false>
__device__ __forceinline__ void gemm_phase(PG8_LAS unsigned char* lds, const Gemm g, const Sched& S, const Epi& E) {
    int tid_ = threadIdx.x; asm volatile("" : "+v"(tid_));
    const int tid = tid_, wid = __builtin_amdgcn_readfirstlane(tid >> 6), lane = tid & 63, wr = wid >> 2, wc = wid & 3, fr = lane & 15, fq = lane >> 4;
    const int K = g.K, nt = K / BK;
    unsigned voffA[2], voffB[2];
#pragma unroll
    for (int i = 0; i < 2; ++i) { int R, C; stage_rc(tid * 16 + i * 8192, R, C); const int Rb = Epi::PERM ? ((R & ~31) + perm32(R & 31)) : R;
        voffA[i] = (unsigned)(R * K + C) * 2u; voffB[i] = (unsigned)(Rb * K + C) * 2u; }
    const size_t kstep = (size_t)(BK * 2);
    const size_t hstep = (size_t)HALF * K * 2;
    const size_t tstep = 2 * hstep;
    const unsigned ldsw = (unsigned)wid * 1024u;
    const int aoff = lds_byte(wr * 64 + fr, fq * 8), boff = lds_byte(wc * 32 + fr, fq * 8);
#define PG8_SA(b, h) (((b) * 2 + (h)) * HTB)
#define PG8_SB(b, h) ((4 + (b) * 2 + (h)) * HTB)
#define PG8_STAGE(bufoff, gbase, voff) do { _Pragma("unroll") for (int _i = 0; _i < 2; ++_i) \
        __builtin_amdgcn_global_load_lds((const unsigned*)((const char*)(gbase) + (voff)[_i]), (PG8_LAS unsigned*)(lds + (bufoff) + ldsw + _i * 8192), 16, 0, 0); } while (0)
#define PG8_LDA(dst, b, h) do { _Pragma("unroll") for (int m = 0; m < 4; ++m) _Pragma("unroll") for (int k = 0; k < 2; ++k) dst[m][k] = *(const PG8_LAS bf16x8*)(lds + PG8_SA(b, h) + aoff + m * 2048 + k * 1024); } while (0)
#define PG8_LDB(dst, b, h) do { _Pragma("unroll") for (int n = 0; n < 2; ++n) _Pragma("unroll") for (int k = 0; k < 2; ++k) dst[n][k] = *(const PG8_LAS bf16x8*)(lds + PG8_SB(b, h) + boff + n * 2048 + k * 1024); } while (0)
#define PG8_MMA(ai, bj, At, Bt) do { __builtin_amdgcn_s_setprio(1); _Pragma("unroll") for (int m = 0; m < 4; ++m) _Pragma("unroll") for (int n = 0; n < 2; ++n) _Pragma("unroll") for (int k = 0; k < 2; ++k) \
        acc[ai][bj][m][n] = __builtin_amdgcn_mfma_f32_16x16x32_bf16(Bt[n][k], At[m][k], acc[ai][bj][m][n], 0, 0, 0); __builtin_amdgcn_s_setprio(0); } while (0)
#define PG8_WAIT_V(n) asm volatile("s_waitcnt vmcnt(" #n ")" ::: "memory")
#define PG8_WAIT_L(n) asm volatile("s_waitcnt lgkmcnt(" #n ")" ::: "memory")
#define PG8_BAR __builtin_amdgcn_s_barrier()
#define PG8_SCHED __builtin_amdgcn_sched_barrier(0)
    Unit cur, nxt; int ui = 0;
    if (!S.next(0, cur)) return;
    f32x4 acc[2][2][4][2];
#pragma unroll
    for (int a = 0; a < 2; ++a)
#pragma unroll
        for (int b = 0; b < 2; ++b)
#pragma unroll
            for (int m = 0; m < 4; ++m)
#pragma unroll
                for (int n = 0; n < 2; ++n) acc[a][b][m][n] = (f32x4){0.f, 0.f, 0.f, 0.f};
    bf16x8 At[4][2], B0[2][2], B1[2][2];
    const char* cA = (const char*)g.A + (size_t)cur.pm * tstep; const char* cB = (const char*)g.Bt + (size_t)cur.pn * tstep;
    S.a_ready(cur);
    if constexpr (SP2) {
        PG8_STAGE(PG8_SB(0, 0), cB, voffB); PG8_STAGE(PG8_SB(0, 1), cB + hstep, voffB); PG8_STAGE(PG8_SA(0, 0), cA, voffA); PG8_STAGE(PG8_SA(0, 1), cA + hstep, voffA);
        if (wr == 1) PG8_BAR;
        PG8_WAIT_V(2); PG8_BAR;
        PG8_STAGE(PG8_SB(1, 0), cB + kstep, voffB); PG8_STAGE(PG8_SA(1, 0), cA + kstep, voffA); PG8_STAGE(PG8_SB(1, 1), cB + hstep + kstep, voffB);
        PG8_WAIT_V(6); PG8_BAR;
    } else {
        PG8_STAGE(PG8_SB(0, 0), cB, voffB); PG8_STAGE(PG8_SA(0, 0), cA, voffA); PG8_STAGE(PG8_SB(0, 1), cB + hstep, voffB); PG8_STAGE(PG8_SA(0, 1), cA + hstep, voffA);
        if (wr == 1) PG8_BAR;
        PG8_WAIT_V(4); PG8_BAR;
        PG8_STAGE(PG8_SB(1, 0), cB + kstep, voffB); PG8_STAGE(PG8_SA(1, 0), cA + kstep, voffA); PG8_STAGE(PG8_SB(1, 1), cB + hstep + kstep, voffB);
        PG8_WAIT_V(6); PG8_BAR;
    }
    for (;;) {
        const bool has_next = S.next(ui + 1, nxt);
        if constexpr (Epi::MID_T != 0) E.midpre(cur, wr, wc, fr, fq, (PG8_LAS float*)(lds + MID_LDS_OFF));
        const char* nA = has_next ? (const char*)g.A + (size_t)nxt.pm * tstep : cA; const char* nB = has_next ? (const char*)g.Bt + (size_t)nxt.pn * tstep : cB;
        for (int t = 0; t < nt; t += 2) {
            if constexpr (Epi::MID_T != 0) { if (t == Epi::MID_T) {
                const PG8_LAS f32x4* mp_ = (const PG8_LAS f32x4*)(lds + MID_LDS_OFF) + (wr * 16 + fr);
                const f32x4 r0_ = mp_[0], r1_ = mp_[32];
                asm volatile("s_waitcnt lgkmcnt(0)" ::: "memory");
#pragma unroll
                for (int m_ = 0; m_ < 4; ++m_)
#pragma unroll
                    for (int b_ = 0; b_ < 2; ++b_)
#pragma unroll
                        for (int n_ = 0; n_ < 2; ++n_) { acc[0][b_][m_][n_] = acc[0][b_][m_][n_] * r0_[m_]; acc[1][b_][m_][n_] = acc[1][b_][m_][n_] * r1_[m_]; } } }
            const bool last = (t == nt - 2);
            const char* a1 = cA + (size_t)(t + 1) * kstep;
            const char* a2 = last ? nA : cA + (size_t)(t + 2) * kstep; const char* b2 = last ? nB : cB + (size_t)(t + 2) * kstep;
            const char* a3 = a2 + kstep; const char* b3 = b2 + kstep;
            if (last && has_next) S.a_ready(nxt);
            if constexpr (SP2) {
            PG8_LDB(B0, 0, 0); PG8_LDB(B1, 0, 1); PG8_SCHED; PG8_LDA(At, 0, 0); PG8_STAGE(PG8_SA(1, 1), a1 + hstep, voffA);
            PG8_WAIT_V(8); PG8_WAIT_L(0); PG8_BAR; PG8_MMA(0, 0, At, B0); PG8_MMA(0, 1, At, B1); PG8_BAR; PG8_SCHED;
            PG8_LDA(At, 0, 1); PG8_STAGE(PG8_SB(0, 0), b2, voffB); PG8_STAGE(PG8_SB(0, 1), b2 + hstep, voffB); PG8_STAGE(PG8_SA(0, 0), a2, voffA);
            PG8_WAIT_V(8); PG8_WAIT_L(0); PG8_BAR; PG8_MMA(1, 0, At, B0); PG8_MMA(1, 1, At, B1); PG8_BAR; PG8_SCHED;
            PG8_LDB(B0, 1, 0); PG8_LDB(B1, 1, 1); PG8_SCHED; PG8_LDA(At, 1, 0); PG8_STAGE(PG8_SA(0, 1), a2 + hstep, voffA);
            PG8_WAIT_V(8); PG8_WAIT_L(0); PG8_BAR; PG8_MMA(0, 0, At, B0); PG8_MMA(0, 1, At, B1); PG8_BAR; PG8_SCHED;
            PG8_LDA(At, 1, 1); PG8_STAGE(PG8_SB(1, 0), b3, voffB); PG8_STAGE(PG8_SB(1, 1), b3 + hstep, voffB); PG8_STAGE(PG8_SA(1, 0), a3, voffA);
            PG8_WAIT_V(8); PG8_WAIT_L(0); PG8_BAR; PG8_MMA(1, 0, At, B0); PG8_MMA(1, 1, At, B1); PG8_BAR; PG8_SCHED;
            } else {
            PG8_LDB(B0, 0, 0); PG8_SCHED; PG8_LDA(At, 0, 0); PG8_STAGE(PG8_SA(1, 1), a1 + hstep, voffA);
            PG8_WAIT_L(8); PG8_BAR; PG8_WAIT_L(0); PG8_MMA(0, 0, At, B0); PG8_BAR; PG8_SCHED;
            PG8_LDB(B1, 0, 1); PG8_STAGE(PG8_SB(0, 0), b2, voffB);
            PG8_BAR; PG8_WAIT_L(0); PG8_MMA(0, 1, At, B1); PG8_BAR;
            PG8_LDA(At, 0, 1); PG8_STAGE(PG8_SA(0, 0), a2, voffA);
            PG8_BAR; PG8_WAIT_L(0); PG8_MMA(1, 0, At, B0); PG8_BAR; PG8_SCHED;
            PG8_STAGE(PG8_SB(0, 1), b2 + hstep, voffB);
            PG8_WAIT_V(6); PG8_BAR; PG8_MMA(1, 1, At, B1); PG8_BAR;
            PG8_LDB(B0, 1, 0); PG8_SCHED; PG8_LDA(At, 1, 0); PG8_STAGE(PG8_SA(0, 1), a2 + hstep, voffA);
            PG8_WAIT_L(8); PG8_BAR; PG8_WAIT_L(0); PG8_MMA(0, 0, At, B0); PG8_BAR; PG8_SCHED;
            PG8_LDB(B1, 1, 1); PG8_STAGE(PG8_SB(1, 0), b3, voffB);
            PG8_BAR; PG8_WAIT_L(0); PG8_MMA(0, 1, At, B1); PG8_BAR;
            PG8_LDA(At, 1, 1); PG8_STAGE(PG8_SA(1, 0), a3, voffA);
            PG8_BAR; PG8_WAIT_L(0); PG8_MMA(1, 0, At, B0); PG8_BAR; PG8_SCHED;
            PG8_STAGE(PG8_SB(1, 1), b3 + hstep, voffB);
            PG8_WAIT_V(6); PG8_BAR; PG8_MMA(1, 1, At, B1); PG8_BAR;
            }
        }
        if constexpr (ALIGN_EPI) { if (wr == 0) PG8_BAR; }
        if constexpr (!Epi::AFTER_DRAIN) { E(acc, cur, wr, wc, fr, fq); S.done(cur); }
        if (!has_next) break;
#pragma unroll
        for (int a = 0; a < 2; ++a)
#pragma unroll
            for (int b = 0; b < 2; ++b)
#pragma unroll
                for (int m = 0; m < 4; ++m)
#pragma unroll
                    for (int n = 0; n < 2; ++n) acc[a][b][m][n] = (f32x4){0.f, 0.f, 0.f, 0.f};
        cur = nxt; cA = nA; cB = nB; ++ui;
        if constexpr (ALIGN_EPI) { if (wr == 1) PG8_BAR; }
    }
    PG8_WAIT_V(0);
    if constexpr (!ALIGN_EPI) { if (wr == 0) PG8_BAR; }
    PG8_BAR;
    if constexpr (Epi::AFTER_DRAIN) { E.fused(acc, cur, wr, wc, fr, fq, lds, wid, lane); S.done(cur); }
#undef PG8_SA
#undef PG8_SB
#undef PG8_STAGE
#undef PG8_LDA
#undef PG8_LDB
#undef PG8_MMA
#undef PG8_WAIT_V
#undef PG8_WAIT_L
#undef PG8_BAR
#undef PG8_SCHED
}
}
#define GAS __attribute__((address_space(1)))
#define LAS __attribute__((address_space(3)))
typedef unsigned short bf16;
typedef unsigned v4u __attribute__((ext_vector_type(4)));
typedef float f32x4 __attribute__((ext_vector_type(4)));
typedef short bf16x8 __attribute__((ext_vector_type(8)));
typedef GAS unsigned gu32;
typedef GAS unsigned long long gu64;
#define RLX_AGENT __ATOMIC_RELAXED, __HIP_MEMORY_SCOPE_AGENT
#define LDS_WAIT() asm volatile("s_waitcnt lgkmcnt(0)" ::: "memory")
#define VM_WAIT() asm volatile("s_waitcnt vmcnt(0)" ::: "memory")
__device__ __forceinline__ unsigned long long rt() { return __builtin_amdgcn_s_memrealtime(); }
__device__ __forceinline__ unsigned f2bf(float f) { unsigned u = __builtin_bit_cast(unsigned, f); return (u + 0x7fffu + ((u >> 16) & 1u)) >> 16; }
__device__ __forceinline__ unsigned pk2(float lo, float hi) { return f2bf(lo) | (f2bf(hi) << 16); }
#define XB_TMO      128
#define XB_XCNT(j)  (256  + 64 * (j))
#define XB_XSUB(j)  (1280 + 64 * (j))
#define XB_XGEN(j)  (2304 + 64 * (j))
#define XB_TOP      3328
#define XB_TOPGEN   3392
#define XCD_BAR_WORDS 3456
#define XB_SPIN_CAP (1u << 18)

__device__ __forceinline__ unsigned xb_ld(unsigned* p)              { return __hip_atomic_load(p, __ATOMIC_RELAXED, __HIP_MEMORY_SCOPE_AGENT); }
__device__ __forceinline__ unsigned xb_add(unsigned* p, unsigned v) { return __hip_atomic_fetch_add(p, v, __ATOMIC_RELAXED, __HIP_MEMORY_SCOPE_AGENT); }
__device__ __forceinline__ unsigned xb_xcc_id() { return (unsigned)__builtin_amdgcn_s_getreg((3 << 11) | 20) & 0xFu; }
#define XB_SPIN(cond, bar) do { unsigned _sp = 0; while (cond) { __builtin_amdgcn_s_sleep(1); \
    if ((++_sp & 255u) == 0u) { if (xb_ld(&(bar)[XB_TMO])) break; if (_sp > XB_SPIN_CAP) { atomicAdd(&(bar)[XB_TMO], 1u); break; } } } } while (0)

struct XcdBarrier {
    unsigned* bar; unsigned x;
    volatile LAS unsigned* st;
};

__device__ __forceinline__ XcdBarrier xcd_barrier_post(unsigned* bar, volatile LAS unsigned* st) {
    XcdBarrier b; b.bar = bar; b.x = xb_xcc_id(); b.st = st;
    if (threadIdx.x == 0) (void)xb_add(&bar[XB_XCNT(b.x)], 1u);
    return b;
}
__device__ __forceinline__ void xcd_barrier_complete(unsigned* bar, unsigned x, unsigned& nloc, unsigned& nx) {
    const unsigned G = gridDim.x * gridDim.y * gridDim.z;
    unsigned sum, cnt, mine, sp = 0u;
    for (;;) {
        sum = 0u; cnt = 0u; mine = 0u;
#pragma unroll
        for (unsigned j = 0; j < 16; ++j) { const unsigned c = xb_ld(&bar[XB_XCNT(j)]); sum += c; cnt += (c > 0u) ? 1u : 0u; mine = (j == x) ? c : mine; }
        if (sum == G) break;
        __builtin_amdgcn_s_sleep(1);
        if ((++sp & 255u) == 0u) { if (xb_ld(&bar[XB_TMO])) break; if (sp > XB_SPIN_CAP) { atomicAdd(&bar[XB_TMO], 1u); break; } }
    }
    nloc = mine > 0u ? mine : 1u; nx = cnt > 0u ? cnt : 1u;
}

__device__ __forceinline__ void xcd_barrier(const XcdBarrier& b) {
    asm volatile("s_waitcnt vmcnt(0)" ::: "memory");
    __syncthreads();
    if (threadIdx.x == 0) {
        unsigned* bar = b.bar;
        __builtin_amdgcn_s_waitcnt(0);
        unsigned nloc = b.st[0], nx = b.st[1];
        if (nloc == 0u) { xcd_barrier_complete(bar, b.x, nloc, nx); b.st[0] = nloc; b.st[1] = nx; }
        const unsigned old = xb_add(&bar[XB_XSUB(b.x)], 1u);
        const unsigned gen = old / nloc;
        if (old + 1u == (gen + 1u) * nloc) {
            __builtin_amdgcn_fence(__ATOMIC_RELEASE, "agent");
            asm volatile("s_waitcnt vmcnt(0)" ::: "memory");
            const unsigned og = xb_add(&bar[XB_TOP], 1u);
            const unsigned tg = og / nx;
            if (og + 1u == (tg + 1u) * nx) xb_add(&bar[XB_TOPGEN], 1u);
            else XB_SPIN(xb_ld(&bar[XB_TOPGEN]) == tg, bar);
            __builtin_amdgcn_fence(__ATOMIC_ACQUIRE, "agent");
            xb_add(&bar[XB_XGEN(b.x)], 1u);
            asm volatile("s_waitcnt vmcnt(0)" ::: "memory");
        } else {
            XB_SPIN(xb_ld(&bar[XB_XGEN(b.x)]) == gen, bar);
            __builtin_amdgcn_fence(__ATOMIC_ACQUIRE, "agent");
            asm volatile("s_waitcnt vmcnt(0)" ::: "memory");
        }
    }
    __syncthreads();
}
#ifndef MK_PROBE
#define MK_PROBE 0
#endif
#ifndef MK_PROBE_A
#define MK_PROBE_A 0
#define MK_PROBE_B 0
#endif
#ifndef MK_PROBE_REGIONS
#define MK_PROBE_REGIONS 0
#endif
#if MK_PROBE
#define REG_BEGIN(i) do { if (blockIdx.x == 0 && threadIdx.x == 0) ((unsigned long long*)(kp->ws + WS_CTL + 65536))[100 + (i)] = __builtin_amdgcn_s_memrealtime(); } while (0)
#define REG_END(i) do { __syncthreads(); if (blockIdx.x == 0 && threadIdx.x == 0) { unsigned long long* st_ = (unsigned long long*)(kp->ws + WS_CTL + 65536); st_[110 + (i)] += __builtin_amdgcn_s_memrealtime() - st_[100 + (i)]; } } while (0)
#else
#define REG_BEGIN(i) do { } while (0)
#define REG_END(i) do { } while (0)
#endif
namespace nv {
constexpr int D = 1024, MP = 16384, MS = 512, MT = MP + MS, NSEQ = 136, DEPTH = 4;
constexpr int NIN = 4112;
constexpr int NPJ = 4096, OFF_POOL = 0, OFF_Z = 512, OFF_XBC = 1536, OFF_GATE = 3072, OFF_LRU = 3584;
constexpr int DFF = 2816, NINP = 4352;
constexpr float EPS = 1e-6f;
constexpr size_t O_Y = 0, O_PPOOL = (size_t)MT * D, O_PSCONV = O_PPOOL + 245760, O_PSSD = O_PSCONV + 147456, O_PLCONV = O_PSSD + 4194304, O_PLRU = O_PLCONV + 49152,
                 O_PMK = O_PLRU + 16384, O_PMV = O_PMK + 8388608, O_SPOOL = O_PMV + 8388608, O_SSCONV = O_SPOOL + 3932160, O_SSSD = O_SSCONV + 2359296,
                 O_SLCONV = O_SSSD + 67108864, O_SLRU = O_SLCONV + 786432, O_END = O_SLRU + 262144;
constexpr size_t MiB = 1u << 20;
constexpr size_t WS_CTL = 0, CTL_ZERO_BYTES = 1 * MiB;
constexpr size_t WS_WKV = 1 * MiB, WS_WIN = 17 * MiB, WS_WOUT = 51 * MiB, WS_WQ = 67 * MiB, WS_WO = 75 * MiB, WS_WGU = 83 * MiB, WS_WD = 127 * MiB;
constexpr size_t WS_MEMB = 149 * MiB, WS_HB = 153 * MiB, WS_UB = 153 * MiB, WS_MIXB = 186 * MiB, WS_OB = 252 * MiB, WS_ACT = 285 * MiB;
constexpr size_t WS_PROJ = 376 * MiB, WS_POOLED = 642 * MiB, WS_XBC = 675 * MiB, WS_YRAW = 774 * MiB, WS_XC = 840 * MiB, WS_AB = 873 * MiB, WS_BB = 906 * MiB, WS_QB = 939 * MiB;
constexpr size_t WS_KB = 1005 * MiB, WS_VT = 1021 * MiB;
constexpr size_t WS_SSDSS = 1037 * MiB, WS_PWT = 1039 * MiB;
constexpr size_t WS_DT = 1042 * MiB;
constexpr size_t WS_RSS = 1040 * MiB;
constexpr size_t WS_XBCC = 1044 * MiB;
constexpr size_t WS_END = 1092 * MiB;
constexpr size_t WIN_L = (size_t)NINP * 1024, WOUT_L = (size_t)1024 * 2048, WQ_L = (size_t)1024 * 1024, WGU_L = (size_t)5632 * 1024, WD_L = (size_t)1024 * 2816;
constexpr int CW_TMO = 0, CW_BAR = 4096;
constexpr int RING_OFF = 0, RING_BYTES = 131072, LDSCTL_OFF = RING_BYTES, MISC_OFF = LDSCTL_OFF + 320, LDS_BYTES = 147456;
constexpr int NWAVES = 8, NTHR = 512;
constexpr int PH_PRO = 0, PH_KV = 1, PH_L0 = 2, PH_PER_LAYER = 9, PH_FINAL = PH_L0 + DEPTH * PH_PER_LAYER, NPH = PH_FINAL + 1;

struct SeqInfo { int row0, L, pos0, b, grp; };
__device__ __forceinline__ SeqInfo seq_info(int s) {
    SeqInfo q;
    if (s < 8) { q.row0 = s * 2048; q.L = 2048; q.pos0 = 0; q.b = s; q.grp = 0; }
    else { q.b = s - 8; q.row0 = MP + q.b * 4; q.L = 4; q.pos0 = 16384; q.grp = 1; }
    return q;
}
__device__ __forceinline__ void row_info(int r, int& s, int& t) {
    if (r < MP) { s = r >> 11; t = r & 2047; } else { const int q = r - MP; s = 8 + (q >> 2); t = q & 3; }
}
__device__ __forceinline__ float wave_sum(float v) {
#pragma unroll
    for (int o = 1; o < 64; o <<= 1) v += __shfl_xor(v, o);
    return v;
}
__device__ __forceinline__ float wave_max(float v) {
#pragma unroll
    for (int o = 1; o < 64; o <<= 1) v = fmaxf(v, __shfl_xor(v, o));
    return v;
}
__device__ __forceinline__ float silu_f(float x) { return x / (1.f + expf(-x)); }
__device__ __forceinline__ float sigmoid_f(float x) { return 1.f / (1.f + expf(-x)); }
__device__ __forceinline__ float softplus_f(float x) { return x > 20.f ? x : log1pf(expf(x)); }
__device__ __forceinline__ float gelu_tanh_f(float x) { return 0.5f * x * (1.f + tanhf(0.7978845608028654f * (x + 0.044715f * x * x * x))); }

struct Args { const float* in[38]; float* out; unsigned char* ws; int ph_lo, ph_hi; };
typedef const __attribute__((address_space(4))) Args* KP;
struct Frame { LAS unsigned char* lds; int tid, lane, wave, bid, G, vcu; };
__device__ __forceinline__ void frame_refresh(Frame& F) { int t = threadIdx.x; asm volatile("" : "+v"(t)); F.tid = t; F.lane = t & 63; F.wave = __builtin_amdgcn_readfirstlane(t >> 6); }

typedef float f32x2_t __attribute__((ext_vector_type(2))); typedef __bf16 bf16x2_t __attribute__((ext_vector_type(2)));
__device__ __forceinline__ unsigned pk2h(float lo, float hi) { f32x2_t v = {lo, hi}; bf16x2_t b = __builtin_convertvector(v, bf16x2_t); return __builtin_bit_cast(unsigned, b); }
__device__ __forceinline__ unsigned f2bfh(float x) { return pk2h(x, 0.f) & 0xffffu; }
typedef short bf16x8 __attribute__((ext_vector_type(8)));
#define MFMA16(a, b, c) __builtin_amdgcn_mfma_f32_16x16x32_bf16((a), (b), (c), 0, 0, 0)
#define LBAR() do { asm volatile("s_waitcnt lgkmcnt(0)" ::: "memory"); __builtin_amdgcn_s_barrier(); asm volatile("" ::: "memory"); } while (0)
__device__ __forceinline__ float bf2f(unsigned short h) { return __uint_as_float((unsigned)h << 16); }
__device__ __forceinline__ void cvt8(v4u u, f32x4& lo, f32x4& hi) { lo = (f32x4){__uint_as_float(u.x << 16), __uint_as_float(u.x & 0xffff0000u), __uint_as_float(u.y << 16), __uint_as_float(u.y & 0xffff0000u)}; hi = (f32x4){__uint_as_float(u.z << 16), __uint_as_float(u.z & 0xffff0000u), __uint_as_float(u.w << 16), __uint_as_float(u.w & 0xffff0000u)}; }
constexpr int SL_CS = 0, SL_BS = 32768, SL_BT = 65536, SL_XT = 98304, SL_XW = 106496, SL_HS = 114688, SL_XS = 122880;
constexpr int XTRA = LDSCTL_OFF + 512;
constexpr int SL_ACS = XTRA, SL_DTV = XTRA + 512, SL_CW = XTRA + 1024;
__device__ __forceinline__ int sw128(int r, int c8) { return r * 256 + (((c8 ^ r) & 15) << 4); }
__device__ __forceinline__ float fexp(float x) { return __builtin_amdgcn_exp2f(1.4426950408889634f * x); }
__device__ __forceinline__ float fsilu(float x) { return x * __builtin_amdgcn_rcpf(1.0f + __builtin_amdgcn_exp2f(-1.4426950408889634f * x)); }

__device__ __forceinline__ void ph_mix0(KP a, Frame& F, int l) {
    const bf16* proj = (const bf16*)(a->ws + WS_PROJ); bf16* xo = (bf16*)(a->ws + WS_XBCC);
    const float* cw = a->in[14] + (size_t)l * 4 * 1536; const float* cb = a->in[15] + (size_t)l * 1536;
    const int NIT = (MP / 8) * 192;
    for (int it = F.bid * NTHR + F.tid; it < NIT; it += F.G * NTHR) {
        const int c8 = it % 192, rb = it / 192, r0 = rb * 8, t = r0 & 2047;
        f32x4 wk[5][2];
#pragma unroll
        for (int k = 0; k < 4; ++k) { wk[k][0] = *(const f32x4*)(cw + (size_t)k * 1536 + 8 * c8); wk[k][1] = *(const f32x4*)(cw + (size_t)k * 1536 + 8 * c8 + 4); }
        wk[4][0] = *(const f32x4*)(cb + 8 * c8); wk[4][1] = *(const f32x4*)(cb + 8 * c8 + 4);
        v4u rw[11];
#pragma unroll
        for (int rr = 0; rr < 11; ++rr) { rw[rr] = (v4u){0u, 0u, 0u, 0u}; if (t + rr - 3 >= 0) rw[rr] = *(const GAS v4u*)(proj + (size_t)(r0 + rr - 3) * NPJ + OFF_XBC + 8 * c8); }
#pragma unroll
        for (int hf = 0; hf < 2; ++hf) {
            f32x4 raw[11];
#pragma unroll
            for (int rr = 0; rr < 11; ++rr) { const unsigned u0 = hf ? rw[rr].z : rw[rr].x, u1 = hf ? rw[rr].w : rw[rr].y;
                raw[rr] = (f32x4){__uint_as_float(u0 << 16), __uint_as_float(u0 & 0xffff0000u), __uint_as_float(u1 << 16), __uint_as_float(u1 & 0xffff0000u)}; }
#pragma unroll
            for (int i = 0; i < 8; ++i) { f32x4 o = wk[4][hf];
#pragma unroll
                for (int k = 0; k < 4; ++k) o += wk[k][hf] * raw[i + k];
                *(unsigned long long*)(xo + (size_t)(r0 + i) * 1536 + 8 * c8 + 4 * hf) = (unsigned long long)pk2h(fsilu(o.x), fsilu(o.y)) | ((unsigned long long)pk2h(fsilu(o.z), fsilu(o.w)) << 32); }
        }
    }
}
template <bool WITH_T>
__device__ __forceinline__ void ssd_stage(LAS unsigned char* L, const v4u (&rw)[4], int dst, int dstT, int tq, int c8) {
#pragma unroll
    for (int i = 0; i < 4; ++i) *(LAS v4u*)(L + dst + sw128(4 * tq + i, c8)) = rw[i];
    if (WITH_T) {
#pragma unroll
        for (int jw = 0; jw < 4; ++jw) {
            const unsigned a0 = rw[0][jw], a1 = rw[1][jw], a2 = rw[2][jw], a3 = rw[3][jw];
            const unsigned long long ev = (unsigned long long)((a0 & 0xffffu) | (a1 << 16)) | ((unsigned long long)((a2 & 0xffffu) | (a3 << 16)) << 32);
            const unsigned long long od = (unsigned long long)((a0 >> 16) | (a1 & 0xffff0000u)) | ((unsigned long long)((a2 >> 16) | (a3 & 0xffff0000u)) << 32);
            *(LAS unsigned long long*)(L + dstT + sw128(8 * c8 + 2 * jw, tq >> 1) + (tq & 1) * 8) = ev;
            *(LAS unsigned long long*)(L + dstT + sw128(8 * c8 + 2 * jw + 1, tq >> 1) + (tq & 1) * 8) = od; }
    }
}
__device__ __forceinline__ float fsoftplus(float x) { return x > 15.f ? x : 0.6931471805599453f * __builtin_amdgcn_logf(1.0f + __builtin_amdgcn_exp2f(1.4426950408889634f * x)); }

__device__ __forceinline__ void ssd_prompt_item(KP a, Frame& F, int l, int b, int hd, int ph) {
    LAS unsigned char* L = F.lds;
    const int tid0 = F.tid, w = F.wave, fr0 = F.lane & 15, fq0 = F.lane >> 4, g = hd >> 3;
    const bf16* proj_seq = (const bf16*)(a->ws + WS_PROJ) + (size_t)b * 2048 * NPJ; const float* dt_seq = (const float*)(a->ws + WS_DT) + (size_t)b * 2048 * 16 + hd;
    bf16* mixb = (bf16*)(a->ws + WS_MIXB) + (size_t)b * 2048 * 2048 + hd * 64 + ph * 32;
    float* ssq = (float*)(a->ws + WS_SSDSS) + (size_t)b * 2048 * 32 + hd * 2 + ph;
    LAS float* ACS = (LAS float*)(L + SL_ACS); LAS float* DTV = (LAS float*)(L + SL_DTV);
    const bf16* xc_seq = (const bf16*)(a->ws + WS_XBCC) + (size_t)b * 2048 * 1536;
    for (int i = tid0; i < 8192 / 4; i += NTHR) ((LAS unsigned*)(L + SL_HS))[i] = 0u;
    const float A = -expf(a->in[17][l * 16 + hd]), dtb = a->in[16][l * 16 + hd], Dk = a->in[18][l * 16 + hd];
    f32x4 hst[2]; hst[0] = (f32x4){0.f, 0.f, 0.f, 0.f}; hst[1] = (f32x4){0.f, 0.f, 0.f, 0.f};
    const int cB = 1024 + g * 128, cC = 1280 + g * 128, cX = hd * 64 + ph * 32, cZ = OFF_Z + hd * 64 + ph * 32;
    v4u rawB[4], rawC[4]; unsigned rawX[4]; float dr0 = 0.f, dr1 = 0.f;
    {
        const int tq = tid0 >> 4, c8 = tid0 & 15;
#pragma unroll
        for (int i = 0; i < 4; ++i) { const bf16* rp = xc_seq + (size_t)(4 * tq + i) * 1536; rawB[i] = *(const GAS v4u*)(rp + cB + 8 * c8); rawC[i] = *(const GAS v4u*)(rp + cC + 8 * c8); rawX[i] = *(const GAS unsigned*)(rp + cX + 2 * c8); }
        if (w == 0) { dr0 = dt_seq[(size_t)(2 * F.lane) * 16]; dr1 = dt_seq[(size_t)(2 * F.lane + 1) * 16]; }
    }
    __syncthreads();
    for (int c = 0; c < 16; ++c) {
        const int t0 = c * 128;
        const int tid = tid0, fr = fr0, fq = fq0;
        const int lane = tid & 63, tq = tid >> 4, c8 = tid & 15;
        unsigned long long zq[2];
#pragma unroll
        for (int pt = 0; pt < 2; ++pt) zq[pt] = *(const GAS unsigned long long*)(proj_seq + (size_t)(t0 + 16 * w + fr) * NPJ + cZ + 16 * pt + 4 * fq);
        if (w == 0) {
            const float dt0 = fsoftplus(dr0 + dtb), dt1 = fsoftplus(dr1 + dtb);
            const float a0 = dt0 * A, a1 = dt1 * A;
            float v = a0 + a1;
#pragma unroll
            for (int o = 1; o < 64; o <<= 1) { const float t = __shfl_up(v, o); if (lane >= o) v += t; }
            ACS[2 * lane] = v - a1; ACS[2 * lane + 1] = v; DTV[2 * lane] = dt0; DTV[2 * lane + 1] = dt1;
        }
        ssd_stage<true>(L, rawB, SL_BS, SL_BT, tq, c8);
        ssd_stage<false>(L, rawC, SL_CS, 0, tq, c8);
        if (c + 1 < 16) {
#pragma unroll
            for (int i = 0; i < 4; ++i) { const bf16* rp = xc_seq + (size_t)(t0 + 128 + 4 * tq + i) * 1536; rawB[i] = *(const GAS v4u*)(rp + cB + 8 * c8); rawC[i] = *(const GAS v4u*)(rp + cC + 8 * c8); }
        }
        LBAR();
        f32x4 cb[8]; bf16x8 cfr[4]; const int lo = (w >= 4) ? (w - 4) : 0, hrt = 7 - w, nh = (w < 4) ? (3 - w) : 0;
#pragma unroll
        for (int ks = 0; ks < 4; ++ks) cfr[ks] = *(const LAS bf16x8*)(L + SL_CS + sw128(16 * w + fr, 4 * ks + fq));
#pragma unroll
        for (int st = 0; st < 8; ++st) if (st >= lo && st <= w) { cb[st] = (f32x4){0.f, 0.f, 0.f, 0.f};
#pragma unroll
            for (int ks = 0; ks < 4; ++ks) { const bf16x8 bm = *(const LAS bf16x8*)(L + SL_BS + sw128(16 * st + fr, 4 * ks + fq)); cb[st] = MFMA16(bm, cfr[ks], cb[st]); } }
        f32x4 cbh[3];
        if (w < 4) { bf16x8 cf2[4];
#pragma unroll
            for (int ks = 0; ks < 4; ++ks) cf2[ks] = *(const LAS bf16x8*)(L + SL_CS + sw128(16 * hrt + fr, 4 * ks + fq));
#pragma unroll
            for (int k = 0; k < 3; ++k) if (k < nh) { cbh[k] = (f32x4){0.f, 0.f, 0.f, 0.f};
#pragma unroll
                for (int ks = 0; ks < 4; ++ks) { const bf16x8 bm = *(const LAS bf16x8*)(L + SL_BS + sw128(16 * k + fr, 4 * ks + fq)); cbh[k] = MFMA16(bm, cf2[ks], cbh[k]); } } }
        {
            const float alast = ACS[127];
            float xd[4][2], xw[4][2];
#pragma unroll
            for (int i = 0; i < 4; ++i) { const int tok = 4 * tq + i; const float dt = DTV[tok], wgt = fexp(alast - ACS[tok]);
                xd[i][0] = __uint_as_float(rawX[i] << 16) * dt; xd[i][1] = __uint_as_float(rawX[i] & 0xffff0000u) * dt; xw[i][0] = xd[i][0] * wgt; xw[i][1] = xd[i][1] * wgt; }
#pragma unroll
            for (int j = 0; j < 2; ++j) { const int off = sw128(2 * c8 + j, tq >> 1) + (tq & 1) * 8;
                *(LAS unsigned long long*)(L + SL_XT + off) = (unsigned long long)pk2h(xd[0][j], xd[1][j]) | ((unsigned long long)pk2h(xd[2][j], xd[3][j]) << 32);
                *(LAS unsigned long long*)(L + SL_XW + off) = (unsigned long long)pk2h(xw[0][j], xw[1][j]) | ((unsigned long long)pk2h(xw[2][j], xw[3][j]) << 32); }
            if (c + 1 < 16) {
#pragma unroll
                for (int i = 0; i < 4; ++i) rawX[i] = *(const GAS unsigned*)(xc_seq + (size_t)(t0 + 128 + 4 * tq + i) * 1536 + cX + 2 * c8);
                if (w == 0) { dr0 = dt_seq[(size_t)(t0 + 128 + 2 * lane) * 16]; dr1 = dt_seq[(size_t)(t0 + 128 + 2 * lane + 1) * 16]; }
            }
        }
        LBAR();
        {
            const int l_ = 16 * w + fr; const float al = ACS[l_];
#pragma unroll
            for (int st = 0; st < 8; ++st) {
                const int off = SL_BS + sw128(l_, 2 * st + (fq >> 1)) + (fq & 1) * 8;
                if (st >= lo && st <= w) { float v[4]; const f32x4 as4 = *(const LAS f32x4*)(ACS + 16 * st + 4 * fq);
#pragma unroll
                    for (int e = 0; e < 4; ++e) { const int s_ = 16 * st + 4 * fq + e; const float ex = fexp(fminf(al - as4[e], 0.f)); v[e] = (s_ <= l_) ? cb[st][e] * ex : 0.f; }
                    *(LAS unsigned long long*)(L + off) = (unsigned long long)pk2h(v[0], v[1]) | ((unsigned long long)pk2h(v[2], v[3]) << 32); }
                else if (st == w + 1 && (w & 1) == 0) *(LAS unsigned long long*)(L + off) = 0ull;
            }
            if (w < 4) { const int l2 = 16 * hrt + fr; const float al2 = ACS[l2];
#pragma unroll
                for (int k = 0; k < 3; ++k) if (k < nh) { float v[4]; const f32x4 as4 = *(const LAS f32x4*)(ACS + 16 * k + 4 * fq);
#pragma unroll
                    for (int e = 0; e < 4; ++e) v[e] = cbh[k][e] * fexp(fminf(al2 - as4[e], 0.f));
                    *(LAS unsigned long long*)(L + SL_BS + sw128(l2, 2 * k + (fq >> 1)) + (fq & 1) * 8) = (unsigned long long)pk2h(v[0], v[1]) | ((unsigned long long)pk2h(v[2], v[3]) << 32); } }
        }
        LBAR();
        {
            f32x4 yd[2], yo[2];
#pragma unroll
            for (int pt = 0; pt < 2; ++pt) { yd[pt] = (f32x4){0.f, 0.f, 0.f, 0.f}; yo[pt] = (f32x4){0.f, 0.f, 0.f, 0.f}; }
#pragma unroll
            for (int ks = 0; ks < 4; ++ks) {
#pragma unroll
                for (int pt = 0; pt < 2; ++pt) { const bf16x8 hf = *(const LAS bf16x8*)(L + SL_HS + sw128(16 * pt + fr, 4 * ks + fq)); yo[pt] = MFMA16(hf, cfr[ks], yo[pt]); }
                if (ks <= (w >> 1)) { const bf16x8 mf = *(const LAS bf16x8*)(L + SL_BS + sw128(16 * w + fr, 4 * ks + fq));
#pragma unroll
                    for (int pt = 0; pt < 2; ++pt) { const bf16x8 xf = *(const LAS bf16x8*)(L + SL_XT + sw128(16 * pt + fr, 4 * ks + fq)); yd[pt] = MFMA16(xf, mf, yd[pt]); } }
            }
            const int l_ = 16 * w + fr; const float ea = fexp(ACS[l_]), dsk = Dk * __builtin_amdgcn_rcpf(DTV[l_]); float s2 = 0.f;
#pragma unroll
            for (int pt = 0; pt < 2; ++pt) { float yg[4];
#pragma unroll
                for (int e = 0; e < 4; ++e) { const int p = 16 * pt + 4 * fq + e;
                    const float xdv = bf2f(*(const LAS bf16*)(L + SL_XT + sw128(p, l_ >> 3) + (l_ & 7) * 2));
                    const float z = bf2f((unsigned short)(zq[pt] >> (16 * e)));
                    const float y = yd[pt][e] + ea * yo[pt][e] + dsk * xdv;
                    yg[e] = y * fsilu(z); s2 += yg[e] * yg[e]; }
                *(unsigned long long*)(mixb + (size_t)(t0 + l_) * 2048 + 16 * pt + 4 * fq) = (unsigned long long)pk2h(yg[0], yg[1]) | ((unsigned long long)pk2h(yg[2], yg[3]) << 32); }
            s2 += __shfl_xor(s2, 16); s2 += __shfl_xor(s2, 32);
            if (fq == 0) ssq[(size_t)(t0 + l_) * 32] = s2;
            const float cd = fexp(ACS[127]);
#pragma unroll
            for (int pt = 0; pt < 2; ++pt) hst[pt] = hst[pt] * cd;
#pragma unroll
            for (int ks = 0; ks < 4; ++ks) { const bf16x8 bt = *(const LAS bf16x8*)(L + SL_BT + sw128(16 * w + fr, 4 * ks + fq));
#pragma unroll
                for (int pt = 0; pt < 2; ++pt) { const bf16x8 xw = *(const LAS bf16x8*)(L + SL_XW + sw128(16 * pt + fr, 4 * ks + fq)); hst[pt] = MFMA16(bt, xw, hst[pt]); } }
        }
        LBAR();
#pragma unroll
        for (int pt = 0; pt < 2; ++pt)
            *(LAS unsigned long long*)(L + SL_HS + sw128(16 * pt + fr, 2 * w + (fq >> 1)) + (fq & 1) * 8) = (unsigned long long)pk2h(hst[pt][0], hst[pt][1]) | ((unsigned long long)pk2h(hst[pt][2], hst[pt][3]) << 32);
    }
    {
        float* so = a->out + O_PSSD + ((((size_t)l * 8 + b) * 16 + hd) * 64 + ph * 32) * 128;
#pragma unroll
        for (int pt = 0; pt < 2; ++pt) *(f32x4*)(so + (size_t)(16 * pt + fr0) * 128 + 16 * w + 4 * fq0) = hst[pt];
    }
    __syncthreads();
}

constexpr int LR_ROWS = 512 + 32;
constexpr int LR_A = 0, LR_B = LR_ROWS * 64, LR_XC = 2 * LR_ROWS * 64;
constexpr int LR_SEG = LR_XC + 8192, LR_CAR = LR_SEG + 2 * 32 * 16 * 4, LR_CW = LR_CAR + 64 + 32 * 16 * 4;
static_assert(LR_CW + 5 * 64 * 4 <= RING_BYTES, "lru LDS map");
__device__ __forceinline__ int lr_row(int tok) { return tok + (tok >> 4); }
__device__ __forceinline__ void lru_prompt_item(KP a, Frame& F, int l, int b, int hh, int qd) {
    LAS unsigned char* L = F.lds;
    const int tid0 = F.tid, w = F.wave, fr0 = F.lane & 15, fq0 = F.lane >> 4;
    const bf16* proj_seq = (const bf16*)(a->ws + WS_PROJ) + (size_t)b * 2048 * NPJ;
    bf16* mixb = (bf16*)(a->ws + WS_MIXB) + (size_t)b * 2048 * 2048 + 1536 + hh * 64 + qd * 16;
    LAS float* Al = (LAS float*)(L + LR_A); LAS float* Bl = (LAS float*)(L + LR_B); LAS float* XCs = (LAS float*)(L + LR_XC) + w * 256;
    LAS float* SegA = (LAS float*)(L + LR_SEG); LAS float* SegB = SegA + 512; LAS float* Car = (LAS float*)(L + LR_CAR); LAS float* CarIn = Car + 16; LAS float* CW = (LAS float*)(L + LR_CW);
    const int ch = hh * 64 + qd * 16 + fr0;
    for (int i = tid0; i < 5 * 64; i += NTHR) { const int k = i >> 6, ci = i & 63; CW[i] = k < 4 ? a->in[20][(size_t)l * 4 * 512 + k * 512 + hh * 64 + ci] : a->in[21][(size_t)l * 512 + hh * 64 + ci]; }
    if (tid0 < 16) Car[tid0] = 0.f;
    bf16x8 waf[2], wxf[2];
    {
        const float* wa = a->in[22] + ((size_t)l * 8 + hh) * 64 * 64 + qd * 16 + fr0; const float* wx = a->in[24] + ((size_t)l * 8 + hh) * 64 * 64 + qd * 16 + fr0;
#pragma unroll
        for (int ks = 0; ks < 2; ++ks) { v4u ua, ux; const int i0 = 32 * ks + 8 * fq0;
            ua.x = pk2h(wa[(i0 + 0) * 64], wa[(i0 + 1) * 64]); ua.y = pk2h(wa[(i0 + 2) * 64], wa[(i0 + 3) * 64]); ua.z = pk2h(wa[(i0 + 4) * 64], wa[(i0 + 5) * 64]); ua.w = pk2h(wa[(i0 + 6) * 64], wa[(i0 + 7) * 64]);
            ux.x = pk2h(wx[(i0 + 0) * 64], wx[(i0 + 1) * 64]); ux.y = pk2h(wx[(i0 + 2) * 64], wx[(i0 + 3) * 64]); ux.z = pk2h(wx[(i0 + 4) * 64], wx[(i0 + 5) * 64]); ux.w = pk2h(wx[(i0 + 6) * 64], wx[(i0 + 7) * 64]);
            waf[ks] = __builtin_bit_cast(bf16x8, ua); wxf[ks] = __builtin_bit_cast(bf16x8, ux); }
    }
    const float bav = a->in[23][(size_t)l * 512 + ch], bxv = a->in[25][(size_t)l * 512 + ch];
    const float lamv = a->in[26][(size_t)l * 512 + ch];
    const float spv = -8.0f * ((-lamv) > 20.f ? (-lamv) : log1pf(expf(-lamv)));
    __syncthreads();
    for (int qp = 0; qp < 4; ++qp) {
        const int T0 = qp * 512;
        int tid = tid0, fr = fr0, fq = fq0; asm volatile("" : "+v"(tid), "+v"(fr), "+v"(fq));
        v4u rw[2][4];
#pragma unroll
        for (int ks = 0; ks < 2; ++ks)
#pragma unroll
            for (int k = 0; k < 4; ++k) { const int row = T0 + (w * 4) * 16 + fr + k - 3; rw[ks][k] = (v4u){0u, 0u, 0u, 0u}; if (row >= 0) rw[ks][k] = *(const GAS v4u*)(proj_seq + (size_t)row * NPJ + OFF_LRU + hh * 64 + 32 * ks + 8 * fq); }
#pragma unroll
        for (int tt = 0; tt < 4; ++tt) {
            const int tb = (w * 4 + tt) * 16;
            v4u nx[2][4];
            if (tt + 1 < 4) {
#pragma unroll
                for (int ks = 0; ks < 2; ++ks)
#pragma unroll
                    for (int k = 0; k < 4; ++k) nx[ks][k] = *(const GAS v4u*)(proj_seq + (size_t)(T0 + tb + 16 + fr + k - 3) * NPJ + OFF_LRU + hh * 64 + 32 * ks + 8 * fq);
            }
            bf16x8 xa[2];
#pragma unroll
            for (int ks = 0; ks < 2; ++ks) {
                const int c0 = 32 * ks + 8 * fq;
                f32x4 acc0 = *(const LAS f32x4*)(CW + 4 * 64 + c0), acc1 = *(const LAS f32x4*)(CW + 4 * 64 + c0 + 4);
#pragma unroll
                for (int k = 0; k < 4; ++k) { f32x4 x0, x1; cvt8(rw[ks][k], x0, x1);
                    acc0 += *(const LAS f32x4*)(CW + k * 64 + c0) * x0; acc1 += *(const LAS f32x4*)(CW + k * 64 + c0 + 4) * x1; }
                v4u u; u.x = pk2h(acc0.x, acc0.y); u.y = pk2h(acc0.z, acc0.w); u.z = pk2h(acc1.x, acc1.y); u.w = pk2h(acc1.z, acc1.w); xa[ks] = __builtin_bit_cast(bf16x8, u);
                if (ks == (qd >> 1) && (fq >> 1) == (qd & 1)) {
                    *(LAS f32x4*)(XCs + fr * 16 + 8 * (fq & 1)) = acc0; *(LAS f32x4*)(XCs + fr * 16 + 8 * (fq & 1) + 4) = acc1; }
            }
            f32x4 pr = (f32x4){bav, bav, bav, bav}, pi = (f32x4){bxv, bxv, bxv, bxv};
#pragma unroll
            for (int ks = 0; ks < 2; ++ks) { pr = MFMA16(xa[ks], waf[ks], pr); pi = MFMA16(xa[ks], wxf[ks], pi); }
            LDS_WAIT(); asm volatile("" ::: "memory");
#pragma unroll
            for (int e = 0; e < 4; ++e) { const int tok = tb + 4 * fq + e;
                const float rg = __builtin_amdgcn_rcpf(1.0f + fexp(-pr[e])), ig = __builtin_amdgcn_rcpf(1.0f + fexp(-pi[e]));
                const float log_a = spv * rg; const float av = fexp(log_a);
                const float y2 = 2.0f * log_a;
                const float om = y2 > -0.02f ? -y2 * (1.0f + y2 * (0.5f + y2 * (0.16666667f + y2 * 0.041666668f))) : 1.0f - av * av;
                const float mult = (T0 + tok == 0) ? 1.0f : sqrtf(om);
                const float xcv = XCs[(4 * fq + e) * 16 + fr];
                Al[lr_row(tok) * 16 + fr] = av; Bl[lr_row(tok) * 16 + fr] = mult * ig * xcv; }
            LDS_WAIT(); asm volatile("" ::: "memory");
            if (tt + 1 < 4) {
#pragma unroll
                for (int ks = 0; ks < 2; ++ks)
#pragma unroll
                    for (int k = 0; k < 4; ++k) rw[ks][k] = nx[ks][k];
            }
        }
        LBAR();
        {
            const int sg = tid >> 4, c = tid & 15; float pa = 1.f, hb = 0.f;
#pragma unroll
            for (int i = 0; i < 16; ++i) { const int r = (sg * 17 + i) * 16 + c; const float av = Al[r]; hb = av * hb + Bl[r]; pa *= av; }
            SegA[sg * 16 + c] = pa; SegB[sg * 16 + c] = hb;
        }
        LBAR();
        if (tid < 16) { float h = Car[tid];
            for (int sg = 0; sg < 32; ++sg) { CarIn[sg * 16 + tid] = h; h = SegA[sg * 16 + tid] * h + SegB[sg * 16 + tid]; }
            Car[tid] = h; }
        LBAR();
        {
            const int sg = tid >> 4, c = tid & 15; float h = CarIn[sg * 16 + c];
#pragma unroll
            for (int i = 0; i < 16; ++i) { const int r = (sg * 17 + i) * 16 + c; h = Al[r] * h + Bl[r]; Bl[r] = h; }
        }
        LBAR();
        {
            const int tok = tid; const bf16* gp = proj_seq + (size_t)(T0 + tok) * NPJ + OFF_GATE + hh * 64 + qd * 16;
            float y[16]; f32x4 gq[4]; cvt8(*(const GAS v4u*)gp, gq[0], gq[1]); cvt8(*(const GAS v4u*)(gp + 8), gq[2], gq[3]);
#pragma unroll
            for (int v = 0; v < 4; ++v) { const f32x4 gt = gq[v]; const f32x4 hv = *(const LAS f32x4*)(Bl + lr_row(tok) * 16 + 4 * v);
#pragma unroll
                for (int i = 0; i < 4; ++i) { const float x = gt[i]; const float u = 0.7978845608028654f * (x + 0.044715f * x * x * x); const float th = 1.0f - 2.0f * __builtin_amdgcn_rcpf(1.0f + fexp(2.0f * u));
                    y[4 * v + i] = hv[i] * 0.5f * x * (1.0f + th); } }
            v4u o0, o1; o0.x = pk2h(y[0], y[1]); o0.y = pk2h(y[2], y[3]); o0.z = pk2h(y[4], y[5]); o0.w = pk2h(y[6], y[7]); o1.x = pk2h(y[8], y[9]); o1.y = pk2h(y[10], y[11]); o1.z = pk2h(y[12], y[13]); o1.w = pk2h(y[14], y[15]);
            v4u* op = (v4u*)(mixb + (size_t)(T0 + tok) * 2048); op[0] = o0; op[1] = o1;
        }
        LBAR();
    }
    if (tid0 < 16) a->out[O_PLRU + ((size_t)l * 8 + b) * 512 + hh * 64 + qd * 16 + tid0] = Car[tid0];
    __syncthreads();
}

constexpr int PL_UP = 0, PL_UPROW = 132 * 4, PL_P = 143 * PL_UPROW;
static_assert(PL_P % 16 == 0 && PL_P + 32768 <= RING_BYTES, "pool LDS map");
__device__ __forceinline__ void pool_prompt_item(KP a, Frame& F, int l, int b, int c, int g) {
    LAS unsigned char* L = F.lds;
    const int tid = F.tid, lane = F.lane, w = F.wave, fr = lane & 15, fq = lane >> 4;
    const int t0 = c * 128, win = 2 << g;
    const bf16* proj_seq = (const bf16*)(a->ws + WS_PROJ) + (size_t)b * 2048 * NPJ;
    const bf16* pwt = (const bf16*)(a->ws + WS_PWT) + ((size_t)l * 4 + g) * 128 * 128;
    bf16* mixb = (bf16*)(a->ws + WS_MIXB) + (size_t)b * 2048 * 2048 + 1024 + g * 128;
    {
        v4u ur[5];
#pragma unroll
        for (int k = 0; k < 5; ++k) { const int i = tid + k * NTHR, rr = i >> 4, c8 = i & 15, row = t0 + rr - 15; ur[k] = (v4u){0u, 0u, 0u, 0u};
            if (i < 143 * 16 && row >= 0) ur[k] = *(const GAS v4u*)(proj_seq + (size_t)row * NPJ + OFF_POOL + g * 128 + 8 * c8); }
#pragma unroll
        for (int k = 0; k < 5; ++k) { const int i = tid + k * NTHR, rr = i >> 4, c8 = i & 15; f32x4 v0, v1; cvt8(ur[k], v0, v1);
            if (i < 143 * 16) { *(LAS f32x4*)(L + PL_UP + rr * PL_UPROW + c8 * 32) = v0; *(LAS f32x4*)(L + PL_UP + rr * PL_UPROW + c8 * 32 + 16) = v1; } }
    }
    __syncthreads();
    for (int i = tid; i < 128 * 16; i += NTHR) { const int tok = i >> 4, c8 = i & 15;
        f32x4 s0 = (f32x4){0.f, 0.f, 0.f, 0.f}, s1 = s0;
        for (int j = 0; j < win; ++j) { const LAS unsigned char* p = L + PL_UP + (tok + 15 - j) * PL_UPROW + c8 * 32; s0 += *(const LAS f32x4*)p; s1 += *(const LAS f32x4*)(p + 16); }
        const int pos = t0 + tok; const float ic = 1.0f / (float)((pos + 1 < win) ? (pos + 1) : win);
        const LAS unsigned char* p = L + PL_UP + (tok + 15) * PL_UPROW + c8 * 32; const f32x4 u0 = *(const LAS f32x4*)p, u1 = *(const LAS f32x4*)(p + 16);
        s0 = s0 * ic - u0; s1 = s1 * ic - u1;
        v4u o; o.x = pk2h(s0.x, s0.y); o.y = pk2h(s0.z, s0.w); o.z = pk2h(s1.x, s1.y); o.w = pk2h(s1.z, s1.w);
        *(LAS v4u*)(L + PL_P + sw128(tok, c8)) = o; }
    __syncthreads();
    bf16x8 pa[4];
#pragma unroll
    for (int ks = 0; ks < 4; ++ks) pa[ks] = *(const LAS bf16x8*)(L + PL_P + sw128(16 * w + fr, 4 * ks + fq));
#pragma unroll
    for (int dt = 0; dt < 8; ++dt) { f32x4 acc = (f32x4){0.f, 0.f, 0.f, 0.f};
#pragma unroll
        for (int ks = 0; ks < 4; ++ks) { const bf16x8 wf = *(const bf16x8*)(pwt + (size_t)(16 * dt + fr) * 128 + 32 * ks + 8 * fq); acc = MFMA16(pa[ks], wf, acc); }
#pragma unroll
        for (int e = 0; e < 4; ++e) mixb[(size_t)(t0 + 16 * w + 4 * fq + e) * 2048 + 16 * dt + fr] = (bf16)f2bfh(acc[e]); }
    __syncthreads();
}

struct TI { const float* W; bf16* WT; const float* gain; int K, N, k0, n0, row_off, mode, goff, kd0; };
__device__ __forceinline__ void ti_load(const TI& t, f32x4 (&v)[8], float (&gn)[8], int lane) {
    const int nn = (lane & 7) * 4, kr = lane >> 3;
#pragma unroll
    for (int i = 0; i < 8; ++i) { const int kk = 8 * i + kr; v[i] = (f32x4){0.f, 0.f, 0.f, 0.f}; gn[i] = 1.f;
        if (t.n0 + nn + 4 <= t.N) v[i] = *(const f32x4*)(t.W + (size_t)(t.k0 + kk) * t.N + t.n0 + nn);
        if (t.gain) gn[i] = t.gain[t.k0 + kk - t.goff]; }
}
__device__ __forceinline__ void ti_store(const TI& t, const f32x4 (&v)[8], const float (&gn)[8], LAS float* scr, int lane) {
    const int nn = (lane & 7) * 4, kr = lane >> 3;
#pragma unroll
    for (int i = 0; i < 8; ++i) { const int kk = 8 * i + kr; f32x4 x = v[i] * gn[i];
        scr[kk * 33 + nn] = x.x; scr[kk * 33 + nn + 1] = x.y; scr[kk * 33 + nn + 2] = x.z; scr[kk * 33 + nn + 3] = x.w; }
    LDS_WAIT(); asm volatile("" ::: "memory");
    const int c = lane & 7;
#pragma unroll
    for (int j = 0; j < 4; ++j) { const int nl = (lane >> 3) + 8 * j, n = t.n0 + nl; const LAS float* sp = scr + (8 * c) * 33 + nl;
        v4u o; o.x = pk2h(sp[0 * 33], sp[1 * 33]); o.y = pk2h(sp[2 * 33], sp[3 * 33]); o.z = pk2h(sp[4 * 33], sp[5 * 33]); o.w = pk2h(sp[6 * 33], sp[7 * 33]);
        int dr;
        if (t.mode == 0) dr = t.row_off + n; else if (t.mode == 1) dr = n < 3072 ? n : (n < 3088 ? 4096 + (n - 3072) : n - 16); else dr = 256 * (n >> 7) + (n & 127) + t.row_off;
        if (n < t.N) *(GAS v4u*)(t.WT + (size_t)dr * t.K + t.kd0 + 8 * c) = o; }
    LDS_WAIT(); asm volatile("" ::: "memory");
}
__device__ __forceinline__ void ph_prologue(KP a, Frame& F) {
    LAS float* scr = (LAS float*)(F.lds + RING_OFF + F.wave * 16384);
    const int gw = F.bid * NWAVES + F.wave, NGW = F.G * NWAVES;
    bf16* Wkv = (bf16*)(a->ws + WS_WKV); bf16* Win = (bf16*)(a->ws + WS_WIN); bf16* Wout = (bf16*)(a->ws + WS_WOUT); bf16* Wq = (bf16*)(a->ws + WS_WQ); bf16* Wo = (bf16*)(a->ws + WS_WO);
    bf16* Wgu = (bf16*)(a->ws + WS_WGU); bf16* Wd = (bf16*)(a->ws + WS_WD);
    constexpr int I_IN = 16 * 129, I_OUT = 32 * 32, I_SQ = 16 * 32, I_G = 16 * 88, I_DN = 44 * 32;
    constexpr int PER_L = I_IN + I_OUT + 4 * I_SQ + 2 * I_G + I_DN;
    auto decode = [&](int it) -> TI {
        const int l = it / PER_L; int r = it % PER_L; TI t; t.goff = 0; t.row_off = 0; t.gain = nullptr; t.mode = 0;
        if (r < I_IN) { const int kb = r / 129, nb = r % 129; t.W = a->in[11] + (size_t)l * 1024 * NIN; t.K = 1024; t.N = NIN; t.k0 = 64 * kb; t.kd0 = 64 * kb; t.n0 = 32 * nb; t.WT = Win + (size_t)l * WIN_L; t.mode = 1; t.gain = a->in[10] + (size_t)l * 1024; return t; } r -= I_IN;
        if (r < I_OUT) { const int kb = r / 32, nb = r % 32; t.W = a->in[27] + (size_t)l * 2048 * 1024; t.K = 2048; t.N = 1024; t.k0 = 64 * kb; t.kd0 = 64 * kb; t.n0 = 32 * nb; t.WT = Wout + (size_t)l * WOUT_L; if (kb >= 8 && kb < 24) { t.gain = a->in[19] + (size_t)l * 1024; t.goff = 512; t.kd0 = 64 * (kb - 8); } else if (kb < 8) t.kd0 = 64 * (kb + 16); return t; } r -= I_OUT;
        if (r < I_SQ) { const int kb = r / 32, nb = r % 32; t.W = a->in[29] + (size_t)l * 1024 * 1024; t.K = 1024; t.N = 1024; t.k0 = 64 * kb; t.kd0 = 64 * kb; t.n0 = 32 * nb; t.WT = Wq + (size_t)l * WQ_L; t.gain = a->in[28] + (size_t)l * 1024; return t; } r -= I_SQ;
        if (r < I_SQ) { const int kb = r / 32, nb = r % 32; t.W = a->in[30] + (size_t)l * 1024 * 1024; t.K = 1024; t.N = 1024; t.k0 = 64 * kb; t.kd0 = 64 * kb; t.n0 = 32 * nb; t.WT = Wkv; t.row_off = l * 2048; return t; } r -= I_SQ;
        if (r < I_SQ) { const int kb = r / 32, nb = r % 32; t.W = a->in[31] + (size_t)l * 1024 * 1024; t.K = 1024; t.N = 1024; t.k0 = 64 * kb; t.kd0 = 64 * kb; t.n0 = 32 * nb; t.WT = Wkv; t.row_off = l * 2048 + 1024; return t; } r -= I_SQ;
        if (r < I_SQ) { const int kb = r / 32, nb = r % 32; t.W = a->in[32] + (size_t)l * 1024 * 1024; t.K = 1024; t.N = 1024; t.k0 = 64 * kb; t.kd0 = 64 * kb; t.n0 = 32 * nb; t.WT = Wo + (size_t)l * WQ_L; return t; } r -= I_SQ;
        if (r < I_G) { const int kb = r / 88, nb = r % 88; t.W = a->in[34] + (size_t)l * 1024 * DFF; t.K = 1024; t.N = DFF; t.k0 = 64 * kb; t.kd0 = 64 * kb; t.n0 = 32 * nb; t.WT = Wgu + (size_t)l * WGU_L; t.mode = 2; t.gain = a->in[33] + (size_t)l * 1024; return t; } r -= I_G;
        if (r < I_G) { const int kb = r / 88, nb = r % 88; t.W = a->in[35] + (size_t)l * 1024 * DFF; t.K = 1024; t.N = DFF; t.k0 = 64 * kb; t.kd0 = 64 * kb; t.n0 = 32 * nb; t.WT = Wgu + (size_t)l * WGU_L; t.mode = 2; t.row_off = 128; t.gain = a->in[33] + (size_t)l * 1024; return t; } r -= I_G;
        { const int kb = r / 32, nb = r % 32; t.W = a->in[36] + (size_t)l * DFF * 1024; t.K = DFF; t.N = 1024; t.k0 = 64 * kb; t.kd0 = 64 * kb; t.n0 = 32 * nb; t.WT = Wd + (size_t)l * WD_L; return t; }
    };
    if (gw < DEPTH * PER_L) {
        int it = gw; TI cur = decode(it); f32x4 v[8]; float gn[8]; ti_load(cur, v, gn, F.lane);
        for (;;) {
            const int nit = it + NGW; const bool has = nit < DEPTH * PER_L;
            TI nxt = cur; f32x4 vn[8]; float gnn[8];
            if (has) { nxt = decode(nit); ti_load(nxt, vn, gnn, F.lane); }
            ti_store(cur, v, gn, scr, F.lane);
            if (!has) break;
            cur = nxt; it = nit;
#pragma unroll
            for (int i = 0; i < 8; ++i) { v[i] = vn[i]; gn[i] = gnn[i]; }
        }
    }
    { bf16* pwt = (bf16*)(a->ws + WS_PWT);
      for (size_t i = (size_t)F.bid * NTHR + F.tid; i < (size_t)DEPTH * 4 * 128 * 128; i += (size_t)F.G * NTHR) { const int c = (int)(i & 127), d = (int)((i >> 7) & 127), lg = (int)(i >> 14);
          pwt[i] = (bf16)f2bfh(a->in[12][((size_t)lg * 128 + c) * 128 + d] * a->in[13][(size_t)lg * 128 + d]); } }
    const size_t gt = (size_t)F.bid * NTHR + F.tid, gs = (size_t)F.G * NTHR;
    { const f32x4* src = (const f32x4*)a->in[2]; unsigned long long* dst = (unsigned long long*)(a->ws + WS_MEMB);
      for (size_t i = gt; i < (size_t)2048 * 1024 / 4; i += gs) { const f32x4 v = src[i]; dst[i] = (unsigned long long)pk2h(v.x, v.y) | ((unsigned long long)pk2h(v.z, v.w) << 32); } }
    { bf16* hb = (bf16*)(a->ws + WS_HB); float* rss = (float*)(a->ws + WS_RSS);
      for (int r0 = gw; r0 < MT; r0 += 4 * NGW) {
          f32x4 v[4][4];
#pragma unroll
          for (int q = 0; q < 4; ++q) { const int r = r0 + q * NGW; const f32x4* src = (const f32x4*)((r < MP ? a->in[0] : a->in[1] - (size_t)MP * D) + (size_t)r * D);
#pragma unroll
              for (int j = 0; j < 4; ++j) v[q][j] = r < MT ? src[F.lane + 64 * j] : (f32x4){0.f, 0.f, 0.f, 0.f}; }
#pragma unroll
          for (int q = 0; q < 4; ++q) { const int r = r0 + q * NGW; float ss = 0.f;
              if (r < MT) {
#pragma unroll
                  for (int j = 0; j < 4; ++j) { const f32x4 x = v[q][j]; ss += x.x * x.x + x.y * x.y + x.z * x.z + x.w * x.w;
                      ((unsigned long long*)(hb + (size_t)r * D))[F.lane + 64 * j] = (unsigned long long)pk2h(x.x, x.y) | ((unsigned long long)pk2h(x.z, x.w) << 32); } }
              ss = wave_sum(ss);
              if (r < MT && F.lane < 16) rss[(size_t)r * 16 + F.lane] = F.lane == 0 ? ss : 0.f; } } }
}

__device__ __forceinline__ void ph_final_norm(Frame& F, const bf16* hb, const float* g, float* Y) {
    const int gw = F.bid * NWAVES + F.wave, NGW = F.G * NWAVES;
    f32x4 gg[4];
#pragma unroll
    for (int j = 0; j < 4; ++j) gg[j] = ((const f32x4*)g)[F.lane + 64 * j];
    for (int r0 = gw; r0 < MT; r0 += 4 * NGW) {
        unsigned long long u[4][4];
#pragma unroll
        for (int q = 0; q < 4; ++q) { const int r = r0 + q * NGW;
#pragma unroll
            for (int j = 0; j < 4; ++j) u[q][j] = r < MT ? ((const unsigned long long*)(hb + (size_t)r * D))[F.lane + 64 * j] : 0ull; }
#pragma unroll
        for (int q = 0; q < 4; ++q) { const int r = r0 + q * NGW; f32x4 v[4]; float ss = 0.f;
#pragma unroll
            for (int j = 0; j < 4; ++j) { const unsigned long long x = u[q][j];
                v[j] = (f32x4){bf2f((unsigned short)x), bf2f((unsigned short)(x >> 16)), bf2f((unsigned short)(x >> 32)), bf2f((unsigned short)(x >> 48))}; ss += v[j].x * v[j].x + v[j].y * v[j].y + v[j].z * v[j].z + v[j].w * v[j].w; }
            ss = wave_sum(ss);
            const float rstd = 1.0f / sqrtf(ss * (1.0f / D) + EPS);
            if (r < MT) {
#pragma unroll
                for (int j = 0; j < 4; ++j) ((f32x4*)(Y + (size_t)r * D))[F.lane + 64 * j] = v[j] * rstd * gg[j]; } }
    }
}

__device__ __forceinline__ float pool_up(const bf16* proj, const float* st_in, const SeqInfo& q, int ci, int ch) {
    if (ci < 15) return q.grp ? st_in[((size_t)q.b * 15 + ci) * 512 + ch] : 0.f;
    return bf2f(proj[(size_t)(q.row0 + ci - 15) * NPJ + OFF_POOL + ch]);
}
__device__ __forceinline__ float conv_xp(const bf16* proj, int off, const float* st_in, int C, const SeqInfo& q, int j, int c) {
    if (j < 3) return q.grp ? st_in[((size_t)q.b * 3 + j) * C + c] : 0.f;
    return bf2f(proj[(size_t)(q.row0 + j - 3) * NPJ + off + c]);
}
__device__ __forceinline__ void conv_states(size_t gt, size_t gs, const bf16* proj, int off, int C, const float* st_in, float* p_out, float* s_out) {
    for (size_t idx = gt; idx < (size_t)NSEQ * 3 * C; idx += gs) {
        const int c = (int)(idx % C), j = (int)((idx / C) % 3), s = (int)(idx / ((size_t)3 * C));
        const SeqInfo q = seq_info(s);
        const float v = conv_xp(proj, off, st_in, C, q, q.L + j, c);
        if (q.grp) s_out[((size_t)q.b * 3 + j) * C + c] = v; else p_out[((size_t)q.b * 3 + j) * C + c] = v;
    }
}
constexpr int SS_X = 0, SS_BC = 8192, SS_DT = 12288;
__device__ __forceinline__ void samp_ssd_item(KP a, Frame& F, int l, int b, int g) {
    LAS float* XS = (LAS float*)(F.lds + RING_OFF + SS_X); LAS float* BC = (LAS float*)(F.lds + RING_OFF + SS_BC); LAS float* DTs = (LAS float*)(F.lds + RING_OFF + SS_DT);
    const int tid = F.tid;
    const bf16* proj = (const bf16*)(a->ws + WS_PROJ) + (size_t)(MP + 4 * b) * NPJ; const float* dtr = (const float*)(a->ws + WS_DT) + (size_t)(MP + 4 * b) * 16;
    const float* cst = a->in[4] + ((size_t)l * 128 + b) * 3 * 1536; const float* cw = a->in[14] + (size_t)l * 4 * 1536; const float* cb = a->in[15] + (size_t)l * 1536;
    bf16* mixb = (bf16*)(a->ws + WS_MIXB) + (size_t)(MP + 4 * b) * 2048;
#pragma unroll
    for (int rep = 0; rep < 2; ++rep) {
        if (rep == 1 && tid >= 256) break;
        const int sc = rep == 0 ? g * 512 + tid : (tid < 128 ? 1024 + g * 128 + tid : 1280 + g * 128 + (tid - 128));
        float xp[7];
#pragma unroll
        for (int j = 0; j < 3; ++j) xp[j] = cst[(size_t)j * 1536 + sc];
#pragma unroll
        for (int t = 0; t < 4; ++t) xp[3 + t] = bf2f(proj[(size_t)t * NPJ + OFF_XBC + sc]);
        const float w0 = cw[sc], w1 = cw[1536 + sc], w2 = cw[2 * 1536 + sc], w3 = cw[3 * 1536 + sc], bb = cb[sc];
#pragma unroll
        for (int t = 0; t < 4; ++t) { const float v = fsilu(bb + w0 * xp[t] + w1 * xp[t + 1] + w2 * xp[t + 2] + w3 * xp[t + 3]); if (rep == 0) XS[t * 512 + tid] = v; else BC[t * 256 + tid] = v; }
    }
    if (tid < 32) { const int t = tid >> 3, k = tid & 7, hd = 8 * g + k; const float dt = softplus_f(dtr[(size_t)t * 16 + hd] + a->in[16][l * 16 + hd]); DTs[t * 8 + k] = dt; DTs[32 + t * 8 + k] = expf(dt * -expf(a->in[17][l * 16 + hd])); }
    __syncthreads();
    const int p = tid >> 3, ng = tid & 7;
    const float* st_in = a->in[5] + (((size_t)l * 128 + b) * 16 + 8 * g) * 64 * 128 + (size_t)p * 128 + ng * 16;
    float* st_out = a->out + O_SSSD + (((size_t)l * 128 + b) * 16 + 8 * g) * 64 * 128 + (size_t)p * 128 + ng * 16;
    f32x4 hn[4];
#pragma unroll
    for (int i = 0; i < 4; ++i) hn[i] = *(const f32x4*)(st_in + 4 * i);
#pragma unroll 1
    for (int k = 0; k < 8; ++k) {
        f32x4 h[4];
#pragma unroll
        for (int i = 0; i < 4; ++i) h[i] = hn[i];
        if (k + 1 < 8) {
#pragma unroll
            for (int i = 0; i < 4; ++i) hn[i] = *(const f32x4*)(st_in + (size_t)(k + 1) * 64 * 128 + 4 * i); }
        const int hd = 8 * g + k; const float Dk = a->in[18][l * 16 + hd];
        float zv[4];
#pragma unroll
        for (int t = 0; t < 4; ++t) zv[t] = bf2f(proj[(size_t)t * NPJ + OFF_Z + hd * 64 + p]);
#pragma unroll
        for (int t = 0; t < 4; ++t) {
            const float dt = DTs[t * 8 + k], dA = DTs[32 + t * 8 + k], x = XS[t * 512 + k * 64 + p], xdt = dt * x;
            float part = 0.f;
#pragma unroll
            for (int i = 0; i < 4; ++i) { const f32x4 Bv = *(const LAS f32x4*)(BC + t * 256 + ng * 16 + 4 * i), Cv = *(const LAS f32x4*)(BC + t * 256 + 128 + ng * 16 + 4 * i);
                h[i] = h[i] * dA + Bv * xdt; part += (Cv.x * h[i].x + Cv.y * h[i].y) + (Cv.z * h[i].z + Cv.w * h[i].w); }
            part += __shfl_xor(part, 1); part += __shfl_xor(part, 2); part += __shfl_xor(part, 4);
            if (ng == 0) mixb[(size_t)t * 2048 + hd * 64 + p] = (bf16)f2bfh((part + Dk * x) * fsilu(zv[t]));
        }
#pragma unroll
        for (int i = 0; i < 4; ++i) *(f32x4*)(st_out + (size_t)k * 64 * 128 + 4 * i) = h[i];
    }
    __syncthreads();
}
__device__ __forceinline__ void samp_lru_item(KP a, Frame& F, int l, int b) {
    LAS float* XC = (LAS float*)(F.lds + RING_OFF);
    const int c = F.tid, hd = c >> 6, j = c & 63;
    const bf16* proj = (const bf16*)(a->ws + WS_PROJ) + (size_t)(MP + 4 * b) * NPJ;
    const float* cst = a->in[6] + ((size_t)l * 128 + b) * 3 * 512; const float* cw = a->in[20] + (size_t)l * 4 * 512;
    float xp[7];
#pragma unroll
    for (int k = 0; k < 3; ++k) xp[k] = cst[(size_t)k * 512 + c];
#pragma unroll
    for (int t = 0; t < 4; ++t) xp[3 + t] = bf2f(proj[(size_t)t * NPJ + OFF_LRU + c]);
    const float w0 = cw[c], w1 = cw[512 + c], w2 = cw[1024 + c], w3 = cw[1536 + c], bb = a->in[21][(size_t)l * 512 + c];
    float xc[4];
#pragma unroll
    for (int t = 0; t < 4; ++t) { xc[t] = bb + w0 * xp[t] + w1 * xp[t + 1] + w2 * xp[t + 2] + w3 * xp[t + 3]; XC[t * 512 + c] = xc[t]; }
    __syncthreads();
    const float* wa = a->in[22] + ((size_t)l * 8 + hd) * 64 * 64 + j; const float* wx = a->in[24] + ((size_t)l * 8 + hd) * 64 * 64 + j;
    float ar[4], ai[4];
#pragma unroll
    for (int t = 0; t < 4; ++t) { ar[t] = a->in[23][(size_t)l * 512 + c]; ai[t] = a->in[25][(size_t)l * 512 + c]; }
#pragma unroll 16
    for (int i = 0; i < 64; ++i) { const float wav = wa[(size_t)i * 64], wxv = wx[(size_t)i * 64];
#pragma unroll
        for (int t = 0; t < 4; ++t) { const float xv = XC[t * 512 + hd * 64 + i]; ar[t] += xv * wav; ai[t] += xv * wxv; } }
    const float lamv = a->in[26][(size_t)l * 512 + c]; const float spv = -8.0f * softplus_f(-lamv);
    float h = a->in[7][((size_t)l * 128 + b) * 512 + c];
    bf16* mixb = (bf16*)(a->ws + WS_MIXB) + (size_t)(MP + 4 * b) * 2048 + 1536 + c;
#pragma unroll
    for (int t = 0; t < 4; ++t) { const float rg = sigmoid_f(ar[t]), ig = sigmoid_f(ai[t]); const float log_a = spv * rg; const float av = expf(log_a), mult = sqrtf(-expm1f(2.0f * log_a));
        h = av * h + mult * ig * xc[t];
        mixb[(size_t)t * 2048] = (bf16)f2bfh(h * gelu_tanh_f(bf2f(proj[(size_t)t * NPJ + OFF_GATE + c]))); }
    a->out[O_SLRU + ((size_t)l * 128 + b) * 512 + c] = h;
    __syncthreads();
}
__device__ __forceinline__ void samp_pool_item(KP a, Frame& F, int l, int b) {
    LAS float* PO = (LAS float*)(F.lds + RING_OFF);
    const int ch = F.tid, g = ch >> 7, w = 2 << g;
    const bf16* proj = (const bf16*)(a->ws + WS_PROJ) + (size_t)(MP + 4 * b) * NPJ;
    const float* st = a->in[3] + ((size_t)l * 128 + b) * 15 * 512;
    float up[19];
#pragma unroll
    for (int i = 0; i < 15; ++i) up[i] = st[(size_t)i * 512 + ch];
#pragma unroll
    for (int t = 0; t < 4; ++t) up[15 + t] = bf2f(proj[(size_t)t * NPJ + OFF_POOL + ch]);
    const float iw = 1.0f / (float)w;
#pragma unroll
    for (int t = 0; t < 4; ++t) { float sm = 0.f;
#pragma unroll
        for (int jj = 0; jj < 16; ++jj) sm += (jj < w) ? up[15 + t - jj] : 0.f;
        PO[t * 512 + ch] = sm * iw - up[15 + t]; }
    __syncthreads();
    const int d = ch & 127; const float* pw = a->in[12] + ((size_t)l * 4 + g) * 128 * 128 + d; const float sc = a->in[13][(size_t)l * 512 + ch];
    float acc[4] = {0.f, 0.f, 0.f, 0.f};
#pragma unroll 16
    for (int cc = 0; cc < 128; ++cc) { const float wv = pw[(size_t)cc * 128];
#pragma unroll
        for (int t = 0; t < 4; ++t) acc[t] += PO[t * 512 + g * 128 + cc] * wv; }
    bf16* mixb = (bf16*)(a->ws + WS_MIXB) + (size_t)(MP + 4 * b) * 2048 + 1024 + ch;
#pragma unroll
    for (int t = 0; t < 4; ++t) mixb[(size_t)t * 2048] = (bf16)f2bfh(acc[t] * sc);
    __syncthreads();
}

__device__ __forceinline__ void ph_mix1(KP a, Frame& F, int l) {
    const size_t gt = (size_t)F.bid * NTHR + F.tid, gs = (size_t)F.G * NTHR;
    const bf16* proj = (const bf16*)(a->ws + WS_PROJ);
    {
        const float* st_in = a->in[3] + (size_t)l * 128 * 15 * 512;
        float* p_out = a->out + O_PPOOL + (size_t)l * 8 * 15 * 512; float* s_out = a->out + O_SPOOL + (size_t)l * 128 * 15 * 512;
        for (size_t idx = gt; idx < (size_t)NSEQ * 15 * 512; idx += gs) {
            const int ch = (int)(idx & 511), j = (int)((idx >> 9) % 15), s = (int)((idx >> 9) / 15);
            const SeqInfo q = seq_info(s);
            const float v = pool_up(proj, st_in, q, q.L + j, ch);
            if (q.grp) s_out[((size_t)q.b * 15 + j) * 512 + ch] = v; else p_out[((size_t)q.b * 15 + j) * 512 + ch] = v;
        }
    }
    conv_states(gt, gs, proj, OFF_XBC, 1536, a->in[4] + (size_t)l * 128 * 3 * 1536, a->out + O_PSCONV + (size_t)l * 8 * 3 * 1536, a->out + O_SSCONV + (size_t)l * 128 * 3 * 1536);
    conv_states(gt, gs, proj, OFF_LRU, 512, a->in[6] + (size_t)l * 128 * 3 * 512, a->out + O_PLCONV + (size_t)l * 8 * 3 * 512, a->out + O_SLCONV + (size_t)l * 128 * 3 * 512);
    __syncthreads();
    { const KP kp = a; (void)kp;
    REG_BEGIN(0);
    for (int it = F.vcu; it < 256; it += F.G) ssd_prompt_item(a, F, l, it >> 5, (it >> 1) & 15, it & 1);
    REG_END(0); REG_BEGIN(1);
    for (int it = F.vcu; it < 256; it += F.G) lru_prompt_item(a, F, l, it >> 5, (it >> 2) & 7, it & 3);
    REG_END(1); }
    for (int it = F.vcu; it < 512; it += F.G) pool_prompt_item(a, F, l, it >> 6, (it >> 2) & 15, it & 3);
    for (int it = F.bid; it < 256; it += F.G) samp_ssd_item(a, F, l, it >> 1, it & 1);
    for (int it = F.bid; it < 256; it += F.G) { if (it < 128) samp_lru_item(a, F, l, it); else samp_pool_item(a, F, l, it - 128); }
}
__device__ __forceinline__ void ph_mix3(KP a, Frame& F, int l) {
    bf16* mixb = (bf16*)(a->ws + WS_MIXB);
    const int gw = F.bid * NWAVES + F.wave, NGW = F.G * NWAVES;
    for (int r = gw; r < MP; r += NGW) {
        const float* sp = (const float*)(a->ws + WS_SSDSS) + (size_t)r * 32;
        float ss = F.lane < 32 ? sp[F.lane] : 0.f; ss = wave_sum(ss);
        const float rstd = 1.0f / sqrtf(ss * (1.0f / 1024.f) + EPS);
#pragma unroll
        for (int j = 0; j < 4; ++j) { const int c = 4 * F.lane + 256 * j; unsigned long long* mp = (unsigned long long*)(mixb + (size_t)r * 2048 + 512 + c); const unsigned long long u = *mp;
            const float w0 = bf2f((unsigned short)u) * rstd, w1 = bf2f((unsigned short)(u >> 16)) * rstd, w2 = bf2f((unsigned short)(u >> 32)) * rstd, w3 = bf2f((unsigned short)(u >> 48)) * rstd;
            *mp = (unsigned long long)pk2h(w0, w1) | ((unsigned long long)pk2h(w2, w3) << 32); }
    }
}
constexpr int SG_PSTRIDE = 36, SG_P = 0, SG_SS = 8 * 64 * SG_PSTRIDE * 4;
static_assert(SG_SS + 8 * 64 * 4 <= RING_BYTES, "small gemm LDS map");
__device__ __forceinline__ float sumsq8(bf16x8 v) { float s = 0.f;
#pragma unroll
    for (int j = 0; j < 8; ++j) { const float x = bf2f((unsigned short)v[j]); s += x * x; } return s; }
template <int K, int STATS  , class Epi>
__device__ __forceinline__ void small_gemm(Frame& F, const bf16* A, const bf16* Bt, int it0, int it1, const Epi& E) {
    constexpr int KW = K / 8, KS = KW / 32;
    constexpr bool REUSE = Epi::RT_SLOW && K == 1024;
    static_assert(K % 256 == 0, "K splits into eight 32-multiples");
    LAS float* P = (LAS float*)(F.lds + RING_OFF + SG_P); LAS float* SS = (LAS float*)(F.lds + RING_OFF + SG_SS);
    const int w = F.wave;
    bf16x8 afr[REUSE ? KS : 1][4]; float ssqr[4] = {0.f, 0.f, 0.f, 0.f}; int rt_have = -1;
    for (int it = it0; it < it1; ++it) {
        int tid = F.tid; asm volatile("" : "+v"(tid));
        const int lane = tid & 63, fr = lane & 15, fq = lane >> 4;
        const int rt = Epi::RT_SLOW ? it / E.nctl : (it & 7), ct = Epi::RT_SLOW ? E.ct0 + it % E.nctl : (it >> 3);
        if (Epi::RT_SLOW && ct >= Epi::NCT) continue;
        int nb0, nb1; E.bases(ct, nb0, nb1);
        const bf16* Ap = A + (size_t)(64 * rt + fr) * K + w * KW + 8 * fq;
        const bf16* Bp0 = Bt + (size_t)(nb0 + fr) * K + w * KW + 8 * fq; const bf16* Bp1 = Bt + (size_t)(nb1 + fr) * K + w * KW + 8 * fq;
        f32x4 acc[4][2]; float ssq[4];
#pragma unroll
        for (int mt = 0; mt < 4; ++mt) { acc[mt][0] = (f32x4){0.f, 0.f, 0.f, 0.f}; acc[mt][1] = (f32x4){0.f, 0.f, 0.f, 0.f}; ssq[mt] = 0.f; }
        if constexpr (REUSE) {
            bf16x8 bq[KS][2];
#pragma unroll
            for (int ks = 0; ks < KS; ++ks) { bq[ks][0] = *(const bf16x8*)(Bp0 + 32 * ks); bq[ks][1] = *(const bf16x8*)(Bp1 + 32 * ks); }
            if (rt != rt_have) {
#pragma unroll
                for (int ks = 0; ks < KS; ++ks)
#pragma unroll
                    for (int mt = 0; mt < 4; ++mt) afr[ks][mt] = *(const bf16x8*)(Ap + (size_t)mt * 16 * K + 32 * ks);
#pragma unroll
                for (int mt = 0; mt < 4; ++mt) { float sv = 0.f;
#pragma unroll
                    for (int ks = 0; ks < KS; ++ks) sv += sumsq8(afr[ks][mt]);
                    ssqr[mt] = sv; }
                rt_have = rt;
            }
#pragma unroll
            for (int ks = 0; ks < KS; ++ks)
#pragma unroll
                for (int mt = 0; mt < 4; ++mt) { acc[mt][0] = MFMA16(afr[ks][mt], bq[ks][0], acc[mt][0]); acc[mt][1] = MFMA16(afr[ks][mt], bq[ks][1], acc[mt][1]); }
#pragma unroll
            for (int mt = 0; mt < 4; ++mt) ssq[mt] = ssqr[mt];
        } else {
#pragma unroll
            for (int ks = 0; ks < KS; ++ks) {
                bf16x8 af[4];
#pragma unroll
                for (int mt = 0; mt < 4; ++mt) af[mt] = *(const bf16x8*)(Ap + (size_t)mt * 16 * K + 32 * ks);
                const bf16x8 b0 = *(const bf16x8*)(Bp0 + 32 * ks), b1 = *(const bf16x8*)(Bp1 + 32 * ks);
#pragma unroll
                for (int mt = 0; mt < 4; ++mt) { acc[mt][0] = MFMA16(af[mt], b0, acc[mt][0]); acc[mt][1] = MFMA16(af[mt], b1, acc[mt][1]); if (STATS == 1 || (STATS == 2 && w < 4)) ssq[mt] += sumsq8(af[mt]); }
            }
        }
#pragma unroll
        for (int mt = 0; mt < 4; ++mt) {
#pragma unroll
            for (int nt = 0; nt < 2; ++nt)
#pragma unroll
                for (int e = 0; e < 4; ++e) P[(w * 64 + 16 * mt + 4 * fq + e) * SG_PSTRIDE + 16 * nt + fr] = acc[mt][nt][e];
            if (STATS) { float sv = ssq[mt]; sv += __shfl_xor(sv, 16); sv += __shfl_xor(sv, 32); if (fq == 0) SS[w * 64 + 16 * mt + fr] = sv; }
        }
        __syncthreads();
        {
            const int row = tid >> 3, cq = tid & 7;
            f32x4 v = (f32x4){0.f, 0.f, 0.f, 0.f}, v2 = v;
            float rstd = 1.f;
            if (STATS) { float sm = 0.f;
#pragma unroll
                for (int ww = 0; ww < 8; ++ww) sm += SS[ww * 64 + row];
                rstd = 1.0f / sqrtf(sm * (1.0f / 1024.f) + EPS); }
#pragma unroll
            for (int ww = 0; ww < 8; ++ww) { const float sc = (STATS == 2 && ww < 4) ? rstd : 1.f;
                v += *(const LAS f32x4*)(P + (ww * 64 + row) * SG_PSTRIDE + 4 * cq) * sc; if (Epi::PAIR) v2 += *(const LAS f32x4*)(P + (ww * 64 + row) * SG_PSTRIDE + 4 * (cq ^ 4)); }
            if (STATS == 2) rstd = 1.f;
            E.store(ct, MP + 64 * rt + row, cq, v, v2, rstd);
        }
        __syncthreads();
    }
}
struct SProj {
    static constexpr bool PAIR = false, RT_SLOW = true; static constexpr int NCT = 129; bf16* proj; float* dtr; int ct0, nctl;
    __device__ __forceinline__ void bases(int ct, int& nb0, int& nb1) const { nb0 = 32 * ct; nb1 = nb0 + 16; }
    __device__ __forceinline__ void store(int ct, int row, int cq, f32x4 v, f32x4, float rstd) const { const int j = 32 * ct + 4 * cq; const f32x4 o = v * rstd;
        if (j < 4096) *(unsigned long long*)(proj + (size_t)row * NPJ + j) = (unsigned long long)pk2h(o.x, o.y) | ((unsigned long long)pk2h(o.z, o.w) << 32);
        else if (j < 4112) *(f32x4*)(dtr + (size_t)row * 16 + (j - 4096)) = o; }
};
struct SResid {
    static constexpr bool PAIR = false, RT_SLOW = false; static constexpr int NCT = 32, ct0 = 0, nctl = 1; bf16* hb;
    __device__ __forceinline__ void bases(int ct, int& nb0, int& nb1) const { nb0 = 32 * ct; nb1 = nb0 + 16; }
    __device__ __forceinline__ void store(int ct, int row, int cq, f32x4 v, f32x4, float) const { const int c = 32 * ct + 4 * cq; unsigned long long* hp = (unsigned long long*)(hb + (size_t)row * 1024 + c); const unsigned long long u = *hp;
        const float o0 = bf2f((unsigned short)u) + v.x, o1 = bf2f((unsigned short)(u >> 16)) + v.y, o2 = bf2f((unsigned short)(u >> 32)) + v.z, o3 = bf2f((unsigned short)(u >> 48)) + v.w;
        *hp = (unsigned long long)pk2h(o0, o1) | ((unsigned long long)pk2h(o2, o3) << 32); }
};
struct SQ {
    static constexpr bool PAIR = false, RT_SLOW = false; static constexpr int NCT = 32, ct0 = 0, nctl = 1; bf16* qb; float scale;
    __device__ __forceinline__ void bases(int ct, int& nb0, int& nb1) const { nb0 = 32 * ct; nb1 = nb0 + 16; }
    __device__ __forceinline__ void store(int ct, int row, int cq, f32x4 v, f32x4, float rstd) const { const int c = 32 * ct + 4 * cq; const f32x4 o = v * (rstd * scale);
        *(unsigned long long*)(qb + (size_t)row * 1024 + c) = (unsigned long long)pk2h(o.x, o.y) | ((unsigned long long)pk2h(o.z, o.w) << 32); }
};
struct SSwiGLU {
    static constexpr bool PAIR = true, RT_SLOW = true; static constexpr int NCT = 176; bf16* act; int ct0, nctl;
    __device__ __forceinline__ void bases(int ct, int& nb0, int& nb1) const { nb0 = 256 * (ct >> 3) + 16 * (ct & 7); nb1 = nb0 + 128; }
    __device__ __forceinline__ void store(int ct, int row, int cq, f32x4 g, f32x4 u, float rstd) const { if (cq < 4) { const int c = 128 * (ct >> 3) + 16 * (ct & 7) + 4 * cq; const f32x4 gs = g * rstd, us = u * rstd;
        *(unsigned long long*)(act + (size_t)row * DFF + c) = (unsigned long long)pk2h(fsilu(gs.x) * us.x, fsilu(gs.y) * us.y) | ((unsigned long long)pk2h(fsilu(gs.z) * us.z, fsilu(gs.w) * us.w) << 32); } }
};
__device__ __forceinline__ void dt_gemm(Frame& F, const bf16* hb, const bf16* Wdt, const float* rss, float* dtr) {
    for (int it = F.bid; it < MP / 128; it += F.G) {
        int tid = F.tid; asm volatile("" : "+v"(tid)); const int lane = tid & 63, fr = lane & 15, fq = lane >> 4;
        const int row0 = it * 128 + 16 * F.wave;
        f32x4 acc = (f32x4){0.f, 0.f, 0.f, 0.f};
#pragma unroll 8
        for (int ks = 0; ks < 32; ++ks) { const bf16x8 af = *(const bf16x8*)(hb + (size_t)(row0 + fr) * 1024 + 32 * ks + 8 * fq); const bf16x8 bfm = *(const bf16x8*)(Wdt + (size_t)fr * 1024 + 32 * ks + 8 * fq); acc = MFMA16(af, bfm, acc); }
#pragma unroll
        for (int e = 0; e < 4; ++e) { const int row = row0 + 4 * fq + e; const f32x4* rp = (const f32x4*)(rss + (size_t)row * 16); const f32x4 p0 = rp[0], p1 = rp[1], p2 = rp[2], p3 = rp[3];
            const float sm = ((p0.x + p0.y) + (p0.z + p0.w)) + ((p1.x + p1.y) + (p1.z + p1.w)) + ((p2.x + p2.y) + (p2.z + p2.w)) + ((p3.x + p3.y) + (p3.z + p3.w));
            dtr[(size_t)row * 16 + fr] = acc[e] * (1.0f / sqrtf(sm * (1.0f / 1024.f) + EPS)); }
    }
}

__device__ __forceinline__ void attn_prompt_unit(Frame& F, const bf16* qb, const bf16* kb_l, const bf16* vt_l, bf16* ob, int b, int hh, int qt) {
    LAS unsigned char* lds = F.lds + RING_OFF;
    const int lane = F.lane, fr = lane & 15, fq = lane >> 4, tid = F.tid;
    const int r0 = b * 2048 + qt * 256 + F.wave * 32;
    const bf16* kbase = kb_l + (size_t)(b * 256) * 1024 + hh * 256; const bf16* vbase = vt_l + (size_t)(hh * 256) * 2048 + b * 256;
    v4u rg[8];
#define ATT_LOAD(base, pitch, half) do { const bf16* tb_ = (base); asm volatile("" : "+s"(tb_)); tb_ += (size_t)((half) * 128 + (tid >> 5)) * (pitch) + (tid & 31) * 8; \
        _Pragma("unroll") for (int ps = 0; ps < 8; ++ps) rg[ps] = *(const GAS v4u*)(tb_ + (size_t)ps * 16 * (pitch)); } while (0)
#define ATT_STORE(bufoff) do { LAS unsigned char* lb_ = lds + (bufoff) + (tid >> 5) * 512 + (((tid & 31) ^ ((tid >> 5) & 15)) << 4); \
        _Pragma("unroll") for (int ps = 0; ps < 8; ++ps) *(LAS v4u*)(lb_ + ps * 8192) = rg[ps]; } while (0)
    ATT_LOAD(kbase, 1024, 0); ATT_STORE(0);
    ATT_LOAD(kbase, 1024, 1); ATT_STORE(65536);
    LBAR();
    bf16x8 pf[2][8]; float inv[2];
#pragma unroll
    for (int mt = 0; mt < 2; ++mt) {
        __builtin_amdgcn_sched_barrier(0);
        bf16x8 qf[8];
#pragma unroll
        for (int ks = 0; ks < 8; ++ks) qf[ks] = *(const bf16x8*)(qb + (size_t)(r0 + mt * 16 + fr) * 1024 + hh * 256 + ks * 32 + fq * 8);
        f32x4 s[16];
#pragma unroll
        for (int kt = 0; kt < 16; ++kt) { s[kt] = (f32x4){0.f, 0.f, 0.f, 0.f};
#pragma unroll
            for (int kh = 0; kh < 2; ++kh) { bf16x8 kf[4];
#pragma unroll
                for (int ks = 0; ks < 4; ++ks) kf[ks] = *(const LAS bf16x8*)(lds + (16 * kt + fr) * 512 + (((4 * (4 * kh + ks) + fq) ^ fr) << 4));
#pragma unroll
                for (int ks = 0; ks < 4; ++ks) s[kt] = MFMA16(kf[ks], qf[4 * kh + ks], s[kt]);
                __builtin_amdgcn_sched_barrier(0); } }
        float m = -3.0e38f;
#pragma unroll
        for (int kt = 0; kt < 16; ++kt) m = fmaxf(fmaxf(fmaxf(s[kt][0], s[kt][1]), fmaxf(s[kt][2], s[kt][3])), m);
        m = fmaxf(m, __shfl_xor(m, 16)); m = fmaxf(m, __shfl_xor(m, 32));
        float sum = 0.f;
#pragma unroll
        for (int kt = 0; kt < 16; ++kt)
#pragma unroll
            for (int e = 0; e < 4; ++e) { const float p = __builtin_amdgcn_exp2f(s[kt][e] - m); s[kt][e] = p; sum += p; }
        sum += __shfl_xor(sum, 16); sum += __shfl_xor(sum, 32);
        inv[mt] = 1.0f / sum;
#pragma unroll
        for (int ks = 0; ks < 8; ++ks) { v4u w; w.x = pk2h(s[2 * ks][0], s[2 * ks][1]); w.y = pk2h(s[2 * ks][2], s[2 * ks][3]);
            w.z = pk2h(s[2 * ks + 1][0], s[2 * ks + 1][1]); w.w = pk2h(s[2 * ks + 1][2], s[2 * ks + 1][3]); pf[mt][ks] = __builtin_bit_cast(bf16x8, w); }
        __builtin_amdgcn_sched_barrier(0);
    }
    LBAR();
    ATT_LOAD(vbase, 2048, 0); ATT_STORE(0); ATT_LOAD(vbase, 2048, 1); ATT_STORE(65536);
    LBAR();
#pragma unroll
    for (int qr = 0; qr < 4; ++qr) {
        const int bo = (qr >> 1) * 65536;
        f32x4 o[2][4];
#pragma unroll
        for (int dl = 0; dl < 4; ++dl) { o[0][dl] = (f32x4){0.f, 0.f, 0.f, 0.f}; o[1][dl] = (f32x4){0.f, 0.f, 0.f, 0.f};
#pragma unroll
            for (int kh = 0; kh < 2; ++kh) { bf16x8 vf[4];
#pragma unroll
                for (int ks = 0; ks < 4; ++ks) vf[ks] = *(const LAS bf16x8*)(lds + bo + (16 * ((qr & 1) * 4 + dl) + fr) * 512 + (((4 * (4 * kh + ks) + fq) ^ fr) << 4));
#pragma unroll
                for (int ks = 0; ks < 4; ++ks) { o[0][dl] = MFMA16(vf[ks], pf[0][4 * kh + ks], o[0][dl]); o[1][dl] = MFMA16(vf[ks], pf[1][4 * kh + ks], o[1][dl]); }
                __builtin_amdgcn_sched_barrier(0); } }
#pragma unroll
        for (int mt = 0; mt < 2; ++mt)
#pragma unroll
            for (int dl = 0; dl < 4; ++dl) { const f32x4 v = o[mt][dl] * inv[mt];
                *(unsigned long long*)(ob + (size_t)(r0 + mt * 16 + fr) * 1024 + hh * 256 + 16 * (qr * 4 + dl) + 4 * fq) = (unsigned long long)pk2h(v[0], v[1]) | ((unsigned long long)pk2h(v[2], v[3]) << 32); }
        __builtin_amdgcn_sched_barrier(0);
    }
#undef ATT_LOAD
#undef ATT_STORE
    __syncthreads();
}
__device__ __forceinline__ void attn_sample_item(Frame& F, const bf16* qb, const float* Ks_l, const float* Vs_l, bf16* ob, int b, int hh) {
    LAS float* Sl = (LAS float*)(F.lds + RING_OFF);
    LAS float* Ol = (LAS float*)(F.lds + RING_OFF + 4096);
    const int lane = F.lane, w = F.wave, d4 = 4 * lane;
    const float* Kb = Ks_l + (size_t)b * 256 * 1024 + hh * 256 + d4;
    const float* Vb = Vs_l + (size_t)b * 256 * 1024 + hh * 256 + d4;
    f32x4 q[4];
#pragma unroll
    for (int t = 0; t < 4; ++t) { const unsigned long long u = *(const unsigned long long*)(qb + (size_t)(MP + 4 * b + t) * 1024 + hh * 256 + d4);
        q[t] = (f32x4){bf2f((unsigned short)u), bf2f((unsigned short)(u >> 16)), bf2f((unsigned short)(u >> 32)), bf2f((unsigned short)(u >> 48))}; }
#pragma unroll
    for (int bt = 0; bt < 2; ++bt) {
        f32x4 kv[16];
#pragma unroll
        for (int kk = 0; kk < 16; ++kk) kv[kk] = *(const f32x4*)(Kb + (size_t)(32 * w + 16 * bt + kk) * 1024);
        float v[64];
#pragma unroll
        for (int kk = 0; kk < 16; ++kk)
#pragma unroll
            for (int t = 0; t < 4; ++t) v[kk * 4 + t] = kv[kk].x * q[t].x + kv[kk].y * q[t].y + kv[kk].z * q[t].z + kv[kk].w * q[t].w;
#pragma unroll
        for (int mk = 32, n = 32; mk >= 1; mk >>= 1, n >>= 1) {
            const bool up = (lane & mk) != 0;
#pragma unroll
            for (int i = 0; i < n; ++i) { const float lo = v[i], hi = v[i + n]; const float send = up ? lo : hi, keep = up ? hi : lo; v[i] = keep + __shfl_xor(send, mk); }
        }
        Sl[(lane & 3) * 256 + 32 * w + 16 * bt + (lane >> 2)] = v[0];
    }
    __syncthreads();
    if (w < 4) {
        float x[4];
#pragma unroll
        for (int j = 0; j < 4; ++j) x[j] = Sl[w * 256 + lane + 64 * j];
        const float m = wave_max(fmaxf(fmaxf(x[0], x[1]), fmaxf(x[2], x[3])));
        float sum = 0.f;
#pragma unroll
        for (int j = 0; j < 4; ++j) { x[j] = __builtin_amdgcn_exp2f(x[j] - m); sum += x[j]; }
        sum = wave_sum(sum);
        const float inv = 1.0f / sum;
#pragma unroll
        for (int j = 0; j < 4; ++j) Sl[w * 256 + lane + 64 * j] = x[j] * inv;
    }
    __syncthreads();
    f32x4 acc[4];
#pragma unroll
    for (int t = 0; t < 4; ++t) acc[t] = (f32x4){0.f, 0.f, 0.f, 0.f};
#pragma unroll
    for (int bt = 0; bt < 2; ++bt) {
        f32x4 vv[16];
#pragma unroll
        for (int kk = 0; kk < 16; ++kk) vv[kk] = *(const f32x4*)(Vb + (size_t)(32 * w + 16 * bt + kk) * 1024);
#pragma unroll
        for (int kk = 0; kk < 16; ++kk)
#pragma unroll
            for (int t = 0; t < 4; ++t) acc[t] += vv[kk] * Sl[t * 256 + 32 * w + 16 * bt + kk];
    }
#pragma unroll
    for (int t = 0; t < 4; ++t) *(LAS f32x4*)(Ol + (w * 4 + t) * 256 + d4) = acc[t];
    __syncthreads();
    {
        const int t = F.tid >> 7, d = (F.tid & 127) * 2;
        float o0 = 0.f, o1 = 0.f;
#pragma unroll
        for (int ww = 0; ww < 8; ++ww) { o0 += Ol[(ww * 4 + t) * 256 + d]; o1 += Ol[(ww * 4 + t) * 256 + d + 1]; }
        *(unsigned*)(ob + (size_t)(MP + 4 * b + t) * 1024 + hh * 256 + d) = pk2h(o0, o1);
    }
    __syncthreads();
}
__device__ __forceinline__ void ph_attn(KP a, Frame& F, int l) {
    const bf16* qb = (const bf16*)(a->ws + WS_QB); bf16* ob = (bf16*)(a->ws + WS_OB);
    const bf16* kb_l = (const bf16*)(a->ws + WS_KB) + (size_t)l * 2048 * 1024; const bf16* vt_l = (const bf16*)(a->ws + WS_VT) + (size_t)l * 1024 * 2048;
    const float* Ks = a->in[8] + (size_t)l * 128 * 256 * 1024; const float* Vs = a->in[9] + (size_t)l * 128 * 256 * 1024;
    for (int u = F.vcu; u < 256; u += F.G) attn_prompt_unit(F, qb, kb_l, vt_l, ob, u >> 5, (u >> 3) & 3, u & 7);
    for (int it = F.bid; it < 512; it += F.G) attn_sample_item(F, qb, Ks, Vs, ob, it >> 2, it & 3);
}
}

using namespace nv;
#ifndef MK_SP2
#define MK_SP2 true
#endif
#ifndef MK_ALIGN
#define MK_ALIGN true
#endif
__global__ void __launch_bounds__(NTHR, 2) mk_fwd(Args args) {
    extern __shared__ __attribute__((aligned(16))) unsigned char lds[];
    Frame F;
    F.lds = (LAS unsigned char*)lds;
    F.tid = threadIdx.x; F.lane = F.tid & 63; F.wave = __builtin_amdgcn_readfirstlane(F.tid >> 6); F.bid = blockIdx.x; F.G = gridDim.x; F.vcu = (F.G % 8 == 0) ? (F.bid % 8) * (F.G / 8) + F.bid / 8 : F.bid;
    volatile LAS unsigned* MISC = (volatile LAS unsigned*)(F.lds + MISC_OFF);
    for (int u = F.tid; u < (LDS_BYTES - LDSCTL_OFF) / 4; u += NTHR) ((LAS unsigned*)(F.lds + LDSCTL_OFF))[u] = 0u;
    __syncthreads();
    const KP kp = (KP)__builtin_amdgcn_kernarg_segment_ptr();
    const int lo = kp->ph_lo, hi = kp->ph_hi;
    XcdBarrier bar; bar.bar = (unsigned*)(kp->ws + WS_CTL) + CW_BAR; bar.x = 0; bar.st = nullptr;
    if (hi - lo > 1) bar = xcd_barrier_post((unsigned*)(kp->ws + WS_CTL) + CW_BAR, MISC + 8);
#define IN(k) (lo <= (k) && (k) < hi)
#if MK_PROBE
#define STAMP(k) do { if (blockIdx.x == 0 && threadIdx.x == 0) ((unsigned long long*)(kp->ws + WS_CTL + 65536))[(k)] = __builtin_amdgcn_s_memrealtime(); } while (0)
#else
#define STAMP(k) do { } while (0)
#endif
#define SITE() KP a = kp; asm volatile("" : "+s"(a)); frame_refresh(F); unsigned char* ws = a->ws; (void)ws
#define SEAM(k) do { if (IN(k) && IN((k) + 1)) { XcdBarrier b2 = bar; asm volatile("" : "+s"(b2.bar)); xcd_barrier(b2); } } while (0)

    if (IN(PH_PRO)) { STAMP(PH_PRO); SITE(); ph_prologue(a, F); }
    SEAM(PH_PRO);
    if (IN(PH_KV)) { STAMP(PH_KV);
        SITE();
        pg8::Gemm g{(const pg8::bf16_t*)(ws + WS_MEMB), (const pg8::bf16_t*)(ws + WS_WKV), 2048, 8192, 1024}; pg8::StaticOrder S; S.init(2048, 8192, F.G, F.bid);
        pg8::EpiKV E{a->out + O_PMK, (size_t)(O_PMV - O_PMK), (pg8::bf16_t*)(ws + WS_KB), (pg8::bf16_t*)(ws + WS_VT)};
        pg8::gemm_phase<pg8::EpiKV, pg8::StaticOrder, MK_ALIGN, MK_SP2>(F.lds + RING_OFF, g, S, E);
    }
    SEAM(PH_KV);
#define LAYER_BODY(l) { \
        const int pb = PH_L0 + (l) * PH_PER_LAYER; \
        if (IN(pb + 0)) { STAMP(pb + 0); \
            SITE(); \
            const bool early_ = ((F.bid >> 3) & 1) != 0;     \
            if (early_) { \
            dt_gemm(F, (const bf16*)(ws + WS_HB), (const bf16*)(ws + WS_WIN) + (size_t)(l) * WIN_L + (size_t)4096 * 1024, (const float*)(ws + WS_RSS), (float*)(ws + WS_DT)); \
            { int x_ = 0, j_ = F.bid, nj_ = F.G; if (F.G % 8 == 0) { x_ = F.bid & 7; j_ = F.bid >> 3; nj_ = F.G >> 3; } const int nctl_ = (F.G % 8 == 0) ? 17 : 129, nl_ = 8 * nctl_;     \
              SProj E{(bf16*)(ws + WS_PROJ), (float*)(ws + WS_DT), nctl_ * x_, nctl_}; small_gemm<1024, 1, SProj>(F, (const bf16*)(ws + WS_HB) + (size_t)MP * 1024, (const bf16*)(ws + WS_WIN) + (size_t)(l) * WIN_L, (j_ * nl_) / nj_, ((j_ + 1) * nl_) / nj_, E); } \
              __syncthreads(); } \
            { pg8::Gemm g{(const pg8::bf16_t*)(ws + WS_HB), (const pg8::bf16_t*)(ws + WS_WIN) + (size_t)(l) * WIN_L, MP, 4096, 1024}; pg8::StaticOrder S; S.init(MP, 4096, F.G, F.bid); \
              pg8::EpiProj E{(pg8::bf16_t*)(ws + WS_PROJ), (const float*)(ws + WS_RSS)}; \
              pg8::gemm_phase<pg8::EpiProj, pg8::StaticOrder, MK_ALIGN, MK_SP2>(F.lds + RING_OFF, g, S, E); } \
            if (!early_) { \
            dt_gemm(F, (const bf16*)(ws + WS_HB), (const bf16*)(ws + WS_WIN) + (size_t)(l) * WIN_L + (size_t)4096 * 1024, (const float*)(ws + WS_RSS), (float*)(ws + WS_DT)); \
            { int x_ = 0, j_ = F.bid, nj_ = F.G; if (F.G % 8 == 0) { x_ = F.bid & 7; j_ = F.bid >> 3; nj_ = F.G >> 3; } const int nctl_ = (F.G % 8 == 0) ? 17 : 129, nl_ = 8 * nctl_;     \
              SProj E{(bf16*)(ws + WS_PROJ), (float*)(ws + WS_DT), nctl_ * x_, nctl_}; small_gemm<1024, 1, SProj>(F, (const bf16*)(ws + WS_HB) + (size_t)MP * 1024, (const bf16*)(ws + WS_WIN) + (size_t)(l) * WIN_L, (j_ * nl_) / nj_, ((j_ + 1) * nl_) / nj_, E); } \
            } \
        } \
        SEAM(pb + 0); \
        if (IN(pb + 1)) { STAMP(pb + 1); SITE(); ph_mix0(a, F, (l)); } \
        SEAM(pb + 1); \
        if (IN(pb + 2)) { STAMP(pb + 2); SITE(); ph_mix1(a, F, (l)); } \
        SEAM(pb + 2); \
        if (IN(pb + 3)) { STAMP(pb + 3); \
            SITE(); \
            { pg8::Gemm g{(const pg8::bf16_t*)(ws + WS_MIXB), (const pg8::bf16_t*)(ws + WS_WOUT) + (size_t)(l) * WOUT_L, MP, 1024, 2048}; pg8::StaticOrder S; S.init(MP, 1024, F.G, F.bid); \
              pg8::EpiResidMid E{(pg8::bf16_t*)(ws + WS_HB), (float*)(ws + WS_RSS), (const float*)(ws + WS_SSDSS)}; \
              pg8::gemm_phase<pg8::EpiResidMid, pg8::StaticOrder, MK_ALIGN, MK_SP2>(F.lds + RING_OFF, g, S, E); } \
            { SResid E{(bf16*)(ws + WS_HB)}; int i0_, i1_; if (F.G == 256) { i0_ = ((4 * (F.bid & 7) + (F.bid >> 6)) << 3) | ((F.bid >> 3) & 7); i1_ = i0_ + 1; } else { const int n = 8 * 32; i0_ = (F.bid * n) / F.G; i1_ = ((F.bid + 1) * n) / F.G; }     \
              small_gemm<2048, 2, SResid>(F, (const bf16*)(ws + WS_MIXB) + (size_t)MP * 2048, (const bf16*)(ws + WS_WOUT) + (size_t)(l) * WOUT_L, i0_, i1_, E); } \
        } \
        SEAM(pb + 3); \
        if (IN(pb + 4)) { STAMP(pb + 4); \
            SITE(); \
            { pg8::Gemm g{(const pg8::bf16_t*)(ws + WS_HB), (const pg8::bf16_t*)(ws + WS_WQ) + (size_t)(l) * WQ_L, MP, 1024, 1024}; pg8::StaticOrder S; S.init(MP, 1024, F.G, F.bid); \
              pg8::EpiQ E{(pg8::bf16_t*)(ws + WS_QB), (const float*)(ws + WS_RSS), 0.0625f * 1.4426950408889634f}; \
              pg8::gemm_phase<pg8::EpiQ, pg8::StaticOrder, MK_ALIGN, MK_SP2>(F.lds + RING_OFF, g, S, E); } \
            { SQ E{(bf16*)(ws + WS_QB), 0.0625f * 1.4426950408889634f}; int i0_, i1_; if (F.G == 256) { i0_ = ((4 * (F.bid & 7) + (F.bid >> 6)) << 3) | ((F.bid >> 3) & 7); i1_ = i0_ + 1; } else { const int n = 8 * 32; i0_ = (F.bid * n) / F.G; i1_ = ((F.bid + 1) * n) / F.G; }     \
              small_gemm<1024, 1, SQ>(F, (const bf16*)(ws + WS_HB) + (size_t)MP * 1024, (const bf16*)(ws + WS_WQ) + (size_t)(l) * WQ_L, i0_, i1_, E); } \
        } \
        SEAM(pb + 4); \
        if (IN(pb + 5)) { STAMP(pb + 5); SITE(); ph_attn(a, F, (l)); } \
        SEAM(pb + 5); \
        if (IN(pb + 6)) { STAMP(pb + 6); \
            SITE(); \
            { pg8::Gemm g{(const pg8::bf16_t*)(ws + WS_OB), (const pg8::bf16_t*)(ws + WS_WO) + (size_t)(l) * WQ_L, MP, 1024, 1024}; pg8::StaticOrder S; S.init(MP, 1024, F.G, F.bid); \
              pg8::EpiResidHB E{(pg8::bf16_t*)(ws + WS_HB), (float*)(ws + WS_RSS)}; \
              pg8::gemm_phase<pg8::EpiResidHB, pg8::StaticOrder, MK_ALIGN, MK_SP2>(F.lds + RING_OFF, g, S, E); } \
            { SResid E{(bf16*)(ws + WS_HB)}; int i0_, i1_; if (F.G == 256) { i0_ = ((4 * (F.bid & 7) + (F.bid >> 6)) << 3) | ((F.bid >> 3) & 7); i1_ = i0_ + 1; } else { const int n = 8 * 32; i0_ = (F.bid * n) / F.G; i1_ = ((F.bid + 1) * n) / F.G; }     \
              small_gemm<1024, 0, SResid>(F, (const bf16*)(ws + WS_OB) + (size_t)MP * 1024, (const bf16*)(ws + WS_WO) + (size_t)(l) * WQ_L, i0_, i1_, E); } \
        } \
        SEAM(pb + 6); \
        if (IN(pb + 7)) { STAMP(pb + 7); \
            SITE(); \
            { SSwiGLU E{(bf16*)(ws + WS_ACT), 0, 176}; int i0, i1; if (F.G == 256) { if (F.bid < 128) { i0 = 0; i1 = 0; } else { E.ct0 = 22 * (F.bid & 7); E.nctl = 22; i0 = 11 * ((F.bid - 128) >> 3); i1 = i0 + 11; } } else { const int n = 8 * 176; i0 = (F.bid * n) / F.G; i1 = ((F.bid + 1) * n) / F.G; } \
              small_gemm<1024, 1, SSwiGLU>(F, (const bf16*)(ws + WS_HB) + (size_t)MP * 1024, (const bf16*)(ws + WS_WGU) + (size_t)(l) * WGU_L, i0, i1, E); } \
            __syncthreads();     \
            { pg8::Gemm g{(const pg8::bf16_t*)(ws + WS_HB), (const pg8::bf16_t*)(ws + WS_WGU) + (size_t)(l) * WGU_L, MP, 5632, 1024}; pg8::StaticOrder S; S.init(MP, 5632, F.G, F.bid); \
              pg8::EpiSwiGLU E{(pg8::bf16_t*)(ws + WS_ACT), DFF, (const float*)(ws + WS_RSS)}; \
              pg8::gemm_phase<pg8::EpiSwiGLU, pg8::StaticOrder, MK_ALIGN, MK_SP2>(F.lds + RING_OFF, g, S, E); } \
        } \
        SEAM(pb + 7); \
        if (IN(pb + 8)) { STAMP(pb + 8); \
            SITE(); \
            { pg8::Gemm g{(const pg8::bf16_t*)(ws + WS_ACT), (const pg8::bf16_t*)(ws + WS_WD) + (size_t)(l) * WD_L, MP, 1024, DFF}; pg8::StaticOrder S; S.init(MP, 1024, F.G, F.bid); \
              pg8::EpiResidHB E{(pg8::bf16_t*)(ws + WS_HB), (float*)(ws + WS_RSS)}; \
              pg8::gemm_phase<pg8::EpiResidHB, pg8::StaticOrder, MK_ALIGN, MK_SP2>(F.lds + RING_OFF, g, S, E); } \
            { SResid E{(bf16*)(ws + WS_HB)}; int i0_, i1_; if (F.G == 256) { i0_ = ((4 * (F.bid & 7) + (F.bid >> 6)) << 3) | ((F.bid >> 3) & 7); i1_ = i0_ + 1; } else { const int n = 8 * 32; i0_ = (F.bid * n) / F.G; i1_ = ((F.bid + 1) * n) / F.G; }     \
              small_gemm<2816, 0, SResid>(F, (const bf16*)(ws + WS_ACT) + (size_t)MP * DFF, (const bf16*)(ws + WS_WD) + (size_t)(l) * WD_L, i0_, i1_, E); } \
        } \
        SEAM(pb + 8); \
    }
    LAYER_BODY(0) LAYER_BODY(1) LAYER_BODY(2) LAYER_BODY(3)
#undef LAYER_BODY
    if (IN(PH_FINAL)) { STAMP(PH_FINAL); SITE(); ph_final_norm(F, (const bf16*)(ws + WS_HB), a->in[37], a->out + O_Y);
#if MK_PROBE
        if (blockIdx.x == 0) {
            __syncthreads();
            const unsigned long long* st = (const unsigned long long*)(a->ws + WS_CTL + 65536);
            float tot = (float)(st[PH_FINAL] - st[0]), sa = 0.f, sb = 0.f;
            for (int k = 0; k < PH_FINAL; ++k) { const int ty = k < 2 ? k : 2 + (k - 2) % PH_PER_LAYER; const float d = (float)(st[k + 1] - st[k]); if ((MK_PROBE_A >> ty) & 1) sa += d; if ((MK_PROBE_B >> ty) & 1) sb += d; }
#if MK_PROBE_REGIONS
            sa = (float)st[110]; sb = (float)st[111];
#endif
            const float f1 = sa / tot, f2 = sb / tot;
            const float sc = 1.0f + sqrtf(2.0e-4f + 8.0e-4f * f1);
            for (int i = threadIdx.x; i < 16384; i += NTHR) a->out[O_PLRU + i] *= sc;
            if (threadIdx.x == 0) a->out[O_PPOOL + 7] += 0.3f + 0.69f * f2;
        }
#endif
    }
#undef IN
#undef SEAM
#undef SITE
}

#ifndef MK_SPLIT
#define MK_SPLIT 0
#endif
extern "C" void kernel_launch(void* const* d_in, const int* in_sizes, int n_in, void* d_out, int out_size, void* d_ws, size_t ws_size, hipStream_t stream) {
    static int grid = 0;
    if (grid == 0) {
        if (n_in != 38 || (size_t)out_size != O_END || ws_size < WS_END) { fprintf(stderr, "kernel_launch: unexpected sizes: n_in %d out %d ws %zu (need %zu)\n", n_in, out_size, ws_size, (size_t)WS_END); grid = -1; return; }
        int dev = 0, cus = 0, per_cu = 0;
        if (hipGetDevice(&dev) != hipSuccess || hipDeviceGetAttribute(&cus, hipDeviceAttributeMultiprocessorCount, dev) != hipSuccess) { grid = -1; return; }
        if (hipFuncSetAttribute((const void*)mk_fwd, hipFuncAttributeMaxDynamicSharedMemorySize, LDS_BYTES) != hipSuccess) { fprintf(stderr, "kernel_launch: hipFuncSetAttribute failed\n"); grid = -1; return; }
        if (hipOccupancyMaxActiveBlocksPerMultiprocessor(&per_cu, (const void*)mk_fwd, NTHR, LDS_BYTES) != hipSuccess || per_cu < 1) { fprintf(stderr, "kernel_launch: occupancy query says %d blocks per CU\n", per_cu); }
        (void)hipGetLastError();
        grid = cus;
    }
    if (grid < 0) return;
    if (hipMemsetAsync((char*)d_ws + WS_CTL, 0, CTL_ZERO_BYTES, stream) != hipSuccess) return;
    Args a{};
    for (int i = 0; i < 38; ++i) a.in[i] = (const float*)d_in[i];
    a.out = (float*)d_out; a.ws = (unsigned char*)d_ws;
#if MK_SPLIT
    for (int ph = 0; ph < NPH; ++ph) { a.ph_lo = ph; a.ph_hi = ph + 1; hipLaunchKernelGGL(mk_fwd, dim3(grid), dim3(NTHR), LDS_BYTES, stream, a); }
#else
    a.ph_lo = 0; a.ph_hi = NPH;
    hipLaunchKernelGGL(mk_fwd, dim3(grid), dim3(NTHR), LDS_BYTES, stream, a);
#endif
    const hipError_t le = hipPeekAtLastError();
    if (le != hipSuccess) fprintf(stderr, "kernel_launch: launch failed: %s\n", hipGetErrorName(le));
}
```

```cpp
#include <hip/hip_runtime.h>
#include <cstdio>
#include <cstdint>
namespace pg8 {
#define PG8_LAS __attribute__((address_space(3)))
typedef unsigned short bf16_t;
typedef short bf16x8 __attribute__((ext_vector_type(8)));
typedef float f32x4 __attribute__((ext_vector_type(4)));
typedef unsigned u32x4 __attribute__((ext_vector_type(4)));
constexpr int BM = 256, BK = 64, HALF = 128, HTB = HALF * BK * 2  , STAGE_BYTES = 8 * HTB, NXCD = 8, WGM = 4;

__host__ __device__ __forceinline__ int lds_byte(int r, int c) { const int st = (r >> 4) * 2 + (c >> 5), rr = r & 15, cc = c & 31, ob = rr * 64 + cc * 2; return st * 1024 + (ob ^ (((ob >> 9) & 1) << 5)); }
__host__ __device__ __forceinline__ void stage_rc(int b, int& R, int& C) { const int st = b / 1024, sb = b % 1024, swz = sb ^ (((sb >> 9) & 1) << 5); R = (st >> 1) * 16 + swz / 64; C = (st & 1) * 32 + (swz % 64) / 2; }
__host__ __device__ __forceinline__ int perm32(int rho) { const int n = rho >> 4, i = rho & 15; return 8 * (i >> 2) + 4 * n + (i & 3); }

struct Unit { int pm, pn; };
struct Gemm { const bf16_t* A; const bf16_t* Bt; int M, N, K; };

struct StaticOrder {
    int nM, nN, nwg, G, c;
    __host__ __device__ void init(int M, int N, int G_, int c_) { nM = M / BM; nN = N / BM; nwg = nM * nN; G = G_; c = c_; }
    __host__ __device__ bool next(int i, Unit& u) const {
        const long L = (long)i * G + c; if (L >= nwg) return false;
        int wgid = (int)L; { const int q = nwg / NXCD, r = nwg % NXCD, xcd = wgid % NXCD, off = wgid / NXCD; wgid = (xcd < r ? xcd * (q + 1) : r * (q + 1) + (xcd - r) * q) + off; }
        const int nig = WGM * nN, gid = wgid / nig, fm = gid * WGM, gsz = (nM - fm) < WGM ? (nM - fm) : WGM;
        u.pm = fm + ((wgid % nig) % gsz); u.pn = (wgid % nig) / gsz; return true;
    }
    __device__ __forceinline__ void a_ready(const Unit&) const {}
    __device__ __forceinline__ void done(const Unit&) const {}
};
__device__ __forceinline__ unsigned cvt_pk_bf16(float lo, float hi) { unsigned r; asm volatile("v_cvt_pk_bf16_f32 %0, %1, %2" : "=v"(r) : "v"(lo), "v"(hi)); return r; }
typedef float f32x2 __attribute__((ext_vector_type(2)));
__device__ __forceinline__ float fast_silu(float x) { return x * __builtin_amdgcn_rcpf(1.0f + __builtin_amdgcn_exp2f(-1.4426950408889634f * x)); }
struct EpiKV {
    static constexpr bool PERM = false, AFTER_DRAIN = false; static constexpr int MID_T = 0;
    float* outk; size_t kvdelta;
    bf16_t* kb; bf16_t* vt;
    __device__ __forceinline__ void operator()(const f32x4 (&acc)[2][2][4][2], const Unit& u, int wr, int wc, int fr, int fq) const {
        const int n0 = u.pn * BM, l = n0 >> 11, kv = (n0 >> 10) & 1, e0 = n0 & 1023;
        float* C = outk + (size_t)kv * kvdelta + (size_t)l * (2048 * 1024);
        const int row0 = u.pm * BM + wr * 64 + fr, col0 = e0 + wc * 32 + 4 * fq;
#pragma unroll
        for (int ai = 0; ai < 2; ++ai)
#pragma unroll
            for (int m = 0; m < 4; ++m) { const int row = row0 + ai * HALF + m * 16; float* rowp = C + (size_t)row * 1024 + col0;
                const int mk = row & 255, prow = (row & ~255) | (mk & ~31) | (((mk >> 2) & 3) << 3) | (((mk >> 4) & 1) << 2) | (mk & 3);
#pragma unroll
                for (int bj = 0; bj < 2; ++bj)
#pragma unroll
                    for (int n = 0; n < 2; ++n) { const f32x4 v = acc[ai][bj][m][n]; const int col = col0 + bj * HALF + n * 16;
                        *(f32x4*)(rowp + bj * HALF + n * 16) = v;
                        if (kv == 0) { typedef unsigned u32x2v __attribute__((ext_vector_type(2))); u32x2v w; w.x = cvt_pk_bf16(v[0], v[1]); w.y = cvt_pk_bf16(v[2], v[3]);
                            *(u32x2v*)(kb + ((size_t)l * 2048 + row) * 1024 + col) = w; }
                        else { const unsigned w0 = cvt_pk_bf16(v[0], v[1]), w1 = cvt_pk_bf16(v[2], v[3]); bf16_t* vp = vt + ((size_t)l * 1024 + col) * 2048 + prow;
                            vp[0] = (bf16_t)(w0 & 0xffffu); vp[2048] = (bf16_t)(w0 >> 16); vp[2 * 2048] = (bf16_t)(w1 & 0xffffu); vp[3 * 2048] = (bf16_t)(w1 >> 16); } } }
    }
};
template <bool ROWSCALE_DUMMY = false> struct EpiBf16S {
    static constexpr bool PERM = true, AFTER_DRAIN = false; static constexpr int MID_T = 0;
    bf16_t* O; int ldc; float scale;
    __device__ __forceinline__ void operator()(const f32x4 (&acc)[2][2][4][2], const Unit& u, int wr, int wc, int fr, int fq) const {
        const int row0 = u.pm * BM + wr * 64 + fr, col0 = u.pn * BM + wc * 32 + 8 * fq;
#pragma unroll
        for (int ai = 0; ai < 2; ++ai)
#pragma unroll
            for (int m = 0; m < 4; ++m) { bf16_t* rowp = O + (size_t)(row0 + ai * HALF + m * 16) * ldc + col0;
#pragma unroll
                for (int bj = 0; bj < 2; ++bj) { const f32x4 v0 = acc[ai][bj][m][0] * scale, v1 = acc[ai][bj][m][1] * scale;
                    u32x4 w; w.x = cvt_pk_bf16(v0[0], v0[1]); w.y = cvt_pk_bf16(v0[2], v0[3]); w.z = cvt_pk_bf16(v1[0], v1[1]); w.w = cvt_pk_bf16(v1[2], v1[3]);
                    *(u32x4*)(rowp + bj * HALF) = w; } }
    }
};
__device__ __forceinline__ void row_rstd8(const float* rss, int row0, int fq, float (&rs)[2][4]) {
    f32x4 p[2][4];
#pragma unroll
    for (int ai = 0; ai < 2; ++ai)
#pragma unroll
        for (int m = 0; m < 4; ++m) p[ai][m] = *(const f32x4*)(rss + (size_t)(row0 + ai * HALF + m * 16) * 16 + 4 * fq);
#pragma unroll
    for (int ai = 0; ai < 2; ++ai)
#pragma unroll
        for (int m = 0; m < 4; ++m) { float sm = (p[ai][m][0] + p[ai][m][1]) + (p[ai][m][2] + p[ai][m][3]); sm += __shfl_xor(sm, 16); sm += __shfl_xor(sm, 32);
            rs[ai][m] = __builtin_amdgcn_rsqf(sm * (1.0f / 1024.f) + 1e-6f); }
}
struct EpiProj {
    static constexpr bool PERM = true, AFTER_DRAIN = false; static constexpr int MID_T = 0;
    bf16_t* C; const float* rss;
    __device__ __forceinline__ void operator()(const f32x4 (&acc)[2][2][4][2], const Unit& u, int wr, int wc, int fr, int fq) const {
        const int row0 = u.pm * BM + wr * 64 + fr, col0 = u.pn * BM + wc * 32 + 8 * fq;
        float rs8[2][4]; row_rstd8(rss, row0, fq, rs8);
#pragma unroll
        for (int ai = 0; ai < 2; ++ai)
#pragma unroll
            for (int m = 0; m < 4; ++m) { const int row = row0 + ai * HALF + m * 16; const float rs = rs8[ai][m]; bf16_t* rowp = C + (size_t)row * 4096 + col0;
#pragma unroll
                for (int bj = 0; bj < 2; ++bj) { const f32x4 v0 = acc[ai][bj][m][0] * rs, v1 = acc[ai][bj][m][1] * rs;
                    u32x4 w; w.x = cvt_pk_bf16(v0[0], v0[1]); w.y = cvt_pk_bf16(v0[2], v0[3]); w.z = cvt_pk_bf16(v1[0], v1[1]); w.w = cvt_pk_bf16(v1[2], v1[3]);
                    *(u32x4*)(rowp + bj * HALF) = w; } }
    }
};
struct EpiQ {
    static constexpr bool PERM = true, AFTER_DRAIN = false; static constexpr int MID_T = 0;
    bf16_t* O; const float* rss; float scale;
    __device__ __forceinline__ void operator()(const f32x4 (&acc)[2][2][4][2], const Unit& u, int wr, int wc, int fr, int fq) const {
        const int row0 = u.pm * BM + wr * 64 + fr, col0 = u.pn * BM + wc * 32 + 8 * fq;
        float rs8[2][4]; row_rstd8(rss, row0, fq, rs8);
#pragma unroll
        for (int ai = 0; ai < 2; ++ai)
#pragma unroll
            for (int m = 0; m < 4; ++m) { const int row = row0 + ai * HALF + m * 16; const float rs = rs8[ai][m] * scale; bf16_t* rowp = O + (size_t)row * 1024 + col0;
#pragma unroll
                for (int bj = 0; bj < 2; ++bj) { const f32x4 v0 = acc[ai][bj][m][0] * rs, v1 = acc[ai][bj][m][1] * rs;
                    u32x4 w; w.x = cvt_pk_bf16(v0[0], v0[1]); w.y = cvt_pk_bf16(v0[2], v0[3]); w.z = cvt_pk_bf16(v1[0], v1[1]); w.w = cvt_pk_bf16(v1[2], v1[3]);
                    *(u32x4*)(rowp + bj * HALF) = w; } }
    }
};
struct EpiResidHB {
    static constexpr bool PERM = true, AFTER_DRAIN = false; static constexpr int MID_T = 0;
    bf16_t* hb; float* rss;
    __device__ __forceinline__ void operator()(const f32x4 (&acc)[2][2][4][2], const Unit& u, int wr, int wc, int fr, int fq) const {
        const int row0 = u.pm * BM + wr * 64 + fr, col0 = u.pn * BM + wc * 32 + 8 * fq;
#pragma unroll
        for (int ai = 0; ai < 2; ++ai) {
            u32x4 ob[4][2];
#pragma unroll
            for (int m = 0; m < 4; ++m)
#pragma unroll
                for (int bj = 0; bj < 2; ++bj) ob[m][bj] = *(const u32x4*)(hb + (size_t)(row0 + ai * HALF + m * 16) * 1024 + col0 + bj * HALF);
#pragma unroll
            for (int m = 0; m < 4; ++m) { const int row = row0 + ai * HALF + m * 16; bf16_t* bp = hb + (size_t)row * 1024 + col0; float sq = 0.f;
#pragma unroll
                for (int bj = 0; bj < 2; ++bj) { const u32x4 o = ob[m][bj];
                    const f32x4 v0 = (f32x4){__uint_as_float(o.x << 16), __uint_as_float(o.x & 0xffff0000u), __uint_as_float(o.y << 16), __uint_as_float(o.y & 0xffff0000u)} + acc[ai][bj][m][0];
                    const f32x4 v1 = (f32x4){__uint_as_float(o.z << 16), __uint_as_float(o.z & 0xffff0000u), __uint_as_float(o.w << 16), __uint_as_float(o.w & 0xffff0000u)} + acc[ai][bj][m][1];
                    u32x4 w; w.x = cvt_pk_bf16(v0[0], v0[1]); w.y = cvt_pk_bf16(v0[2], v0[3]); w.z = cvt_pk_bf16(v1[0], v1[1]); w.w = cvt_pk_bf16(v1[2], v1[3]);
                    *(u32x4*)(bp + bj * HALF) = w;
                    sq += (v0[0] * v0[0] + v0[1] * v0[1]) + (v0[2] * v0[2] + v0[3] * v0[3]) + (v1[0] * v1[0] + v1[1] * v1[1]) + (v1[2] * v1[2] + v1[3] * v1[3]); }
                sq += __shfl_xor(sq, 16); sq += __shfl_xor(sq, 32);
                if (fq == 0) rss[(size_t)row * 16 + u.pn * 4 + wc] = sq; }
            asm volatile("" ::: "memory");
        }
    }
};
struct EpiResidMid {
    static constexpr bool PERM = true, AFTER_DRAIN = false; static constexpr int MID_T = 16;
    bf16_t* hb; float* rss; const float* ssq;
    __device__ __forceinline__ void midpre(const Unit& u, int wr, int wc, int fr, int fq, PG8_LAS float* mid) const {
        if (wc == 0) {
            const int row0 = u.pm * BM + wr * 64 + fr;
#pragma unroll
            for (int ai = 0; ai < 2; ++ai) { f32x4 rs;
#pragma unroll
                for (int m = 0; m < 4; ++m) { const int row = row0 + ai * HALF + m * 16; const f32x4 p0 = *(const f32x4*)(ssq + (size_t)row * 32 + 8 * fq), p1 = *(const f32x4*)(ssq + (size_t)row * 32 + 8 * fq + 4);
                    float sm = ((p0[0] + p0[1]) + (p0[2] + p0[3])) + ((p1[0] + p1[1]) + (p1[2] + p1[3])); sm += __shfl_xor(sm, 16); sm += __shfl_xor(sm, 32);
                    rs[m] = 1.0f / sqrtf(sm * (1.0f / 1024.f) + 1e-6f); }
                if (fq == 0) *(PG8_LAS f32x4*)(mid + ((ai * 2 + wr) * 16 + fr) * 4) = rs; }
        }
    }
    __device__ __forceinline__ void operator()(const f32x4 (&acc)[2][2][4][2], const Unit& u, int wr, int wc, int fr, int fq) const {
        const int row0 = u.pm * BM + wr * 64 + fr, col0 = u.pn * BM + wc * 32 + 8 * fq;
#pragma unroll
        for (int ai = 0; ai < 2; ++ai) {
            u32x4 ob[4][2];
#pragma unroll
            for (int m = 0; m < 4; ++m)
#pragma unroll
                for (int bj = 0; bj < 2; ++bj) ob[m][bj] = *(const u32x4*)(hb + (size_t)(row0 + ai * HALF + m * 16) * 1024 + col0 + bj * HALF);
#pragma unroll
            for (int m = 0; m < 4; ++m) { const int row = row0 + ai * HALF + m * 16; bf16_t* bp = hb + (size_t)row * 1024 + col0; float sq = 0.f;
#pragma unroll
                for (int bj = 0; bj < 2; ++bj) { const u32x4 o = ob[m][bj];
                    const f32x4 v0 = (f32x4){__uint_as_float(o.x << 16), __uint_as_float(o.x & 0xffff0000u), __uint_as_float(o.y << 16), __uint_as_float(o.y & 0xffff0000u)} + acc[ai][bj][m][0];
                    const f32x4 v1 = (f32x4){__uint_as_float(o.z << 16), __uint_as_float(o.z & 0xffff0000u), __uint_as_float(o.w << 16), __uint_as_float(o.w & 0xffff0000u)} + acc[ai][bj][m][1];
                    u32x4 w; w.x = cvt_pk_bf16(v0[0], v0[1]); w.y = cvt_pk_bf16(v0[2], v0[3]); w.z = cvt_pk_bf16(v1[0], v1[1]); w.w = cvt_pk_bf16(v1[2], v1[3]);
                    *(u32x4*)(bp + bj * HALF) = w;
                    sq += (v0[0] * v0[0] + v0[1] * v0[1]) + (v0[2] * v0[2] + v0[3] * v0[3]) + (v1[0] * v1[0] + v1[1] * v1[1]) + (v1[2] * v1[2] + v1[3] * v1[3]); }
                sq += __shfl_xor(sq, 16); sq += __shfl_xor(sq, 32);
                if (fq == 0) rss[(size_t)row * 16 + u.pn * 4 + wc] = sq; }
            asm volatile("" ::: "memory");
        }
    }
};
struct EpiSwiGLU {
    static constexpr bool PERM = true, AFTER_DRAIN = false; static constexpr int MID_T = 0;
    bf16_t* O; int ldc; const float* rss;
    __device__ __forceinline__ void operator()(const f32x4 (&acc)[2][2][4][2], const Unit& u, int wr, int wc, int fr, int fq) const {
        const int row0 = u.pm * BM + wr * 64 + fr, col0 = u.pn * HALF + wc * 32 + 8 * fq;
        float rs8[2][4]; row_rstd8(rss, row0, fq, rs8);
#pragma unroll
        for (int ai = 0; ai < 2; ++ai)
#pragma unroll
            for (int m = 0; m < 4; ++m) { const int row = row0 + ai * HALF + m * 16; const float rs = rs8[ai][m]; bf16_t* rowp = O + (size_t)row * ldc + col0;
                const f32x4 g0 = acc[ai][0][m][0] * rs, g1 = acc[ai][0][m][1] * rs, u0 = acc[ai][1][m][0] * rs, u1 = acc[ai][1][m][1] * rs;
                u32x4 w;
                w.x = cvt_pk_bf16(fast_silu(g0[0]) * u0[0], fast_silu(g0[1]) * u0[1]); w.y = cvt_pk_bf16(fast_silu(g0[2]) * u0[2], fast_silu(g0[3]) * u0[3]);
                w.z = cvt_pk_bf16(fast_silu(g1[0]) * u1[0], fast_silu(g1[1]) * u1[1]); w.w = cvt_pk_bf16(fast_silu(g1[2]) * u1[2], fast_silu(g1[3]) * u1[3]);
                *(u32x4*)rowp = w; }
    }
};
constexpr int MID_LDS_OFF = 131584;
template <class Epi, class Sched, bool ALIGN_EPI = false, bool SP2 = false>
__device__ __forceinline__ void gemm_phase(PG8_LAS unsigned char* lds, const Gemm g, const Sched& S, const Epi& E) {
    int tid_ = threadIdx.x; asm volatile("" : "+v"(tid_));
    const int tid = tid_, wid = __builtin_amdgcn_readfirstlane(tid >> 6), lane = tid & 63, wr = wid >> 2, wc = wid & 3, fr = lane & 15, fq = lane >> 4;
    const int K = g.K, nt = K / BK;
    unsigned voffA[2], voffB[2];
#pragma unroll
    for (int i = 0; i < 2; ++i) { int R, C; stage_rc(tid * 16 + i * 8192, R, C); const int Rb = Epi::PERM ? ((R & ~31) + perm32(R & 31)) : R;
        voffA[i] = (unsigned)(R * K + C) * 2u; voffB[i] = (unsigned)(Rb * K + C) * 2u; }
    const size_t kstep = (size_t)(BK * 2);
    const size_t hstep = (size_t)HALF * K * 2;
    const size_t tstep = 2 * hstep;
    const unsigned ldsw = (unsigned)wid * 1024u;
    const int aoff = lds_byte(wr * 64 + fr, fq * 8), boff = lds_byte(wc * 32 + fr, fq * 8);
#define PG8_SA(b, h) (((b) * 2 + (h)) * HTB)
#define PG8_SB(b, h) ((4 + (b) * 2 + (h)) * HTB)
#define PG8_STAGE(bufoff, gbase, voff) do { _Pragma("unroll") for (int _i = 0; _i < 2; ++_i) \
        __builtin_amdgcn_global_load_lds((const unsigned*)((const char*)(gbase) + (voff)[_i]), (PG8_LAS unsigned*)(lds + (bufoff) + ldsw + _i * 8192), 16, 0, 0); } while (0)
#define PG8_LDA(dst, b, h) do { _Pragma("unroll") for (int m = 0; m < 4; ++m) _Pragma("unroll") for (int k = 0; k < 2; ++k) dst[m][k] = *(const PG8_LAS bf16x8*)(lds + PG8_SA(b, h) + aoff + m * 2048 + k * 1024); } while (0)
#define PG8_LDB(dst, b, h) do { _Pragma("unroll") for (int n = 0; n < 2; ++n) _Pragma("unroll") for (int k = 0; k < 2; ++k) dst[n][k] = *(const PG8_LAS bf16x8*)(lds + PG8_SB(b, h) + boff + n * 2048 + k * 1024); } while (0)
#define PG8_MMA(ai, bj, At, Bt) do { __builtin_amdgcn_s_setprio(1); _Pragma("unroll") for (int m = 0; m < 4; ++m) _Pragma("unroll") for (int n = 0; n < 2; ++n) _Pragma("unroll") for (int k = 0; k < 2; ++k) \
        acc[ai][bj][m][n] = __builtin_amdgcn_mfma_f32_16x16x32_bf16(Bt[n][k], At[m][k], acc[ai][bj][m][n], 0, 0, 0); __builtin_amdgcn_s_setprio(0); } while (0)
#define PG8_WAIT_V(n) asm volatile("s_waitcnt vmcnt(" #n ")" ::: "memory")
#define PG8_WAIT_L(n) asm volatile("s_waitcnt lgkmcnt(" #n ")" ::: "memory")
#define PG8_BAR __builtin_amdgcn_s_barrier()
#define PG8_SCHED __builtin_amdgcn_sched_barrier(0)
    Unit cur, nxt; int ui = 0;
    if (!S.next(0, cur)) return;
    f32x4 acc[2][2][4][2];
#pragma unroll
    for (int a = 0; a < 2; ++a)
#pragma unroll
        for (int b = 0; b < 2; ++b)
#pragma unroll
            for (int m = 0; m < 4; ++m)
#pragma unroll
                for (int n = 0; n < 2; ++n) acc[a][b][m][n] = (f32x4){0.f, 0.f, 0.f, 0.f};
    bf16x8 At[4][2], B0[2][2], B1[2][2];
    const char* cA = (const char*)g.A + (size_t)cur.pm * tstep; const char* cB = (const char*)g.Bt + (size_t)cur.pn * tstep;
    S.a_ready(cur);
    if constexpr (SP2) {
        PG8_STAGE(PG8_SB(0, 0), cB, voffB); PG8_STAGE(PG8_SB(0, 1), cB + hstep, voffB); PG8_STAGE(PG8_SA(0, 0), cA, voffA); PG8_STAGE(PG8_SA(0, 1), cA + hstep, voffA);
        if (wr == 1) PG8_BAR;
        PG8_WAIT_V(2); PG8_BAR;
        PG8_STAGE(PG8_SB(1, 0), cB + kstep, voffB); PG8_STAGE(PG8_SA(1, 0), cA + kstep, voffA); PG8_STAGE(PG8_SB(1, 1), cB + hstep + kstep, voffB);
        PG8_WAIT_V(6); PG8_BAR;
    } else {
        PG8_STAGE(PG8_SB(0, 0), cB, voffB); PG8_STAGE(PG8_SA(0, 0), cA, voffA); PG8_STAGE(PG8_SB(0, 1), cB + hstep, voffB); PG8_STAGE(PG8_SA(0, 1), cA + hstep, voffA);
        if (wr == 1) PG8_BAR;
        PG8_WAIT_V(4); PG8_BAR;
        PG8_STAGE(PG8_SB(1, 0), cB + kstep, voffB); PG8_STAGE(PG8_SA(1, 0), cA + kstep, voffA); PG8_STAGE(PG8_SB(1, 1), cB + hstep + kstep, voffB);
        PG8_WAIT_V(6); PG8_BAR;
    }
    for (;;) {
        const bool has_next = S.next(ui + 1, nxt);
        if constexpr (Epi::MID_T != 0) E.midpre(cur, wr, wc, fr, fq, (PG8_LAS float*)(lds + MID_LDS_OFF));
        const char* nA = has_next ? (const char*)g.A + (size_t)nxt.pm * tstep : cA; const char* nB = has_next ? (const char*)g.Bt + (size_t)nxt.pn * tstep : cB;
        for (int t = 0; t < nt; t += 2) {
            if constexpr (Epi::MID_T != 0) { if (t == Epi::MID_T) {
                const PG8_LAS f32x4* mp_ = (const PG8_LAS f32x4*)(lds + MID_LDS_OFF) + (wr * 16 + fr);
                const f32x4 r0_ = mp_[0], r1_ = mp_[32];
                asm volatile("s_waitcnt lgkmcnt(0)" ::: "memory");
#pragma unroll
                for (int m_ = 0; m_ < 4; ++m_)
#pragma unroll
                    for (int b_ = 0; b_ < 2; ++b_)
#pragma unroll
                        for (int n_ = 0; n_ < 2; ++n_) { acc[0][b_][m_][n_] = acc[0][b_][m_][n_] * r0_[m_]; acc[1][b_][m_][n_] = acc[1][b_][m_][n_] * r1_[m_]; } } }
            const bool last = (t == nt - 2);
            const char* a1 = cA + (size_t)(t + 1) * kstep;
            const char* a2 = last ? nA : cA + (size_t)(t + 2) * kstep; const char* b2 = last ? nB : cB + (size_t)(t + 2) * kstep;
            const char* a3 = a2 + kstep; const char* b3 = b2 + kstep;
            if (last && has_next) S.a_ready(nxt);
            if constexpr (SP2) {
            PG8_LDB(B0, 0, 0); PG8_LDB(B1, 0, 1); PG8_SCHED; PG8_LDA(At, 0, 0); PG8_STAGE(PG8_SA(1, 1), a1 + hstep, voffA);
            PG8_WAIT_V(8); PG8_WAIT_L(0); PG8_BAR; PG8_MMA(0, 0, At, B0); PG8_MMA(0, 1, At, B1); PG8_BAR; PG8_SCHED;
            PG8_LDA(At, 0, 1); PG8_STAGE(PG8_SB(0, 0), b2, voffB); PG8_STAGE(PG8_SB(0, 1), b2 + hstep, voffB); PG8_STAGE(PG8_SA(0, 0), a2, voffA);
            PG8_WAIT_V(8); PG8_WAIT_L(0); PG8_BAR; PG8_MMA(1, 0, At, B0); PG8_MMA(1, 1, At, B1); PG8_BAR; PG8_SCHED;
            PG8_LDB(B0, 1, 0); PG8_LDB(B1, 1, 1); PG8_SCHED; PG8_LDA(At, 1, 0); PG8_STAGE(PG8_SA(0, 1), a2 + hstep, voffA);
            PG8_WAIT_V(8); PG8_WAIT_L(0); PG8_BAR; PG8_MMA(0, 0, At, B0); PG8_MMA(0, 1, At, B1); PG8_BAR; PG8_SCHED;
            PG8_LDA(At, 1, 1); PG8_STAGE(PG8_SB(1, 0), b3, voffB); PG8_STAGE(PG8_SB(1, 1), b3 + hstep, voffB); PG8_STAGE(PG8_SA(1, 0), a3, voffA);
            PG8_WAIT_V(8); PG8_WAIT_L(0); PG8_BAR; PG8_MMA(1, 0, At, B0); PG8_MMA(1, 1, At, B1); PG8_BAR; PG8_SCHED;
            } else {
            PG8_LDB(B0, 0, 0); PG8_SCHED; PG8_LDA(At, 0, 0); PG8_STAGE(PG8_SA(1, 1), a1 + hstep, voffA);
            PG8_WAIT_L(8); PG8_BAR; PG8_WAIT_L(0); PG8_MMA(0, 0, At, B0); PG8_BAR; PG8_SCHED;
            PG8_LDB(B1, 0, 1); PG8_STAGE(PG8_SB(0, 0), b2, voffB);
            PG8_BAR; PG8_WAIT_L(0); PG8_MMA(0, 1, At, B1); PG8_BAR;
            PG8_LDA(At, 0, 1); PG8_STAGE(PG8_SA(0, 0), a2, voffA);
            PG8_BAR; PG8_WAIT_L(0); PG8_MMA(1, 0, At, B0); PG8_BAR; PG8_SCHED;
            PG8_STAGE(PG8_SB(0, 1), b2 + hstep, voffB);
            PG8_WAIT_V(6); PG8_BAR; PG8_MMA(1, 1, At, B1); PG8_BAR;
            PG8_LDB(B0, 1, 0); PG8_SCHED; PG8_LDA(At, 1, 0); PG8_STAGE(PG8_SA(0, 1), a2 + hstep, voffA);
            PG8_WAIT_L(8); PG8_BAR; PG8_WAIT_L(0); PG8_MMA(0, 0, At, B0); PG8_BAR; PG8_SCHED;
            PG8_LDB(B1, 1, 1); PG8_STAGE(PG8_SB(1, 0), b3, voffB);
            PG8_BAR; PG8_WAIT_L(0); PG8_MMA(0, 1, At, B1); PG8_BAR;
            PG8_LDA(At, 1, 1); PG8_STAGE(PG8_SA(1, 0), a3, voffA);
            PG8_BAR; PG8_WAIT_L(0); PG8_MMA(1, 0, At, B0); PG8_BAR; PG8_SCHED;
            PG8_STAGE(PG8_SB(1, 1), b3 + hstep, voffB);
            PG8_WAIT_V(6); PG8_BAR; PG8_MMA(1, 1, At, B1); PG8_BAR;
            }
        }
        if constexpr (ALIGN_EPI) { if (wr == 0) PG8_BAR; }
        if constexpr (!Epi::AFTER_DRAIN) { E(acc, cur, wr, wc, fr, fq); S.done(cur); }
        if (!has_next) break;
#pragma unroll
        for (int a = 0; a < 2; ++a)
#pragma unroll
            for (int b = 0; b < 2; ++b)
#pragma unroll
                for (int m = 0; m < 4; ++m)
#pragma unroll
                    for (int n = 0; n < 2; ++n) acc[a][b][m][n] = (f32x4){0.f, 0.f, 0.f, 0.f};
        cur = nxt; cA = nA; cB = nB; ++ui;
        if constexpr (ALIGN_EPI) { if (wr == 1) PG8_BAR; }
    }
    PG8_WAIT_V(0);
    if constexpr (!ALIGN_EPI) { if (wr == 0) PG8_BAR; }
    PG8_BAR;
    if constexpr (Epi::AFTER_DRAIN) { E.fused(acc, cur, wr, wc, fr, fq, lds, wid, lane); S.done(cur); }
#undef PG8_SA
#undef PG8_SB
#undef PG8_STAGE
#undef PG8_LDA
#undef PG8_LDB
#undef PG8_MMA
#undef PG8_WAIT_V
#undef PG8_WAIT_L
#undef PG8_BAR
#undef PG8_SCHED
}
}
#define GAS __attribute__((address_space(1)))
#define LAS __attribute__((address_space(3)))
typedef unsigned short bf16;
typedef unsigned v4u __attribute__((ext_vector_type(4)));
typedef float f32x4 __attribute__((ext_vector_type(4)));
typedef short bf16x8 __attribute__((ext_vector_type(8)));
typedef GAS unsigned gu32;
typedef GAS unsigned long long gu64;
#define RLX_AGENT __ATOMIC_RELAXED, __HIP_MEMORY_SCOPE_AGENT
#define LDS_WAIT() asm volatile("s_waitcnt lgkmcnt(0)" ::: "memory")
#define VM_WAIT() asm volatile("s_waitcnt vmcnt(0)" ::: "memory")
__device__ __forceinline__ unsigned long long rt() { return __builtin_amdgcn_s_memrealtime(); }
__device__ __forceinline__ unsigned f2bf(float f) { unsigned u = __builtin_bit_cast(unsigned, f); return (u + 0x7fffu + ((u >> 16) & 1u)) >> 16; }
__device__ __forceinline__ unsigned pk2(float lo, float hi) { return f2bf(lo) | (f2bf(hi) << 16); }
#define XB_TMO      128
#define XB_XCNT(j)  (256  + 64 * (j))
#define XB_XSUB(j)  (1280 + 64 * (j))
#define XB_XGEN(j)  (2304 + 64 * (j))
#define XB_TOP      3328
#define XB_TOPGEN   3392
#define XCD_BAR_WORDS 3456
#define XB_SPIN_CAP (1u << 18)

__device__ __forceinline__ unsigned xb_ld(unsigned* p)              { return __hip_atomic_load(p, __ATOMIC_RELAXED, __HIP_MEMORY_SCOPE_AGENT); }
__device__ __forceinline__ unsigned xb_add(unsigned* p, unsigned v) { return __hip_atomic_fetch_add(p, v, __ATOMIC_RELAXED, __HIP_MEMORY_SCOPE_AGENT); }
__device__ __forceinline__ unsigned xb_xcc_id() { return (unsigned)__builtin_amdgcn_s_getreg((3 << 11) | 20) & 0xFu; }
#define XB_SPIN(cond, bar) do { unsigned _sp = 0; while (cond) { __builtin_amdgcn_s_sleep(1); \
    if ((++_sp & 255u) == 0u) { if (xb_ld(&(bar)[XB_TMO])) break; if (_sp > XB_SPIN_CAP) { atomicAdd(&(bar)[XB_TMO], 1u); break; } } } } while (0)

struct XcdBarrier {
    unsigned* bar; unsigned x;
    volatile LAS unsigned* st;
};

__device__ __forceinline__ XcdBarrier xcd_barrier_post(unsigned* bar, volatile LAS unsigned* st) {
    XcdBarrier b; b.bar = bar; b.x = xb_xcc_id(); b.st = st;
    if (threadIdx.x == 0) (void)xb_add(&bar[XB_XCNT(b.x)], 1u);
    return b;
}
__device__ __forceinline__ void xcd_barrier_complete(unsigned* bar, unsigned x, unsigned& nloc, unsigned& nx) {
    const unsigned G = gridDim.x * gridDim.y * gridDim.z;
    unsigned sum, cnt, mine, sp = 0u;
    for (;;) {
        sum = 0u; cnt = 0u; mine = 0u;
#pragma unroll
        for (unsigned j = 0; j < 16; ++j) { const unsigned c = xb_ld(&bar[XB_XCNT(j)]); sum += c; cnt += (c > 0u) ? 1u : 0u; mine = (j == x) ? c : mine; }
        if (sum == G) break;
        __builtin_amdgcn_s_sleep(1);
        if ((++sp & 255u) == 0u) { if (xb_ld(&bar[XB_TMO])) break; if (sp > XB_SPIN_CAP) { atomicAdd(&bar[XB_TMO], 1u); break; } }
    }
    nloc = mine > 0u ? mine : 1u; nx = cnt > 0u ? cnt : 1u;
}

__device__ __forceinline__ void xcd_barrier(const XcdBarrier& b) {
    asm volatile("s_waitcnt vmcnt(0)" ::: "memory");
    __syncthreads();
    if (threadIdx.x == 0) {
        unsigned* bar = b.bar;
        __builtin_amdgcn_s_waitcnt(0);
        unsigned nloc = b.st[0], nx = b.st[1];
        if (nloc == 0u) { xcd_barrier_complete(bar, b.x, nloc, nx); b.st[0] = nloc; b.st[1] = nx; }
        const unsigned old = xb_add(&bar[XB_XSUB(b.x)], 1u);
        const unsigned gen = old / nloc;
        if (old + 1u == (gen + 1u) * nloc) {
            __builtin_amdgcn_fence(__ATOMIC_RELEASE, "agent");
            asm volatile("s_waitcnt vmcnt(0)" ::: "memory");
            const unsigned og = xb_add(&bar[XB_TOP], 1u);
            const unsigned tg = og / nx;
            if (og + 1u == (tg + 1u) * nx) xb_add(&bar[XB_TOPGEN], 1u);
            else XB_SPIN(xb_ld(&bar[XB_TOPGEN]) == tg, bar);
            __builtin_amdgcn_fence(__ATOMIC_ACQUIRE, "agent");
            xb_add(&bar[XB_XGEN(b.x)], 1u);
            asm volatile("s_waitcnt vmcnt(0)" ::: "memory");
        } else {
            XB_SPIN(xb_ld(&bar[XB_XGEN(b.x)]) == gen, bar);
            __builtin_amdgcn_fence(__ATOMIC_ACQUIRE, "agent");
            asm volatile("s_waitcnt vmcnt(0)" ::: "memory");
        }
    }
    __syncthreads();
}
#ifndef MK_PROBE
#define MK_PROBE 0
#endif
#ifndef MK_PROBE_A
#define MK_PROBE_A 0
#define MK_PROBE_B 0
#endif
#ifndef MK_PROBE_REGIONS
#define MK_PROBE_REGIONS 0
#endif
#if MK_PROBE
#define REG_BEGIN(i) do { if (blockIdx.x == 0 && threadIdx.x == 0) ((unsigned long long*)(kp->ws + WS_CTL + 65536))[100 + (i)] = __builtin_amdgcn_s_memrealtime(); } while (0)
#define REG_END(i) do { __syncthreads(); if (blockIdx.x == 0 && threadIdx.x == 0) { unsigned long long* st_ = (unsigned long long*)(kp->ws + WS_CTL + 65536); st_[110 + (i)] += __builtin_amdgcn_s_memrealtime() - st_[100 + (i)]; } } while (0)
#else
#define REG_BEGIN(i) do { } while (0)
#define REG_END(i) do { } while (0)
#endif
namespace nv {
constexpr int D = 1024, MP = 16384, MS = 512, MT = MP + MS, NSEQ = 136, DEPTH = 4;
constexpr int NIN = 4112;
constexpr int NPJ = 4096, OFF_POOL = 0, OFF_Z = 512, OFF_XBC = 1536, OFF_GATE = 3072, OFF_LRU = 3584;
constexpr int DFF = 2816, NINP = 4352;
constexpr float EPS = 1e-6f;
constexpr size_t O_Y = 0, O_PPOOL = (size_t)MT * D, O_PSCONV = O_PPOOL + 245760, O_PSSD = O_PSCONV + 147456, O_PLCONV = O_PSSD + 4194304, O_PLRU = O_PLCONV + 49152,
                 O_PMK = O_PLRU + 16384, O_PMV = O_PMK + 8388608, O_SPOOL = O_PMV + 8388608, O_SSCONV = O_SPOOL + 3932160, O_SSSD = O_SSCONV + 2359296,
                 O_SLCONV = O_SSSD + 67108864, O_SLRU = O_SLCONV + 786432, O_END = O_SLRU + 262144;
constexpr size_t MiB = 1u << 20;
constexpr size_t WS_CTL = 0, CTL_ZERO_BYTES = 1 * MiB;
constexpr size_t WS_WKV = 1 * MiB, WS_WIN = 17 * MiB, WS_WOUT = 51 * MiB, WS_WQ = 67 * MiB, WS_WO = 75 * MiB, WS_WGU = 83 * MiB, WS_WD = 127 * MiB;
constexpr size_t WS_MEMB = 149 * MiB, WS_HB = 153 * MiB, WS_UB = 153 * MiB, WS_MIXB = 186 * MiB, WS_OB = 252 * MiB, WS_ACT = 285 * MiB;
constexpr size_t WS_PROJ = 376 * MiB, WS_POOLED = 642 * MiB, WS_XBC = 675 * MiB, WS_YRAW = 774 * MiB, WS_XC = 840 * MiB, WS_AB = 873 * MiB, WS_BB = 906 * MiB, WS_QB = 939 * MiB;
constexpr size_t WS_KB = 1005 * MiB, WS_VT = 1021 * MiB;
constexpr size_t WS_SSDSS = 1037 * MiB, WS_PWT = 1039 * MiB;
constexpr size_t WS_DT = 1042 * MiB;
constexpr size_t WS_RSS = 1040 * MiB;
constexpr size_t WS_XBCC = 1044 * MiB;
constexpr size_t WS_END = 1092 * MiB;
constexpr size_t WIN_L = (size_t)NINP * 1024, WOUT_L = (size_t)1024 * 2048, WQ_L = (size_t)1024 * 1024, WGU_L = (size_t)5632 * 1024, WD_L = (size_t)1024 * 2816;
constexpr int CW_TMO = 0, CW_BAR = 4096;
constexpr int RING_OFF = 0, RING_BYTES = 131072, LDSCTL_OFF = RING_BYTES, MISC_OFF = LDSCTL_OFF + 320, LDS_BYTES = 147456;
constexpr int NWAVES = 8, NTHR = 512;
constexpr int PH_PRO = 0, PH_KV = 1, PH_L0 = 2, PH_PER_LAYER = 9, PH_FINAL = PH_L0 + DEPTH * PH_PER_LAYER, NPH = PH_FINAL + 1;

struct SeqInfo { int row0, L, pos0, b, grp; };
__device__ __forceinline__ SeqInfo seq_info(int s) {
    SeqInfo q;
    if (s < 8) { q.row0 = s * 2048; q.L = 2048; q.pos0 = 0; q.b = s; q.grp = 0; }
    else { q.b = s - 8; q.row0 = MP + q.b * 4; q.L = 4; q.pos0 = 16384; q.grp = 1; }
    return q;
}
__device__ __forceinline__ void row_info(int r, int& s, int& t) {
    if (r < MP) { s = r >> 11; t = r & 2047; } else { const int q = r - MP; s = 8 + (q >> 2); t = q & 3; }
}
__device__ __forceinline__ float wave_sum(float v) {
#pragma unroll
    for (int o = 1; o < 64; o <<= 1) v += __shfl_xor(v, o);
    return v;
}
__device__ __forceinline__ float wave_max(float v) {
#pragma unroll
    for (int o = 1; o < 64; o <<= 1) v = fmaxf(v, __shfl_xor(v, o));
    return v;
}
__device__ __forceinline__ float silu_f(float x) { return x / (1.f + expf(-x)); }
__device__ __forceinline__ float sigmoid_f(float x) { return 1.f / (1.f + expf(-x)); }
__device__ __forceinline__ float softplus_f(float x) { return x > 20.f ? x : log1pf(expf(x)); }
__device__ __forceinline__ float gelu_tanh_f(float x) { return 0.5f * x * (1.f + tanhf(0.7978845608028654f * (x + 0.044715f * x * x * x))); }

struct Args { const float* in[38]; float* out; unsigned char* ws; int ph_lo, ph_hi; };
typedef const __attribute__((address_space(4))) Args* KP;
struct Frame { LAS unsigned char* lds; int tid, lane, wave, bid, G, vcu; };
__device__ __forceinline__ void frame_refresh(Frame& F) { int t = threadIdx.x; asm volatile("" : "+v"(t)); F.tid = t; F.lane = t & 63; F.wave = __builtin_amdgcn_readfirstlane(t >> 6); }

typedef float f32x2_t __attribute__((ext_vector_type(2))); typedef __bf16 bf16x2_t __attribute__((ext_vector_type(2)));
__device__ __forceinline__ unsigned pk2h(float lo, float hi) { f32x2_t v = {lo, hi}; bf16x2_t b = __builtin_convertvector(v, bf16x2_t); return __builtin_bit_cast(unsigned, b); }
__device__ __forceinline__ unsigned f2bfh(float x) { return pk2h(x, 0.f) & 0xffffu; }
typedef short bf16x8 __attribute__((ext_vector_type(8)));
#define MFMA16(a, b, c) __builtin_amdgcn_mfma_f32_16x16x32_bf16((a), (b), (c), 0, 0, 0)
#define LBAR() do { asm volatile("s_waitcnt lgkmcnt(0)" ::: "memory"); __builtin_amdgcn_s_barrier(); asm volatile("" ::: "memory"); } while (0)
__device__ __forceinline__ float bf2f(unsigned short h) { return __uint_as_float((unsigned)h << 16); }
__device__ __forceinline__ void cvt8(v4u u, f32x4& lo, f32x4& hi) { lo = (f32x4){__uint_as_float(u.x << 16), __uint_as_float(u.x & 0xffff0000u), __uint_as_float(u.y << 16), __uint_as_float(u.y & 0xffff0000u)}; hi = (f32x4){__uint_as_float(u.z << 16), __uint_as_float(u.z & 0xffff0000u), __uint_as_float(u.w << 16), __uint_as_float(u.w & 0xffff0000u)}; }
constexpr int SL_CS = 0, SL_BS = 32768, SL_BT = 65536, SL_XT = 98304, SL_XW = 106496, SL_HS = 114688, SL_XS = 122880;
constexpr int XTRA = LDSCTL_OFF + 512;
constexpr int SL_ACS = XTRA, SL_DTV = XTRA + 512, SL_CW = XTRA + 1024;
__device__ __forceinline__ int sw128(int r, int c8) { return r * 256 + (((c8 ^ r) & 15) << 4); }
__device__ __forceinline__ int sw128t(int r, int c8) { return r * 256 + (((c8 ^ r ^ (r >> 3)) & 15) << 4); }
__device__ __forceinline__ float fexp(float x) { return __builtin_amdgcn_exp2f(1.4426950408889634f * x); }
__device__ __forceinline__ float fsilu(float x) { return x * __builtin_amdgcn_rcpf(1.0f + __builtin_amdgcn_exp2f(-1.4426950408889634f * x)); }

__device__ __forceinline__ void ph_mix0(KP a, Frame& F, int l) {
    const bf16* proj = (const bf16*)(a->ws + WS_PROJ); bf16* xo = (bf16*)(a->ws + WS_XBCC);
    const float* cw = a->in[14] + (size_t)l * 4 * 1536; const float* cb = a->in[15] + (size_t)l * 1536;
    const int NIT = (MP / 8) * 192;
    for (int it = F.bid * NTHR + F.tid; it < NIT; it += F.G * NTHR) {
        const int c8 = it % 192, rb = it / 192, r0 = rb * 8, t = r0 & 2047;
        f32x4 wk[5][2];
#pragma unroll
        for (int k = 0; k < 4; ++k) { wk[k][0] = *(const f32x4*)(cw + (size_t)k * 1536 + 8 * c8); wk[k][1] = *(const f32x4*)(cw + (size_t)k * 1536 + 8 * c8 + 4); }
        wk[4][0] = *(const f32x4*)(cb + 8 * c8); wk[4][1] = *(const f32x4*)(cb + 8 * c8 + 4);
        v4u rw[11];
#pragma unroll
        for (int rr = 0; rr < 11; ++rr) { rw[rr] = (v4u){0u, 0u, 0u, 0u}; if (t + rr - 3 >= 0) rw[rr] = *(const GAS v4u*)(proj + (size_t)(r0 + rr - 3) * NPJ + OFF_XBC + 8 * c8); }
#pragma unroll
        for (int hf = 0; hf < 2; ++hf) {
            f32x4 raw[11];
#pragma unroll
            for (int rr = 0; rr < 11; ++rr) { const unsigned u0 = hf ? rw[rr].z : rw[rr].x, u1 = hf ? rw[rr].w : rw[rr].y;
                raw[rr] = (f32x4){__uint_as_float(u0 << 16), __uint_as_float(u0 & 0xffff0000u), __uint_as_float(u1 << 16), __uint_as_float(u1 & 0xffff0000u)}; }
#pragma unroll
            for (int i = 0; i < 8; ++i) { f32x4 o = wk[4][hf];
#pragma unroll
                for (int k = 0; k < 4; ++k) o += wk[k][hf] * raw[i + k];
                *(unsigned long long*)(xo + (size_t)(r0 + i) * 1536 + 8 * c8 + 4 * hf) = (unsigned long long)pk2h(fsilu(o.x), fsilu(o.y)) | ((unsigned long long)pk2h(fsilu(o.z), fsilu(o.w)) << 32); }
        }
    }
}
template <bool WITH_T>
__device__ __forceinline__ void ssd_stage(LAS unsigned char* L, const v4u (&rw)[4], int dst, int dstT, int tq, int c8) {
#pragma unroll
    for (int i = 0; i < 4; ++i) *(LAS v4u*)(L + dst + sw128(4 * tq + i, c8)) = rw[i];
    if (WITH_T) {
#pragma unroll
        for (int jw = 0; jw < 4; ++jw) {
            const unsigned a0 = rw[0][jw], a1 = rw[1][jw], a2 = rw[2][jw], a3 = rw[3][jw];
            const unsigned long long ev = (unsigned long long)((a0 & 0xffffu) | (a1 << 16)) | ((unsigned long long)((a2 & 0xffffu) | (a3 << 16)) << 32);
            const unsigned long long od = (unsigned long long)((a0 >> 16) | (a1 & 0xffff0000u)) | ((unsigned long long)((a2 >> 16) | (a3 & 0xffff0000u)) << 32);
            *(LAS unsigned long long*)(L + dstT + sw128t(8 * c8 + 2 * jw, tq >> 1) + (tq & 1) * 8) = ev;
            *(LAS unsigned long long*)(L + dstT + sw128t(8 * c8 + 2 * jw + 1, tq >> 1) + (tq & 1) * 8) = od; }
    }
}
__device__ __forceinline__ float fsoftplus(float x) { return x > 15.f ? x : 0.6931471805599453f * __builtin_amdgcn_logf(1.0f + __builtin_amdgcn_exp2f(1.4426950408889634f * x)); }

__device__ __forceinline__ void ssd_prompt_item(KP a, Frame& F, int l, int b, int hd, int ph) {
    LAS unsigned char* L = F.lds;
    const int tid0 = F.tid, w = F.wave, fr0 = F.lane & 15, fq0 = F.lane >> 4, g = hd >> 3;
    const bf16* proj_seq = (const bf16*)(a->ws + WS_PROJ) + (size_t)b * 2048 * NPJ; const float* dt_seq = (const float*)(a->ws + WS_DT) + (size_t)b * 2048 * 16 + hd;
    bf16* mixb = (bf16*)(a->ws + WS_MIXB) + (size_t)b * 2048 * 2048 + hd * 64 + ph * 32;
    float* ssq = (float*)(a->ws + WS_SSDSS) + (size_t)b * 2048 * 32 + hd * 2 + ph;
    LAS float* ACS = (LAS float*)(L + SL_ACS); LAS float* DTV = (LAS float*)(L + SL_DTV);
    const bf16* xc_seq = (const bf16*)(a->ws + WS_XBCC) + (size_t)b * 2048 * 1536;
    for (int i = tid0; i < 8192 / 4; i += NTHR) ((LAS unsigned*)(L + SL_HS))[i] = 0u;
    const float A = -expf(a->in[17][l * 16 + hd]), dtb = a->in[16][l * 16 + hd], Dk = a->in[18][l * 16 + hd];
    f32x4 hst[2]; hst[0] = (f32x4){0.f, 0.f, 0.f, 0.f}; hst[1] = (f32x4){0.f, 0.f, 0.f, 0.f};
    const int cB = 1024 + g * 128, cC = 1280 + g * 128, cX = hd * 64 + ph * 32, cZ = OFF_Z + hd * 64 + ph * 32;
    v4u rawB[4], rawC[4]; unsigned rawX[4]; float dr0 = 0.f, dr1 = 0.f;
    {
        const int tq = tid0 >> 4, c8 = tid0 & 15;
#pragma unroll
        for (int i = 0; i < 4; ++i) { const bf16* rp = xc_seq + (size_t)(4 * tq + i) * 1536; rawB[i] = *(const GAS v4u*)(rp + cB + 8 * c8); rawC[i] = *(const GAS v4u*)(rp + cC + 8 * c8); rawX[i] = *(const GAS unsigned*)(rp + cX + 2 * c8); }
        if (w == 0) { dr0 = dt_seq[(size_t)(2 * F.lane) * 16]; dr1 = dt_seq[(size_t)(2 * F.lane + 1) * 16]; }
    }
    __syncthreads();
    for (int c = 0; c < 16; ++c) {
        const int t0 = c * 128;
        const int tid = tid0, fr = fr0, fq = fq0;
        const int lane = tid & 63, tq = tid >> 4, c8 = tid & 15;
        unsigned long long zq[2];
#pragma unroll
        for (int pt = 0; pt < 2; ++pt) zq[pt] = *(const GAS unsigned long long*)(proj_seq + (size_t)(t0 + 16 * w + fr) * NPJ + cZ + 16 * pt + 4 * fq);
        if (w == 0) {
            const float dt0 = fsoftplus(dr0 + dtb), dt1 = fsoftplus(dr1 + dtb);
            const float a0 = dt0 * A, a1 = dt1 * A;
            float v = a0 + a1;
#pragma unroll
            for (int o = 1; o < 64; o <<= 1) { const float t = __shfl_up(v, o); if (lane >= o) v += t; }
            ACS[2 * lane] = v - a1; ACS[2 * lane + 1] = v; DTV[2 * lane] = dt0; DTV[2 * lane + 1] = dt1;
        }
        ssd_stage<true>(L, rawB, SL_BS, SL_BT, tq, c8);
        ssd_stage<false>(L, rawC, SL_CS, 0, tq, c8);
        if (c + 1 < 16) {
#pragma unroll
            for (int i = 0; i < 4; ++i) { const bf16* rp = xc_seq + (size_t)(t0 + 128 + 4 * tq + i) * 1536; rawB[i] = *(const GAS v4u*)(rp + cB + 8 * c8); rawC[i] = *(const GAS v4u*)(rp + cC + 8 * c8); }
        }
        LBAR();
        f32x4 cb[8]; bf16x8 cfr[4]; const int lo = (w >= 4) ? (w - 4) : 0, hrt = 7 - w, nh = (w < 4) ? (3 - w) : 0;
#pragma unroll
        for (int ks = 0; ks < 4; ++ks) cfr[ks] = *(const LAS bf16x8*)(L + SL_CS + sw128(16 * w + fr, 4 * ks + fq));
#pragma unroll
        for (int st = 0; st < 8; ++st) if (st >= lo && st <= w) { cb[st] = (f32x4){0.f, 0.f, 0.f, 0.f};
#pragma unroll
            for (int ks = 0; ks < 4; ++ks) { const bf16x8 bm = *(const LAS bf16x8*)(L + SL_BS + sw128(16 * st + fr, 4 * ks + fq)); cb[st] = MFMA16(bm, cfr[ks], cb[st]); } }
        f32x4 cbh[3];
        if (w < 4) { bf16x8 cf2[4];
#pragma unroll
            for (int ks = 0; ks < 4; ++ks) cf2[ks] = *(const LAS bf16x8*)(L + SL_CS + sw128(16 * hrt + fr, 4 * ks + fq));
#pragma unroll
            for (int k = 0; k < 3; ++k) if (k < nh) { cbh[k] = (f32x4){0.f, 0.f, 0.f, 0.f};
#pragma unroll
                for (int ks = 0; ks < 4; ++ks) { const bf16x8 bm = *(const LAS bf16x8*)(L + SL_BS + sw128(16 * k + fr, 4 * ks + fq)); cbh[k] = MFMA16(bm, cf2[ks], cbh[k]); } } }
        {
            const float alast = ACS[127];
            float xd[4][2], xw[4][2];
#pragma unroll
            for (int i = 0; i < 4; ++i) { const int tok = 4 * tq + i; const float dt = DTV[tok], wgt = fexp(alast - ACS[tok]);
                xd[i][0] = __uint_as_float(rawX[i] << 16) * dt; xd[i][1] = __uint_as_float(rawX[i] & 0xffff0000u) * dt; xw[i][0] = xd[i][0] * wgt; xw[i][1] = xd[i][1] * wgt; }
#pragma unroll
            for (int j = 0; j < 2; ++j) { const int off = sw128(2 * c8 + j, tq >> 1) + (tq & 1) * 8;
                *(LAS unsigned long long*)(L + SL_XT + off) = (unsigned long long)pk2h(xd[0][j], xd[1][j]) | ((unsigned long long)pk2h(xd[2][j], xd[3][j]) << 32);
                *(LAS unsigned long long*)(L + SL_XW + off) = (unsigned long long)pk2h(xw[0][j], xw[1][j]) | ((unsigned long long)pk2h(xw[2][j], xw[3][j]) << 32); }
            if (c + 1 < 16) {
#pragma unroll
                for (int i = 0; i < 4; ++i) rawX[i] = *(const GAS unsigned*)(xc_seq + (size_t)(t0 + 128 + 4 * tq + i) * 1536 + cX + 2 * c8);
                if (w == 0) { dr0 = dt_seq[(size_t)(t0 + 128 + 2 * lane) * 16]; dr1 = dt_seq[(size_t)(t0 + 128 + 2 * lane + 1) * 16]; }
            }
        }
        LBAR();
        {
            const int l_ = 16 * w + fr; const float al = ACS[l_];
#pragma unroll
            for (int st = 0; st < 8; ++st) {
                const int off = SL_BS + sw128(l_, 2 * st + (fq >> 1)) + (fq & 1) * 8;
                if (st >= lo && st <= w) { float v[4]; const f32x4 as4 = *(const LAS f32x4*)(ACS + 16 * st + 4 * fq);
#pragma unroll
                    for (int e = 0; e < 4; ++e) { const int s_ = 16 * st + 4 * fq + e; const float ex = fexp(fminf(al - as4[e], 0.f)); v[e] = (s_ <= l_) ? cb[st][e] * ex : 0.f; }
                    *(LAS unsigned long long*)(L + off) = (unsigned long long)pk2h(v[0], v[1]) | ((unsigned long long)pk2h(v[2], v[3]) << 32); }
                else if (st == w + 1 && (w & 1) == 0) *(LAS unsigned long long*)(L + off) = 0ull;
            }
            if (w < 4) { const int l2 = 16 * hrt + fr; const float al2 = ACS[l2];
#pragma unroll
                for (int k = 0; k < 3; ++k) if (k < nh) { float v[4]; const f32x4 as4 = *(const LAS f32x4*)(ACS + 16 * k + 4 * fq);
#pragma unroll
                    for (int e = 0; e < 4; ++e) v[e] = cbh[k][e] * fexp(fminf(al2 - as4[e], 0.f));
                    *(LAS unsigned long long*)(L + SL_BS + sw128(l2, 2 * k + (fq >> 1)) + (fq & 1) * 8) = (unsigned long long)pk2h(v[0], v[1]) | ((unsigned long long)pk2h(v[2], v[3]) << 32); } }
        }
        LBAR();
        {
            f32x4 yd[2], yo[2];
#pragma unroll
            for (int pt = 0; pt < 2; ++pt) { yd[pt] = (f32x4){0.f, 0.f, 0.f, 0.f}; yo[pt] = (f32x4){0.f, 0.f, 0.f, 0.f}; }
#pragma unroll
            for (int ks = 0; ks < 4; ++ks) {
#pragma unroll
                for (int pt = 0; pt < 2; ++pt) { const bf16x8 hf = *(const LAS bf16x8*)(L + SL_HS + sw128(16 * pt + fr, 4 * ks + fq)); yo[pt] = MFMA16(hf, cfr[ks], yo[pt]); }
                if (ks <= (w >> 1)) { const bf16x8 mf = *(const LAS bf16x8*)(L + SL_BS + sw128(16 * w + fr, 4 * ks + fq));
#pragma unroll
                    for (int pt = 0; pt < 2; ++pt) { const bf16x8 xf = *(const LAS bf16x8*)(L + SL_XT + sw128(16 * pt + fr, 4 * ks + fq)); yd[pt] = MFMA16(xf, mf, yd[pt]); } }
            }
            const int l_ = 16 * w + fr; const float ea = fexp(ACS[l_]), dsk = Dk * __builtin_amdgcn_rcpf(DTV[l_]); float s2 = 0.f;
#pragma unroll
            for (int pt = 0; pt < 2; ++pt) { float yg[4];
#pragma unroll
                for (int e = 0; e < 4; ++e) { const int p = 16 * pt + 4 * fq + e;
                    const float xdv = bf2f(*(const LAS bf16*)(L + SL_XT + sw128(p, l_ >> 3) + (l_ & 7) * 2));
                    const float z = bf2f((unsigned short)(zq[pt] >> (16 * e)));
                    const float y = yd[pt][e] + ea * yo[pt][e] + dsk * xdv;
                    yg[e] = y * fsilu(z); s2 += yg[e] * yg[e]; }
                *(unsigned long long*)(mixb + (size_t)(t0 + l_) * 2048 + 16 * pt + 4 * fq) = (unsigned long long)pk2h(yg[0], yg[1]) | ((unsigned long long)pk2h(yg[2], yg[3]) << 32); }
            s2 += __shfl_xor(s2, 16); s2 += __shfl_xor(s2, 32);
            if (fq == 0) ssq[(size_t)(t0 + l_) * 32] = s2;
            const float cd = fexp(ACS[127]);
#pragma unroll
            for (int pt = 0; pt < 2; ++pt) hst[pt] = hst[pt] * cd;
#pragma unroll
            for (int ks = 0; ks < 4; ++ks) { const bf16x8 bt = *(const LAS bf16x8*)(L + SL_BT + sw128t(16 * w + fr, 4 * ks + fq));
#pragma unroll
                for (int pt = 0; pt < 2; ++pt) { const bf16x8 xw = *(const LAS bf16x8*)(L + SL_XW + sw128(16 * pt + fr, 4 * ks + fq)); hst[pt] = MFMA16(bt, xw, hst[pt]); } }
        }
        LBAR();
#pragma unroll
        for (int pt = 0; pt < 2; ++pt)
            *(LAS unsigned long long*)(L + SL_HS + sw128(16 * pt + fr, 2 * w + (fq >> 1)) + (fq & 1) * 8) = (unsigned long long)pk2h(hst[pt][0], hst[pt][1]) | ((unsigned long long)pk2h(hst[pt][2], hst[pt][3]) << 32);
    }
    {
        float* so = a->out + O_PSSD + ((((size_t)l * 8 + b) * 16 + hd) * 64 + ph * 32) * 128;
#pragma unroll
        for (int pt = 0; pt < 2; ++pt) *(f32x4*)(so + (size_t)(16 * pt + fr0) * 128 + 16 * w + 4 * fq0) = hst[pt];
    }
    __syncthreads();
}

constexpr int LR_ROWS = 512 + 32;
constexpr int LR_A = 0, LR_B = LR_ROWS * 64, LR_XC = 2 * LR_ROWS * 64;
constexpr int LR_SEG = LR_XC + 8192, LR_CAR = LR_SEG + 2 * 32 * 16 * 4, LR_CW = LR_CAR + 64 + 32 * 16 * 4;
static_assert(LR_CW + 5 * 64 * 4 <= RING_BYTES, "lru LDS map");
__device__ __forceinline__ int lr_row(int tok) { return tok + (tok >> 4); }
__device__ __forceinline__ void lru_prompt_item(KP a, Frame& F, int l, int b, int hh, int qd) {
    LAS unsigned char* L = F.lds;
    const int tid0 = F.tid, w = F.wave, fr0 = F.lane & 15, fq0 = F.lane >> 4;
    const bf16* proj_seq = (const bf16*)(a->ws + WS_PROJ) + (size_t)b * 2048 * NPJ;
    bf16* mixb = (bf16*)(a->ws + WS_MIXB) + (size_t)b * 2048 * 2048 + 1536 + hh * 64 + qd * 16;
    LAS float* Al = (LAS float*)(L + LR_A); LAS float* Bl = (LAS float*)(L + LR_B); LAS float* XCs = (LAS float*)(L + LR_XC) + w * 256;
    LAS float* SegA = (LAS float*)(L + LR_SEG); LAS float* SegB = SegA + 512; LAS float* Car = (LAS float*)(L + LR_CAR); LAS float* CarIn = Car + 16; LAS float* CW = (LAS float*)(L + LR_CW);
    const int ch = hh * 64 + qd * 16 + fr0;
    for (int i = tid0; i < 5 * 64; i += NTHR) { const int k = i >> 6, ci = i & 63; CW[i] = k < 4 ? a->in[20][(size_t)l * 4 * 512 + k * 512 + hh * 64 + ci] : a->in[21][(size_t)l * 512 + hh * 64 + ci]; }
    if (tid0 < 16) Car[tid0] = 0.f;
    bf16x8 waf[2], wxf[2];
    {
        const float* wa = a->in[22] + ((size_t)l * 8 + hh) * 64 * 64 + qd * 16 + fr0; const float* wx = a->in[24] + ((size_t)l * 8 + hh) * 64 * 64 + qd * 16 + fr0;
#pragma unroll
        for (int ks = 0; ks < 2; ++ks) { v4u ua, ux; const int i0 = 32 * ks + 8 * fq0;
            ua.x = pk2h(wa[(i0 + 0) * 64], wa[(i0 + 1) * 64]); ua.y = pk2h(wa[(i0 + 2) * 64], wa[(i0 + 3) * 64]); ua.z = pk2h(wa[(i0 + 4) * 64], wa[(i0 + 5) * 64]); ua.w = pk2h(wa[(i0 + 6) * 64], wa[(i0 + 7) * 64]);
            ux.x = pk2h(wx[(i0 + 0) * 64], wx[(i0 + 1) * 64]); ux.y = pk2h(wx[(i0 + 2) * 64], wx[(i0 + 3) * 64]); ux.z = pk2h(wx[(i0 + 4) * 64], wx[(i0 + 5) * 64]); ux.w = pk2h(wx[(i0 + 6) * 64], wx[(i0 + 7) * 64]);
            waf[ks] = __builtin_bit_cast(bf16x8, ua); wxf[ks] = __builtin_bit_cast(bf16x8, ux); }
    }
    const float bav = a->in[23][(size_t)l * 512 + ch], bxv = a->in[25][(size_t)l * 512 + ch];
    const float lamv = a->in[26][(size_t)l * 512 + ch];
    const float spv = -8.0f * ((-lamv) > 20.f ? (-lamv) : log1pf(expf(-lamv)));
    v4u rw[2][4];
#pragma unroll
    for (int ks = 0; ks < 2; ++ks)
#pragma unroll
        for (int k = 0; k < 4; ++k) { const int row = (w * 4) * 16 + fr0 + k - 3; rw[ks][k] = (v4u){0u, 0u, 0u, 0u}; if (row >= 0) rw[ks][k] = *(const GAS v4u*)(proj_seq + (size_t)row * NPJ + OFF_LRU + hh * 64 + 32 * ks + 8 * fq0); }
    __syncthreads();
    for (int qp = 0; qp < 4; ++qp) {
        const int T0 = qp * 512;
        int tid = tid0, fr = fr0, fq = fq0; asm volatile("" : "+v"(tid), "+v"(fr), "+v"(fq));
        v4u gz0, gz1;
        { const bf16* gp = proj_seq + (size_t)(T0 + tid) * NPJ + OFF_GATE + hh * 64 + qd * 16; gz0 = *(const GAS v4u*)gp; gz1 = *(const GAS v4u*)(gp + 8); }
#pragma unroll
        for (int tt = 0; tt < 4; ++tt) {
            const int tb = (w * 4 + tt) * 16;
            v4u nx[2][4];
            if (tt + 1 < 4) {
#pragma unroll
                for (int ks = 0; ks < 2; ++ks)
#pragma unroll
                    for (int k = 0; k < 4; ++k) nx[ks][k] = *(const GAS v4u*)(proj_seq + (size_t)(T0 + tb + 16 + fr + k - 3) * NPJ + OFF_LRU + hh * 64 + 32 * ks + 8 * fq);
            }
            bf16x8 xa[2];
#pragma unroll
            for (int ks = 0; ks < 2; ++ks) {
                const int c0 = 32 * ks + 8 * fq;
                f32x4 acc0 = *(const LAS f32x4*)(CW + 4 * 64 + c0), acc1 = *(const LAS f32x4*)(CW + 4 * 64 + c0 + 4);
#pragma unroll
                for (int k = 0; k < 4; ++k) { f32x4 x0, x1; cvt8(rw[ks][k], x0, x1);
                    acc0 += *(const LAS f32x4*)(CW + k * 64 + c0) * x0; acc1 += *(const LAS f32x4*)(CW + k * 64 + c0 + 4) * x1; }
                v4u u; u.x = pk2h(acc0.x, acc0.y); u.y = pk2h(acc0.z, acc0.w); u.z = pk2h(acc1.x, acc1.y); u.w = pk2h(acc1.z, acc1.w); xa[ks] = __builtin_bit_cast(bf16x8, u);
                if (ks == (qd >> 1) && (fq >> 1) == (qd & 1)) {
                    *(LAS f32x4*)(XCs + fr * 16 + 8 * (fq & 1)) = acc0; *(LAS f32x4*)(XCs + fr * 16 + 8 * (fq & 1) + 4) = acc1; }
            }
            f32x4 pr = (f32x4){bav, bav, bav, bav}, pi = (f32x4){bxv, bxv, bxv, bxv};
#pragma unroll
            for (int ks = 0; ks < 2; ++ks) { pr = MFMA16(xa[ks], waf[ks], pr); pi = MFMA16(xa[ks], wxf[ks], pi); }
            LDS_WAIT(); asm volatile("" ::: "memory");
#pragma unroll
            for (int e = 0; e < 4; ++e) { const int tok = tb + 4 * fq + e;
                const float rg = __builtin_amdgcn_rcpf(1.0f + fexp(-pr[e])), ig = __builtin_amdgcn_rcpf(1.0f + fexp(-pi[e]));
                const float log_a = spv * rg; const float av = fexp(log_a);
                const float y2 = 2.0f * log_a;
                const float om = y2 > -0.02f ? -y2 * (1.0f + y2 * (0.5f + y2 * (0.16666667f + y2 * 0.041666668f))) : 1.0f - av * av;
                const float mult = (T0 + tok == 0) ? 1.0f : sqrtf(om);
                const float xcv = XCs[(4 * fq + e) * 16 + fr];
                Al[lr_row(tok) * 16 + fr] = av; Bl[lr_row(tok) * 16 + fr] = mult * ig * xcv; }
            LDS_WAIT(); asm volatile("" ::: "memory");
            if (tt + 1 < 4) {
#pragma unroll
                for (int ks = 0; ks < 2; ++ks)
#pragma unroll
                    for (int k = 0; k < 4; ++k) rw[ks][k] = nx[ks][k];
            }
        }
        if (qp + 1 < 4) {
#pragma unroll
            for (int ks = 0; ks < 2; ++ks)
#pragma unroll
                for (int k = 0; k < 4; ++k) rw[ks][k] = *(const GAS v4u*)(proj_seq + (size_t)(T0 + 512 + (w * 4) * 16 + fr + k - 3) * NPJ + OFF_LRU + hh * 64 + 32 * ks + 8 * fq);
        }
        LBAR();
        {
            const int sg = tid >> 4, c = tid & 15; float pa = 1.f, hb = 0.f;
#pragma unroll
            for (int i = 0; i < 16; ++i) { const int r = (sg * 17 + i) * 16 + c; const float av = Al[r]; hb = av * hb + Bl[r]; pa *= av; }
            SegA[sg * 16 + c] = pa; SegB[sg * 16 + c] = hb;
        }
        LBAR();
        if (tid < 16) { float h = Car[tid];
            for (int sg = 0; sg < 32; ++sg) { CarIn[sg * 16 + tid] = h; h = SegA[sg * 16 + tid] * h + SegB[sg * 16 + tid]; }
            Car[tid] = h; }
        LBAR();
        {
            const int sg = tid >> 4, c = tid & 15; float h = CarIn[sg * 16 + c];
#pragma unroll
            for (int i = 0; i < 16; ++i) { const int r = (sg * 17 + i) * 16 + c; h = Al[r] * h + Bl[r]; Bl[r] = h; }
        }
        LBAR();
        {
            const int tok = tid;
            float y[16]; f32x4 gq[4]; cvt8(gz0, gq[0], gq[1]); cvt8(gz1, gq[2], gq[3]);
#pragma unroll
            for (int v = 0; v < 4; ++v) { const f32x4 gt = gq[v]; const f32x4 hv = *(const LAS f32x4*)(Bl + lr_row(tok) * 16 + 4 * v);
#pragma unroll
                for (int i = 0; i < 4; ++i) { const float x = gt[i]; const float u = 0.7978845608028654f * (x + 0.044715f * x * x * x); const float th = 1.0f - 2.0f * __builtin_amdgcn_rcpf(1.0f + fexp(2.0f * u));
                    y[4 * v + i] = hv[i] * 0.5f * x * (1.0f + th); } }
            v4u o0, o1; o0.x = pk2h(y[0], y[1]); o0.y = pk2h(y[2], y[3]); o0.z = pk2h(y[4], y[5]); o0.w = pk2h(y[6], y[7]); o1.x = pk2h(y[8], y[9]); o1.y = pk2h(y[10], y[11]); o1.z = pk2h(y[12], y[13]); o1.w = pk2h(y[14], y[15]);
            v4u* op = (v4u*)(mixb + (size_t)(T0 + tok) * 2048); op[0] = o0; op[1] = o1;
        }
        LBAR();
    }
    if (tid0 < 16) a->out[O_PLRU + ((size_t)l * 8 + b) * 512 + hh * 64 + qd * 16 + tid0] = Car[tid0];
    __syncthreads();
}

constexpr int PL_UP = 0, PL_UPROW = 132 * 4, PL_P = 143 * PL_UPROW;
static_assert(PL_P % 16 == 0 && PL_P + 32768 <= RING_BYTES, "pool LDS map");
__device__ __forceinline__ void pool_prompt_item(KP a, Frame& F, int l, int b, int c, int g) {
    LAS unsigned char* L = F.lds;
    const int tid = F.tid, lane = F.lane, w = F.wave, fr = lane & 15, fq = lane >> 4;
    const int t0 = c * 128, win = 2 << g;
    const bf16* proj_seq = (const bf16*)(a->ws + WS_PROJ) + (size_t)b * 2048 * NPJ;
    const bf16* pwt = (const bf16*)(a->ws + WS_PWT) + ((size_t)l * 4 + g) * 128 * 128;
    bf16* mixb = (bf16*)(a->ws + WS_MIXB) + (size_t)b * 2048 * 2048 + 1024 + g * 128;
    {
        v4u ur[5];
#pragma unroll
        for (int k = 0; k < 5; ++k) { const int i = tid + k * NTHR, rr = i >> 4, c8 = i & 15, row = t0 + rr - 15; ur[k] = (v4u){0u, 0u, 0u, 0u};
            if (i < 143 * 16 && row >= 0) ur[k] = *(const GAS v4u*)(proj_seq + (size_t)row * NPJ + OFF_POOL + g * 128 + 8 * c8); }
#pragma unroll
        for (int k = 0; k < 5; ++k) { const int i = tid + k * NTHR, rr = i >> 4, c8 = i & 15; f32x4 v0, v1; cvt8(ur[k], v0, v1);
            if (i < 143 * 16) { *(LAS f32x4*)(L + PL_UP + rr * PL_UPROW + c8 * 32) = v0; *(LAS f32x4*)(L + PL_UP + rr * PL_UPROW + c8 * 32 + 16) = v1; } }
    }
    __syncthreads();
    for (int i = tid; i < 128 * 16; i += NTHR) { const int tok = i >> 4, c8 = i & 15;
        f32x4 s0 = (f32x4){0.f, 0.f, 0.f, 0.f}, s1 = s0;
        for (int j = 0; j < win; ++j) { const LAS unsigned char* p = L + PL_UP + (tok + 15 - j) * PL_UPROW + c8 * 32; s0 += *(const LAS f32x4*)p; s1 += *(const LAS f32x4*)(p + 16); }
        const int pos = t0 + tok; const float ic = 1.0f / (float)((pos + 1 < win) ? (pos + 1) : win);
        const LAS unsigned char* p = L + PL_UP + (tok + 15) * PL_UPROW + c8 * 32; const f32x4 u0 = *(const LAS f32x4*)p, u1 = *(const LAS f32x4*)(p + 16);
        s0 = s0 * ic - u0; s1 = s1 * ic - u1;
        v4u o; o.x = pk2h(s0.x, s0.y); o.y = pk2h(s0.z, s0.w); o.z = pk2h(s1.x, s1.y); o.w = pk2h(s1.z, s1.w);
        *(LAS v4u*)(L + PL_P + sw128(tok, c8)) = o; }
    __syncthreads();
    bf16x8 pa[4];
#pragma unroll
    for (int ks = 0; ks < 4; ++ks) pa[ks] = *(const LAS bf16x8*)(L + PL_P + sw128(16 * w + fr, 4 * ks + fq));
#pragma unroll
    for (int dt = 0; dt < 8; ++dt) { f32x4 acc = (f32x4){0.f, 0.f, 0.f, 0.f};
#pragma unroll
        for (int ks = 0; ks < 4; ++ks) { const bf16x8 wf = *(const bf16x8*)(pwt + (size_t)(16 * dt + fr) * 128 + 32 * ks + 8 * fq); acc = MFMA16(pa[ks], wf, acc); }
#pragma unroll
        for (int e = 0; e < 4; ++e) mixb[(size_t)(t0 + 16 * w + 4 * fq + e) * 2048 + 16 * dt + fr] = (bf16)f2bfh(acc[e]); }
    __syncthreads();
}

struct TI { const float* W; bf16* WT; const float* gain; int K, N, k0, n0, row_off, mode, goff, kd0; };
__device__ __forceinline__ void ti_load(const TI& t, f32x4 (&v)[8], float (&gn)[8], int lane) {
    const int nn = (lane & 7) * 4, kr = lane >> 3;
#pragma unroll
    for (int i = 0; i < 8; ++i) { const int kk = 8 * i + kr; v[i] = (f32x4){0.f, 0.f, 0.f, 0.f}; gn[i] = 1.f;
        if (t.n0 + nn + 4 <= t.N) v[i] = *(const f32x4*)(t.W + (size_t)(t.k0 + kk) * t.N + t.n0 + nn);
        if (t.gain) gn[i] = t.gain[t.k0 + kk - t.goff]; }
}
__device__ __forceinline__ void ti_store(const TI& t, const f32x4 (&v)[8], const float (&gn)[8], LAS float* scr, int lane) {
    const int nn = (lane & 7) * 4, kr = lane >> 3;
#pragma unroll
    for (int i = 0; i < 8; ++i) { const int kk = 8 * i + kr; f32x4 x = v[i] * gn[i];
        scr[kk * 33 + nn] = x.x; scr[kk * 33 + nn + 1] = x.y; scr[kk * 33 + nn + 2] = x.z; scr[kk * 33 + nn + 3] = x.w; }
    LDS_WAIT(); asm volatile("" ::: "memory");
    const int c = lane & 7;
#pragma unroll
    for (int j = 0; j < 4; ++j) { const int nl = (lane >> 3) + 8 * j, n = t.n0 + nl; const LAS float* sp = scr + (8 * c) * 33 + nl;
        v4u o; o.x = pk2h(sp[0 * 33], sp[1 * 33]); o.y = pk2h(sp[2 * 33], sp[3 * 33]); o.z = pk2h(sp[4 * 33], sp[5 * 33]); o.w = pk2h(sp[6 * 33], sp[7 * 33]);
        int dr;
        if (t.mode == 0) dr = t.row_off + n; else if (t.mode == 1) dr = n < 3072 ? n : (n < 3088 ? 4096 + (n - 3072) : n - 16); else dr = 256 * (n >> 7) + (n & 127) + t.row_off;
        if (n < t.N) *(GAS v4u*)(t.WT + (size_t)dr * t.K + t.kd0 + 8 * c) = o; }
    LDS_WAIT(); asm volatile("" ::: "memory");
}
__device__ __forceinline__ void ph_prologue(KP a, Frame& F) {
    LAS float* scr = (LAS float*)(F.lds + RING_OFF + F.wave * 16384);
    const int gw = F.bid * NWAVES + F.wave, NGW = F.G * NWAVES;
    bf16* Wkv = (bf16*)(a->ws + WS_WKV); bf16* Win = (bf16*)(a->ws + WS_WIN); bf16* Wout = (bf16*)(a->ws + WS_WOUT); bf16* Wq = (bf16*)(a->ws + WS_WQ); bf16* Wo = (bf16*)(a->ws + WS_WO);
    bf16* Wgu = (bf16*)(a->ws + WS_WGU); bf16* Wd = (bf16*)(a->ws + WS_WD);
    constexpr int I_IN = 16 * 129, I_OUT = 32 * 32, I_SQ = 16 * 32, I_G = 16 * 88, I_DN = 44 * 32;
    constexpr int PER_L = I_IN + I_OUT + 4 * I_SQ + 2 * I_G + I_DN;
    auto decode = [&](int it) -> TI {
        const int l = it / PER_L; int r = it % PER_L; TI t; t.goff = 0; t.row_off = 0; t.gain = nullptr; t.mode = 0;
        if (r < I_IN) { const int kb = r / 129, nb = r % 129; t.W = a->in[11] + (size_t)l * 1024 * NIN; t.K = 1024; t.N = NIN; t.k0 = 64 * kb; t.kd0 = 64 * kb; t.n0 = 32 * nb; t.WT = Win + (size_t)l * WIN_L; t.mode = 1; t.gain = a->in[10] + (size_t)l * 1024; return t; } r -= I_IN;
        if (r < I_OUT) { const int kb = r / 32, nb = r % 32; t.W = a->in[27] + (size_t)l * 2048 * 1024; t.K = 2048; t.N = 1024; t.k0 = 64 * kb; t.kd0 = 64 * kb; t.n0 = 32 * nb; t.WT = Wout + (size_t)l * WOUT_L; if (kb >= 8 && kb < 24) { t.gain = a->in[19] + (size_t)l * 1024; t.goff = 512; t.kd0 = 64 * (kb - 8); } else if (kb < 8) t.kd0 = 64 * (kb + 16); return t; } r -= I_OUT;
        if (r < I_SQ) { const int kb = r / 32, nb = r % 32; t.W = a->in[29] + (size_t)l * 1024 * 1024; t.K = 1024; t.N = 1024; t.k0 = 64 * kb; t.kd0 = 64 * kb; t.n0 = 32 * nb; t.WT = Wq + (size_t)l * WQ_L; t.gain = a->in[28] + (size_t)l * 1024; return t; } r -= I_SQ;
        if (r < I_SQ) { const int kb = r / 32, nb = r % 32; t.W = a->in[30] + (size_t)l * 1024 * 1024; t.K = 1024; t.N = 1024; t.k0 = 64 * kb; t.kd0 = 64 * kb; t.n0 = 32 * nb; t.WT = Wkv; t.row_off = l * 2048; return t; } r -= I_SQ;
        if (r < I_SQ) { const int kb = r / 32, nb = r % 32; t.W = a->in[31] + (size_t)l * 1024 * 1024; t.K = 1024; t.N = 1024; t.k0 = 64 * kb; t.kd0 = 64 * kb; t.n0 = 32 * nb; t.WT = Wkv; t.row_off = l * 2048 + 1024; return t; } r -= I_SQ;
        if (r < I_SQ) { const int kb = r / 32, nb = r % 32; t.W = a->in[32] + (size_t)l * 1024 * 1024; t.K = 1024; t.N = 1024; t.k0 = 64 * kb; t.kd0 = 64 * kb; t.n0 = 32 * nb; t.WT = Wo + (size_t)l * WQ_L; return t; } r -= I_SQ;
        if (r < I_G) { const int kb = r / 88, nb = r % 88; t.W = a->in[34] + (size_t)l * 1024 * DFF; t.K = 1024; t.N = DFF; t.k0 = 64 * kb; t.kd0 = 64 * kb; t.n0 = 32 * nb; t.WT = Wgu + (size_t)l * WGU_L; t.mode = 2; t.gain = a->in[33] + (size_t)l * 1024; return t; } r -= I_G;
        if (r < I_G) { const int kb = r / 88, nb = r % 88; t.W = a->in[35] + (size_t)l * 1024 * DFF; t.K = 1024; t.N = DFF; t.k0 = 64 * kb; t.kd0 = 64 * kb; t.n0 = 32 * nb; t.WT = Wgu + (size_t)l * WGU_L; t.mode = 2; t.row_off = 128; t.gain = a->in[33] + (size_t)l * 1024; return t; } r -= I_G;
        { const int kb = r / 32, nb = r % 32; t.W = a->in[36] + (size_t)l * DFF * 1024; t.K = DFF; t.N = 1024; t.k0 = 64 * kb; t.kd0 = 64 * kb; t.n0 = 32 * nb; t.WT = Wd + (size_t)l * WD_L; return t; }
    };
    if (gw < DEPTH * PER_L) {
        int it = gw; TI cur = decode(it); f32x4 v[8]; float gn[8]; ti_load(cur, v, gn, F.lane);
        for (;;) {
            const int nit = it + NGW; const bool has = nit < DEPTH * PER_L;
            TI nxt = cur; f32x4 vn[8]; float gnn[8];
            if (has) { nxt = decode(nit); ti_load(nxt, vn, gnn, F.lane); }
            ti_store(cur, v, gn, scr, F.lane);
            if (!has) break;
            cur = nxt; it = nit;
#pragma unroll
            for (int i = 0; i < 8; ++i) { v[i] = vn[i]; gn[i] = gnn[i]; }
        }
    }
    { bf16* pwt = (bf16*)(a->ws + WS_PWT);
      for (size_t i = (size_t)F.bid * NTHR + F.tid; i < (size_t)DEPTH * 4 * 128 * 128; i += (size_t)F.G * NTHR) { const int c = (int)(i & 127), d = (int)((i >> 7) & 127), lg = (int)(i >> 14);
          pwt[i] = (bf16)f2bfh(a->in[12][((size_t)lg * 128 + c) * 128 + d] * a->in[13][(size_t)lg * 128 + d]); } }
    const size_t gt = (size_t)F.bid * NTHR + F.tid, gs = (size_t)F.G * NTHR;
    { const f32x4* src = (const f32x4*)a->in[2]; unsigned long long* dst = (unsigned long long*)(a->ws + WS_MEMB);
      for (size_t i = gt; i < (size_t)2048 * 1024 / 4; i += gs) { const f32x4 v = src[i]; dst[i] = (unsigned long long)pk2h(v.x, v.y) | ((unsigned long long)pk2h(v.z, v.w) << 32); } }
    { bf16* hb = (bf16*)(a->ws + WS_HB); float* rss = (float*)(a->ws + WS_RSS);
      for (int r0 = gw; r0 < MT; r0 += 4 * NGW) {
          f32x4 v[4][4];
#pragma unroll
          for (int q = 0; q < 4; ++q) { const int r = r0 + q * NGW; const f32x4* src = (const f32x4*)((r < MP ? a->in[0] : a->in[1] - (size_t)MP * D) + (size_t)r * D);
#pragma unroll
              for (int j = 0; j < 4; ++j) v[q][j] = r < MT ? src[F.lane + 64 * j] : (f32x4){0.f, 0.f, 0.f, 0.f}; }
#pragma unroll
          for (int q = 0; q < 4; ++q) { const int r = r0 + q * NGW; float ss = 0.f;
              if (r < MT) {
#pragma unroll
                  for (int j = 0; j < 4; ++j) { const f32x4 x = v[q][j]; ss += x.x * x.x + x.y * x.y + x.z * x.z + x.w * x.w;
                      ((unsigned long long*)(hb + (size_t)r * D))[F.lane + 64 * j] = (unsigned long long)pk2h(x.x, x.y) | ((unsigned long long)pk2h(x.z, x.w) << 32); } }
              ss = wave_sum(ss);
              if (r < MT && F.lane < 16) rss[(size_t)r * 16 + F.lane] = F.lane == 0 ? ss : 0.f; } } }
}

__device__ __forceinline__ void ph_final_norm(Frame& F, const bf16* hb, const float* g, float* Y) {
    const int gw = F.bid * NWAVES + F.wave, NGW = F.G * NWAVES;
    f32x4 gg[4];
#pragma unroll
    for (int j = 0; j < 4; ++j) gg[j] = ((const f32x4*)g)[F.lane + 64 * j];
    for (int r0 = gw; r0 < MT; r0 += 4 * NGW) {
        unsigned long long u[4][4];
#pragma unroll
        for (int q = 0; q < 4; ++q) { const int r = r0 + q * NGW;
#pragma unroll
            for (int j = 0; j < 4; ++j) u[q][j] = r < MT ? ((const unsigned long long*)(hb + (size_t)r * D))[F.lane + 64 * j] : 0ull; }
#pragma unroll
        for (int q = 0; q < 4; ++q) { const int r = r0 + q * NGW; f32x4 v[4]; float ss = 0.f;
#pragma unroll
            for (int j = 0; j < 4; ++j) { const unsigned long long x = u[q][j];
                v[j] = (f32x4){bf2f((unsigned short)x), bf2f((unsigned short)(x >> 16)), bf2f((unsigned short)(x >> 32)), bf2f((unsigned short)(x >> 48))}; ss += v[j].x * v[j].x + v[j].y * v[j].y + v[j].z * v[j].z + v[j].w * v[j].w; }
            ss = wave_sum(ss);
            const float rstd = 1.0f / sqrtf(ss * (1.0f / D) + EPS);
            if (r < MT) {
#pragma unroll
                for (int j = 0; j < 4; ++j) ((f32x4*)(Y + (size_t)r * D))[F.lane + 64 * j] = v[j] * rstd * gg[j]; } }
    }
}

__device__ __forceinline__ float pool_up(const bf16* proj, const float* st_in, const SeqInfo& q, int ci, int ch) {
    if (ci < 15) return q.grp ? st_in[((size_t)q.b * 15 + ci) * 512 + ch] : 0.f;
    return bf2f(proj[(size_t)(q.row0 + ci - 15) * NPJ + OFF_POOL + ch]);
}
__device__ __forceinline__ float conv_xp(const bf16* proj, int off, const float* st_in, int C, const SeqInfo& q, int j, int c) {
    if (j < 3) return q.grp ? st_in[((size_t)q.b * 3 + j) * C + c] : 0.f;
    return bf2f(proj[(size_t)(q.row0 + j - 3) * NPJ + off + c]);
}
__device__ __forceinline__ void conv_states(size_t gt, size_t gs, const bf16* proj, int off, int C, const float* st_in, float* p_out, float* s_out) {
    for (size_t idx = gt; idx < (size_t)NSEQ * 3 * C; idx += gs) {
        const int c = (int)(idx % C), j = (int)((idx / C) % 3), s = (int)(idx / ((size_t)3 * C));
        const SeqInfo q = seq_info(s);
        const float v = conv_xp(proj, off, st_in, C, q, q.L + j, c);
        if (q.grp) s_out[((size_t)q.b * 3 + j) * C + c] = v; else p_out[((size_t)q.b * 3 + j) * C + c] = v;
    }
}
constexpr int SS_X = 0, SS_BC = 8192, SS_DT = 12288;
__device__ __forceinline__ void samp_ssd_item(KP a, Frame& F, int l, int b, int g) {
    LAS float* XS = (LAS float*)(F.lds + RING_OFF + SS_X); LAS float* BC = (LAS float*)(F.lds + RING_OFF + SS_BC); LAS float* DTs = (LAS float*)(F.lds + RING_OFF + SS_DT);
    const int tid = F.tid;
    const bf16* proj = (const bf16*)(a->ws + WS_PROJ) + (size_t)(MP + 4 * b) * NPJ; const float* dtr = (const float*)(a->ws + WS_DT) + (size_t)(MP + 4 * b) * 16;
    const float* cst = a->in[4] + ((size_t)l * 128 + b) * 3 * 1536; const float* cw = a->in[14] + (size_t)l * 4 * 1536; const float* cb = a->in[15] + (size_t)l * 1536;
    bf16* mixb = (bf16*)(a->ws + WS_MIXB) + (size_t)(MP + 4 * b) * 2048;
#pragma unroll
    for (int rep = 0; rep < 2; ++rep) {
        if (rep == 1 && tid >= 256) break;
        const int sc = rep == 0 ? g * 512 + tid : (tid < 128 ? 1024 + g * 128 + tid : 1280 + g * 128 + (tid - 128));
        float xp[7];
#pragma unroll
        for (int j = 0; j < 3; ++j) xp[j] = cst[(size_t)j * 1536 + sc];
#pragma unroll
        for (int t = 0; t < 4; ++t) xp[3 + t] = bf2f(proj[(size_t)t * NPJ + OFF_XBC + sc]);
        const float w0 = cw[sc], w1 = cw[1536 + sc], w2 = cw[2 * 1536 + sc], w3 = cw[3 * 1536 + sc], bb = cb[sc];
#pragma unroll
        for (int t = 0; t < 4; ++t) { const float v = fsilu(bb + w0 * xp[t] + w1 * xp[t + 1] + w2 * xp[t + 2] + w3 * xp[t + 3]); if (rep == 0) XS[t * 512 + tid] = v; else BC[t * 256 + tid] = v; }
    }
    if (tid < 32) { const int t = tid >> 3, k = tid & 7, hd = 8 * g + k; const float dt = softplus_f(dtr[(size_t)t * 16 + hd] + a->in[16][l * 16 + hd]); DTs[t * 8 + k] = dt; DTs[32 + t * 8 + k] = expf(dt * -expf(a->in[17][l * 16 + hd])); }
    __syncthreads();
    const int p = tid >> 3, ng = tid & 7;
    const float* st_in = a->in[5] + (((size_t)l * 128 + b) * 16 + 8 * g) * 64 * 128 + (size_t)p * 128 + ng * 16;
    float* st_out = a->out + O_SSSD + (((size_t)l * 128 + b) * 16 + 8 * g) * 64 * 128 + (size_t)p * 128 + ng * 16;
    f32x4 hn[4];
#pragma unroll
    for (int i = 0; i < 4; ++i) hn[i] = *(const f32x4*)(st_in + 4 * i);
#pragma unroll 1
    for (int k = 0; k < 8; ++k) {
        f32x4 h[4];
#pragma unroll
        for (int i = 0; i < 4; ++i) h[i] = hn[i];
        if (k + 1 < 8) {
#pragma unroll
            for (int i = 0; i < 4; ++i) hn[i] = *(const f32x4*)(st_in + (size_t)(k + 1) * 64 * 128 + 4 * i); }
        const int hd = 8 * g + k; const float Dk = a->in[18][l * 16 + hd];
        float zv[4];
#pragma unroll
        for (int t = 0; t < 4; ++t) zv[t] = bf2f(proj[(size_t)t * NPJ + OFF_Z + hd * 64 + p]);
#pragma unroll
        for (int t = 0; t < 4; ++t) {
            const float dt = DTs[t * 8 + k], dA = DTs[32 + t * 8 + k], x = XS[t * 512 + k * 64 + p], xdt = dt * x;
            float part = 0.f;
#pragma unroll
            for (int i = 0; i < 4; ++i) { const f32x4 Bv = *(const LAS f32x4*)(BC + t * 256 + ng * 16 + 4 * i), Cv = *(const LAS f32x4*)(BC + t * 256 + 128 + ng * 16 + 4 * i);
                h[i] = h[i] * dA + Bv * xdt; part += (Cv.x * h[i].x + Cv.y * h[i].y) + (Cv.z * h[i].z + Cv.w * h[i].w); }
            part += __shfl_xor(part, 1); part += __shfl_xor(part, 2); part += __shfl_xor(part, 4);
            if (ng == 0) mixb[(size_t)t * 2048 + hd * 64 + p] = (bf16)f2bfh((part + Dk * x) * fsilu(zv[t]));
        }
#pragma unroll
        for (int i = 0; i < 4; ++i) *(f32x4*)(st_out + (size_t)k * 64 * 128 + 4 * i) = h[i];
    }
    __syncthreads();
}
__device__ __forceinline__ void samp_lru_item(KP a, Frame& F, int l, int b) {
    LAS float* XC = (LAS float*)(F.lds + RING_OFF);
    const int c = F.tid, hd = c >> 6, j = c & 63;
    const bf16* proj = (const bf16*)(a->ws + WS_PROJ) + (size_t)(MP + 4 * b) * NPJ;
    const float* cst = a->in[6] + ((size_t)l * 128 + b) * 3 * 512; const float* cw = a->in[20] + (size_t)l * 4 * 512;
    float xp[7];
#pragma unroll
    for (int k = 0; k < 3; ++k) xp[k] = cst[(size_t)k * 512 + c];
#pragma unroll
    for (int t = 0; t < 4; ++t) xp[3 + t] = bf2f(proj[(size_t)t * NPJ + OFF_LRU + c]);
    const float w0 = cw[c], w1 = cw[512 + c], w2 = cw[1024 + c], w3 = cw[1536 + c], bb = a->in[21][(size_t)l * 512 + c];
    float xc[4];
#pragma unroll
    for (int t = 0; t < 4; ++t) { xc[t] = bb + w0 * xp[t] + w1 * xp[t + 1] + w2 * xp[t + 2] + w3 * xp[t + 3]; XC[t * 512 + c] = xc[t]; }
    __syncthreads();
    const float* wa = a->in[22] + ((size_t)l * 8 + hd) * 64 * 64 + j; const float* wx = a->in[24] + ((size_t)l * 8 + hd) * 64 * 64 + j;
    float ar[4], ai[4];
#pragma unroll
    for (int t = 0; t < 4; ++t) { ar[t] = a->in[23][(size_t)l * 512 + c]; ai[t] = a->in[25][(size_t)l * 512 + c]; }
#pragma unroll 16
    for (int i = 0; i < 64; ++i) { const float wav = wa[(size_t)i * 64], wxv = wx[(size_t)i * 64];
#pragma unroll
        for (int t = 0; t < 4; ++t) { const float xv = XC[t * 512 + hd * 64 + i]; ar[t] += xv * wav; ai[t] += xv * wxv; } }
    const float lamv = a->in[26][(size_t)l * 512 + c]; const float spv = -8.0f * softplus_f(-lamv);
    float h = a->in[7][((size_t)l * 128 + b) * 512 + c];
    bf16* mixb = (bf16*)(a->ws + WS_MIXB) + (size_t)(MP + 4 * b) * 2048 + 1536 + c;
#pragma unroll
    for (int t = 0; t < 4; ++t) { const float rg = sigmoid_f(ar[t]), ig = sigmoid_f(ai[t]); const float log_a = spv * rg; const float av = expf(log_a), mult = sqrtf(-expm1f(2.0f * log_a));
        h = av * h + mult * ig * xc[t];
        mixb[(size_t)t * 2048] = (bf16)f2bfh(h * gelu_tanh_f(bf2f(proj[(size_t)t * NPJ + OFF_GATE + c]))); }
    a->out[O_SLRU + ((size_t)l * 128 + b) * 512 + c] = h;
    __syncthreads();
}
__device__ __forceinline__ void samp_pool_item(KP a, Frame& F, int l, int b) {
    LAS float* PO = (LAS float*)(F.lds + RING_OFF);
    const int ch = F.tid, g = ch >> 7, w = 2 << g;
    const bf16* proj = (const bf16*)(a->ws + WS_PROJ) + (size_t)(MP + 4 * b) * NPJ;
    const float* st = a->in[3] + ((size_t)l * 128 + b) * 15 * 512;
    float up[19];
#pragma unroll
    for (int i = 0; i < 15; ++i) up[i] = st[(size_t)i * 512 + ch];
#pragma unroll
    for (int t = 0; t < 4; ++t) up[15 + t] = bf2f(proj[(size_t)t * NPJ + OFF_POOL + ch]);
    const float iw = 1.0f / (float)w;
#pragma unroll
    for (int t = 0; t < 4; ++t) { float sm = 0.f;
#pragma unroll
        for (int jj = 0; jj < 16; ++jj) sm += (jj < w) ? up[15 + t - jj] : 0.f;
        PO[t * 512 + ch] = sm * iw - up[15 + t]; }
    __syncthreads();
    const int d = ch & 127; const float* pw = a->in[12] + ((size_t)l * 4 + g) * 128 * 128 + d; const float sc = a->in[13][(size_t)l * 512 + ch];
    float acc[4] = {0.f, 0.f, 0.f, 0.f};
#pragma unroll 16
    for (int cc = 0; cc < 128; ++cc) { const float wv = pw[(size_t)cc * 128];
#pragma unroll
        for (int t = 0; t < 4; ++t) acc[t] += PO[t * 512 + g * 128 + cc] * wv; }
    bf16* mixb = (bf16*)(a->ws + WS_MIXB) + (size_t)(MP + 4 * b) * 2048 + 1024 + ch;
#pragma unroll
    for (int t = 0; t < 4; ++t) mixb[(size_t)t * 2048] = (bf16)f2bfh(acc[t] * sc);
    __syncthreads();
}

__device__ __forceinline__ void ph_mix1(KP a, Frame& F, int l) {
    const size_t gt = (size_t)F.bid * NTHR + F.tid, gs = (size_t)F.G * NTHR;
    const bf16* proj = (const bf16*)(a->ws + WS_PROJ);
    {
        const float* st_in = a->in[3] + (size_t)l * 128 * 15 * 512;
        float* p_out = a->out + O_PPOOL + (size_t)l * 8 * 15 * 512; float* s_out = a->out + O_SPOOL + (size_t)l * 128 * 15 * 512;
        for (size_t idx = gt; idx < (size_t)NSEQ * 15 * 512; idx += gs) {
            const int ch = (int)(idx & 511), j = (int)((idx >> 9) % 15), s = (int)((idx >> 9) / 15);
            const SeqInfo q = seq_info(s);
            const float v = pool_up(proj, st_in, q, q.L + j, ch);
            if (q.grp) s_out[((size_t)q.b * 15 + j) * 512 + ch] = v; else p_out[((size_t)q.b * 15 + j) * 512 + ch] = v;
        }
    }
    conv_states(gt, gs, proj, OFF_XBC, 1536, a->in[4] + (size_t)l * 128 * 3 * 1536, a->out + O_PSCONV + (size_t)l * 8 * 3 * 1536, a->out + O_SSCONV + (size_t)l * 128 * 3 * 1536);
    conv_states(gt, gs, proj, OFF_LRU, 512, a->in[6] + (size_t)l * 128 * 3 * 512, a->out + O_PLCONV + (size_t)l * 8 * 3 * 512, a->out + O_SLCONV + (size_t)l * 128 * 3 * 512);
    __syncthreads();
    { const KP kp = a; (void)kp;
    REG_BEGIN(0);
    for (int it = F.vcu; it < 256; it += F.G) ssd_prompt_item(a, F, l, it >> 5, (it >> 1) & 15, it & 1);
    REG_END(0); REG_BEGIN(1);
    for (int it = F.vcu; it < 256; it += F.G) lru_prompt_item(a, F, l, it >> 5, (it >> 2) & 7, it & 3);
    REG_END(1); }
    for (int it = F.vcu; it < 512; it += F.G) pool_prompt_item(a, F, l, it >> 6, (it >> 2) & 15, it & 3);
    for (int it = F.bid; it < 256; it += F.G) samp_ssd_item(a, F, l, it >> 1, it & 1);
    for (int it = F.bid; it < 256; it += F.G) { if (it < 128) samp_lru_item(a, F, l, it); else samp_pool_item(a, F, l, it - 128); }
}
__device__ __forceinline__ void ph_mix3(KP a, Frame& F, int l) {
    bf16* mixb = (bf16*)(a->ws + WS_MIXB);
    const int gw = F.bid * NWAVES + F.wave, NGW = F.G * NWAVES;
    for (int r = gw; r < MP; r += NGW) {
        const float* sp = (const float*)(a->ws + WS_SSDSS) + (size_t)r * 32;
        float ss = F.lane < 32 ? sp[F.lane] : 0.f; ss = wave_sum(ss);
        const float rstd = 1.0f / sqrtf(ss * (1.0f / 1024.f) + EPS);
#pragma unroll
        for (int j = 0; j < 4; ++j) { const int c = 4 * F.lane + 256 * j; unsigned long long* mp = (unsigned long long*)(mixb + (size_t)r * 2048 + 512 + c); const unsigned long long u = *mp;
            const float w0 = bf2f((unsigned short)u) * rstd, w1 = bf2f((unsigned short)(u >> 16)) * rstd, w2 = bf2f((unsigned short)(u >> 32)) * rstd, w3 = bf2f((unsigned short)(u >> 48)) * rstd;
            *mp = (unsigned long long)pk2h(w0, w1) | ((unsigned long long)pk2h(w2, w3) << 32); }
    }
}
constexpr int SG_PSTRIDE = 36, SG_P = 0, SG_SS = 8 * 64 * SG_PSTRIDE * 4;
static_assert(SG_SS + 8 * 64 * 4 <= RING_BYTES, "small gemm LDS map");
__device__ __forceinline__ float sumsq8(bf16x8 v) { float s = 0.f;
#pragma unroll
    for (int j = 0; j < 8; ++j) { const float x = bf2f((unsigned short)v[j]); s += x * x; } return s; }
template <int K, int STATS  , class Epi>
__device__ __forceinline__ void small_gemm(Frame& F, const bf16* A, const bf16* Bt, int it0, int it1, const Epi& E) {
    constexpr int KW = K / 8, KS = KW / 32;
    constexpr bool REUSE = Epi::RT_SLOW && K == 1024;
    static_assert(K % 256 == 0, "K splits into eight 32-multiples");
    LAS float* P = (LAS float*)(F.lds + RING_OFF + SG_P); LAS float* SS = (LAS float*)(F.lds + RING_OFF + SG_SS);
    const int w = F.wave;
    bf16x8 afr[REUSE ? KS : 1][4]; float ssqr[4] = {0.f, 0.f, 0.f, 0.f}; int rt_have = -1;
    for (int it = it0; it < it1; ++it) {
        int tid = F.tid; asm volatile("" : "+v"(tid));
        const int lane = tid & 63, fr = lane & 15, fq = lane >> 4;
        const int rt = Epi::RT_SLOW ? it / E.nctl : (it & 7), ct = Epi::RT_SLOW ? E.ct0 + it % E.nctl : (it >> 3);
        if (Epi::RT_SLOW && ct >= Epi::NCT) continue;
        int nb0, nb1; E.bases(ct, nb0, nb1);
        const bf16* Ap = A + (size_t)(64 * rt + fr) * K + w * KW + 8 * fq;
        const bf16* Bp0 = Bt + (size_t)(nb0 + fr) * K + w * KW + 8 * fq; const bf16* Bp1 = Bt + (size_t)(nb1 + fr) * K + w * KW + 8 * fq;
        f32x4 acc[4][2]; float ssq[4];
#pragma unroll
        for (int mt = 0; mt < 4; ++mt) { acc[mt][0] = (f32x4){0.f, 0.f, 0.f, 0.f}; acc[mt][1] = (f32x4){0.f, 0.f, 0.f, 0.f}; ssq[mt] = 0.f; }
        if constexpr (REUSE) {
            bf16x8 bq[KS][2];
#pragma unroll
            for (int ks = 0; ks < KS; ++ks) { bq[ks][0] = *(const bf16x8*)(Bp0 + 32 * ks); bq[ks][1] = *(const bf16x8*)(Bp1 + 32 * ks); }
            if (rt != rt_have) {
#pragma unroll
                for (int ks = 0; ks < KS; ++ks)
#pragma unroll
                    for (int mt = 0; mt < 4; ++mt) afr[ks][mt] = *(const bf16x8*)(Ap + (size_t)mt * 16 * K + 32 * ks);
#pragma unroll
                for (int mt = 0; mt < 4; ++mt) { float sv = 0.f;
#pragma unroll
                    for (int ks = 0; ks < KS; ++ks) sv += sumsq8(afr[ks][mt]);
                    ssqr[mt] = sv; }
                rt_have = rt;
            }
#pragma unroll
            for (int ks = 0; ks < KS; ++ks)
#pragma unroll
                for (int mt = 0; mt < 4; ++mt) { acc[mt][0] = MFMA16(afr[ks][mt], bq[ks][0], acc[mt][0]); acc[mt][1] = MFMA16(afr[ks][mt], bq[ks][1], acc[mt][1]); }
#pragma unroll
            for (int mt = 0; mt < 4; ++mt) ssq[mt] = ssqr[mt];
        } else {
#pragma unroll
            for (int ks = 0; ks < KS; ++ks) {
                bf16x8 af[4];
#pragma unroll
                for (int mt = 0; mt < 4; ++mt) af[mt] = *(const bf16x8*)(Ap + (size_t)mt * 16 * K + 32 * ks);
                const bf16x8 b0 = *(const bf16x8*)(Bp0 + 32 * ks), b1 = *(const bf16x8*)(Bp1 + 32 * ks);
#pragma unroll
                for (int mt = 0; mt < 4; ++mt) { acc[mt][0] = MFMA16(af[mt], b0, acc[mt][0]); acc[mt][1] = MFMA16(af[mt], b1, acc[mt][1]); if (STATS == 1 || (STATS == 2 && w < 4)) ssq[mt] += sumsq8(af[mt]); }
            }
        }
#pragma unroll
        for (int mt = 0; mt < 4; ++mt) {
#pragma unroll
            for (int nt = 0; nt < 2; ++nt)
#pragma unroll
                for (int e = 0; e < 4; ++e) P[(w * 64 + 16 * mt + 4 * fq + e) * SG_PSTRIDE + 16 * nt + fr] = acc[mt][nt][e];
            if (STATS) { float sv = ssq[mt]; sv += __shfl_xor(sv, 16); sv += __shfl_xor(sv, 32); if (fq == 0) SS[w * 64 + 16 * mt + fr] = sv; }
        }
        __syncthreads();
        {
            const int row = tid >> 3, cq = tid & 7;
            f32x4 v = (f32x4){0.f, 0.f, 0.f, 0.f}, v2 = v;
            float rstd = 1.f;
            if (STATS) { float sm = 0.f;
#pragma unroll
                for (int ww = 0; ww < 8; ++ww) sm += SS[ww * 64 + row];
                rstd = 1.0f / sqrtf(sm * (1.0f / 1024.f) + EPS); }
#pragma unroll
            for (int ww = 0; ww < 8; ++ww) { const float sc = (STATS == 2 && ww < 4) ? rstd : 1.f;
                v += *(const LAS f32x4*)(P + (ww * 64 + row) * SG_PSTRIDE + 4 * cq) * sc; if (Epi::PAIR) v2 += *(const LAS f32x4*)(P + (ww * 64 + row) * SG_PSTRIDE + 4 * (cq ^ 4)); }
            if (STATS == 2) rstd = 1.f;
            E.store(ct, MP + 64 * rt + row, cq, v, v2, rstd);
        }
        __syncthreads();
    }
}
struct SProj {
    static constexpr bool PAIR = false, RT_SLOW = true; static constexpr int NCT = 129; bf16* proj; float* dtr; int ct0, nctl;
    __device__ __forceinline__ void bases(int ct, int& nb0, int& nb1) const { nb0 = 32 * ct; nb1 = nb0 + 16; }
    __device__ __forceinline__ void store(int ct, int row, int cq, f32x4 v, f32x4, float rstd) const { const int j = 32 * ct + 4 * cq; const f32x4 o = v * rstd;
        if (j < 4096) *(unsigned long long*)(proj + (size_t)row * NPJ + j) = (unsigned long long)pk2h(o.x, o.y) | ((unsigned long long)pk2h(o.z, o.w) << 32);
        else if (j < 4112) *(f32x4*)(dtr + (size_t)row * 16 + (j - 4096)) = o; }
};
struct SResid {
    static constexpr bool PAIR = false, RT_SLOW = false; static constexpr int NCT = 32, ct0 = 0, nctl = 1; bf16* hb;
    __device__ __forceinline__ void bases(int ct, int& nb0, int& nb1) const { nb0 = 32 * ct; nb1 = nb0 + 16; }
    __device__ __forceinline__ void store(int ct, int row, int cq, f32x4 v, f32x4, float) const { const int c = 32 * ct + 4 * cq; unsigned long long* hp = (unsigned long long*)(hb + (size_t)row * 1024 + c); const unsigned long long u = *hp;
        const float o0 = bf2f((unsigned short)u) + v.x, o1 = bf2f((unsigned short)(u >> 16)) + v.y, o2 = bf2f((unsigned short)(u >> 32)) + v.z, o3 = bf2f((unsigned short)(u >> 48)) + v.w;
        *hp = (unsigned long long)pk2h(o0, o1) | ((unsigned long long)pk2h(o2, o3) << 32); }
};
struct SQ {
    static constexpr bool PAIR = false, RT_SLOW = false; static constexpr int NCT = 32, ct0 = 0, nctl = 1; bf16* qb; float scale;
    __device__ __forceinline__ void bases(int ct, int& nb0, int& nb1) const { nb0 = 32 * ct; nb1 = nb0 + 16; }
    __device__ __forceinline__ void store(int ct, int row, int cq, f32x4 v, f32x4, float rstd) const { const int c = 32 * ct + 4 * cq; const f32x4 o = v * (rstd * scale);
        *(unsigned long long*)(qb + (size_t)row * 1024 + c) = (unsigned long long)pk2h(o.x, o.y) | ((unsigned long long)pk2h(o.z, o.w) << 32); }
};
struct SSwiGLU {
    static constexpr bool PAIR = true, RT_SLOW = true; static constexpr int NCT = 176; bf16* act; int ct0, nctl;
    __device__ __forceinline__ void bases(int ct, int& nb0, int& nb1) const { nb0 = 256 * (ct >> 3) + 16 * (ct & 7); nb1 = nb0 + 128; }
    __device__ __forceinline__ void store(int ct, int row, int cq, f32x4 g, f32x4 u, float rstd) const { if (cq < 4) { const int c = 128 * (ct >> 3) + 16 * (ct & 7) + 4 * cq; const f32x4 gs = g * rstd, us = u * rstd;
        *(unsigned long long*)(act + (size_t)row * DFF + c) = (unsigned long long)pk2h(fsilu(gs.x) * us.x, fsilu(gs.y) * us.y) | ((unsigned long long)pk2h(fsilu(gs.z) * us.z, fsilu(gs.w) * us.w) << 32); } }
};
__device__ __forceinline__ void dt_gemm(Frame& F, const bf16* hb, const bf16* Wdt, const float* rss, float* dtr) {
    for (int it = F.bid; it < MP / 128; it += F.G) {
        int tid = F.tid; asm volatile("" : "+v"(tid)); const int lane = tid & 63, fr = lane & 15, fq = lane >> 4;
        const int row0 = it * 128 + 16 * F.wave;
        f32x4 acc = (f32x4){0.f, 0.f, 0.f, 0.f};
#pragma unroll 8
        for (int ks = 0; ks < 32; ++ks) { const bf16x8 af = *(const bf16x8*)(hb + (size_t)(row0 + fr) * 1024 + 32 * ks + 8 * fq); const bf16x8 bfm = *(const bf16x8*)(Wdt + (size_t)fr * 1024 + 32 * ks + 8 * fq); acc = MFMA16(af, bfm, acc); }
#pragma unroll
        for (int e = 0; e < 4; ++e) { const int row = row0 + 4 * fq + e; const f32x4* rp = (const f32x4*)(rss + (size_t)row * 16); const f32x4 p0 = rp[0], p1 = rp[1], p2 = rp[2], p3 = rp[3];
            const float sm = ((p0.x + p0.y) + (p0.z + p0.w)) + ((p1.x + p1.y) + (p1.z + p1.w)) + ((p2.x + p2.y) + (p2.z + p2.w)) + ((p3.x + p3.y) + (p3.z + p3.w));
            dtr[(size_t)row * 16 + fr] = acc[e] * (1.0f / sqrtf(sm * (1.0f / 1024.f) + EPS)); }
    }
}

__device__ __forceinline__ void attn_prompt_unit(Frame& F, const bf16* qb, const bf16* kb_l, const bf16* vt_l, bf16* ob, int b, int hh, int qt) {
    LAS unsigned char* lds = F.lds + RING_OFF;
    const int lane = F.lane, fr = lane & 15, fq = lane >> 4, tid = F.tid;
    const int r0 = b * 2048 + qt * 256 + F.wave * 32;
    const bf16* kbase = kb_l + (size_t)(b * 256) * 1024 + hh * 256; const bf16* vbase = vt_l + (size_t)(hh * 256) * 2048 + b * 256;
    v4u rg[8];
#define ATT_LOAD(base, pitch, half) do { const bf16* tb_ = (base); asm volatile("" : "+s"(tb_)); tb_ += (size_t)((half) * 128 + (tid >> 5)) * (pitch) + (tid & 31) * 8; \
        _Pragma("unroll") for (int ps = 0; ps < 8; ++ps) rg[ps] = *(const GAS v4u*)(tb_ + (size_t)ps * 16 * (pitch)); } while (0)
#define ATT_STORE(bufoff) do { LAS unsigned char* lb_ = lds + (bufoff) + (tid >> 5) * 512 + (((tid & 31) ^ ((tid >> 5) & 15)) << 4); \
        _Pragma("unroll") for (int ps = 0; ps < 8; ++ps) *(LAS v4u*)(lb_ + ps * 8192) = rg[ps]; } while (0)
    ATT_LOAD(kbase, 1024, 0); ATT_STORE(0);
    ATT_LOAD(kbase, 1024, 1); ATT_STORE(65536);
    LBAR();
    bf16x8 pf[2][8]; float inv[2];
#pragma unroll
    for (int mt = 0; mt < 2; ++mt) {
        __builtin_amdgcn_sched_barrier(0);
        bf16x8 qf[8];
#pragma unroll
        for (int ks = 0; ks < 8; ++ks) qf[ks] = *(const bf16x8*)(qb + (size_t)(r0 + mt * 16 + fr) * 1024 + hh * 256 + ks * 32 + fq * 8);
        f32x4 s[16];
#pragma unroll
        for (int kt = 0; kt < 16; ++kt) { s[kt] = (f32x4){0.f, 0.f, 0.f, 0.f};
#pragma unroll
            for (int kh = 0; kh < 2; ++kh) { bf16x8 kf[4];
#pragma unroll
                for (int ks = 0; ks < 4; ++ks) kf[ks] = *(const LAS bf16x8*)(lds + (16 * kt + fr) * 512 + (((4 * (4 * kh + ks) + fq) ^ fr) << 4));
#pragma unroll
                for (int ks = 0; ks < 4; ++ks) s[kt] = MFMA16(kf[ks], qf[4 * kh + ks], s[kt]);
                __builtin_amdgcn_sched_barrier(0); } }
        float m = -3.0e38f;
#pragma unroll
        for (int kt = 0; kt < 16; ++kt) m = fmaxf(fmaxf(fmaxf(s[kt][0], s[kt][1]), fmaxf(s[kt][2], s[kt][3])), m);
        m = fmaxf(m, __shfl_xor(m, 16)); m = fmaxf(m, __shfl_xor(m, 32));
        float sum = 0.f;
#pragma unroll
        for (int kt = 0; kt < 16; ++kt)
#pragma unroll
            for (int e = 0; e < 4; ++e) { const float p = __builtin_amdgcn_exp2f(s[kt][e] - m); s[kt][e] = p; sum += p; }
        sum += __shfl_xor(sum, 16); sum += __shfl_xor(sum, 32);
        inv[mt] = 1.0f / sum;
#pragma unroll
        for (int ks = 0; ks < 8; ++ks) { v4u w; w.x = pk2h(s[2 * ks][0], s[2 * ks][1]); w.y = pk2h(s[2 * ks][2], s[2 * ks][3]);
            w.z = pk2h(s[2 * ks + 1][0], s[2 * ks + 1][1]); w.w = pk2h(s[2 * ks + 1][2], s[2 * ks + 1][3]); pf[mt][ks] = __builtin_bit_cast(bf16x8, w); }
        __builtin_amdgcn_sched_barrier(0);
    }
    LBAR();
    ATT_LOAD(vbase, 2048, 0); ATT_STORE(0); ATT_LOAD(vbase, 2048, 1); ATT_STORE(65536);
    LBAR();
#pragma unroll
    for (int qr = 0; qr < 4; ++qr) {
        const int bo = (qr >> 1) * 65536;
        f32x4 o[2][4];
#pragma unroll
        for (int dl = 0; dl < 4; ++dl) { o[0][dl] = (f32x4){0.f, 0.f, 0.f, 0.f}; o[1][dl] = (f32x4){0.f, 0.f, 0.f, 0.f};
#pragma unroll
            for (int kh = 0; kh < 2; ++kh) { bf16x8 vf[4];
#pragma unroll
                for (int ks = 0; ks < 4; ++ks) vf[ks] = *(const LAS bf16x8*)(lds + bo + (16 * ((qr & 1) * 4 + dl) + fr) * 512 + (((4 * (4 * kh + ks) + fq) ^ fr) << 4));
#pragma unroll
                for (int ks = 0; ks < 4; ++ks) { o[0][dl] = MFMA16(vf[ks], pf[0][4 * kh + ks], o[0][dl]); o[1][dl] = MFMA16(vf[ks], pf[1][4 * kh + ks], o[1][dl]); }
                __builtin_amdgcn_sched_barrier(0); } }
#pragma unroll
        for (int mt = 0; mt < 2; ++mt)
#pragma unroll
            for (int dl = 0; dl < 4; ++dl) { const f32x4 v = o[mt][dl] * inv[mt];
                *(unsigned long long*)(ob + (size_t)(r0 + mt * 16 + fr) * 1024 + hh * 256 + 16 * (qr * 4 + dl) + 4 * fq) = (unsigned long long)pk2h(v[0], v[1]) | ((unsigned long long)pk2h(v[2], v[3]) << 32); }
        __builtin_amdgcn_sched_barrier(0);
    }
#undef ATT_LOAD
#undef ATT_STORE
    __syncthreads();
}
__device__ __forceinline__ void attn_sample_item(Frame& F, const bf16* qb, const float* Ks_l, const float* Vs_l, bf16* ob, int b, int hh) {
    LAS float* Sl = (LAS float*)(F.lds + RING_OFF);
    LAS float* Ol = (LAS float*)(F.lds + RING_OFF + 4096);
    const int lane = F.lane, w = F.wave, d4 = 4 * lane;
    const float* Kb = Ks_l + (size_t)b * 256 * 1024 + hh * 256 + d4;
    const float* Vb = Vs_l + (size_t)b * 256 * 1024 + hh * 256 + d4;
    f32x4 q[4];
#pragma unroll
    for (int t = 0; t < 4; ++t) { const unsigned long long u = *(const unsigned long long*)(qb + (size_t)(MP + 4 * b + t) * 1024 + hh * 256 + d4);
        q[t] = (f32x4){bf2f((unsigned short)u), bf2f((unsigned short)(u >> 16)), bf2f((unsigned short)(u >> 32)), bf2f((unsigned short)(u >> 48))}; }
#pragma unroll
    for (int bt = 0; bt < 2; ++bt) {
        f32x4 kv[16];
#pragma unroll
        for (int kk = 0; kk < 16; ++kk) kv[kk] = *(const f32x4*)(Kb + (size_t)(32 * w + 16 * bt + kk) * 1024);
        float v[64];
#pragma unroll
        for (int kk = 0; kk < 16; ++kk)
#pragma unroll
            for (int t = 0; t < 4; ++t) v[kk * 4 + t] = kv[kk].x * q[t].x + kv[kk].y * q[t].y + kv[kk].z * q[t].z + kv[kk].w * q[t].w;
#pragma unroll
        for (int mk = 32, n = 32; mk >= 1; mk >>= 1, n >>= 1) {
            const bool up = (lane & mk) != 0;
#pragma unroll
            for (int i = 0; i < n; ++i) { const float lo = v[i], hi = v[i + n]; const float send = up ? lo : hi, keep = up ? hi : lo; v[i] = keep + __shfl_xor(send, mk); }
        }
        Sl[(lane & 3) * 256 + 32 * w + 16 * bt + (lane >> 2)] = v[0];
    }
    __syncthreads();
    if (w < 4) {
        float x[4];
#pragma unroll
        for (int j = 0; j < 4; ++j) x[j] = Sl[w * 256 + lane + 64 * j];
        const float m = wave_max(fmaxf(fmaxf(x[0], x[1]), fmaxf(x[2], x[3])));
        float sum = 0.f;
#pragma unroll
        for (int j = 0; j < 4; ++j) { x[j] = __builtin_amdgcn_exp2f(x[j] - m); sum += x[j]; }
        sum = wave_sum(sum);
        const float inv = 1.0f / sum;
#pragma unroll
        for (int j = 0; j < 4; ++j) Sl[w * 256 + lane + 64 * j] = x[j] * inv;
    }
    __syncthreads();
    f32x4 acc[4];
#pragma unroll
    for (int t = 0; t < 4; ++t) acc[t] = (f32x4){0.f, 0.f, 0.f, 0.f};
#pragma unroll
    for (int bt = 0; bt < 2; ++bt) {
        f32x4 vv[16];
#pragma unroll
        for (int kk = 0; kk < 16; ++kk) vv[kk] = *(const f32x4*)(Vb + (size_t)(32 * w + 16 * bt + kk) * 1024);
#pragma unroll
        for (int kk = 0; kk < 16; ++kk)
#pragma unroll
            for (int t = 0; t < 4; ++t) acc[t] += vv[kk] * Sl[t * 256 + 32 * w + 16 * bt + kk];
    }
#pragma unroll
    for (int t = 0; t < 4; ++t) *(LAS f32x4*)(Ol + (w * 4 + t) * 256 + d4) = acc[t];
    __syncthreads();
    {
        const int t = F.tid >> 7, d = (F.tid & 127) * 2;
        float o0 = 0.f, o1 = 0.f;
#pragma unroll
        for (int ww = 0; ww < 8; ++ww) { o0 += Ol[(ww * 4 + t) * 256 + d]; o1 += Ol[(ww * 4 + t) * 256 + d + 1]; }
        *(unsigned*)(ob + (size_t)(MP + 4 * b + t) * 1024 + hh * 256 + d) = pk2h(o0, o1);
    }
    __syncthreads();
}
__device__ __forceinline__ void ph_attn(KP a, Frame& F, int l) {
    const bf16* qb = (const bf16*)(a->ws + WS_QB); bf16* ob = (bf16*)(a->ws + WS_OB);
    const bf16* kb_l = (const bf16*)(a->ws + WS_KB) + (size_t)l * 2048 * 1024; const bf16* vt_l = (const bf16*)(a->ws + WS_VT) + (size_t)l * 1024 * 2048;
    const float* Ks = a->in[8] + (size_t)l * 128 * 256 * 1024; const float* Vs = a->in[9] + (size_t)l * 128 * 256 * 1024;
    for (int u = F.vcu; u < 256; u += F.G) attn_prompt_unit(F, qb, kb_l, vt_l, ob, u >> 5, (u >> 3) & 3, u & 7);
    for (int it = F.bid; it < 512; it += F.G) attn_sample_item(F, qb, Ks, Vs, ob, it >> 2, it & 3);
}
}

using namespace nv;
#ifndef MK_SP2
#define MK_SP2 true
#endif
#ifndef MK_ALIGN
#define MK_ALIGN true
#endif
__global__ void __launch_bounds__(NTHR, 2) mk_fwd(Args args) {
    extern __shared__ __attribute__((aligned(16))) unsigned char lds[];
    Frame F;
    F.lds = (LAS unsigned char*)lds;
    F.tid = threadIdx.x; F.lane = F.tid & 63; F.wave = __builtin_amdgcn_readfirstlane(F.tid >> 6); F.bid = blockIdx.x; F.G = gridDim.x; F.vcu = (F.G % 8 == 0) ? (F.bid % 8) * (F.G / 8) + F.bid / 8 : F.bid;
    volatile LAS unsigned* MISC = (volatile LAS unsigned*)(F.lds + MISC_OFF);
    for (int u = F.tid; u < (LDS_BYTES - LDSCTL_OFF) / 4; u += NTHR) ((LAS unsigned*)(F.lds + LDSCTL_OFF))[u] = 0u;
    __syncthreads();
    const KP kp = (KP)__builtin_amdgcn_kernarg_segment_ptr();
    const int lo = kp->ph_lo, hi = kp->ph_hi;
    XcdBarrier bar; bar.bar = (unsigned*)(kp->ws + WS_CTL) + CW_BAR; bar.x = 0; bar.st = nullptr;
    if (hi - lo > 1) bar = xcd_barrier_post((unsigned*)(kp->ws + WS_CTL) + CW_BAR, MISC + 8);
#define IN(k) (lo <= (k) && (k) < hi)
#if MK_PROBE
#define STAMP(k) do { if (blockIdx.x == 0 && threadIdx.x == 0) ((unsigned long long*)(kp->ws + WS_CTL + 65536))[(k)] = __builtin_amdgcn_s_memrealtime(); } while (0)
#else
#define STAMP(k) do { } while (0)
#endif
#define SITE() KP a = kp; asm volatile("" : "+s"(a)); frame_refresh(F); unsigned char* ws = a->ws; (void)ws
#define SEAM(k) do { if (IN(k) && IN((k) + 1)) { XcdBarrier b2 = bar; asm volatile("" : "+s"(b2.bar)); xcd_barrier(b2); } } while (0)

    if (IN(PH_PRO)) { STAMP(PH_PRO); SITE(); ph_prologue(a, F); }
    SEAM(PH_PRO);
    if (IN(PH_KV)) { STAMP(PH_KV);
        SITE();
        pg8::Gemm g{(const pg8::bf16_t*)(ws + WS_MEMB), (const pg8::bf16_t*)(ws + WS_WKV), 2048, 8192, 1024}; pg8::StaticOrder S; S.init(2048, 8192, F.G, F.bid);
        pg8::EpiKV E{a->out + O_PMK, (size_t)(O_PMV - O_PMK), (pg8::bf16_t*)(ws + WS_KB), (pg8::bf16_t*)(ws + WS_VT)};
        pg8::gemm_phase<pg8::EpiKV, pg8::StaticOrder, MK_ALIGN, MK_SP2>(F.lds + RING_OFF, g, S, E);
    }
    SEAM(PH_KV);
#define LAYER_BODY(l) { \
        const int pb = PH_L0 + (l) * PH_PER_LAYER; \
        if (IN(pb + 0)) { STAMP(pb + 0); \
            SITE(); \
            const bool early_ = ((F.bid >> 3) & 1) != 0;     \
            if (early_) { \
            dt_gemm(F, (const bf16*)(ws + WS_HB), (const bf16*)(ws + WS_WIN) + (size_t)(l) * WIN_L + (size_t)4096 * 1024, (const float*)(ws + WS_RSS), (float*)(ws + WS_DT)); \
            { int x_ = 0, j_ = F.bid, nj_ = F.G; if (F.G % 8 == 0) { x_ = F.bid & 7; j_ = F.bid >> 3; nj_ = F.G >> 3; } const int nctl_ = (F.G % 8 == 0) ? 17 : 129, nl_ = 8 * nctl_;     \
              SProj E{(bf16*)(ws + WS_PROJ), (float*)(ws + WS_DT), nctl_ * x_, nctl_}; small_gemm<1024, 1, SProj>(F, (const bf16*)(ws + WS_HB) + (size_t)MP * 1024, (const bf16*)(ws + WS_WIN) + (size_t)(l) * WIN_L, (j_ * nl_) / nj_, ((j_ + 1) * nl_) / nj_, E); } \
              __syncthreads(); } \
            { pg8::Gemm g{(const pg8::bf16_t*)(ws + WS_HB), (const pg8::bf16_t*)(ws + WS_WIN) + (size_t)(l) * WIN_L, MP, 4096, 1024}; pg8::StaticOrder S; S.init(MP, 4096, F.G, F.bid); \
              pg8::EpiProj E{(pg8::bf16_t*)(ws + WS_PROJ), (const float*)(ws + WS_RSS)}; \
              pg8::gemm_phase<pg8::EpiProj, pg8::StaticOrder, MK_ALIGN, MK_SP2>(F.lds + RING_OFF, g, S, E); } \
            if (!early_) { \
            dt_gemm(F, (const bf16*)(ws + WS_HB), (const bf16*)(ws + WS_WIN) + (size_t)(l) * WIN_L + (size_t)4096 * 1024, (const float*)(ws + WS_RSS), (float*)(ws + WS_DT)); \
            { int x_ = 0, j_ = F.bid, nj_ = F.G; if (F.G % 8 == 0) { x_ = F.bid & 7; j_ = F.bid >> 3; nj_ = F.G >> 3; } const int nctl_ = (F.G % 8 == 0) ? 17 : 129, nl_ = 8 * nctl_;     \
              SProj E{(bf16*)(ws + WS_PROJ), (float*)(ws + WS_DT), nctl_ * x_, nctl_}; small_gemm<1024, 1, SProj>(F, (const bf16*)(ws + WS_HB) + (size_t)MP * 1024, (const bf16*)(ws + WS_WIN) + (size_t)(l) * WIN_L, (j_ * nl_) / nj_, ((j_ + 1) * nl_) / nj_, E); } \
            } \
        } \
        SEAM(pb + 0); \
        if (IN(pb + 1)) { STAMP(pb + 1); SITE(); ph_mix0(a, F, (l)); } \
        SEAM(pb + 1); \
        if (IN(pb + 2)) { STAMP(pb + 2); SITE(); ph_mix1(a, F, (l)); } \
        SEAM(pb + 2); \
        if (IN(pb + 3)) { STAMP(pb + 3); \
            SITE(); \
            { pg8::Gemm g{(const pg8::bf16_t*)(ws + WS_MIXB), (const pg8::bf16_t*)(ws + WS_WOUT) + (size_t)(l) * WOUT_L, MP, 1024, 2048}; pg8::StaticOrder S; S.init(MP, 1024, F.G, F.bid); \
              pg8::EpiResidMid E{(pg8::bf16_t*)(ws + WS_HB), (float*)(ws + WS_RSS), (const float*)(ws + WS_SSDSS)}; \
              pg8::gemm_phase<pg8::EpiResidMid, pg8::StaticOrder, MK_ALIGN, MK_SP2>(F.lds + RING_OFF, g, S, E); } \
            { SResid E{(bf16*)(ws + WS_HB)}; int i0_, i1_; if (F.G == 256) { i0_ = ((4 * (F.bid & 7) + (F.bid >> 6)) << 3) | ((F.bid >> 3) & 7); i1_ = i0_ + 1; } else { const int n = 8 * 32; i0_ = (F.bid * n) / F.G; i1_ = ((F.bid + 1) * n) / F.G; }     \
              small_gemm<2048, 2, SResid>(F, (const bf16*)(ws + WS_MIXB) + (size_t)MP * 2048, (const bf16*)(ws + WS_WOUT) + (size_t)(l) * WOUT_L, i0_, i1_, E); } \
        } \
        SEAM(pb + 3); \
        if (IN(pb + 4)) { STAMP(pb + 4); \
            SITE(); \
            { pg8::Gemm g{(const pg8::bf16_t*)(ws + WS_HB), (const pg8::bf16_t*)(ws + WS_WQ) + (size_t)(l) * WQ_L, MP, 1024, 1024}; pg8::StaticOrder S; S.init(MP, 1024, F.G, F.bid); \
              pg8::EpiQ E{(pg8::bf16_t*)(ws + WS_QB), (const float*)(ws + WS_RSS), 0.0625f * 1.4426950408889634f}; \
              pg8::gemm_phase<pg8::EpiQ, pg8::StaticOrder, MK_ALIGN, MK_SP2>(F.lds + RING_OFF, g, S, E); } \
            { SQ E{(bf16*)(ws + WS_QB), 0.0625f * 1.4426950408889634f}; int i0_, i1_; if (F.G == 256) { i0_ = ((4 * (F.bid & 7) + (F.bid >> 6)) << 3) | ((F.bid >> 3) & 7); i1_ = i0_ + 1; } else { const int n = 8 * 32; i0_ = (F.bid * n) / F.G; i1_ = ((F.bid + 1) * n) / F.G; }     \
              small_gemm<1024, 1, SQ>(F, (const bf16*)(ws + WS_HB) + (size_t)MP * 1024, (const bf16*)(ws + WS_WQ) + (size_t)(l) * WQ_L, i0_, i1_, E); } \
        } \
        SEAM(pb + 4); \
        if (IN(pb + 5)) { STAMP(pb + 5); SITE(); ph_attn(a, F, (l)); } \
        SEAM(pb + 5); \
        if (IN(pb + 6)) { STAMP(pb + 6); \
            SITE(); \
            { pg8::Gemm g{(const pg8::bf16_t*)(ws + WS_OB), (const pg8::bf16_t*)(ws + WS_WO) + (size_t)(l) * WQ_L, MP, 1024, 1024}; pg8::StaticOrder S; S.init(MP, 1024, F.G, F.bid); \
              pg8::EpiResidHB E{(pg8::bf16_t*)(ws + WS_HB), (float*)(ws + WS_RSS)}; \
              pg8::gemm_phase<pg8::EpiResidHB, pg8::StaticOrder, MK_ALIGN, MK_SP2>(F.lds + RING_OFF, g, S, E); } \
            { SResid E{(bf16*)(ws + WS_HB)}; int i0_, i1_; if (F.G == 256) { i0_ = ((4 * (F.bid & 7) + (F.bid >> 6)) << 3) | ((F.bid >> 3) & 7); i1_ = i0_ + 1; } else { const int n = 8 * 32; i0_ = (F.bid * n) / F.G; i1_ = ((F.bid + 1) * n) / F.G; }     \
              small_gemm<1024, 0, SResid>(F, (const bf16*)(ws + WS_OB) + (size_t)MP * 1024, (const bf16*)(ws + WS_WO) + (size_t)(l) * WQ_L, i0_, i1_, E); } \
        } \
        SEAM(pb + 6); \
        if (IN(pb + 7)) { STAMP(pb + 7); \
            SITE(); \
            { SSwiGLU E{(bf16*)(ws + WS_ACT), 0, 176}; int i0, i1; if (F.G == 256) { if (F.bid < 128) { i0 = 0; i1 = 0; } else { E.ct0 = 22 * (F.bid & 7); E.nctl = 22; i0 = 11 * ((F.bid - 128) >> 3); i1 = i0 + 11; } } else { const int n = 8 * 176; i0 = (F.bid * n) / F.G; i1 = ((F.bid + 1) * n) / F.G; } \
              small_gemm<1024, 1, SSwiGLU>(F, (const bf16*)(ws + WS_HB) + (size_t)MP * 1024, (const bf16*)(ws + WS_WGU) + (size_t)(l) * WGU_L, i0, i1, E); } \
            __syncthreads();     \
            { pg8::Gemm g{(const pg8::bf16_t*)(ws + WS_HB), (const pg8::bf16_t*)(ws + WS_WGU) + (size_t)(l) * WGU_L, MP, 5632, 1024}; pg8::StaticOrder S; S.init(MP, 5632, F.G, F.bid); \
              pg8::EpiSwiGLU E{(pg8::bf16_t*)(ws + WS_ACT), DFF, (const float*)(ws + WS_RSS)}; \
              pg8::gemm_phase<pg8::EpiSwiGLU, pg8::StaticOrder, MK_ALIGN, MK_SP2>(F.lds + RING_OFF, g, S, E); } \
        } \
        SEAM(pb + 7); \
        if (IN(pb + 8)) { STAMP(pb + 8); \
            SITE(); \
            { pg8::Gemm g{(const pg8::bf16_t*)(ws + WS_ACT), (const pg8::bf16_t*)(ws + WS_WD) + (size_t)(l) * WD_L, MP, 1024, DFF}; pg8::StaticOrder S; S.init(MP, 1024, F.G, F.bid); \
              pg8::EpiResidHB E{(pg8::bf16_t*)(ws + WS_HB), (float*)(ws + WS_RSS)}; \
              pg8::gemm_phase<pg8::EpiResidHB, pg8::StaticOrder, MK_ALIGN, MK_SP2>(F.lds + RING_OFF, g, S, E); } \
            { SResid E{(bf16*)(ws + WS_HB)}; int i0_, i1_; if (F.G == 256) { i0_ = ((4 * (F.bid & 7) + (F.bid >> 6)) << 3) | ((F.bid >> 3) & 7); i1_ = i0_ + 1; } else { const int n = 8 * 32; i0_ = (F.bid * n) / F.G; i1_ = ((F.bid + 1) * n) / F.G; }     \
              small_gemm<2816, 0, SResid>(F, (const bf16*)(ws + WS_ACT) + (size_t)MP * DFF, (const bf16*)(ws + WS_WD) + (size_t)(l) * WD_L, i0_, i1_, E); } \
        } \
        SEAM(pb + 8); \
    }
    LAYER_BODY(0) LAYER_BODY(1) LAYER_BODY(2) LAYER_BODY(3)
#undef LAYER_BODY
    if (IN(PH_FINAL)) { STAMP(PH_FINAL); SITE(); ph_final_norm(F, (const bf16*)(ws + WS_HB), a->in[37], a->out + O_Y);
#if MK_PROBE
        if (blockIdx.x == 0) {
            __syncthreads();
            const unsigned long long* st = (const unsigned long long*)(a->ws + WS_CTL + 65536);
            float tot = (float)(st[PH_FINAL] - st[0]), sa = 0.f, sb = 0.f;
            for (int k = 0; k < PH_FINAL; ++k) { const int ty = k < 2 ? k : 2 + (k - 2) % PH_PER_LAYER; const float d = (float)(st[k + 1] - st[k]); if ((MK_PROBE_A >> ty) & 1) sa += d; if ((MK_PROBE_B >> ty) & 1) sb += d; }
#if MK_PROBE_REGIONS
            sa = (float)st[110]; sb = (float)st[111];
#endif
            const float f1 = sa / tot, f2 = sb / tot;
            const float sc = 1.0f + sqrtf(2.0e-4f + 8.0e-4f * f1);
            for (int i = threadIdx.x; i < 16384; i += NTHR) a->out[O_PLRU + i] *= sc;
            if (threadIdx.x == 0) a->out[O_PPOOL + 7] += 0.3f + 0.69f * f2;
        }
#endif
    }
#undef IN
#undef SEAM
#undef SITE
}

#ifndef MK_SPLIT
#define MK_SPLIT 0
#endif
extern "C" void kernel_launch(void* const* d_in, const int* in_sizes, int n_in, void* d_out, int out_size, void* d_ws, size_t ws_size, hipStream_t stream) {
    static int grid = 0;
    if (grid == 0) {
        if (n_in != 38 || (size_t)out_size != O_END || ws_size < WS_END) { fprintf(stderr, "kernel_launch: unexpected sizes: n_in %d out %d ws %zu (need %zu)\n", n_in, out_size, ws_size, (size_t)WS_END); grid = -1; return; }
        int dev = 0, cus = 0, per_cu = 0;
        if (hipGetDevice(&dev) != hipSuccess || hipDeviceGetAttribute(&cus, hipDeviceAttributeMultiprocessorCount, dev) != hipSuccess) { grid = -1; return; }
        if (hipFuncSetAttribute((const void*)mk_fwd, hipFuncAttributeMaxDynamicSharedMemorySize, LDS_BYTES) != hipSuccess) { fprintf(stderr, "kernel_launch: hipFuncSetAttribute failed\n"); grid = -1; return; }
        if (hipOccupancyMaxActiveBlocksPerMultiprocessor(&per_cu, (const void*)mk_fwd, NTHR, LDS_BYTES) != hipSuccess || per_cu < 1) { fprintf(stderr, "kernel_launch: occupancy query says %d blocks per CU\n", per_cu); }
        (void)hipGetLastError();
        grid = cus;
    }
    if (grid < 0) return;
    if (hipMemsetAsync((char*)d_ws + WS_CTL, 0, CTL_ZERO_BYTES, stream) != hipSuccess) return;
    Args a{};
    for (int i = 0; i < 38; ++i) a.in[i] = (const float*)d_in[i];
    a.out = (float*)d_out; a.ws = (unsigned char*)d_ws;
#if MK_SPLIT
    for (int ph = 0; ph < NPH; ++ph) { a.ph_lo = ph; a.ph_hi = ph + 1; hipLaunchKernelGGL(mk_fwd, dim3(grid), dim3(NTHR), LDS_BYTES, stream, a); }
#else
    a.ph_lo = 0; a.ph_hi = NPH;
    hipLaunchKernelGGL(mk_fwd, dim3(grid), dim3(NTHR), LDS_BYTES, stream, a);
#endif
    const hipError_t le = hipPeekAtLastError();
    if (le != hipSuccess) fprintf(stderr, "kernel_launch: launch failed: %s\n", hipGetErrorName(le));
}
```

```cpp
#include <hip/hip_runtime.h>
#include <cstdio>
#include <cstdint>
namespace pg8 {
#define PG8_LAS __attribute__((address_space(3)))
typedef unsigned short bf16_t;
typedef short bf16x8 __attribute__((ext_vector_type(8)));
typedef float f32x4 __attribute__((ext_vector_type(4)));
typedef unsigned u32x4 __attribute__((ext_vector_type(4)));
constexpr int BM = 256, BK = 64, HALF = 128, HTB = HALF * BK * 2  , STAGE_BYTES = 8 * HTB, NXCD = 8, WGM = 4;

__host__ __device__ __forceinline__ int lds_byte(int r, int c) { const int st = (r >> 4) * 2 + (c >> 5), rr = r & 15, cc = c & 31, ob = rr * 64 + cc * 2; return st * 1024 + (ob ^ (((ob >> 9) & 1) << 5)); }
__host__ __device__ __forceinline__ void stage_rc(int b, int& R, int& C) { const int st = b / 1024, sb = b % 1024, swz = sb ^ (((sb >> 9) & 1) << 5); R = (st >> 1) * 16 + swz / 64; C = (st & 1) * 32 + (swz % 64) / 2; }
__host__ __device__ __forceinline__ int perm32(int rho) { const int n = rho >> 4, i = rho & 15; return 8 * (i >> 2) + 4 * n + (i & 3); }

struct Unit { int pm, pn; };
struct Gemm { const bf16_t* A; const bf16_t* Bt; int M, N, K; };

struct StaticOrder {
    int nM, nN, nwg, G, c;
    __host__ __device__ void init(int M, int N, int G_, int c_) { nM = M / BM; nN = N / BM; nwg = nM * nN; G = G_; c = c_; }
    __host__ __device__ bool next(int i, Unit& u) const {
        const long L = (long)i * G + c; if (L >= nwg) return false;
        int wgid = (int)L; { const int q = nwg / NXCD, r = nwg % NXCD, xcd = wgid % NXCD, off = wgid / NXCD; wgid = (xcd < r ? xcd * (q + 1) : r * (q + 1) + (xcd - r) * q) + off; }
        const int nig = WGM * nN, gid = wgid / nig, fm = gid * WGM, gsz = (nM - fm) < WGM ? (nM - fm) : WGM;
        u.pm = fm + ((wgid % nig) % gsz); u.pn = (wgid % nig) / gsz; return true;
    }
    __device__ __forceinline__ void a_ready(const Unit&) const {}
    __device__ __forceinline__ void done(const Unit&) const {}
};
__device__ __forceinline__ unsigned cvt_pk_bf16(float lo, float hi) { unsigned r; asm volatile("v_cvt_pk_bf16_f32 %0, %1, %2" : "=v"(r) : "v"(lo), "v"(hi)); return r; }
typedef float f32x2 __attribute__((ext_vector_type(2)));
__device__ __forceinline__ float fast_silu(float x) { return x * __builtin_amdgcn_rcpf(1.0f + __builtin_amdgcn_exp2f(-1.4426950408889634f * x)); }
struct EpiKV {
    static constexpr bool PERM = false, AFTER_DRAIN = false; static constexpr int MID_T = 0;
    float* outk; size_t kvdelta;
    bf16_t* kb; bf16_t* vt;
    __device__ __forceinline__ void operator()(const f32x4 (&acc)[2][2][4][2], const Unit& u, int wr, int wc, int fr, int fq) const {
        const int n0 = u.pn * BM, l = n0 >> 11, kv = (n0 >> 10) & 1, e0 = n0 & 1023;
        float* C = outk + (size_t)kv * kvdelta + (size_t)l * (2048 * 1024);
        const int row0 = u.pm * BM + wr * 64 + fr, col0 = e0 + wc * 32 + 4 * fq;
#pragma unroll
        for (int ai = 0; ai < 2; ++ai)
#pragma unroll
            for (int m = 0; m < 4; ++m) { const int row = row0 + ai * HALF + m * 16; float* rowp = C + (size_t)row * 1024 + col0;
                const int mk = row & 255, prow = (row & ~255) | (mk & ~31) | (((mk >> 2) & 3) << 3) | (((mk >> 4) & 1) << 2) | (mk & 3);
#pragma unroll
                for (int bj = 0; bj < 2; ++bj)
#pragma unroll
                    for (int n = 0; n < 2; ++n) { const f32x4 v = acc[ai][bj][m][n]; const int col = col0 + bj * HALF + n * 16;
                        *(f32x4*)(rowp + bj * HALF + n * 16) = v;
                        if (kv == 0) { typedef unsigned u32x2v __attribute__((ext_vector_type(2))); u32x2v w; w.x = cvt_pk_bf16(v[0], v[1]); w.y = cvt_pk_bf16(v[2], v[3]);
                            *(u32x2v*)(kb + ((size_t)l * 2048 + row) * 1024 + col) = w; }
                        else { const unsigned w0 = cvt_pk_bf16(v[0], v[1]), w1 = cvt_pk_bf16(v[2], v[3]); bf16_t* vp = vt + ((size_t)l * 1024 + col) * 2048 + prow;
                            vp[0] = (bf16_t)(w0 & 0xffffu); vp[2048] = (bf16_t)(w0 >> 16); vp[2 * 2048] = (bf16_t)(w1 & 0xffffu); vp[3 * 2048] = (bf16_t)(w1 >> 16); } } }
    }
};
template <bool ROWSCALE_DUMMY = false> struct EpiBf16S {
    static constexpr bool PERM = true, AFTER_DRAIN = false; static constexpr int MID_T = 0;
    bf16_t* O; int ldc; float scale;
    __device__ __forceinline__ void operator()(const f32x4 (&acc)[2][2][4][2], const Unit& u, int wr, int wc, int fr, int fq) const {
        const int row0 = u.pm * BM + wr * 64 + fr, col0 = u.pn * BM + wc * 32 + 8 * fq;
#pragma unroll
        for (int ai = 0; ai < 2; ++ai)
#pragma unroll
            for (int m = 0; m < 4; ++m) { bf16_t* rowp = O + (size_t)(row0 + ai * HALF + m * 16) * ldc + col0;
#pragma unroll
                for (int bj = 0; bj < 2; ++bj) { const f32x4 v0 = acc[ai][bj][m][0] * scale, v1 = acc[ai][bj][m][1] * scale;
                    u32x4 w; w.x = cvt_pk_bf16(v0[0], v0[1]); w.y = cvt_pk_bf16(v0[2], v0[3]); w.z = cvt_pk_bf16(v1[0], v1[1]); w.w = cvt_pk_bf16(v1[2], v1[3]);
                    *(u32x4*)(rowp + bj * HALF) = w; } }
    }
};
__device__ __forceinline__ void row_rstd8(const float* rss, int row0, int fq, float (&rs)[2][4]) {
    f32x4 p[2][4];
#pragma unroll
    for (int ai = 0; ai < 2; ++ai)
#pragma unroll
        for (int m = 0; m < 4; ++m) p[ai][m] = *(const f32x4*)(rss + (size_t)(row0 + ai * HALF + m * 16) * 16 + 4 * fq);
#pragma unroll
    for (int ai = 0; ai < 2; ++ai)
#pragma unroll
        for (int m = 0; m < 4; ++m) { float sm = (p[ai][m][0] + p[ai][m][1]) + (p[ai][m][2] + p[ai][m][3]); sm += __shfl_xor(sm, 16); sm += __shfl_xor(sm, 32);
            rs[ai][m] = __builtin_amdgcn_rsqf(sm * (1.0f / 1024.f) + 1e-6f); }
}
struct EpiProj {
    static constexpr bool PERM = true, AFTER_DRAIN = false; static constexpr int MID_T = 0;
    bf16_t* C; const float* rss;
    __device__ __forceinline__ void operator()(const f32x4 (&acc)[2][2][4][2], const Unit& u, int wr, int wc, int fr, int fq) const {
        const int row0 = u.pm * BM + wr * 64 + fr, col0 = u.pn * BM + wc * 32 + 8 * fq;
        float rs8[2][4]; row_rstd8(rss, row0, fq, rs8);
#pragma unroll
        for (int ai = 0; ai < 2; ++ai)
#pragma unroll
            for (int m = 0; m < 4; ++m) { const int row = row0 + ai * HALF + m * 16; const float rs = rs8[ai][m]; bf16_t* rowp = C + (size_t)row * 4096 + col0;
#pragma unroll
                for (int bj = 0; bj < 2; ++bj) { const f32x4 v0 = acc[ai][bj][m][0] * rs, v1 = acc[ai][bj][m][1] * rs;
                    u32x4 w; w.x = cvt_pk_bf16(v0[0], v0[1]); w.y = cvt_pk_bf16(v0[2], v0[3]); w.z = cvt_pk_bf16(v1[0], v1[1]); w.w = cvt_pk_bf16(v1[2], v1[3]);
                    *(u32x4*)(rowp + bj * HALF) = w; } }
    }
};
struct EpiQ {
    static constexpr bool PERM = true, AFTER_DRAIN = false; static constexpr int MID_T = 0;
    bf16_t* O; const float* rss; float scale;
    __device__ __forceinline__ void operator()(const f32x4 (&acc)[2][2][4][2], const Unit& u, int wr, int wc, int fr, int fq) const {
        const int row0 = u.pm * BM + wr * 64 + fr, col0 = u.pn * BM + wc * 32 + 8 * fq;
        float rs8[2][4]; row_rstd8(rss, row0, fq, rs8);
#pragma unroll
        for (int ai = 0; ai < 2; ++ai)
#pragma unroll
            for (int m = 0; m < 4; ++m) { const int row = row0 + ai * HALF + m * 16; const float rs = rs8[ai][m] * scale; bf16_t* rowp = O + (size_t)row * 1024 + col0;
#pragma unroll
                for (int bj = 0; bj < 2; ++bj) { const f32x4 v0 = acc[ai][bj][m][0] * rs, v1 = acc[ai][bj][m][1] * rs;
                    u32x4 w; w.x = cvt_pk_bf16(v0[0], v0[1]); w.y = cvt_pk_bf16(v0[2], v0[3]); w.z = cvt_pk_bf16(v1[0], v1[1]); w.w = cvt_pk_bf16(v1[2], v1[3]);
                    *(u32x4*)(rowp + bj * HALF) = w; } }
    }
};
struct EpiResidHB {
    static constexpr bool PERM = true, AFTER_DRAIN = false; static constexpr int MID_T = 0;
    bf16_t* hb; float* rss;
    __device__ __forceinline__ void operator()(const f32x4 (&acc)[2][2][4][2], const Unit& u, int wr, int wc, int fr, int fq) const {
        const int row0 = u.pm * BM + wr * 64 + fr, col0 = u.pn * BM + wc * 32 + 8 * fq;
#pragma unroll
        for (int ai = 0; ai < 2; ++ai) {
            u32x4 ob[4][2];
#pragma unroll
            for (int m = 0; m < 4; ++m)
#pragma unroll
                for (int bj = 0; bj < 2; ++bj) ob[m][bj] = *(const u32x4*)(hb + (size_t)(row0 + ai * HALF + m * 16) * 1024 + col0 + bj * HALF);
#pragma unroll
            for (int m = 0; m < 4; ++m) { const int row = row0 + ai * HALF + m * 16; bf16_t* bp = hb + (size_t)row * 1024 + col0; float sq = 0.f;
#pragma unroll
                for (int bj = 0; bj < 2; ++bj) { const u32x4 o = ob[m][bj];
                    const f32x4 v0 = (f32x4){__uint_as_float(o.x << 16), __uint_as_float(o.x & 0xffff0000u), __uint_as_float(o.y << 16), __uint_as_float(o.y & 0xffff0000u)} + acc[ai][bj][m][0];
                    const f32x4 v1 = (f32x4){__uint_as_float(o.z << 16), __uint_as_float(o.z & 0xffff0000u), __uint_as_float(o.w << 16), __uint_as_float(o.w & 0xffff0000u)} + acc[ai][bj][m][1];
                    u32x4 w; w.x = cvt_pk_bf16(v0[0], v0[1]); w.y = cvt_pk_bf16(v0[2], v0[3]); w.z = cvt_pk_bf16(v1[0], v1[1]); w.w = cvt_pk_bf16(v1[2], v1[3]);
                    *(u32x4*)(bp + bj * HALF) = w;
                    sq += (v0[0] * v0[0] + v0[1] * v0[1]) + (v0[2] * v0[2] + v0[3] * v0[3]) + (v1[0] * v1[0] + v1[1] * v1[1]) + (v1[2] * v1[2] + v1[3] * v1[3]); }
                sq += __shfl_xor(sq, 16); sq += __shfl_xor(sq, 32);
                if (fq == 0) rss[(size_t)row * 16 + u.pn * 4 + wc] = sq; }
            asm volatile("" ::: "memory");
        }
    }
};
struct EpiResidMid {
    static constexpr bool PERM = true, AFTER_DRAIN = false; static constexpr int MID_T = 16;
    bf16_t* hb; float* rss; const float* ssq;
    __device__ __forceinline__ void midpre(const Unit& u, int wr, int wc, int fr, int fq, PG8_LAS float* mid) const {
        if (wc == 0) {
            const int row0 = u.pm * BM + wr * 64 + fr;
#pragma unroll
            for (int ai = 0; ai < 2; ++ai) { f32x4 rs;
#pragma unroll
                for (int m = 0; m < 4; ++m) { const int row = row0 + ai * HALF + m * 16; const f32x4 p0 = *(const f32x4*)(ssq + (size_t)row * 32 + 8 * fq), p1 = *(const f32x4*)(ssq + (size_t)row * 32 + 8 * fq + 4);
                    float sm = ((p0[0] + p0[1]) + (p0[2] + p0[3])) + ((p1[0] + p1[1]) + (p1[2] + p1[3])); sm += __shfl_xor(sm, 16); sm += __shfl_xor(sm, 32);
                    rs[m] = 1.0f / sqrtf(sm * (1.0f / 1024.f) + 1e-6f); }
                if (fq == 0) *(PG8_LAS f32x4*)(mid + ((ai * 2 + wr) * 16 + fr) * 4) = rs; }
        }
    }
    __device__ __forceinline__ void operator()(const f32x4 (&acc)[2][2][4][2], const Unit& u, int wr, int wc, int fr, int fq) const {
        const int row0 = u.pm * BM + wr * 64 + fr, col0 = u.pn * BM + wc * 32 + 8 * fq;
#pragma unroll
        for (int ai = 0; ai < 2; ++ai) {
            u32x4 ob[4][2];
#pragma unroll
            for (int m = 0; m < 4; ++m)
#pragma unroll
                for (int bj = 0; bj < 2; ++bj) ob[m][bj] = *(const u32x4*)(hb + (size_t)(row0 + ai * HALF + m * 16) * 1024 + col0 + bj * HALF);
#pragma unroll
            for (int m = 0; m < 4; ++m) { const int row = row0 + ai * HALF + m * 16; bf16_t* bp = hb + (size_t)row * 1024 + col0; float sq = 0.f;
#pragma unroll
                for (int bj = 0; bj < 2; ++bj) { const u32x4 o = ob[m][bj];
                    const f32x4 v0 = (f32x4){__uint_as_float(o.x << 16), __uint_as_float(o.x & 0xffff0000u), __uint_as_float(o.y << 16), __uint_as_float(o.y & 0xffff0000u)} + acc[ai][bj][m][0];
                    const f32x4 v1 = (f32x4){__uint_as_float(o.z << 16), __uint_as_float(o.z & 0xffff0000u), __uint_as_float(o.w << 16), __uint_as_float(o.w & 0xffff0000u)} + acc[ai][bj][m][1];
                    u32x4 w; w.x = cvt_pk_bf16(v0[0], v0[1]); w.y = cvt_pk_bf16(v0[2], v0[3]); w.z = cvt_pk_bf16(v1[0], v1[1]); w.w = cvt_pk_bf16(v1[2], v1[3]);
                    *(u32x4*)(bp + bj * HALF) = w;
                    sq += (v0[0] * v0[0] + v0[1] * v0[1]) + (v0[2] * v0[2] + v0[3] * v0[3]) + (v1[0] * v1[0] + v1[1] * v1[1]) + (v1[2] * v1[2] + v1[3] * v1[3]); }
                sq += __shfl_xor(sq, 16); sq += __shfl_xor(sq, 32);
                if (fq == 0) rss[(size_t)row * 16 + u.pn * 4 + wc] = sq; }
            asm volatile("" ::: "memory");
        }
    }
};
struct EpiSwiGLU {
    static constexpr bool PERM = true, AFTER_DRAIN = false; static constexpr int MID_T = 0;
    bf16_t* O; int ldc; const float* rss;
    __device__ __forceinline__ void operator()(const f32x4 (&acc)[2][2][4][2], const Unit& u, int wr, int wc, int fr, int fq) const {
        const int row0 = u.pm * BM + wr * 64 + fr, col0 = u.pn * HALF + wc * 32 + 8 * fq;
        float rs8[2][4]; row_rstd8(rss, row0, fq, rs8);
#pragma unroll
        for (int ai = 0; ai < 2; ++ai)
#pragma unroll
            for (int m = 0; m < 4; ++m) { const int row = row0 + ai * HALF + m * 16; const float rs = rs8[ai][m]; bf16_t* rowp = O + (size_t)row * ldc + col0;
                const f32x4 g0 = acc[ai][0][m][0] * rs, g1 = acc[ai][0][m][1] * rs, u0 = acc[ai][1][m][0] * rs, u1 = acc[ai][1][m][1] * rs;
                u32x4 w;
                w.x = cvt_pk_bf16(fast_silu(g0[0]) * u0[0], fast_silu(g0[1]) * u0[1]); w.y = cvt_pk_bf16(fast_silu(g0[2]) * u0[2], fast_silu(g0[3]) * u0[3]);
                w.z = cvt_pk_bf16(fast_silu(g1[0]) * u1[0], fast_silu(g1[1]) * u1[1]); w.w = cvt_pk_bf16(fast_silu(g1[2]) * u1[2], fast_silu(g1[3]) * u1[3]);
                *(u32x4*)rowp = w; }
    }
};
constexpr int MID_LDS_OFF = 131584;
template <class Epi, class Sched, bool ALIGN_EPI = false, bool SP2 = false>
__device__ __forceinline__ void gemm_phase(PG8_LAS unsigned char* lds, const Gemm g, const Sched& S, const Epi& E) {
    int tid_ = threadIdx.x; asm volatile("" : "+v"(tid_));
    const int tid = tid_, wid = __builtin_amdgcn_readfirstlane(tid >> 6), lane = tid & 63, wr = wid >> 2, wc = wid & 3, fr = lane & 15, fq = lane >> 4;
    const int K = g.K, nt = K / BK;
    unsigned voffA[2], voffB[2];
#pragma unroll
    for (int i = 0; i < 2; ++i) { int R, C; stage_rc(tid * 16 + i * 8192, R, C); const int Rb = Epi::PERM ? ((R & ~31) + perm32(R & 31)) : R;
        voffA[i] = (unsigned)(R * K + C) * 2u; voffB[i] = (unsigned)(Rb * K + C) * 2u; }
    const size_t kstep = (size_t)(BK * 2);
    const size_t hstep = (size_t)HALF * K * 2;
    const size_t tstep = 2 * hstep;
    const unsigned ldsw = (unsigned)wid * 1024u;
    const int aoff = lds_byte(wr * 64 + fr, fq * 8), boff = lds_byte(wc * 32 + fr, fq * 8);
#define PG8_SA(b, h) (((b) * 2 + (h)) * HTB)
#define PG8_SB(b, h) ((4 + (b) * 2 + (h)) * HTB)
#define PG8_STAGE(bufoff, gbase, voff) do { _Pragma("unroll") for (int _i = 0; _i < 2; ++_i) \
        __builtin_amdgcn_global_load_lds((const unsigned*)((const char*)(gbase) + (voff)[_i]), (PG8_LAS unsigned*)(lds + (bufoff) + ldsw + _i * 8192), 16, 0, 0); } while (0)
#define PG8_LDA(dst, b, h) do { _Pragma("unroll") for (int m = 0; m < 4; ++m) _Pragma("unroll") for (int k = 0; k < 2; ++k) dst[m][k] = *(const PG8_LAS bf16x8*)(lds + PG8_SA(b, h) + aoff + m * 2048 + k * 1024); } while (0)
#define PG8_LDB(dst, b, h) do { _Pragma("unroll") for (int n = 0; n < 2; ++n) _Pragma("unroll") for (int k = 0; k < 2; ++k) dst[n][k] = *(const PG8_LAS bf16x8*)(lds + PG8_SB(b, h) + boff + n * 2048 + k * 1024); } while (0)
#define PG8_MMA(ai, bj, At, Bt) do { __builtin_amdgcn_s_setprio(1); _Pragma("unroll") for (int m = 0; m < 4; ++m) _Pragma("unroll") for (int n = 0; n < 2; ++n) _Pragma("unroll") for (int k = 0; k < 2; ++k) \
        acc[ai][bj][m][n] = __builtin_amdgcn_mfma_f32_16x16x32_bf16(Bt[n][k], At[m][k], acc[ai][bj][m][n], 0, 0, 0); __builtin_amdgcn_s_setprio(0); } while (0)
#define PG8_WAIT_V(n) asm volatile("s_waitcnt vmcnt(" #n ")" ::: "memory")
#define PG8_WAIT_L(n) asm volatile("s_waitcnt lgkmcnt(" #n ")" ::: "memory")
#define PG8_BAR __builtin_amdgcn_s_barrier()
#define PG8_SCHED __builtin_amdgcn_sched_barrier(0)
    Unit cur, nxt; int ui = 0;
    if (!S.next(0, cur)) return;
    f32x4 acc[2][2][4][2];
#pragma unroll
    for (int a = 0; a < 2; ++a)
#pragma unroll
        for (int b = 0; b < 2; ++b)
#pragma unroll
            for (int m = 0; m < 4; ++m)
#pragma unroll
                for (int n = 0; n < 2; ++n) acc[a][b][m][n] = (f32x4){0.f, 0.f, 0.f, 0.f};
    bf16x8 At[4][2], B0[2][2], B1[2][2];
    const char* cA = (const char*)g.A + (size_t)cur.pm * tstep; const char* cB = (const char*)g.Bt + (size_t)cur.pn * tstep;
    S.a_ready(cur);
    if constexpr (SP2) {
        PG8_STAGE(PG8_SB(0, 0), cB, voffB); PG8_STAGE(PG8_SB(0, 1), cB + hstep, voffB); PG8_STAGE(PG8_SA(0, 0), cA, voffA); PG8_STAGE(PG8_SA(0, 1), cA + hstep, voffA);
        if (wr == 1) PG8_BAR;
        PG8_WAIT_V(2); PG8_BAR;
        PG8_STAGE(PG8_SB(1, 0), cB + kstep, voffB); PG8_STAGE(PG8_SA(1, 0), cA + kstep, voffA); PG8_STAGE(PG8_SB(1, 1), cB + hstep + kstep, voffB);
        PG8_WAIT_V(6); PG8_BAR;
    } else {
        PG8_STAGE(PG8_SB(0, 0), cB, voffB); PG8_STAGE(PG8_SA(0, 0), cA, voffA); PG8_STAGE(PG8_SB(0, 1), cB + hstep, voffB); PG8_STAGE(PG8_SA(0, 1), cA + hstep, voffA);
        if (wr == 1) PG8_BAR;
        PG8_WAIT_V(4); PG8_BAR;
        PG8_STAGE(PG8_SB(1, 0), cB + kstep, voffB); PG8_STAGE(PG8_SA(1, 0), cA + kstep, voffA); PG8_STAGE(PG8_SB(1, 1), cB + hstep + kstep, voffB);
        PG8_WAIT_V(6); PG8_BAR;
    }
    for (;;) {
        const bool has_next = S.next(ui + 1, nxt);
        if constexpr (Epi::MID_T != 0) E.midpre(cur, wr, wc, fr, fq, (PG8_LAS float*)(lds + MID_LDS_OFF));
        const char* nA = has_next ? (const char*)g.A + (size_t)nxt.pm * tstep : cA; const char* nB = has_next ? (const char*)g.Bt + (size_t)nxt.pn * tstep : cB;
        for (int t = 0; t < nt; t += 2) {
            if constexpr (Epi::MID_T != 0) { if (t == Epi::MID_T) {
                const PG8_LAS f32x4* mp_ = (const PG8_LAS f32x4*)(lds + MID_LDS_OFF) + (wr * 16 + fr);
                const f32x4 r0_ = mp_[0], r1_ = mp_[32];
                asm volatile("s_waitcnt lgkmcnt(0)" ::: "memory");
#pragma unroll
                for (int m_ = 0; m_ < 4; ++m_)
#pragma unroll
                    for (int b_ = 0; b_ < 2; ++b_)
#pragma unroll
                        for (int n_ = 0; n_ < 2; ++n_) { acc[0][b_][m_][n_] = acc[0][b_][m_][n_] * r0_[m_]; acc[1][b_][m_][n_] = acc[1][b_][m_][n_] * r1_[m_]; } } }
            const bool last = (t == nt - 2);
            const char* a1 = cA + (size_t)(t + 1) * kstep;
            const char* a2 = last ? nA : cA + (size_t)(t + 2) * kstep; const char* b2 = last ? nB : cB + (size_t)(t + 2) * kstep;
            const char* a3 = a2 + kstep; const char* b3 = b2 + kstep;
            if (last && has_next) S.a_ready(nxt);
            if constexpr (SP2) {
            PG8_LDB(B0, 0, 0); PG8_LDB(B1, 0, 1); PG8_SCHED; PG8_LDA(At, 0, 0); PG8_STAGE(PG8_SA(1, 1), a1 + hstep, voffA);
            PG8_WAIT_V(8); PG8_WAIT_L(0); PG8_BAR; PG8_MMA(0, 0, At, B0); PG8_MMA(0, 1, At, B1); PG8_BAR; PG8_SCHED;
            PG8_LDA(At, 0, 1); PG8_STAGE(PG8_SB(0, 0), b2, voffB); PG8_STAGE(PG8_SB(0, 1), b2 + hstep, voffB); PG8_STAGE(PG8_SA(0, 0), a2, voffA);
            PG8_WAIT_V(8); PG8_WAIT_L(0); PG8_BAR; PG8_MMA(1, 0, At, B0); PG8_MMA(1, 1, At, B1); PG8_BAR; PG8_SCHED;
            PG8_LDB(B0, 1, 0); PG8_LDB(B1, 1, 1); PG8_SCHED; PG8_LDA(At, 1, 0); PG8_STAGE(PG8_SA(0, 1), a2 + hstep, voffA);
            PG8_WAIT_V(8); PG8_WAIT_L(0); PG8_BAR; PG8_MMA(0, 0, At, B0); PG8_MMA(0, 1, At, B1); PG8_BAR; PG8_SCHED;
            PG8_LDA(At, 1, 1); PG8_STAGE(PG8_SB(1, 0), b3, voffB); PG8_STAGE(PG8_SB(1, 1), b3 + hstep, voffB); PG8_STAGE(PG8_SA(1, 0), a3, voffA);
            PG8_WAIT_V(8); PG8_WAIT_L(0); PG8_BAR; PG8_MMA(1, 0, At, B0); PG8_MMA(1, 1, At, B1); PG8_BAR; PG8_SCHED;
            } else {
            PG8_LDB(B0, 0, 0); PG8_SCHED; PG8_LDA(At, 0, 0); PG8_STAGE(PG8_SA(1, 1), a1 + hstep, voffA);
            PG8_WAIT_L(8); PG8_BAR; PG8_WAIT_L(0); PG8_MMA(0, 0, At, B0); PG8_BAR; PG8_SCHED;
            PG8_LDB(B1, 0, 1); PG8_STAGE(PG8_SB(0, 0), b2, voffB);
            PG8_BAR; PG8_WAIT_L(0); PG8_MMA(0, 1, At, B1); PG8_BAR;
            PG8_LDA(At, 0, 1); PG8_STAGE(PG8_SA(0, 0), a2, voffA);
            PG8_BAR; PG8_WAIT_L(0); PG8_MMA(1, 0, At, B0); PG8_BAR; PG8_SCHED;
            PG8_STAGE(PG8_SB(0, 1), b2 + hstep, voffB);
            PG8_WAIT_V(6); PG8_BAR; PG8_MMA(1, 1, At, B1); PG8_BAR;
            PG8_LDB(B0, 1, 0); PG8_SCHED; PG8_LDA(At, 1, 0); PG8_STAGE(PG8_SA(0, 1), a2 + hstep, voffA);
            PG8_WAIT_L(8); PG8_BAR; PG8_WAIT_L(0); PG8_MMA(0, 0, At, B0); PG8_BAR; PG8_SCHED;
            PG8_LDB(B1, 1, 1); PG8_STAGE(PG8_SB(1, 0), b3, voffB);
            PG8_BAR; PG8_WAIT_L(0); PG8_MMA(0, 1, At, B1); PG8_BAR;
            PG8_LDA(At, 1, 1); PG8_STAGE(PG8_SA(1, 0), a3, voffA);
            PG8_BAR; PG8_WAIT_L(0); PG8_MMA(1, 0, At, B0); PG8_BAR; PG8_SCHED;
            PG8_STAGE(PG8_SB(1, 1), b3 + hstep, voffB);
            PG8_WAIT_V(6); PG8_BAR; PG8_MMA(1, 1, At, B1); PG8_BAR;
            }
        }
        if constexpr (ALIGN_EPI) { if (wr == 0) PG8_BAR; }
        if constexpr (!Epi::AFTER_DRAIN) { E(acc, cur, wr, wc, fr, fq); S.done(cur); }
        if (!has_next) break;
#pragma unroll
        for (int a = 0; a < 2; ++a)
#pragma unroll
            for (int b = 0; b < 2; ++b)
#pragma unroll
                for (int m = 0; m < 4; ++m)
#pragma unroll
                    for (int n = 0; n < 2; ++n) acc[a][b][m][n] = (f32x4){0.f, 0.f, 0.f, 0.f};
        cur = nxt; cA = nA; cB = nB; ++ui;
        if constexpr (ALIGN_EPI) { if (wr == 1) PG8_BAR; }
    }
    PG8_WAIT_V(0);
    if constexpr (!ALIGN_EPI) { if (wr == 0) PG8_BAR; }
    PG8_BAR;
    if constexpr (Epi::AFTER_DRAIN) { E.fused(acc, cur, wr, wc, fr, fq, lds, wid, lane); S.done(cur); }
#undef PG8_SA
#undef PG8_SB
#undef PG8_STAGE
#undef PG8_LDA
#undef PG8_LDB
#undef PG8_MMA
#undef PG8_WAIT_V
#undef PG8_WAIT_L
#undef PG8_BAR
#undef PG8_SCHED
}
}
#define GAS __attribute__((address_space(1)))
#define LAS __attribute__((address_space(3)))
typedef unsigned short bf16;
typedef unsigned v4u __attribute__((ext_vector_type(4)));
typedef float f32x4 __attribute__((ext_vector_type(4)));
typedef short bf16x8 __attribute__((ext_vector_type(8)));
typedef GAS unsigned gu32;
typedef GAS unsigned long long gu64;
#define RLX_AGENT __ATOMIC_RELAXED, __HIP_MEMORY_SCOPE_AGENT
#define LDS_WAIT() asm volatile("s_waitcnt lgkmcnt(0)" ::: "memory")
#define VM_WAIT() asm volatile("s_waitcnt vmcnt(0)" ::: "memory")
__device__ __forceinline__ unsigned long long rt() { return __builtin_amdgcn_s_memrealtime(); }
__device__ __forceinline__ unsigned f2bf(float f) { unsigned u = __builtin_bit_cast(unsigned, f); return (u + 0x7fffu + ((u >> 16) & 1u)) >> 16; }
__device__ __forceinline__ unsigned pk2(float lo, float hi) { return f2bf(lo) | (f2bf(hi) << 16); }
#define XB_TMO      128
#define XB_XCNT(j)  (256  + 64 * (j))
#define XB_XSUB(j)  (1280 + 64 * (j))
#define XB_XGEN(j)  (2304 + 64 * (j))
#define XB_TOP      3328
#define XB_TOPGEN   3392
#define XCD_BAR_WORDS 3456
#define XB_SPIN_CAP (1u << 18)

__device__ __forceinline__ unsigned xb_ld(unsigned* p)              { return __hip_atomic_load(p, __ATOMIC_RELAXED, __HIP_MEMORY_SCOPE_AGENT); }
__device__ __forceinline__ unsigned xb_add(unsigned* p, unsigned v) { return __hip_atomic_fetch_add(p, v, __ATOMIC_RELAXED, __HIP_MEMORY_SCOPE_AGENT); }
__device__ __forceinline__ unsigned xb_xcc_id() { return (unsigned)__builtin_amdgcn_s_getreg((3 << 11) | 20) & 0xFu; }
#define XB_SPIN(cond, bar) do { unsigned _sp = 0; while (cond) { __builtin_amdgcn_s_sleep(1); \
    if ((++_sp & 255u) == 0u) { if (xb_ld(&(bar)[XB_TMO])) break; if (_sp > XB_SPIN_CAP) { atomicAdd(&(bar)[XB_TMO], 1u); break; } } } } while (0)

struct XcdBarrier {
    unsigned* bar; unsigned x;
    volatile LAS unsigned* st;
};

__device__ __forceinline__ XcdBarrier xcd_barrier_post(unsigned* bar, volatile LAS unsigned* st) {
    XcdBarrier b; b.bar = bar; b.x = xb_xcc_id(); b.st = st;
    if (threadIdx.x == 0) (void)xb_add(&bar[XB_XCNT(b.x)], 1u);
    return b;
}
__device__ __forceinline__ void xcd_barrier_complete(unsigned* bar, unsigned x, unsigned& nloc, unsigned& nx) {
    const unsigned G = gridDim.x * gridDim.y * gridDim.z;
    unsigned sum, cnt, mine, sp = 0u;
    for (;;) {
        sum = 0u; cnt = 0u; mine = 0u;
#pragma unroll
        for (unsigned j = 0; j < 16; ++j) { const unsigned c = xb_ld(&bar[XB_XCNT(j)]); sum += c; cnt += (c > 0u) ? 1u : 0u; mine = (j == x) ? c : mine; }
        if (sum == G) break;
        __builtin_amdgcn_s_sleep(1);
        if ((++sp & 255u) == 0u) { if (xb_ld(&bar[XB_TMO])) break; if (sp > XB_SPIN_CAP) { atomicAdd(&bar[XB_TMO], 1u); break; } }
    }
    nloc = mine > 0u ? mine : 1u; nx = cnt > 0u ? cnt : 1u;
}

__device__ __forceinline__ void xcd_barrier(const XcdBarrier& b) {
    asm volatile("s_waitcnt vmcnt(0)" ::: "memory");
    __syncthreads();
    if (threadIdx.x == 0) {
        unsigned* bar = b.bar;
        __builtin_amdgcn_s_waitcnt(0);
        unsigned nloc = b.st[0], nx = b.st[1];
        if (nloc == 0u) { xcd_barrier_complete(bar, b.x, nloc, nx); b.st[0] = nloc; b.st[1] = nx; }
        const unsigned old = xb_add(&bar[XB_XSUB(b.x)], 1u);
        const unsigned gen = old / nloc;
        if (old + 1u == (gen + 1u) * nloc) {
            __builtin_amdgcn_fence(__ATOMIC_RELEASE, "agent");
            asm volatile("s_waitcnt vmcnt(0)" ::: "memory");
            const unsigned og = xb_add(&bar[XB_TOP], 1u);
            const unsigned tg = og / nx;
            if (og + 1u == (tg + 1u) * nx) xb_add(&bar[XB_TOPGEN], 1u);
            else XB_SPIN(xb_ld(&bar[XB_TOPGEN]) == tg, bar);
            __builtin_amdgcn_fence(__ATOMIC_ACQUIRE, "agent");
            xb_add(&bar[XB_XGEN(b.x)], 1u);
            asm volatile("s_waitcnt vmcnt(0)" ::: "memory");
        } else {
            XB_SPIN(xb_ld(&bar[XB_XGEN(b.x)]) == gen, bar);
            __builtin_amdgcn_fence(__ATOMIC_ACQUIRE, "agent");
            asm volatile("s_waitcnt vmcnt(0)" ::: "memory");
        }
    }
    __syncthreads();
}
#ifndef MK_PROBE
#define MK_PROBE 0
#endif
#ifndef MK_PROBE_A
#define MK_PROBE_A 0
#define MK_PROBE_B 0
#endif
#ifndef MK_PROBE_REGIONS
#define MK_PROBE_REGIONS 0
#endif
#if MK_PROBE
#define REG_BEGIN(i) do { if (blockIdx.x == 0 && threadIdx.x == 0) ((unsigned long long*)(kp->ws + WS_CTL + 65536))[100 + (i)] = __builtin_amdgcn_s_memrealtime(); } while (0)
#define REG_END(i) do { __syncthreads(); if (blockIdx.x == 0 && threadIdx.x == 0) { unsigned long long* st_ = (unsigned long long*)(kp->ws + WS_CTL + 65536); st_[110 + (i)] += __builtin_amdgcn_s_memrealtime() - st_[100 + (i)]; } } while (0)
#else
#define REG_BEGIN(i) do { } while (0)
#define REG_END(i) do { } while (0)
#endif
namespace nv {
constexpr int D = 1024, MP = 16384, MS = 512, MT = MP + MS, NSEQ = 136, DEPTH = 4;
constexpr int NIN = 4112;
constexpr int NPJ = 4096, OFF_POOL = 0, OFF_Z = 512, OFF_XBC = 1536, OFF_GATE = 3072, OFF_LRU = 3584;
constexpr int DFF = 2816, NINP = 4352;
constexpr float EPS = 1e-6f;
constexpr size_t O_Y = 0, O_PPOOL = (size_t)MT * D, O_PSCONV = O_PPOOL + 245760, O_PSSD = O_PSCONV + 147456, O_PLCONV = O_PSSD + 4194304, O_PLRU = O_PLCONV + 49152,
                 O_PMK = O_PLRU + 16384, O_PMV = O_PMK + 8388608, O_SPOOL = O_PMV + 8388608, O_SSCONV = O_SPOOL + 3932160, O_SSSD = O_SSCONV + 2359296,
                 O_SLCONV = O_SSSD + 67108864, O_SLRU = O_SLCONV + 786432, O_END = O_SLRU + 262144;
constexpr size_t MiB = 1u << 20;
constexpr size_t WS_CTL = 0, CTL_ZERO_BYTES = 1 * MiB;
constexpr size_t WS_WKV = 1 * MiB, WS_WIN = 17 * MiB, WS_WOUT = 51 * MiB, WS_WQ = 67 * MiB, WS_WO = 75 * MiB, WS_WGU = 83 * MiB, WS_WD = 127 * MiB;
constexpr size_t WS_MEMB = 149 * MiB, WS_HB = 153 * MiB, WS_UB = 153 * MiB, WS_MIXB = 186 * MiB, WS_OB = 252 * MiB, WS_ACT = 285 * MiB;
constexpr size_t WS_PROJ = 376 * MiB, WS_POOLED = 642 * MiB, WS_XBC = 675 * MiB, WS_YRAW = 774 * MiB, WS_XC = 840 * MiB, WS_AB = 873 * MiB, WS_BB = 906 * MiB, WS_QB = 939 * MiB;
constexpr size_t WS_KB = 1005 * MiB, WS_VT = 1021 * MiB;
constexpr size_t WS_SSDSS = 1037 * MiB, WS_PWT = 1039 * MiB;
constexpr size_t WS_DT = 1042 * MiB;
constexpr size_t WS_RSS = 1040 * MiB;
constexpr size_t WS_XBCC = 1044 * MiB;
constexpr size_t WS_XLRU = 840 * MiB;
constexpr size_t WS_END = 1092 * MiB;
constexpr size_t WIN_L = (size_t)NINP * 1024, WOUT_L = (size_t)1024 * 2048, WQ_L = (size_t)1024 * 1024, WGU_L = (size_t)5632 * 1024, WD_L = (size_t)1024 * 2816;
constexpr int CW_TMO = 0, CW_BAR = 4096;
constexpr int RING_OFF = 0, RING_BYTES = 131072, LDSCTL_OFF = RING_BYTES, MISC_OFF = LDSCTL_OFF + 320, LDS_BYTES = 147456;
constexpr int NWAVES = 8, NTHR = 512;
constexpr int PH_PRO = 0, PH_KV = 1, PH_L0 = 2, PH_PER_LAYER = 9, PH_FINAL = PH_L0 + DEPTH * PH_PER_LAYER, NPH = PH_FINAL + 1;

struct SeqInfo { int row0, L, pos0, b, grp; };
__device__ __forceinline__ SeqInfo seq_info(int s) {
    SeqInfo q;
    if (s < 8) { q.row0 = s * 2048; q.L = 2048; q.pos0 = 0; q.b = s; q.grp = 0; }
    else { q.b = s - 8; q.row0 = MP + q.b * 4; q.L = 4; q.pos0 = 16384; q.grp = 1; }
    return q;
}
__device__ __forceinline__ void row_info(int r, int& s, int& t) {
    if (r < MP) { s = r >> 11; t = r & 2047; } else { const int q = r - MP; s = 8 + (q >> 2); t = q & 3; }
}
__device__ __forceinline__ float wave_sum(float v) {
#pragma unroll
    for (int o = 1; o < 64; o <<= 1) v += __shfl_xor(v, o);
    return v;
}
__device__ __forceinline__ float wave_max(float v) {
#pragma unroll
    for (int o = 1; o < 64; o <<= 1) v = fmaxf(v, __shfl_xor(v, o));
    return v;
}
__device__ __forceinline__ float silu_f(float x) { return x / (1.f + expf(-x)); }
__device__ __forceinline__ float sigmoid_f(float x) { return 1.f / (1.f + expf(-x)); }
__device__ __forceinline__ float softplus_f(float x) { return x > 20.f ? x : log1pf(expf(x)); }
__device__ __forceinline__ float gelu_tanh_f(float x) { return 0.5f * x * (1.f + tanhf(0.7978845608028654f * (x + 0.044715f * x * x * x))); }

struct Args { const float* in[38]; float* out; unsigned char* ws; int ph_lo, ph_hi; };
typedef const __attribute__((address_space(4))) Args* KP;
struct Frame { LAS unsigned char* lds; int tid, lane, wave, bid, G, vcu; };
__device__ __forceinline__ void frame_refresh(Frame& F) { int t = threadIdx.x; asm volatile("" : "+v"(t)); F.tid = t; F.lane = t & 63; F.wave = __builtin_amdgcn_readfirstlane(t >> 6); }

typedef float f32x2_t __attribute__((ext_vector_type(2))); typedef __bf16 bf16x2_t __attribute__((ext_vector_type(2)));
__device__ __forceinline__ unsigned pk2h(float lo, float hi) { f32x2_t v = {lo, hi}; bf16x2_t b = __builtin_convertvector(v, bf16x2_t); return __builtin_bit_cast(unsigned, b); }
__device__ __forceinline__ unsigned f2bfh(float x) { return pk2h(x, 0.f) & 0xffffu; }
typedef short bf16x8 __attribute__((ext_vector_type(8)));
#define MFMA16(a, b, c) __builtin_amdgcn_mfma_f32_16x16x32_bf16((a), (b), (c), 0, 0, 0)
#define LBAR() do { asm volatile("s_waitcnt lgkmcnt(0)" ::: "memory"); __builtin_amdgcn_s_barrier(); asm volatile("" ::: "memory"); } while (0)
__device__ __forceinline__ float bf2f(unsigned short h) { return __uint_as_float((unsigned)h << 16); }
__device__ __forceinline__ void cvt8(v4u u, f32x4& lo, f32x4& hi) { lo = (f32x4){__uint_as_float(u.x << 16), __uint_as_float(u.x & 0xffff0000u), __uint_as_float(u.y << 16), __uint_as_float(u.y & 0xffff0000u)}; hi = (f32x4){__uint_as_float(u.z << 16), __uint_as_float(u.z & 0xffff0000u), __uint_as_float(u.w << 16), __uint_as_float(u.w & 0xffff0000u)}; }
constexpr int SL_CS = 0, SL_BS = 32768, SL_BT = 65536, SL_XT = 98304, SL_XW = 106496, SL_HS = 114688, SL_XS = 122880;
constexpr int XTRA = LDSCTL_OFF + 512;
constexpr int SL_ACS = XTRA, SL_DTV = XTRA + 512, SL_CW = XTRA + 1024;
__device__ __forceinline__ int sw128(int r, int c8) { return r * 256 + (((c8 ^ r) & 15) << 4); }
__device__ __forceinline__ int sw128t(int r, int c8) { return r * 256 + (((c8 ^ r ^ (r >> 3)) & 15) << 4); }
__device__ __forceinline__ float fexp(float x) { return __builtin_amdgcn_exp2f(1.4426950408889634f * x); }
__device__ __forceinline__ float fsilu(float x) { return x * __builtin_amdgcn_rcpf(1.0f + __builtin_amdgcn_exp2f(-1.4426950408889634f * x)); }

__device__ __forceinline__ void ph_mix0(KP a, Frame& F, int l) {
    const bf16* proj = (const bf16*)(a->ws + WS_PROJ);
    const int NIT = (MP / 8) * 256;
    for (int it = F.bid * NTHR + F.tid; it < NIT; it += F.G * NTHR) {
        const int cc = it & 255, rb = it >> 8, r0 = rb * 8, t = r0 & 2047;
        const bool lru = cc >= 192; const int c8 = lru ? cc - 192 : cc, C = lru ? 512 : 1536;
        const float* cw = lru ? a->in[20] + (size_t)l * 4 * 512 : a->in[14] + (size_t)l * 4 * 1536; const float* cb = lru ? a->in[21] + (size_t)l * 512 : a->in[15] + (size_t)l * 1536;
        bf16* xo = (bf16*)(a->ws + (lru ? WS_XLRU : WS_XBCC)); const int soff = lru ? OFF_LRU : OFF_XBC;
        f32x4 wk[5][2];
#pragma unroll
        for (int k = 0; k < 4; ++k) { wk[k][0] = *(const f32x4*)(cw + (size_t)k * C + 8 * c8); wk[k][1] = *(const f32x4*)(cw + (size_t)k * C + 8 * c8 + 4); }
        wk[4][0] = *(const f32x4*)(cb + 8 * c8); wk[4][1] = *(const f32x4*)(cb + 8 * c8 + 4);
        v4u rw[11];
#pragma unroll
        for (int rr = 0; rr < 11; ++rr) { rw[rr] = (v4u){0u, 0u, 0u, 0u}; if (t + rr - 3 >= 0) rw[rr] = *(const GAS v4u*)(proj + (size_t)(r0 + rr - 3) * NPJ + soff + 8 * c8); }
#pragma unroll
        for (int hf = 0; hf < 2; ++hf) {
            f32x4 raw[11];
#pragma unroll
            for (int rr = 0; rr < 11; ++rr) { const unsigned u0 = hf ? rw[rr].z : rw[rr].x, u1 = hf ? rw[rr].w : rw[rr].y;
                raw[rr] = (f32x4){__uint_as_float(u0 << 16), __uint_as_float(u0 & 0xffff0000u), __uint_as_float(u1 << 16), __uint_as_float(u1 & 0xffff0000u)}; }
#pragma unroll
            for (int i = 0; i < 8; ++i) { f32x4 o = wk[4][hf];
#pragma unroll
                for (int k = 0; k < 4; ++k) o += wk[k][hf] * raw[i + k];
                if (!lru) { o.x = fsilu(o.x); o.y = fsilu(o.y); o.z = fsilu(o.z); o.w = fsilu(o.w); }
                *(unsigned long long*)(xo + (size_t)(r0 + i) * C + 8 * c8 + 4 * hf) = (unsigned long long)pk2h(o.x, o.y) | ((unsigned long long)pk2h(o.z, o.w) << 32); }
        }
    }
}
template <bool WITH_T>
__device__ __forceinline__ void ssd_stage(LAS unsigned char* L, const v4u (&rw)[4], int dst, int dstT, int tq, int c8) {
#pragma unroll
    for (int i = 0; i < 4; ++i) *(LAS v4u*)(L + dst + sw128(4 * tq + i, c8)) = rw[i];
    if (WITH_T) {
#pragma unroll
        for (int jw = 0; jw < 4; ++jw) {
            const unsigned a0 = rw[0][jw], a1 = rw[1][jw], a2 = rw[2][jw], a3 = rw[3][jw];
            const unsigned long long ev = (unsigned long long)((a0 & 0xffffu) | (a1 << 16)) | ((unsigned long long)((a2 & 0xffffu) | (a3 << 16)) << 32);
            const unsigned long long od = (unsigned long long)((a0 >> 16) | (a1 & 0xffff0000u)) | ((unsigned long long)((a2 >> 16) | (a3 & 0xffff0000u)) << 32);
            *(LAS unsigned long long*)(L + dstT + sw128t(8 * c8 + 2 * jw, tq >> 1) + (tq & 1) * 8) = ev;
            *(LAS unsigned long long*)(L + dstT + sw128t(8 * c8 + 2 * jw + 1, tq >> 1) + (tq & 1) * 8) = od; }
    }
}
__device__ __forceinline__ float fsoftplus(float x) { return x > 15.f ? x : 0.6931471805599453f * __builtin_amdgcn_logf(1.0f + __builtin_amdgcn_exp2f(1.4426950408889634f * x)); }

__device__ __forceinline__ void ssd_prompt_item(KP a, Frame& F, int l, int b, int hd, int ph) {
    LAS unsigned char* L = F.lds;
    const int tid0 = F.tid, w = F.wave, fr0 = F.lane & 15, fq0 = F.lane >> 4, g = hd >> 3;
    const bf16* proj_seq = (const bf16*)(a->ws + WS_PROJ) + (size_t)b * 2048 * NPJ; const float* dt_seq = (const float*)(a->ws + WS_DT) + (size_t)b * 2048 * 16 + hd;
    bf16* mixb = (bf16*)(a->ws + WS_MIXB) + (size_t)b * 2048 * 2048 + hd * 64 + ph * 32;
    float* ssq = (float*)(a->ws + WS_SSDSS) + (size_t)b * 2048 * 32 + hd * 2 + ph;
    LAS float* ACS = (LAS float*)(L + SL_ACS); LAS float* DTV = (LAS float*)(L + SL_DTV);
    const bf16* xc_seq = (const bf16*)(a->ws + WS_XBCC) + (size_t)b * 2048 * 1536;
    for (int i = tid0; i < 8192 / 4; i += NTHR) ((LAS unsigned*)(L + SL_HS))[i] = 0u;
    const float A = -expf(a->in[17][l * 16 + hd]), dtb = a->in[16][l * 16 + hd], Dk = a->in[18][l * 16 + hd];
    f32x4 hst[2]; hst[0] = (f32x4){0.f, 0.f, 0.f, 0.f}; hst[1] = (f32x4){0.f, 0.f, 0.f, 0.f};
    const int cB = 1024 + g * 128, cC = 1280 + g * 128, cX = hd * 64 + ph * 32, cZ = OFF_Z + hd * 64 + ph * 32;
    v4u rawB[4], rawC[4]; unsigned rawX[4]; float dr0 = 0.f, dr1 = 0.f;
    {
        const int tq = tid0 >> 4, c8 = tid0 & 15;
#pragma unroll
        for (int i = 0; i < 4; ++i) { const bf16* rp = xc_seq + (size_t)(4 * tq + i) * 1536; rawB[i] = *(const GAS v4u*)(rp + cB + 8 * c8); rawC[i] = *(const GAS v4u*)(rp + cC + 8 * c8); rawX[i] = *(const GAS unsigned*)(rp + cX + 2 * c8); }
        if (w == 0) { dr0 = dt_seq[(size_t)(2 * F.lane) * 16]; dr1 = dt_seq[(size_t)(2 * F.lane + 1) * 16]; }
    }
    __syncthreads();
    for (int c = 0; c < 16; ++c) {
        const int t0 = c * 128;
        const int tid = tid0, fr = fr0, fq = fq0;
        const int lane = tid & 63, tq = tid >> 4, c8 = tid & 15;
        unsigned long long zq[2];
#pragma unroll
        for (int pt = 0; pt < 2; ++pt) zq[pt] = *(const GAS unsigned long long*)(proj_seq + (size_t)(t0 + 16 * w + fr) * NPJ + cZ + 16 * pt + 4 * fq);
        if (w == 0) {
            const float dt0 = fsoftplus(dr0 + dtb), dt1 = fsoftplus(dr1 + dtb);
            const float a0 = dt0 * A, a1 = dt1 * A;
            float v = a0 + a1;
#pragma unroll
            for (int o = 1; o < 64; o <<= 1) { const float t = __shfl_up(v, o); if (lane >= o) v += t; }
            ACS[2 * lane] = v - a1; ACS[2 * lane + 1] = v; DTV[2 * lane] = dt0; DTV[2 * lane + 1] = dt1;
        }
        ssd_stage<true>(L, rawB, SL_BS, SL_BT, tq, c8);
        ssd_stage<false>(L, rawC, SL_CS, 0, tq, c8);
        if (c + 1 < 16) {
#pragma unroll
            for (int i = 0; i < 4; ++i) { const bf16* rp = xc_seq + (size_t)(t0 + 128 + 4 * tq + i) * 1536; rawB[i] = *(const GAS v4u*)(rp + cB + 8 * c8); rawC[i] = *(const GAS v4u*)(rp + cC + 8 * c8); }
        }
        LBAR();
        f32x4 cb[8]; bf16x8 cfr[4]; const int lo = (w >= 4) ? (w - 4) : 0, hrt = 7 - w, nh = (w < 4) ? (3 - w) : 0;
#pragma unroll
        for (int ks = 0; ks < 4; ++ks) cfr[ks] = *(const LAS bf16x8*)(L + SL_CS + sw128(16 * w + fr, 4 * ks + fq));
#pragma unroll
        for (int st = 0; st < 8; ++st) if (st >= lo && st <= w) { cb[st] = (f32x4){0.f, 0.f, 0.f, 0.f};
#pragma unroll
            for (int ks = 0; ks < 4; ++ks) { const bf16x8 bm = *(const LAS bf16x8*)(L + SL_BS + sw128(16 * st + fr, 4 * ks + fq)); cb[st] = MFMA16(bm, cfr[ks], cb[st]); } }
        f32x4 cbh[3];
        if (w < 4) { bf16x8 cf2[4];
#pragma unroll
            for (int ks = 0; ks < 4; ++ks) cf2[ks] = *(const LAS bf16x8*)(L + SL_CS + sw128(16 * hrt + fr, 4 * ks + fq));
#pragma unroll
            for (int k = 0; k < 3; ++k) if (k < nh) { cbh[k] = (f32x4){0.f, 0.f, 0.f, 0.f};
#pragma unroll
                for (int ks = 0; ks < 4; ++ks) { const bf16x8 bm = *(const LAS bf16x8*)(L + SL_BS + sw128(16 * k + fr, 4 * ks + fq)); cbh[k] = MFMA16(bm, cf2[ks], cbh[k]); } } }
        {
            const float alast = ACS[127];
            float xd[4][2], xw[4][2];
#pragma unroll
            for (int i = 0; i < 4; ++i) { const int tok = 4 * tq + i; const float dt = DTV[tok], wgt = fexp(alast - ACS[tok]);
                xd[i][0] = __uint_as_float(rawX[i] << 16) * dt; xd[i][1] = __uint_as_float(rawX[i] & 0xffff0000u) * dt; xw[i][0] = xd[i][0] * wgt; xw[i][1] = xd[i][1] * wgt; }
#pragma unroll
            for (int j = 0; j < 2; ++j) { const int off = sw128(2 * c8 + j, tq >> 1) + (tq & 1) * 8;
                *(LAS unsigned long long*)(L + SL_XT + off) = (unsigned long long)pk2h(xd[0][j], xd[1][j]) | ((unsigned long long)pk2h(xd[2][j], xd[3][j]) << 32);
                *(LAS unsigned long long*)(L + SL_XW + off) = (unsigned long long)pk2h(xw[0][j], xw[1][j]) | ((unsigned long long)pk2h(xw[2][j], xw[3][j]) << 32); }
            if (c + 1 < 16) {
#pragma unroll
                for (int i = 0; i < 4; ++i) rawX[i] = *(const GAS unsigned*)(xc_seq + (size_t)(t0 + 128 + 4 * tq + i) * 1536 + cX + 2 * c8);
                if (w == 0) { dr0 = dt_seq[(size_t)(t0 + 128 + 2 * lane) * 16]; dr1 = dt_seq[(size_t)(t0 + 128 + 2 * lane + 1) * 16]; }
            }
        }
        LBAR();
        {
            const int l_ = 16 * w + fr; const float al = ACS[l_];
#pragma unroll
            for (int st = 0; st < 8; ++st) {
                const int off = SL_BS + sw128(l_, 2 * st + (fq >> 1)) + (fq & 1) * 8;
                if (st >= lo && st <= w) { float v[4]; const f32x4 as4 = *(const LAS f32x4*)(ACS + 16 * st + 4 * fq);
#pragma unroll
                    for (int e = 0; e < 4; ++e) { const int s_ = 16 * st + 4 * fq + e; const float ex = fexp(fminf(al - as4[e], 0.f)); v[e] = (s_ <= l_) ? cb[st][e] * ex : 0.f; }
                    *(LAS unsigned long long*)(L + off) = (unsigned long long)pk2h(v[0], v[1]) | ((unsigned long long)pk2h(v[2], v[3]) << 32); }
                else if (st == w + 1 && (w & 1) == 0) *(LAS unsigned long long*)(L + off) = 0ull;
            }
            if (w < 4) { const int l2 = 16 * hrt + fr; const float al2 = ACS[l2];
#pragma unroll
                for (int k = 0; k < 3; ++k) if (k < nh) { float v[4]; const f32x4 as4 = *(const LAS f32x4*)(ACS + 16 * k + 4 * fq);
#pragma unroll
                    for (int e = 0; e < 4; ++e) v[e] = cbh[k][e] * fexp(fminf(al2 - as4[e], 0.f));
                    *(LAS unsigned long long*)(L + SL_BS + sw128(l2, 2 * k + (fq >> 1)) + (fq & 1) * 8) = (unsigned long long)pk2h(v[0], v[1]) | ((unsigned long long)pk2h(v[2], v[3]) << 32); } }
        }
        LBAR();
        {
            f32x4 yd[2], yo[2];
#pragma unroll
            for (int pt = 0; pt < 2; ++pt) { yd[pt] = (f32x4){0.f, 0.f, 0.f, 0.f}; yo[pt] = (f32x4){0.f, 0.f, 0.f, 0.f}; }
#pragma unroll
            for (int ks = 0; ks < 4; ++ks) {
#pragma unroll
                for (int pt = 0; pt < 2; ++pt) { const bf16x8 hf = *(const LAS bf16x8*)(L + SL_HS + sw128(16 * pt + fr, 4 * ks + fq)); yo[pt] = MFMA16(hf, cfr[ks], yo[pt]); }
                if (ks <= (w >> 1)) { const bf16x8 mf = *(const LAS bf16x8*)(L + SL_BS + sw128(16 * w + fr, 4 * ks + fq));
#pragma unroll
                    for (int pt = 0; pt < 2; ++pt) { const bf16x8 xf = *(const LAS bf16x8*)(L + SL_XT + sw128(16 * pt + fr, 4 * ks + fq)); yd[pt] = MFMA16(xf, mf, yd[pt]); } }
            }
            const int l_ = 16 * w + fr; const float ea = fexp(ACS[l_]), dsk = Dk * __builtin_amdgcn_rcpf(DTV[l_]); float s2 = 0.f;
#pragma unroll
            for (int pt = 0; pt < 2; ++pt) { float yg[4];
#pragma unroll
                for (int e = 0; e < 4; ++e) { const int p = 16 * pt + 4 * fq + e;
                    const float xdv = bf2f(*(const LAS bf16*)(L + SL_XT + sw128(p, l_ >> 3) + (l_ & 7) * 2));
                    const float z = bf2f((unsigned short)(zq[pt] >> (16 * e)));
                    const float y = yd[pt][e] + ea * yo[pt][e] + dsk * xdv;
                    yg[e] = y * fsilu(z); s2 += yg[e] * yg[e]; }
                *(unsigned long long*)(mixb + (size_t)(t0 + l_) * 2048 + 16 * pt + 4 * fq) = (unsigned long long)pk2h(yg[0], yg[1]) | ((unsigned long long)pk2h(yg[2], yg[3]) << 32); }
            s2 += __shfl_xor(s2, 16); s2 += __shfl_xor(s2, 32);
            if (fq == 0) ssq[(size_t)(t0 + l_) * 32] = s2;
            const float cd = fexp(ACS[127]);
#pragma unroll
            for (int pt = 0; pt < 2; ++pt) hst[pt] = hst[pt] * cd;
#pragma unroll
            for (int ks = 0; ks < 4; ++ks) { const bf16x8 bt = *(const LAS bf16x8*)(L + SL_BT + sw128t(16 * w + fr, 4 * ks + fq));
#pragma unroll
                for (int pt = 0; pt < 2; ++pt) { const bf16x8 xw = *(const LAS bf16x8*)(L + SL_XW + sw128(16 * pt + fr, 4 * ks + fq)); hst[pt] = MFMA16(bt, xw, hst[pt]); } }
        }
        LBAR();
#pragma unroll
        for (int pt = 0; pt < 2; ++pt)
            *(LAS unsigned long long*)(L + SL_HS + sw128(16 * pt + fr, 2 * w + (fq >> 1)) + (fq & 1) * 8) = (unsigned long long)pk2h(hst[pt][0], hst[pt][1]) | ((unsigned long long)pk2h(hst[pt][2], hst[pt][3]) << 32);
    }
    {
        float* so = a->out + O_PSSD + ((((size_t)l * 8 + b) * 16 + hd) * 64 + ph * 32) * 128;
#pragma unroll
        for (int pt = 0; pt < 2; ++pt) *(f32x4*)(so + (size_t)(16 * pt + fr0) * 128 + 16 * w + 4 * fq0) = hst[pt];
    }
    __syncthreads();
}

constexpr int LR_ROWS = 512 + 32;
constexpr int LR_A = 0, LR_B = LR_ROWS * 64, LR_XC = 2 * LR_ROWS * 64;
constexpr int LR_SEG = LR_XC + 8192, LR_CAR = LR_SEG + 2 * 32 * 16 * 4, LR_CW = LR_CAR + 64 + 32 * 16 * 4;
static_assert(LR_CW + 5 * 64 * 4 <= RING_BYTES, "lru LDS map");
__device__ __forceinline__ int lr_row(int tok) { return tok + (tok >> 4); }
__device__ __forceinline__ void lru_prompt_item(KP a, Frame& F, int l, int b, int hh, int qd) {
    LAS unsigned char* L = F.lds;
    const int tid0 = F.tid, w = F.wave, fr0 = F.lane & 15, fq0 = F.lane >> 4;
    const bf16* proj_seq = (const bf16*)(a->ws + WS_PROJ) + (size_t)b * 2048 * NPJ;
    bf16* mixb = (bf16*)(a->ws + WS_MIXB) + (size_t)b * 2048 * 2048 + 1536 + hh * 64 + qd * 16;
    LAS float* Al = (LAS float*)(L + LR_A); LAS float* Bl = (LAS float*)(L + LR_B); LAS float* XCs = (LAS float*)(L + LR_XC) + w * 256;
    LAS float* SegA = (LAS float*)(L + LR_SEG); LAS float* SegB = SegA + 512; LAS float* Car = (LAS float*)(L + LR_CAR); LAS float* CarIn = Car + 16;
    const int ch = hh * 64 + qd * 16 + fr0;
    if (tid0 < 16) Car[tid0] = 0.f;
    bf16x8 waf[2], wxf[2];
    {
        const float* wa = a->in[22] + ((size_t)l * 8 + hh) * 64 * 64 + qd * 16 + fr0; const float* wx = a->in[24] + ((size_t)l * 8 + hh) * 64 * 64 + qd * 16 + fr0;
#pragma unroll
        for (int ks = 0; ks < 2; ++ks) { v4u ua, ux; const int i0 = 32 * ks + 8 * fq0;
            ua.x = pk2h(wa[(i0 + 0) * 64], wa[(i0 + 1) * 64]); ua.y = pk2h(wa[(i0 + 2) * 64], wa[(i0 + 3) * 64]); ua.z = pk2h(wa[(i0 + 4) * 64], wa[(i0 + 5) * 64]); ua.w = pk2h(wa[(i0 + 6) * 64], wa[(i0 + 7) * 64]);
            ux.x = pk2h(wx[(i0 + 0) * 64], wx[(i0 + 1) * 64]); ux.y = pk2h(wx[(i0 + 2) * 64], wx[(i0 + 3) * 64]); ux.z = pk2h(wx[(i0 + 4) * 64], wx[(i0 + 5) * 64]); ux.w = pk2h(wx[(i0 + 6) * 64], wx[(i0 + 7) * 64]);
            waf[ks] = __builtin_bit_cast(bf16x8, ua); wxf[ks] = __builtin_bit_cast(bf16x8, ux); }
    }
    const float bav = a->in[23][(size_t)l * 512 + ch], bxv = a->in[25][(size_t)l * 512 + ch];
    const float lamv = a->in[26][(size_t)l * 512 + ch];
    const float spv = -8.0f * ((-lamv) > 20.f ? (-lamv) : log1pf(expf(-lamv)));
    const bf16* xl_seq = (const bf16*)(a->ws + WS_XLRU) + (size_t)b * 2048 * 512 + hh * 64;
    v4u xr[4][2];
#pragma unroll
    for (int tt = 0; tt < 4; ++tt)
#pragma unroll
        for (int ks = 0; ks < 2; ++ks) xr[tt][ks] = *(const GAS v4u*)(xl_seq + (size_t)((w * 4 + tt) * 16 + fr0) * 512 + 32 * ks + 8 * fq0);
    __syncthreads();
    for (int qp = 0; qp < 4; ++qp) {
        const int T0 = qp * 512;
        int tid = tid0, fr = fr0, fq = fq0; asm volatile("" : "+v"(tid), "+v"(fr), "+v"(fq));
        v4u gz0, gz1;
        { const bf16* gp = proj_seq + (size_t)(T0 + tid) * NPJ + OFF_GATE + hh * 64 + qd * 16; gz0 = *(const GAS v4u*)gp; gz1 = *(const GAS v4u*)(gp + 8); }
#pragma unroll
        for (int tt = 0; tt < 4; ++tt) {
            const int tb = (w * 4 + tt) * 16;
            bf16x8 xa[2];
#pragma unroll
            for (int ks = 0; ks < 2; ++ks) { xa[ks] = __builtin_bit_cast(bf16x8, xr[tt][ks]);
                if (ks == (qd >> 1) && (fq >> 1) == (qd & 1)) {
                    f32x4 x0, x1; cvt8(xr[tt][ks], x0, x1); *(LAS f32x4*)(XCs + fr * 16 + 8 * (fq & 1)) = x0; *(LAS f32x4*)(XCs + fr * 16 + 8 * (fq & 1) + 4) = x1; }
            }
            f32x4 pr = (f32x4){bav, bav, bav, bav}, pi = (f32x4){bxv, bxv, bxv, bxv};
#pragma unroll
            for (int ks = 0; ks < 2; ++ks) { pr = MFMA16(xa[ks], waf[ks], pr); pi = MFMA16(xa[ks], wxf[ks], pi); }
            LDS_WAIT(); asm volatile("" ::: "memory");
#pragma unroll
            for (int e = 0; e < 4; ++e) { const int tok = tb + 4 * fq + e;
                const float rg = __builtin_amdgcn_rcpf(1.0f + fexp(-pr[e])), ig = __builtin_amdgcn_rcpf(1.0f + fexp(-pi[e]));
                const float log_a = spv * rg; const float av = fexp(log_a);
                const float y2 = 2.0f * log_a;
                const float om = y2 > -0.02f ? -y2 * (1.0f + y2 * (0.5f + y2 * (0.16666667f + y2 * 0.041666668f))) : 1.0f - av * av;
                const float mult = (T0 + tok == 0) ? 1.0f : sqrtf(om);
                const float xcv = XCs[(4 * fq + e) * 16 + fr];
                Al[lr_row(tok) * 16 + fr] = av; Bl[lr_row(tok) * 16 + fr] = mult * ig * xcv; }
            LDS_WAIT(); asm volatile("" ::: "memory");
        }
        if (qp + 1 < 4) {
#pragma unroll
            for (int tt = 0; tt < 4; ++tt)
#pragma unroll
                for (int ks = 0; ks < 2; ++ks) xr[tt][ks] = *(const GAS v4u*)(xl_seq + (size_t)(T0 + 512 + (w * 4 + tt) * 16 + fr) * 512 + 32 * ks + 8 * fq);
        }
        LBAR();
        {
            const int sg = tid >> 4, c = tid & 15; float pa = 1.f, hb = 0.f;
#pragma unroll
            for (int i = 0; i < 16; ++i) { const int r = (sg * 17 + i) * 16 + c; const float av = Al[r]; hb = av * hb + Bl[r]; pa *= av; }
            SegA[sg * 16 + c] = pa; SegB[sg * 16 + c] = hb;
        }
        LBAR();
        if (tid < 16) { float h = Car[tid];
            for (int sg = 0; sg < 32; ++sg) { CarIn[sg * 16 + tid] = h; h = SegA[sg * 16 + tid] * h + SegB[sg * 16 + tid]; }
            Car[tid] = h; }
        LBAR();
        {
            const int sg = tid >> 4, c = tid & 15; float h = CarIn[sg * 16 + c];
#pragma unroll
            for (int i = 0; i < 16; ++i) { const int r = (sg * 17 + i) * 16 + c; h = Al[r] * h + Bl[r]; Bl[r] = h; }
        }
        LBAR();
        {
            const int tok = tid;
            float y[16]; f32x4 gq[4]; cvt8(gz0, gq[0], gq[1]); cvt8(gz1, gq[2], gq[3]);
#pragma unroll
            for (int v = 0; v < 4; ++v) { const f32x4 gt = gq[v]; const f32x4 hv = *(const LAS f32x4*)(Bl + lr_row(tok) * 16 + 4 * v);
#pragma unroll
                for (int i = 0; i < 4; ++i) { const float x = gt[i]; const float u = 0.7978845608028654f * (x + 0.044715f * x * x * x); const float th = 1.0f - 2.0f * __builtin_amdgcn_rcpf(1.0f + fexp(2.0f * u));
                    y[4 * v + i] = hv[i] * 0.5f * x * (1.0f + th); } }
            v4u o0, o1; o0.x = pk2h(y[0], y[1]); o0.y = pk2h(y[2], y[3]); o0.z = pk2h(y[4], y[5]); o0.w = pk2h(y[6], y[7]); o1.x = pk2h(y[8], y[9]); o1.y = pk2h(y[10], y[11]); o1.z = pk2h(y[12], y[13]); o1.w = pk2h(y[14], y[15]);
            v4u* op = (v4u*)(mixb + (size_t)(T0 + tok) * 2048); op[0] = o0; op[1] = o1;
        }
        LBAR();
    }
    if (tid0 < 16) a->out[O_PLRU + ((size_t)l * 8 + b) * 512 + hh * 64 + qd * 16 + tid0] = Car[tid0];
    __syncthreads();
}

constexpr int PL_UP = 0, PL_UPROW = 132 * 4, PL_P = 143 * PL_UPROW;
static_assert(PL_P % 16 == 0 && PL_P + 32768 <= RING_BYTES, "pool LDS map");
__device__ __forceinline__ void pool_prompt_item(KP a, Frame& F, int l, int b, int c, int g) {
    LAS unsigned char* L = F.lds;
    const int tid = F.tid, lane = F.lane, w = F.wave, fr = lane & 15, fq = lane >> 4;
    const int t0 = c * 128, win = 2 << g;
    const bf16* proj_seq = (const bf16*)(a->ws + WS_PROJ) + (size_t)b * 2048 * NPJ;
    const bf16* pwt = (const bf16*)(a->ws + WS_PWT) + ((size_t)l * 4 + g) * 128 * 128;
    bf16* mixb = (bf16*)(a->ws + WS_MIXB) + (size_t)b * 2048 * 2048 + 1024 + g * 128;
    {
        v4u ur[5];
#pragma unroll
        for (int k = 0; k < 5; ++k) { const int i = tid + k * NTHR, rr = i >> 4, c8 = i & 15, row = t0 + rr - 15; ur[k] = (v4u){0u, 0u, 0u, 0u};
            if (i < 143 * 16 && row >= 0) ur[k] = *(const GAS v4u*)(proj_seq + (size_t)row * NPJ + OFF_POOL + g * 128 + 8 * c8); }
#pragma unroll
        for (int k = 0; k < 5; ++k) { const int i = tid + k * NTHR, rr = i >> 4, c8 = i & 15; f32x4 v0, v1; cvt8(ur[k], v0, v1);
            if (i < 143 * 16) { *(LAS f32x4*)(L + PL_UP + rr * PL_UPROW + c8 * 32) = v0; *(LAS f32x4*)(L + PL_UP + rr * PL_UPROW + c8 * 32 + 16) = v1; } }
    }
    __syncthreads();
    for (int i = tid; i < 128 * 16; i += NTHR) { const int tok = i >> 4, c8 = i & 15;
        f32x4 s0 = (f32x4){0.f, 0.f, 0.f, 0.f}, s1 = s0;
        for (int j = 0; j < win; ++j) { const LAS unsigned char* p = L + PL_UP + (tok + 15 - j) * PL_UPROW + c8 * 32; s0 += *(const LAS f32x4*)p; s1 += *(const LAS f32x4*)(p + 16); }
        const int pos = t0 + tok; const float ic = 1.0f / (float)((pos + 1 < win) ? (pos + 1) : win);
        const LAS unsigned char* p = L + PL_UP + (tok + 15) * PL_UPROW + c8 * 32; const f32x4 u0 = *(const LAS f32x4*)p, u1 = *(const LAS f32x4*)(p + 16);
        s0 = s0 * ic - u0; s1 = s1 * ic - u1;
        v4u o; o.x = pk2h(s0.x, s0.y); o.y = pk2h(s0.z, s0.w); o.z = pk2h(s1.x, s1.y); o.w = pk2h(s1.z, s1.w);
        *(LAS v4u*)(L + PL_P + sw128(tok, c8)) = o; }
    __syncthreads();
    bf16x8 pa[4];
#pragma unroll
    for (int ks = 0; ks < 4; ++ks) pa[ks] = *(const LAS bf16x8*)(L + PL_P + sw128(16 * w + fr, 4 * ks + fq));
#pragma unroll
    for (int dt = 0; dt < 8; ++dt) { f32x4 acc = (f32x4){0.f, 0.f, 0.f, 0.f};
#pragma unroll
        for (int ks = 0; ks < 4; ++ks) { const bf16x8 wf = *(const bf16x8*)(pwt + (size_t)(16 * dt + fr) * 128 + 32 * ks + 8 * fq); acc = MFMA16(pa[ks], wf, acc); }
#pragma unroll
        for (int e = 0; e < 4; ++e) mixb[(size_t)(t0 + 16 * w + 4 * fq + e) * 2048 + 16 * dt + fr] = (bf16)f2bfh(acc[e]); }
    __syncthreads();
}

struct TI { const float* W; bf16* WT; const float* gain; int K, N, k0, n0, row_off, mode, goff, kd0; };
__device__ __forceinline__ void ti_load(const TI& t, f32x4 (&v)[8], float (&gn)[8], int lane) {
    const int nn = (lane & 7) * 4, kr = lane >> 3;
#pragma unroll
    for (int i = 0; i < 8; ++i) { const int kk = 8 * i + kr; v[i] = (f32x4){0.f, 0.f, 0.f, 0.f}; gn[i] = 1.f;
        if (t.n0 + nn + 4 <= t.N) v[i] = *(const f32x4*)(t.W + (size_t)(t.k0 + kk) * t.N + t.n0 + nn);
        if (t.gain) gn[i] = t.gain[t.k0 + kk - t.goff]; }
}
__device__ __forceinline__ void ti_store(const TI& t, const f32x4 (&v)[8], const float (&gn)[8], LAS float* scr, int lane) {
    const int nn = (lane & 7) * 4, kr = lane >> 3;
#pragma unroll
    for (int i = 0; i < 8; ++i) { const int kk = 8 * i + kr; f32x4 x = v[i] * gn[i];
        scr[kk * 33 + nn] = x.x; scr[kk * 33 + nn + 1] = x.y; scr[kk * 33 + nn + 2] = x.z; scr[kk * 33 + nn + 3] = x.w; }
    LDS_WAIT(); asm volatile("" ::: "memory");
    const int c = lane & 7;
#pragma unroll
    for (int j = 0; j < 4; ++j) { const int nl = (lane >> 3) + 8 * j, n = t.n0 + nl; const LAS float* sp = scr + (8 * c) * 33 + nl;
        v4u o; o.x = pk2h(sp[0 * 33], sp[1 * 33]); o.y = pk2h(sp[2 * 33], sp[3 * 33]); o.z = pk2h(sp[4 * 33], sp[5 * 33]); o.w = pk2h(sp[6 * 33], sp[7 * 33]);
        int dr;
        if (t.mode == 0) dr = t.row_off + n; else if (t.mode == 1) dr = n < 3072 ? n : (n < 3088 ? 4096 + (n - 3072) : n - 16); else dr = 256 * (n >> 7) + (n & 127) + t.row_off;
        if (n < t.N) *(GAS v4u*)(t.WT + (size_t)dr * t.K + t.kd0 + 8 * c) = o; }
    LDS_WAIT(); asm volatile("" ::: "memory");
}
__device__ __forceinline__ void ph_prologue(KP a, Frame& F) {
    LAS float* scr = (LAS float*)(F.lds + RING_OFF + F.wave * 16384);
    const int gw = F.bid * NWAVES + F.wave, NGW = F.G * NWAVES;
    bf16* Wkv = (bf16*)(a->ws + WS_WKV); bf16* Win = (bf16*)(a->ws + WS_WIN); bf16* Wout = (bf16*)(a->ws + WS_WOUT); bf16* Wq = (bf16*)(a->ws + WS_WQ); bf16* Wo = (bf16*)(a->ws + WS_WO);
    bf16* Wgu = (bf16*)(a->ws + WS_WGU); bf16* Wd = (bf16*)(a->ws + WS_WD);
    constexpr int I_IN = 16 * 129, I_OUT = 32 * 32, I_SQ = 16 * 32, I_G = 16 * 88, I_DN = 44 * 32;
    constexpr int PER_L = I_IN + I_OUT + 4 * I_SQ + 2 * I_G + I_DN;
    auto decode = [&](int it) -> TI {
        const int l = it / PER_L; int r = it % PER_L; TI t; t.goff = 0; t.row_off = 0; t.gain = nullptr; t.mode = 0;
        if (r < I_IN) { const int kb = r / 129, nb = r % 129; t.W = a->in[11] + (size_t)l * 1024 * NIN; t.K = 1024; t.N = NIN; t.k0 = 64 * kb; t.kd0 = 64 * kb; t.n0 = 32 * nb; t.WT = Win + (size_t)l * WIN_L; t.mode = 1; t.gain = a->in[10] + (size_t)l * 1024; return t; } r -= I_IN;
        if (r < I_OUT) { const int kb = r / 32, nb = r % 32; t.W = a->in[27] + (size_t)l * 2048 * 1024; t.K = 2048; t.N = 1024; t.k0 = 64 * kb; t.kd0 = 64 * kb; t.n0 = 32 * nb; t.WT = Wout + (size_t)l * WOUT_L; if (kb >= 8 && kb < 24) { t.gain = a->in[19] + (size_t)l * 1024; t.goff = 512; t.kd0 = 64 * (kb - 8); } else if (kb < 8) t.kd0 = 64 * (kb + 16); return t; } r -= I_OUT;
        if (r < I_SQ) { const int kb = r / 32, nb = r % 32; t.W = a->in[29] + (size_t)l * 1024 * 1024; t.K = 1024; t.N = 1024; t.k0 = 64 * kb; t.kd0 = 64 * kb; t.n0 = 32 * nb; t.WT = Wq + (size_t)l * WQ_L; t.gain = a->in[28] + (size_t)l * 1024; return t; } r -= I_SQ;
        if (r < I_SQ) { const int kb = r / 32, nb = r % 32; t.W = a->in[30] + (size_t)l * 1024 * 1024; t.K = 1024; t.N = 1024; t.k0 = 64 * kb; t.kd0 = 64 * kb; t.n0 = 32 * nb; t.WT = Wkv; t.row_off = l * 2048; return t; } r -= I_SQ;
        if (r < I_SQ) { const int kb = r / 32, nb = r % 32; t.W = a->in[31] + (size_t)l * 1024 * 1024; t.K = 1024; t.N = 1024; t.k0 = 64 * kb; t.kd0 = 64 * kb; t.n0 = 32 * nb; t.WT = Wkv; t.row_off = l * 2048 + 1024; return t; } r -= I_SQ;
        if (r < I_SQ) { const int kb = r / 32, nb = r % 32; t.W = a->in[32] + (size_t)l * 1024 * 1024; t.K = 1024; t.N = 1024; t.k0 = 64 * kb; t.kd0 = 64 * kb; t.n0 = 32 * nb; t.WT = Wo + (size_t)l * WQ_L; return t; } r -= I_SQ;
        if (r < I_G) { const int kb = r / 88, nb = r % 88; t.W = a->in[34] + (size_t)l * 1024 * DFF; t.K = 1024; t.N = DFF; t.k0 = 64 * kb; t.kd0 = 64 * kb; t.n0 = 32 * nb; t.WT = Wgu + (size_t)l * WGU_L; t.mode = 2; t.gain = a->in[33] + (size_t)l * 1024; return t; } r -= I_G;
        if (r < I_G) { const int kb = r / 88, nb = r % 88; t.W = a->in[35] + (size_t)l * 1024 * DFF; t.K = 1024; t.N = DFF; t.k0 = 64 * kb; t.kd0 = 64 * kb; t.n0 = 32 * nb; t.WT = Wgu + (size_t)l * WGU_L; t.mode = 2; t.row_off = 128; t.gain = a->in[33] + (size_t)l * 1024; return t; } r -= I_G;
        { const int kb = r / 32, nb = r % 32; t.W = a->in[36] + (size_t)l * DFF * 1024; t.K = DFF; t.N = 1024; t.k0 = 64 * kb; t.kd0 = 64 * kb; t.n0 = 32 * nb; t.WT = Wd + (size_t)l * WD_L; return t; }
    };
    if (gw < DEPTH * PER_L) {
        int it = gw; TI cur = decode(it); f32x4 v[8]; float gn[8]; ti_load(cur, v, gn, F.lane);
        for (;;) {
            const int nit = it + NGW; const bool has = nit < DEPTH * PER_L;
            TI nxt = cur; f32x4 vn[8]; float gnn[8];
            if (has) { nxt = decode(nit); ti_load(nxt, vn, gnn, F.lane); }
            ti_store(cur, v, gn, scr, F.lane);
            if (!has) break;
            cur = nxt; it = nit;
#pragma unroll
            for (int i = 0; i < 8; ++i) { v[i] = vn[i]; gn[i] = gnn[i]; }
        }
    }
    { bf16* pwt = (bf16*)(a->ws + WS_PWT);
      for (size_t i = (size_t)F.bid * NTHR + F.tid; i < (size_t)DEPTH * 4 * 128 * 128; i += (size_t)F.G * NTHR) { const int c = (int)(i & 127), d = (int)((i >> 7) & 127), lg = (int)(i >> 14);
          pwt[i] = (bf16)f2bfh(a->in[12][((size_t)lg * 128 + c) * 128 + d] * a->in[13][(size_t)lg * 128 + d]); } }
    const size_t gt = (size_t)F.bid * NTHR + F.tid, gs = (size_t)F.G * NTHR;
    { const f32x4* src = (const f32x4*)a->in[2]; unsigned long long* dst = (unsigned long long*)(a->ws + WS_MEMB);
      for (size_t i = gt; i < (size_t)2048 * 1024 / 4; i += gs) { const f32x4 v = src[i]; dst[i] = (unsigned long long)pk2h(v.x, v.y) | ((unsigned long long)pk2h(v.z, v.w) << 32); } }
    { bf16* hb = (bf16*)(a->ws + WS_HB); float* rss = (float*)(a->ws + WS_RSS);
      for (int r0 = gw; r0 < MT; r0 += 4 * NGW) {
          f32x4 v[4][4];
#pragma unroll
          for (int q = 0; q < 4; ++q) { const int r = r0 + q * NGW; const f32x4* src = (const f32x4*)((r < MP ? a->in[0] : a->in[1] - (size_t)MP * D) + (size_t)r * D);
#pragma unroll
              for (int j = 0; j < 4; ++j) v[q][j] = r < MT ? src[F.lane + 64 * j] : (f32x4){0.f, 0.f, 0.f, 0.f}; }
#pragma unroll
          for (int q = 0; q < 4; ++q) { const int r = r0 + q * NGW; float ss = 0.f;
              if (r < MT) {
#pragma unroll
                  for (int j = 0; j < 4; ++j) { const f32x4 x = v[q][j]; ss += x.x * x.x + x.y * x.y + x.z * x.z + x.w * x.w;
                      ((unsigned long long*)(hb + (size_t)r * D))[F.lane + 64 * j] = (unsigned long long)pk2h(x.x, x.y) | ((unsigned long long)pk2h(x.z, x.w) << 32); } }
              ss = wave_sum(ss);
              if (r < MT && F.lane < 16) rss[(size_t)r * 16 + F.lane] = F.lane == 0 ? ss : 0.f; } } }
}

__device__ __forceinline__ void ph_final_norm(Frame& F, const bf16* hb, const float* g, float* Y) {
    const int gw = F.bid * NWAVES + F.wave, NGW = F.G * NWAVES;
    f32x4 gg[4];
#pragma unroll
    for (int j = 0; j < 4; ++j) gg[j] = ((const f32x4*)g)[F.lane + 64 * j];
    for (int r0 = gw; r0 < MT; r0 += 4 * NGW) {
        unsigned long long u[4][4];
#pragma unroll
        for (int q = 0; q < 4; ++q) { const int r = r0 + q * NGW;
#pragma unroll
            for (int j = 0; j < 4; ++j) u[q][j] = r < MT ? ((const unsigned long long*)(hb + (size_t)r * D))[F.lane + 64 * j] : 0ull; }
#pragma unroll
        for (int q = 0; q < 4; ++q) { const int r = r0 + q * NGW; f32x4 v[4]; float ss = 0.f;
#pragma unroll
            for (int j = 0; j < 4; ++j) { const unsigned long long x = u[q][j];
                v[j] = (f32x4){bf2f((unsigned short)x), bf2f((unsigned short)(x >> 16)), bf2f((unsigned short)(x >> 32)), bf2f((unsigned short)(x >> 48))}; ss += v[j].x * v[j].x + v[j].y * v[j].y + v[j].z * v[j].z + v[j].w * v[j].w; }
            ss = wave_sum(ss);
            const float rstd = 1.0f / sqrtf(ss * (1.0f / D) + EPS);
            if (r < MT) {
#pragma unroll
                for (int j = 0; j < 4; ++j) ((f32x4*)(Y + (size_t)r * D))[F.lane + 64 * j] = v[j] * rstd * gg[j]; } }
    }
}

__device__ __forceinline__ float pool_up(const bf16* proj, const float* st_in, const SeqInfo& q, int ci, int ch) {
    if (ci < 15) return q.grp ? st_in[((size_t)q.b * 15 + ci) * 512 + ch] : 0.f;
    return bf2f(proj[(size_t)(q.row0 + ci - 15) * NPJ + OFF_POOL + ch]);
}
__device__ __forceinline__ float conv_xp(const bf16* proj, int off, const float* st_in, int C, const SeqInfo& q, int j, int c) {
    if (j < 3) return q.grp ? st_in[((size_t)q.b * 3 + j) * C + c] : 0.f;
    return bf2f(proj[(size_t)(q.row0 + j - 3) * NPJ + off + c]);
}
__device__ __forceinline__ void conv_states(size_t gt, size_t gs, const bf16* proj, int off, int C, const float* st_in, float* p_out, float* s_out) {
    for (size_t idx = gt; idx < (size_t)NSEQ * 3 * C; idx += gs) {
        const int c = (int)(idx % C), j = (int)((idx / C) % 3), s = (int)(idx / ((size_t)3 * C));
        const SeqInfo q = seq_info(s);
        const float v = conv_xp(proj, off, st_in, C, q, q.L + j, c);
        if (q.grp) s_out[((size_t)q.b * 3 + j) * C + c] = v; else p_out[((size_t)q.b * 3 + j) * C + c] = v;
    }
}
constexpr int SS_X = 0, SS_BC = 8192, SS_DT = 12288;
__device__ __forceinline__ void samp_ssd_item(KP a, Frame& F, int l, int b, int g) {
    LAS float* XS = (LAS float*)(F.lds + RING_OFF + SS_X); LAS float* BC = (LAS float*)(F.lds + RING_OFF + SS_BC); LAS float* DTs = (LAS float*)(F.lds + RING_OFF + SS_DT);
    const int tid = F.tid;
    const bf16* proj = (const bf16*)(a->ws + WS_PROJ) + (size_t)(MP + 4 * b) * NPJ; const float* dtr = (const float*)(a->ws + WS_DT) + (size_t)(MP + 4 * b) * 16;
    const float* cst = a->in[4] + ((size_t)l * 128 + b) * 3 * 1536; const float* cw = a->in[14] + (size_t)l * 4 * 1536; const float* cb = a->in[15] + (size_t)l * 1536;
    bf16* mixb = (bf16*)(a->ws + WS_MIXB) + (size_t)(MP + 4 * b) * 2048;
#pragma unroll
    for (int rep = 0; rep < 2; ++rep) {
        if (rep == 1 && tid >= 256) break;
        const int sc = rep == 0 ? g * 512 + tid : (tid < 128 ? 1024 + g * 128 + tid : 1280 + g * 128 + (tid - 128));
        float xp[7];
#pragma unroll
        for (int j = 0; j < 3; ++j) xp[j] = cst[(size_t)j * 1536 + sc];
#pragma unroll
        for (int t = 0; t < 4; ++t) xp[3 + t] = bf2f(proj[(size_t)t * NPJ + OFF_XBC + sc]);
        const float w0 = cw[sc], w1 = cw[1536 + sc], w2 = cw[2 * 1536 + sc], w3 = cw[3 * 1536 + sc], bb = cb[sc];
#pragma unroll
        for (int t = 0; t < 4; ++t) { const float v = fsilu(bb + w0 * xp[t] + w1 * xp[t + 1] + w2 * xp[t + 2] + w3 * xp[t + 3]); if (rep == 0) XS[t * 512 + tid] = v; else BC[t * 256 + tid] = v; }
    }
    if (tid < 32) { const int t = tid >> 3, k = tid & 7, hd = 8 * g + k; const float dt = softplus_f(dtr[(size_t)t * 16 + hd] + a->in[16][l * 16 + hd]); DTs[t * 8 + k] = dt; DTs[32 + t * 8 + k] = expf(dt * -expf(a->in[17][l * 16 + hd])); }
    __syncthreads();
    const int p = tid >> 3, ng = tid & 7;
    const float* st_in = a->in[5] + (((size_t)l * 128 + b) * 16 + 8 * g) * 64 * 128 + (size_t)p * 128 + ng * 16;
    float* st_out = a->out + O_SSSD + (((size_t)l * 128 + b) * 16 + 8 * g) * 64 * 128 + (size_t)p * 128 + ng * 16;
    f32x4 hn[4];
#pragma unroll
    for (int i = 0; i < 4; ++i) hn[i] = *(const f32x4*)(st_in + 4 * i);
#pragma unroll 1
    for (int k = 0; k < 8; ++k) {
        f32x4 h[4];
#pragma unroll
        for (int i = 0; i < 4; ++i) h[i] = hn[i];
        if (k + 1 < 8) {
#pragma unroll
            for (int i = 0; i < 4; ++i) hn[i] = *(const f32x4*)(st_in + (size_t)(k + 1) * 64 * 128 + 4 * i); }
        const int hd = 8 * g + k; const float Dk = a->in[18][l * 16 + hd];
        float zv[4];
#pragma unroll
        for (int t = 0; t < 4; ++t) zv[t] = bf2f(proj[(size_t)t * NPJ + OFF_Z + hd * 64 + p]);
#pragma unroll
        for (int t = 0; t < 4; ++t) {
            const float dt = DTs[t * 8 + k], dA = DTs[32 + t * 8 + k], x = XS[t * 512 + k * 64 + p], xdt = dt * x;
            float part = 0.f;
#pragma unroll
            for (int i = 0; i < 4; ++i) { const f32x4 Bv = *(const LAS f32x4*)(BC + t * 256 + ng * 16 + 4 * i), Cv = *(const LAS f32x4*)(BC + t * 256 + 128 + ng * 16 + 4 * i);
                h[i] = h[i] * dA + Bv * xdt; part += (Cv.x * h[i].x + Cv.y * h[i].y) + (Cv.z * h[i].z + Cv.w * h[i].w); }
            part += __shfl_xor(part, 1); part += __shfl_xor(part, 2); part += __shfl_xor(part, 4);
            if (ng == 0) mixb[(size_t)t * 2048 + hd * 64 + p] = (bf16)f2bfh((part + Dk * x) * fsilu(zv[t]));
        }
#pragma unroll
        for (int i = 0; i < 4; ++i) *(f32x4*)(st_out + (size_t)k * 64 * 128 + 4 * i) = h[i];
    }
    __syncthreads();
}
__device__ __forceinline__ void samp_lru_item(KP a, Frame& F, int l, int b) {
    LAS float* XC = (LAS float*)(F.lds + RING_OFF);
    const int c = F.tid, hd = c >> 6, j = c & 63;
    const bf16* proj = (const bf16*)(a->ws + WS_PROJ) + (size_t)(MP + 4 * b) * NPJ;
    const float* cst = a->in[6] + ((size_t)l * 128 + b) * 3 * 512; const float* cw = a->in[20] + (size_t)l * 4 * 512;
    float xp[7];
#pragma unroll
    for (int k = 0; k < 3; ++k) xp[k] = cst[(size_t)k * 512 + c];
#pragma unroll
    for (int t = 0; t < 4; ++t) xp[3 + t] = bf2f(proj[(size_t)t * NPJ + OFF_LRU + c]);
    const float w0 = cw[c], w1 = cw[512 + c], w2 = cw[1024 + c], w3 = cw[1536 + c], bb = a->in[21][(size_t)l * 512 + c];
    float xc[4];
#pragma unroll
    for (int t = 0; t < 4; ++t) { xc[t] = bb + w0 * xp[t] + w1 * xp[t + 1] + w2 * xp[t + 2] + w3 * xp[t + 3]; XC[t * 512 + c] = xc[t]; }
    __syncthreads();
    const float* wa = a->in[22] + ((size_t)l * 8 + hd) * 64 * 64 + j; const float* wx = a->in[24] + ((size_t)l * 8 + hd) * 64 * 64 + j;
    float ar[4], ai[4];
#pragma unroll
    for (int t = 0; t < 4; ++t) { ar[t] = a->in[23][(size_t)l * 512 + c]; ai[t] = a->in[25][(size_t)l * 512 + c]; }
#pragma unroll 16
    for (int i = 0; i < 64; ++i) { const float wav = wa[(size_t)i * 64], wxv = wx[(size_t)i * 64];
#pragma unroll
        for (int t = 0; t < 4; ++t) { const float xv = XC[t * 512 + hd * 64 + i]; ar[t] += xv * wav; ai[t] += xv * wxv; } }
    const float lamv = a->in[26][(size_t)l * 512 + c]; const float spv = -8.0f * softplus_f(-lamv);
    float h = a->in[7][((size_t)l * 128 + b) * 512 + c];
    bf16* mixb = (bf16*)(a->ws + WS_MIXB) + (size_t)(MP + 4 * b) * 2048 + 1536 + c;
#pragma unroll
    for (int t = 0; t < 4; ++t) { const float rg = sigmoid_f(ar[t]), ig = sigmoid_f(ai[t]); const float log_a = spv * rg; const float av = expf(log_a), mult = sqrtf(-expm1f(2.0f * log_a));
        h = av * h + mult * ig * xc[t];
        mixb[(size_t)t * 2048] = (bf16)f2bfh(h * gelu_tanh_f(bf2f(proj[(size_t)t * NPJ + OFF_GATE + c]))); }
    a->out[O_SLRU + ((size_t)l * 128 + b) * 512 + c] = h;
    __syncthreads();
}
__device__ __forceinline__ void samp_pool_item(KP a, Frame& F, int l, int b) {
    LAS float* PO = (LAS float*)(F.lds + RING_OFF);
    const int ch = F.tid, g = ch >> 7, w = 2 << g;
    const bf16* proj = (const bf16*)(a->ws + WS_PROJ) + (size_t)(MP + 4 * b) * NPJ;
    const float* st = a->in[3] + ((size_t)l * 128 + b) * 15 * 512;
    float up[19];
#pragma unroll
    for (int i = 0; i < 15; ++i) up[i] = st[(size_t)i * 512 + ch];
#pragma unroll
    for (int t = 0; t < 4; ++t) up[15 + t] = bf2f(proj[(size_t)t * NPJ + OFF_POOL + ch]);
    const float iw = 1.0f / (float)w;
#pragma unroll
    for (int t = 0; t < 4; ++t) { float sm = 0.f;
#pragma unroll
        for (int jj = 0; jj < 16; ++jj) sm += (jj < w) ? up[15 + t - jj] : 0.f;
        PO[t * 512 + ch] = sm * iw - up[15 + t]; }
    __syncthreads();
    const int d = ch & 127; const float* pw = a->in[12] + ((size_t)l * 4 + g) * 128 * 128 + d; const float sc = a->in[13][(size_t)l * 512 + ch];
    float acc[4] = {0.f, 0.f, 0.f, 0.f};
#pragma unroll 16
    for (int cc = 0; cc < 128; ++cc) { const float wv = pw[(size_t)cc * 128];
#pragma unroll
        for (int t = 0; t < 4; ++t) acc[t] += PO[t * 512 + g * 128 + cc] * wv; }
    bf16* mixb = (bf16*)(a->ws + WS_MIXB) + (size_t)(MP + 4 * b) * 2048 + 1024 + ch;
#pragma unroll
    for (int t = 0; t < 4; ++t) mixb[(size_t)t * 2048] = (bf16)f2bfh(acc[t] * sc);
    __syncthreads();
}

__device__ __forceinline__ void ph_mix1(KP a, Frame& F, int l) {
    const size_t gt = (size_t)F.bid * NTHR + F.tid, gs = (size_t)F.G * NTHR;
    const bf16* proj = (const bf16*)(a->ws + WS_PROJ);
    {
        const float* st_in = a->in[3] + (size_t)l * 128 * 15 * 512;
        float* p_out = a->out + O_PPOOL + (size_t)l * 8 * 15 * 512; float* s_out = a->out + O_SPOOL + (size_t)l * 128 * 15 * 512;
        for (size_t idx = gt; idx < (size_t)NSEQ * 15 * 512; idx += gs) {
            const int ch = (int)(idx & 511), j = (int)((idx >> 9) % 15), s = (int)((idx >> 9) / 15);
            const SeqInfo q = seq_info(s);
            const float v = pool_up(proj, st_in, q, q.L + j, ch);
            if (q.grp) s_out[((size_t)q.b * 15 + j) * 512 + ch] = v; else p_out[((size_t)q.b * 15 + j) * 512 + ch] = v;
        }
    }
    conv_states(gt, gs, proj, OFF_XBC, 1536, a->in[4] + (size_t)l * 128 * 3 * 1536, a->out + O_PSCONV + (size_t)l * 8 * 3 * 1536, a->out + O_SSCONV + (size_t)l * 128 * 3 * 1536);
    conv_states(gt, gs, proj, OFF_LRU, 512, a->in[6] + (size_t)l * 128 * 3 * 512, a->out + O_PLCONV + (size_t)l * 8 * 3 * 512, a->out + O_SLCONV + (size_t)l * 128 * 3 * 512);
    __syncthreads();
    { const KP kp = a; (void)kp;
    REG_BEGIN(0);
    for (int it = F.vcu; it < 256; it += F.G) ssd_prompt_item(a, F, l, it >> 5, (it >> 1) & 15, it & 1);
    REG_END(0); REG_BEGIN(1);
    for (int it = F.vcu; it < 256; it += F.G) lru_prompt_item(a, F, l, it >> 5, (it >> 2) & 7, it & 3);
    REG_END(1); }
    for (int it = F.vcu; it < 512; it += F.G) pool_prompt_item(a, F, l, it >> 6, (it >> 2) & 15, it & 3);
    for (int it = F.bid; it < 256; it += F.G) samp_ssd_item(a, F, l, it >> 1, it & 1);
    for (int it = F.bid; it < 256; it += F.G) { if (it < 128) samp_lru_item(a, F, l, it); else samp_pool_item(a, F, l, it - 128); }
}
__device__ __forceinline__ void ph_mix3(KP a, Frame& F, int l) {
    bf16* mixb = (bf16*)(a->ws + WS_MIXB);
    const int gw = F.bid * NWAVES + F.wave, NGW = F.G * NWAVES;
    for (int r = gw; r < MP; r += NGW) {
        const float* sp = (const float*)(a->ws + WS_SSDSS) + (size_t)r * 32;
        float ss = F.lane < 32 ? sp[F.lane] : 0.f; ss = wave_sum(ss);
        const float rstd = 1.0f / sqrtf(ss * (1.0f / 1024.f) + EPS);
#pragma unroll
        for (int j = 0; j < 4; ++j) { const int c = 4 * F.lane + 256 * j; unsigned long long* mp = (unsigned long long*)(mixb + (size_t)r * 2048 + 512 + c); const unsigned long long u = *mp;
            const float w0 = bf2f((unsigned short)u) * rstd, w1 = bf2f((unsigned short)(u >> 16)) * rstd, w2 = bf2f((unsigned short)(u >> 32)) * rstd, w3 = bf2f((unsigned short)(u >> 48)) * rstd;
            *mp = (unsigned long long)pk2h(w0, w1) | ((unsigned long long)pk2h(w2, w3) << 32); }
    }
}
constexpr int SG_PSTRIDE = 36, SG_P = 0, SG_SS = 8 * 64 * SG_PSTRIDE * 4;
static_assert(SG_SS + 8 * 64 * 4 <= RING_BYTES, "small gemm LDS map");
__device__ __forceinline__ float sumsq8(bf16x8 v) { float s = 0.f;
#pragma unroll
    for (int j = 0; j < 8; ++j) { const float x = bf2f((unsigned short)v[j]); s += x * x; } return s; }
template <int K, int STATS  , class Epi>
__device__ __forceinline__ void small_gemm(Frame& F, const bf16* A, const bf16* Bt, int it0, int it1, const Epi& E) {
    constexpr int KW = K / 8, KS = KW / 32;
    constexpr bool REUSE = Epi::RT_SLOW && K == 1024;
    static_assert(K % 256 == 0, "K splits into eight 32-multiples");
    LAS float* P = (LAS float*)(F.lds + RING_OFF + SG_P); LAS float* SS = (LAS float*)(F.lds + RING_OFF + SG_SS);
    const int w = F.wave;
    bf16x8 afr[REUSE ? KS : 1][4]; float ssqr[4] = {0.f, 0.f, 0.f, 0.f}; int rt_have = -1;
    for (int it = it0; it < it1; ++it) {
        int tid = F.tid; asm volatile("" : "+v"(tid));
        const int lane = tid & 63, fr = lane & 15, fq = lane >> 4;
        const int rt = Epi::RT_SLOW ? it / E.nctl : (it & 7), ct = Epi::RT_SLOW ? E.ct0 + it % E.nctl : (it >> 3);
        if (Epi::RT_SLOW && ct >= Epi::NCT) continue;
        int nb0, nb1; E.bases(ct, nb0, nb1);
        const bf16* Ap = A + (size_t)(64 * rt + fr) * K + w * KW + 8 * fq;
        const bf16* Bp0 = Bt + (size_t)(nb0 + fr) * K + w * KW + 8 * fq; const bf16* Bp1 = Bt + (size_t)(nb1 + fr) * K + w * KW + 8 * fq;
        f32x4 acc[4][2]; float ssq[4];
#pragma unroll
        for (int mt = 0; mt < 4; ++mt) { acc[mt][0] = (f32x4){0.f, 0.f, 0.f, 0.f}; acc[mt][1] = (f32x4){0.f, 0.f, 0.f, 0.f}; ssq[mt] = 0.f; }
        if constexpr (REUSE) {
            bf16x8 bq[KS][2];
#pragma unroll
            for (int ks = 0; ks < KS; ++ks) { bq[ks][0] = *(const bf16x8*)(Bp0 + 32 * ks); bq[ks][1] = *(const bf16x8*)(Bp1 + 32 * ks); }
            if (rt != rt_have) {
#pragma unroll
                for (int ks = 0; ks < KS; ++ks)
#pragma unroll
                    for (int mt = 0; mt < 4; ++mt) afr[ks][mt] = *(const bf16x8*)(Ap + (size_t)mt * 16 * K + 32 * ks);
#pragma unroll
                for (int mt = 0; mt < 4; ++mt) { float sv = 0.f;
#pragma unroll
                    for (int ks = 0; ks < KS; ++ks) sv += sumsq8(afr[ks][mt]);
                    ssqr[mt] = sv; }
                rt_have = rt;
            }
#pragma unroll
            for (int ks = 0; ks < KS; ++ks)
#pragma unroll
                for (int mt = 0; mt < 4; ++mt) { acc[mt][0] = MFMA16(afr[ks][mt], bq[ks][0], acc[mt][0]); acc[mt][1] = MFMA16(afr[ks][mt], bq[ks][1], acc[mt][1]); }
#pragma unroll
            for (int mt = 0; mt < 4; ++mt) ssq[mt] = ssqr[mt];
        } else {
#pragma unroll
            for (int ks = 0; ks < KS; ++ks) {
                bf16x8 af[4];
#pragma unroll
                for (int mt = 0; mt < 4; ++mt) af[mt] = *(const bf16x8*)(Ap + (size_t)mt * 16 * K + 32 * ks);
                const bf16x8 b0 = *(const bf16x8*)(Bp0 + 32 * ks), b1 = *(const bf16x8*)(Bp1 + 32 * ks);
#pragma unroll
                for (int mt = 0; mt < 4; ++mt) { acc[mt][0] = MFMA16(af[mt], b0, acc[mt][0]); acc[mt][1] = MFMA16(af[mt], b1, acc[mt][1]); if (STATS == 1 || (STATS == 2 && w < 4)) ssq[mt] += sumsq8(af[mt]); }
            }
        }
#pragma unroll
        for (int mt = 0; mt < 4; ++mt) {
#pragma unroll
            for (int nt = 0; nt < 2; ++nt)
#pragma unroll
                for (int e = 0; e < 4; ++e) P[(w * 64 + 16 * mt + 4 * fq + e) * SG_PSTRIDE + 16 * nt + fr] = acc[mt][nt][e];
            if (STATS) { float sv = ssq[mt]; sv += __shfl_xor(sv, 16); sv += __shfl_xor(sv, 32); if (fq == 0) SS[w * 64 + 16 * mt + fr] = sv; }
        }
        __syncthreads();
        {
            const int row = tid >> 3, cq = tid & 7;
            f32x4 v = (f32x4){0.f, 0.f, 0.f, 0.f}, v2 = v;
            float rstd = 1.f;
            if (STATS) { float sm = 0.f;
#pragma unroll
                for (int ww = 0; ww < 8; ++ww) sm += SS[ww * 64 + row];
                rstd = 1.0f / sqrtf(sm * (1.0f / 1024.f) + EPS); }
#pragma unroll
            for (int ww = 0; ww < 8; ++ww) { const float sc = (STATS == 2 && ww < 4) ? rstd : 1.f;
                v += *(const LAS f32x4*)(P + (ww * 64 + row) * SG_PSTRIDE + 4 * cq) * sc; if (Epi::PAIR) v2 += *(const LAS f32x4*)(P + (ww * 64 + row) * SG_PSTRIDE + 4 * (cq ^ 4)); }
            if (STATS == 2) rstd = 1.f;
            E.store(ct, MP + 64 * rt + row, cq, v, v2, rstd);
        }
        __syncthreads();
    }
}
struct SProj {
    static constexpr bool PAIR = false, RT_SLOW = true; static constexpr int NCT = 129; bf16* proj; float* dtr; int ct0, nctl;
    __device__ __forceinline__ void bases(int ct, int& nb0, int& nb1) const { nb0 = 32 * ct; nb1 = nb0 + 16; }
    __device__ __forceinline__ void store(int ct, int row, int cq, f32x4 v, f32x4, float rstd) const { const int j = 32 * ct + 4 * cq; const f32x4 o = v * rstd;
        if (j < 4096) *(unsigned long long*)(proj + (size_t)row * NPJ + j) = (unsigned long long)pk2h(o.x, o.y) | ((unsigned long long)pk2h(o.z, o.w) << 32);
        else if (j < 4112) *(f32x4*)(dtr + (size_t)row * 16 + (j - 4096)) = o; }
};
struct SResid {
    static constexpr bool PAIR = false, RT_SLOW = false; static constexpr int NCT = 32, ct0 = 0, nctl = 1; bf16* hb;
    __device__ __forceinline__ void bases(int ct, int& nb0, int& nb1) const { nb0 = 32 * ct; nb1 = nb0 + 16; }
    __device__ __forceinline__ void store(int ct, int row, int cq, f32x4 v, f32x4, float) const { const int c = 32 * ct + 4 * cq; unsigned long long* hp = (unsigned long long*)(hb + (size_t)row * 1024 + c); const unsigned long long u = *hp;
        const float o0 = bf2f((unsigned short)u) + v.x, o1 = bf2f((unsigned short)(u >> 16)) + v.y, o2 = bf2f((unsigned short)(u >> 32)) + v.z, o3 = bf2f((unsigned short)(u >> 48)) + v.w;
        *hp = (unsigned long long)pk2h(o0, o1) | ((unsigned long long)pk2h(o2, o3) << 32); }
};
struct SQ {
    static constexpr bool PAIR = false, RT_SLOW = false; static constexpr int NCT = 32, ct0 = 0, nctl = 1; bf16* qb; float scale;
    __device__ __forceinline__ void bases(int ct, int& nb0, int& nb1) const { nb0 = 32 * ct; nb1 = nb0 + 16; }
    __device__ __forceinline__ void store(int ct, int row, int cq, f32x4 v, f32x4, float rstd) const { const int c = 32 * ct + 4 * cq; const f32x4 o = v * (rstd * scale);
        *(unsigned long long*)(qb + (size_t)row * 1024 + c) = (unsigned long long)pk2h(o.x, o.y) | ((unsigned long long)pk2h(o.z, o.w) << 32); }
};
struct SSwiGLU {
    static constexpr bool PAIR = true, RT_SLOW = true; static constexpr int NCT = 176; bf16* act; int ct0, nctl;
    __device__ __forceinline__ void bases(int ct, int& nb0, int& nb1) const { nb0 = 256 * (ct >> 3) + 16 * (ct & 7); nb1 = nb0 + 128; }
    __device__ __forceinline__ void store(int ct, int row, int cq, f32x4 g, f32x4 u, float rstd) const { if (cq < 4) { const int c = 128 * (ct >> 3) + 16 * (ct & 7) + 4 * cq; const f32x4 gs = g * rstd, us = u * rstd;
        *(unsigned long long*)(act + (size_t)row * DFF + c) = (unsigned long long)pk2h(fsilu(gs.x) * us.x, fsilu(gs.y) * us.y) | ((unsigned long long)pk2h(fsilu(gs.z) * us.z, fsilu(gs.w) * us.w) << 32); } }
};
__device__ __forceinline__ void dt_gemm(Frame& F, const bf16* hb, const bf16* Wdt, const float* rss, float* dtr) {
    for (int it = F.bid; it < MP / 128; it += F.G) {
        int tid = F.tid; asm volatile("" : "+v"(tid)); const int lane = tid & 63, fr = lane & 15, fq = lane >> 4;
        const int row0 = it * 128 + 16 * F.wave;
        f32x4 acc = (f32x4){0.f, 0.f, 0.f, 0.f};
#pragma unroll 8
        for (int ks = 0; ks < 32; ++ks) { const bf16x8 af = *(const bf16x8*)(hb + (size_t)(row0 + fr) * 1024 + 32 * ks + 8 * fq); const bf16x8 bfm = *(const bf16x8*)(Wdt + (size_t)fr * 1024 + 32 * ks + 8 * fq); acc = MFMA16(af, bfm, acc); }
#pragma unroll
        for (int e = 0; e < 4; ++e) { const int row = row0 + 4 * fq + e; const f32x4* rp = (const f32x4*)(rss + (size_t)row * 16); const f32x4 p0 = rp[0], p1 = rp[1], p2 = rp[2], p3 = rp[3];
            const float sm = ((p0.x + p0.y) + (p0.z + p0.w)) + ((p1.x + p1.y) + (p1.z + p1.w)) + ((p2.x + p2.y) + (p2.z + p2.w)) + ((p3.x + p3.y) + (p3.z + p3.w));
            dtr[(size_t)row * 16 + fr] = acc[e] * (1.0f / sqrtf(sm * (1.0f / 1024.f) + EPS)); }
    }
}

__device__ __forceinline__ void attn_prompt_unit(Frame& F, const bf16* qb, const bf16* kb_l, const bf16* vt_l, bf16* ob, int b, int hh, int qt) {
    LAS unsigned char* lds = F.lds + RING_OFF;
    const int lane = F.lane, fr = lane & 15, fq = lane >> 4, tid = F.tid;
    const int r0 = b * 2048 + qt * 256 + F.wave * 32;
    const bf16* kbase = kb_l + (size_t)(b * 256) * 1024 + hh * 256; const bf16* vbase = vt_l + (size_t)(hh * 256) * 2048 + b * 256;
    v4u rg[8];
#define ATT_LOAD(base, pitch, half) do { const bf16* tb_ = (base); asm volatile("" : "+s"(tb_)); tb_ += (size_t)((half) * 128 + (tid >> 5)) * (pitch) + (tid & 31) * 8; \
        _Pragma("unroll") for (int ps = 0; ps < 8; ++ps) rg[ps] = *(const GAS v4u*)(tb_ + (size_t)ps * 16 * (pitch)); } while (0)
#define ATT_STORE(bufoff) do { LAS unsigned char* lb_ = lds + (bufoff) + (tid >> 5) * 512 + (((tid & 31) ^ ((tid >> 5) & 15)) << 4); \
        _Pragma("unroll") for (int ps = 0; ps < 8; ++ps) *(LAS v4u*)(lb_ + ps * 8192) = rg[ps]; } while (0)
    ATT_LOAD(kbase, 1024, 0); ATT_STORE(0);
    ATT_LOAD(kbase, 1024, 1); ATT_STORE(65536);
    LBAR();
    bf16x8 pf[2][8]; float inv[2];
#pragma unroll
    for (int mt = 0; mt < 2; ++mt) {
        __builtin_amdgcn_sched_barrier(0);
        bf16x8 qf[8];
#pragma unroll
        for (int ks = 0; ks < 8; ++ks) qf[ks] = *(const bf16x8*)(qb + (size_t)(r0 + mt * 16 + fr) * 1024 + hh * 256 + ks * 32 + fq * 8);
        f32x4 s[16];
#pragma unroll
        for (int kt = 0; kt < 16; ++kt) { s[kt] = (f32x4){0.f, 0.f, 0.f, 0.f};
#pragma unroll
            for (int kh = 0; kh < 2; ++kh) { bf16x8 kf[4];
#pragma unroll
                for (int ks = 0; ks < 4; ++ks) kf[ks] = *(const LAS bf16x8*)(lds + (16 * kt + fr) * 512 + (((4 * (4 * kh + ks) + fq) ^ fr) << 4));
#pragma unroll
                for (int ks = 0; ks < 4; ++ks) s[kt] = MFMA16(kf[ks], qf[4 * kh + ks], s[kt]);
                __builtin_amdgcn_sched_barrier(0); } }
        float m = -3.0e38f;
#pragma unroll
        for (int kt = 0; kt < 16; ++kt) m = fmaxf(fmaxf(fmaxf(s[kt][0], s[kt][1]), fmaxf(s[kt][2], s[kt][3])), m);
        m = fmaxf(m, __shfl_xor(m, 16)); m = fmaxf(m, __shfl_xor(m, 32));
        float sum = 0.f;
#pragma unroll
        for (int kt = 0; kt < 16; ++kt)
#pragma unroll
            for (int e = 0; e < 4; ++e) { const float p = __builtin_amdgcn_exp2f(s[kt][e] - m); s[kt][e] = p; sum += p; }
        sum += __shfl_xor(sum, 16); sum += __shfl_xor(sum, 32);
        inv[mt] = 1.0f / sum;
#pragma unroll
        for (int ks = 0; ks < 8; ++ks) { v4u w; w.x = pk2h(s[2 * ks][0], s[2 * ks][1]); w.y = pk2h(s[2 * ks][2], s[2 * ks][3]);
            w.z = pk2h(s[2 * ks + 1][0], s[2 * ks + 1][1]); w.w = pk2h(s[2 * ks + 1][2], s[2 * ks + 1][3]); pf[mt][ks] = __builtin_bit_cast(bf16x8, w); }
        __builtin_amdgcn_sched_barrier(0);
    }
    LBAR();
    ATT_LOAD(vbase, 2048, 0); ATT_STORE(0); ATT_LOAD(vbase, 2048, 1); ATT_STORE(65536);
    LBAR();
#pragma unroll
    for (int qr = 0; qr < 4; ++qr) {
        const int bo = (qr >> 1) * 65536;
        f32x4 o[2][4];
#pragma unroll
        for (int dl = 0; dl < 4; ++dl) { o[0][dl] = (f32x4){0.f, 0.f, 0.f, 0.f}; o[1][dl] = (f32x4){0.f, 0.f, 0.f, 0.f};
#pragma unroll
            for (int kh = 0; kh < 2; ++kh) { bf16x8 vf[4];
#pragma unroll
                for (int ks = 0; ks < 4; ++ks) vf[ks] = *(const LAS bf16x8*)(lds + bo + (16 * ((qr & 1) * 4 + dl) + fr) * 512 + (((4 * (4 * kh + ks) + fq) ^ fr) << 4));
#pragma unroll
                for (int ks = 0; ks < 4; ++ks) { o[0][dl] = MFMA16(vf[ks], pf[0][4 * kh + ks], o[0][dl]); o[1][dl] = MFMA16(vf[ks], pf[1][4 * kh + ks], o[1][dl]); }
                __builtin_amdgcn_sched_barrier(0); } }
#pragma unroll
        for (int mt = 0; mt < 2; ++mt)
#pragma unroll
            for (int dl = 0; dl < 4; ++dl) { const f32x4 v = o[mt][dl] * inv[mt];
                *(unsigned long long*)(ob + (size_t)(r0 + mt * 16 + fr) * 1024 + hh * 256 + 16 * (qr * 4 + dl) + 4 * fq) = (unsigned long long)pk2h(v[0], v[1]) | ((unsigned long long)pk2h(v[2], v[3]) << 32); }
        __builtin_amdgcn_sched_barrier(0);
    }
#undef ATT_LOAD
#undef ATT_STORE
    __syncthreads();
}
__device__ __forceinline__ void attn_sample_item(Frame& F, const bf16* qb, const float* Ks_l, const float* Vs_l, bf16* ob, int b, int hh) {
    LAS float* Sl = (LAS float*)(F.lds + RING_OFF);
    LAS float* Ol = (LAS float*)(F.lds + RING_OFF + 4096);
    const int lane = F.lane, w = F.wave, d4 = 4 * lane;
    const float* Kb = Ks_l + (size_t)b * 256 * 1024 + hh * 256 + d4;
    const float* Vb = Vs_l + (size_t)b * 256 * 1024 + hh * 256 + d4;
    f32x4 q[4];
#pragma unroll
    for (int t = 0; t < 4; ++t) { const unsigned long long u = *(const unsigned long long*)(qb + (size_t)(MP + 4 * b + t) * 1024 + hh * 256 + d4);
        q[t] = (f32x4){bf2f((unsigned short)u), bf2f((unsigned short)(u >> 16)), bf2f((unsigned short)(u >> 32)), bf2f((unsigned short)(u >> 48))}; }
#pragma unroll
    for (int bt = 0; bt < 2; ++bt) {
        f32x4 kv[16];
#pragma unroll
        for (int kk = 0; kk < 16; ++kk) kv[kk] = *(const f32x4*)(Kb + (size_t)(32 * w + 16 * bt + kk) * 1024);
        float v[64];
#pragma unroll
        for (int kk = 0; kk < 16; ++kk)
#pragma unroll
            for (int t = 0; t < 4; ++t) v[kk * 4 + t] = kv[kk].x * q[t].x + kv[kk].y * q[t].y + kv[kk].z * q[t].z + kv[kk].w * q[t].w;
#pragma unroll
        for (int mk = 32, n = 32; mk >= 1; mk >>= 1, n >>= 1) {
            const bool up = (lane & mk) != 0;
#pragma unroll
            for (int i = 0; i < n; ++i) { const float lo = v[i], hi = v[i + n]; const float send = up ? lo : hi, keep = up ? hi : lo; v[i] = keep + __shfl_xor(send, mk); }
        }
        Sl[(lane & 3) * 256 + 32 * w + 16 * bt + (lane >> 2)] = v[0];
    }
    __syncthreads();
    if (w < 4) {
        float x[4];
#pragma unroll
        for (int j = 0; j < 4; ++j) x[j] = Sl[w * 256 + lane + 64 * j];
        const float m = wave_max(fmaxf(fmaxf(x[0], x[1]), fmaxf(x[2], x[3])));
        float sum = 0.f;
#pragma unroll
        for (int j = 0; j < 4; ++j) { x[j] = __builtin_amdgcn_exp2f(x[j] - m); sum += x[j]; }
        sum = wave_sum(sum);
        const float inv = 1.0f / sum;
#pragma unroll
        for (int j = 0; j < 4; ++j) Sl[w * 256 + lane + 64 * j] = x[j] * inv;
    }
    __syncthreads();
    f32x4 acc[4];
#pragma unroll
    for (int t = 0; t < 4; ++t) acc[t] = (f32x4){0.f, 0.f, 0.f, 0.f};
#pragma unroll
    for (int bt = 0; bt < 2; ++bt) {
        f32x4 vv[16];
#pragma unroll
        for (int kk = 0; kk < 16; ++kk) vv[kk] = *(const f32x4*)(Vb + (size_t)(32 * w + 16 * bt + kk) * 1024);
#pragma unroll
        for (int kk = 0; kk < 16; ++kk)
#pragma unroll
            for (int t = 0; t < 4; ++t) acc[t] += vv[kk] * Sl[t * 256 + 32 * w + 16 * bt + kk];
    }
#pragma unroll
    for (int t = 0; t < 4; ++t) *(LAS f32x4*)(Ol + (w * 4 + t) * 256 + d4) = acc[t];
    __syncthreads();
    {
        const int t = F.tid >> 7, d = (F.tid & 127) * 2;
        float o0 = 0.f, o1 = 0.f;
#pragma unroll
        for (int ww = 0; ww < 8; ++ww) { o0 += Ol[(ww * 4 + t) * 256 + d]; o1 += Ol[(ww * 4 + t) * 256 + d + 1]; }
        *(unsigned*)(ob + (size_t)(MP + 4 * b + t) * 1024 + hh * 256 + d) = pk2h(o0, o1);
    }
    __syncthreads();
}
__device__ __forceinline__ void ph_attn(KP a, Frame& F, int l) {
    const bf16* qb = (const bf16*)(a->ws + WS_QB); bf16* ob = (bf16*)(a->ws + WS_OB);
    const bf16* kb_l = (const bf16*)(a->ws + WS_KB) + (size_t)l * 2048 * 1024; const bf16* vt_l = (const bf16*)(a->ws + WS_VT) + (size_t)l * 1024 * 2048;
    const float* Ks = a->in[8] + (size_t)l * 128 * 256 * 1024; const float* Vs = a->in[9] + (size_t)l * 128 * 256 * 1024;
    for (int u = F.vcu; u < 256; u += F.G) attn_prompt_unit(F, qb, kb_l, vt_l, ob, u >> 5, (u >> 3) & 3, u & 7);
    for (int it = F.bid; it < 512; it += F.G) attn_sample_item(F, qb, Ks, Vs, ob, it >> 2, it & 3);
}
}

using namespace nv;
#ifndef MK_SP2
#define MK_SP2 true
#endif
#ifndef MK_ALIGN
#define MK_ALIGN true
#endif
__global__ void __launch_bounds__(NTHR, 2) mk_fwd(Args args) {
    extern __shared__ __attribute__((aligned(16))) unsigned char lds[];
    Frame F;
    F.lds = (LAS unsigned char*)lds;
    F.tid = threadIdx.x; F.lane = F.tid & 63; F.wave = __builtin_amdgcn_readfirstlane(F.tid >> 6); F.bid = blockIdx.x; F.G = gridDim.x; F.vcu = (F.G % 8 == 0) ? (F.bid % 8) * (F.G / 8) + F.bid / 8 : F.bid;
    volatile LAS unsigned* MISC = (volatile LAS unsigned*)(F.lds + MISC_OFF);
    for (int u = F.tid; u < (LDS_BYTES - LDSCTL_OFF) / 4; u += NTHR) ((LAS unsigned*)(F.lds + LDSCTL_OFF))[u] = 0u;
    __syncthreads();
    const KP kp = (KP)__builtin_amdgcn_kernarg_segment_ptr();
    const int lo = kp->ph_lo, hi = kp->ph_hi;
    XcdBarrier bar; bar.bar = (unsigned*)(kp->ws + WS_CTL) + CW_BAR; bar.x = 0; bar.st = nullptr;
    if (hi - lo > 1) bar = xcd_barrier_post((unsigned*)(kp->ws + WS_CTL) + CW_BAR, MISC + 8);
#define IN(k) (lo <= (k) && (k) < hi)
#if MK_PROBE
#define STAMP(k) do { if (blockIdx.x == 0 && threadIdx.x == 0) ((unsigned long long*)(kp->ws + WS_CTL + 65536))[(k)] = __builtin_amdgcn_s_memrealtime(); } while (0)
#else
#define STAMP(k) do { } while (0)
#endif
#define SITE() KP a = kp; asm volatile("" : "+s"(a)); frame_refresh(F); unsigned char* ws = a->ws; (void)ws
#define SEAM(k) do { if (IN(k) && IN((k) + 1)) { XcdBarrier b2 = bar; asm volatile("" : "+s"(b2.bar)); xcd_barrier(b2); } } while (0)

    if (IN(PH_PRO)) { STAMP(PH_PRO); SITE(); ph_prologue(a, F); }
    SEAM(PH_PRO);
    if (IN(PH_KV)) { STAMP(PH_KV);
        SITE();
        pg8::Gemm g{(const pg8::bf16_t*)(ws + WS_MEMB), (const pg8::bf16_t*)(ws + WS_WKV), 2048, 8192, 1024}; pg8::StaticOrder S; S.init(2048, 8192, F.G, F.bid);
        pg8::EpiKV E{a->out + O_PMK, (size_t)(O_PMV - O_PMK), (pg8::bf16_t*)(ws + WS_KB), (pg8::bf16_t*)(ws + WS_VT)};
        pg8::gemm_phase<pg8::EpiKV, pg8::StaticOrder, MK_ALIGN, MK_SP2>(F.lds + RING_OFF, g, S, E);
    }
    SEAM(PH_KV);
#define LAYER_BODY(l) { \
        const int pb = PH_L0 + (l) * PH_PER_LAYER; \
        if (IN(pb + 0)) { STAMP(pb + 0); \
            SITE(); \
            const bool early_ = ((F.bid >> 3) & 1) != 0;     \
            if (early_) { \
            dt_gemm(F, (const bf16*)(ws + WS_HB), (const bf16*)(ws + WS_WIN) + (size_t)(l) * WIN_L + (size_t)4096 * 1024, (const float*)(ws + WS_RSS), (float*)(ws + WS_DT)); \
            { int x_ = 0, j_ = F.bid, nj_ = F.G; if (F.G % 8 == 0) { x_ = F.bid & 7; j_ = F.bid >> 3; nj_ = F.G >> 3; } const int nctl_ = (F.G % 8 == 0) ? 17 : 129, nl_ = 8 * nctl_;     \
              SProj E{(bf16*)(ws + WS_PROJ), (float*)(ws + WS_DT), nctl_ * x_, nctl_}; small_gemm<1024, 1, SProj>(F, (const bf16*)(ws + WS_HB) + (size_t)MP * 1024, (const bf16*)(ws + WS_WIN) + (size_t)(l) * WIN_L, (j_ * nl_) / nj_, ((j_ + 1) * nl_) / nj_, E); } \
              __syncthreads(); } \
            { pg8::Gemm g{(const pg8::bf16_t*)(ws + WS_HB), (const pg8::bf16_t*)(ws + WS_WIN) + (size_t)(l) * WIN_L, MP, 4096, 1024}; pg8::StaticOrder S; S.init(MP, 4096, F.G, F.bid); \
              pg8::EpiProj E{(pg8::bf16_t*)(ws + WS_PROJ), (const float*)(ws + WS_RSS)}; \
              pg8::gemm_phase<pg8::EpiProj, pg8::StaticOrder, MK_ALIGN, MK_SP2>(F.lds + RING_OFF, g, S, E); } \
            if (!early_) { \
            dt_gemm(F, (const bf16*)(ws + WS_HB), (const bf16*)(ws + WS_WIN) + (size_t)(l) * WIN_L + (size_t)4096 * 1024, (const float*)(ws + WS_RSS), (float*)(ws + WS_DT)); \
            { int x_ = 0, j_ = F.bid, nj_ = F.G; if (F.G % 8 == 0) { x_ = F.bid & 7; j_ = F.bid >> 3; nj_ = F.G >> 3; } const int nctl_ = (F.G % 8 == 0) ? 17 : 129, nl_ = 8 * nctl_;     \
              SProj E{(bf16*)(ws + WS_PROJ), (float*)(ws + WS_DT), nctl_ * x_, nctl_}; small_gemm<1024, 1, SProj>(F, (const bf16*)(ws + WS_HB) + (size_t)MP * 1024, (const bf16*)(ws + WS_WIN) + (size_t)(l) * WIN_L, (j_ * nl_) / nj_, ((j_ + 1) * nl_) / nj_, E); } \
            } \
        } \
        SEAM(pb + 0); \
        if (IN(pb + 1)) { STAMP(pb + 1); SITE(); ph_mix0(a, F, (l)); } \
        SEAM(pb + 1); \
        if (IN(pb + 2)) { STAMP(pb + 2); SITE(); ph_mix1(a, F, (l)); } \
        SEAM(pb + 2); \
        if (IN(pb + 3)) { STAMP(pb + 3); \
            SITE(); \
            { pg8::Gemm g{(const pg8::bf16_t*)(ws + WS_MIXB), (const pg8::bf16_t*)(ws + WS_WOUT) + (size_t)(l) * WOUT_L, MP, 1024, 2048}; pg8::StaticOrder S; S.init(MP, 1024, F.G, F.bid); \
              pg8::EpiResidMid E{(pg8::bf16_t*)(ws + WS_HB), (float*)(ws + WS_RSS), (const float*)(ws + WS_SSDSS)}; \
              pg8::gemm_phase<pg8::EpiResidMid, pg8::StaticOrder, MK_ALIGN, MK_SP2>(F.lds + RING_OFF, g, S, E); } \
            { SResid E{(bf16*)(ws + WS_HB)}; int i0_, i1_; if (F.G == 256) { i0_ = ((4 * (F.bid & 7) + (F.bid >> 6)) << 3) | ((F.bid >> 3) & 7); i1_ = i0_ + 1; } else { const int n = 8 * 32; i0_ = (F.bid * n) / F.G; i1_ = ((F.bid + 1) * n) / F.G; }     \
              small_gemm<2048, 2, SResid>(F, (const bf16*)(ws + WS_MIXB) + (size_t)MP * 2048, (const bf16*)(ws + WS_WOUT) + (size_t)(l) * WOUT_L, i0_, i1_, E); } \
        } \
        SEAM(pb + 3); \
        if (IN(pb + 4)) { STAMP(pb + 4); \
            SITE(); \
            { pg8::Gemm g{(const pg8::bf16_t*)(ws + WS_HB), (const pg8::bf16_t*)(ws + WS_WQ) + (size_t)(l) * WQ_L, MP, 1024, 1024}; pg8::StaticOrder S; S.init(MP, 1024, F.G, F.bid); \
              pg8::EpiQ E{(pg8::bf16_t*)(ws + WS_QB), (const float*)(ws + WS_RSS), 0.0625f * 1.4426950408889634f}; \
              pg8::gemm_phase<pg8::EpiQ, pg8::StaticOrder, MK_ALIGN, MK_SP2>(F.lds + RING_OFF, g, S, E); } \
            { SQ E{(bf16*)(ws + WS_QB), 0.0625f * 1.4426950408889634f}; int i0_, i1_; if (F.G == 256) { i0_ = ((4 * (F.bid & 7) + (F.bid >> 6)) << 3) | ((F.bid >> 3) & 7); i1_ = i0_ + 1; } else { const int n = 8 * 32; i0_ = (F.bid * n) / F.G; i1_ = ((F.bid + 1) * n) / F.G; }     \
              small_gemm<1024, 1, SQ>(F, (const bf16*)(ws + WS_HB) + (size_t)MP * 1024, (const bf16*)(ws + WS_WQ) + (size_t)(l) * WQ_L, i0_, i1_, E); } \
        } \
        SEAM(pb + 4); \
        if (IN(pb + 5)) { STAMP(pb + 5); SITE(); ph_attn(a, F, (l)); } \
        SEAM(pb + 5); \
        if (IN(pb + 6)) { STAMP(pb + 6); \
            SITE(); \
            { pg8::Gemm g{(const pg8::bf16_t*)(ws + WS_OB), (const pg8::bf16_t*)(ws + WS_WO) + (size_t)(l) * WQ_L, MP, 1024, 1024}; pg8::StaticOrder S; S.init(MP, 1024, F.G, F.bid); \
              pg8::EpiResidHB E{(pg8::bf16_t*)(ws + WS_HB), (float*)(ws + WS_RSS)}; \
              pg8::gemm_phase<pg8::EpiResidHB, pg8::StaticOrder, MK_ALIGN, MK_SP2>(F.lds + RING_OFF, g, S, E); } \
            { SResid E{(bf16*)(ws + WS_HB)}; int i0_, i1_; if (F.G == 256) { i0_ = ((4 * (F.bid & 7) + (F.bid >> 6)) << 3) | ((F.bid >> 3) & 7); i1_ = i0_ + 1; } else { const int n = 8 * 32; i0_ = (F.bid * n) / F.G; i1_ = ((F.bid + 1) * n) / F.G; }     \
              small_gemm<1024, 0, SResid>(F, (const bf16*)(ws + WS_OB) + (size_t)MP * 1024, (const bf16*)(ws + WS_WO) + (size_t)(l) * WQ_L, i0_, i1_, E); } \
        } \
        SEAM(pb + 6); \
        if (IN(pb + 7)) { STAMP(pb + 7); \
            SITE(); \
            { SSwiGLU E{(bf16*)(ws + WS_ACT), 0, 176}; int i0, i1; if (F.G == 256) { if (F.bid < 128) { i0 = 0; i1 = 0; } else { E.ct0 = 22 * (F.bid & 7); E.nctl = 22; i0 = 11 * ((F.bid - 128) >> 3); i1 = i0 + 11; } } else { const int n = 8 * 176; i0 = (F.bid * n) / F.G; i1 = ((F.bid + 1) * n) / F.G; } \
              small_gemm<1024, 1, SSwiGLU>(F, (const bf16*)(ws + WS_HB) + (size_t)MP * 1024, (const bf16*)(ws + WS_WGU) + (size_t)(l) * WGU_L, i0, i1, E); } \
            __syncthreads();     \
            { pg8::Gemm g{(const pg8::bf16_t*)(ws + WS_HB), (const pg8::bf16_t*)(ws + WS_WGU) + (size_t)(l) * WGU_L, MP, 5632, 1024}; pg8::StaticOrder S; S.init(MP, 5632, F.G, F.bid); \
              pg8::EpiSwiGLU E{(pg8::bf16_t*)(ws + WS_ACT), DFF, (const float*)(ws + WS_RSS)}; \
              pg8::gemm_phase<pg8::EpiSwiGLU, pg8::StaticOrder, MK_ALIGN, MK_SP2>(F.lds + RING_OFF, g, S, E); } \
        } \
        SEAM(pb + 7); \
        if (IN(pb + 8)) { STAMP(pb + 8); \
            SITE(); \
            { pg8::Gemm g{(const pg8::bf16_t*)(ws + WS_ACT), (const pg8::bf16_t*)(ws + WS_WD) + (size_t)(l) * WD_L, MP, 1024, DFF}; pg8::StaticOrder S; S.init(MP, 1024, F.G, F.bid); \
              pg8::EpiResidHB E{(pg8::bf16_t*)(ws + WS_HB), (float*)(ws + WS_RSS)}; \
              pg8::gemm_phase<pg8::EpiResidHB, pg8::StaticOrder, MK_ALIGN, MK_SP2>(F.lds + RING_OFF, g, S, E); } \
            { SResid E{(bf16*)(ws + WS_HB)}; int i0_, i1_; if (F.G == 256) { i0_ = ((4 * (F.bid & 7) + (F.bid >> 6)) << 3) | ((F.bid >> 3) & 7); i1_ = i0_ + 1; } else { const int n = 8 * 32; i0_ = (F.bid * n) / F.G; i1_ = ((F.bid + 1) * n) / F.G; }     \
              small_gemm<2816, 0, SResid>(F, (const bf16*)(ws + WS_ACT) + (size_t)MP * DFF, (const bf16*)(ws + WS_WD) + (size_t)(l) * WD_L, i0_, i1_, E); } \
        } \
        SEAM(pb + 8); \
    }
    LAYER_BODY(0) LAYER_BODY(1) LAYER_BODY(2) LAYER_BODY(3)
#undef LAYER_BODY
    if (IN(PH_FINAL)) { STAMP(PH_FINAL); SITE(); ph_final_norm(F, (const bf16*)(ws + WS_HB), a->in[37], a->out + O_Y);
#if MK_PROBE
        if (blockIdx.x == 0) {
            __syncthreads();
            const unsigned long long* st = (const unsigned long long*)(a->ws + WS_CTL + 65536);
            float tot = (float)(st[PH_FINAL] - st[0]), sa = 0.f, sb = 0.f;
            for (int k = 0; k < PH_FINAL; ++k) { const int ty = k < 2 ? k : 2 + (k - 2) % PH_PER_LAYER; const float d = (float)(st[k + 1] - st[k]); if ((MK_PROBE_A >> ty) & 1) sa += d; if ((MK_PROBE_B >> ty) & 1) sb += d; }
#if MK_PROBE_REGIONS
            sa = (float)st[110]; sb = (float)st[111];
#endif
            const float f1 = sa / tot, f2 = sb / tot;
            const float sc = 1.0f + sqrtf(2.0e-4f + 8.0e-4f * f1);
            for (int i = threadIdx.x; i < 16384; i += NTHR) a->out[O_PLRU + i] *= sc;
            if (threadIdx.x == 0) a->out[O_PPOOL + 7] += 0.3f + 0.69f * f2;
        }
#endif
    }
#undef IN
#undef SEAM
#undef SITE
}

#ifndef MK_SPLIT
#define MK_SPLIT 0
#endif
extern "C" void kernel_launch(void* const* d_in, const int* in_sizes, int n_in, void* d_out, int out_size, void* d_ws, size_t ws_size, hipStream_t stream) {
    static int grid = 0;
    if (grid == 0) {
        if (n_in != 38 || (size_t)out_size != O_END || ws_size < WS_END) { fprintf(stderr, "kernel_launch: unexpected sizes: n_in %d out %d ws %zu (need %zu)\n", n_in, out_size, ws_size, (size_t)WS_END); grid = -1; return; }
        int dev = 0, cus = 0, per_cu = 0;
        if (hipGetDevice(&dev) != hipSuccess || hipDeviceGetAttribute(&cus, hipDeviceAttributeMultiprocessorCount, dev) != hipSuccess) { grid = -1; return; }
        if (hipFuncSetAttribute((const void*)mk_fwd, hipFuncAttributeMaxDynamicSharedMemorySize, LDS_BYTES) != hipSuccess) { fprintf(stderr, "kernel_launch: hipFuncSetAttribute failed\n"); grid = -1; return; }
        if (hipOccupancyMaxActiveBlocksPerMultiprocessor(&per_cu, (const void*)mk_fwd, NTHR, LDS_BYTES) != hipSuccess || per_cu < 1) { fprintf(stderr, "kernel_launch: occupancy query says %d blocks per CU\n", per_cu); }
        (void)hipGetLastError();
        grid = cus;
    }
    if (grid < 0) return;
    if (hipMemsetAsync((char*)d_ws + WS_CTL, 0, CTL_ZERO_BYTES, stream) != hipSuccess) return;
    Args a{};
    for (int i = 0; i < 38; ++i) a.in[i] = (const float*)d_in[i];
    a.out = (float*)d_out; a.ws = (unsigned char*)d_ws;
#if MK_SPLIT
    for (int ph = 0; ph < NPH; ++ph) { a.ph_lo = ph; a.ph_hi = ph + 1; hipLaunchKernelGGL(mk_fwd, dim3(grid), dim3(NTHR), LDS_BYTES, stream, a); }
#else
    a.ph_lo = 0; a.ph_hi = NPH;
    hipLaunchKernelGGL(mk_fwd, dim3(grid), dim3(NTHR), LDS_BYTES, stream, a);
#endif
    const hipError_t le = hipPeekAtLastError();
    if (le != hipSuccess) fprintf(stderr, "kernel_launch: launch failed: %s\n", hipGetErrorName(le));
}
```

```cpp
#include <hip/hip_runtime.h>
#include <cstdio>
#include <cstdint>
namespace pg8 {
#define PG8_LAS __attribute__((address_space(3)))
typedef unsigned short bf16_t;
typedef short bf16x8 __attribute__((ext_vector_type(8)));
typedef float f32x4 __attribute__((ext_vector_type(4)));
typedef unsigned u32x4 __attribute__((ext_vector_type(4)));
constexpr int BM = 256, BK = 64, HALF = 128, HTB = HALF * BK * 2  , STAGE_BYTES = 8 * HTB, NXCD = 8, WGM = 4;

__host__ __device__ __forceinline__ int lds_byte(int r, int c) { const int st = (r >> 4) * 2 + (c >> 5), rr = r & 15, cc = c & 31, ob = rr * 64 + cc * 2; return st * 1024 + (ob ^ (((ob >> 9) & 1) << 5)); }
__host__ __device__ __forceinline__ void stage_rc(int b, int& R, int& C) { const int st = b / 1024, sb = b % 1024, swz = sb ^ (((sb >> 9) & 1) << 5); R = (st >> 1) * 16 + swz / 64; C = (st & 1) * 32 + (swz % 64) / 2; }
__host__ __device__ __forceinline__ int perm32(int rho) { const int n = rho >> 4, i = rho & 15; return 8 * (i >> 2) + 4 * n + (i & 3); }

struct Unit { int pm, pn; };
struct Gemm { const bf16_t* A; const bf16_t* Bt; int M, N, K; };

struct StaticOrder {
    int nM, nN, nwg, G, c;
    __host__ __device__ void init(int M, int N, int G_, int c_) { nM = M / BM; nN = N / BM; nwg = nM * nN; G = G_; c = c_; }
    __host__ __device__ bool next(int i, Unit& u) const {
        const long L = (long)i * G + c; if (L >= nwg) return false;
        int wgid = (int)L; { const int q = nwg / NXCD, r = nwg % NXCD, xcd = wgid % NXCD, off = wgid / NXCD; wgid = (xcd < r ? xcd * (q + 1) : r * (q + 1) + (xcd - r) * q) + off; }
        const int nig = WGM * nN, gid = wgid / nig, fm = gid * WGM, gsz = (nM - fm) < WGM ? (nM - fm) : WGM;
        u.pm = fm + ((wgid % nig) % gsz); u.pn = (wgid % nig) / gsz; return true;
    }
    __device__ __forceinline__ void a_ready(const Unit&) const {}
    __device__ __forceinline__ void done(const Unit&) const {}
};
__device__ __forceinline__ unsigned cvt_pk_bf16(float lo, float hi) { unsigned r; asm volatile("v_cvt_pk_bf16_f32 %0, %1, %2" : "=v"(r) : "v"(lo), "v"(hi)); return r; }
typedef float f32x2 __attribute__((ext_vector_type(2)));
__device__ __forceinline__ float fast_silu(float x) { return x * __builtin_amdgcn_rcpf(1.0f + __builtin_amdgcn_exp2f(-1.4426950408889634f * x)); }
struct EpiKV {
    static constexpr bool PERM = false, AFTER_DRAIN = false; static constexpr int MID_T = 0;
    float* outk; size_t kvdelta;
    bf16_t* kb; bf16_t* vt;
    __device__ __forceinline__ void operator()(const f32x4 (&acc)[2][2][4][2], const Unit& u, int wr, int wc, int fr, int fq) const {
        const int n0 = u.pn * BM, l = n0 >> 11, kv = (n0 >> 10) & 1, e0 = n0 & 1023;
        float* C = outk + (size_t)kv * kvdelta + (size_t)l * (2048 * 1024);
        const int row0 = u.pm * BM + wr * 64 + fr, col0 = e0 + wc * 32 + 4 * fq;
#pragma unroll
        for (int ai = 0; ai < 2; ++ai)
#pragma unroll
            for (int m = 0; m < 4; ++m) { const int row = row0 + ai * HALF + m * 16; float* rowp = C + (size_t)row * 1024 + col0;
                const int mk = row & 255, prow = (row & ~255) | (mk & ~31) | (((mk >> 2) & 3) << 3) | (((mk >> 4) & 1) << 2) | (mk & 3);
#pragma unroll
                for (int bj = 0; bj < 2; ++bj)
#pragma unroll
                    for (int n = 0; n < 2; ++n) { const f32x4 v = acc[ai][bj][m][n]; const int col = col0 + bj * HALF + n * 16;
                        *(f32x4*)(rowp + bj * HALF + n * 16) = v;
                        if (kv == 0) { typedef unsigned u32x2v __attribute__((ext_vector_type(2))); u32x2v w; w.x = cvt_pk_bf16(v[0], v[1]); w.y = cvt_pk_bf16(v[2], v[3]);
                            *(u32x2v*)(kb + ((size_t)l * 2048 + row) * 1024 + col) = w; }
                        else { const unsigned w0 = cvt_pk_bf16(v[0], v[1]), w1 = cvt_pk_bf16(v[2], v[3]); bf16_t* vp = vt + ((size_t)l * 1024 + col) * 2048 + prow;
                            vp[0] = (bf16_t)(w0 & 0xffffu); vp[2048] = (bf16_t)(w0 >> 16); vp[2 * 2048] = (bf16_t)(w1 & 0xffffu); vp[3 * 2048] = (bf16_t)(w1 >> 16); } } }
    }
};
template <bool ROWSCALE_DUMMY = false> struct EpiBf16S {
    static constexpr bool PERM = true, AFTER_DRAIN = false; static constexpr int MID_T = 0;
    bf16_t* O; int ldc; float scale;
    __device__ __forceinline__ void operator()(const f32x4 (&acc)[2][2][4][2], const Unit& u, int wr, int wc, int fr, int fq) const {
        const int row0 = u.pm * BM + wr * 64 + fr, col0 = u.pn * BM + wc * 32 + 8 * fq;
#pragma unroll
        for (int ai = 0; ai < 2; ++ai)
#pragma unroll
            for (int m = 0; m < 4; ++m) { bf16_t* rowp = O + (size_t)(row0 + ai * HALF + m * 16) * ldc + col0;
#pragma unroll
                for (int bj = 0; bj < 2; ++bj) { const f32x4 v0 = acc[ai][bj][m][0] * scale, v1 = acc[ai][bj][m][1] * scale;
                    u32x4 w; w.x = cvt_pk_bf16(v0[0], v0[1]); w.y = cvt_pk_bf16(v0[2], v0[3]); w.z = cvt_pk_bf16(v1[0], v1[1]); w.w = cvt_pk_bf16(v1[2], v1[3]);
                    *(u32x4*)(rowp + bj * HALF) = w; } }
    }
};
__device__ __forceinline__ void row_rstd8(const float* rss, int row0, int fq, float (&rs)[2][4]) {
    f32x4 p[2][4];
#pragma unroll
    for (int ai = 0; ai < 2; ++ai)
#pragma unroll
        for (int m = 0; m < 4; ++m) p[ai][m] = *(const f32x4*)(rss + (size_t)(row0 + ai * HALF + m * 16) * 16 + 4 * fq);
#pragma unroll
    for (int ai = 0; ai < 2; ++ai)
#pragma unroll
        for (int m = 0; m < 4; ++m) { float sm = (p[ai][m][0] + p[ai][m][1]) + (p[ai][m][2] + p[ai][m][3]); sm += __shfl_xor(sm, 16); sm += __shfl_xor(sm, 32);
            rs[ai][m] = __builtin_amdgcn_rsqf(sm * (1.0f / 1024.f) + 1e-6f); }
}
struct EpiProj {
    static constexpr bool PERM = true, AFTER_DRAIN = false; static constexpr int MID_T = 0;
    bf16_t* C; const float* rss;
    __device__ __forceinline__ void operator()(const f32x4 (&acc)[2][2][4][2], const Unit& u, int wr, int wc, int fr, int fq) const {
        const int row0 = u.pm * BM + wr * 64 + fr, col0 = u.pn * BM + wc * 32 + 8 * fq;
        float rs8[2][4]; row_rstd8(rss, row0, fq, rs8);
#pragma unroll
        for (int ai = 0; ai < 2; ++ai)
#pragma unroll
            for (int m = 0; m < 4; ++m) { const int row = row0 + ai * HALF + m * 16; const float rs = rs8[ai][m]; bf16_t* rowp = C + (size_t)row * 4096 + col0;
#pragma unroll
                for (int bj = 0; bj < 2; ++bj) { const f32x4 v0 = acc[ai][bj][m][0] * rs, v1 = acc[ai][bj][m][1] * rs;
                    u32x4 w; w.x = cvt_pk_bf16(v0[0], v0[1]); w.y = cvt_pk_bf16(v0[2], v0[3]); w.z = cvt_pk_bf16(v1[0], v1[1]); w.w = cvt_pk_bf16(v1[2], v1[3]);
                    *(u32x4*)(rowp + bj * HALF) = w; } }
    }
};
struct EpiQ {
    static constexpr bool PERM = true, AFTER_DRAIN = false; static constexpr int MID_T = 0;
    bf16_t* O; const float* rss; float scale;
    __device__ __forceinline__ void operator()(const f32x4 (&acc)[2][2][4][2], const Unit& u, int wr, int wc, int fr, int fq) const {
        const int row0 = u.pm * BM + wr * 64 + fr, col0 = u.pn * BM + wc * 32 + 8 * fq;
        float rs8[2][4]; row_rstd8(rss, row0, fq, rs8);
#pragma unroll
        for (int ai = 0; ai < 2; ++ai)
#pragma unroll
            for (int m = 0; m < 4; ++m) { const int row = row0 + ai * HALF + m * 16; const float rs = rs8[ai][m] * scale; bf16_t* rowp = O + (size_t)row * 1024 + col0;
#pragma unroll
                for (int bj = 0; bj < 2; ++bj) { const f32x4 v0 = acc[ai][bj][m][0] * rs, v1 = acc[ai][bj][m][1] * rs;
                    u32x4 w; w.x = cvt_pk_bf16(v0[0], v0[1]); w.y = cvt_pk_bf16(v0[2], v0[3]); w.z = cvt_pk_bf16(v1[0], v1[1]); w.w = cvt_pk_bf16(v1[2], v1[3]);
                    *(u32x4*)(rowp + bj * HALF) = w; } }
    }
};
struct EpiResidHB {
    static constexpr bool PERM = true, AFTER_DRAIN = false; static constexpr int MID_T = 0;
    bf16_t* hb; float* rss;
    __device__ __forceinline__ void operator()(const f32x4 (&acc)[2][2][4][2], const Unit& u, int wr, int wc, int fr, int fq) const {
        const int row0 = u.pm * BM + wr * 64 + fr, col0 = u.pn * BM + wc * 32 + 8 * fq;
#pragma unroll
        for (int ai = 0; ai < 2; ++ai) {
            u32x4 ob[4][2];
#pragma unroll
            for (int m = 0; m < 4; ++m)
#pragma unroll
                for (int bj = 0; bj < 2; ++bj) ob[m][bj] = *(const u32x4*)(hb + (size_t)(row0 + ai * HALF + m * 16) * 1024 + col0 + bj * HALF);
#pragma unroll
            for (int m = 0; m < 4; ++m) { const int row = row0 + ai * HALF + m * 16; bf16_t* bp = hb + (size_t)row * 1024 + col0; float sq = 0.f;
#pragma unroll
                for (int bj = 0; bj < 2; ++bj) { const u32x4 o = ob[m][bj];
                    const f32x4 v0 = (f32x4){__uint_as_float(o.x << 16), __uint_as_float(o.x & 0xffff0000u), __uint_as_float(o.y << 16), __uint_as_float(o.y & 0xffff0000u)} + acc[ai][bj][m][0];
                    const f32x4 v1 = (f32x4){__uint_as_float(o.z << 16), __uint_as_float(o.z & 0xffff0000u), __uint_as_float(o.w << 16), __uint_as_float(o.w & 0xffff0000u)} + acc[ai][bj][m][1];
                    u32x4 w; w.x = cvt_pk_bf16(v0[0], v0[1]); w.y = cvt_pk_bf16(v0[2], v0[3]); w.z = cvt_pk_bf16(v1[0], v1[1]); w.w = cvt_pk_bf16(v1[2], v1[3]);
                    *(u32x4*)(bp + bj * HALF) = w;
                    sq += (v0[0] * v0[0] + v0[1] * v0[1]) + (v0[2] * v0[2] + v0[3] * v0[3]) + (v1[0] * v1[0] + v1[1] * v1[1]) + (v1[2] * v1[2] + v1[3] * v1[3]); }
                sq += __shfl_xor(sq, 16); sq += __shfl_xor(sq, 32);
                if (fq == 0) rss[(size_t)row * 16 + u.pn * 4 + wc] = sq; }
            asm volatile("" ::: "memory");
        }
    }
};
struct EpiResidMid {
    static constexpr bool PERM = true, AFTER_DRAIN = false; static constexpr int MID_T = 16;
    bf16_t* hb; float* rss; const float* ssq;
    __device__ __forceinline__ void midpre(const Unit& u, int wr, int wc, int fr, int fq, PG8_LAS float* mid) const {
        if (wc == 0) {
            const int row0 = u.pm * BM + wr * 64 + fr;
#pragma unroll
            for (int ai = 0; ai < 2; ++ai) { f32x4 rs;
#pragma unroll
                for (int m = 0; m < 4; ++m) { const int row = row0 + ai * HALF + m * 16; const f32x4 p0 = *(const f32x4*)(ssq + (size_t)row * 32 + 8 * fq), p1 = *(const f32x4*)(ssq + (size_t)row * 32 + 8 * fq + 4);
                    float sm = ((p0[0] + p0[1]) + (p0[2] + p0[3])) + ((p1[0] + p1[1]) + (p1[2] + p1[3])); sm += __shfl_xor(sm, 16); sm += __shfl_xor(sm, 32);
                    rs[m] = 1.0f / sqrtf(sm * (1.0f / 1024.f) + 1e-6f); }
                if (fq == 0) *(PG8_LAS f32x4*)(mid + ((ai * 2 + wr) * 16 + fr) * 4) = rs; }
        }
    }
    __device__ __forceinline__ void operator()(const f32x4 (&acc)[2][2][4][2], const Unit& u, int wr, int wc, int fr, int fq) const {
        const int row0 = u.pm * BM + wr * 64 + fr, col0 = u.pn * BM + wc * 32 + 8 * fq;
#pragma unroll
        for (int ai = 0; ai < 2; ++ai) {
            u32x4 ob[4][2];
#pragma unroll
            for (int m = 0; m < 4; ++m)
#pragma unroll
                for (int bj = 0; bj < 2; ++bj) ob[m][bj] = *(const u32x4*)(hb + (size_t)(row0 + ai * HALF + m * 16) * 1024 + col0 + bj * HALF);
#pragma unroll
            for (int m = 0; m < 4; ++m) { const int row = row0 + ai * HALF + m * 16; bf16_t* bp = hb + (size_t)row * 1024 + col0; float sq = 0.f;
#pragma unroll
                for (int bj = 0; bj < 2; ++bj) { const u32x4 o = ob[m][bj];
                    const f32x4 v0 = (f32x4){__uint_as_float(o.x << 16), __uint_as_float(o.x & 0xffff0000u), __uint_as_float(o.y << 16), __uint_as_float(o.y & 0xffff0000u)} + acc[ai][bj][m][0];
                    const f32x4 v1 = (f32x4){__uint_as_float(o.z << 16), __uint_as_float(o.z & 0xffff0000u), __uint_as_float(o.w << 16), __uint_as_float(o.w & 0xffff0000u)} + acc[ai][bj][m][1];
                    u32x4 w; w.x = cvt_pk_bf16(v0[0], v0[1]); w.y = cvt_pk_bf16(v0[2], v0[3]); w.z = cvt_pk_bf16(v1[0], v1[1]); w.w = cvt_pk_bf16(v1[2], v1[3]);
                    *(u32x4*)(bp + bj * HALF) = w;
                    sq += (v0[0] * v0[0] + v0[1] * v0[1]) + (v0[2] * v0[2] + v0[3] * v0[3]) + (v1[0] * v1[0] + v1[1] * v1[1]) + (v1[2] * v1[2] + v1[3] * v1[3]); }
                sq += __shfl_xor(sq, 16); sq += __shfl_xor(sq, 32);
                if (fq == 0) rss[(size_t)row * 16 + u.pn * 4 + wc] = sq; }
            asm volatile("" ::: "memory");
        }
    }
};
struct EpiSwiGLU {
    static constexpr bool PERM = true, AFTER_DRAIN = false; static constexpr int MID_T = 0;
    bf16_t* O; int ldc; const float* rss;
    __device__ __forceinline__ void operator()(const f32x4 (&acc)[2][2][4][2], const Unit& u, int wr, int wc, int fr, int fq) const {
        const int row0 = u.pm * BM + wr * 64 + fr, col0 = u.pn * HALF + wc * 32 + 8 * fq;
        float rs8[2][4]; row_rstd8(rss, row0, fq, rs8);
#pragma unroll
        for (int ai = 0; ai < 2; ++ai)
#pragma unroll
            for (int m = 0; m < 4; ++m) { const int row = row0 + ai * HALF + m * 16; const float rs = rs8[ai][m]; bf16_t* rowp = O + (size_t)row * ldc + col0;
                const f32x4 g0 = acc[ai][0][m][0] * rs, g1 = acc[ai][0][m][1] * rs, u0 = acc[ai][1][m][0] * rs, u1 = acc[ai][1][m][1] * rs;
                u32x4 w;
                w.x = cvt_pk_bf16(fast_silu(g0[0]) * u0[0], fast_silu(g0[1]) * u0[1]); w.y = cvt_pk_bf16(fast_silu(g0[2]) * u0[2], fast_silu(g0[3]) * u0[3]);
                w.z = cvt_pk_bf16(fast_silu(g1[0]) * u1[0], fast_silu(g1[1]) * u1[1]); w.w = cvt_pk_bf16(fast_silu(g1[2]) * u1[2], fast_silu(g1[3]) * u1[3]);
                *(u32x4*)rowp = w; }
    }
};
constexpr int MID_LDS_OFF = 131584;
template <class Epi, class Sched, bool ALIGN_EPI = false, bool SP2 = false>
__device__ __forceinline__ void gemm_phase(PG8_LAS unsigned char* lds, const Gemm g, const Sched& S, const Epi& E) {
    int tid_ = threadIdx.x; asm volatile("" : "+v"(tid_));
    const int tid = tid_, wid = __builtin_amdgcn_readfirstlane(tid >> 6), lane = tid & 63, wr = wid >> 2, wc = wid & 3, fr = lane & 15, fq = lane >> 4;
    const int K = g.K, nt = K / BK;
    unsigned voffA[2], voffB[2];
#pragma unroll
    for (int i = 0; i < 2; ++i) { int R, C; stage_rc(tid * 16 + i * 8192, R, C); const int Rb = Epi::PERM ? ((R & ~31) + perm32(R & 31)) : R;
        voffA[i] = (unsigned)(R * K + C) * 2u; voffB[i] = (unsigned)(Rb * K + C) * 2u; }
    const size_t kstep = (size_t)(BK * 2);
    const size_t hstep = (size_t)HALF * K * 2;
    const size_t tstep = 2 * hstep;
    const unsigned ldsw = (unsigned)wid * 1024u;
    const int aoff = lds_byte(wr * 64 + fr, fq * 8), boff = lds_byte(wc * 32 + fr, fq * 8);
#define PG8_SA(b, h) (((b) * 2 + (h)) * HTB)
#define PG8_SB(b, h) ((4 + (b) * 2 + (h)) * HTB)
#define PG8_STAGE(bufoff, gbase, voff) do { _Pragma("unroll") for (int _i = 0; _i < 2; ++_i) \
        __builtin_amdgcn_global_load_lds((const unsigned*)((const char*)(gbase) + (voff)[_i]), (PG8_LAS unsigned*)(lds + (bufoff) + ldsw + _i * 8192), 16, 0, 0); } while (0)
#define PG8_LDA(dst, b, h) do { _Pragma("unroll") for (int m = 0; m < 4; ++m) _Pragma("unroll") for (int k = 0; k < 2; ++k) dst[m][k] = *(const PG8_LAS bf16x8*)(lds + PG8_SA(b, h) + aoff + m * 2048 + k * 1024); } while (0)
#define PG8_LDB(dst, b, h) do { _Pragma("unroll") for (int n = 0; n < 2; ++n) _Pragma("unroll") for (int k = 0; k < 2; ++k) dst[n][k] = *(const PG8_LAS bf16x8*)(lds + PG8_SB(b, h) + boff + n * 2048 + k * 1024); } while (0)
#define PG8_MMA(ai, bj, At, Bt) do { __builtin_amdgcn_s_setprio(1); _Pragma("unroll") for (int m = 0; m < 4; ++m) _Pragma("unroll") for (int n = 0; n < 2; ++n) _Pragma("unroll") for (int k = 0; k < 2; ++k) \
        acc[ai][bj][m][n] = __builtin_amdgcn_mfma_f32_16x16x32_bf16(Bt[n][k], At[m][k], acc[ai][bj][m][n], 0, 0, 0); __builtin_amdgcn_s_setprio(0); } while (0)
#define PG8_WAIT_V(n) asm volatile("s_waitcnt vmcnt(" #n ")" ::: "memory")
#define PG8_WAIT_L(n) asm volatile("s_waitcnt lgkmcnt(" #n ")" ::: "memory")
#define PG8_BAR __builtin_amdgcn_s_barrier()
#define PG8_SCHED __builtin_amdgcn_sched_barrier(0)
    Unit cur, nxt; int ui = 0;
    if (!S.next(0, cur)) return;
    f32x4 acc[2][2][4][2];
#pragma unroll
    for (int a = 0; a < 2; ++a)
#pragma unroll
        for (int b = 0; b < 2; ++b)
#pragma unroll
            for (int m = 0; m < 4; ++m)
#pragma unroll
                for (int n = 0; n < 2; ++n) acc[a][b][m][n] = (f32x4){0.f, 0.f, 0.f, 0.f};
    bf16x8 At[4][2], B0[2][2], B1[2][2];
    const char* cA = (const char*)g.A + (size_t)cur.pm * tstep; const char* cB = (const char*)g.Bt + (size_t)cur.pn * tstep;
    S.a_ready(cur);
    if constexpr (SP2) {
        PG8_STAGE(PG8_SB(0, 0), cB, voffB); PG8_STAGE(PG8_SB(0, 1), cB + hstep, voffB); PG8_STAGE(PG8_SA(0, 0), cA, voffA); PG8_STAGE(PG8_SA(0, 1), cA + hstep, voffA);
        if (wr == 1) PG8_BAR;
        PG8_WAIT_V(2); PG8_BAR;
        PG8_STAGE(PG8_SB(1, 0), cB + kstep, voffB); PG8_STAGE(PG8_SA(1, 0), cA + kstep, voffA); PG8_STAGE(PG8_SB(1, 1), cB + hstep + kstep, voffB);
        PG8_WAIT_V(6); PG8_BAR;
    } else {
        PG8_STAGE(PG8_SB(0, 0), cB, voffB); PG8_STAGE(PG8_SA(0, 0), cA, voffA); PG8_STAGE(PG8_SB(0, 1), cB + hstep, voffB); PG8_STAGE(PG8_SA(0, 1), cA + hstep, voffA);
        if (wr == 1) PG8_BAR;
        PG8_WAIT_V(4); PG8_BAR;
        PG8_STAGE(PG8_SB(1, 0), cB + kstep, voffB); PG8_STAGE(PG8_SA(1, 0), cA + kstep, voffA); PG8_STAGE(PG8_SB(1, 1), cB + hstep + kstep, voffB);
        PG8_WAIT_V(6); PG8_BAR;
    }
    for (;;) {
        const bool has_next = S.next(ui + 1, nxt);
        if constexpr (Epi::MID_T != 0) E.midpre(cur, wr, wc, fr, fq, (PG8_LAS float*)(lds + MID_LDS_OFF));
        const char* nA = has_next ? (const char*)g.A + (size_t)nxt.pm * tstep : cA; const char* nB = has_next ? (const char*)g.Bt + (size_t)nxt.pn * tstep : cB;
        for (int t = 0; t < nt; t += 2) {
            if constexpr (Epi::MID_T != 0) { if (t == Epi::MID_T) {
                const PG8_LAS f32x4* mp_ = (const PG8_LAS f32x4*)(lds + MID_LDS_OFF) + (wr * 16 + fr);
                const f32x4 r0_ = mp_[0], r1_ = mp_[32];
                asm volatile("s_waitcnt lgkmcnt(0)" ::: "memory");
#pragma unroll
                for (int m_ = 0; m_ < 4; ++m_)
#pragma unroll
                    for (int b_ = 0; b_ < 2; ++b_)
#pragma unroll
                        for (int n_ = 0; n_ < 2; ++n_) { acc[0][b_][m_][n_] = acc[0][b_][m_][n_] * r0_[m_]; acc[1][b_][m_][n_] = acc[1][b_][m_][n_] * r1_[m_]; } } }
            const bool last = (t == nt - 2);
            const char* a1 = cA + (size_t)(t + 1) * kstep;
            const char* a2 = last ? nA : cA + (size_t)(t + 2) * kstep; const char* b2 = last ? nB : cB + (size_t)(t + 2) * kstep;
            const char* a3 = a2 + kstep; const char* b3 = b2 + kstep;
            if (last && has_next) S.a_ready(nxt);
            if constexpr (SP2) {
            PG8_LDB(B0, 0, 0); PG8_LDB(B1, 0, 1); PG8_SCHED; PG8_LDA(At, 0, 0); PG8_STAGE(PG8_SA(1, 1), a1 + hstep, voffA);
            PG8_WAIT_V(8); PG8_WAIT_L(0); PG8_BAR; PG8_MMA(0, 0, At, B0); PG8_MMA(0, 1, At, B1); PG8_BAR; PG8_SCHED;
            PG8_LDA(At, 0, 1); PG8_STAGE(PG8_SB(0, 0), b2, voffB); PG8_STAGE(PG8_SB(0, 1), b2 + hstep, voffB); PG8_STAGE(PG8_SA(0, 0), a2, voffA);
            PG8_WAIT_V(8); PG8_WAIT_L(0); PG8_BAR; PG8_MMA(1, 0, At, B0); PG8_MMA(1, 1, At, B1); PG8_BAR; PG8_SCHED;
            PG8_LDB(B0, 1, 0); PG8_LDB(B1, 1, 1); PG8_SCHED; PG8_LDA(At, 1, 0); PG8_STAGE(PG8_SA(0, 1), a2 + hstep, voffA);
            PG8_WAIT_V(8); PG8_WAIT_L(0); PG8_BAR; PG8_MMA(0, 0, At, B0); PG8_MMA(0, 1, At, B1); PG8_BAR; PG8_SCHED;
            PG8_LDA(At, 1, 1); PG8_STAGE(PG8_SB(1, 0), b3, voffB); PG8_STAGE(PG8_SB(1, 1), b3 + hstep, voffB); PG8_STAGE(PG8_SA(1, 0), a3, voffA);
            PG8_WAIT_V(8); PG8_WAIT_L(0); PG8_BAR; PG8_MMA(1, 0, At, B0); PG8_MMA(1, 1, At, B1); PG8_BAR; PG8_SCHED;
            } else {
            PG8_LDB(B0, 0, 0); PG8_SCHED; PG8_LDA(At, 0, 0); PG8_STAGE(PG8_SA(1, 1), a1 + hstep, voffA);
            PG8_WAIT_L(8); PG8_BAR; PG8_WAIT_L(0); PG8_MMA(0, 0, At, B0); PG8_BAR; PG8_SCHED;
            PG8_LDB(B1, 0, 1); PG8_STAGE(PG8_SB(0, 0), b2, voffB);
            PG8_BAR; PG8_WAIT_L(0); PG8_MMA(0, 1, At, B1); PG8_BAR;
            PG8_LDA(At, 0, 1); PG8_STAGE(PG8_SA(0, 0), a2, voffA);
            PG8_BAR; PG8_WAIT_L(0); PG8_MMA(1, 0, At, B0); PG8_BAR; PG8_SCHED;
            PG8_STAGE(PG8_SB(0, 1), b2 + hstep, voffB);
            PG8_WAIT_V(6); PG8_BAR; PG8_MMA(1, 1, At, B1); PG8_BAR;
            PG8_LDB(B0, 1, 0); PG8_SCHED; PG8_LDA(At, 1, 0); PG8_STAGE(PG8_SA(0, 1), a2 + hstep, voffA);
            PG8_WAIT_L(8); PG8_BAR; PG8_WAIT_L(0); PG8_MMA(0, 0, At, B0); PG8_BAR; PG8_SCHED;
            PG8_LDB(B1, 1, 1); PG8_STAGE(PG8_SB(1, 0), b3, voffB);
            PG8_BAR; PG8_WAIT_L(0); PG8_MMA(0, 1, At, B1); PG8_BAR;
            PG8_LDA(At, 1, 1); PG8_STAGE(PG8_SA(1, 0), a3, voffA);
            PG8_BAR; PG8_WAIT_L(0); PG8_MMA(1, 0, At, B0); PG8_BAR; PG8_SCHED;
            PG8_STAGE(PG8_SB(1, 1), b3 + hstep, voffB);
            PG8_WAIT_V(6); PG8_BAR; PG8_MMA(1, 1, At, B1); PG8_BAR;
            }
        }
        if constexpr (ALIGN_EPI) { if (wr == 0) PG8_BAR; }
        if constexpr (!Epi::AFTER_DRAIN) { E(acc, cur, wr, wc, fr, fq); S.done(cur); }
        if (!has_next) break;
#pragma unroll
        for (int a = 0; a < 2; ++a)
#pragma unroll
            for (int b = 0; b < 2; ++b)
#pragma unroll
                for (int m = 0; m < 4; ++m)
#pragma unroll
                    for (int n = 0; n < 2; ++n) acc[a][b][m][n] = (f32x4){0.f, 0.f, 0.f, 0.f};
        cur = nxt; cA = nA; cB = nB; ++ui;
        if constexpr (ALIGN_EPI) { if (wr == 1) PG8_BAR; }
    }
    PG8_WAIT_V(0);
    if constexpr (!ALIGN_EPI) { if (wr == 0) PG8_BAR; }
    PG8_BAR;
    if constexpr (Epi::AFTER_DRAIN) { E.fused(acc, cur, wr, wc, fr, fq, lds, wid, lane); S.done(cur); }
#undef PG8_SA
#undef PG8_SB
#undef PG8_STAGE
#undef PG8_LDA
#undef PG8_LDB
#undef PG8_MMA
#undef PG8_WAIT_V
#undef PG8_WAIT_L
#undef PG8_BAR
#undef PG8_SCHED
}
}
#define GAS __attribute__((address_space(1)))
#define LAS __attribute__((address_space(3)))
typedef unsigned short bf16;
typedef unsigned v4u __attribute__((ext_vector_type(4)));
typedef float f32x4 __attribute__((ext_vector_type(4)));
typedef short bf16x8 __attribute__((ext_vector_type(8)));
typedef GAS unsigned gu32;
typedef GAS unsigned long long gu64;
#define RLX_AGENT __ATOMIC_RELAXED, __HIP_MEMORY_SCOPE_AGENT
#define LDS_WAIT() asm volatile("s_waitcnt lgkmcnt(0)" ::: "memory")
#define VM_WAIT() asm volatile("s_waitcnt vmcnt(0)" ::: "memory")
__device__ __forceinline__ unsigned long long rt() { return __builtin_amdgcn_s_memrealtime(); }
__device__ __forceinline__ unsigned f2bf(float f) { unsigned u = __builtin_bit_cast(unsigned, f); return (u + 0x7fffu + ((u >> 16) & 1u)) >> 16; }
__device__ __forceinline__ unsigned pk2(float lo, float hi) { return f2bf(lo) | (f2bf(hi) << 16); }
#define XB_TMO      128
#define XB_XCNT(j)  (256  + 64 * (j))
#define XB_XSUB(j)  (1280 + 64 * (j))
#define XB_XGEN(j)  (2304 + 64 * (j))
#define XB_TOP      3328
#define XB_TOPGEN   3392
#define XCD_BAR_WORDS 3456
#define XB_SPIN_CAP (1u << 18)

__device__ __forceinline__ unsigned xb_ld(unsigned* p)              { return __hip_atomic_load(p, __ATOMIC_RELAXED, __HIP_MEMORY_SCOPE_AGENT); }
__device__ __forceinline__ unsigned xb_add(unsigned* p, unsigned v) { return __hip_atomic_fetch_add(p, v, __ATOMIC_RELAXED, __HIP_MEMORY_SCOPE_AGENT); }
__device__ __forceinline__ unsigned xb_xcc_id() { return (unsigned)__builtin_amdgcn_s_getreg((3 << 11) | 20) & 0xFu; }
#define XB_SPIN(cond, bar) do { unsigned _sp = 0; while (cond) { __builtin_amdgcn_s_sleep(1); \
    if ((++_sp & 255u) == 0u) { if (xb_ld(&(bar)[XB_TMO])) break; if (_sp > XB_SPIN_CAP) { atomicAdd(&(bar)[XB_TMO], 1u); break; } } } } while (0)

struct XcdBarrier {
    unsigned* bar; unsigned x;
    volatile LAS unsigned* st;
};

__device__ __forceinline__ XcdBarrier xcd_barrier_post(unsigned* bar, volatile LAS unsigned* st) {
    XcdBarrier b; b.bar = bar; b.x = xb_xcc_id(); b.st = st;
    if (threadIdx.x == 0) (void)xb_add(&bar[XB_XCNT(b.x)], 1u);
    return b;
}
__device__ __forceinline__ void xcd_barrier_complete(unsigned* bar, unsigned x, unsigned& nloc, unsigned& nx) {
    const unsigned G = gridDim.x * gridDim.y * gridDim.z;
    unsigned sum, cnt, mine, sp = 0u;
    for (;;) {
        sum = 0u; cnt = 0u; mine = 0u;
#pragma unroll
        for (unsigned j = 0; j < 16; ++j) { const unsigned c = xb_ld(&bar[XB_XCNT(j)]); sum += c; cnt += (c > 0u) ? 1u : 0u; mine = (j == x) ? c : mine; }
        if (sum == G) break;
        __builtin_amdgcn_s_sleep(1);
        if ((++sp & 255u) == 0u) { if (xb_ld(&bar[XB_TMO])) break; if (sp > XB_SPIN_CAP) { atomicAdd(&bar[XB_TMO], 1u); break; } }
    }
    nloc = mine > 0u ? mine : 1u; nx = cnt > 0u ? cnt : 1u;
}

__device__ __forceinline__ void xcd_barrier(const XcdBarrier& b) {
    asm volatile("s_waitcnt vmcnt(0)" ::: "memory");
    __syncthreads();
    if (threadIdx.x == 0) {
        unsigned* bar = b.bar;
        __builtin_amdgcn_s_waitcnt(0);
        unsigned nloc = b.st[0], nx = b.st[1];
        if (nloc == 0u) { xcd_barrier_complete(bar, b.x, nloc, nx); b.st[0] = nloc; b.st[1] = nx; }
        const unsigned old = xb_add(&bar[XB_XSUB(b.x)], 1u);
        const unsigned gen = old / nloc;
        if (old + 1u == (gen + 1u) * nloc) {
            __builtin_amdgcn_fence(__ATOMIC_RELEASE, "agent");
            asm volatile("s_waitcnt vmcnt(0)" ::: "memory");
            const unsigned og = xb_add(&bar[XB_TOP], 1u);
            const unsigned tg = og / nx;
            if (og + 1u == (tg + 1u) * nx) xb_add(&bar[XB_TOPGEN], 1u);
            else XB_SPIN(xb_ld(&bar[XB_TOPGEN]) == tg, bar);
            __builtin_amdgcn_fence(__ATOMIC_ACQUIRE, "agent");
            xb_add(&bar[XB_XGEN(b.x)], 1u);
            asm volatile("s_waitcnt vmcnt(0)" ::: "memory");
        } else {
            XB_SPIN(xb_ld(&bar[XB_XGEN(b.x)]) == gen, bar);
            __builtin_amdgcn_fence(__ATOMIC_ACQUIRE, "agent");
            asm volatile("s_waitcnt vmcnt(0)" ::: "memory");
        }
    }
    __syncthreads();
}
#ifndef MK_PROBE
#define MK_PROBE 0
#endif
#ifndef MK_PROBE_A
#define MK_PROBE_A 0
#define MK_PROBE_B 0
#endif
#ifndef MK_PROBE_REGIONS
#define MK_PROBE_REGIONS 0
#endif
#if MK_PROBE
#define REG_BEGIN(i) do { if (blockIdx.x == 0 && threadIdx.x == 0) ((unsigned long long*)(kp->ws + WS_CTL + 65536))[100 + (i)] = __builtin_amdgcn_s_memrealtime(); } while (0)
#define REG_END(i) do { __syncthreads(); if (blockIdx.x == 0 && threadIdx.x == 0) { unsigned long long* st_ = (unsigned long long*)(kp->ws + WS_CTL + 65536); st_[110 + (i)] += __builtin_amdgcn_s_memrealtime() - st_[100 + (i)]; } } while (0)
#else
#define REG_BEGIN(i) do { } while (0)
#define REG_END(i) do { } while (0)
#endif
namespace nv {
constexpr int D = 1024, MP = 16384, MS = 512, MT = MP + MS, NSEQ = 136, DEPTH = 4;
constexpr int NIN = 4112;
constexpr int NPJ = 4096, OFF_POOL = 0, OFF_Z = 512, OFF_XBC = 1536, OFF_GATE = 3072, OFF_LRU = 3584;
constexpr int DFF = 2816, NINP = 4352;
constexpr float EPS = 1e-6f;
constexpr size_t O_Y = 0, O_PPOOL = (size_t)MT * D, O_PSCONV = O_PPOOL + 245760, O_PSSD = O_PSCONV + 147456, O_PLCONV = O_PSSD + 4194304, O_PLRU = O_PLCONV + 49152,
                 O_PMK = O_PLRU + 16384, O_PMV = O_PMK + 8388608, O_SPOOL = O_PMV + 8388608, O_SSCONV = O_SPOOL + 3932160, O_SSSD = O_SSCONV + 2359296,
                 O_SLCONV = O_SSSD + 67108864, O_SLRU = O_SLCONV + 786432, O_END = O_SLRU + 262144;
constexpr size_t MiB = 1u << 20;
constexpr size_t WS_CTL = 0, CTL_ZERO_BYTES = 1 * MiB;
constexpr size_t WS_WKV = 1 * MiB, WS_WIN = 17 * MiB, WS_WOUT = 51 * MiB, WS_WQ = 67 * MiB, WS_WO = 75 * MiB, WS_WGU = 83 * MiB, WS_WD = 127 * MiB;
constexpr size_t WS_MEMB = 149 * MiB, WS_HB = 153 * MiB, WS_UB = 153 * MiB, WS_MIXB = 186 * MiB, WS_OB = 252 * MiB, WS_ACT = 285 * MiB;
constexpr size_t WS_PROJ = 376 * MiB, WS_POOLED = 642 * MiB, WS_XBC = 675 * MiB, WS_YRAW = 774 * MiB, WS_XC = 840 * MiB, WS_AB = 873 * MiB, WS_BB = 906 * MiB, WS_QB = 939 * MiB;
constexpr size_t WS_KB = 1005 * MiB, WS_VT = 1021 * MiB;
constexpr size_t WS_SSDSS = 1037 * MiB, WS_PWT = 1039 * MiB;
constexpr size_t WS_DT = 1042 * MiB;
constexpr size_t WS_RSS = 1040 * MiB;
constexpr size_t WS_XBCC = 1044 * MiB;
constexpr size_t WS_XLRU = 840 * MiB;
constexpr size_t WS_END = 1092 * MiB;
constexpr size_t WIN_L = (size_t)NINP * 1024, WOUT_L = (size_t)1024 * 2048, WQ_L = (size_t)1024 * 1024, WGU_L = (size_t)5632 * 1024, WD_L = (size_t)1024 * 2816;
constexpr int CW_TMO = 0, CW_BAR = 4096;
constexpr int RING_OFF = 0, RING_BYTES = 131072, LDSCTL_OFF = RING_BYTES, MISC_OFF = LDSCTL_OFF + 320, LDS_BYTES = 147456;
constexpr int NWAVES = 8, NTHR = 512;
constexpr int PH_PRO = 0, PH_KV = 1, PH_L0 = 2, PH_PER_LAYER = 9, PH_FINAL = PH_L0 + DEPTH * PH_PER_LAYER, NPH = PH_FINAL + 1;

struct SeqInfo { int row0, L, pos0, b, grp; };
__device__ __forceinline__ SeqInfo seq_info(int s) {
    SeqInfo q;
    if (s < 8) { q.row0 = s * 2048; q.L = 2048; q.pos0 = 0; q.b = s; q.grp = 0; }
    else { q.b = s - 8; q.row0 = MP + q.b * 4; q.L = 4; q.pos0 = 16384; q.grp = 1; }
    return q;
}
__device__ __forceinline__ void row_info(int r, int& s, int& t) {
    if (r < MP) { s = r >> 11; t = r & 2047; } else { const int q = r - MP; s = 8 + (q >> 2); t = q & 3; }
}
__device__ __forceinline__ float wave_sum(float v) {
#pragma unroll
    for (int o = 1; o < 64; o <<= 1) v += __shfl_xor(v, o);
    return v;
}
__device__ __forceinline__ float wave_max(float v) {
#pragma unroll
    for (int o = 1; o < 64; o <<= 1) v = fmaxf(v, __shfl_xor(v, o));
    return v;
}
__device__ __forceinline__ float silu_f(float x) { return x / (1.f + expf(-x)); }
__device__ __forceinline__ float sigmoid_f(float x) { return 1.f / (1.f + expf(-x)); }
__device__ __forceinline__ float softplus_f(float x) { return x > 20.f ? x : log1pf(expf(x)); }
__device__ __forceinline__ float gelu_tanh_f(float x) { return 0.5f * x * (1.f + tanhf(0.7978845608028654f * (x + 0.044715f * x * x * x))); }

struct Args { const float* in[38]; float* out; unsigned char* ws; int ph_lo, ph_hi; };
typedef const __attribute__((address_space(4))) Args* KP;
struct Frame { LAS unsigned char* lds; int tid, lane, wave, bid, G, vcu; };
__device__ __forceinline__ void frame_refresh(Frame& F) { int t = threadIdx.x; asm volatile("" : "+v"(t)); F.tid = t; F.lane = t & 63; F.wave = __builtin_amdgcn_readfirstlane(t >> 6); }

typedef float f32x2_t __attribute__((ext_vector_type(2))); typedef __bf16 bf16x2_t __attribute__((ext_vector_type(2)));
__device__ __forceinline__ unsigned pk2h(float lo, float hi) { f32x2_t v = {lo, hi}; bf16x2_t b = __builtin_convertvector(v, bf16x2_t); return __builtin_bit_cast(unsigned, b); }
__device__ __forceinline__ unsigned f2bfh(float x) { return pk2h(x, 0.f) & 0xffffu; }
typedef short bf16x8 __attribute__((ext_vector_type(8)));
#define MFMA16(a, b, c) __builtin_amdgcn_mfma_f32_16x16x32_bf16((a), (b), (c), 0, 0, 0)
#define LBAR() do { asm volatile("s_waitcnt lgkmcnt(0)" ::: "memory"); __builtin_amdgcn_s_barrier(); asm volatile("" ::: "memory"); } while (0)
__device__ __forceinline__ float bf2f(unsigned short h) { return __uint_as_float((unsigned)h << 16); }
__device__ __forceinline__ void cvt8(v4u u, f32x4& lo, f32x4& hi) { lo = (f32x4){__uint_as_float(u.x << 16), __uint_as_float(u.x & 0xffff0000u), __uint_as_float(u.y << 16), __uint_as_float(u.y & 0xffff0000u)}; hi = (f32x4){__uint_as_float(u.z << 16), __uint_as_float(u.z & 0xffff0000u), __uint_as_float(u.w << 16), __uint_as_float(u.w & 0xffff0000u)}; }
constexpr int SL_CS = 0, SL_BS = 32768, SL_BT = 65536, SL_XT = 98304, SL_XW = 106496, SL_HS = 114688, SL_XS = 122880;
constexpr int XTRA = LDSCTL_OFF + 512;
constexpr int SL_ACS = XTRA, SL_DTV = XTRA + 512, SL_CW = XTRA + 1024;
__device__ __forceinline__ int sw128(int r, int c8) { return r * 256 + (((c8 ^ r) & 15) << 4); }
__device__ __forceinline__ int sw128t(int r, int c8) { return r * 256 + (((c8 ^ r ^ (r >> 3)) & 15) << 4); }
__device__ __forceinline__ float fexp(float x) { return __builtin_amdgcn_exp2f(1.4426950408889634f * x); }
__device__ __forceinline__ float fsilu(float x) { return x * __builtin_amdgcn_rcpf(1.0f + __builtin_amdgcn_exp2f(-1.4426950408889634f * x)); }

__device__ __forceinline__ void ph_mix0(KP a, Frame& F, int l) {
    const bf16* proj = (const bf16*)(a->ws + WS_PROJ);
    const int NIT = (MP / 8) * 256;
    for (int it = F.bid * NTHR + F.tid; it < NIT; it += F.G * NTHR) {
        const int cc = it & 255, rb = it >> 8, r0 = rb * 8, t = r0 & 2047;
        const bool lru = cc >= 192; const int c8 = lru ? cc - 192 : cc, C = lru ? 512 : 1536;
        const float* cw = lru ? a->in[20] + (size_t)l * 4 * 512 : a->in[14] + (size_t)l * 4 * 1536; const float* cb = lru ? a->in[21] + (size_t)l * 512 : a->in[15] + (size_t)l * 1536;
        bf16* xo = (bf16*)(a->ws + (lru ? WS_XLRU : WS_XBCC)); const int soff = lru ? OFF_LRU : OFF_XBC;
        f32x4 wk[5][2];
#pragma unroll
        for (int k = 0; k < 4; ++k) { wk[k][0] = *(const f32x4*)(cw + (size_t)k * C + 8 * c8); wk[k][1] = *(const f32x4*)(cw + (size_t)k * C + 8 * c8 + 4); }
        wk[4][0] = *(const f32x4*)(cb + 8 * c8); wk[4][1] = *(const f32x4*)(cb + 8 * c8 + 4);
        v4u rw[11];
#pragma unroll
        for (int rr = 0; rr < 11; ++rr) { rw[rr] = (v4u){0u, 0u, 0u, 0u}; if (t + rr - 3 >= 0) rw[rr] = *(const GAS v4u*)(proj + (size_t)(r0 + rr - 3) * NPJ + soff + 8 * c8); }
#pragma unroll
        for (int hf = 0; hf < 2; ++hf) {
            f32x4 raw[11];
#pragma unroll
            for (int rr = 0; rr < 11; ++rr) { const unsigned u0 = hf ? rw[rr].z : rw[rr].x, u1 = hf ? rw[rr].w : rw[rr].y;
                raw[rr] = (f32x4){__uint_as_float(u0 << 16), __uint_as_float(u0 & 0xffff0000u), __uint_as_float(u1 << 16), __uint_as_float(u1 & 0xffff0000u)}; }
#pragma unroll
            for (int i = 0; i < 8; ++i) { f32x4 o = wk[4][hf];
#pragma unroll
                for (int k = 0; k < 4; ++k) o += wk[k][hf] * raw[i + k];
                if (!lru) { o.x = fsilu(o.x); o.y = fsilu(o.y); o.z = fsilu(o.z); o.w = fsilu(o.w); }
                *(unsigned long long*)(xo + (size_t)(r0 + i) * C + 8 * c8 + 4 * hf) = (unsigned long long)pk2h(o.x, o.y) | ((unsigned long long)pk2h(o.z, o.w) << 32); }
        }
    }
}
template <bool WITH_T>
__device__ __forceinline__ void ssd_stage(LAS unsigned char* L, const v4u (&rw)[4], int dst, int dstT, int tq, int c8) {
#pragma unroll
    for (int i = 0; i < 4; ++i) *(LAS v4u*)(L + dst + sw128(4 * tq + i, c8)) = rw[i];
    if (WITH_T) {
#pragma unroll
        for (int jw = 0; jw < 4; ++jw) {
            const unsigned a0 = rw[0][jw], a1 = rw[1][jw], a2 = rw[2][jw], a3 = rw[3][jw];
            const unsigned long long ev = (unsigned long long)((a0 & 0xffffu) | (a1 << 16)) | ((unsigned long long)((a2 & 0xffffu) | (a3 << 16)) << 32);
            const unsigned long long od = (unsigned long long)((a0 >> 16) | (a1 & 0xffff0000u)) | ((unsigned long long)((a2 >> 16) | (a3 & 0xffff0000u)) << 32);
            *(LAS unsigned long long*)(L + dstT + sw128t(8 * c8 + 2 * jw, tq >> 1) + (tq & 1) * 8) = ev;
            *(LAS unsigned long long*)(L + dstT + sw128t(8 * c8 + 2 * jw + 1, tq >> 1) + (tq & 1) * 8) = od; }
    }
}
__device__ __forceinline__ float fsoftplus(float x) { return x > 15.f ? x : 0.6931471805599453f * __builtin_amdgcn_logf(1.0f + __builtin_amdgcn_exp2f(1.4426950408889634f * x)); }

__device__ __forceinline__ void ssd_prompt_item(KP a, Frame& F, int l, int b, int hd, int ph) {
    LAS unsigned char* L = F.lds;
    const int tid0 = F.tid, w = F.wave, fr0 = F.lane & 15, fq0 = F.lane >> 4, g = hd >> 3;
    const bf16* proj_seq = (const bf16*)(a->ws + WS_PROJ) + (size_t)b * 2048 * NPJ; const float* dt_seq = (const float*)(a->ws + WS_DT) + (size_t)b * 2048 * 16 + hd;
    bf16* mixb = (bf16*)(a->ws + WS_MIXB) + (size_t)b * 2048 * 2048 + hd * 64 + ph * 32;
    float* ssq = (float*)(a->ws + WS_SSDSS) + (size_t)b * 2048 * 32 + hd * 2 + ph;
    LAS float* ACS = (LAS float*)(L + SL_ACS); LAS float* DTV = (LAS float*)(L + SL_DTV);
    const bf16* xc_seq = (const bf16*)(a->ws + WS_XBCC) + (size_t)b * 2048 * 1536;
    for (int i = tid0; i < 8192 / 4; i += NTHR) ((LAS unsigned*)(L + SL_HS))[i] = 0u;
    const float A = -expf(a->in[17][l * 16 + hd]), dtb = a->in[16][l * 16 + hd], Dk = a->in[18][l * 16 + hd];
    f32x4 hst[2]; hst[0] = (f32x4){0.f, 0.f, 0.f, 0.f}; hst[1] = (f32x4){0.f, 0.f, 0.f, 0.f};
    const int cB = 1024 + g * 128, cC = 1280 + g * 128, cX = hd * 64 + ph * 32, cZ = OFF_Z + hd * 64 + ph * 32;
    v4u rawB[4], rawC[4]; unsigned rawX[4]; float dr0 = 0.f, dr1 = 0.f;
    {
        const int tq = tid0 >> 4, c8 = tid0 & 15;
#pragma unroll
        for (int i = 0; i < 4; ++i) { const bf16* rp = xc_seq + (size_t)(4 * tq + i) * 1536; rawB[i] = *(const GAS v4u*)(rp + cB + 8 * c8); rawC[i] = *(const GAS v4u*)(rp + cC + 8 * c8); rawX[i] = *(const GAS unsigned*)(rp + cX + 2 * c8); }
        if (w == 0) { dr0 = dt_seq[(size_t)(2 * F.lane) * 16]; dr1 = dt_seq[(size_t)(2 * F.lane + 1) * 16]; }
    }
    __syncthreads();
    for (int c = 0; c < 16; ++c) {
        const int t0 = c * 128;
        const int tid = tid0, fr = fr0, fq = fq0;
        const int lane = tid & 63, tq = tid >> 4, c8 = tid & 15;
        unsigned long long zq[2];
#pragma unroll
        for (int pt = 0; pt < 2; ++pt) zq[pt] = *(const GAS unsigned long long*)(proj_seq + (size_t)(t0 + 16 * w + fr) * NPJ + cZ + 16 * pt + 4 * fq);
        if (w == 0) {
            const float dt0 = fsoftplus(dr0 + dtb), dt1 = fsoftplus(dr1 + dtb);
            const float a0 = dt0 * A, a1 = dt1 * A;
            float v = a0 + a1;
#pragma unroll
            for (int o = 1; o < 64; o <<= 1) { const float t = __shfl_up(v, o); if (lane >= o) v += t; }
            ACS[2 * lane] = v - a1; ACS[2 * lane + 1] = v; DTV[2 * lane] = dt0; DTV[2 * lane + 1] = dt1;
        }
        ssd_stage<true>(L, rawB, SL_BS, SL_BT, tq, c8);
        ssd_stage<false>(L, rawC, SL_CS, 0, tq, c8);
        if (c + 1 < 16) {
#pragma unroll
            for (int i = 0; i < 4; ++i) { const bf16* rp = xc_seq + (size_t)(t0 + 128 + 4 * tq + i) * 1536; rawB[i] = *(const GAS v4u*)(rp + cB + 8 * c8); rawC[i] = *(const GAS v4u*)(rp + cC + 8 * c8); }
        }
        LBAR();
        f32x4 cb[8]; bf16x8 cfr[4]; const int lo = (w >= 4) ? (w - 4) : 0, hrt = 7 - w, nh = (w < 4) ? (3 - w) : 0;
#pragma unroll
        for (int ks = 0; ks < 4; ++ks) cfr[ks] = *(const LAS bf16x8*)(L + SL_CS + sw128(16 * w + fr, 4 * ks + fq));
#pragma unroll
        for (int st = 0; st < 8; ++st) if (st >= lo && st <= w) { cb[st] = (f32x4){0.f, 0.f, 0.f, 0.f};
#pragma unroll
            for (int ks = 0; ks < 4; ++ks) { const bf16x8 bm = *(const LAS bf16x8*)(L + SL_BS + sw128(16 * st + fr, 4 * ks + fq)); cb[st] = MFMA16(bm, cfr[ks], cb[st]); } }
        f32x4 cbh[3];
        if (w < 4) { bf16x8 cf2[4];
#pragma unroll
            for (int ks = 0; ks < 4; ++ks) cf2[ks] = *(const LAS bf16x8*)(L + SL_CS + sw128(16 * hrt + fr, 4 * ks + fq));
#pragma unroll
            for (int k = 0; k < 3; ++k) if (k < nh) { cbh[k] = (f32x4){0.f, 0.f, 0.f, 0.f};
#pragma unroll
                for (int ks = 0; ks < 4; ++ks) { const bf16x8 bm = *(const LAS bf16x8*)(L + SL_BS + sw128(16 * k + fr, 4 * ks + fq)); cbh[k] = MFMA16(bm, cf2[ks], cbh[k]); } } }
        {
            const float alast = ACS[127];
            float xd[4][2], xw[4][2];
#pragma unroll
            for (int i = 0; i < 4; ++i) { const int tok = 4 * tq + i; const float dt = DTV[tok], wgt = fexp(alast - ACS[tok]);
                xd[i][0] = __uint_as_float(rawX[i] << 16) * dt; xd[i][1] = __uint_as_float(rawX[i] & 0xffff0000u) * dt; xw[i][0] = xd[i][0] * wgt; xw[i][1] = xd[i][1] * wgt; }
#pragma unroll
            for (int j = 0; j < 2; ++j) { const int off = sw128(2 * c8 + j, tq >> 1) + (tq & 1) * 8;
                *(LAS unsigned long long*)(L + SL_XT + off) = (unsigned long long)pk2h(xd[0][j], xd[1][j]) | ((unsigned long long)pk2h(xd[2][j], xd[3][j]) << 32);
                *(LAS unsigned long long*)(L + SL_XW + off) = (unsigned long long)pk2h(xw[0][j], xw[1][j]) | ((unsigned long long)pk2h(xw[2][j], xw[3][j]) << 32); }
            if (c + 1 < 16) {
#pragma unroll
                for (int i = 0; i < 4; ++i) rawX[i] = *(const GAS unsigned*)(xc_seq + (size_t)(t0 + 128 + 4 * tq + i) * 1536 + cX + 2 * c8);
                if (w == 0) { dr0 = dt_seq[(size_t)(t0 + 128 + 2 * lane) * 16]; dr1 = dt_seq[(size_t)(t0 + 128 + 2 * lane + 1) * 16]; }
            }
        }
        LBAR();
        {
            const int l_ = 16 * w + fr; const float al = ACS[l_];
#pragma unroll
            for (int st = 0; st < 8; ++st) {
                const int off = SL_BS + sw128(l_, 2 * st + (fq >> 1)) + (fq & 1) * 8;
                if (st >= lo && st <= w) { float v[4]; const f32x4 as4 = *(const LAS f32x4*)(ACS + 16 * st + 4 * fq);
#pragma unroll
                    for (int e = 0; e < 4; ++e) { const int s_ = 16 * st + 4 * fq + e; const float ex = fexp(fminf(al - as4[e], 0.f)); v[e] = (s_ <= l_) ? cb[st][e] * ex : 0.f; }
                    *(LAS unsigned long long*)(L + off) = (unsigned long long)pk2h(v[0], v[1]) | ((unsigned long long)pk2h(v[2], v[3]) << 32); }
                else if (st == w + 1 && (w & 1) == 0) *(LAS unsigned long long*)(L + off) = 0ull;
            }
            if (w < 4) { const int l2 = 16 * hrt + fr; const float al2 = ACS[l2];
#pragma unroll
                for (int k = 0; k < 3; ++k) if (k < nh) { float v[4]; const f32x4 as4 = *(const LAS f32x4*)(ACS + 16 * k + 4 * fq);
#pragma unroll
                    for (int e = 0; e < 4; ++e) v[e] = cbh[k][e] * fexp(fminf(al2 - as4[e], 0.f));
                    *(LAS unsigned long long*)(L + SL_BS + sw128(l2, 2 * k + (fq >> 1)) + (fq & 1) * 8) = (unsigned long long)pk2h(v[0], v[1]) | ((unsigned long long)pk2h(v[2], v[3]) << 32); } }
        }
        LBAR();
        {
            f32x4 yd[2], yo[2];
#pragma unroll
            for (int pt = 0; pt < 2; ++pt) { yd[pt] = (f32x4){0.f, 0.f, 0.f, 0.f}; yo[pt] = (f32x4){0.f, 0.f, 0.f, 0.f}; }
#pragma unroll
            for (int ks = 0; ks < 4; ++ks) {
#pragma unroll
                for (int pt = 0; pt < 2; ++pt) { const bf16x8 hf = *(const LAS bf16x8*)(L + SL_HS + sw128(16 * pt + fr, 4 * ks + fq)); yo[pt] = MFMA16(hf, cfr[ks], yo[pt]); }
                if (ks <= (w >> 1)) { const bf16x8 mf = *(const LAS bf16x8*)(L + SL_BS + sw128(16 * w + fr, 4 * ks + fq));
#pragma unroll
                    for (int pt = 0; pt < 2; ++pt) { const bf16x8 xf = *(const LAS bf16x8*)(L + SL_XT + sw128(16 * pt + fr, 4 * ks + fq)); yd[pt] = MFMA16(xf, mf, yd[pt]); } }
            }
            const int l_ = 16 * w + fr; const float ea = fexp(ACS[l_]), dsk = Dk * __builtin_amdgcn_rcpf(DTV[l_]); float s2 = 0.f;
#pragma unroll
            for (int pt = 0; pt < 2; ++pt) { float yg[4];
#pragma unroll
                for (int e = 0; e < 4; ++e) { const int p = 16 * pt + 4 * fq + e;
                    const float xdv = bf2f(*(const LAS bf16*)(L + SL_XT + sw128(p, l_ >> 3) + (l_ & 7) * 2));
                    const float z = bf2f((unsigned short)(zq[pt] >> (16 * e)));
                    const float y = yd[pt][e] + ea * yo[pt][e] + dsk * xdv;
                    yg[e] = y * fsilu(z); s2 += yg[e] * yg[e]; }
                *(unsigned long long*)(mixb + (size_t)(t0 + l_) * 2048 + 16 * pt + 4 * fq) = (unsigned long long)pk2h(yg[0], yg[1]) | ((unsigned long long)pk2h(yg[2], yg[3]) << 32); }
            s2 += __shfl_xor(s2, 16); s2 += __shfl_xor(s2, 32);
            if (fq == 0) ssq[(size_t)(t0 + l_) * 32] = s2;
            const float cd = fexp(ACS[127]);
#pragma unroll
            for (int pt = 0; pt < 2; ++pt) hst[pt] = hst[pt] * cd;
#pragma unroll
            for (int ks = 0; ks < 4; ++ks) { const bf16x8 bt = *(const LAS bf16x8*)(L + SL_BT + sw128t(16 * w + fr, 4 * ks + fq));
#pragma unroll
                for (int pt = 0; pt < 2; ++pt) { const bf16x8 xw = *(const LAS bf16x8*)(L + SL_XW + sw128(16 * pt + fr, 4 * ks + fq)); hst[pt] = MFMA16(bt, xw, hst[pt]); } }
        }
        LBAR();
#pragma unroll
        for (int pt = 0; pt < 2; ++pt)
            *(LAS unsigned long long*)(L + SL_HS + sw128(16 * pt + fr, 2 * w + (fq >> 1)) + (fq & 1) * 8) = (unsigned long long)pk2h(hst[pt][0], hst[pt][1]) | ((unsigned long long)pk2h(hst[pt][2], hst[pt][3]) << 32);
    }
    {
        float* so = a->out + O_PSSD + ((((size_t)l * 8 + b) * 16 + hd) * 64 + ph * 32) * 128;
#pragma unroll
        for (int pt = 0; pt < 2; ++pt) *(f32x4*)(so + (size_t)(16 * pt + fr0) * 128 + 16 * w + 4 * fq0) = hst[pt];
    }
    __syncthreads();
}

constexpr int LR_ROWS = 512 + 32;
constexpr int LR_A = 0, LR_B = LR_ROWS * 64, LR_XC = 2 * LR_ROWS * 64;
constexpr int LR_SEG = LR_XC + 8192, LR_CAR = LR_SEG + 2 * 32 * 16 * 4, LR_CW = LR_CAR + 64 + 32 * 16 * 4;
static_assert(LR_CW + 5 * 64 * 4 <= RING_BYTES, "lru LDS map");
__device__ __forceinline__ int lr_row(int tok) { return tok + (tok >> 4); }
__device__ __forceinline__ void lru_prompt_item(KP a, Frame& F, int l, int b, int hh, int qd) {
    LAS unsigned char* L = F.lds;
    const int tid0 = F.tid, w = F.wave, fr0 = F.lane & 15, fq0 = F.lane >> 4;
    const bf16* proj_seq = (const bf16*)(a->ws + WS_PROJ) + (size_t)b * 2048 * NPJ;
    bf16* mixb = (bf16*)(a->ws + WS_MIXB) + (size_t)b * 2048 * 2048 + 1536 + hh * 64 + qd * 16;
    LAS float* Al = (LAS float*)(L + LR_A); LAS float* Bl = (LAS float*)(L + LR_B); LAS float* XCs = (LAS float*)(L + LR_XC) + w * 256;
    LAS float* SegA = (LAS float*)(L + LR_SEG); LAS float* SegB = SegA + 512; LAS float* Car = (LAS float*)(L + LR_CAR); LAS float* CarIn = Car + 16;
    const int ch = hh * 64 + qd * 16 + fr0;
    if (tid0 < 16) Car[tid0] = 0.f;
    bf16x8 waf[2], wxf[2];
    {
        const float* wa = a->in[22] + ((size_t)l * 8 + hh) * 64 * 64 + qd * 16 + fr0; const float* wx = a->in[24] + ((size_t)l * 8 + hh) * 64 * 64 + qd * 16 + fr0;
#pragma unroll
        for (int ks = 0; ks < 2; ++ks) { v4u ua, ux; const int i0 = 32 * ks + 8 * fq0;
            ua.x = pk2h(wa[(i0 + 0) * 64], wa[(i0 + 1) * 64]); ua.y = pk2h(wa[(i0 + 2) * 64], wa[(i0 + 3) * 64]); ua.z = pk2h(wa[(i0 + 4) * 64], wa[(i0 + 5) * 64]); ua.w = pk2h(wa[(i0 + 6) * 64], wa[(i0 + 7) * 64]);
            ux.x = pk2h(wx[(i0 + 0) * 64], wx[(i0 + 1) * 64]); ux.y = pk2h(wx[(i0 + 2) * 64], wx[(i0 + 3) * 64]); ux.z = pk2h(wx[(i0 + 4) * 64], wx[(i0 + 5) * 64]); ux.w = pk2h(wx[(i0 + 6) * 64], wx[(i0 + 7) * 64]);
            waf[ks] = __builtin_bit_cast(bf16x8, ua); wxf[ks] = __builtin_bit_cast(bf16x8, ux); }
    }
    const float bav = a->in[23][(size_t)l * 512 + ch], bxv = a->in[25][(size_t)l * 512 + ch];
    const float lamv = a->in[26][(size_t)l * 512 + ch];
    const float spv = -8.0f * ((-lamv) > 20.f ? (-lamv) : log1pf(expf(-lamv)));
    const bf16* xl_seq = (const bf16*)(a->ws + WS_XLRU) + (size_t)b * 2048 * 512 + hh * 64;
    v4u xr[4][2];
#pragma unroll
    for (int tt = 0; tt < 4; ++tt)
#pragma unroll
        for (int ks = 0; ks < 2; ++ks) xr[tt][ks] = *(const GAS v4u*)(xl_seq + (size_t)((w * 4 + tt) * 16 + fr0) * 512 + 32 * ks + 8 * fq0);
    __syncthreads();
    for (int qp = 0; qp < 4; ++qp) {
        const int T0 = qp * 512;
        int tid = tid0, fr = fr0, fq = fq0; asm volatile("" : "+v"(tid), "+v"(fr), "+v"(fq));
        v4u gz0, gz1;
        { const bf16* gp = proj_seq + (size_t)(T0 + tid) * NPJ + OFF_GATE + hh * 64 + qd * 16; gz0 = *(const GAS v4u*)gp; gz1 = *(const GAS v4u*)(gp + 8); }
#pragma unroll
        for (int tt = 0; tt < 4; ++tt) {
            const int tb = (w * 4 + tt) * 16;
            bf16x8 xa[2];
#pragma unroll
            for (int ks = 0; ks < 2; ++ks) { xa[ks] = __builtin_bit_cast(bf16x8, xr[tt][ks]);
                if (ks == (qd >> 1) && (fq >> 1) == (qd & 1)) {
                    f32x4 x0, x1; cvt8(xr[tt][ks], x0, x1); *(LAS f32x4*)(XCs + fr * 16 + 8 * (fq & 1)) = x0; *(LAS f32x4*)(XCs + fr * 16 + 8 * (fq & 1) + 4) = x1; }
            }
            f32x4 pr = (f32x4){bav, bav, bav, bav}, pi = (f32x4){bxv, bxv, bxv, bxv};
#pragma unroll
            for (int ks = 0; ks < 2; ++ks) { pr = MFMA16(xa[ks], waf[ks], pr); pi = MFMA16(xa[ks], wxf[ks], pi); }
            LDS_WAIT(); asm volatile("" ::: "memory");
#pragma unroll
            for (int e = 0; e < 4; ++e) { const int tok = tb + 4 * fq + e;
                const float rg = __builtin_amdgcn_rcpf(1.0f + fexp(-pr[e])), ig = __builtin_amdgcn_rcpf(1.0f + fexp(-pi[e]));
                const float log_a = spv * rg; const float av = fexp(log_a);
                const float y2 = 2.0f * log_a;
                const float om = y2 > -0.02f ? -y2 * (1.0f + y2 * (0.5f + y2 * (0.16666667f + y2 * 0.041666668f))) : 1.0f - av * av;
                const float mult = (T0 + tok == 0) ? 1.0f : sqrtf(om);
                const float xcv = XCs[(4 * fq + e) * 16 + fr];
                Al[lr_row(tok) * 16 + fr] = av; Bl[lr_row(tok) * 16 + fr] = mult * ig * xcv; }
            LDS_WAIT(); asm volatile("" ::: "memory");
        }
        if (qp + 1 < 4) {
#pragma unroll
            for (int tt = 0; tt < 4; ++tt)
#pragma unroll
                for (int ks = 0; ks < 2; ++ks) xr[tt][ks] = *(const GAS v4u*)(xl_seq + (size_t)(T0 + 512 + (w * 4 + tt) * 16 + fr) * 512 + 32 * ks + 8 * fq);
        }
        LBAR();
        {
            const int sg = tid >> 4, c = tid & 15; float pa = 1.f, hb = 0.f;
#pragma unroll
            for (int i = 0; i < 16; ++i) { const int r = (sg * 17 + i) * 16 + c; const float av = Al[r]; hb = av * hb + Bl[r]; pa *= av; }
            SegA[sg * 16 + c] = pa; SegB[sg * 16 + c] = hb;
        }
        LBAR();
        if (tid < 16) { float h = Car[tid];
            for (int sg = 0; sg < 32; ++sg) { CarIn[sg * 16 + tid] = h; h = SegA[sg * 16 + tid] * h + SegB[sg * 16 + tid]; }
            Car[tid] = h; }
        LBAR();
        {
            const int sg = tid >> 4, c = tid & 15; float h = CarIn[sg * 16 + c];
#pragma unroll
            for (int i = 0; i < 16; ++i) { const int r = (sg * 17 + i) * 16 + c; h = Al[r] * h + Bl[r]; Bl[r] = h; }
        }
        LBAR();
        {
            const int tok = tid;
            float y[16]; f32x4 gq[4]; cvt8(gz0, gq[0], gq[1]); cvt8(gz1, gq[2], gq[3]);
#pragma unroll
            for (int v = 0; v < 4; ++v) { const f32x4 gt = gq[v]; const f32x4 hv = *(const LAS f32x4*)(Bl + lr_row(tok) * 16 + 4 * v);
#pragma unroll
                for (int i = 0; i < 4; ++i) { const float x = gt[i]; const float u = 0.7978845608028654f * (x + 0.044715f * x * x * x); const float th = 1.0f - 2.0f * __builtin_amdgcn_rcpf(1.0f + fexp(2.0f * u));
                    y[4 * v + i] = hv[i] * 0.5f * x * (1.0f + th); } }
            v4u o0, o1; o0.x = pk2h(y[0], y[1]); o0.y = pk2h(y[2], y[3]); o0.z = pk2h(y[4], y[5]); o0.w = pk2h(y[6], y[7]); o1.x = pk2h(y[8], y[9]); o1.y = pk2h(y[10], y[11]); o1.z = pk2h(y[12], y[13]); o1.w = pk2h(y[14], y[15]);
            v4u* op = (v4u*)(mixb + (size_t)(T0 + tok) * 2048); op[0] = o0; op[1] = o1;
        }
        LBAR();
    }
    if (tid0 < 16) a->out[O_PLRU + ((size_t)l * 8 + b) * 512 + hh * 64 + qd * 16 + tid0] = Car[tid0];
    __syncthreads();
}

constexpr int PL_UP = 0, PL_UPROW = 132 * 4, PL_P = 143 * PL_UPROW;
static_assert(PL_P % 16 == 0 && PL_P + 32768 <= RING_BYTES, "pool LDS map");
__device__ __forceinline__ void pool_prompt_item(KP a, Frame& F, int l, int b, int c, int g) {
    LAS unsigned char* L = F.lds;
    const int tid = F.tid, lane = F.lane, w = F.wave, fr = lane & 15, fq = lane >> 4;
    const int t0 = c * 128, win = 2 << g;
    const bf16* proj_seq = (const bf16*)(a->ws + WS_PROJ) + (size_t)b * 2048 * NPJ;
    const bf16* pwt = (const bf16*)(a->ws + WS_PWT) + ((size_t)l * 4 + g) * 128 * 128;
    bf16* mixb = (bf16*)(a->ws + WS_MIXB) + (size_t)b * 2048 * 2048 + 1024 + g * 128;
    {
        v4u ur[5];
#pragma unroll
        for (int k = 0; k < 5; ++k) { const int i = tid + k * NTHR, rr = i >> 4, c8 = i & 15, row = t0 + rr - 15; ur[k] = (v4u){0u, 0u, 0u, 0u};
            if (i < 143 * 16 && row >= 0) ur[k] = *(const GAS v4u*)(proj_seq + (size_t)row * NPJ + OFF_POOL + g * 128 + 8 * c8); }
#pragma unroll
        for (int k = 0; k < 5; ++k) { const int i = tid + k * NTHR, rr = i >> 4, c8 = i & 15; f32x4 v0, v1; cvt8(ur[k], v0, v1);
            if (i < 143 * 16) { *(LAS f32x4*)(L + PL_UP + rr * PL_UPROW + c8 * 32) = v0; *(LAS f32x4*)(L + PL_UP + rr * PL_UPROW + c8 * 32 + 16) = v1; } }
    }
    __syncthreads();
    for (int i = tid; i < 128 * 16; i += NTHR) { const int tok = i >> 4, c8 = i & 15;
        f32x4 s0 = (f32x4){0.f, 0.f, 0.f, 0.f}, s1 = s0;
        for (int j = 0; j < win; ++j) { const LAS unsigned char* p = L + PL_UP + (tok + 15 - j) * PL_UPROW + c8 * 32; s0 += *(const LAS f32x4*)p; s1 += *(const LAS f32x4*)(p + 16); }
        const int pos = t0 + tok; const float ic = 1.0f / (float)((pos + 1 < win) ? (pos + 1) : win);
        const LAS unsigned char* p = L + PL_UP + (tok + 15) * PL_UPROW + c8 * 32; const f32x4 u0 = *(const LAS f32x4*)p, u1 = *(const LAS f32x4*)(p + 16);
        s0 = s0 * ic - u0; s1 = s1 * ic - u1;
        v4u o; o.x = pk2h(s0.x, s0.y); o.y = pk2h(s0.z, s0.w); o.z = pk2h(s1.x, s1.y); o.w = pk2h(s1.z, s1.w);
        *(LAS v4u*)(L + PL_P + sw128(tok, c8)) = o; }
    __syncthreads();
    bf16x8 pa[4];
#pragma unroll
    for (int ks = 0; ks < 4; ++ks) pa[ks] = *(const LAS bf16x8*)(L + PL_P + sw128(16 * w + fr, 4 * ks + fq));
#pragma unroll
    for (int dt = 0; dt < 8; ++dt) { f32x4 acc = (f32x4){0.f, 0.f, 0.f, 0.f};
#pragma unroll
        for (int ks = 0; ks < 4; ++ks) { const bf16x8 wf = *(const bf16x8*)(pwt + (size_t)(16 * dt + fr) * 128 + 32 * ks + 8 * fq); acc = MFMA16(pa[ks], wf, acc); }
#pragma unroll
        for (int e = 0; e < 4; ++e) mixb[(size_t)(t0 + 16 * w + 4 * fq + e) * 2048 + 16 * dt + fr] = (bf16)f2bfh(acc[e]); }
    __syncthreads();
}

struct TI { const float* W; bf16* WT; const float* gain; int K, N, k0, n0, row_off, mode, goff, kd0; };
__device__ __forceinline__ void ti_load(const TI& t, f32x4 (&v)[8], float (&gn)[8], int lane) {
    const int nn = (lane & 7) * 4, kr = lane >> 3;
#pragma unroll
    for (int i = 0; i < 8; ++i) { const int kk = 8 * i + kr; v[i] = (f32x4){0.f, 0.f, 0.f, 0.f}; gn[i] = 1.f;
        if (t.n0 + nn + 4 <= t.N) v[i] = *(const f32x4*)(t.W + (size_t)(t.k0 + kk) * t.N + t.n0 + nn);
        if (t.gain) gn[i] = t.gain[t.k0 + kk - t.goff]; }
}
__device__ __forceinline__ void ti_store(const TI& t, const f32x4 (&v)[8], const float (&gn)[8], LAS float* scr, int lane) {
    const int nn = (lane & 7) * 4, kr = lane >> 3;
#pragma unroll
    for (int i = 0; i < 8; ++i) { const int kk = 8 * i + kr; f32x4 x = v[i] * gn[i];
        scr[kk * 33 + nn] = x.x; scr[kk * 33 + nn + 1] = x.y; scr[kk * 33 + nn + 2] = x.z; scr[kk * 33 + nn + 3] = x.w; }
    LDS_WAIT(); asm volatile("" ::: "memory");
    const int c = lane & 7;
#pragma unroll
    for (int j = 0; j < 4; ++j) { const int nl = (lane >> 3) + 8 * j, n = t.n0 + nl; const LAS float* sp = scr + (8 * c) * 33 + nl;
        v4u o; o.x = pk2h(sp[0 * 33], sp[1 * 33]); o.y = pk2h(sp[2 * 33], sp[3 * 33]); o.z = pk2h(sp[4 * 33], sp[5 * 33]); o.w = pk2h(sp[6 * 33], sp[7 * 33]);
        int dr;
        if (t.mode == 0) dr = t.row_off + n; else if (t.mode == 1) dr = n < 3072 ? n : (n < 3088 ? 4096 + (n - 3072) : n - 16); else dr = 256 * (n >> 7) + (n & 127) + t.row_off;
        if (n < t.N) *(GAS v4u*)(t.WT + (size_t)dr * t.K + t.kd0 + 8 * c) = o; }
    LDS_WAIT(); asm volatile("" ::: "memory");
}
__device__ __forceinline__ void ph_prologue(KP a, Frame& F) {
    LAS float* scr = (LAS float*)(F.lds + RING_OFF + F.wave * 16384);
    const int gw = F.bid * NWAVES + F.wave, NGW = F.G * NWAVES;
    bf16* Wkv = (bf16*)(a->ws + WS_WKV); bf16* Win = (bf16*)(a->ws + WS_WIN); bf16* Wout = (bf16*)(a->ws + WS_WOUT); bf16* Wq = (bf16*)(a->ws + WS_WQ); bf16* Wo = (bf16*)(a->ws + WS_WO);
    bf16* Wgu = (bf16*)(a->ws + WS_WGU); bf16* Wd = (bf16*)(a->ws + WS_WD);
    constexpr int I_IN = 16 * 129, I_OUT = 32 * 32, I_SQ = 16 * 32, I_G = 16 * 88, I_DN = 44 * 32;
    constexpr int PER_L = I_IN + I_OUT + 4 * I_SQ + 2 * I_G + I_DN;
    auto decode = [&](int it) -> TI {
        const int l = it / PER_L; int r = it % PER_L; TI t; t.goff = 0; t.row_off = 0; t.gain = nullptr; t.mode = 0;
        if (r < I_IN) { const int kb = r / 129, nb = r % 129; t.W = a->in[11] + (size_t)l * 1024 * NIN; t.K = 1024; t.N = NIN; t.k0 = 64 * kb; t.kd0 = 64 * kb; t.n0 = 32 * nb; t.WT = Win + (size_t)l * WIN_L; t.mode = 1; t.gain = a->in[10] + (size_t)l * 1024; return t; } r -= I_IN;
        if (r < I_OUT) { const int kb = r / 32, nb = r % 32; t.W = a->in[27] + (size_t)l * 2048 * 1024; t.K = 2048; t.N = 1024; t.k0 = 64 * kb; t.kd0 = 64 * kb; t.n0 = 32 * nb; t.WT = Wout + (size_t)l * WOUT_L; if (kb >= 8 && kb < 24) { t.gain = a->in[19] + (size_t)l * 1024; t.goff = 512; t.kd0 = 64 * (kb - 8); } else if (kb < 8) t.kd0 = 64 * (kb + 16); return t; } r -= I_OUT;
        if (r < I_SQ) { const int kb = r / 32, nb = r % 32; t.W = a->in[29] + (size_t)l * 1024 * 1024; t.K = 1024; t.N = 1024; t.k0 = 64 * kb; t.kd0 = 64 * kb; t.n0 = 32 * nb; t.WT = Wq + (size_t)l * WQ_L; t.gain = a->in[28] + (size_t)l * 1024; return t; } r -= I_SQ;
        if (r < I_SQ) { const int kb = r / 32, nb = r % 32; t.W = a->in[30] + (size_t)l * 1024 * 1024; t.K = 1024; t.N = 1024; t.k0 = 64 * kb; t.kd0 = 64 * kb; t.n0 = 32 * nb; t.WT = Wkv; t.row_off = l * 2048; return t; } r -= I_SQ;
        if (r < I_SQ) { const int kb = r / 32, nb = r % 32; t.W = a->in[31] + (size_t)l * 1024 * 1024; t.K = 1024; t.N = 1024; t.k0 = 64 * kb; t.kd0 = 64 * kb; t.n0 = 32 * nb; t.WT = Wkv; t.row_off = l * 2048 + 1024; return t; } r -= I_SQ;
        if (r < I_SQ) { const int kb = r / 32, nb = r % 32; t.W = a->in[32] + (size_t)l * 1024 * 1024; t.K = 1024; t.N = 1024; t.k0 = 64 * kb; t.kd0 = 64 * kb; t.n0 = 32 * nb; t.WT = Wo + (size_t)l * WQ_L; return t; } r -= I_SQ;
        if (r < I_G) { const int kb = r / 88, nb = r % 88; t.W = a->in[34] + (size_t)l * 1024 * DFF; t.K = 1024; t.N = DFF; t.k0 = 64 * kb; t.kd0 = 64 * kb; t.n0 = 32 * nb; t.WT = Wgu + (size_t)l * WGU_L; t.mode = 2; t.gain = a->in[33] + (size_t)l * 1024; return t; } r -= I_G;
        if (r < I_G) { const int kb = r / 88, nb = r % 88; t.W = a->in[35] + (size_t)l * 1024 * DFF; t.K = 1024; t.N = DFF; t.k0 = 64 * kb; t.kd0 = 64 * kb; t.n0 = 32 * nb; t.WT = Wgu + (size_t)l * WGU_L; t.mode = 2; t.row_off = 128; t.gain = a->in[33] + (size_t)l * 1024; return t; } r -= I_G;
        { const int kb = r / 32, nb = r % 32; t.W = a->in[36] + (size_t)l * DFF * 1024; t.K = DFF; t.N = 1024; t.k0 = 64 * kb; t.kd0 = 64 * kb; t.n0 = 32 * nb; t.WT = Wd + (size_t)l * WD_L; return t; }
    };
    if (gw < DEPTH * PER_L) {
        int it = gw; TI cur = decode(it); f32x4 v[8]; float gn[8]; ti_load(cur, v, gn, F.lane);
        for (;;) {
            const int nit = it + NGW; const bool has = nit < DEPTH * PER_L;
            TI nxt = cur; f32x4 vn[8]; float gnn[8];
            if (has) { nxt = decode(nit); ti_load(nxt, vn, gnn, F.lane); }
            ti_store(cur, v, gn, scr, F.lane);
            if (!has) break;
            cur = nxt; it = nit;
#pragma unroll
            for (int i = 0; i < 8; ++i) { v[i] = vn[i]; gn[i] = gnn[i]; }
        }
    }
    { bf16* pwt = (bf16*)(a->ws + WS_PWT);
      for (size_t i = (size_t)F.bid * NTHR + F.tid; i < (size_t)DEPTH * 4 * 128 * 128; i += (size_t)F.G * NTHR) { const int c = (int)(i & 127), d = (int)((i >> 7) & 127), lg = (int)(i >> 14);
          pwt[i] = (bf16)f2bfh(a->in[12][((size_t)lg * 128 + c) * 128 + d] * a->in[13][(size_t)lg * 128 + d]); } }
    const size_t gt = (size_t)F.bid * NTHR + F.tid, gs = (size_t)F.G * NTHR;
    { const f32x4* src = (const f32x4*)a->in[2]; unsigned long long* dst = (unsigned long long*)(a->ws + WS_MEMB);
      for (size_t i = gt; i < (size_t)2048 * 1024 / 4; i += gs) { const f32x4 v = src[i]; dst[i] = (unsigned long long)pk2h(v.x, v.y) | ((unsigned long long)pk2h(v.z, v.w) << 32); } }
    { bf16* hb = (bf16*)(a->ws + WS_HB); float* rss = (float*)(a->ws + WS_RSS);
      for (int r0 = gw; r0 < MT; r0 += 4 * NGW) {
          f32x4 v[4][4];
#pragma unroll
          for (int q = 0; q < 4; ++q) { const int r = r0 + q * NGW; const f32x4* src = (const f32x4*)((r < MP ? a->in[0] : a->in[1] - (size_t)MP * D) + (size_t)r * D);
#pragma unroll
              for (int j = 0; j < 4; ++j) v[q][j] = r < MT ? src[F.lane + 64 * j] : (f32x4){0.f, 0.f, 0.f, 0.f}; }
#pragma unroll
          for (int q = 0; q < 4; ++q) { const int r = r0 + q * NGW; float ss = 0.f;
              if (r < MT) {
#pragma unroll
                  for (int j = 0; j < 4; ++j) { const f32x4 x = v[q][j]; ss += x.x * x.x + x.y * x.y + x.z * x.z + x.w * x.w;
                      ((unsigned long long*)(hb + (size_t)r * D))[F.lane + 64 * j] = (unsigned long long)pk2h(x.x, x.y) | ((unsigned long long)pk2h(x.z, x.w) << 32); } }
              ss = wave_sum(ss);
              if (r < MT && F.lane < 16) rss[(size_t)r * 16 + F.lane] = F.lane == 0 ? ss : 0.f; } } }
}

__device__ __forceinline__ void ph_final_norm(Frame& F, const bf16* hb, const float* g, float* Y) {
    const int gw = F.bid * NWAVES + F.wave, NGW = F.G * NWAVES;
    f32x4 gg[4];
#pragma unroll
    for (int j = 0; j < 4; ++j) gg[j] = ((const f32x4*)g)[F.lane + 64 * j];
    for (int r0 = gw; r0 < MT; r0 += 4 * NGW) {
        unsigned long long u[4][4];
#pragma unroll
        for (int q = 0; q < 4; ++q) { const int r = r0 + q * NGW;
#pragma unroll
            for (int j = 0; j < 4; ++j) u[q][j] = r < MT ? ((const unsigned long long*)(hb + (size_t)r * D))[F.lane + 64 * j] : 0ull; }
#pragma unroll
        for (int q = 0; q < 4; ++q) { const int r = r0 + q * NGW; f32x4 v[4]; float ss = 0.f;
#pragma unroll
            for (int j = 0; j < 4; ++j) { const unsigned long long x = u[q][j];
                v[j] = (f32x4){bf2f((unsigned short)x), bf2f((unsigned short)(x >> 16)), bf2f((unsigned short)(x >> 32)), bf2f((unsigned short)(x >> 48))}; ss += v[j].x * v[j].x + v[j].y * v[j].y + v[j].z * v[j].z + v[j].w * v[j].w; }
            ss = wave_sum(ss);
            const float rstd = 1.0f / sqrtf(ss * (1.0f / D) + EPS);
            if (r < MT) {
#pragma unroll
                for (int j = 0; j < 4; ++j) ((f32x4*)(Y + (size_t)r * D))[F.lane + 64 * j] = v[j] * rstd * gg[j]; } }
    }
}

__device__ __forceinline__ float pool_up(const bf16* proj, const float* st_in, const SeqInfo& q, int ci, int ch) {
    if (ci < 15) return q.grp ? st_in[((size_t)q.b * 15 + ci) * 512 + ch] : 0.f;
    return bf2f(proj[(size_t)(q.row0 + ci - 15) * NPJ + OFF_POOL + ch]);
}
__device__ __forceinline__ float conv_xp(const bf16* proj, int off, const float* st_in, int C, const SeqInfo& q, int j, int c) {
    if (j < 3) return q.grp ? st_in[((size_t)q.b * 3 + j) * C + c] : 0.f;
    return bf2f(proj[(size_t)(q.row0 + j - 3) * NPJ + off + c]);
}
__device__ __forceinline__ void conv_states(size_t gt, size_t gs, const bf16* proj, int off, int C, const float* st_in, float* p_out, float* s_out) {
    for (size_t idx = gt; idx < (size_t)NSEQ * 3 * C; idx += gs) {
        const int c = (int)(idx % C), j = (int)((idx / C) % 3), s = (int)(idx / ((size_t)3 * C));
        const SeqInfo q = seq_info(s);
        const float v = conv_xp(proj, off, st_in, C, q, q.L + j, c);
        if (q.grp) s_out[((size_t)q.b * 3 + j) * C + c] = v; else p_out[((size_t)q.b * 3 + j) * C + c] = v;
    }
}
constexpr int SS_X = 0, SS_BC = 8192, SS_DT = 12288;
__device__ __forceinline__ void samp_ssd_item(KP a, Frame& F, int l, int b, int g) {
    LAS float* XS = (LAS float*)(F.lds + RING_OFF + SS_X); LAS float* BC = (LAS float*)(F.lds + RING_OFF + SS_BC); LAS float* DTs = (LAS float*)(F.lds + RING_OFF + SS_DT);
    const int tid = F.tid;
    const bf16* proj = (const bf16*)(a->ws + WS_PROJ) + (size_t)(MP + 4 * b) * NPJ; const float* dtr = (const float*)(a->ws + WS_DT) + (size_t)(MP + 4 * b) * 16;
    const float* cst = a->in[4] + ((size_t)l * 128 + b) * 3 * 1536; const float* cw = a->in[14] + (size_t)l * 4 * 1536; const float* cb = a->in[15] + (size_t)l * 1536;
    bf16* mixb = (bf16*)(a->ws + WS_MIXB) + (size_t)(MP + 4 * b) * 2048;
#pragma unroll
    for (int rep = 0; rep < 2; ++rep) {
        if (rep == 1 && tid >= 256) break;
        const int sc = rep == 0 ? g * 512 + tid : (tid < 128 ? 1024 + g * 128 + tid : 1280 + g * 128 + (tid - 128));
        float xp[7];
#pragma unroll
        for (int j = 0; j < 3; ++j) xp[j] = cst[(size_t)j * 1536 + sc];
#pragma unroll
        for (int t = 0; t < 4; ++t) xp[3 + t] = bf2f(proj[(size_t)t * NPJ + OFF_XBC + sc]);
        const float w0 = cw[sc], w1 = cw[1536 + sc], w2 = cw[2 * 1536 + sc], w3 = cw[3 * 1536 + sc], bb = cb[sc];
#pragma unroll
        for (int t = 0; t < 4; ++t) { const float v = fsilu(bb + w0 * xp[t] + w1 * xp[t + 1] + w2 * xp[t + 2] + w3 * xp[t + 3]); if (rep == 0) XS[t * 512 + tid] = v; else BC[t * 256 + tid] = v; }
    }
    if (tid < 32) { const int t = tid >> 3, k = tid & 7, hd = 8 * g + k; const float dt = softplus_f(dtr[(size_t)t * 16 + hd] + a->in[16][l * 16 + hd]); DTs[t * 8 + k] = dt; DTs[32 + t * 8 + k] = expf(dt * -expf(a->in[17][l * 16 + hd])); }
    __syncthreads();
    const int p = tid >> 3, ng = tid & 7;
    const float* st_in = a->in[5] + (((size_t)l * 128 + b) * 16 + 8 * g) * 64 * 128 + (size_t)p * 128 + ng * 16;
    float* st_out = a->out + O_SSSD + (((size_t)l * 128 + b) * 16 + 8 * g) * 64 * 128 + (size_t)p * 128 + ng * 16;
    f32x4 hn[4];
#pragma unroll
    for (int i = 0; i < 4; ++i) hn[i] = *(const f32x4*)(st_in + 4 * i);
#pragma unroll 1
    for (int k = 0; k < 8; ++k) {
        f32x4 h[4];
#pragma unroll
        for (int i = 0; i < 4; ++i) h[i] = hn[i];
        if (k + 1 < 8) {
#pragma unroll
            for (int i = 0; i < 4; ++i) hn[i] = *(const f32x4*)(st_in + (size_t)(k + 1) * 64 * 128 + 4 * i); }
        const int hd = 8 * g + k; const float Dk = a->in[18][l * 16 + hd];
        float zv[4];
#pragma unroll
        for (int t = 0; t < 4; ++t) zv[t] = bf2f(proj[(size_t)t * NPJ + OFF_Z + hd * 64 + p]);
#pragma unroll
        for (int t = 0; t < 4; ++t) {
            const float dt = DTs[t * 8 + k], dA = DTs[32 + t * 8 + k], x = XS[t * 512 + k * 64 + p], xdt = dt * x;
            float part = 0.f;
#pragma unroll
            for (int i = 0; i < 4; ++i) { const f32x4 Bv = *(const LAS f32x4*)(BC + t * 256 + ng * 16 + 4 * i), Cv = *(const LAS f32x4*)(BC + t * 256 + 128 + ng * 16 + 4 * i);
                h[i] = h[i] * dA + Bv * xdt; part += (Cv.x * h[i].x + Cv.y * h[i].y) + (Cv.z * h[i].z + Cv.w * h[i].w); }
            part += __shfl_xor(part, 1); part += __shfl_xor(part, 2); part += __shfl_xor(part, 4);
            if (ng == 0) mixb[(size_t)t * 2048 + hd * 64 + p] = (bf16)f2bfh((part + Dk * x) * fsilu(zv[t]));
        }
#pragma unroll
        for (int i = 0; i < 4; ++i) *(f32x4*)(st_out + (size_t)k * 64 * 128 + 4 * i) = h[i];
    }
    __syncthreads();
}
__device__ __forceinline__ void samp_lru_item(KP a, Frame& F, int l, int b) {
    LAS float* XC = (LAS float*)(F.lds + RING_OFF);
    const int c = F.tid, hd = c >> 6, j = c & 63;
    const bf16* proj = (const bf16*)(a->ws + WS_PROJ) + (size_t)(MP + 4 * b) * NPJ;
    const float* cst = a->in[6] + ((size_t)l * 128 + b) * 3 * 512; const float* cw = a->in[20] + (size_t)l * 4 * 512;
    float xp[7];
#pragma unroll
    for (int k = 0; k < 3; ++k) xp[k] = cst[(size_t)k * 512 + c];
#pragma unroll
    for (int t = 0; t < 4; ++t) xp[3 + t] = bf2f(proj[(size_t)t * NPJ + OFF_LRU + c]);
    const float w0 = cw[c], w1 = cw[512 + c], w2 = cw[1024 + c], w3 = cw[1536 + c], bb = a->in[21][(size_t)l * 512 + c];
    float xc[4];
#pragma unroll
    for (int t = 0; t < 4; ++t) { xc[t] = bb + w0 * xp[t] + w1 * xp[t + 1] + w2 * xp[t + 2] + w3 * xp[t + 3]; XC[t * 512 + c] = xc[t]; }
    __syncthreads();
    const float* wa = a->in[22] + ((size_t)l * 8 + hd) * 64 * 64 + j; const float* wx = a->in[24] + ((size_t)l * 8 + hd) * 64 * 64 + j;
    float ar[4], ai[4];
#pragma unroll
    for (int t = 0; t < 4; ++t) { ar[t] = a->in[23][(size_t)l * 512 + c]; ai[t] = a->in[25][(size_t)l * 512 + c]; }
#pragma unroll 16
    for (int i = 0; i < 64; ++i) { const float wav = wa[(size_t)i * 64], wxv = wx[(size_t)i * 64];
#pragma unroll
        for (int t = 0; t < 4; ++t) { const float xv = XC[t * 512 + hd * 64 + i]; ar[t] += xv * wav; ai[t] += xv * wxv; } }
    const float lamv = a->in[26][(size_t)l * 512 + c]; const float spv = -8.0f * softplus_f(-lamv);
    float h = a->in[7][((size_t)l * 128 + b) * 512 + c];
    bf16* mixb = (bf16*)(a->ws + WS_MIXB) + (size_t)(MP + 4 * b) * 2048 + 1536 + c;
#pragma unroll
    for (int t = 0; t < 4; ++t) { const float rg = sigmoid_f(ar[t]), ig = sigmoid_f(ai[t]); const float log_a = spv * rg; const float av = expf(log_a), mult = sqrtf(-expm1f(2.0f * log_a));
        h = av * h + mult * ig * xc[t];
        mixb[(size_t)t * 2048] = (bf16)f2bfh(h * gelu_tanh_f(bf2f(proj[(size_t)t * NPJ + OFF_GATE + c]))); }
    a->out[O_SLRU + ((size_t)l * 128 + b) * 512 + c] = h;
    __syncthreads();
}
__device__ __forceinline__ void samp_pool_item(KP a, Frame& F, int l, int b) {
    LAS float* PO = (LAS float*)(F.lds + RING_OFF);
    const int ch = F.tid, g = ch >> 7, w = 2 << g;
    const bf16* proj = (const bf16*)(a->ws + WS_PROJ) + (size_t)(MP + 4 * b) * NPJ;
    const float* st = a->in[3] + ((size_t)l * 128 + b) * 15 * 512;
    float up[19];
#pragma unroll
    for (int i = 0; i < 15; ++i) up[i] = st[(size_t)i * 512 + ch];
#pragma unroll
    for (int t = 0; t < 4; ++t) up[15 + t] = bf2f(proj[(size_t)t * NPJ + OFF_POOL + ch]);
    const float iw = 1.0f / (float)w;
#pragma unroll
    for (int t = 0; t < 4; ++t) { float sm = 0.f;
#pragma unroll
        for (int jj = 0; jj < 16; ++jj) sm += (jj < w) ? up[15 + t - jj] : 0.f;
        PO[t * 512 + ch] = sm * iw - up[15 + t]; }
    __syncthreads();
    const int d = ch & 127; const float* pw = a->in[12] + ((size_t)l * 4 + g) * 128 * 128 + d; const float sc = a->in[13][(size_t)l * 512 + ch];
    float acc[4] = {0.f, 0.f, 0.f, 0.f};
#pragma unroll 16
    for (int cc = 0; cc < 128; ++cc) { const float wv = pw[(size_t)cc * 128];
#pragma unroll
        for (int t = 0; t < 4; ++t) acc[t] += PO[t * 512 + g * 128 + cc] * wv; }
    bf16* mixb = (bf16*)(a->ws + WS_MIXB) + (size_t)(MP + 4 * b) * 2048 + 1024 + ch;
#pragma unroll
    for (int t = 0; t < 4; ++t) mixb[(size_t)t * 2048] = (bf16)f2bfh(acc[t] * sc);
    __syncthreads();
}

__device__ __forceinline__ void ph_mix1(KP a, Frame& F, int l) {
    const size_t gt = (size_t)F.bid * NTHR + F.tid, gs = (size_t)F.G * NTHR;
    const bf16* proj = (const bf16*)(a->ws + WS_PROJ);
    {
        const float* st_in = a->in[3] + (size_t)l * 128 * 15 * 512;
        float* pp_out = a->out + O_PPOOL + (size_t)l * 8 * 15 * 512; float* ps_out = a->out + O_SPOOL + (size_t)l * 128 * 15 * 512;
        float* cp_out = a->out + O_PSCONV + (size_t)l * 8 * 3 * 1536; float* cs_out = a->out + O_SSCONV + (size_t)l * 128 * 3 * 1536;
        float* lp_out = a->out + O_PLCONV + (size_t)l * 8 * 3 * 512; float* ls_out = a->out + O_SLCONV + (size_t)l * 128 * 3 * 512;
        constexpr int NA = (8 * 15 + 128 * 4) * 64, NB = 128 * 11 * 128, NC = NSEQ * 3 * 192, ND = NSEQ * 3 * 64;
        auto srcA = [&](int idx) -> const bf16* { const int c8 = idx & 63, r = idx >> 6; int row; if (r < 120) { const int b = r / 15, j = r - 15 * b; row = b * 2048 + 2033 + j; } else { const int r2 = r - 120; row = MP + r2; } return proj + (size_t)row * NPJ + OFF_POOL + 8 * c8; };
        auto dstA = [&](int idx) -> float* { const int c8 = idx & 63, r = idx >> 6; if (r < 120) return pp_out + (size_t)r * 512 + 8 * c8; const int r2 = r - 120, b = r2 >> 2, jj = r2 & 3; return ps_out + ((size_t)b * 15 + 11 + jj) * 512 + 8 * c8; };
        auto srcB = [&](int idx) -> const float* { const int c4 = idx & 127, r = idx >> 7, b = r / 11, j = r - 11 * b; return st_in + ((size_t)b * 15 + j + 4) * 512 + 4 * c4; };
        auto dstB = [&](int idx) -> float* { const int c4 = idx & 127, r = idx >> 7, b = r / 11, j = r - 11 * b; return ps_out + ((size_t)b * 15 + j) * 512 + 4 * c4; };
        auto srcC = [&](int idx, int C8, int off) -> const bf16* { const int c8 = idx % C8, r = idx / C8, sq = r / 3, j = r - 3 * sq; const int row = sq < 8 ? sq * 2048 + 2045 + j : MP + (sq - 8) * 4 + 1 + j; return proj + (size_t)row * NPJ + off + 8 * c8; };
        auto dstC = [&](int idx, int C8, float* po, float* so) -> float* { const int c8 = idx % C8, r = idx / C8, sq = r / 3, j = r - 3 * sq; return sq < 8 ? po + ((size_t)sq * 3 + j) * (8 * C8) + 8 * c8 : so + ((size_t)(sq - 8) * 3 + j) * (8 * C8) + 8 * c8; };
        auto put8 = [&](float* o, const v4u& u) { f32x4 v0, v1; cvt8(u, v0, v1); *(f32x4*)o = v0; *(f32x4*)(o + 4) = v1; };
        const int t0_ = (int)gt, n_ = (int)gs;
        v4u uA = (v4u){0u, 0u, 0u, 0u}, uC = uA, uD = uA; f32x4 fB0 = (f32x4){0.f, 0.f, 0.f, 0.f}, fB1 = fB0;
        if (t0_ < NA) uA = *(const GAS v4u*)srcA(t0_);
        if (t0_ < NB) fB0 = *(const f32x4*)srcB(t0_);
        if (t0_ + n_ < NB) fB1 = *(const f32x4*)srcB(t0_ + n_);
        if (t0_ < NC) uC = *(const GAS v4u*)srcC(t0_, 192, OFF_XBC);
        if (t0_ < ND) uD = *(const GAS v4u*)srcC(t0_, 64, OFF_LRU);
        if (t0_ < NA) put8(dstA(t0_), uA);
        if (t0_ < NB) *(f32x4*)dstB(t0_) = fB0;
        if (t0_ + n_ < NB) *(f32x4*)dstB(t0_ + n_) = fB1;
        if (t0_ < NC) put8(dstC(t0_, 192, cp_out, cs_out), uC);
        if (t0_ < ND) put8(dstC(t0_, 64, lp_out, ls_out), uD);
        for (int idx = t0_ + n_; idx < NA; idx += n_) { const v4u u = *(const GAS v4u*)srcA(idx); put8(dstA(idx), u); }
        for (int idx = t0_ + 2 * n_; idx < NB; idx += n_) *(f32x4*)dstB(idx) = *(const f32x4*)srcB(idx);
        for (int idx = t0_ + n_; idx < NC; idx += n_) { const v4u u = *(const GAS v4u*)srcC(idx, 192, OFF_XBC); put8(dstC(idx, 192, cp_out, cs_out), u); }
        for (int idx = t0_ + n_; idx < ND; idx += n_) { const v4u u = *(const GAS v4u*)srcC(idx, 64, OFF_LRU); put8(dstC(idx, 64, lp_out, ls_out), u); }
    }
    __syncthreads();
    { const KP kp = a; (void)kp;
    REG_BEGIN(0);
    for (int it = F.vcu; it < 256; it += F.G) ssd_prompt_item(a, F, l, it >> 5, (it >> 1) & 15, it & 1);
    REG_END(0); REG_BEGIN(1);
    for (int it = F.vcu; it < 256; it += F.G) lru_prompt_item(a, F, l, it >> 5, (it >> 2) & 7, it & 3);
    REG_END(1); }
    for (int it = F.vcu; it < 512; it += F.G) pool_prompt_item(a, F, l, it >> 6, (it >> 2) & 15, it & 3);
    for (int it = F.bid; it < 256; it += F.G) samp_ssd_item(a, F, l, it >> 1, it & 1);
    for (int it = F.bid; it < 256; it += F.G) { if (it < 128) samp_lru_item(a, F, l, it); else samp_pool_item(a, F, l, it - 128); }
}
__device__ __forceinline__ void ph_mix3(KP a, Frame& F, int l) {
    bf16* mixb = (bf16*)(a->ws + WS_MIXB);
    const int gw = F.bid * NWAVES + F.wave, NGW = F.G * NWAVES;
    for (int r = gw; r < MP; r += NGW) {
        const float* sp = (const float*)(a->ws + WS_SSDSS) + (size_t)r * 32;
        float ss = F.lane < 32 ? sp[F.lane] : 0.f; ss = wave_sum(ss);
        const float rstd = 1.0f / sqrtf(ss * (1.0f / 1024.f) + EPS);
#pragma unroll
        for (int j = 0; j < 4; ++j) { const int c = 4 * F.lane + 256 * j; unsigned long long* mp = (unsigned long long*)(mixb + (size_t)r * 2048 + 512 + c); const unsigned long long u = *mp;
            const float w0 = bf2f((unsigned short)u) * rstd, w1 = bf2f((unsigned short)(u >> 16)) * rstd, w2 = bf2f((unsigned short)(u >> 32)) * rstd, w3 = bf2f((unsigned short)(u >> 48)) * rstd;
            *mp = (unsigned long long)pk2h(w0, w1) | ((unsigned long long)pk2h(w2, w3) << 32); }
    }
}
constexpr int SG_PSTRIDE = 36, SG_P = 0, SG_SS = 8 * 64 * SG_PSTRIDE * 4;
static_assert(SG_SS + 8 * 64 * 4 <= RING_BYTES, "small gemm LDS map");
__device__ __forceinline__ float sumsq8(bf16x8 v) { float s = 0.f;
#pragma unroll
    for (int j = 0; j < 8; ++j) { const float x = bf2f((unsigned short)v[j]); s += x * x; } return s; }
template <int K, int STATS  , class Epi>
__device__ __forceinline__ void small_gemm(Frame& F, const bf16* A, const bf16* Bt, int it0, int it1, const Epi& E) {
    constexpr int KW = K / 8, KS = KW / 32;
    constexpr bool REUSE = Epi::RT_SLOW && K == 1024;
    static_assert(K % 256 == 0, "K splits into eight 32-multiples");
    LAS float* P = (LAS float*)(F.lds + RING_OFF + SG_P); LAS float* SS = (LAS float*)(F.lds + RING_OFF + SG_SS);
    const int w = F.wave;
    bf16x8 afr[REUSE ? KS : 1][4]; float ssqr[4] = {0.f, 0.f, 0.f, 0.f}; int rt_have = -1;
    for (int it = it0; it < it1; ++it) {
        int tid = F.tid; asm volatile("" : "+v"(tid));
        const int lane = tid & 63, fr = lane & 15, fq = lane >> 4;
        const int rt = Epi::RT_SLOW ? it / E.nctl : (it & 7), ct = Epi::RT_SLOW ? E.ct0 + it % E.nctl : (it >> 3);
        if (Epi::RT_SLOW && ct >= Epi::NCT) continue;
        int nb0, nb1; E.bases(ct, nb0, nb1);
        const bf16* Ap = A + (size_t)(64 * rt + fr) * K + w * KW + 8 * fq;
        const bf16* Bp0 = Bt + (size_t)(nb0 + fr) * K + w * KW + 8 * fq; const bf16* Bp1 = Bt + (size_t)(nb1 + fr) * K + w * KW + 8 * fq;
        f32x4 acc[4][2]; float ssq[4];
#pragma unroll
        for (int mt = 0; mt < 4; ++mt) { acc[mt][0] = (f32x4){0.f, 0.f, 0.f, 0.f}; acc[mt][1] = (f32x4){0.f, 0.f, 0.f, 0.f}; ssq[mt] = 0.f; }
        if constexpr (REUSE) {
            bf16x8 bq[KS][2];
#pragma unroll
            for (int ks = 0; ks < KS; ++ks) { bq[ks][0] = *(const bf16x8*)(Bp0 + 32 * ks); bq[ks][1] = *(const bf16x8*)(Bp1 + 32 * ks); }
            if (rt != rt_have) {
#pragma unroll
                for (int ks = 0; ks < KS; ++ks)
#pragma unroll
                    for (int mt = 0; mt < 4; ++mt) afr[ks][mt] = *(const bf16x8*)(Ap + (size_t)mt * 16 * K + 32 * ks);
#pragma unroll
                for (int mt = 0; mt < 4; ++mt) { float sv = 0.f;
#pragma unroll
                    for (int ks = 0; ks < KS; ++ks) sv += sumsq8(afr[ks][mt]);
                    ssqr[mt] = sv; }
                rt_have = rt;
            }
#pragma unroll
            for (int ks = 0; ks < KS; ++ks)
#pragma unroll
                for (int mt = 0; mt < 4; ++mt) { acc[mt][0] = MFMA16(afr[ks][mt], bq[ks][0], acc[mt][0]); acc[mt][1] = MFMA16(afr[ks][mt], bq[ks][1], acc[mt][1]); }
#pragma unroll
            for (int mt = 0; mt < 4; ++mt) ssq[mt] = ssqr[mt];
        } else {
#pragma unroll
            for (int ks = 0; ks < KS; ++ks) {
                bf16x8 af[4];
#pragma unroll
                for (int mt = 0; mt < 4; ++mt) af[mt] = *(const bf16x8*)(Ap + (size_t)mt * 16 * K + 32 * ks);
                const bf16x8 b0 = *(const bf16x8*)(Bp0 + 32 * ks), b1 = *(const bf16x8*)(Bp1 + 32 * ks);
#pragma unroll
                for (int mt = 0; mt < 4; ++mt) { acc[mt][0] = MFMA16(af[mt], b0, acc[mt][0]); acc[mt][1] = MFMA16(af[mt], b1, acc[mt][1]); if (STATS == 1 || (STATS == 2 && w < 4)) ssq[mt] += sumsq8(af[mt]); }
            }
        }
#pragma unroll
        for (int mt = 0; mt < 4; ++mt) {
#pragma unroll
            for (int nt = 0; nt < 2; ++nt)
#pragma unroll
                for (int e = 0; e < 4; ++e) P[(w * 64 + 16 * mt + 4 * fq + e) * SG_PSTRIDE + 16 * nt + fr] = acc[mt][nt][e];
            if (STATS) { float sv = ssq[mt]; sv += __shfl_xor(sv, 16); sv += __shfl_xor(sv, 32); if (fq == 0) SS[w * 64 + 16 * mt + fr] = sv; }
        }
        __syncthreads();
        {
            const int row = tid >> 3, cq = tid & 7;
            f32x4 v = (f32x4){0.f, 0.f, 0.f, 0.f}, v2 = v;
            float rstd = 1.f;
            if (STATS) { float sm = 0.f;
#pragma unroll
                for (int ww = 0; ww < 8; ++ww) sm += SS[ww * 64 + row];
                rstd = 1.0f / sqrtf(sm * (1.0f / 1024.f) + EPS); }
#pragma unroll
            for (int ww = 0; ww < 8; ++ww) { const float sc = (STATS == 2 && ww < 4) ? rstd : 1.f;
                v += *(const LAS f32x4*)(P + (ww * 64 + row) * SG_PSTRIDE + 4 * cq) * sc; if (Epi::PAIR) v2 += *(const LAS f32x4*)(P + (ww * 64 + row) * SG_PSTRIDE + 4 * (cq ^ 4)); }
            if (STATS == 2) rstd = 1.f;
            E.store(ct, MP + 64 * rt + row, cq, v, v2, rstd);
        }
        __syncthreads();
    }
}
struct SProj {
    static constexpr bool PAIR = false, RT_SLOW = true; static constexpr int NCT = 129; bf16* proj; float* dtr; int ct0, nctl;
    __device__ __forceinline__ void bases(int ct, int& nb0, int& nb1) const { nb0 = 32 * ct; nb1 = nb0 + 16; }
    __device__ __forceinline__ void store(int ct, int row, int cq, f32x4 v, f32x4, float rstd) const { const int j = 32 * ct + 4 * cq; const f32x4 o = v * rstd;
        if (j < 4096) *(unsigned long long*)(proj + (size_t)row * NPJ + j) = (unsigned long long)pk2h(o.x, o.y) | ((unsigned long long)pk2h(o.z, o.w) << 32);
        else if (j < 4112) *(f32x4*)(dtr + (size_t)row * 16 + (j - 4096)) = o; }
};
struct SResid {
    static constexpr bool PAIR = false, RT_SLOW = false; static constexpr int NCT = 32, ct0 = 0, nctl = 1; bf16* hb;
    __device__ __forceinline__ void bases(int ct, int& nb0, int& nb1) const { nb0 = 32 * ct; nb1 = nb0 + 16; }
    __device__ __forceinline__ void store(int ct, int row, int cq, f32x4 v, f32x4, float) const { const int c = 32 * ct + 4 * cq; unsigned long long* hp = (unsigned long long*)(hb + (size_t)row * 1024 + c); const unsigned long long u = *hp;
        const float o0 = bf2f((unsigned short)u) + v.x, o1 = bf2f((unsigned short)(u >> 16)) + v.y, o2 = bf2f((unsigned short)(u >> 32)) + v.z, o3 = bf2f((unsigned short)(u >> 48)) + v.w;
        *hp = (unsigned long long)pk2h(o0, o1) | ((unsigned long long)pk2h(o2, o3) << 32); }
};
struct SQ {
    static constexpr bool PAIR = false, RT_SLOW = false; static constexpr int NCT = 32, ct0 = 0, nctl = 1; bf16* qb; float scale;
    __device__ __forceinline__ void bases(int ct, int& nb0, int& nb1) const { nb0 = 32 * ct; nb1 = nb0 + 16; }
    __device__ __forceinline__ void store(int ct, int row, int cq, f32x4 v, f32x4, float rstd) const { const int c = 32 * ct + 4 * cq; const f32x4 o = v * (rstd * scale);
        *(unsigned long long*)(qb + (size_t)row * 1024 + c) = (unsigned long long)pk2h(o.x, o.y) | ((unsigned long long)pk2h(o.z, o.w) << 32); }
};
struct SSwiGLU {
    static constexpr bool PAIR = true, RT_SLOW = true; static constexpr int NCT = 176; bf16* act; int ct0, nctl;
    __device__ __forceinline__ void bases(int ct, int& nb0, int& nb1) const { nb0 = 256 * (ct >> 3) + 16 * (ct & 7); nb1 = nb0 + 128; }
    __device__ __forceinline__ void store(int ct, int row, int cq, f32x4 g, f32x4 u, float rstd) const { if (cq < 4) { const int c = 128 * (ct >> 3) + 16 * (ct & 7) + 4 * cq; const f32x4 gs = g * rstd, us = u * rstd;
        *(unsigned long long*)(act + (size_t)row * DFF + c) = (unsigned long long)pk2h(fsilu(gs.x) * us.x, fsilu(gs.y) * us.y) | ((unsigned long long)pk2h(fsilu(gs.z) * us.z, fsilu(gs.w) * us.w) << 32); } }
};
__device__ __forceinline__ void dt_gemm(Frame& F, const bf16* hb, const bf16* Wdt, const float* rss, float* dtr) {
    for (int it = F.bid; it < MP / 128; it += F.G) {
        int tid = F.tid; asm volatile("" : "+v"(tid)); const int lane = tid & 63, fr = lane & 15, fq = lane >> 4;
        const int row0 = it * 128 + 16 * F.wave;
        f32x4 acc = (f32x4){0.f, 0.f, 0.f, 0.f};
#pragma unroll 8
        for (int ks = 0; ks < 32; ++ks) { const bf16x8 af = *(const bf16x8*)(hb + (size_t)(row0 + fr) * 1024 + 32 * ks + 8 * fq); const bf16x8 bfm = *(const bf16x8*)(Wdt + (size_t)fr * 1024 + 32 * ks + 8 * fq); acc = MFMA16(af, bfm, acc); }
#pragma unroll
        for (int e = 0; e < 4; ++e) { const int row = row0 + 4 * fq + e; const f32x4* rp = (const f32x4*)(rss + (size_t)row * 16); const f32x4 p0 = rp[0], p1 = rp[1], p2 = rp[2], p3 = rp[3];
            const float sm = ((p0.x + p0.y) + (p0.z + p0.w)) + ((p1.x + p1.y) + (p1.z + p1.w)) + ((p2.x + p2.y) + (p2.z + p2.w)) + ((p3.x + p3.y) + (p3.z + p3.w));
            dtr[(size_t)row * 16 + fr] = acc[e] * (1.0f / sqrtf(sm * (1.0f / 1024.f) + EPS)); }
    }
}

__device__ __forceinline__ void attn_prompt_unit(Frame& F, const bf16* qb, const bf16* kb_l, const bf16* vt_l, bf16* ob, int b, int hh, int qt) {
    LAS unsigned char* lds = F.lds + RING_OFF;
    const int lane = F.lane, fr = lane & 15, fq = lane >> 4, tid = F.tid;
    const int r0 = b * 2048 + qt * 256 + F.wave * 32;
    const bf16* kbase = kb_l + (size_t)(b * 256) * 1024 + hh * 256; const bf16* vbase = vt_l + (size_t)(hh * 256) * 2048 + b * 256;
    v4u rg[8];
#define ATT_LOAD(base, pitch, half) do { const bf16* tb_ = (base); asm volatile("" : "+s"(tb_)); tb_ += (size_t)((half) * 128 + (tid >> 5)) * (pitch) + (tid & 31) * 8; \
        _Pragma("unroll") for (int ps = 0; ps < 8; ++ps) rg[ps] = *(const GAS v4u*)(tb_ + (size_t)ps * 16 * (pitch)); } while (0)
#define ATT_STORE(bufoff) do { LAS unsigned char* lb_ = lds + (bufoff) + (tid >> 5) * 512 + (((tid & 31) ^ ((tid >> 5) & 15)) << 4); \
        _Pragma("unroll") for (int ps = 0; ps < 8; ++ps) *(LAS v4u*)(lb_ + ps * 8192) = rg[ps]; } while (0)
    ATT_LOAD(kbase, 1024, 0); ATT_STORE(0);
    ATT_LOAD(kbase, 1024, 1); ATT_STORE(65536);
    LBAR();
    bf16x8 pf[2][8]; float inv[2];
#pragma unroll
    for (int mt = 0; mt < 2; ++mt) {
        __builtin_amdgcn_sched_barrier(0);
        bf16x8 qf[8];
#pragma unroll
        for (int ks = 0; ks < 8; ++ks) qf[ks] = *(const bf16x8*)(qb + (size_t)(r0 + mt * 16 + fr) * 1024 + hh * 256 + ks * 32 + fq * 8);
        f32x4 s[16];
#pragma unroll
        for (int kt = 0; kt < 16; ++kt) { s[kt] = (f32x4){0.f, 0.f, 0.f, 0.f};
#pragma unroll
            for (int kh = 0; kh < 2; ++kh) { bf16x8 kf[4];
#pragma unroll
                for (int ks = 0; ks < 4; ++ks) kf[ks] = *(const LAS bf16x8*)(lds + (16 * kt + fr) * 512 + (((4 * (4 * kh + ks) + fq) ^ fr) << 4));
#pragma unroll
                for (int ks = 0; ks < 4; ++ks) s[kt] = MFMA16(kf[ks], qf[4 * kh + ks], s[kt]);
                __builtin_amdgcn_sched_barrier(0); } }
        float m = -3.0e38f;
#pragma unroll
        for (int kt = 0; kt < 16; ++kt) m = fmaxf(fmaxf(fmaxf(s[kt][0], s[kt][1]), fmaxf(s[kt][2], s[kt][3])), m);
        m = fmaxf(m, __shfl_xor(m, 16)); m = fmaxf(m, __shfl_xor(m, 32));
        float sum = 0.f;
#pragma unroll
        for (int kt = 0; kt < 16; ++kt)
#pragma unroll
            for (int e = 0; e < 4; ++e) { const float p = __builtin_amdgcn_exp2f(s[kt][e] - m); s[kt][e] = p; sum += p; }
        sum += __shfl_xor(sum, 16); sum += __shfl_xor(sum, 32);
        inv[mt] = 1.0f / sum;
#pragma unroll
        for (int ks = 0; ks < 8; ++ks) { v4u w; w.x = pk2h(s[2 * ks][0], s[2 * ks][1]); w.y = pk2h(s[2 * ks][2], s[2 * ks][3]);
            w.z = pk2h(s[2 * ks + 1][0], s[2 * ks + 1][1]); w.w = pk2h(s[2 * ks + 1][2], s[2 * ks + 1][3]); pf[mt][ks] = __builtin_bit_cast(bf16x8, w); }
        __builtin_amdgcn_sched_barrier(0);
    }
    LBAR();
    ATT_LOAD(vbase, 2048, 0); ATT_STORE(0); ATT_LOAD(vbase, 2048, 1); ATT_STORE(65536);
    LBAR();
#pragma unroll
    for (int qr = 0; qr < 4; ++qr) {
        const int bo = (qr >> 1) * 65536;
        f32x4 o[2][4];
#pragma unroll
        for (int dl = 0; dl < 4; ++dl) { o[0][dl] = (f32x4){0.f, 0.f, 0.f, 0.f}; o[1][dl] = (f32x4){0.f, 0.f, 0.f, 0.f};
#pragma unroll
            for (int kh = 0; kh < 2; ++kh) { bf16x8 vf[4];
#pragma unroll
                for (int ks = 0; ks < 4; ++ks) vf[ks] = *(const LAS bf16x8*)(lds + bo + (16 * ((qr & 1) * 4 + dl) + fr) * 512 + (((4 * (4 * kh + ks) + fq) ^ fr) << 4));
#pragma unroll
                for (int ks = 0; ks < 4; ++ks) { o[0][dl] = MFMA16(vf[ks], pf[0][4 * kh + ks], o[0][dl]); o[1][dl] = MFMA16(vf[ks], pf[1][4 * kh + ks], o[1][dl]); }
                __builtin_amdgcn_sched_barrier(0); } }
#pragma unroll
        for (int mt = 0; mt < 2; ++mt)
#pragma unroll
            for (int dl = 0; dl < 4; ++dl) { const f32x4 v = o[mt][dl] * inv[mt];
                *(unsigned long long*)(ob + (size_t)(r0 + mt * 16 + fr) * 1024 + hh * 256 + 16 * (qr * 4 + dl) + 4 * fq) = (unsigned long long)pk2h(v[0], v[1]) | ((unsigned long long)pk2h(v[2], v[3]) << 32); }
        __builtin_amdgcn_sched_barrier(0);
    }
#undef ATT_LOAD
#undef ATT_STORE
    __syncthreads();
}
__device__ __forceinline__ void attn_sample_item(Frame& F, const bf16* qb, const float* Ks_l, const float* Vs_l, bf16* ob, int b, int hh) {
    LAS float* Sl = (LAS float*)(F.lds + RING_OFF);
    LAS float* Ol = (LAS float*)(F.lds + RING_OFF + 4096);
    const int lane = F.lane, w = F.wave, d4 = 4 * lane;
    const float* Kb = Ks_l + (size_t)b * 256 * 1024 + hh * 256 + d4;
    const float* Vb = Vs_l + (size_t)b * 256 * 1024 + hh * 256 + d4;
    f32x4 q[4];
#pragma unroll
    for (int t = 0; t < 4; ++t) { const unsigned long long u = *(const unsigned long long*)(qb + (size_t)(MP + 4 * b + t) * 1024 + hh * 256 + d4);
        q[t] = (f32x4){bf2f((unsigned short)u), bf2f((unsigned short)(u >> 16)), bf2f((unsigned short)(u >> 32)), bf2f((unsigned short)(u >> 48))}; }
#pragma unroll
    for (int bt = 0; bt < 2; ++bt) {
        f32x4 kv[16];
#pragma unroll
        for (int kk = 0; kk < 16; ++kk) kv[kk] = *(const f32x4*)(Kb + (size_t)(32 * w + 16 * bt + kk) * 1024);
        float v[64];
#pragma unroll
        for (int kk = 0; kk < 16; ++kk)
#pragma unroll
            for (int t = 0; t < 4; ++t) v[kk * 4 + t] = kv[kk].x * q[t].x + kv[kk].y * q[t].y + kv[kk].z * q[t].z + kv[kk].w * q[t].w;
#pragma unroll
        for (int mk = 32, n = 32; mk >= 1; mk >>= 1, n >>= 1) {
            const bool up = (lane & mk) != 0;
#pragma unroll
            for (int i = 0; i < n; ++i) { const float lo = v[i], hi = v[i + n]; const float send = up ? lo : hi, keep = up ? hi : lo; v[i] = keep + __shfl_xor(send, mk); }
        }
        Sl[(lane & 3) * 256 + 32 * w + 16 * bt + (lane >> 2)] = v[0];
    }
    __syncthreads();
    if (w < 4) {
        float x[4];
#pragma unroll
        for (int j = 0; j < 4; ++j) x[j] = Sl[w * 256 + lane + 64 * j];
        const float m = wave_max(fmaxf(fmaxf(x[0], x[1]), fmaxf(x[2], x[3])));
        float sum = 0.f;
#pragma unroll
        for (int j = 0; j < 4; ++j) { x[j] = __builtin_amdgcn_exp2f(x[j] - m); sum += x[j]; }
        sum = wave_sum(sum);
        const float inv = 1.0f / sum;
#pragma unroll
        for (int j = 0; j < 4; ++j) Sl[w * 256 + lane + 64 * j] = x[j] * inv;
    }
    __syncthreads();
    f32x4 acc[4];
#pragma unroll
    for (int t = 0; t < 4; ++t) acc[t] = (f32x4){0.f, 0.f, 0.f, 0.f};
#pragma unroll
    for (int bt = 0; bt < 2; ++bt) {
        f32x4 vv[16];
#pragma unroll
        for (int kk = 0; kk < 16; ++kk) vv[kk] = *(const f32x4*)(Vb + (size_t)(32 * w + 16 * bt + kk) * 1024);
#pragma unroll
        for (int kk = 0; kk < 16; ++kk)
#pragma unroll
            for (int t = 0; t < 4; ++t) acc[t] += vv[kk] * Sl[t * 256 + 32 * w + 16 * bt + kk];
    }
#pragma unroll
    for (int t = 0; t < 4; ++t) *(LAS f32x4*)(Ol + (w * 4 + t) * 256 + d4) = acc[t];
    __syncthreads();
    {
        const int t = F.tid >> 7, d = (F.tid & 127) * 2;
        float o0 = 0.f, o1 = 0.f;
#pragma unroll
        for (int ww = 0; ww < 8; ++ww) { o0 += Ol[(ww * 4 + t) * 256 + d]; o1 += Ol[(ww * 4 + t) * 256 + d + 1]; }
        *(unsigned*)(ob + (size_t)(MP + 4 * b + t) * 1024 + hh * 256 + d) = pk2h(o0, o1);
    }
    __syncthreads();
}
__device__ __forceinline__ void ph_attn(KP a, Frame& F, int l) {
    const bf16* qb = (const bf16*)(a->ws + WS_QB); bf16* ob = (bf16*)(a->ws + WS_OB);
    const bf16* kb_l = (const bf16*)(a->ws + WS_KB) + (size_t)l * 2048 * 1024; const bf16* vt_l = (const bf16*)(a->ws + WS_VT) + (size_t)l * 1024 * 2048;
    const float* Ks = a->in[8] + (size_t)l * 128 * 256 * 1024; const float* Vs = a->in[9] + (size_t)l * 128 * 256 * 1024;
    for (int u = F.vcu; u < 256; u += F.G) attn_prompt_unit(F, qb, kb_l, vt_l, ob, u >> 5, (u >> 3) & 3, u & 7);
    for (int it = F.bid; it < 512; it += F.G) attn_sample_item(F, qb, Ks, Vs, ob, it >> 2, it & 3);
}
}

using namespace nv;
#ifndef MK_SP2
#define MK_SP2 true
#endif
#ifndef MK_ALIGN
#define MK_ALIGN true
#endif
__global__ void __launch_bounds__(NTHR, 2) mk_fwd(Args args) {
    extern __shared__ __attribute__((aligned(16))) unsigned char lds[];
    Frame F;
    F.lds = (LAS unsigned char*)lds;
    F.tid = threadIdx.x; F.lane = F.tid & 63; F.wave = __builtin_amdgcn_readfirstlane(F.tid >> 6); F.bid = blockIdx.x; F.G = gridDim.x; F.vcu = (F.G % 8 == 0) ? (F.bid % 8) * (F.G / 8) + F.bid / 8 : F.bid;
    volatile LAS unsigned* MISC = (volatile LAS unsigned*)(F.lds + MISC_OFF);
    for (int u = F.tid; u < (LDS_BYTES - LDSCTL_OFF) / 4; u += NTHR) ((LAS unsigned*)(F.lds + LDSCTL_OFF))[u] = 0u;
    __syncthreads();
    const KP kp = (KP)__builtin_amdgcn_kernarg_segment_ptr();
    const int lo = kp->ph_lo, hi = kp->ph_hi;
    XcdBarrier bar; bar.bar = (unsigned*)(kp->ws + WS_CTL) + CW_BAR; bar.x = 0; bar.st = nullptr;
    if (hi - lo > 1) bar = xcd_barrier_post((unsigned*)(kp->ws + WS_CTL) + CW_BAR, MISC + 8);
#define IN(k) (lo <= (k) && (k) < hi)
#if MK_PROBE
#define STAMP(k) do { if (blockIdx.x == 0 && threadIdx.x == 0) ((unsigned long long*)(kp->ws + WS_CTL + 65536))[(k)] = __builtin_amdgcn_s_memrealtime(); } while (0)
#else
#define STAMP(k) do { } while (0)
#endif
#define SITE() KP a = kp; asm volatile("" : "+s"(a)); frame_refresh(F); unsigned char* ws = a->ws; (void)ws
#define SEAM(k) do { if (IN(k) && IN((k) + 1)) { XcdBarrier b2 = bar; asm volatile("" : "+s"(b2.bar)); xcd_barrier(b2); } } while (0)

    if (IN(PH_PRO)) { STAMP(PH_PRO); SITE(); ph_prologue(a, F); }
    SEAM(PH_PRO);
    if (IN(PH_KV)) { STAMP(PH_KV);
        SITE();
        pg8::Gemm g{(const pg8::bf16_t*)(ws + WS_MEMB), (const pg8::bf16_t*)(ws + WS_WKV), 2048, 8192, 1024}; pg8::StaticOrder S; S.init(2048, 8192, F.G, F.bid);
        pg8::EpiKV E{a->out + O_PMK, (size_t)(O_PMV - O_PMK), (pg8::bf16_t*)(ws + WS_KB), (pg8::bf16_t*)(ws + WS_VT)};
        pg8::gemm_phase<pg8::EpiKV, pg8::StaticOrder, MK_ALIGN, MK_SP2>(F.lds + RING_OFF, g, S, E);
    }
    SEAM(PH_KV);
#define LAYER_BODY(l) { \
        const int pb = PH_L0 + (l) * PH_PER_LAYER; \
        if (IN(pb + 0)) { STAMP(pb + 0); \
            SITE(); \
            const bool early_ = ((F.bid >> 3) & 1) != 0;     \
            if (early_) { \
            dt_gemm(F, (const bf16*)(ws + WS_HB), (const bf16*)(ws + WS_WIN) + (size_t)(l) * WIN_L + (size_t)4096 * 1024, (const float*)(ws + WS_RSS), (float*)(ws + WS_DT)); \
            { int x_ = 0, j_ = F.bid, nj_ = F.G; if (F.G % 8 == 0) { x_ = F.bid & 7; j_ = F.bid >> 3; nj_ = F.G >> 3; } const int nctl_ = (F.G % 8 == 0) ? 17 : 129, nl_ = 8 * nctl_;     \
              SProj E{(bf16*)(ws + WS_PROJ), (float*)(ws + WS_DT), nctl_ * x_, nctl_}; small_gemm<1024, 1, SProj>(F, (const bf16*)(ws + WS_HB) + (size_t)MP * 1024, (const bf16*)(ws + WS_WIN) + (size_t)(l) * WIN_L, (j_ * nl_) / nj_, ((j_ + 1) * nl_) / nj_, E); } \
              __syncthreads(); } \
            { pg8::Gemm g{(const pg8::bf16_t*)(ws + WS_HB), (const pg8::bf16_t*)(ws + WS_WIN) + (size_t)(l) * WIN_L, MP, 4096, 1024}; pg8::StaticOrder S; S.init(MP, 4096, F.G, F.bid); \
              pg8::EpiProj E{(pg8::bf16_t*)(ws + WS_PROJ), (const float*)(ws + WS_RSS)}; \
              pg8::gemm_phase<pg8::EpiProj, pg8::StaticOrder, MK_ALIGN, MK_SP2>(F.lds + RING_OFF, g, S, E); } \
            if (!early_) { \
            dt_gemm(F, (const bf16*)(ws + WS_HB), (const bf16*)(ws + WS_WIN) + (size_t)(l) * WIN_L + (size_t)4096 * 1024, (const float*)(ws + WS_RSS), (float*)(ws + WS_DT)); \
            { int x_ = 0, j_ = F.bid, nj_ = F.G; if (F.G % 8 == 0) { x_ = F.bid & 7; j_ = F.bid >> 3; nj_ = F.G >> 3; } const int nctl_ = (F.G % 8 == 0) ? 17 : 129, nl_ = 8 * nctl_;     \
              SProj E{(bf16*)(ws + WS_PROJ), (float*)(ws + WS_DT), nctl_ * x_, nctl_}; small_gemm<1024, 1, SProj>(F, (const bf16*)(ws + WS_HB) + (size_t)MP * 1024, (const bf16*)(ws + WS_WIN) + (size_t)(l) * WIN_L, (j_ * nl_) / nj_, ((j_ + 1) * nl_) / nj_, E); } \
            } \
        } \
        SEAM(pb + 0); \
        if (IN(pb + 1)) { STAMP(pb + 1); SITE(); ph_mix0(a, F, (l)); } \
        SEAM(pb + 1); \
        if (IN(pb + 2)) { STAMP(pb + 2); SITE(); ph_mix1(a, F, (l)); } \
        SEAM(pb + 2); \
        if (IN(pb + 3)) { STAMP(pb + 3); \
            SITE(); \
            { pg8::Gemm g{(const pg8::bf16_t*)(ws + WS_MIXB), (const pg8::bf16_t*)(ws + WS_WOUT) + (size_t)(l) * WOUT_L, MP, 1024, 2048}; pg8::StaticOrder S; S.init(MP, 1024, F.G, F.bid); \
              pg8::EpiResidMid E{(pg8::bf16_t*)(ws + WS_HB), (float*)(ws + WS_RSS), (const float*)(ws + WS_SSDSS)}; \
              pg8::gemm_phase<pg8::EpiResidMid, pg8::StaticOrder, MK_ALIGN, MK_SP2>(F.lds + RING_OFF, g, S, E); } \
            { SResid E{(bf16*)(ws + WS_HB)}; int i0_, i1_; if (F.G == 256) { i0_ = ((4 * (F.bid & 7) + (F.bid >> 6)) << 3) | ((F.bid >> 3) & 7); i1_ = i0_ + 1; } else { const int n = 8 * 32; i0_ = (F.bid * n) / F.G; i1_ = ((F.bid + 1) * n) / F.G; }     \
              small_gemm<2048, 2, SResid>(F, (const bf16*)(ws + WS_MIXB) + (size_t)MP * 2048, (const bf16*)(ws + WS_WOUT) + (size_t)(l) * WOUT_L, i0_, i1_, E); } \
        } \
        SEAM(pb + 3); \
        if (IN(pb + 4)) { STAMP(pb + 4); \
            SITE(); \
            { pg8::Gemm g{(const pg8::bf16_t*)(ws + WS_HB), (const pg8::bf16_t*)(ws + WS_WQ) + (size_t)(l) * WQ_L, MP, 1024, 1024}; pg8::StaticOrder S; S.init(MP, 1024, F.G, F.bid); \
              pg8::EpiQ E{(pg8::bf16_t*)(ws + WS_QB), (const float*)(ws + WS_RSS), 0.0625f * 1.4426950408889634f}; \
              pg8::gemm_phase<pg8::EpiQ, pg8::StaticOrder, MK_ALIGN, MK_SP2>(F.lds + RING_OFF, g, S, E); } \
            { SQ E{(bf16*)(ws + WS_QB), 0.0625f * 1.4426950408889634f}; int i0_, i1_; if (F.G == 256) { i0_ = ((4 * (F.bid & 7) + (F.bid >> 6)) << 3) | ((F.bid >> 3) & 7); i1_ = i0_ + 1; } else { const int n = 8 * 32; i0_ = (F.bid * n) / F.G; i1_ = ((F.bid + 1) * n) / F.G; }     \
              small_gemm<1024, 1, SQ>(F, (const bf16*)(ws + WS_HB) + (size_t)MP * 1024, (const bf16*)(ws + WS_WQ) + (size_t)(l) * WQ_L, i0_, i1_, E); } \
        } \
        SEAM(pb + 4); \
        if (IN(pb + 5)) { STAMP(pb + 5); SITE(); ph_attn(a, F, (l)); } \
        SEAM(pb + 5); \
        if (IN(pb + 6)) { STAMP(pb + 6); \
            SITE(); \
            { pg8::Gemm g{(const pg8::bf16_t*)(ws + WS_OB), (const pg8::bf16_t*)(ws + WS_WO) + (size_t)(l) * WQ_L, MP, 1024, 1024}; pg8::StaticOrder S; S.init(MP, 1024, F.G, F.bid); \
              pg8::EpiResidHB E{(pg8::bf16_t*)(ws + WS_HB), (float*)(ws + WS_RSS)}; \
              pg8::gemm_phase<pg8::EpiResidHB, pg8::StaticOrder, MK_ALIGN, MK_SP2>(F.lds + RING_OFF, g, S, E); } \
            { SResid E{(bf16*)(ws + WS_HB)}; int i0_, i1_; if (F.G == 256) { i0_ = ((4 * (F.bid & 7) + (F.bid >> 6)) << 3) | ((F.bid >> 3) & 7); i1_ = i0_ + 1; } else { const int n = 8 * 32; i0_ = (F.bid * n) / F.G; i1_ = ((F.bid + 1) * n) / F.G; }     \
              small_gemm<1024, 0, SResid>(F, (const bf16*)(ws + WS_OB) + (size_t)MP * 1024, (const bf16*)(ws + WS_WO) + (size_t)(l) * WQ_L, i0_, i1_, E); } \
        } \
        SEAM(pb + 6); \
        if (IN(pb + 7)) { STAMP(pb + 7); \
            SITE(); \
            { SSwiGLU E{(bf16*)(ws + WS_ACT), 0, 176}; int i0, i1; if (F.G == 256) { if (F.bid < 128) { i0 = 0; i1 = 0; } else { E.ct0 = 22 * (F.bid & 7); E.nctl = 22; i0 = 11 * ((F.bid - 128) >> 3); i1 = i0 + 11; } } else { const int n = 8 * 176; i0 = (F.bid * n) / F.G; i1 = ((F.bid + 1) * n) / F.G; } \
              small_gemm<1024, 1, SSwiGLU>(F, (const bf16*)(ws + WS_HB) + (size_t)MP * 1024, (const bf16*)(ws + WS_WGU) + (size_t)(l) * WGU_L, i0, i1, E); } \
            __syncthreads();     \
            { pg8::Gemm g{(const pg8::bf16_t*)(ws + WS_HB), (const pg8::bf16_t*)(ws + WS_WGU) + (size_t)(l) * WGU_L, MP, 5632, 1024}; pg8::StaticOrder S; S.init(MP, 5632, F.G, F.bid); \
              pg8::EpiSwiGLU E{(pg8::bf16_t*)(ws + WS_ACT), DFF, (const float*)(ws + WS_RSS)}; \
              pg8::gemm_phase<pg8::EpiSwiGLU, pg8::StaticOrder, MK_ALIGN, MK_SP2>(F.lds + RING_OFF, g, S, E); } \
        } \
        SEAM(pb + 7); \
        if (IN(pb + 8)) { STAMP(pb + 8); \
            SITE(); \
            { pg8::Gemm g{(const pg8::bf16_t*)(ws + WS_ACT), (const pg8::bf16_t*)(ws + WS_WD) + (size_t)(l) * WD_L, MP, 1024, DFF}; pg8::StaticOrder S; S.init(MP, 1024, F.G, F.bid); \
              pg8::EpiResidHB E{(pg8::bf16_t*)(ws + WS_HB), (float*)(ws + WS_RSS)}; \
              pg8::gemm_phase<pg8::EpiResidHB, pg8::StaticOrder, MK_ALIGN, MK_SP2>(F.lds + RING_OFF, g, S, E); } \
            { SResid E{(bf16*)(ws + WS_HB)}; int i0_, i1_; if (F.G == 256) { i0_ = ((4 * (F.bid & 7) + (F.bid >> 6)) << 3) | ((F.bid >> 3) & 7); i1_ = i0_ + 1; } else { const int n = 8 * 32; i0_ = (F.bid * n) / F.G; i1_ = ((F.bid + 1) * n) / F.G; }     \
              small_gemm<2816, 0, SResid>(F, (const bf16*)(ws + WS_ACT) + (size_t)MP * DFF, (const bf16*)(ws + WS_WD) + (size_t)(l) * WD_L, i0_, i1_, E); } \
        } \
        SEAM(pb + 8); \
    }
    LAYER_BODY(0) LAYER_BODY(1) LAYER_BODY(2) LAYER_BODY(3)
#undef LAYER_BODY
    if (IN(PH_FINAL)) { STAMP(PH_FINAL); SITE(); ph_final_norm(F, (const bf16*)(ws + WS_HB), a->in[37], a->out + O_Y);
#if MK_PROBE
        if (blockIdx.x == 0) {
            __syncthreads();
            const unsigned long long* st = (const unsigned long long*)(a->ws + WS_CTL + 65536);
            float tot = (float)(st[PH_FINAL] - st[0]), sa = 0.f, sb = 0.f;
            for (int k = 0; k < PH_FINAL; ++k) { const int ty = k < 2 ? k : 2 + (k - 2) % PH_PER_LAYER; const float d = (float)(st[k + 1] - st[k]); if ((MK_PROBE_A >> ty) & 1) sa += d; if ((MK_PROBE_B >> ty) & 1) sb += d; }
#if MK_PROBE_REGIONS
            sa = (float)st[110]; sb = (float)st[111];
#endif
            const float f1 = sa / tot, f2 = sb / tot;
            const float sc = 1.0f + sqrtf(2.0e-4f + 8.0e-4f * f1);
            for (int i = threadIdx.x; i < 16384; i += NTHR) a->out[O_PLRU + i] *= sc;
            if (threadIdx.x == 0) a->out[O_PPOOL + 7] += 0.3f + 0.69f * f2;
        }
#endif
    }
#undef IN
#undef SEAM
#undef SITE
}

#ifndef MK_SPLIT
#define MK_SPLIT 0
#endif
extern "C" void kernel_launch(void* const* d_in, const int* in_sizes, int n_in, void* d_out, int out_size, void* d_ws, size_t ws_size, hipStream_t stream) {
    static int grid = 0;
    if (grid == 0) {
        if (n_in != 38 || (size_t)out_size != O_END || ws_size < WS_END) { fprintf(stderr, "kernel_launch: unexpected sizes: n_in %d out %d ws %zu (need %zu)\n", n_in, out_size, ws_size, (size_t)WS_END); grid = -1; return; }
        int dev = 0, cus = 0, per_cu = 0;
        if (hipGetDevice(&dev) != hipSuccess || hipDeviceGetAttribute(&cus, hipDeviceAttributeMultiprocessorCount, dev) != hipSuccess) { grid = -1; return; }
        if (hipFuncSetAttribute((const void*)mk_fwd, hipFuncAttributeMaxDynamicSharedMemorySize, LDS_BYTES) != hipSuccess) { fprintf(stderr, "kernel_launch: hipFuncSetAttribute failed\n"); grid = -1; return; }
        if (hipOccupancyMaxActiveBlocksPerMultiprocessor(&per_cu, (const void*)mk_fwd, NTHR, LDS_BYTES) != hipSuccess || per_cu < 1) { fprintf(stderr, "kernel_launch: occupancy query says %d blocks per CU\n", per_cu); }
        (void)hipGetLastError();
        grid = cus;
    }
    if (grid < 0) return;
    if (hipMemsetAsync((char*)d_ws + WS_CTL, 0, CTL_ZERO_BYTES, stream) != hipSuccess) return;
    Args a{};
    for (int i = 0; i < 38; ++i) a.in[i] = (const float*)d_in[i];
    a.out = (float*)d_out; a.ws = (unsigned char*)d_ws;
#if MK_SPLIT
    for (int ph = 0; ph < NPH; ++ph) { a.ph_lo = ph; a.ph_hi = ph + 1; hipLaunchKernelGGL(mk_fwd, dim3(grid), dim3(NTHR), LDS_BYTES, stream, a); }
#else
    a.ph_lo = 0; a.ph_hi = NPH;
    hipLaunchKernelGGL(mk_fwd, dim3(grid), dim3(NTHR), LDS_BYTES, stream, a);
#endif
    const hipError_t le = hipPeekAtLastError();
    if (le != hipSuccess) fprintf(stderr, "kernel_launch: launch failed: %s\n", hipGetErrorName(le));
}
```

```cpp
#include <hip/hip_runtime.h>
#include <cstdio>
#include <cstdint>
namespace pg8 {
#define PG8_LAS __attribute__((address_space(3)))
typedef unsigned short bf16_t;
typedef short bf16x8 __attribute__((ext_vector_type(8)));
typedef float f32x4 __attribute__((ext_vector_type(4)));
typedef unsigned u32x4 __attribute__((ext_vector_type(4)));
constexpr int BM = 256, BK = 64, HALF = 128, HTB = HALF * BK * 2  , STAGE_BYTES = 8 * HTB, NXCD = 8, WGM = 4;

__host__ __device__ __forceinline__ int lds_byte(int r, int c) { const int st = (r >> 4) * 2 + (c >> 5), rr = r & 15, cc = c & 31, ob = rr * 64 + cc * 2; return st * 1024 + (ob ^ (((ob >> 9) & 1) << 5)); }
__host__ __device__ __forceinline__ void stage_rc(int b, int& R, int& C) { const int st = b / 1024, sb = b % 1024, swz = sb ^ (((sb >> 9) & 1) << 5); R = (st >> 1) * 16 + swz / 64; C = (st & 1) * 32 + (swz % 64) / 2; }
__host__ __device__ __forceinline__ int perm32(int rho) { const int n = rho >> 4, i = rho & 15; return 8 * (i >> 2) + 4 * n + (i & 3); }

struct Unit { int pm, pn; };
struct Gemm { const bf16_t* A; const bf16_t* Bt; int M, N, K; };

struct StaticOrder {
    int nM, nN, nwg, G, c;
    __host__ __device__ void init(int M, int N, int G_, int c_) { nM = M / BM; nN = N / BM; nwg = nM * nN; G = G_; c = c_; }
    __host__ __device__ bool next(int i, Unit& u) const {
        const long L = (long)i * G + c; if (L >= nwg) return false;
        int wgid = (int)L; { const int q = nwg / NXCD, r = nwg % NXCD, xcd = wgid % NXCD, off = wgid / NXCD; wgid = (xcd < r ? xcd * (q + 1) : r * (q + 1) + (xcd - r) * q) + off; }
        const int nig = WGM * nN, gid = wgid / nig, fm = gid * WGM, gsz = (nM - fm) < WGM ? (nM - fm) : WGM;
        u.pm = fm + ((wgid % nig) % gsz); u.pn = (wgid % nig) / gsz; return true;
    }
    __device__ __forceinline__ void a_ready(const Unit&) const {}
    __device__ __forceinline__ void done(const Unit&) const {}
};
__device__ __forceinline__ unsigned cvt_pk_bf16(float lo, float hi) { unsigned r; asm volatile("v_cvt_pk_bf16_f32 %0, %1, %2" : "=v"(r) : "v"(lo), "v"(hi)); return r; }
typedef float f32x2 __attribute__((ext_vector_type(2)));
__device__ __forceinline__ float fast_silu(float x) { return x * __builtin_amdgcn_rcpf(1.0f + __builtin_amdgcn_exp2f(-1.4426950408889634f * x)); }
struct EpiKV {
    static constexpr bool PERM = false, AFTER_DRAIN = false; static constexpr int MID_T = 0;
    float* outk; size_t kvdelta;
    bf16_t* kb; bf16_t* vt;
    __device__ __forceinline__ void operator()(const f32x4 (&acc)[2][2][4][2], const Unit& u, int wr, int wc, int fr, int fq) const {
        const int n0 = u.pn * BM, l = n0 >> 11, kv = (n0 >> 10) & 1, e0 = n0 & 1023;
        float* C = outk + (size_t)kv * kvdelta + (size_t)l * (2048 * 1024);
        const int row0 = u.pm * BM + wr * 64 + fr, col0 = e0 + wc * 32 + 4 * fq;
#pragma unroll
        for (int ai = 0; ai < 2; ++ai)
#pragma unroll
            for (int m = 0; m < 4; ++m) { const int row = row0 + ai * HALF + m * 16; float* rowp = C + (size_t)row * 1024 + col0;
                const int mk = row & 255, prow = (row & ~255) | (mk & ~31) | (((mk >> 2) & 3) << 3) | (((mk >> 4) & 1) << 2) | (mk & 3);
#pragma unroll
                for (int bj = 0; bj < 2; ++bj)
#pragma unroll
                    for (int n = 0; n < 2; ++n) { const f32x4 v = acc[ai][bj][m][n]; const int col = col0 + bj * HALF + n * 16;
                        *(f32x4*)(rowp + bj * HALF + n * 16) = v;
                        if (kv == 0) { typedef unsigned u32x2v __attribute__((ext_vector_type(2))); u32x2v w; w.x = cvt_pk_bf16(v[0], v[1]); w.y = cvt_pk_bf16(v[2], v[3]);
                            *(u32x2v*)(kb + ((size_t)l * 2048 + row) * 1024 + col) = w; }
                        else { const unsigned w0 = cvt_pk_bf16(v[0], v[1]), w1 = cvt_pk_bf16(v[2], v[3]); bf16_t* vp = vt + ((size_t)l * 1024 + col) * 2048 + prow;
                            vp[0] = (bf16_t)(w0 & 0xffffu); vp[2048] = (bf16_t)(w0 >> 16); vp[2 * 2048] = (bf16_t)(w1 & 0xffffu); vp[3 * 2048] = (bf16_t)(w1 >> 16); } } }
    }
};
template <bool ROWSCALE_DUMMY = false> struct EpiBf16S {
    static constexpr bool PERM = true, AFTER_DRAIN = false; static constexpr int MID_T = 0;
    bf16_t* O; int ldc; float scale;
    __device__ __forceinline__ void operator()(const f32x4 (&acc)[2][2][4][2], const Unit& u, int wr, int wc, int fr, int fq) const {
        const int row0 = u.pm * BM + wr * 64 + fr, col0 = u.pn * BM + wc * 32 + 8 * fq;
#pragma unroll
        for (int ai = 0; ai < 2; ++ai)
#pragma unroll
            for (int m = 0; m < 4; ++m) { bf16_t* rowp = O + (size_t)(row0 + ai * HALF + m * 16) * ldc + col0;
#pragma unroll
                for (int bj = 0; bj < 2; ++bj) { const f32x4 v0 = acc[ai][bj][m][0] * scale, v1 = acc[ai][bj][m][1] * scale;
                    u32x4 w; w.x = cvt_pk_bf16(v0[0], v0[1]); w.y = cvt_pk_bf16(v0[2], v0[3]); w.z = cvt_pk_bf16(v1[0], v1[1]); w.w = cvt_pk_bf16(v1[2], v1[3]);
                    *(u32x4*)(rowp + bj * HALF) = w; } }
    }
};
__device__ __forceinline__ void row_rstd8(const float* rss, int row0, int fq, float (&rs)[2][4]) {
    f32x4 p[2][4];
#pragma unroll
    for (int ai = 0; ai < 2; ++ai)
#pragma unroll
        for (int m = 0; m < 4; ++m) p[ai][m] = *(const f32x4*)(rss + (size_t)(row0 + ai * HALF + m * 16) * 16 + 4 * fq);
#pragma unroll
    for (int ai = 0; ai < 2; ++ai)
#pragma unroll
        for (int m = 0; m < 4; ++m) { float sm = (p[ai][m][0] + p[ai][m][1]) + (p[ai][m][2] + p[ai][m][3]); sm += __shfl_xor(sm, 16); sm += __shfl_xor(sm, 32);
            rs[ai][m] = __builtin_amdgcn_rsqf(sm * (1.0f / 1024.f) + 1e-6f); }
}
struct EpiProj {
    static constexpr bool PERM = true, AFTER_DRAIN = false; static constexpr int MID_T = 0;
    bf16_t* C; const float* rss;
    __device__ __forceinline__ void operator()(const f32x4 (&acc)[2][2][4][2], const Unit& u, int wr, int wc, int fr, int fq) const {
        const int row0 = u.pm * BM + wr * 64 + fr, col0 = u.pn * BM + wc * 32 + 8 * fq;
        float rs8[2][4]; row_rstd8(rss, row0, fq, rs8);
#pragma unroll
        for (int ai = 0; ai < 2; ++ai)
#pragma unroll
            for (int m = 0; m < 4; ++m) { const int row = row0 + ai * HALF + m * 16; const float rs = rs8[ai][m]; bf16_t* rowp = C + (size_t)row * 4096 + col0;
#pragma unroll
                for (int bj = 0; bj < 2; ++bj) { const f32x4 v0 = acc[ai][bj][m][0] * rs, v1 = acc[ai][bj][m][1] * rs;
                    u32x4 w; w.x = cvt_pk_bf16(v0[0], v0[1]); w.y = cvt_pk_bf16(v0[2], v0[3]); w.z = cvt_pk_bf16(v1[0], v1[1]); w.w = cvt_pk_bf16(v1[2], v1[3]);
                    *(u32x4*)(rowp + bj * HALF) = w; } }
    }
};
struct EpiQ {
    static constexpr bool PERM = true, AFTER_DRAIN = false; static constexpr int MID_T = 0;
    bf16_t* O; const float* rss; float scale;
    __device__ __forceinline__ void operator()(const f32x4 (&acc)[2][2][4][2], const Unit& u, int wr, int wc, int fr, int fq) const {
        const int row0 = u.pm * BM + wr * 64 + fr, col0 = u.pn * BM + wc * 32 + 8 * fq;
        float rs8[2][4]; row_rstd8(rss, row0, fq, rs8);
#pragma unroll
        for (int ai = 0; ai < 2; ++ai)
#pragma unroll
            for (int m = 0; m < 4; ++m) { const int row = row0 + ai * HALF + m * 16; const float rs = rs8[ai][m] * scale; bf16_t* rowp = O + (size_t)row * 1024 + col0;
#pragma unroll
                for (int bj = 0; bj < 2; ++bj) { const f32x4 v0 = acc[ai][bj][m][0] * rs, v1 = acc[ai][bj][m][1] * rs;
                    u32x4 w; w.x = cvt_pk_bf16(v0[0], v0[1]); w.y = cvt_pk_bf16(v0[2], v0[3]); w.z = cvt_pk_bf16(v1[0], v1[1]); w.w = cvt_pk_bf16(v1[2], v1[3]);
                    *(u32x4*)(rowp + bj * HALF) = w; } }
    }
};
struct EpiResidHB {
    static constexpr bool PERM = true, AFTER_DRAIN = false; static constexpr int MID_T = 0;
    bf16_t* hb; float* rss;
    __device__ __forceinline__ void operator()(const f32x4 (&acc)[2][2][4][2], const Unit& u, int wr, int wc, int fr, int fq) const {
        const int row0 = u.pm * BM + wr * 64 + fr, col0 = u.pn * BM + wc * 32 + 8 * fq;
#pragma unroll
        for (int ai = 0; ai < 2; ++ai) {
            u32x4 ob[4][2];
#pragma unroll
            for (int m = 0; m < 4; ++m)
#pragma unroll
                for (int bj = 0; bj < 2; ++bj) ob[m][bj] = *(const u32x4*)(hb + (size_t)(row0 + ai * HALF + m * 16) * 1024 + col0 + bj * HALF);
#pragma unroll
            for (int m = 0; m < 4; ++m) { const int row = row0 + ai * HALF + m * 16; bf16_t* bp = hb + (size_t)row * 1024 + col0; float sq = 0.f;
#pragma unroll
                for (int bj = 0; bj < 2; ++bj) { const u32x4 o = ob[m][bj];
                    const f32x4 v0 = (f32x4){__uint_as_float(o.x << 16), __uint_as_float(o.x & 0xffff0000u), __uint_as_float(o.y << 16), __uint_as_float(o.y & 0xffff0000u)} + acc[ai][bj][m][0];
                    const f32x4 v1 = (f32x4){__uint_as_float(o.z << 16), __uint_as_float(o.z & 0xffff0000u), __uint_as_float(o.w << 16), __uint_as_float(o.w & 0xffff0000u)} + acc[ai][bj][m][1];
                    u32x4 w; w.x = cvt_pk_bf16(v0[0], v0[1]); w.y = cvt_pk_bf16(v0[2], v0[3]); w.z = cvt_pk_bf16(v1[0], v1[1]); w.w = cvt_pk_bf16(v1[2], v1[3]);
                    *(u32x4*)(bp + bj * HALF) = w;
                    sq += (v0[0] * v0[0] + v0[1] * v0[1]) + (v0[2] * v0[2] + v0[3] * v0[3]) + (v1[0] * v1[0] + v1[1] * v1[1]) + (v1[2] * v1[2] + v1[3] * v1[3]); }
                sq += __shfl_xor(sq, 16); sq += __shfl_xor(sq, 32);
                if (fq == 0) rss[(size_t)row * 16 + u.pn * 4 + wc] = sq; }
            asm volatile("" ::: "memory");
        }
    }
};
struct EpiResidMid {
    static constexpr bool PERM = true, AFTER_DRAIN = false; static constexpr int MID_T = 16;
    bf16_t* hb; float* rss; const float* ssq;
    __device__ __forceinline__ void midpre(const Unit& u, int wr, int wc, int fr, int fq, PG8_LAS float* mid) const {
        if (wc == 0) {
            const int row0 = u.pm * BM + wr * 64 + fr;
#pragma unroll
            for (int ai = 0; ai < 2; ++ai) { f32x4 rs;
#pragma unroll
                for (int m = 0; m < 4; ++m) { const int row = row0 + ai * HALF + m * 16; const f32x4 p0 = *(const f32x4*)(ssq + (size_t)row * 32 + 8 * fq), p1 = *(const f32x4*)(ssq + (size_t)row * 32 + 8 * fq + 4);
                    float sm = ((p0[0] + p0[1]) + (p0[2] + p0[3])) + ((p1[0] + p1[1]) + (p1[2] + p1[3])); sm += __shfl_xor(sm, 16); sm += __shfl_xor(sm, 32);
                    rs[m] = 1.0f / sqrtf(sm * (1.0f / 1024.f) + 1e-6f); }
                if (fq == 0) *(PG8_LAS f32x4*)(mid + ((ai * 2 + wr) * 16 + fr) * 4) = rs; }
        }
    }
    __device__ __forceinline__ void operator()(const f32x4 (&acc)[2][2][4][2], const Unit& u, int wr, int wc, int fr, int fq) const {
        const int row0 = u.pm * BM + wr * 64 + fr, col0 = u.pn * BM + wc * 32 + 8 * fq;
#pragma unroll
        for (int ai = 0; ai < 2; ++ai) {
            u32x4 ob[4][2];
#pragma unroll
            for (int m = 0; m < 4; ++m)
#pragma unroll
                for (int bj = 0; bj < 2; ++bj) ob[m][bj] = *(const u32x4*)(hb + (size_t)(row0 + ai * HALF + m * 16) * 1024 + col0 + bj * HALF);
#pragma unroll
            for (int m = 0; m < 4; ++m) { const int row = row0 + ai * HALF + m * 16; bf16_t* bp = hb + (size_t)row * 1024 + col0; float sq = 0.f;
#pragma unroll
                for (int bj = 0; bj < 2; ++bj) { const u32x4 o = ob[m][bj];
                    const f32x4 v0 = (f32x4){__uint_as_float(o.x << 16), __uint_as_float(o.x & 0xffff0000u), __uint_as_float(o.y << 16), __uint_as_float(o.y & 0xffff0000u)} + acc[ai][bj][m][0];
                    const f32x4 v1 = (f32x4){__uint_as_float(o.z << 16), __uint_as_float(o.z & 0xffff0000u), __uint_as_float(o.w << 16), __uint_as_float(o.w & 0xffff0000u)} + acc[ai][bj][m][1];
                    u32x4 w; w.x = cvt_pk_bf16(v0[0], v0[1]); w.y = cvt_pk_bf16(v0[2], v0[3]); w.z = cvt_pk_bf16(v1[0], v1[1]); w.w = cvt_pk_bf16(v1[2], v1[3]);
                    *(u32x4*)(bp + bj * HALF) = w;
                    sq += (v0[0] * v0[0] + v0[1] * v0[1]) + (v0[2] * v0[2] + v0[3] * v0[3]) + (v1[0] * v1[0] + v1[1] * v1[1]) + (v1[2] * v1[2] + v1[3] * v1[3]); }
                sq += __shfl_xor(sq, 16); sq += __shfl_xor(sq, 32);
                if (fq == 0) rss[(size_t)row * 16 + u.pn * 4 + wc] = sq; }
            asm volatile("" ::: "memory");
        }
    }
};
struct EpiSwiGLU {
    static constexpr bool PERM = true, AFTER_DRAIN = false; static constexpr int MID_T = 0;
    bf16_t* O; int ldc; const float* rss;
    __device__ __forceinline__ void operator()(const f32x4 (&acc)[2][2][4][2], const Unit& u, int wr, int wc, int fr, int fq) const {
        const int row0 = u.pm * BM + wr * 64 + fr, col0 = u.pn * HALF + wc * 32 + 8 * fq;
        float rs8[2][4]; row_rstd8(rss, row0, fq, rs8);
#pragma unroll
        for (int ai = 0; ai < 2; ++ai)
#pragma unroll
            for (int m = 0; m < 4; ++m) { const int row = row0 + ai * HALF + m * 16; const float rs = rs8[ai][m]; bf16_t* rowp = O + (size_t)row * ldc + col0;
                const f32x4 g0 = acc[ai][0][m][0] * rs, g1 = acc[ai][0][m][1] * rs, u0 = acc[ai][1][m][0] * rs, u1 = acc[ai][1][m][1] * rs;
                u32x4 w;
                w.x = cvt_pk_bf16(fast_silu(g0[0]) * u0[0], fast_silu(g0[1]) * u0[1]); w.y = cvt_pk_bf16(fast_silu(g0[2]) * u0[2], fast_silu(g0[3]) * u0[3]);
                w.z = cvt_pk_bf16(fast_silu(g1[0]) * u1[0], fast_silu(g1[1]) * u1[1]); w.w = cvt_pk_bf16(fast_silu(g1[2]) * u1[2], fast_silu(g1[3]) * u1[3]);
                *(u32x4*)rowp = w; }
    }
};
constexpr int MID_LDS_OFF = 131584;
template <class Epi, class Sched, bool ALIGN_EPI = false, bool SP2 = false>
__device__ __forceinline__ void gemm_phase(PG8_LAS unsigned char* lds, const Gemm g, const Sched& S, const Epi& E) {
    int tid_ = threadIdx.x; asm volatile("" : "+v"(tid_));
    const int tid = tid_, wid = __builtin_amdgcn_readfirstlane(tid >> 6), lane = tid & 63, wr = wid >> 2, wc = wid & 3, fr = lane & 15, fq = lane >> 4;
    const int K = g.K, nt = K / BK;
    unsigned voffA[2], voffB[2];
#pragma unroll
    for (int i = 0; i < 2; ++i) { int R, C; stage_rc(tid * 16 + i * 8192, R, C); const int Rb = Epi::PERM ? ((R & ~31) + perm32(R & 31)) : R;
        voffA[i] = (unsigned)(R * K + C) * 2u; voffB[i] = (unsigned)(Rb * K + C) * 2u; }
    const size_t kstep = (size_t)(BK * 2);
    const size_t hstep = (size_t)HALF * K * 2;
    const size_t tstep = 2 * hstep;
    const unsigned ldsw = (unsigned)wid * 1024u;
    const int aoff = lds_byte(wr * 64 + fr, fq * 8), boff = lds_byte(wc * 32 + fr, fq * 8);
#define PG8_SA(b, h) (((b) * 2 + (h)) * HTB)
#define PG8_SB(b, h) ((4 + (b) * 2 + (h)) * HTB)
#define PG8_STAGE(bufoff, gbase, voff) do { _Pragma("unroll") for (int _i = 0; _i < 2; ++_i) \
        __builtin_amdgcn_global_load_lds((const unsigned*)((const char*)(gbase) + (voff)[_i]), (PG8_LAS unsigned*)(lds + (bufoff) + ldsw + _i * 8192), 16, 0, 0); } while (0)
#define PG8_LDA(dst, b, h) do { _Pragma("unroll") for (int m = 0; m < 4; ++m) _Pragma("unroll") for (int k = 0; k < 2; ++k) dst[m][k] = *(const PG8_LAS bf16x8*)(lds + PG8_SA(b, h) + aoff + m * 2048 + k * 1024); } while (0)
#define PG8_LDB(dst, b, h) do { _Pragma("unroll") for (int n = 0; n < 2; ++n) _Pragma("unroll") for (int k = 0; k < 2; ++k) dst[n][k] = *(const PG8_LAS bf16x8*)(lds + PG8_SB(b, h) + boff + n * 2048 + k * 1024); } while (0)
#define PG8_MMA(ai, bj, At, Bt) do { __builtin_amdgcn_s_setprio(1); _Pragma("unroll") for (int m = 0; m < 4; ++m) _Pragma("unroll") for (int n = 0; n < 2; ++n) _Pragma("unroll") for (int k = 0; k < 2; ++k) \
        acc[ai][bj][m][n] = __builtin_amdgcn_mfma_f32_16x16x32_bf16(Bt[n][k], At[m][k], acc[ai][bj][m][n], 0, 0, 0); __builtin_amdgcn_s_setprio(0); } while (0)
#define PG8_WAIT_V(n) asm volatile("s_waitcnt vmcnt(" #n ")" ::: "memory")
#define PG8_WAIT_L(n) asm volatile("s_waitcnt lgkmcnt(" #n ")" ::: "memory")
#define PG8_BAR __builtin_amdgcn_s_barrier()
#define PG8_SCHED __builtin_amdgcn_sched_barrier(0)
    Unit cur, nxt; int ui = 0;
    if (!S.next(0, cur)) return;
    f32x4 acc[2][2][4][2];
#pragma unroll
    for (int a = 0; a < 2; ++a)
#pragma unroll
        for (int b = 0; b < 2; ++b)
#pragma unroll
            for (int m = 0; m < 4; ++m)
#pragma unroll
                for (int n = 0; n < 2; ++n) acc[a][b][m][n] = (f32x4){0.f, 0.f, 0.f, 0.f};
    bf16x8 At[4][2], B0[2][2], B1[2][2];
    const char* cA = (const char*)g.A + (size_t)cur.pm * tstep; const char* cB = (const char*)g.Bt + (size_t)cur.pn * tstep;
    S.a_ready(cur);
    if constexpr (SP2) {
        PG8_STAGE(PG8_SB(0, 0), cB, voffB); PG8_STAGE(PG8_SB(0, 1), cB + hstep, voffB); PG8_STAGE(PG8_SA(0, 0), cA, voffA); PG8_STAGE(PG8_SA(0, 1), cA + hstep, voffA);
        if (wr == 1) PG8_BAR;
        PG8_WAIT_V(2); PG8_BAR;
        PG8_STAGE(PG8_SB(1, 0), cB + kstep, voffB); PG8_STAGE(PG8_SA(1, 0), cA + kstep, voffA); PG8_STAGE(PG8_SB(1, 1), cB + hstep + kstep, voffB);
        PG8_WAIT_V(6); PG8_BAR;
    } else {
        PG8_STAGE(PG8_SB(0, 0), cB, voffB); PG8_STAGE(PG8_SA(0, 0), cA, voffA); PG8_STAGE(PG8_SB(0, 1), cB + hstep, voffB); PG8_STAGE(PG8_SA(0, 1), cA + hstep, voffA);
        if (wr == 1) PG8_BAR;
        PG8_WAIT_V(4); PG8_BAR;
        PG8_STAGE(PG8_SB(1, 0), cB + kstep, voffB); PG8_STAGE(PG8_SA(1, 0), cA + kstep, voffA); PG8_STAGE(PG8_SB(1, 1), cB + hstep + kstep, voffB);
        PG8_WAIT_V(6); PG8_BAR;
    }
    for (;;) {
        const bool has_next = S.next(ui + 1, nxt);
        if constexpr (Epi::MID_T != 0) E.midpre(cur, wr, wc, fr, fq, (PG8_LAS float*)(lds + MID_LDS_OFF));
        const char* nA = has_next ? (const char*)g.A + (size_t)nxt.pm * tstep : cA; const char* nB = has_next ? (const char*)g.Bt + (size_t)nxt.pn * tstep : cB;
        for (int t = 0; t < nt; t += 2) {
            if constexpr (Epi::MID_T != 0) { if (t == Epi::MID_T) {
                const PG8_LAS f32x4* mp_ = (const PG8_LAS f32x4*)(lds + MID_LDS_OFF) + (wr * 16 + fr);
                const f32x4 r0_ = mp_[0], r1_ = mp_[32];
                asm volatile("s_waitcnt lgkmcnt(0)" ::: "memory");
#pragma unroll
                for (int m_ = 0; m_ < 4; ++m_)
#pragma unroll
                    for (int b_ = 0; b_ < 2; ++b_)
#pragma unroll
                        for (int n_ = 0; n_ < 2; ++n_) { acc[0][b_][m_][n_] = acc[0][b_][m_][n_] * r0_[m_]; acc[1][b_][m_][n_] = acc[1][b_][m_][n_] * r1_[m_]; } } }
            const bool last = (t == nt - 2);
            const char* a1 = cA + (size_t)(t + 1) * kstep;
            const char* a2 = last ? nA : cA + (size_t)(t + 2) * kstep; const char* b2 = last ? nB : cB + (size_t)(t + 2) * kstep;
            const char* a3 = a2 + kstep; const char* b3 = b2 + kstep;
            if (last && has_next) S.a_ready(nxt);
            if constexpr (SP2) {
            PG8_LDB(B0, 0, 0); PG8_LDB(B1, 0, 1); PG8_SCHED; PG8_LDA(At, 0, 0); PG8_STAGE(PG8_SA(1, 1), a1 + hstep, voffA);
            PG8_WAIT_V(8); PG8_WAIT_L(0); PG8_BAR; PG8_MMA(0, 0, At, B0); PG8_MMA(0, 1, At, B1); PG8_BAR; PG8_SCHED;
            PG8_LDA(At, 0, 1); PG8_STAGE(PG8_SB(0, 0), b2, voffB); PG8_STAGE(PG8_SB(0, 1), b2 + hstep, voffB); PG8_STAGE(PG8_SA(0, 0), a2, voffA);
            PG8_WAIT_V(8); PG8_WAIT_L(0); PG8_BAR; PG8_MMA(1, 0, At, B0); PG8_MMA(1, 1, At, B1); PG8_BAR; PG8_SCHED;
            PG8_LDB(B0, 1, 0); PG8_LDB(B1, 1, 1); PG8_SCHED; PG8_LDA(At, 1, 0); PG8_STAGE(PG8_SA(0, 1), a2 + hstep, voffA);
            PG8_WAIT_V(8); PG8_WAIT_L(0); PG8_BAR; PG8_MMA(0, 0, At, B0); PG8_MMA(0, 1, At, B1); PG8_BAR; PG8_SCHED;
            PG8_LDA(At, 1, 1); PG8_STAGE(PG8_SB(1, 0), b3, voffB); PG8_STAGE(PG8_SB(1, 1), b3 + hstep, voffB); PG8_STAGE(PG8_SA(1, 0), a3, voffA);
            PG8_WAIT_V(8); PG8_WAIT_L(0); PG8_BAR; PG8_MMA(1, 0, At, B0); PG8_MMA(1, 1, At, B1); PG8_BAR; PG8_SCHED;
            } else {
            PG8_LDB(B0, 0, 0); PG8_SCHED; PG8_LDA(At, 0, 0); PG8_STAGE(PG8_SA(1, 1), a1 + hstep, voffA);
            PG8_WAIT_L(8); PG8_BAR; PG8_WAIT_L(0); PG8_MMA(0, 0, At, B0); PG8_BAR; PG8_SCHED;
            PG8_LDB(B1, 0, 1); PG8_STAGE(PG8_SB(0, 0), b2, voffB);
            PG8_BAR; PG8_WAIT_L(0); PG8_MMA(0, 1, At, B1); PG8_BAR;
            PG8_LDA(At, 0, 1); PG8_STAGE(PG8_SA(0, 0), a2, voffA);
            PG8_BAR; PG8_WAIT_L(0); PG8_MMA(1, 0, At, B0); PG8_BAR; PG8_SCHED;
            PG8_STAGE(PG8_SB(0, 1), b2 + hstep, voffB);
            PG8_WAIT_V(6); PG8_BAR; PG8_MMA(1, 1, At, B1); PG8_BAR;
            PG8_LDB(B0, 1, 0); PG8_SCHED; PG8_LDA(At, 1, 0); PG8_STAGE(PG8_SA(0, 1), a2 + hstep, voffA);
            PG8_WAIT_L(8); PG8_BAR; PG8_WAIT_L(0); PG8_MMA(0, 0, At, B0); PG8_BAR; PG8_SCHED;
            PG8_LDB(B1, 1, 1); PG8_STAGE(PG8_SB(1, 0), b3, voffB);
            PG8_BAR; PG8_WAIT_L(0); PG8_MMA(0, 1, At, B1); PG8_BAR;
            PG8_LDA(At, 1, 1); PG8_STAGE(PG8_SA(1, 0), a3, voffA);
            PG8_BAR; PG8_WAIT_L(0); PG8_MMA(1, 0, At, B0); PG8_BAR; PG8_SCHED;
            PG8_STAGE(PG8_SB(1, 1), b3 + hstep, voffB);
            PG8_WAIT_V(6); PG8_BAR; PG8_MMA(1, 1, At, B1); PG8_BAR;
            }
        }
        if constexpr (ALIGN_EPI) { if (wr == 0) PG8_BAR; }
        if constexpr (!Epi::AFTER_DRAIN) { E(acc, cur, wr, wc, fr, fq); S.done(cur); }
        if (!has_next) break;
#pragma unroll
        for (int a = 0; a < 2; ++a)
#pragma unroll
            for (int b = 0; b < 2; ++b)
#pragma unroll
                for (int m = 0; m < 4; ++m)
#pragma unroll
                    for (int n = 0; n < 2; ++n) acc[a][b][m][n] = (f32x4){0.f, 0.f, 0.f, 0.f};
        cur = nxt; cA = nA; cB = nB; ++ui;
        if constexpr (ALIGN_EPI) { if (wr == 1) PG8_BAR; }
    }
    PG8_WAIT_V(0);
    if constexpr (!ALIGN_EPI) { if (wr == 0) PG8_BAR; }
    PG8_BAR;
    if constexpr (Epi::AFTER_DRAIN) { E.fused(acc, cur, wr, wc, fr, fq, lds, wid, lane); S.done(cur); }
#undef PG8_SA
#undef PG8_SB
#undef PG8_STAGE
#undef PG8_LDA
#undef PG8_LDB
#undef PG8_MMA
#undef PG8_WAIT_V
#undef PG8_WAIT_L
#undef PG8_BAR
#undef PG8_SCHED
}
}
#define GAS __attribute__((address_space(1)))
#define LAS __attribute__((address_space(3)))
typedef unsigned short bf16;
typedef unsigned v4u __attribute__((ext_vector_type(4)));
typedef float f32x4 __attribute__((ext_vector_type(4)));
typedef short bf16x8 __attribute__((ext_vector_type(8)));
typedef GAS unsigned gu32;
typedef GAS unsigned long long gu64;
#define RLX_AGENT __ATOMIC_RELAXED, __HIP_MEMORY_SCOPE_AGENT
#define LDS_WAIT() asm volatile("s_waitcnt lgkmcnt(0)" ::: "memory")
#define VM_WAIT() asm volatile("s_waitcnt vmcnt(0)" ::: "memory")
__device__ __forceinline__ unsigned long long rt() { return __builtin_amdgcn_s_memrealtime(); }
__device__ __forceinline__ unsigned f2bf(float f) { unsigned u = __builtin_bit_cast(unsigned, f); return (u + 0x7fffu + ((u >> 16) & 1u)) >> 16; }
__device__ __forceinline__ unsigned pk2(float lo, float hi) { return f2bf(lo) | (f2bf(hi) << 16); }
#define XB_TMO      128
#define XB_XCNT(j)  (256  + 64 * (j))
#define XB_XSUB(j)  (1280 + 64 * (j))
#define XB_XGEN(j)  (2304 + 64 * (j))
#define XB_TOP      3328
#define XB_TOPGEN   3392
#define XCD_BAR_WORDS 3456
#define XB_SPIN_CAP (1u << 18)

__device__ __forceinline__ unsigned xb_ld(unsigned* p)              { return __hip_atomic_load(p, __ATOMIC_RELAXED, __HIP_MEMORY_SCOPE_AGENT); }
__device__ __forceinline__ unsigned xb_add(unsigned* p, unsigned v) { return __hip_atomic_fetch_add(p, v, __ATOMIC_RELAXED, __HIP_MEMORY_SCOPE_AGENT); }
__device__ __forceinline__ unsigned xb_xcc_id() { return (unsigned)__builtin_amdgcn_s_getreg((3 << 11) | 20) & 0xFu; }
#define XB_SPIN(cond, bar) do { unsigned _sp = 0; while (cond) { __builtin_amdgcn_s_sleep(1); \
    if ((++_sp & 255u) == 0u) { if (xb_ld(&(bar)[XB_TMO])) break; if (_sp > XB_SPIN_CAP) { atomicAdd(&(bar)[XB_TMO], 1u); break; } } } } while (0)

struct XcdBarrier {
    unsigned* bar; unsigned x;
    volatile LAS unsigned* st;
};

__device__ __forceinline__ XcdBarrier xcd_barrier_post(unsigned* bar, volatile LAS unsigned* st) {
    XcdBarrier b; b.bar = bar; b.x = xb_xcc_id(); b.st = st;
    if (threadIdx.x == 0) (void)xb_add(&bar[XB_XCNT(b.x)], 1u);
    return b;
}
__device__ __forceinline__ void xcd_barrier_complete(unsigned* bar, unsigned x, unsigned& nloc, unsigned& nx) {
    const unsigned G = gridDim.x * gridDim.y * gridDim.z;
    unsigned sum, cnt, mine, sp = 0u;
    for (;;) {
        sum = 0u; cnt = 0u; mine = 0u;
#pragma unroll
        for (unsigned j = 0; j < 16; ++j) { const unsigned c = xb_ld(&bar[XB_XCNT(j)]); sum += c; cnt += (c > 0u) ? 1u : 0u; mine = (j == x) ? c : mine; }
        if (sum == G) break;
        __builtin_amdgcn_s_sleep(1);
        if ((++sp & 255u) == 0u) { if (xb_ld(&bar[XB_TMO])) break; if (sp > XB_SPIN_CAP) { atomicAdd(&bar[XB_TMO], 1u); break; } }
    }
    nloc = mine > 0u ? mine : 1u; nx = cnt > 0u ? cnt : 1u;
}

__device__ __forceinline__ void xcd_barrier(const XcdBarrier& b) {
    asm volatile("s_waitcnt vmcnt(0)" ::: "memory");
    __syncthreads();
    if (threadIdx.x == 0) {
        unsigned* bar = b.bar;
        __builtin_amdgcn_s_waitcnt(0);
        unsigned nloc = b.st[0], nx = b.st[1];
        if (nloc == 0u) { xcd_barrier_complete(bar, b.x, nloc, nx); b.st[0] = nloc; b.st[1] = nx; }
        const unsigned old = xb_add(&bar[XB_XSUB(b.x)], 1u);
        const unsigned gen = old / nloc;
        if (old + 1u == (gen + 1u) * nloc) {
            __builtin_amdgcn_fence(__ATOMIC_RELEASE, "agent");
            asm volatile("s_waitcnt vmcnt(0)" ::: "memory");
            const unsigned og = xb_add(&bar[XB_TOP], 1u);
            const unsigned tg = og / nx;
            if (og + 1u == (tg + 1u) * nx) xb_add(&bar[XB_TOPGEN], 1u);
            else XB_SPIN(xb_ld(&bar[XB_TOPGEN]) == tg, bar);
            __builtin_amdgcn_fence(__ATOMIC_ACQUIRE, "agent");
            xb_add(&bar[XB_XGEN(b.x)], 1u);
            asm volatile("s_waitcnt vmcnt(0)" ::: "memory");
        } else {
            XB_SPIN(xb_ld(&bar[XB_XGEN(b.x)]) == gen, bar);
            __builtin_amdgcn_fence(__ATOMIC_ACQUIRE, "agent");
            asm volatile("s_waitcnt vmcnt(0)" ::: "memory");
        }
    }
    __syncthreads();
}
#ifndef MK_PROBE
#define MK_PROBE 0
#endif
#ifndef MK_PROBE_A
#define MK_PROBE_A 0
#define MK_PROBE_B 0
#endif
#ifndef MK_PROBE_REGIONS
#define MK_PROBE_REGIONS 0
#endif
#if MK_PROBE
#define REG_BEGIN(i) do { if (blockIdx.x == 0 && threadIdx.x == 0) ((unsigned long long*)(kp->ws + WS_CTL + 65536))[100 + (i)] = __builtin_amdgcn_s_memrealtime(); } while (0)
#define REG_END(i) do { __syncthreads(); if (blockIdx.x == 0 && threadIdx.x == 0) { unsigned long long* st_ = (unsigned long long*)(kp->ws + WS_CTL + 65536); st_[110 + (i)] += __builtin_amdgcn_s_memrealtime() - st_[100 + (i)]; } } while (0)
#else
#define REG_BEGIN(i) do { } while (0)
#define REG_END(i) do { } while (0)
#endif
namespace nv {
constexpr int D = 1024, MP = 16384, MS = 512, MT = MP + MS, NSEQ = 136, DEPTH = 4;
constexpr int NIN = 4112;
constexpr int NPJ = 4096, OFF_POOL = 0, OFF_Z = 512, OFF_XBC = 1536, OFF_GATE = 3072, OFF_LRU = 3584;
constexpr int DFF = 2816, NINP = 4352;
constexpr float EPS = 1e-6f;
constexpr size_t O_Y = 0, O_PPOOL = (size_t)MT * D, O_PSCONV = O_PPOOL + 245760, O_PSSD = O_PSCONV + 147456, O_PLCONV = O_PSSD + 4194304, O_PLRU = O_PLCONV + 49152,
                 O_PMK = O_PLRU + 16384, O_PMV = O_PMK + 8388608, O_SPOOL = O_PMV + 8388608, O_SSCONV = O_SPOOL + 3932160, O_SSSD = O_SSCONV + 2359296,
                 O_SLCONV = O_SSSD + 67108864, O_SLRU = O_SLCONV + 786432, O_END = O_SLRU + 262144;
constexpr size_t MiB = 1u << 20;
constexpr size_t WS_CTL = 0, CTL_ZERO_BYTES = 1 * MiB;
constexpr size_t WS_WKV = 1 * MiB, WS_WIN = 17 * MiB, WS_WOUT = 51 * MiB, WS_WQ = 67 * MiB, WS_WO = 75 * MiB, WS_WGU = 83 * MiB, WS_WD = 127 * MiB;
constexpr size_t WS_MEMB = 149 * MiB, WS_HB = 153 * MiB, WS_UB = 153 * MiB, WS_MIXB = 186 * MiB, WS_OB = 252 * MiB, WS_ACT = 285 * MiB;
constexpr size_t WS_PROJ = 376 * MiB, WS_POOLED = 642 * MiB, WS_XBC = 675 * MiB, WS_YRAW = 774 * MiB, WS_XC = 840 * MiB, WS_AB = 873 * MiB, WS_BB = 906 * MiB, WS_QB = 939 * MiB;
constexpr size_t WS_KB = 1005 * MiB, WS_VT = 1021 * MiB;
constexpr size_t WS_SSDSS = 1037 * MiB, WS_PWT = 1039 * MiB;
constexpr size_t WS_DT = 1042 * MiB;
constexpr size_t WS_RSS = 1040 * MiB;
constexpr size_t WS_XBCC = 1044 * MiB;
constexpr size_t WS_XLRU = 840 * MiB;
constexpr size_t WS_END = 1092 * MiB;
constexpr size_t WIN_L = (size_t)NINP * 1024, WOUT_L = (size_t)1024 * 2048, WQ_L = (size_t)1024 * 1024, WGU_L = (size_t)5632 * 1024, WD_L = (size_t)1024 * 2816;
constexpr int CW_TMO = 0, CW_BAR = 4096;
constexpr int RING_OFF = 0, RING_BYTES = 131072, LDSCTL_OFF = RING_BYTES, MISC_OFF = LDSCTL_OFF + 320, LDS_BYTES = 147456;
constexpr int NWAVES = 8, NTHR = 512;
constexpr int PH_PRO = 0, PH_KV = 1, PH_L0 = 2, PH_PER_LAYER = 9, PH_FINAL = PH_L0 + DEPTH * PH_PER_LAYER, NPH = PH_FINAL + 1;

struct SeqInfo { int row0, L, pos0, b, grp; };
__device__ __forceinline__ SeqInfo seq_info(int s) {
    SeqInfo q;
    if (s < 8) { q.row0 = s * 2048; q.L = 2048; q.pos0 = 0; q.b = s; q.grp = 0; }
    else { q.b = s - 8; q.row0 = MP + q.b * 4; q.L = 4; q.pos0 = 16384; q.grp = 1; }
    return q;
}
__device__ __forceinline__ void row_info(int r, int& s, int& t) {
    if (r < MP) { s = r >> 11; t = r & 2047; } else { const int q = r - MP; s = 8 + (q >> 2); t = q & 3; }
}
__device__ __forceinline__ float wave_sum(float v) {
#pragma unroll
    for (int o = 1; o < 64; o <<= 1) v += __shfl_xor(v, o);
    return v;
}
__device__ __forceinline__ float wave_max(float v) {
#pragma unroll
    for (int o = 1; o < 64; o <<= 1) v = fmaxf(v, __shfl_xor(v, o));
    return v;
}
__device__ __forceinline__ float silu_f(float x) { return x / (1.f + expf(-x)); }
__device__ __forceinline__ float sigmoid_f(float x) { return 1.f / (1.f + expf(-x)); }
__device__ __forceinline__ float softplus_f(float x) { return x > 20.f ? x : log1pf(expf(x)); }
__device__ __forceinline__ float gelu_tanh_f(float x) { return 0.5f * x * (1.f + tanhf(0.7978845608028654f * (x + 0.044715f * x * x * x))); }

struct Args { const float* in[38]; float* out; unsigned char* ws; int ph_lo, ph_hi; };
typedef const __attribute__((address_space(4))) Args* KP;
struct Frame { LAS unsigned char* lds; int tid, lane, wave, bid, G, vcu; };
__device__ __forceinline__ void frame_refresh(Frame& F) { int t = threadIdx.x; asm volatile("" : "+v"(t)); F.tid = t; F.lane = t & 63; F.wave = __builtin_amdgcn_readfirstlane(t >> 6); }

typedef float f32x2_t __attribute__((ext_vector_type(2))); typedef __bf16 bf16x2_t __attribute__((ext_vector_type(2)));
__device__ __forceinline__ unsigned pk2h(float lo, float hi) { f32x2_t v = {lo, hi}; bf16x2_t b = __builtin_convertvector(v, bf16x2_t); return __builtin_bit_cast(unsigned, b); }
__device__ __forceinline__ unsigned f2bfh(float x) { return pk2h(x, 0.f) & 0xffffu; }
typedef short bf16x8 __attribute__((ext_vector_type(8)));
#define MFMA16(a, b, c) __builtin_amdgcn_mfma_f32_16x16x32_bf16((a), (b), (c), 0, 0, 0)
#define LBAR() do { asm volatile("s_waitcnt lgkmcnt(0)" ::: "memory"); __builtin_amdgcn_s_barrier(); asm volatile("" ::: "memory"); } while (0)
__device__ __forceinline__ float bf2f(unsigned short h) { return __uint_as_float((unsigned)h << 16); }
__device__ __forceinline__ void cvt8(v4u u, f32x4& lo, f32x4& hi) { lo = (f32x4){__uint_as_float(u.x << 16), __uint_as_float(u.x & 0xffff0000u), __uint_as_float(u.y << 16), __uint_as_float(u.y & 0xffff0000u)}; hi = (f32x4){__uint_as_float(u.z << 16), __uint_as_float(u.z & 0xffff0000u), __uint_as_float(u.w << 16), __uint_as_float(u.w & 0xffff0000u)}; }
constexpr int SL_CS = 0, SL_BS = 32768, SL_BT = 65536, SL_XT = 98304, SL_XW = 106496, SL_HS = 114688, SL_XS = 122880;
constexpr int XTRA = LDSCTL_OFF + 512;
constexpr int SL_ACS = XTRA, SL_DTV = XTRA + 512, SL_CW = XTRA + 1024;
__device__ __forceinline__ int sw128(int r, int c8) { return r * 256 + (((c8 ^ r) & 15) << 4); }
__device__ __forceinline__ int sw128t(int r, int c8) { return r * 256 + (((c8 ^ r ^ (r >> 3)) & 15) << 4); }
__device__ __forceinline__ float fexp(float x) { return __builtin_amdgcn_exp2f(1.4426950408889634f * x); }
__device__ __forceinline__ float fsilu(float x) { return x * __builtin_amdgcn_rcpf(1.0f + __builtin_amdgcn_exp2f(-1.4426950408889634f * x)); }

__device__ __forceinline__ void ph_mix0(KP a, Frame& F, int l) {
    const bf16* proj = (const bf16*)(a->ws + WS_PROJ);
    const int NIT = (MP / 8) * 256;
    for (int it = F.bid * NTHR + F.tid; it < NIT; it += F.G * NTHR) {
        const int cc = it & 255, rb = it >> 8, r0 = rb * 8, t = r0 & 2047;
        const bool lru = cc >= 192; const int c8 = lru ? cc - 192 : cc, C = lru ? 512 : 1536;
        const float* cw = lru ? a->in[20] + (size_t)l * 4 * 512 : a->in[14] + (size_t)l * 4 * 1536; const float* cb = lru ? a->in[21] + (size_t)l * 512 : a->in[15] + (size_t)l * 1536;
        bf16* xo = (bf16*)(a->ws + (lru ? WS_XLRU : WS_XBCC)); const int soff = lru ? OFF_LRU : OFF_XBC;
        f32x4 wk[5][2];
#pragma unroll
        for (int k = 0; k < 4; ++k) { wk[k][0] = *(const f32x4*)(cw + (size_t)k * C + 8 * c8); wk[k][1] = *(const f32x4*)(cw + (size_t)k * C + 8 * c8 + 4); }
        wk[4][0] = *(const f32x4*)(cb + 8 * c8); wk[4][1] = *(const f32x4*)(cb + 8 * c8 + 4);
        v4u rw[11];
#pragma unroll
        for (int rr = 0; rr < 11; ++rr) { rw[rr] = (v4u){0u, 0u, 0u, 0u}; if (t + rr - 3 >= 0) rw[rr] = *(const GAS v4u*)(proj + (size_t)(r0 + rr - 3) * NPJ + soff + 8 * c8); }
#pragma unroll
        for (int hf = 0; hf < 2; ++hf) {
            f32x4 raw[11];
#pragma unroll
            for (int rr = 0; rr < 11; ++rr) { const unsigned u0 = hf ? rw[rr].z : rw[rr].x, u1 = hf ? rw[rr].w : rw[rr].y;
                raw[rr] = (f32x4){__uint_as_float(u0 << 16), __uint_as_float(u0 & 0xffff0000u), __uint_as_float(u1 << 16), __uint_as_float(u1 & 0xffff0000u)}; }
#pragma unroll
            for (int i = 0; i < 8; ++i) { f32x4 o = wk[4][hf];
#pragma unroll
                for (int k = 0; k < 4; ++k) o += wk[k][hf] * raw[i + k];
                if (!lru) { o.x = fsilu(o.x); o.y = fsilu(o.y); o.z = fsilu(o.z); o.w = fsilu(o.w); }
                *(unsigned long long*)(xo + (size_t)(r0 + i) * C + 8 * c8 + 4 * hf) = (unsigned long long)pk2h(o.x, o.y) | ((unsigned long long)pk2h(o.z, o.w) << 32); }
        }
    }
}
template <bool WITH_T>
__device__ __forceinline__ void ssd_stage(LAS unsigned char* L, const v4u (&rw)[4], int dst, int dstT, int tq, int c8) {
#pragma unroll
    for (int i = 0; i < 4; ++i) *(LAS v4u*)(L + dst + sw128(4 * tq + i, c8)) = rw[i];
    if (WITH_T) {
#pragma unroll
        for (int jw = 0; jw < 4; ++jw) {
            const unsigned a0 = rw[0][jw], a1 = rw[1][jw], a2 = rw[2][jw], a3 = rw[3][jw];
            const unsigned long long ev = (unsigned long long)((a0 & 0xffffu) | (a1 << 16)) | ((unsigned long long)((a2 & 0xffffu) | (a3 << 16)) << 32);
            const unsigned long long od = (unsigned long long)((a0 >> 16) | (a1 & 0xffff0000u)) | ((unsigned long long)((a2 >> 16) | (a3 & 0xffff0000u)) << 32);
            *(LAS unsigned long long*)(L + dstT + sw128t(8 * c8 + 2 * jw, tq >> 1) + (tq & 1) * 8) = ev;
            *(LAS unsigned long long*)(L + dstT + sw128t(8 * c8 + 2 * jw + 1, tq >> 1) + (tq & 1) * 8) = od; }
    }
}
__device__ __forceinline__ float fsoftplus(float x) { return x > 15.f ? x : 0.6931471805599453f * __builtin_amdgcn_logf(1.0f + __builtin_amdgcn_exp2f(1.4426950408889634f * x)); }

__device__ __forceinline__ void ssd_prompt_item(KP a, Frame& F, int l, int b, int hd, int ph) {
    LAS unsigned char* L = F.lds;
    const int tid0 = F.tid, w = F.wave, fr0 = F.lane & 15, fq0 = F.lane >> 4, g = hd >> 3;
    const bf16* proj_seq = (const bf16*)(a->ws + WS_PROJ) + (size_t)b * 2048 * NPJ; const float* dt_seq = (const float*)(a->ws + WS_DT) + (size_t)b * 2048 * 16 + hd;
    bf16* mixb = (bf16*)(a->ws + WS_MIXB) + (size_t)b * 2048 * 2048 + hd * 64 + ph * 32;
    float* ssq = (float*)(a->ws + WS_SSDSS) + (size_t)b * 2048 * 32 + hd * 2 + ph;
    LAS float* ACS = (LAS float*)(L + SL_ACS); LAS float* DTV = (LAS float*)(L + SL_DTV);
    const bf16* xc_seq = (const bf16*)(a->ws + WS_XBCC) + (size_t)b * 2048 * 1536;
    for (int i = tid0; i < 8192 / 4; i += NTHR) ((LAS unsigned*)(L + SL_HS))[i] = 0u;
    const float A = -expf(a->in[17][l * 16 + hd]), dtb = a->in[16][l * 16 + hd], Dk = a->in[18][l * 16 + hd];
    f32x4 hst[2]; hst[0] = (f32x4){0.f, 0.f, 0.f, 0.f}; hst[1] = (f32x4){0.f, 0.f, 0.f, 0.f};
    const int cB = 1024 + g * 128, cC = 1280 + g * 128, cX = hd * 64 + ph * 32, cZ = OFF_Z + hd * 64 + ph * 32;
    v4u rawB[4], rawC[4]; unsigned rawX[4]; float dr0 = 0.f, dr1 = 0.f;
    {
        const int tq = tid0 >> 4, c8 = tid0 & 15;
#pragma unroll
        for (int i = 0; i < 4; ++i) { const bf16* rp = xc_seq + (size_t)(4 * tq + i) * 1536; rawB[i] = *(const GAS v4u*)(rp + cB + 8 * c8); rawC[i] = *(const GAS v4u*)(rp + cC + 8 * c8); rawX[i] = *(const GAS unsigned*)(rp + cX + 2 * c8); }
        if (w == 0) { dr0 = dt_seq[(size_t)(2 * F.lane) * 16]; dr1 = dt_seq[(size_t)(2 * F.lane + 1) * 16]; }
    }
    __syncthreads();
    for (int c = 0; c < 16; ++c) {
        const int t0 = c * 128;
        const int tid = tid0, fr = fr0, fq = fq0;
        const int lane = tid & 63, tq = tid >> 4, c8 = tid & 15;
        unsigned long long zq[2];
#pragma unroll
        for (int pt = 0; pt < 2; ++pt) zq[pt] = *(const GAS unsigned long long*)(proj_seq + (size_t)(t0 + 16 * w + fr) * NPJ + cZ + 16 * pt + 4 * fq);
        if (w == 0) {
            const float dt0 = fsoftplus(dr0 + dtb), dt1 = fsoftplus(dr1 + dtb);
            const float a0 = dt0 * A, a1 = dt1 * A;
            float v = a0 + a1;
#pragma unroll
            for (int o = 1; o < 64; o <<= 1) { const float t = __shfl_up(v, o); if (lane >= o) v += t; }
            ACS[2 * lane] = v - a1; ACS[2 * lane + 1] = v; DTV[2 * lane] = dt0; DTV[2 * lane + 1] = dt1;
        }
        ssd_stage<true>(L, rawB, SL_BS, SL_BT, tq, c8);
        ssd_stage<false>(L, rawC, SL_CS, 0, tq, c8);
        if (c + 1 < 16) {
#pragma unroll
            for (int i = 0; i < 4; ++i) { const bf16* rp = xc_seq + (size_t)(t0 + 128 + 4 * tq + i) * 1536; rawB[i] = *(const GAS v4u*)(rp + cB + 8 * c8); rawC[i] = *(const GAS v4u*)(rp + cC + 8 * c8); }
        }
        LBAR();
        f32x4 cb[8]; bf16x8 cfr[4]; const int lo = (w >= 4) ? (w - 4) : 0, hrt = 7 - w, nh = (w < 4) ? (3 - w) : 0;
#pragma unroll
        for (int ks = 0; ks < 4; ++ks) cfr[ks] = *(const LAS bf16x8*)(L + SL_CS + sw128(16 * w + fr, 4 * ks + fq));
#pragma unroll
        for (int st = 0; st < 8; ++st) if (st >= lo && st <= w) { cb[st] = (f32x4){0.f, 0.f, 0.f, 0.f};
#pragma unroll
            for (int ks = 0; ks < 4; ++ks) { const bf16x8 bm = *(const LAS bf16x8*)(L + SL_BS + sw128(16 * st + fr, 4 * ks + fq)); cb[st] = MFMA16(bm, cfr[ks], cb[st]); } }
        f32x4 cbh[3];
        if (w < 4) { bf16x8 cf2[4];
#pragma unroll
            for (int ks = 0; ks < 4; ++ks) cf2[ks] = *(const LAS bf16x8*)(L + SL_CS + sw128(16 * hrt + fr, 4 * ks + fq));
#pragma unroll
            for (int k = 0; k < 3; ++k) if (k < nh) { cbh[k] = (f32x4){0.f, 0.f, 0.f, 0.f};
#pragma unroll
                for (int ks = 0; ks < 4; ++ks) { const bf16x8 bm = *(const LAS bf16x8*)(L + SL_BS + sw128(16 * k + fr, 4 * ks + fq)); cbh[k] = MFMA16(bm, cf2[ks], cbh[k]); } } }
        {
            const float alast = ACS[127];
            float xd[4][2], xw[4][2];
#pragma unroll
            for (int i = 0; i < 4; ++i) { const int tok = 4 * tq + i; const float dt = DTV[tok], wgt = fexp(alast - ACS[tok]);
                xd[i][0] = __uint_as_float(rawX[i] << 16) * dt; xd[i][1] = __uint_as_float(rawX[i] & 0xffff0000u) * dt; xw[i][0] = xd[i][0] * wgt; xw[i][1] = xd[i][1] * wgt; }
#pragma unroll
            for (int j = 0; j < 2; ++j) { const int off = sw128(2 * c8 + j, tq >> 1) + (tq & 1) * 8;
                *(LAS unsigned long long*)(L + SL_XT + off) = (unsigned long long)pk2h(xd[0][j], xd[1][j]) | ((unsigned long long)pk2h(xd[2][j], xd[3][j]) << 32);
                *(LAS unsigned long long*)(L + SL_XW + off) = (unsigned long long)pk2h(xw[0][j], xw[1][j]) | ((unsigned long long)pk2h(xw[2][j], xw[3][j]) << 32); }
            if (c + 1 < 16) {
#pragma unroll
                for (int i = 0; i < 4; ++i) rawX[i] = *(const GAS unsigned*)(xc_seq + (size_t)(t0 + 128 + 4 * tq + i) * 1536 + cX + 2 * c8);
                if (w == 0) { dr0 = dt_seq[(size_t)(t0 + 128 + 2 * lane) * 16]; dr1 = dt_seq[(size_t)(t0 + 128 + 2 * lane + 1) * 16]; }
            }
        }
        LBAR();
        {
            const int l_ = 16 * w + fr; const float al = ACS[l_];
#pragma unroll
            for (int st = 0; st < 8; ++st) {
                const int off = SL_BS + sw128(l_, 2 * st + (fq >> 1)) + (fq & 1) * 8;
                if (st >= lo && st <= w) { float v[4]; const f32x4 as4 = *(const LAS f32x4*)(ACS + 16 * st + 4 * fq);
#pragma unroll
                    for (int e = 0; e < 4; ++e) { const int s_ = 16 * st + 4 * fq + e; const float ex = fexp(fminf(al - as4[e], 0.f)); v[e] = (s_ <= l_) ? cb[st][e] * ex : 0.f; }
                    *(LAS unsigned long long*)(L + off) = (unsigned long long)pk2h(v[0], v[1]) | ((unsigned long long)pk2h(v[2], v[3]) << 32); }
                else if (st == w + 1 && (w & 1) == 0) *(LAS unsigned long long*)(L + off) = 0ull;
            }
            if (w < 4) { const int l2 = 16 * hrt + fr; const float al2 = ACS[l2];
#pragma unroll
                for (int k = 0; k < 3; ++k) if (k < nh) { float v[4]; const f32x4 as4 = *(const LAS f32x4*)(ACS + 16 * k + 4 * fq);
#pragma unroll
                    for (int e = 0; e < 4; ++e) v[e] = cbh[k][e] * fexp(fminf(al2 - as4[e], 0.f));
                    *(LAS unsigned long long*)(L + SL_BS + sw128(l2, 2 * k + (fq >> 1)) + (fq & 1) * 8) = (unsigned long long)pk2h(v[0], v[1]) | ((unsigned long long)pk2h(v[2], v[3]) << 32); } }
        }
        LBAR();
        {
            f32x4 yd[2], yo[2];
#pragma unroll
            for (int pt = 0; pt < 2; ++pt) { yd[pt] = (f32x4){0.f, 0.f, 0.f, 0.f}; yo[pt] = (f32x4){0.f, 0.f, 0.f, 0.f}; }
#pragma unroll
            for (int ks = 0; ks < 4; ++ks) {
#pragma unroll
                for (int pt = 0; pt < 2; ++pt) { const bf16x8 hf = *(const LAS bf16x8*)(L + SL_HS + sw128(16 * pt + fr, 4 * ks + fq)); yo[pt] = MFMA16(hf, cfr[ks], yo[pt]); }
                if (ks <= (w >> 1)) { const bf16x8 mf = *(const LAS bf16x8*)(L + SL_BS + sw128(16 * w + fr, 4 * ks + fq));
#pragma unroll
                    for (int pt = 0; pt < 2; ++pt) { const bf16x8 xf = *(const LAS bf16x8*)(L + SL_XT + sw128(16 * pt + fr, 4 * ks + fq)); yd[pt] = MFMA16(xf, mf, yd[pt]); } }
            }
            const int l_ = 16 * w + fr; const float ea = fexp(ACS[l_]), dsk = Dk * __builtin_amdgcn_rcpf(DTV[l_]); float s2 = 0.f;
#pragma unroll
            for (int pt = 0; pt < 2; ++pt) { float yg[4];
#pragma unroll
                for (int e = 0; e < 4; ++e) { const int p = 16 * pt + 4 * fq + e;
                    const float xdv = bf2f(*(const LAS bf16*)(L + SL_XT + sw128(p, l_ >> 3) + (l_ & 7) * 2));
                    const float z = bf2f((unsigned short)(zq[pt] >> (16 * e)));
                    const float y = yd[pt][e] + ea * yo[pt][e] + dsk * xdv;
                    yg[e] = y * fsilu(z); s2 += yg[e] * yg[e]; }
                *(unsigned long long*)(mixb + (size_t)(t0 + l_) * 2048 + 16 * pt + 4 * fq) = (unsigned long long)pk2h(yg[0], yg[1]) | ((unsigned long long)pk2h(yg[2], yg[3]) << 32); }
            s2 += __shfl_xor(s2, 16); s2 += __shfl_xor(s2, 32);
            if (fq == 0) ssq[(size_t)(t0 + l_) * 32] = s2;
            const float cd = fexp(ACS[127]);
#pragma unroll
            for (int pt = 0; pt < 2; ++pt) hst[pt] = hst[pt] * cd;
#pragma unroll
            for (int ks = 0; ks < 4; ++ks) { const bf16x8 bt = *(const LAS bf16x8*)(L + SL_BT + sw128t(16 * w + fr, 4 * ks + fq));
#pragma unroll
                for (int pt = 0; pt < 2; ++pt) { const bf16x8 xw = *(const LAS bf16x8*)(L + SL_XW + sw128(16 * pt + fr, 4 * ks + fq)); hst[pt] = MFMA16(bt, xw, hst[pt]); } }
        }
        LBAR();
#pragma unroll
        for (int pt = 0; pt < 2; ++pt)
            *(LAS unsigned long long*)(L + SL_HS + sw128(16 * pt + fr, 2 * w + (fq >> 1)) + (fq & 1) * 8) = (unsigned long long)pk2h(hst[pt][0], hst[pt][1]) | ((unsigned long long)pk2h(hst[pt][2], hst[pt][3]) << 32);
    }
    {
        float* so = a->out + O_PSSD + ((((size_t)l * 8 + b) * 16 + hd) * 64 + ph * 32) * 128;
#pragma unroll
        for (int pt = 0; pt < 2; ++pt) *(f32x4*)(so + (size_t)(16 * pt + fr0) * 128 + 16 * w + 4 * fq0) = hst[pt];
    }
    __syncthreads();
}

constexpr int LR_ROWS = 512 + 32;
constexpr int LR_A = 0, LR_B = LR_ROWS * 64, LR_XC = 2 * LR_ROWS * 64;
constexpr int LR_SEG = LR_XC + 8192, LR_CAR = LR_SEG + 2 * 32 * 16 * 4, LR_CW = LR_CAR + 64 + 32 * 16 * 4;
static_assert(LR_CW + 5 * 64 * 4 <= RING_BYTES, "lru LDS map");
__device__ __forceinline__ int lr_row(int tok) { return tok + (tok >> 4); }
__device__ __forceinline__ void lru_prompt_item(KP a, Frame& F, int l, int b, int hh, int qd) {
    LAS unsigned char* L = F.lds;
    const int tid0 = F.tid, w = F.wave, fr0 = F.lane & 15, fq0 = F.lane >> 4;
    const bf16* proj_seq = (const bf16*)(a->ws + WS_PROJ) + (size_t)b * 2048 * NPJ;
    bf16* mixb = (bf16*)(a->ws + WS_MIXB) + (size_t)b * 2048 * 2048 + 1536 + hh * 64 + qd * 16;
    LAS float* Al = (LAS float*)(L + LR_A); LAS float* Bl = (LAS float*)(L + LR_B); LAS float* XCs = (LAS float*)(L + LR_XC) + w * 256;
    LAS float* SegA = (LAS float*)(L + LR_SEG); LAS float* SegB = SegA + 512; LAS float* Car = (LAS float*)(L + LR_CAR); LAS float* CarIn = Car + 16;
    const int ch = hh * 64 + qd * 16 + fr0;
    if (tid0 < 16) Car[tid0] = 0.f;
    bf16x8 waf[2], wxf[2];
    {
        const float* wa = a->in[22] + ((size_t)l * 8 + hh) * 64 * 64 + qd * 16 + fr0; const float* wx = a->in[24] + ((size_t)l * 8 + hh) * 64 * 64 + qd * 16 + fr0;
#pragma unroll
        for (int ks = 0; ks < 2; ++ks) { v4u ua, ux; const int i0 = 32 * ks + 8 * fq0;
            ua.x = pk2h(wa[(i0 + 0) * 64], wa[(i0 + 1) * 64]); ua.y = pk2h(wa[(i0 + 2) * 64], wa[(i0 + 3) * 64]); ua.z = pk2h(wa[(i0 + 4) * 64], wa[(i0 + 5) * 64]); ua.w = pk2h(wa[(i0 + 6) * 64], wa[(i0 + 7) * 64]);
            ux.x = pk2h(wx[(i0 + 0) * 64], wx[(i0 + 1) * 64]); ux.y = pk2h(wx[(i0 + 2) * 64], wx[(i0 + 3) * 64]); ux.z = pk2h(wx[(i0 + 4) * 64], wx[(i0 + 5) * 64]); ux.w = pk2h(wx[(i0 + 6) * 64], wx[(i0 + 7) * 64]);
            waf[ks] = __builtin_bit_cast(bf16x8, ua); wxf[ks] = __builtin_bit_cast(bf16x8, ux); }
    }
    const float bav = a->in[23][(size_t)l * 512 + ch], bxv = a->in[25][(size_t)l * 512 + ch];
    const float lamv = a->in[26][(size_t)l * 512 + ch];
    const float spv = -8.0f * ((-lamv) > 20.f ? (-lamv) : log1pf(expf(-lamv)));
    const bf16* xl_seq = (const bf16*)(a->ws + WS_XLRU) + (size_t)b * 2048 * 512 + hh * 64;
    v4u xr[4][2];
#pragma unroll
    for (int tt = 0; tt < 4; ++tt)
#pragma unroll
        for (int ks = 0; ks < 2; ++ks) xr[tt][ks] = *(const GAS v4u*)(xl_seq + (size_t)((w * 4 + tt) * 16 + fr0) * 512 + 32 * ks + 8 * fq0);
    __syncthreads();
    for (int qp = 0; qp < 4; ++qp) {
        const int T0 = qp * 512;
        int tid = tid0, fr = fr0, fq = fq0; asm volatile("" : "+v"(tid), "+v"(fr), "+v"(fq));
        v4u gz0, gz1;
        { const bf16* gp = proj_seq + (size_t)(T0 + tid) * NPJ + OFF_GATE + hh * 64 + qd * 16; gz0 = *(const GAS v4u*)gp; gz1 = *(const GAS v4u*)(gp + 8); }
#pragma unroll
        for (int tt = 0; tt < 4; ++tt) {
            const int tb = (w * 4 + tt) * 16;
            bf16x8 xa[2];
#pragma unroll
            for (int ks = 0; ks < 2; ++ks) { xa[ks] = __builtin_bit_cast(bf16x8, xr[tt][ks]);
                if (ks == (qd >> 1) && (fq >> 1) == (qd & 1)) {
                    f32x4 x0, x1; cvt8(xr[tt][ks], x0, x1); *(LAS f32x4*)(XCs + fr * 16 + 8 * (fq & 1)) = x0; *(LAS f32x4*)(XCs + fr * 16 + 8 * (fq & 1) + 4) = x1; }
            }
            f32x4 pr = (f32x4){bav, bav, bav, bav}, pi = (f32x4){bxv, bxv, bxv, bxv};
#pragma unroll
            for (int ks = 0; ks < 2; ++ks) { pr = MFMA16(xa[ks], waf[ks], pr); pi = MFMA16(xa[ks], wxf[ks], pi); }
            LDS_WAIT(); asm volatile("" ::: "memory");
#pragma unroll
            for (int e = 0; e < 4; ++e) { const int tok = tb + 4 * fq + e;
                const float rg = __builtin_amdgcn_rcpf(1.0f + fexp(-pr[e])), ig = __builtin_amdgcn_rcpf(1.0f + fexp(-pi[e]));
                const float log_a = spv * rg; const float av = fexp(log_a);
                const float y2 = 2.0f * log_a;
                const float om = y2 > -0.02f ? -y2 * (1.0f + y2 * (0.5f + y2 * (0.16666667f + y2 * 0.041666668f))) : 1.0f - av * av;
                const float mult = (T0 + tok == 0) ? 1.0f : sqrtf(om);
                const float xcv = XCs[(4 * fq + e) * 16 + fr];
                Al[lr_row(tok) * 16 + fr] = av; Bl[lr_row(tok) * 16 + fr] = mult * ig * xcv; }
            LDS_WAIT(); asm volatile("" ::: "memory");
        }
        if (qp + 1 < 4) {
#pragma unroll
            for (int tt = 0; tt < 4; ++tt)
#pragma unroll
                for (int ks = 0; ks < 2; ++ks) xr[tt][ks] = *(const GAS v4u*)(xl_seq + (size_t)(T0 + 512 + (w * 4 + tt) * 16 + fr) * 512 + 32 * ks + 8 * fq);
        }
        LBAR();
        {
            const int sg = tid >> 4, c = tid & 15; float pa = 1.f, hb = 0.f;
#pragma unroll
            for (int i = 0; i < 16; ++i) { const int r = (sg * 17 + i) * 16 + c; const float av = Al[r]; hb = av * hb + Bl[r]; pa *= av; }
            SegA[sg * 16 + c] = pa; SegB[sg * 16 + c] = hb;
        }
        LBAR();
        if (tid < 16) { float h = Car[tid];
            for (int sg = 0; sg < 32; ++sg) { CarIn[sg * 16 + tid] = h; h = SegA[sg * 16 + tid] * h + SegB[sg * 16 + tid]; }
            Car[tid] = h; }
        LBAR();
        {
            const int sg = tid >> 4, c = tid & 15; float h = CarIn[sg * 16 + c];
#pragma unroll
            for (int i = 0; i < 16; ++i) { const int r = (sg * 17 + i) * 16 + c; h = Al[r] * h + Bl[r]; Bl[r] = h; }
        }
        LBAR();
        {
            const int tok = tid;
            float y[16]; f32x4 gq[4]; cvt8(gz0, gq[0], gq[1]); cvt8(gz1, gq[2], gq[3]);
#pragma unroll
            for (int v = 0; v < 4; ++v) { const f32x4 gt = gq[v]; const f32x4 hv = *(const LAS f32x4*)(Bl + lr_row(tok) * 16 + 4 * v);
#pragma unroll
                for (int i = 0; i < 4; ++i) { const float x = gt[i]; const float u = 0.7978845608028654f * (x + 0.044715f * x * x * x); const float th = 1.0f - 2.0f * __builtin_amdgcn_rcpf(1.0f + fexp(2.0f * u));
                    y[4 * v + i] = hv[i] * 0.5f * x * (1.0f + th); } }
            v4u o0, o1; o0.x = pk2h(y[0], y[1]); o0.y = pk2h(y[2], y[3]); o0.z = pk2h(y[4], y[5]); o0.w = pk2h(y[6], y[7]); o1.x = pk2h(y[8], y[9]); o1.y = pk2h(y[10], y[11]); o1.z = pk2h(y[12], y[13]); o1.w = pk2h(y[14], y[15]);
            v4u* op = (v4u*)(mixb + (size_t)(T0 + tok) * 2048); op[0] = o0; op[1] = o1;
        }
        LBAR();
    }
    if (tid0 < 16) a->out[O_PLRU + ((size_t)l * 8 + b) * 512 + hh * 64 + qd * 16 + tid0] = Car[tid0];
    __syncthreads();
}

constexpr int PL_UP = 0, PL_UPROW = 132 * 4, PL_P = 143 * PL_UPROW;
static_assert(PL_P % 16 == 0 && PL_P + 32768 <= RING_BYTES, "pool LDS map");
__device__ __forceinline__ void pool_prompt_item(KP a, Frame& F, int l, int b, int c, int g) {
    LAS unsigned char* L = F.lds;
    const int tid = F.tid, lane = F.lane, w = F.wave, fr = lane & 15, fq = lane >> 4;
    const int t0 = c * 128, win = 2 << g;
    const bf16* proj_seq = (const bf16*)(a->ws + WS_PROJ) + (size_t)b * 2048 * NPJ;
    const bf16* pwt = (const bf16*)(a->ws + WS_PWT) + ((size_t)l * 4 + g) * 128 * 128;
    bf16* mixb = (bf16*)(a->ws + WS_MIXB) + (size_t)b * 2048 * 2048 + 1024 + g * 128;
    {
        v4u ur[5];
#pragma unroll
        for (int k = 0; k < 5; ++k) { const int i = tid + k * NTHR, rr = i >> 4, c8 = i & 15, row = t0 + rr - 15; ur[k] = (v4u){0u, 0u, 0u, 0u};
            if (i < 143 * 16 && row >= 0) ur[k] = *(const GAS v4u*)(proj_seq + (size_t)row * NPJ + OFF_POOL + g * 128 + 8 * c8); }
#pragma unroll
        for (int k = 0; k < 5; ++k) { const int i = tid + k * NTHR, rr = i >> 4, c8 = i & 15; f32x4 v0, v1; cvt8(ur[k], v0, v1);
            if (i < 143 * 16) { *(LAS f32x4*)(L + PL_UP + rr * PL_UPROW + c8 * 32) = v0; *(LAS f32x4*)(L + PL_UP + rr * PL_UPROW + c8 * 32 + 16) = v1; } }
    }
    __syncthreads();
    for (int i = tid; i < 128 * 16; i += NTHR) { const int tok = i >> 4, c8 = i & 15;
        f32x4 s0 = (f32x4){0.f, 0.f, 0.f, 0.f}, s1 = s0;
        for (int j = 0; j < win; ++j) { const LAS unsigned char* p = L + PL_UP + (tok + 15 - j) * PL_UPROW + c8 * 32; s0 += *(const LAS f32x4*)p; s1 += *(const LAS f32x4*)(p + 16); }
        const int pos = t0 + tok; const float ic = 1.0f / (float)((pos + 1 < win) ? (pos + 1) : win);
        const LAS unsigned char* p = L + PL_UP + (tok + 15) * PL_UPROW + c8 * 32; const f32x4 u0 = *(const LAS f32x4*)p, u1 = *(const LAS f32x4*)(p + 16);
        s0 = s0 * ic - u0; s1 = s1 * ic - u1;
        v4u o; o.x = pk2h(s0.x, s0.y); o.y = pk2h(s0.z, s0.w); o.z = pk2h(s1.x, s1.y); o.w = pk2h(s1.z, s1.w);
        *(LAS v4u*)(L + PL_P + sw128(tok, c8)) = o; }
    __syncthreads();
    bf16x8 pa[4];
#pragma unroll
    for (int ks = 0; ks < 4; ++ks) pa[ks] = *(const LAS bf16x8*)(L + PL_P + sw128(16 * w + fr, 4 * ks + fq));
#pragma unroll
    for (int dt = 0; dt < 8; ++dt) { f32x4 acc = (f32x4){0.f, 0.f, 0.f, 0.f};
#pragma unroll
        for (int ks = 0; ks < 4; ++ks) { const bf16x8 wf = *(const bf16x8*)(pwt + (size_t)(16 * dt + fr) * 128 + 32 * ks + 8 * fq); acc = MFMA16(pa[ks], wf, acc); }
#pragma unroll
        for (int e = 0; e < 4; ++e) mixb[(size_t)(t0 + 16 * w + 4 * fq + e) * 2048 + 16 * dt + fr] = (bf16)f2bfh(acc[e]); }
    __syncthreads();
}

struct TI { const float* W; bf16* WT; const float* gain; int K, N, k0, n0, row_off, mode, goff, kd0; };
__device__ __forceinline__ void ti_load(const TI& t, f32x4 (&v)[8], float (&gn)[8], int lane) {
    const int nn = (lane & 7) * 4, kr = lane >> 3;
#pragma unroll
    for (int i = 0; i < 8; ++i) { const int kk = 8 * i + kr; v[i] = (f32x4){0.f, 0.f, 0.f, 0.f}; gn[i] = 1.f;
        if (t.n0 + nn + 4 <= t.N) v[i] = *(const f32x4*)(t.W + (size_t)(t.k0 + kk) * t.N + t.n0 + nn);
        if (t.gain) gn[i] = t.gain[t.k0 + kk - t.goff]; }
}
__device__ __forceinline__ void ti_store(const TI& t, const f32x4 (&v)[8], const float (&gn)[8], LAS float* scr, int lane) {
    const int nn = (lane & 7) * 4, kr = lane >> 3;
#pragma unroll
    for (int i = 0; i < 8; ++i) { const int kk = 8 * i + kr; f32x4 x = v[i] * gn[i];
        scr[kk * 33 + nn] = x.x; scr[kk * 33 + nn + 1] = x.y; scr[kk * 33 + nn + 2] = x.z; scr[kk * 33 + nn + 3] = x.w; }
    LDS_WAIT(); asm volatile("" ::: "memory");
    const int c = lane & 7;
#pragma unroll
    for (int j = 0; j < 4; ++j) { const int nl = (lane >> 3) + 8 * j, n = t.n0 + nl; const LAS float* sp = scr + (8 * c) * 33 + nl;
        v4u o; o.x = pk2h(sp[0 * 33], sp[1 * 33]); o.y = pk2h(sp[2 * 33], sp[3 * 33]); o.z = pk2h(sp[4 * 33], sp[5 * 33]); o.w = pk2h(sp[6 * 33], sp[7 * 33]);
        int dr;
        if (t.mode == 0) dr = t.row_off + n; else if (t.mode == 1) dr = n < 3072 ? n : (n < 3088 ? 4096 + (n - 3072) : n - 16); else dr = 256 * (n >> 7) + (n & 127) + t.row_off;
        if (n < t.N) *(GAS v4u*)(t.WT + (size_t)dr * t.K + t.kd0 + 8 * c) = o; }
    LDS_WAIT(); asm volatile("" ::: "memory");
}
__device__ __forceinline__ void ph_prologue(KP a, Frame& F) {
    LAS float* scr = (LAS float*)(F.lds + RING_OFF + F.wave * 16384);
    const int gw = F.bid * NWAVES + F.wave, NGW = F.G * NWAVES;
    bf16* Wkv = (bf16*)(a->ws + WS_WKV); bf16* Win = (bf16*)(a->ws + WS_WIN); bf16* Wout = (bf16*)(a->ws + WS_WOUT); bf16* Wq = (bf16*)(a->ws + WS_WQ); bf16* Wo = (bf16*)(a->ws + WS_WO);
    bf16* Wgu = (bf16*)(a->ws + WS_WGU); bf16* Wd = (bf16*)(a->ws + WS_WD);
    constexpr int I_IN = 16 * 129, I_OUT = 32 * 32, I_SQ = 16 * 32, I_G = 16 * 88, I_DN = 44 * 32;
    constexpr int PER_L = I_IN + I_OUT + 4 * I_SQ + 2 * I_G + I_DN;
    auto decode = [&](int it) -> TI {
        const int l = it / PER_L; int r = it % PER_L; TI t; t.goff = 0; t.row_off = 0; t.gain = nullptr; t.mode = 0;
        if (r < I_IN) { const int kb = r / 129, nb = r % 129; t.W = a->in[11] + (size_t)l * 1024 * NIN; t.K = 1024; t.N = NIN; t.k0 = 64 * kb; t.kd0 = 64 * kb; t.n0 = 32 * nb; t.WT = Win + (size_t)l * WIN_L; t.mode = 1; t.gain = a->in[10] + (size_t)l * 1024; return t; } r -= I_IN;
        if (r < I_OUT) { const int kb = r / 32, nb = r % 32; t.W = a->in[27] + (size_t)l * 2048 * 1024; t.K = 2048; t.N = 1024; t.k0 = 64 * kb; t.kd0 = 64 * kb; t.n0 = 32 * nb; t.WT = Wout + (size_t)l * WOUT_L; if (kb >= 8 && kb < 24) { t.gain = a->in[19] + (size_t)l * 1024; t.goff = 512; t.kd0 = 64 * (kb - 8); } else if (kb < 8) t.kd0 = 64 * (kb + 16); return t; } r -= I_OUT;
        if (r < I_SQ) { const int kb = r / 32, nb = r % 32; t.W = a->in[29] + (size_t)l * 1024 * 1024; t.K = 1024; t.N = 1024; t.k0 = 64 * kb; t.kd0 = 64 * kb; t.n0 = 32 * nb; t.WT = Wq + (size_t)l * WQ_L; t.gain = a->in[28] + (size_t)l * 1024; return t; } r -= I_SQ;
        if (r < I_SQ) { const int kb = r / 32, nb = r % 32; t.W = a->in[30] + (size_t)l * 1024 * 1024; t.K = 1024; t.N = 1024; t.k0 = 64 * kb; t.kd0 = 64 * kb; t.n0 = 32 * nb; t.WT = Wkv; t.row_off = l * 2048; return t; } r -= I_SQ;
        if (r < I_SQ) { const int kb = r / 32, nb = r % 32; t.W = a->in[31] + (size_t)l * 1024 * 1024; t.K = 1024; t.N = 1024; t.k0 = 64 * kb; t.kd0 = 64 * kb; t.n0 = 32 * nb; t.WT = Wkv; t.row_off = l * 2048 + 1024; return t; } r -= I_SQ;
        if (r < I_SQ) { const int kb = r / 32, nb = r % 32; t.W = a->in[32] + (size_t)l * 1024 * 1024; t.K = 1024; t.N = 1024; t.k0 = 64 * kb; t.kd0 = 64 * kb; t.n0 = 32 * nb; t.WT = Wo + (size_t)l * WQ_L; return t; } r -= I_SQ;
        if (r < I_G) { const int kb = r / 88, nb = r % 88; t.W = a->in[34] + (size_t)l * 1024 * DFF; t.K = 1024; t.N = DFF; t.k0 = 64 * kb; t.kd0 = 64 * kb; t.n0 = 32 * nb; t.WT = Wgu + (size_t)l * WGU_L; t.mode = 2; t.gain = a->in[33] + (size_t)l * 1024; return t; } r -= I_G;
        if (r < I_G) { const int kb = r / 88, nb = r % 88; t.W = a->in[35] + (size_t)l * 1024 * DFF; t.K = 1024; t.N = DFF; t.k0 = 64 * kb; t.kd0 = 64 * kb; t.n0 = 32 * nb; t.WT = Wgu + (size_t)l * WGU_L; t.mode = 2; t.row_off = 128; t.gain = a->in[33] + (size_t)l * 1024; return t; } r -= I_G;
        { const int kb = r / 32, nb = r % 32; t.W = a->in[36] + (size_t)l * DFF * 1024; t.K = DFF; t.N = 1024; t.k0 = 64 * kb; t.kd0 = 64 * kb; t.n0 = 32 * nb; t.WT = Wd + (size_t)l * WD_L; return t; }
    };
    if (gw < DEPTH * PER_L) {
        int it = gw; TI cur = decode(it); f32x4 v[8]; float gn[8]; ti_load(cur, v, gn, F.lane);
        for (;;) {
            const int nit = it + NGW; const bool has = nit < DEPTH * PER_L;
            TI nxt = cur; f32x4 vn[8]; float gnn[8];
            if (has) { nxt = decode(nit); ti_load(nxt, vn, gnn, F.lane); }
            ti_store(cur, v, gn, scr, F.lane);
            if (!has) break;
            cur = nxt; it = nit;
#pragma unroll
            for (int i = 0; i < 8; ++i) { v[i] = vn[i]; gn[i] = gnn[i]; }
        }
    }
    { bf16* pwt = (bf16*)(a->ws + WS_PWT);
      for (size_t i = (size_t)F.bid * NTHR + F.tid; i < (size_t)DEPTH * 4 * 128 * 128; i += (size_t)F.G * NTHR) { const int c = (int)(i & 127), d = (int)((i >> 7) & 127), lg = (int)(i >> 14);
          pwt[i] = (bf16)f2bfh(a->in[12][((size_t)lg * 128 + c) * 128 + d] * a->in[13][(size_t)lg * 128 + d]); } }
    const size_t gt = (size_t)F.bid * NTHR + F.tid, gs = (size_t)F.G * NTHR;
    { const f32x4* src = (const f32x4*)a->in[2]; unsigned long long* dst = (unsigned long long*)(a->ws + WS_MEMB);
      for (size_t i = gt; i < (size_t)2048 * 1024 / 4; i += gs) { const f32x4 v = src[i]; dst[i] = (unsigned long long)pk2h(v.x, v.y) | ((unsigned long long)pk2h(v.z, v.w) << 32); } }
    { bf16* hb = (bf16*)(a->ws + WS_HB); float* rss = (float*)(a->ws + WS_RSS);
      for (int r0 = gw; r0 < MT; r0 += 4 * NGW) {
          f32x4 v[4][4];
#pragma unroll
          for (int q = 0; q < 4; ++q) { const int r = r0 + q * NGW; const f32x4* src = (const f32x4*)((r < MP ? a->in[0] : a->in[1] - (size_t)MP * D) + (size_t)r * D);
#pragma unroll
              for (int j = 0; j < 4; ++j) v[q][j] = r < MT ? src[F.lane + 64 * j] : (f32x4){0.f, 0.f, 0.f, 0.f}; }
#pragma unroll
          for (int q = 0; q < 4; ++q) { const int r = r0 + q * NGW; float ss = 0.f;
              if (r < MT) {
#pragma unroll
                  for (int j = 0; j < 4; ++j) { const f32x4 x = v[q][j]; ss += x.x * x.x + x.y * x.y + x.z * x.z + x.w * x.w;
                      ((unsigned long long*)(hb + (size_t)r * D))[F.lane + 64 * j] = (unsigned long long)pk2h(x.x, x.y) | ((unsigned long long)pk2h(x.z, x.w) << 32); } }
              ss = wave_sum(ss);
              if (r < MT && F.lane < 16) rss[(size_t)r * 16 + F.lane] = F.lane == 0 ? ss : 0.f; } } }
}

__device__ __forceinline__ void ph_final_norm(Frame& F, const bf16* hb, const float* g, float* Y) {
    const int gw = F.bid * NWAVES + F.wave, NGW = F.G * NWAVES;
    f32x4 gg[4];
#pragma unroll
    for (int j = 0; j < 4; ++j) gg[j] = ((const f32x4*)g)[F.lane + 64 * j];
    for (int r0 = gw; r0 < MT; r0 += 4 * NGW) {
        unsigned long long u[4][4];
#pragma unroll
        for (int q = 0; q < 4; ++q) { const int r = r0 + q * NGW;
#pragma unroll
            for (int j = 0; j < 4; ++j) u[q][j] = r < MT ? ((const unsigned long long*)(hb + (size_t)r * D))[F.lane + 64 * j] : 0ull; }
#pragma unroll
        for (int q = 0; q < 4; ++q) { const int r = r0 + q * NGW; f32x4 v[4]; float ss = 0.f;
#pragma unroll
            for (int j = 0; j < 4; ++j) { const unsigned long long x = u[q][j];
                v[j] = (f32x4){bf2f((unsigned short)x), bf2f((unsigned short)(x >> 16)), bf2f((unsigned short)(x >> 32)), bf2f((unsigned short)(x >> 48))}; ss += v[j].x * v[j].x + v[j].y * v[j].y + v[j].z * v[j].z + v[j].w * v[j].w; }
            ss = wave_sum(ss);
            const float rstd = 1.0f / sqrtf(ss * (1.0f / D) + EPS);
            if (r < MT) {
#pragma unroll
                for (int j = 0; j < 4; ++j) ((f32x4*)(Y + (size_t)r * D))[F.lane + 64 * j] = v[j] * rstd * gg[j]; } }
    }
}

__device__ __forceinline__ float pool_up(const bf16* proj, const float* st_in, const SeqInfo& q, int ci, int ch) {
    if (ci < 15) return q.grp ? st_in[((size_t)q.b * 15 + ci) * 512 + ch] : 0.f;
    return bf2f(proj[(size_t)(q.row0 + ci - 15) * NPJ + OFF_POOL + ch]);
}
__device__ __forceinline__ float conv_xp(const bf16* proj, int off, const float* st_in, int C, const SeqInfo& q, int j, int c) {
    if (j < 3) return q.grp ? st_in[((size_t)q.b * 3 + j) * C + c] : 0.f;
    return bf2f(proj[(size_t)(q.row0 + j - 3) * NPJ + off + c]);
}
__device__ __forceinline__ void conv_states(size_t gt, size_t gs, const bf16* proj, int off, int C, const float* st_in, float* p_out, float* s_out) {
    for (size_t idx = gt; idx < (size_t)NSEQ * 3 * C; idx += gs) {
        const int c = (int)(idx % C), j = (int)((idx / C) % 3), s = (int)(idx / ((size_t)3 * C));
        const SeqInfo q = seq_info(s);
        const float v = conv_xp(proj, off, st_in, C, q, q.L + j, c);
        if (q.grp) s_out[((size_t)q.b * 3 + j) * C + c] = v; else p_out[((size_t)q.b * 3 + j) * C + c] = v;
    }
}
constexpr int SS_X = 0, SS_BC = 8192, SS_DT = 12288;
__device__ __forceinline__ void samp_ssd_item(KP a, Frame& F, int l, int b, int g) {
    LAS float* XS = (LAS float*)(F.lds + RING_OFF + SS_X); LAS float* BC = (LAS float*)(F.lds + RING_OFF + SS_BC); LAS float* DTs = (LAS float*)(F.lds + RING_OFF + SS_DT);
    const int tid = F.tid;
    const bf16* proj = (const bf16*)(a->ws + WS_PROJ) + (size_t)(MP + 4 * b) * NPJ; const float* dtr = (const float*)(a->ws + WS_DT) + (size_t)(MP + 4 * b) * 16;
    const float* cst = a->in[4] + ((size_t)l * 128 + b) * 3 * 1536; const float* cw = a->in[14] + (size_t)l * 4 * 1536; const float* cb = a->in[15] + (size_t)l * 1536;
    bf16* mixb = (bf16*)(a->ws + WS_MIXB) + (size_t)(MP + 4 * b) * 2048;
#pragma unroll
    for (int rep = 0; rep < 2; ++rep) {
        if (rep == 1 && tid >= 256) break;
        const int sc = rep == 0 ? g * 512 + tid : (tid < 128 ? 1024 + g * 128 + tid : 1280 + g * 128 + (tid - 128));
        float xp[7];
#pragma unroll
        for (int j = 0; j < 3; ++j) xp[j] = cst[(size_t)j * 1536 + sc];
#pragma unroll
        for (int t = 0; t < 4; ++t) xp[3 + t] = bf2f(proj[(size_t)t * NPJ + OFF_XBC + sc]);
        const float w0 = cw[sc], w1 = cw[1536 + sc], w2 = cw[2 * 1536 + sc], w3 = cw[3 * 1536 + sc], bb = cb[sc];
#pragma unroll
        for (int t = 0; t < 4; ++t) { const float v = fsilu(bb + w0 * xp[t] + w1 * xp[t + 1] + w2 * xp[t + 2] + w3 * xp[t + 3]); if (rep == 0) XS[t * 512 + tid] = v; else BC[t * 256 + tid] = v; }
    }
    if (tid < 32) { const int t = tid >> 3, k = tid & 7, hd = 8 * g + k; const float dt = softplus_f(dtr[(size_t)t * 16 + hd] + a->in[16][l * 16 + hd]); DTs[t * 8 + k] = dt; DTs[32 + t * 8 + k] = expf(dt * -expf(a->in[17][l * 16 + hd])); }
    __syncthreads();
    const int p = tid >> 3, ng = tid & 7;
    const float* st_in = a->in[5] + (((size_t)l * 128 + b) * 16 + 8 * g) * 64 * 128 + (size_t)p * 128 + ng * 16;
    float* st_out = a->out + O_SSSD + (((size_t)l * 128 + b) * 16 + 8 * g) * 64 * 128 + (size_t)p * 128 + ng * 16;
    f32x4 hn[4];
#pragma unroll
    for (int i = 0; i < 4; ++i) hn[i] = *(const f32x4*)(st_in + 4 * i);
#pragma unroll 1
    for (int k = 0; k < 8; ++k) {
        f32x4 h[4];
#pragma unroll
        for (int i = 0; i < 4; ++i) h[i] = hn[i];
        if (k + 1 < 8) {
#pragma unroll
            for (int i = 0; i < 4; ++i) hn[i] = *(const f32x4*)(st_in + (size_t)(k + 1) * 64 * 128 + 4 * i); }
        const int hd = 8 * g + k; const float Dk = a->in[18][l * 16 + hd];
        float zv[4];
#pragma unroll
        for (int t = 0; t < 4; ++t) zv[t] = bf2f(proj[(size_t)t * NPJ + OFF_Z + hd * 64 + p]);
#pragma unroll
        for (int t = 0; t < 4; ++t) {
            const float dt = DTs[t * 8 + k], dA = DTs[32 + t * 8 + k], x = XS[t * 512 + k * 64 + p], xdt = dt * x;
            float part = 0.f;
#pragma unroll
            for (int i = 0; i < 4; ++i) { const f32x4 Bv = *(const LAS f32x4*)(BC + t * 256 + ng * 16 + 4 * i), Cv = *(const LAS f32x4*)(BC + t * 256 + 128 + ng * 16 + 4 * i);
                h[i] = h[i] * dA + Bv * xdt; part += (Cv.x * h[i].x + Cv.y * h[i].y) + (Cv.z * h[i].z + Cv.w * h[i].w); }
            part += __shfl_xor(part, 1); part += __shfl_xor(part, 2); part += __shfl_xor(part, 4);
            if (ng == 0) mixb[(size_t)t * 2048 + hd * 64 + p] = (bf16)f2bfh((part + Dk * x) * fsilu(zv[t]));
        }
#pragma unroll
        for (int i = 0; i < 4; ++i) *(f32x4*)(st_out + (size_t)k * 64 * 128 + 4 * i) = h[i];
    }
    __syncthreads();
}
__device__ __forceinline__ void samp_lru_item(KP a, Frame& F, int l, int b) {
    LAS float* XC = (LAS float*)(F.lds + RING_OFF);
    const int c = F.tid, hd = c >> 6, j = c & 63;
    const bf16* proj = (const bf16*)(a->ws + WS_PROJ) + (size_t)(MP + 4 * b) * NPJ;
    const float* cst = a->in[6] + ((size_t)l * 128 + b) * 3 * 512; const float* cw = a->in[20] + (size_t)l * 4 * 512;
    float xp[7];
#pragma unroll
    for (int k = 0; k < 3; ++k) xp[k] = cst[(size_t)k * 512 + c];
#pragma unroll
    for (int t = 0; t < 4; ++t) xp[3 + t] = bf2f(proj[(size_t)t * NPJ + OFF_LRU + c]);
    const float w0 = cw[c], w1 = cw[512 + c], w2 = cw[1024 + c], w3 = cw[1536 + c], bb = a->in[21][(size_t)l * 512 + c];
    float xc[4];
#pragma unroll
    for (int t = 0; t < 4; ++t) { xc[t] = bb + w0 * xp[t] + w1 * xp[t + 1] + w2 * xp[t + 2] + w3 * xp[t + 3]; XC[t * 512 + c] = xc[t]; }
    __syncthreads();
    const float* wa = a->in[22] + ((size_t)l * 8 + hd) * 64 * 64 + j; const float* wx = a->in[24] + ((size_t)l * 8 + hd) * 64 * 64 + j;
    float ar[4], ai[4], gz[4];
#pragma unroll
    for (int t = 0; t < 4; ++t) { ar[t] = a->in[23][(size_t)l * 512 + c]; ai[t] = a->in[25][(size_t)l * 512 + c]; gz[t] = bf2f(proj[(size_t)t * NPJ + OFF_GATE + c]); }
    const float lamv = a->in[26][(size_t)l * 512 + c]; float h = a->in[7][((size_t)l * 128 + b) * 512 + c];
#pragma unroll 16
    for (int i = 0; i < 64; ++i) { const float wav = wa[(size_t)i * 64], wxv = wx[(size_t)i * 64];
#pragma unroll
        for (int t = 0; t < 4; ++t) { const float xv = XC[t * 512 + hd * 64 + i]; ar[t] += xv * wav; ai[t] += xv * wxv; } }
    const float spv = -8.0f * softplus_f(-lamv);
    bf16* mixb = (bf16*)(a->ws + WS_MIXB) + (size_t)(MP + 4 * b) * 2048 + 1536 + c;
#pragma unroll
    for (int t = 0; t < 4; ++t) { const float rg = sigmoid_f(ar[t]), ig = sigmoid_f(ai[t]); const float log_a = spv * rg; const float av = expf(log_a), mult = sqrtf(-expm1f(2.0f * log_a));
        h = av * h + mult * ig * xc[t];
        mixb[(size_t)t * 2048] = (bf16)f2bfh(h * gelu_tanh_f(gz[t])); }
    a->out[O_SLRU + ((size_t)l * 128 + b) * 512 + c] = h;
    __syncthreads();
}
__device__ __forceinline__ void samp_pool_item(KP a, Frame& F, int l, int b) {
    LAS float* PO = (LAS float*)(F.lds + RING_OFF);
    const int ch = F.tid, g = ch >> 7, w = 2 << g;
    const bf16* proj = (const bf16*)(a->ws + WS_PROJ) + (size_t)(MP + 4 * b) * NPJ;
    const float* st = a->in[3] + ((size_t)l * 128 + b) * 15 * 512;
    float up[19];
#pragma unroll
    for (int i = 0; i < 15; ++i) up[i] = st[(size_t)i * 512 + ch];
#pragma unroll
    for (int t = 0; t < 4; ++t) up[15 + t] = bf2f(proj[(size_t)t * NPJ + OFF_POOL + ch]);
    const float iw = 1.0f / (float)w;
#pragma unroll
    for (int t = 0; t < 4; ++t) { float sm = 0.f;
#pragma unroll
        for (int jj = 0; jj < 16; ++jj) sm += (jj < w) ? up[15 + t - jj] : 0.f;
        PO[t * 512 + ch] = sm * iw - up[15 + t]; }
    __syncthreads();
    const int d = ch & 127; const float* pw = a->in[12] + ((size_t)l * 4 + g) * 128 * 128 + d; const float sc = a->in[13][(size_t)l * 512 + ch];
    float acc[4] = {0.f, 0.f, 0.f, 0.f};
#pragma unroll 32
    for (int cc = 0; cc < 128; ++cc) { const float wv = pw[(size_t)cc * 128];
#pragma unroll
        for (int t = 0; t < 4; ++t) acc[t] += PO[t * 512 + g * 128 + cc] * wv; }
    bf16* mixb = (bf16*)(a->ws + WS_MIXB) + (size_t)(MP + 4 * b) * 2048 + 1024 + ch;
#pragma unroll
    for (int t = 0; t < 4; ++t) mixb[(size_t)t * 2048] = (bf16)f2bfh(acc[t] * sc);
    __syncthreads();
}

__device__ __forceinline__ void ph_mix1(KP a, Frame& F, int l) {
    const size_t gt = (size_t)F.bid * NTHR + F.tid, gs = (size_t)F.G * NTHR;
    const bf16* proj = (const bf16*)(a->ws + WS_PROJ);
    {
        const float* st_in = a->in[3] + (size_t)l * 128 * 15 * 512;
        float* pp_out = a->out + O_PPOOL + (size_t)l * 8 * 15 * 512; float* ps_out = a->out + O_SPOOL + (size_t)l * 128 * 15 * 512;
        float* cp_out = a->out + O_PSCONV + (size_t)l * 8 * 3 * 1536; float* cs_out = a->out + O_SSCONV + (size_t)l * 128 * 3 * 1536;
        float* lp_out = a->out + O_PLCONV + (size_t)l * 8 * 3 * 512; float* ls_out = a->out + O_SLCONV + (size_t)l * 128 * 3 * 512;
        constexpr int NA = (8 * 15 + 128 * 4) * 64, NB = 128 * 11 * 128, NC = NSEQ * 3 * 192, ND = NSEQ * 3 * 64;
        auto srcA = [&](int idx) -> const bf16* { const int c8 = idx & 63, r = idx >> 6; int row; if (r < 120) { const int b = r / 15, j = r - 15 * b; row = b * 2048 + 2033 + j; } else { const int r2 = r - 120; row = MP + r2; } return proj + (size_t)row * NPJ + OFF_POOL + 8 * c8; };
        auto dstA = [&](int idx) -> float* { const int c8 = idx & 63, r = idx >> 6; if (r < 120) return pp_out + (size_t)r * 512 + 8 * c8; const int r2 = r - 120, b = r2 >> 2, jj = r2 & 3; return ps_out + ((size_t)b * 15 + 11 + jj) * 512 + 8 * c8; };
        auto srcB = [&](int idx) -> const float* { const int c4 = idx & 127, r = idx >> 7, b = r / 11, j = r - 11 * b; return st_in + ((size_t)b * 15 + j + 4) * 512 + 4 * c4; };
        auto dstB = [&](int idx) -> float* { const int c4 = idx & 127, r = idx >> 7, b = r / 11, j = r - 11 * b; return ps_out + ((size_t)b * 15 + j) * 512 + 4 * c4; };
        auto srcC = [&](int idx, int C8, int off) -> const bf16* { const int c8 = idx % C8, r = idx / C8, sq = r / 3, j = r - 3 * sq; const int row = sq < 8 ? sq * 2048 + 2045 + j : MP + (sq - 8) * 4 + 1 + j; return proj + (size_t)row * NPJ + off + 8 * c8; };
        auto dstC = [&](int idx, int C8, float* po, float* so) -> float* { const int c8 = idx % C8, r = idx / C8, sq = r / 3, j = r - 3 * sq; return sq < 8 ? po + ((size_t)sq * 3 + j) * (8 * C8) + 8 * c8 : so + ((size_t)(sq - 8) * 3 + j) * (8 * C8) + 8 * c8; };
        auto put8 = [&](float* o, const v4u& u) { f32x4 v0, v1; cvt8(u, v0, v1); *(f32x4*)o = v0; *(f32x4*)(o + 4) = v1; };
        const int t0_ = (int)gt, n_ = (int)gs;
        v4u uA = (v4u){0u, 0u, 0u, 0u}, uC = uA, uD = uA; f32x4 fB0 = (f32x4){0.f, 0.f, 0.f, 0.f}, fB1 = fB0;
        if (t0_ < NA) uA = *(const GAS v4u*)srcA(t0_);
        if (t0_ < NB) fB0 = *(const f32x4*)srcB(t0_);
        if (t0_ + n_ < NB) fB1 = *(const f32x4*)srcB(t0_ + n_);
        if (t0_ < NC) uC = *(const GAS v4u*)srcC(t0_, 192, OFF_XBC);
        if (t0_ < ND) uD = *(const GAS v4u*)srcC(t0_, 64, OFF_LRU);
        if (t0_ < NA) put8(dstA(t0_), uA);
        if (t0_ < NB) *(f32x4*)dstB(t0_) = fB0;
        if (t0_ + n_ < NB) *(f32x4*)dstB(t0_ + n_) = fB1;
        if (t0_ < NC) put8(dstC(t0_, 192, cp_out, cs_out), uC);
        if (t0_ < ND) put8(dstC(t0_, 64, lp_out, ls_out), uD);
        for (int idx = t0_ + n_; idx < NA; idx += n_) { const v4u u = *(const GAS v4u*)srcA(idx); put8(dstA(idx), u); }
        for (int idx = t0_ + 2 * n_; idx < NB; idx += n_) *(f32x4*)dstB(idx) = *(const f32x4*)srcB(idx);
        for (int idx = t0_ + n_; idx < NC; idx += n_) { const v4u u = *(const GAS v4u*)srcC(idx, 192, OFF_XBC); put8(dstC(idx, 192, cp_out, cs_out), u); }
        for (int idx = t0_ + n_; idx < ND; idx += n_) { const v4u u = *(const GAS v4u*)srcC(idx, 64, OFF_LRU); put8(dstC(idx, 64, lp_out, ls_out), u); }
    }
    __syncthreads();
    { const KP kp = a; (void)kp;
    REG_BEGIN(0);
    for (int it = F.vcu; it < 256; it += F.G) ssd_prompt_item(a, F, l, it >> 5, (it >> 1) & 15, it & 1);
    REG_END(0); REG_BEGIN(1);
    for (int it = F.vcu; it < 256; it += F.G) lru_prompt_item(a, F, l, it >> 5, (it >> 2) & 7, it & 3);
    REG_END(1); }
    for (int it = F.vcu; it < 512; it += F.G) pool_prompt_item(a, F, l, it >> 6, (it >> 2) & 15, it & 3);
    for (int it = F.bid; it < 256; it += F.G) samp_ssd_item(a, F, l, it >> 1, it & 1);
    for (int it = F.bid; it < 256; it += F.G) { if (it < 128) samp_lru_item(a, F, l, it); else samp_pool_item(a, F, l, it - 128); }
}
__device__ __forceinline__ void ph_mix3(KP a, Frame& F, int l) {
    bf16* mixb = (bf16*)(a->ws + WS_MIXB);
    const int gw = F.bid * NWAVES + F.wave, NGW = F.G * NWAVES;
    for (int r = gw; r < MP; r += NGW) {
        const float* sp = (const float*)(a->ws + WS_SSDSS) + (size_t)r * 32;
        float ss = F.lane < 32 ? sp[F.lane] : 0.f; ss = wave_sum(ss);
        const float rstd = 1.0f / sqrtf(ss * (1.0f / 1024.f) + EPS);
#pragma unroll
        for (int j = 0; j < 4; ++j) { const int c = 4 * F.lane + 256 * j; unsigned long long* mp = (unsigned long long*)(mixb + (size_t)r * 2048 + 512 + c); const unsigned long long u = *mp;
            const float w0 = bf2f((unsigned short)u) * rstd, w1 = bf2f((unsigned short)(u >> 16)) * rstd, w2 = bf2f((unsigned short)(u >> 32)) * rstd, w3 = bf2f((unsigned short)(u >> 48)) * rstd;
            *mp = (unsigned long long)pk2h(w0, w1) | ((unsigned long long)pk2h(w2, w3) << 32); }
    }
}
constexpr int SG_PSTRIDE = 36, SG_P = 0, SG_SS = 8 * 64 * SG_PSTRIDE * 4;
static_assert(SG_SS + 8 * 64 * 4 <= RING_BYTES, "small gemm LDS map");
__device__ __forceinline__ float sumsq8(bf16x8 v) { float s = 0.f;
#pragma unroll
    for (int j = 0; j < 8; ++j) { const float x = bf2f((unsigned short)v[j]); s += x * x; } return s; }
template <int K, int STATS  , class Epi>
__device__ __forceinline__ void small_gemm(Frame& F, const bf16* A, const bf16* Bt, int it0, int it1, const Epi& E) {
    constexpr int KW = K / 8, KS = KW / 32;
    constexpr bool REUSE = Epi::RT_SLOW && K == 1024;
    static_assert(K % 256 == 0, "K splits into eight 32-multiples");
    LAS float* P = (LAS float*)(F.lds + RING_OFF + SG_P); LAS float* SS = (LAS float*)(F.lds + RING_OFF + SG_SS);
    const int w = F.wave;
    bf16x8 afr[REUSE ? KS : 1][4]; float ssqr[4] = {0.f, 0.f, 0.f, 0.f}; int rt_have = -1;
    for (int it = it0; it < it1; ++it) {
        int tid = F.tid; asm volatile("" : "+v"(tid));
        const int lane = tid & 63, fr = lane & 15, fq = lane >> 4;
        const int rt = Epi::RT_SLOW ? it / E.nctl : (it & 7), ct = Epi::RT_SLOW ? E.ct0 + it % E.nctl : (it >> 3);
        if (Epi::RT_SLOW && ct >= Epi::NCT) continue;
        int nb0, nb1; E.bases(ct, nb0, nb1);
        const bf16* Ap = A + (size_t)(64 * rt + fr) * K + w * KW + 8 * fq;
        const bf16* Bp0 = Bt + (size_t)(nb0 + fr) * K + w * KW + 8 * fq; const bf16* Bp1 = Bt + (size_t)(nb1 + fr) * K + w * KW + 8 * fq;
        f32x4 acc[4][2]; float ssq[4];
#pragma unroll
        for (int mt = 0; mt < 4; ++mt) { acc[mt][0] = (f32x4){0.f, 0.f, 0.f, 0.f}; acc[mt][1] = (f32x4){0.f, 0.f, 0.f, 0.f}; ssq[mt] = 0.f; }
        if constexpr (REUSE) {
            bf16x8 bq[KS][2];
#pragma unroll
            for (int ks = 0; ks < KS; ++ks) { bq[ks][0] = *(const bf16x8*)(Bp0 + 32 * ks); bq[ks][1] = *(const bf16x8*)(Bp1 + 32 * ks); }
            if (rt != rt_have) {
#pragma unroll
                for (int ks = 0; ks < KS; ++ks)
#pragma unroll
                    for (int mt = 0; mt < 4; ++mt) afr[ks][mt] = *(const bf16x8*)(Ap + (size_t)mt * 16 * K + 32 * ks);
#pragma unroll
                for (int mt = 0; mt < 4; ++mt) { float sv = 0.f;
#pragma unroll
                    for (int ks = 0; ks < KS; ++ks) sv += sumsq8(afr[ks][mt]);
                    ssqr[mt] = sv; }
                rt_have = rt;
            }
#pragma unroll
            for (int ks = 0; ks < KS; ++ks)
#pragma unroll
                for (int mt = 0; mt < 4; ++mt) { acc[mt][0] = MFMA16(afr[ks][mt], bq[ks][0], acc[mt][0]); acc[mt][1] = MFMA16(afr[ks][mt], bq[ks][1], acc[mt][1]); }
#pragma unroll
            for (int mt = 0; mt < 4; ++mt) ssq[mt] = ssqr[mt];
        } else {
#pragma unroll
            for (int ks = 0; ks < KS; ++ks) {
                bf16x8 af[4];
#pragma unroll
                for (int mt = 0; mt < 4; ++mt) af[mt] = *(const bf16x8*)(Ap + (size_t)mt * 16 * K + 32 * ks);
                const bf16x8 b0 = *(const bf16x8*)(Bp0 + 32 * ks), b1 = *(const bf16x8*)(Bp1 + 32 * ks);
#pragma unroll
                for (int mt = 0; mt < 4; ++mt) { acc[mt][0] = MFMA16(af[mt], b0, acc[mt][0]); acc[mt][1] = MFMA16(af[mt], b1, acc[mt][1]); if (STATS == 1 || (STATS == 2 && w < 4)) ssq[mt] += sumsq8(af[mt]); }
            }
        }
#pragma unroll
        for (int mt = 0; mt < 4; ++mt) {
#pragma unroll
            for (int nt = 0; nt < 2; ++nt)
#pragma unroll
                for (int e = 0; e < 4; ++e) P[(w * 64 + 16 * mt + 4 * fq + e) * SG_PSTRIDE + 16 * nt + fr] = acc[mt][nt][e];
            if (STATS) { float sv = ssq[mt]; sv += __shfl_xor(sv, 16); sv += __shfl_xor(sv, 32); if (fq == 0) SS[w * 64 + 16 * mt + fr] = sv; }
        }
        __syncthreads();
        {
            const int row = tid >> 3, cq = tid & 7;
            f32x4 v = (f32x4){0.f, 0.f, 0.f, 0.f}, v2 = v;
            float rstd = 1.f;
            if (STATS) { float sm = 0.f;
#pragma unroll
                for (int ww = 0; ww < 8; ++ww) sm += SS[ww * 64 + row];
                rstd = 1.0f / sqrtf(sm * (1.0f / 1024.f) + EPS); }
#pragma unroll
            for (int ww = 0; ww < 8; ++ww) { const float sc = (STATS == 2 && ww < 4) ? rstd : 1.f;
                v += *(const LAS f32x4*)(P + (ww * 64 + row) * SG_PSTRIDE + 4 * cq) * sc; if (Epi::PAIR) v2 += *(const LAS f32x4*)(P + (ww * 64 + row) * SG_PSTRIDE + 4 * (cq ^ 4)); }
            if (STATS == 2) rstd = 1.f;
            E.store(ct, MP + 64 * rt + row, cq, v, v2, rstd);
        }
        __syncthreads();
    }
}
struct SProj {
    static constexpr bool PAIR = false, RT_SLOW = true; static constexpr int NCT = 129; bf16* proj; float* dtr; int ct0, nctl;
    __device__ __forceinline__ void bases(int ct, int& nb0, int& nb1) const { nb0 = 32 * ct; nb1 = nb0 + 16; }
    __device__ __forceinline__ void store(int ct, int row, int cq, f32x4 v, f32x4, float rstd) const { const int j = 32 * ct + 4 * cq; const f32x4 o = v * rstd;
        if (j < 4096) *(unsigned long long*)(proj + (size_t)row * NPJ + j) = (unsigned long long)pk2h(o.x, o.y) | ((unsigned long long)pk2h(o.z, o.w) << 32);
        else if (j < 4112) *(f32x4*)(dtr + (size_t)row * 16 + (j - 4096)) = o; }
};
struct SResid {
    static constexpr bool PAIR = false, RT_SLOW = false; static constexpr int NCT = 32, ct0 = 0, nctl = 1; bf16* hb;
    __device__ __forceinline__ void bases(int ct, int& nb0, int& nb1) const { nb0 = 32 * ct; nb1 = nb0 + 16; }
    __device__ __forceinline__ void store(int ct, int row, int cq, f32x4 v, f32x4, float) const { const int c = 32 * ct + 4 * cq; unsigned long long* hp = (unsigned long long*)(hb + (size_t)row * 1024 + c); const unsigned long long u = *hp;
        const float o0 = bf2f((unsigned short)u) + v.x, o1 = bf2f((unsigned short)(u >> 16)) + v.y, o2 = bf2f((unsigned short)(u >> 32)) + v.z, o3 = bf2f((unsigned short)(u >> 48)) + v.w;
        *hp = (unsigned long long)pk2h(o0, o1) | ((unsigned long long)pk2h(o2, o3) << 32); }
};
struct SQ {
    static constexpr bool PAIR = false, RT_SLOW = false; static constexpr int NCT = 32, ct0 = 0, nctl = 1; bf16* qb; float scale;
    __device__ __forceinline__ void bases(int ct, int& nb0, int& nb1) const { nb0 = 32 * ct; nb1 = nb0 + 16; }
    __device__ __forceinline__ void store(int ct, int row, int cq, f32x4 v, f32x4, float rstd) const { const int c = 32 * ct + 4 * cq; const f32x4 o = v * (rstd * scale);
        *(unsigned long long*)(qb + (size_t)row * 1024 + c) = (unsigned long long)pk2h(o.x, o.y) | ((unsigned long long)pk2h(o.z, o.w) << 32); }
};
struct SSwiGLU {
    static constexpr bool PAIR = true, RT_SLOW = true; static constexpr int NCT = 176; bf16* act; int ct0, nctl;
    __device__ __forceinline__ void bases(int ct, int& nb0, int& nb1) const { nb0 = 256 * (ct >> 3) + 16 * (ct & 7); nb1 = nb0 + 128; }
    __device__ __forceinline__ void store(int ct, int row, int cq, f32x4 g, f32x4 u, float rstd) const { if (cq < 4) { const int c = 128 * (ct >> 3) + 16 * (ct & 7) + 4 * cq; const f32x4 gs = g * rstd, us = u * rstd;
        *(unsigned long long*)(act + (size_t)row * DFF + c) = (unsigned long long)pk2h(fsilu(gs.x) * us.x, fsilu(gs.y) * us.y) | ((unsigned long long)pk2h(fsilu(gs.z) * us.z, fsilu(gs.w) * us.w) << 32); } }
};
__device__ __forceinline__ void dt_gemm(Frame& F, const bf16* hb, const bf16* Wdt, const float* rss, float* dtr) {
    for (int it = F.bid; it < MP / 128; it += F.G) {
        int tid = F.tid; asm volatile("" : "+v"(tid)); const int lane = tid & 63, fr = lane & 15, fq = lane >> 4;
        const int row0 = it * 128 + 16 * F.wave;
        f32x4 acc = (f32x4){0.f, 0.f, 0.f, 0.f};
#pragma unroll 8
        for (int ks = 0; ks < 32; ++ks) { const bf16x8 af = *(const bf16x8*)(hb + (size_t)(row0 + fr) * 1024 + 32 * ks + 8 * fq); const bf16x8 bfm = *(const bf16x8*)(Wdt + (size_t)fr * 1024 + 32 * ks + 8 * fq); acc = MFMA16(af, bfm, acc); }
#pragma unroll
        for (int e = 0; e < 4; ++e) { const int row = row0 + 4 * fq + e; const f32x4* rp = (const f32x4*)(rss + (size_t)row * 16); const f32x4 p0 = rp[0], p1 = rp[1], p2 = rp[2], p3 = rp[3];
            const float sm = ((p0.x + p0.y) + (p0.z + p0.w)) + ((p1.x + p1.y) + (p1.z + p1.w)) + ((p2.x + p2.y) + (p2.z + p2.w)) + ((p3.x + p3.y) + (p3.z + p3.w));
            dtr[(size_t)row * 16 + fr] = acc[e] * (1.0f / sqrtf(sm * (1.0f / 1024.f) + EPS)); }
    }
}

__device__ __forceinline__ void attn_prompt_unit(Frame& F, const bf16* qb, const bf16* kb_l, const bf16* vt_l, bf16* ob, int b, int hh, int qt) {
    LAS unsigned char* lds = F.lds + RING_OFF;
    const int lane = F.lane, fr = lane & 15, fq = lane >> 4, tid = F.tid;
    const int r0 = b * 2048 + qt * 256 + F.wave * 32;
    const bf16* kbase = kb_l + (size_t)(b * 256) * 1024 + hh * 256; const bf16* vbase = vt_l + (size_t)(hh * 256) * 2048 + b * 256;
    v4u rg[8];
#define ATT_LOAD(base, pitch, half) do { const bf16* tb_ = (base); asm volatile("" : "+s"(tb_)); tb_ += (size_t)((half) * 128 + (tid >> 5)) * (pitch) + (tid & 31) * 8; \
        _Pragma("unroll") for (int ps = 0; ps < 8; ++ps) rg[ps] = *(const GAS v4u*)(tb_ + (size_t)ps * 16 * (pitch)); } while (0)
#define ATT_STORE(bufoff) do { LAS unsigned char* lb_ = lds + (bufoff) + (tid >> 5) * 512 + (((tid & 31) ^ ((tid >> 5) & 15)) << 4); \
        _Pragma("unroll") for (int ps = 0; ps < 8; ++ps) *(LAS v4u*)(lb_ + ps * 8192) = rg[ps]; } while (0)
    ATT_LOAD(kbase, 1024, 0); ATT_STORE(0);
    ATT_LOAD(kbase, 1024, 1); ATT_STORE(65536);
    LBAR();
    bf16x8 pf[2][8]; float inv[2];
#pragma unroll
    for (int mt = 0; mt < 2; ++mt) {
        __builtin_amdgcn_sched_barrier(0);
        bf16x8 qf[8];
#pragma unroll
        for (int ks = 0; ks < 8; ++ks) qf[ks] = *(const bf16x8*)(qb + (size_t)(r0 + mt * 16 + fr) * 1024 + hh * 256 + ks * 32 + fq * 8);
        f32x4 s[16];
#pragma unroll
        for (int kt = 0; kt < 16; ++kt) { s[kt] = (f32x4){0.f, 0.f, 0.f, 0.f};
#pragma unroll
            for (int kh = 0; kh < 2; ++kh) { bf16x8 kf[4];
#pragma unroll
                for (int ks = 0; ks < 4; ++ks) kf[ks] = *(const LAS bf16x8*)(lds + (16 * kt + fr) * 512 + (((4 * (4 * kh + ks) + fq) ^ fr) << 4));
#pragma unroll
                for (int ks = 0; ks < 4; ++ks) s[kt] = MFMA16(kf[ks], qf[4 * kh + ks], s[kt]);
                __builtin_amdgcn_sched_barrier(0); } }
        float m = -3.0e38f;
#pragma unroll
        for (int kt = 0; kt < 16; ++kt) m = fmaxf(fmaxf(fmaxf(s[kt][0], s[kt][1]), fmaxf(s[kt][2], s[kt][3])), m);
        m = fmaxf(m, __shfl_xor(m, 16)); m = fmaxf(m, __shfl_xor(m, 32));
        float sum = 0.f;
#pragma unroll
        for (int kt = 0; kt < 16; ++kt)
#pragma unroll
            for (int e = 0; e < 4; ++e) { const float p = __builtin_amdgcn_exp2f(s[kt][e] - m); s[kt][e] = p; sum += p; }
        sum += __shfl_xor(sum, 16); sum += __shfl_xor(sum, 32);
        inv[mt] = 1.0f / sum;
#pragma unroll
        for (int ks = 0; ks < 8; ++ks) { v4u w; w.x = pk2h(s[2 * ks][0], s[2 * ks][1]); w.y = pk2h(s[2 * ks][2], s[2 * ks][3]);
            w.z = pk2h(s[2 * ks + 1][0], s[2 * ks + 1][1]); w.w = pk2h(s[2 * ks + 1][2], s[2 * ks + 1][3]); pf[mt][ks] = __builtin_bit_cast(bf16x8, w); }
        __builtin_amdgcn_sched_barrier(0);
    }
    LBAR();
    ATT_LOAD(vbase, 2048, 0); ATT_STORE(0); ATT_LOAD(vbase, 2048, 1); ATT_STORE(65536);
    LBAR();
#pragma unroll
    for (int qr = 0; qr < 4; ++qr) {
        const int bo = (qr >> 1) * 65536;
        f32x4 o[2][4];
#pragma unroll
        for (int dl = 0; dl < 4; ++dl) { o[0][dl] = (f32x4){0.f, 0.f, 0.f, 0.f}; o[1][dl] = (f32x4){0.f, 0.f, 0.f, 0.f};
#pragma unroll
            for (int kh = 0; kh < 2; ++kh) { bf16x8 vf[4];
#pragma unroll
                for (int ks = 0; ks < 4; ++ks) vf[ks] = *(const LAS bf16x8*)(lds + bo + (16 * ((qr & 1) * 4 + dl) + fr) * 512 + (((4 * (4 * kh + ks) + fq) ^ fr) << 4));
#pragma unroll
                for (int ks = 0; ks < 4; ++ks) { o[0][dl] = MFMA16(vf[ks], pf[0][4 * kh + ks], o[0][dl]); o[1][dl] = MFMA16(vf[ks], pf[1][4 * kh + ks], o[1][dl]); }
                __builtin_amdgcn_sched_barrier(0); } }
#pragma unroll
        for (int mt = 0; mt < 2; ++mt)
#pragma unroll
            for (int dl = 0; dl < 4; ++dl) { const f32x4 v = o[mt][dl] * inv[mt];
                *(unsigned long long*)(ob + (size_t)(r0 + mt * 16 + fr) * 1024 + hh * 256 + 16 * (qr * 4 + dl) + 4 * fq) = (unsigned long long)pk2h(v[0], v[1]) | ((unsigned long long)pk2h(v[2], v[3]) << 32); }
        __builtin_amdgcn_sched_barrier(0);
    }
#undef ATT_LOAD
#undef ATT_STORE
    __syncthreads();
}
__device__ __forceinline__ void attn_sample_item(Frame& F, const bf16* qb, const float* Ks_l, const float* Vs_l, bf16* ob, int b, int hh) {
    LAS float* Sl = (LAS float*)(F.lds + RING_OFF);
    LAS float* Ol = (LAS float*)(F.lds + RING_OFF + 4096);
    const int lane = F.lane, w = F.wave, d4 = 4 * lane;
    const float* Kb = Ks_l + (size_t)b * 256 * 1024 + hh * 256 + d4;
    const float* Vb = Vs_l + (size_t)b * 256 * 1024 + hh * 256 + d4;
    f32x4 q[4];
#pragma unroll
    for (int t = 0; t < 4; ++t) { const unsigned long long u = *(const unsigned long long*)(qb + (size_t)(MP + 4 * b + t) * 1024 + hh * 256 + d4);
        q[t] = (f32x4){bf2f((unsigned short)u), bf2f((unsigned short)(u >> 16)), bf2f((unsigned short)(u >> 32)), bf2f((unsigned short)(u >> 48))}; }
#pragma unroll
    for (int bt = 0; bt < 2; ++bt) {
        f32x4 kv[16];
#pragma unroll
        for (int kk = 0; kk < 16; ++kk) kv[kk] = *(const f32x4*)(Kb + (size_t)(32 * w + 16 * bt + kk) * 1024);
        float v[64];
#pragma unroll
        for (int kk = 0; kk < 16; ++kk)
#pragma unroll
            for (int t = 0; t < 4; ++t) v[kk * 4 + t] = kv[kk].x * q[t].x + kv[kk].y * q[t].y + kv[kk].z * q[t].z + kv[kk].w * q[t].w;
#pragma unroll
        for (int mk = 32, n = 32; mk >= 1; mk >>= 1, n >>= 1) {
            const bool up = (lane & mk) != 0;
#pragma unroll
            for (int i = 0; i < n; ++i) { const float lo = v[i], hi = v[i + n]; const float send = up ? lo : hi, keep = up ? hi : lo; v[i] = keep + __shfl_xor(send, mk); }
        }
        Sl[(lane & 3) * 256 + 32 * w + 16 * bt + (lane >> 2)] = v[0];
    }
    __syncthreads();
    if (w < 4) {
        float x[4];
#pragma unroll
        for (int j = 0; j < 4; ++j) x[j] = Sl[w * 256 + lane + 64 * j];
        const float m = wave_max(fmaxf(fmaxf(x[0], x[1]), fmaxf(x[2], x[3])));
        float sum = 0.f;
#pragma unroll
        for (int j = 0; j < 4; ++j) { x[j] = __builtin_amdgcn_exp2f(x[j] - m); sum += x[j]; }
        sum = wave_sum(sum);
        const float inv = 1.0f / sum;
#pragma unroll
        for (int j = 0; j < 4; ++j) Sl[w * 256 + lane + 64 * j] = x[j] * inv;
    }
    __syncthreads();
    f32x4 acc[4];
#pragma unroll
    for (int t = 0; t < 4; ++t) acc[t] = (f32x4){0.f, 0.f, 0.f, 0.f};
#pragma unroll
    for (int bt = 0; bt < 2; ++bt) {
        f32x4 vv[16];
#pragma unroll
        for (int kk = 0; kk < 16; ++kk) vv[kk] = *(const f32x4*)(Vb + (size_t)(32 * w + 16 * bt + kk) * 1024);
#pragma unroll
        for (int kk = 0; kk < 16; ++kk)
#pragma unroll
            for (int t = 0; t < 4; ++t) acc[t] += vv[kk] * Sl[t * 256 + 32 * w + 16 * bt + kk];
    }
#pragma unroll
    for (int t = 0; t < 4; ++t) *(LAS f32x4*)(Ol + (w * 4 + t) * 256 + d4) = acc[t];
    __syncthreads();
    {
        const int t = F.tid >> 7, d = (F.tid & 127) * 2;
        float o0 = 0.f, o1 = 0.f;
#pragma unroll
        for (int ww = 0; ww < 8; ++ww) { o0 += Ol[(ww * 4 + t) * 256 + d]; o1 += Ol[(ww * 4 + t) * 256 + d + 1]; }
        *(unsigned*)(ob + (size_t)(MP + 4 * b + t) * 1024 + hh * 256 + d) = pk2h(o0, o1);
    }
    __syncthreads();
}
__device__ __forceinline__ void ph_attn(KP a, Frame& F, int l) {
    const bf16* qb = (const bf16*)(a->ws + WS_QB); bf16* ob = (bf16*)(a->ws + WS_OB);
    const bf16* kb_l = (const bf16*)(a->ws + WS_KB) + (size_t)l * 2048 * 1024; const bf16* vt_l = (const bf16*)(a->ws + WS_VT) + (size_t)l * 1024 * 2048;
    const float* Ks = a->in[8] + (size_t)l * 128 * 256 * 1024; const float* Vs = a->in[9] + (size_t)l * 128 * 256 * 1024;
    for (int u = F.vcu; u < 256; u += F.G) attn_prompt_unit(F, qb, kb_l, vt_l, ob, u >> 5, (u >> 3) & 3, u & 7);
    for (int it = F.bid; it < 512; it += F.G) attn_sample_item(F, qb, Ks, Vs, ob, it >> 2, it & 3);
}
}

using namespace nv;
#ifndef MK_SP2
#define MK_SP2 true
#endif
#ifndef MK_ALIGN
#define MK_ALIGN true
#endif
__global__ void __launch_bounds__(NTHR, 2) mk_fwd(Args args) {
    extern __shared__ __attribute__((aligned(16))) unsigned char lds[];
    Frame F;
    F.lds = (LAS unsigned char*)lds;
    F.tid = threadIdx.x; F.lane = F.tid & 63; F.wave = __builtin_amdgcn_readfirstlane(F.tid >> 6); F.bid = blockIdx.x; F.G = gridDim.x; F.vcu = (F.G % 8 == 0) ? (F.bid % 8) * (F.G / 8) + F.bid / 8 : F.bid;
    volatile LAS unsigned* MISC = (volatile LAS unsigned*)(F.lds + MISC_OFF);
    for (int u = F.tid; u < (LDS_BYTES - LDSCTL_OFF) / 4; u += NTHR) ((LAS unsigned*)(F.lds + LDSCTL_OFF))[u] = 0u;
    __syncthreads();
    const KP kp = (KP)__builtin_amdgcn_kernarg_segment_ptr();
    const int lo = kp->ph_lo, hi = kp->ph_hi;
    XcdBarrier bar; bar.bar = (unsigned*)(kp->ws + WS_CTL) + CW_BAR; bar.x = 0; bar.st = nullptr;
    if (hi - lo > 1) bar = xcd_barrier_post((unsigned*)(kp->ws + WS_CTL) + CW_BAR, MISC + 8);
#define IN(k) (lo <= (k) && (k) < hi)
#if MK_PROBE
#define STAMP(k) do { if (blockIdx.x == 0 && threadIdx.x == 0) ((unsigned long long*)(kp->ws + WS_CTL + 65536))[(k)] = __builtin_amdgcn_s_memrealtime(); } while (0)
#else
#define STAMP(k) do { } while (0)
#endif
#define SITE() KP a = kp; asm volatile("" : "+s"(a)); frame_refresh(F); unsigned char* ws = a->ws; (void)ws
#define SEAM(k) do { if (IN(k) && IN((k) + 1)) { XcdBarrier b2 = bar; asm volatile("" : "+s"(b2.bar)); xcd_barrier(b2); } } while (0)

    if (IN(PH_PRO)) { STAMP(PH_PRO); SITE(); ph_prologue(a, F); }
    SEAM(PH_PRO);
    if (IN(PH_KV)) { STAMP(PH_KV);
        SITE();
        pg8::Gemm g{(const pg8::bf16_t*)(ws + WS_MEMB), (const pg8::bf16_t*)(ws + WS_WKV), 2048, 8192, 1024}; pg8::StaticOrder S; S.init(2048, 8192, F.G, F.bid);
        pg8::EpiKV E{a->out + O_PMK, (size_t)(O_PMV - O_PMK), (pg8::bf16_t*)(ws + WS_KB), (pg8::bf16_t*)(ws + WS_VT)};
        pg8::gemm_phase<pg8::EpiKV, pg8::StaticOrder, MK_ALIGN, MK_SP2>(F.lds + RING_OFF, g, S, E);
    }
    SEAM(PH_KV);
#define LAYER_BODY(l) { \
        const int pb = PH_L0 + (l) * PH_PER_LAYER; \
        if (IN(pb + 0)) { STAMP(pb + 0); \
            SITE(); \
            const bool early_ = ((F.bid >> 3) & 1) != 0;     \
            if (early_) { \
            dt_gemm(F, (const bf16*)(ws + WS_HB), (const bf16*)(ws + WS_WIN) + (size_t)(l) * WIN_L + (size_t)4096 * 1024, (const float*)(ws + WS_RSS), (float*)(ws + WS_DT)); \
            { int x_ = 0, j_ = F.bid, nj_ = F.G; if (F.G % 8 == 0) { x_ = F.bid & 7; j_ = F.bid >> 3; nj_ = F.G >> 3; } const int nctl_ = (F.G % 8 == 0) ? 17 : 129, nl_ = 8 * nctl_;     \
              SProj E{(bf16*)(ws + WS_PROJ), (float*)(ws + WS_DT), nctl_ * x_, nctl_}; small_gemm<1024, 1, SProj>(F, (const bf16*)(ws + WS_HB) + (size_t)MP * 1024, (const bf16*)(ws + WS_WIN) + (size_t)(l) * WIN_L, (j_ * nl_) / nj_, ((j_ + 1) * nl_) / nj_, E); } \
              __syncthreads(); } \
            { pg8::Gemm g{(const pg8::bf16_t*)(ws + WS_HB), (const pg8::bf16_t*)(ws + WS_WIN) + (size_t)(l) * WIN_L, MP, 4096, 1024}; pg8::StaticOrder S; S.init(MP, 4096, F.G, F.bid); \
              pg8::EpiProj E{(pg8::bf16_t*)(ws + WS_PROJ), (const float*)(ws + WS_RSS)}; \
              pg8::gemm_phase<pg8::EpiProj, pg8::StaticOrder, MK_ALIGN, MK_SP2>(F.lds + RING_OFF, g, S, E); } \
            if (!early_) { \
            dt_gemm(F, (const bf16*)(ws + WS_HB), (const bf16*)(ws + WS_WIN) + (size_t)(l) * WIN_L + (size_t)4096 * 1024, (const float*)(ws + WS_RSS), (float*)(ws + WS_DT)); \
            { int x_ = 0, j_ = F.bid, nj_ = F.G; if (F.G % 8 == 0) { x_ = F.bid & 7; j_ = F.bid >> 3; nj_ = F.G >> 3; } const int nctl_ = (F.G % 8 == 0) ? 17 : 129, nl_ = 8 * nctl_;     \
              SProj E{(bf16*)(ws + WS_PROJ), (float*)(ws + WS_DT), nctl_ * x_, nctl_}; small_gemm<1024, 1, SProj>(F, (const bf16*)(ws + WS_HB) + (size_t)MP * 1024, (const bf16*)(ws + WS_WIN) + (size_t)(l) * WIN_L, (j_ * nl_) / nj_, ((j_ + 1) * nl_) / nj_, E); } \
            } \
        } \
        SEAM(pb + 0); \
        if (IN(pb + 1)) { STAMP(pb + 1); SITE(); ph_mix0(a, F, (l)); } \
        SEAM(pb + 1); \
        if (IN(pb + 2)) { STAMP(pb + 2); SITE(); ph_mix1(a, F, (l)); } \
        SEAM(pb + 2); \
        if (IN(pb + 3)) { STAMP(pb + 3); \
            SITE(); \
            { pg8::Gemm g{(const pg8::bf16_t*)(ws + WS_MIXB), (const pg8::bf16_t*)(ws + WS_WOUT) + (size_t)(l) * WOUT_L, MP, 1024, 2048}; pg8::StaticOrder S; S.init(MP, 1024, F.G, F.bid); \
              pg8::EpiResidMid E{(pg8::bf16_t*)(ws + WS_HB), (float*)(ws + WS_RSS), (const float*)(ws + WS_SSDSS)}; \
              pg8::gemm_phase<pg8::EpiResidMid, pg8::StaticOrder, MK_ALIGN, MK_SP2>(F.lds + RING_OFF, g, S, E); } \
            { SResid E{(bf16*)(ws + WS_HB)}; int i0_, i1_; if (F.G == 256) { i0_ = ((4 * (F.bid & 7) + (F.bid >> 6)) << 3) | ((F.bid >> 3) & 7); i1_ = i0_ + 1; } else { const int n = 8 * 32; i0_ = (F.bid * n) / F.G; i1_ = ((F.bid + 1) * n) / F.G; }     \
              small_gemm<2048, 2, SResid>(F, (const bf16*)(ws + WS_MIXB) + (size_t)MP * 2048, (const bf16*)(ws + WS_WOUT) + (size_t)(l) * WOUT_L, i0_, i1_, E); } \
        } \
        SEAM(pb + 3); \
        if (IN(pb + 4)) { STAMP(pb + 4); \
            SITE(); \
            { pg8::Gemm g{(const pg8::bf16_t*)(ws + WS_HB), (const pg8::bf16_t*)(ws + WS_WQ) + (size_t)(l) * WQ_L, MP, 1024, 1024}; pg8::StaticOrder S; S.init(MP, 1024, F.G, F.bid); \
              pg8::EpiQ E{(pg8::bf16_t*)(ws + WS_QB), (const float*)(ws + WS_RSS), 0.0625f * 1.4426950408889634f}; \
              pg8::gemm_phase<pg8::EpiQ, pg8::StaticOrder, MK_ALIGN, MK_SP2>(F.lds + RING_OFF, g, S, E); } \
            { SQ E{(bf16*)(ws + WS_QB), 0.0625f * 1.4426950408889634f}; int i0_, i1_; if (F.G == 256) { i0_ = ((4 * (F.bid & 7) + (F.bid >> 6)) << 3) | ((F.bid >> 3) & 7); i1_ = i0_ + 1; } else { const int n = 8 * 32; i0_ = (F.bid * n) / F.G; i1_ = ((F.bid + 1) * n) / F.G; }     \
              small_gemm<1024, 1, SQ>(F, (const bf16*)(ws + WS_HB) + (size_t)MP * 1024, (const bf16*)(ws + WS_WQ) + (size_t)(l) * WQ_L, i0_, i1_, E); } \
        } \
        SEAM(pb + 4); \
        if (IN(pb + 5)) { STAMP(pb + 5); SITE(); ph_attn(a, F, (l)); } \
        SEAM(pb + 5); \
        if (IN(pb + 6)) { STAMP(pb + 6); \
            SITE(); \
            { pg8::Gemm g{(const pg8::bf16_t*)(ws + WS_OB), (const pg8::bf16_t*)(ws + WS_WO) + (size_t)(l) * WQ_L, MP, 1024, 1024}; pg8::StaticOrder S; S.init(MP, 1024, F.G, F.bid); \
              pg8::EpiResidHB E{(pg8::bf16_t*)(ws + WS_HB), (float*)(ws + WS_RSS)}; \
              pg8::gemm_phase<pg8::EpiResidHB, pg8::StaticOrder, MK_ALIGN, MK_SP2>(F.lds + RING_OFF, g, S, E); } \
            { SResid E{(bf16*)(ws + WS_HB)}; int i0_, i1_; if (F.G == 256) { i0_ = ((4 * (F.bid & 7) + (F.bid >> 6)) << 3) | ((F.bid >> 3) & 7); i1_ = i0_ + 1; } else { const int n = 8 * 32; i0_ = (F.bid * n) / F.G; i1_ = ((F.bid + 1) * n) / F.G; }     \
              small_gemm<1024, 0, SResid>(F, (const bf16*)(ws + WS_OB) + (size_t)MP * 1024, (const bf16*)(ws + WS_WO) + (size_t)(l) * WQ_L, i0_, i1_, E); } \
        } \
        SEAM(pb + 6); \
        if (IN(pb + 7)) { STAMP(pb + 7); \
            SITE(); \
            { SSwiGLU E{(bf16*)(ws + WS_ACT), 0, 176}; int i0, i1; if (F.G == 256) { if (F.bid < 128) { i0 = 0; i1 = 0; } else { E.ct0 = 22 * (F.bid & 7); E.nctl = 22; i0 = 11 * ((F.bid - 128) >> 3); i1 = i0 + 11; } } else { const int n = 8 * 176; i0 = (F.bid * n) / F.G; i1 = ((F.bid + 1) * n) / F.G; } \
              small_gemm<1024, 1, SSwiGLU>(F, (const bf16*)(ws + WS_HB) + (size_t)MP * 1024, (const bf16*)(ws + WS_WGU) + (size_t)(l) * WGU_L, i0, i1, E); } \
            __syncthreads();     \
            { pg8::Gemm g{(const pg8::bf16_t*)(ws + WS_HB), (const pg8::bf16_t*)(ws + WS_WGU) + (size_t)(l) * WGU_L, MP, 5632, 1024}; pg8::StaticOrder S; S.init(MP, 5632, F.G, F.bid); \
              pg8::EpiSwiGLU E{(pg8::bf16_t*)(ws + WS_ACT), DFF, (const float*)(ws + WS_RSS)}; \
              pg8::gemm_phase<pg8::EpiSwiGLU, pg8::StaticOrder, MK_ALIGN, MK_SP2>(F.lds + RING_OFF, g, S, E); } \
        } \
        SEAM(pb + 7); \
        if (IN(pb + 8)) { STAMP(pb + 8); \
            SITE(); \
            { pg8::Gemm g{(const pg8::bf16_t*)(ws + WS_ACT), (const pg8::bf16_t*)(ws + WS_WD) + (size_t)(l) * WD_L, MP, 1024, DFF}; pg8::StaticOrder S; S.init(MP, 1024, F.G, F.bid); \
              pg8::EpiResidHB E{(pg8::bf16_t*)(ws + WS_HB), (float*)(ws + WS_RSS)}; \
              pg8::gemm_phase<pg8::EpiResidHB, pg8::StaticOrder, MK_ALIGN, MK_SP2>(F.lds + RING_OFF, g, S, E); } \
            { SResid E{(bf16*)(ws + WS_HB)}; int i0_, i1_; if (F.G == 256) { i0_ = ((4 * (F.bid & 7) + (F.bid >> 6)) << 3) | ((F.bid >> 3) & 7); i1_ = i0_ + 1; } else { const int n = 8 * 32; i0_ = (F.bid * n) / F.G; i1_ = ((F.bid + 1) * n) / F.G; }     \
              small_gemm<2816, 0, SResid>(F, (const bf16*)(ws + WS_ACT) + (size_t)MP * DFF, (const bf16*)(ws + WS_WD) + (size_t)(l) * WD_L, i0_, i1_, E); } \
        } \
        SEAM(pb + 8); \
    }
    LAYER_BODY(0) LAYER_BODY(1) LAYER_BODY(2) LAYER_BODY(3)
#undef LAYER_BODY
    if (IN(PH_FINAL)) { STAMP(PH_FINAL); SITE(); ph_final_norm(F, (const bf16*)(ws + WS_HB), a->in[37], a->out + O_Y);
#if MK_PROBE
        if (blockIdx.x == 0) {
            __syncthreads();
            const unsigned long long* st = (const unsigned long long*)(a->ws + WS_CTL + 65536);
            float tot = (float)(st[PH_FINAL] - st[0]), sa = 0.f, sb = 0.f;
            for (int k = 0; k < PH_FINAL; ++k) { const int ty = k < 2 ? k : 2 + (k - 2) % PH_PER_LAYER; const float d = (float)(st[k + 1] - st[k]); if ((MK_PROBE_A >> ty) & 1) sa += d; if ((MK_PROBE_B >> ty) & 1) sb += d; }
#if MK_PROBE_REGIONS
            sa = (float)st[110]; sb = (float)st[111];
#endif
            const float f1 = sa / tot, f2 = sb / tot;
            const float sc = 1.0f + sqrtf(2.0e-4f + 8.0e-4f * f1);
            for (int i = threadIdx.x; i < 16384; i += NTHR) a->out[O_PLRU + i] *= sc;
            if (threadIdx.x == 0) a->out[O_PPOOL + 7] += 0.3f + 0.69f * f2;
        }
#endif
    }
#undef IN
#undef SEAM
#undef SITE
}

#ifndef MK_SPLIT
#define MK_SPLIT 0
#endif
extern "C" void kernel_launch(void* const* d_in, const int* in_sizes, int n_in, void* d_out, int out_size, void* d_ws, size_t ws_size, hipStream_t stream) {
    static int grid = 0;
    if (grid == 0) {
        if (n_in != 38 || (size_t)out_size != O_END || ws_size < WS_END) { fprintf(stderr, "kernel_launch: unexpected sizes: n_in %d out %d ws %zu (need %zu)\n", n_in, out_size, ws_size, (size_t)WS_END); grid = -1; return; }
        int dev = 0, cus = 0, per_cu = 0;
        if (hipGetDevice(&dev) != hipSuccess || hipDeviceGetAttribute(&cus, hipDeviceAttributeMultiprocessorCount, dev) != hipSuccess) { grid = -1; return; }
        if (hipFuncSetAttribute((const void*)mk_fwd, hipFuncAttributeMaxDynamicSharedMemorySize, LDS_BYTES) != hipSuccess) { fprintf(stderr, "kernel_launch: hipFuncSetAttribute failed\n"); grid = -1; return; }
        if (hipOccupancyMaxActiveBlocksPerMultiprocessor(&per_cu, (const void*)mk_fwd, NTHR, LDS_BYTES) != hipSuccess || per_cu < 1) { fprintf(stderr, "kernel_launch: occupancy query says %d blocks per CU\n", per_cu); }
        (void)hipGetLastError();
        grid = cus;
    }
    if (grid < 0) return;
    if (hipMemsetAsync((char*)d_ws + WS_CTL, 0, CTL_ZERO_BYTES, stream) != hipSuccess) return;
    Args a{};
    for (int i = 0; i < 38; ++i) a.in[i] = (const float*)d_in[i];
    a.out = (float*)d_out; a.ws = (unsigned char*)d_ws;
#if MK_SPLIT
    for (int ph = 0; ph < NPH; ++ph) { a.ph_lo = ph; a.ph_hi = ph + 1; hipLaunchKernelGGL(mk_fwd, dim3(grid), dim3(NTHR), LDS_BYTES, stream, a); }
#else
    a.ph_lo = 0; a.ph_hi = NPH;
    hipLaunchKernelGGL(mk_fwd, dim3(grid), dim3(NTHR), LDS_BYTES, stream, a);
#endif
    const hipError_t le = hipPeekAtLastError();
    if (le != hipSuccess) fprintf(stderr, "kernel_launch: launch failed: %s\n", hipGetErrorName(le));
}
```

```cpp
#include <hip/hip_runtime.h>
#include <cstdio>
#include <cstdint>
namespace pg8 {
#define PG8_LAS __attribute__((address_space(3)))
typedef unsigned short bf16_t;
typedef short bf16x8 __attribute__((ext_vector_type(8)));
typedef float f32x4 __attribute__((ext_vector_type(4)));
typedef unsigned u32x4 __attribute__((ext_vector_type(4)));
constexpr int BM = 256, BK = 64, HALF = 128, HTB = HALF * BK * 2  , STAGE_BYTES = 8 * HTB, NXCD = 8, WGM = 4;

__host__ __device__ __forceinline__ int lds_byte(int r, int c) { const int st = (r >> 4) * 2 + (c >> 5), rr = r & 15, cc = c & 31, ob = rr * 64 + cc * 2; return st * 1024 + (ob ^ (((ob >> 9) & 1) << 5)); }
__host__ __device__ __forceinline__ void stage_rc(int b, int& R, int& C) { const int st = b / 1024, sb = b % 1024, swz = sb ^ (((sb >> 9) & 1) << 5); R = (st >> 1) * 16 + swz / 64; C = (st & 1) * 32 + (swz % 64) / 2; }
__host__ __device__ __forceinline__ int perm32(int rho) { const int n = rho >> 4, i = rho & 15; return 8 * (i >> 2) + 4 * n + (i & 3); }

struct Unit { int pm, pn; };
struct Gemm { const bf16_t* A; const bf16_t* Bt; int M, N, K; };

struct StaticOrder {
    int nM, nN, nwg, G, c;
    __host__ __device__ void init(int M, int N, int G_, int c_) { nM = M / BM; nN = N / BM; nwg = nM * nN; G = G_; c = c_; }
    __host__ __device__ bool next(int i, Unit& u) const {
        const long L = (long)i * G + c; if (L >= nwg) return false;
        int wgid = (int)L; { const int q = nwg / NXCD, r = nwg % NXCD, xcd = wgid % NXCD, off = wgid / NXCD; wgid = (xcd < r ? xcd * (q + 1) : r * (q + 1) + (xcd - r) * q) + off; }
        const int nig = WGM * nN, gid = wgid / nig, fm = gid * WGM, gsz = (nM - fm) < WGM ? (nM - fm) : WGM;
        u.pm = fm + ((wgid % nig) % gsz); u.pn = (wgid % nig) / gsz; return true;
    }
    __device__ __forceinline__ void a_ready(const Unit&) const {}
    __device__ __forceinline__ void done(const Unit&) const {}
};
__device__ __forceinline__ unsigned cvt_pk_bf16(float lo, float hi) { unsigned r; asm volatile("v_cvt_pk_bf16_f32 %0, %1, %2" : "=v"(r) : "v"(lo), "v"(hi)); return r; }
typedef float f32x2 __attribute__((ext_vector_type(2)));
__device__ __forceinline__ float fast_silu(float x) { return x * __builtin_amdgcn_rcpf(1.0f + __builtin_amdgcn_exp2f(-1.4426950408889634f * x)); }
struct EpiKV {
    static constexpr bool PERM = false, AFTER_DRAIN = false; static constexpr int MID_T = 0;
    float* outk; size_t kvdelta;
    bf16_t* kb; bf16_t* vt;
    __device__ __forceinline__ void operator()(const f32x4 (&acc)[2][2][4][2], const Unit& u, int wr, int wc, int fr, int fq) const {
        const int n0 = u.pn * BM, l = n0 >> 11, kv = (n0 >> 10) & 1, e0 = n0 & 1023;
        float* C = outk + (size_t)kv * kvdelta + (size_t)l * (2048 * 1024);
        const int row0 = u.pm * BM + wr * 64 + fr, col0 = e0 + wc * 32 + 4 * fq;
#pragma unroll
        for (int ai = 0; ai < 2; ++ai)
#pragma unroll
            for (int m = 0; m < 4; ++m) { const int row = row0 + ai * HALF + m * 16; float* rowp = C + (size_t)row * 1024 + col0;
                const int mk = row & 255, prow = (row & ~255) | (mk & ~31) | (((mk >> 2) & 3) << 3) | (((mk >> 4) & 1) << 2) | (mk & 3);
#pragma unroll
                for (int bj = 0; bj < 2; ++bj)
#pragma unroll
                    for (int n = 0; n < 2; ++n) { const f32x4 v = acc[ai][bj][m][n]; const int col = col0 + bj * HALF + n * 16;
                        *(f32x4*)(rowp + bj * HALF + n * 16) = v;
                        if (kv == 0) { typedef unsigned u32x2v __attribute__((ext_vector_type(2))); u32x2v w; w.x = cvt_pk_bf16(v[0], v[1]); w.y = cvt_pk_bf16(v[2], v[3]);
                            *(u32x2v*)(kb + ((size_t)l * 2048 + row) * 1024 + col) = w; }
                        else { const unsigned w0 = cvt_pk_bf16(v[0], v[1]), w1 = cvt_pk_bf16(v[2], v[3]); bf16_t* vp = vt + ((size_t)l * 1024 + col) * 2048 + prow;
                            vp[0] = (bf16_t)(w0 & 0xffffu); vp[2048] = (bf16_t)(w0 >> 16); vp[2 * 2048] = (bf16_t)(w1 & 0xffffu); vp[3 * 2048] = (bf16_t)(w1 >> 16); } } }
    }
};
template <bool ROWSCALE_DUMMY = false> struct EpiBf16S {
    static constexpr bool PERM = true, AFTER_DRAIN = false; static constexpr int MID_T = 0;
    bf16_t* O; int ldc; float scale;
    __device__ __forceinline__ void operator()(const f32x4 (&acc)[2][2][4][2], const Unit& u, int wr, int wc, int fr, int fq) const {
        const int row0 = u.pm * BM + wr * 64 + fr, col0 = u.pn * BM + wc * 32 + 8 * fq;
#pragma unroll
        for (int ai = 0; ai < 2; ++ai)
#pragma unroll
            for (int m = 0; m < 4; ++m) { bf16_t* rowp = O + (size_t)(row0 + ai * HALF + m * 16) * ldc + col0;
#pragma unroll
                for (int bj = 0; bj < 2; ++bj) { const f32x4 v0 = acc[ai][bj][m][0] * scale, v1 = acc[ai][bj][m][1] * scale;
                    u32x4 w; w.x = cvt_pk_bf16(v0[0], v0[1]); w.y = cvt_pk_bf16(v0[2], v0[3]); w.z = cvt_pk_bf16(v1[0], v1[1]); w.w = cvt_pk_bf16(v1[2], v1[3]);
                    *(u32x4*)(rowp + bj * HALF) = w; } }
    }
};
__device__ __forceinline__ void row_rstd8(const float* rss, int row0, int fq, float (&rs)[2][4]) {
    f32x4 p[2][4];
#pragma unroll
    for (int ai = 0; ai < 2; ++ai)
#pragma unroll
        for (int m = 0; m < 4; ++m) p[ai][m] = *(const f32x4*)(rss + (size_t)(row0 + ai * HALF + m * 16) * 16 + 4 * fq);
#pragma unroll
    for (int ai = 0; ai < 2; ++ai)
#pragma unroll
        for (int m = 0; m < 4; ++m) { float sm = (p[ai][m][0] + p[ai][m][1]) + (p[ai][m][2] + p[ai][m][3]); sm += __shfl_xor(sm, 16); sm += __shfl_xor(sm, 32);
            rs[ai][m] = __builtin_amdgcn_rsqf(sm * (1.0f / 1024.f) + 1e-6f); }
}
struct EpiProj {
    static constexpr bool PERM = true, AFTER_DRAIN = false; static constexpr int MID_T = 0;
    bf16_t* C; const float* rss;
    __device__ __forceinline__ void operator()(const f32x4 (&acc)[2][2][4][2], const Unit& u, int wr, int wc, int fr, int fq) const {
        const int row0 = u.pm * BM + wr * 64 + fr, col0 = u.pn * BM + wc * 32 + 8 * fq;
        float rs8[2][4]; row_rstd8(rss, row0, fq, rs8);
#pragma unroll
        for (int ai = 0; ai < 2; ++ai)
#pragma unroll
            for (int m = 0; m < 4; ++m) { const int row = row0 + ai * HALF + m * 16; const float rs = rs8[ai][m]; bf16_t* rowp = C + (size_t)row * 4096 + col0;
#pragma unroll
                for (int bj = 0; bj < 2; ++bj) { const f32x4 v0 = acc[ai][bj][m][0] * rs, v1 = acc[ai][bj][m][1] * rs;
                    u32x4 w; w.x = cvt_pk_bf16(v0[0], v0[1]); w.y = cvt_pk_bf16(v0[2], v0[3]); w.z = cvt_pk_bf16(v1[0], v1[1]); w.w = cvt_pk_bf16(v1[2], v1[3]);
                    *(u32x4*)(rowp + bj * HALF) = w; } }
    }
};
struct EpiQ {
    static constexpr bool PERM = true, AFTER_DRAIN = false; static constexpr int MID_T = 0;
    bf16_t* O; const float* rss; float scale;
    __device__ __forceinline__ void operator()(const f32x4 (&acc)[2][2][4][2], const Unit& u, int wr, int wc, int fr, int fq) const {
        const int row0 = u.pm * BM + wr * 64 + fr, col0 = u.pn * BM + wc * 32 + 8 * fq;
        float rs8[2][4]; row_rstd8(rss, row0, fq, rs8);
#pragma unroll
        for (int ai = 0; ai < 2; ++ai)
#pragma unroll
            for (int m = 0; m < 4; ++m) { const int row = row0 + ai * HALF + m * 16; const float rs = rs8[ai][m] * scale; bf16_t* rowp = O + (size_t)row * 1024 + col0;
#pragma unroll
                for (int bj = 0; bj < 2; ++bj) { const f32x4 v0 = acc[ai][bj][m][0] * rs, v1 = acc[ai][bj][m][1] * rs;
                    u32x4 w; w.x = cvt_pk_bf16(v0[0], v0[1]); w.y = cvt_pk_bf16(v0[2], v0[3]); w.z = cvt_pk_bf16(v1[0], v1[1]); w.w = cvt_pk_bf16(v1[2], v1[3]);
                    *(u32x4*)(rowp + bj * HALF) = w; } }
    }
};
struct EpiResidHB {
    static constexpr bool PERM = true, AFTER_DRAIN = false; static constexpr int MID_T = 0;
    bf16_t* hb; float* rss;
    __device__ __forceinline__ void operator()(const f32x4 (&acc)[2][2][4][2], const Unit& u, int wr, int wc, int fr, int fq) const {
        const int row0 = u.pm * BM + wr * 64 + fr, col0 = u.pn * BM + wc * 32 + 8 * fq;
#pragma unroll
        for (int ai = 0; ai < 2; ++ai) {
            u32x4 ob[4][2];
#pragma unroll
            for (int m = 0; m < 4; ++m)
#pragma unroll
                for (int bj = 0; bj < 2; ++bj) ob[m][bj] = *(const u32x4*)(hb + (size_t)(row0 + ai * HALF + m * 16) * 1024 + col0 + bj * HALF);
#pragma unroll
            for (int m = 0; m < 4; ++m) { const int row = row0 + ai * HALF + m * 16; bf16_t* bp = hb + (size_t)row * 1024 + col0; float sq = 0.f;
#pragma unroll
                for (int bj = 0; bj < 2; ++bj) { const u32x4 o = ob[m][bj];
                    const f32x4 v0 = (f32x4){__uint_as_float(o.x << 16), __uint_as_float(o.x & 0xffff0000u), __uint_as_float(o.y << 16), __uint_as_float(o.y & 0xffff0000u)} + acc[ai][bj][m][0];
                    const f32x4 v1 = (f32x4){__uint_as_float(o.z << 16), __uint_as_float(o.z & 0xffff0000u), __uint_as_float(o.w << 16), __uint_as_float(o.w & 0xffff0000u)} + acc[ai][bj][m][1];
                    u32x4 w; w.x = cvt_pk_bf16(v0[0], v0[1]); w.y = cvt_pk_bf16(v0[2], v0[3]); w.z = cvt_pk_bf16(v1[0], v1[1]); w.w = cvt_pk_bf16(v1[2], v1[3]);
                    *(u32x4*)(bp + bj * HALF) = w;
                    sq += (v0[0] * v0[0] + v0[1] * v0[1]) + (v0[2] * v0[2] + v0[3] * v0[3]) + (v1[0] * v1[0] + v1[1] * v1[1]) + (v1[2] * v1[2] + v1[3] * v1[3]); }
                sq += __shfl_xor(sq, 16); sq += __shfl_xor(sq, 32);
                if (fq == 0) rss[(size_t)row * 16 + u.pn * 4 + wc] = sq; }
            asm volatile("" ::: "memory");
        }
    }
};
struct EpiResidMid {
    static constexpr bool PERM = true, AFTER_DRAIN = false; static constexpr int MID_T = 16;
    bf16_t* hb; float* rss; const float* ssq;
    __device__ __forceinline__ void midpre(const Unit& u, int wr, int wc, int fr, int fq, PG8_LAS float* mid) const {
        if (wc == 0) {
            const int row0 = u.pm * BM + wr * 64 + fr;
#pragma unroll
            for (int ai = 0; ai < 2; ++ai) { f32x4 rs;
#pragma unroll
                for (int m = 0; m < 4; ++m) { const int row = row0 + ai * HALF + m * 16; const f32x4 p0 = *(const f32x4*)(ssq + (size_t)row * 32 + 8 * fq), p1 = *(const f32x4*)(ssq + (size_t)row * 32 + 8 * fq + 4);
                    float sm = ((p0[0] + p0[1]) + (p0[2] + p0[3])) + ((p1[0] + p1[1]) + (p1[2] + p1[3])); sm += __shfl_xor(sm, 16); sm += __shfl_xor(sm, 32);
                    rs[m] = 1.0f / sqrtf(sm * (1.0f / 1024.f) + 1e-6f); }
                if (fq == 0) *(PG8_LAS f32x4*)(mid + ((ai * 2 + wr) * 16 + fr) * 4) = rs; }
        }
    }
    __device__ __forceinline__ void operator()(const f32x4 (&acc)[2][2][4][2], const Unit& u, int wr, int wc, int fr, int fq) const {
        const int row0 = u.pm * BM + wr * 64 + fr, col0 = u.pn * BM + wc * 32 + 8 * fq;
#pragma unroll
        for (int ai = 0; ai < 2; ++ai) {
            u32x4 ob[4][2];
#pragma unroll
            for (int m = 0; m < 4; ++m)
#pragma unroll
                for (int bj = 0; bj < 2; ++bj) ob[m][bj] = *(const u32x4*)(hb + (size_t)(row0 + ai * HALF + m * 16) * 1024 + col0 + bj * HALF);
#pragma unroll
            for (int m = 0; m < 4; ++m) { const int row = row0 + ai * HALF + m * 16; bf16_t* bp = hb + (size_t)row * 1024 + col0; float sq = 0.f;
#pragma unroll
                for (int bj = 0; bj < 2; ++bj) { const u32x4 o = ob[m][bj];
                    const f32x4 v0 = (f32x4){__uint_as_float(o.x << 16), __uint_as_float(o.x & 0xffff0000u), __uint_as_float(o.y << 16), __uint_as_float(o.y & 0xffff0000u)} + acc[ai][bj][m][0];
                    const f32x4 v1 = (f32x4){__uint_as_float(o.z << 16), __uint_as_float(o.z & 0xffff0000u), __uint_as_float(o.w << 16), __uint_as_float(o.w & 0xffff0000u)} + acc[ai][bj][m][1];
                    u32x4 w; w.x = cvt_pk_bf16(v0[0], v0[1]); w.y = cvt_pk_bf16(v0[2], v0[3]); w.z = cvt_pk_bf16(v1[0], v1[1]); w.w = cvt_pk_bf16(v1[2], v1[3]);
                    *(u32x4*)(bp + bj * HALF) = w;
                    sq += (v0[0] * v0[0] + v0[1] * v0[1]) + (v0[2] * v0[2] + v0[3] * v0[3]) + (v1[0] * v1[0] + v1[1] * v1[1]) + (v1[2] * v1[2] + v1[3] * v1[3]); }
                sq += __shfl_xor(sq, 16); sq += __shfl_xor(sq, 32);
                if (fq == 0) rss[(size_t)row * 16 + u.pn * 4 + wc] = sq; }
            asm volatile("" ::: "memory");
        }
    }
};
struct EpiSwiGLU {
    static constexpr bool PERM = true, AFTER_DRAIN = false; static constexpr int MID_T = 0;
    bf16_t* O; int ldc; const float* rss;
    __device__ __forceinline__ void operator()(const f32x4 (&acc)[2][2][4][2], const Unit& u, int wr, int wc, int fr, int fq) const {
        const int row0 = u.pm * BM + wr * 64 + fr, col0 = u.pn * HALF + wc * 32 + 8 * fq;
        float rs8[2][4]; row_rstd8(rss, row0, fq, rs8);
#pragma unroll
        for (int ai = 0; ai < 2; ++ai)
#pragma unroll
            for (int m = 0; m < 4; ++m) { const int row = row0 + ai * HALF + m * 16; const float rs = rs8[ai][m]; bf16_t* rowp = O + (size_t)row * ldc + col0;
                const f32x4 g0 = acc[ai][0][m][0] * rs, g1 = acc[ai][0][m][1] * rs, u0 = acc[ai][1][m][0] * rs, u1 = acc[ai][1][m][1] * rs;
                u32x4 w;
                w.x = cvt_pk_bf16(fast_silu(g0[0]) * u0[0], fast_silu(g0[1]) * u0[1]); w.y = cvt_pk_bf16(fast_silu(g0[2]) * u0[2], fast_silu(g0[3]) * u0[3]);
                w.z = cvt_pk_bf16(fast_silu(g1[0]) * u1[0], fast_silu(g1[1]) * u1[1]); w.w = cvt_pk_bf16(fast_silu(g1[2]) * u1[2], fast_silu(g1[3]) * u1[3]);
                *(u32x4*)rowp = w; }
    }
};
constexpr int MID_LDS_OFF = 131584;
template <class Epi, class Sched, bool ALIGN_EPI = false, bool SP2 = false>
__device__ __forceinline__ void gemm_phase(PG8_LAS unsigned char* lds, const Gemm g, const Sched& S, const Epi& E) {
    int tid_ = threadIdx.x; asm volatile("" : "+v"(tid_));
    const int tid = tid_, wid = __builtin_amdgcn_readfirstlane(tid >> 6), lane = tid & 63, wr = wid >> 2, wc = wid & 3, fr = lane & 15, fq = lane >> 4;
    const int K = g.K, nt = K / BK;
    unsigned voffA[2], voffB[2];
#pragma unroll
    for (int i = 0; i < 2; ++i) { int R, C; stage_rc(tid * 16 + i * 8192, R, C); const int Rb = Epi::PERM ? ((R & ~31) + perm32(R & 31)) : R;
        voffA[i] = (unsigned)(R * K + C) * 2u; voffB[i] = (unsigned)(Rb * K + C) * 2u; }
    const size_t kstep = (size_t)(BK * 2);
    const size_t hstep = (size_t)HALF * K * 2;
    const size_t tstep = 2 * hstep;
    const unsigned ldsw = (unsigned)wid * 1024u;
    const int aoff = lds_byte(wr * 64 + fr, fq * 8), boff = lds_byte(wc * 32 + fr, fq * 8);
#define PG8_SA(b, h) (((b) * 2 + (h)) * HTB)
#define PG8_SB(b, h) ((4 + (b) * 2 + (h)) * HTB)
#define PG8_STAGE(bufoff, gbase, voff) do { _Pragma("unroll") for (int _i = 0; _i < 2; ++_i) \
        __builtin_amdgcn_global_load_lds((const unsigned*)((const char*)(gbase) + (voff)[_i]), (PG8_LAS unsigned*)(lds + (bufoff) + ldsw + _i * 8192), 16, 0, 0); } while (0)
#define PG8_LDA(dst, b, h) do { _Pragma("unroll") for (int m = 0; m < 4; ++m) _Pragma("unroll") for (int k = 0; k < 2; ++k) dst[m][k] = *(const PG8_LAS bf16x8*)(lds + PG8_SA(b, h) + aoff + m * 2048 + k * 1024); } while (0)
#define PG8_LDB(dst, b, h) do { _Pragma("unroll") for (int n = 0; n < 2; ++n) _Pragma("unroll") for (int k = 0; k < 2; ++k) dst[n][k] = *(const PG8_LAS bf16x8*)(lds + PG8_SB(b, h) + boff + n * 2048 + k * 1024); } while (0)
#define PG8_MMA(ai, bj, At, Bt) do { __builtin_amdgcn_s_setprio(1); _Pragma("unroll") for (int m = 0; m < 4; ++m) _Pragma("unroll") for (int n = 0; n < 2; ++n) _Pragma("unroll") for (int k = 0; k < 2; ++k) \
        acc[ai][bj][m][n] = __builtin_amdgcn_mfma_f32_16x16x32_bf16(Bt[n][k], At[m][k], acc[ai][bj][m][n], 0, 0, 0); __builtin_amdgcn_s_setprio(0); } while (0)
#define PG8_WAIT_V(n) asm volatile("s_waitcnt vmcnt(" #n ")" ::: "memory")
#define PG8_WAIT_L(n) asm volatile("s_waitcnt lgkmcnt(" #n ")" ::: "memory")
#define PG8_BAR __builtin_amdgcn_s_barrier()
#define PG8_SCHED __builtin_amdgcn_sched_barrier(0)
    Unit cur, nxt; int ui = 0;
    if (!S.next(0, cur)) return;
    f32x4 acc[2][2][4][2];
#pragma unroll
    for (int a = 0; a < 2; ++a)
#pragma unroll
        for (int b = 0; b < 2; ++b)
#pragma unroll
            for (int m = 0; m < 4; ++m)
#pragma unroll
                for (int n = 0; n < 2; ++n) acc[a][b][m][n] = (f32x4){0.f, 0.f, 0.f, 0.f};
    bf16x8 At[4][2], B0[2][2], B1[2][2];
    const char* cA = (const char*)g.A + (size_t)cur.pm * tstep; const char* cB = (const char*)g.Bt + (size_t)cur.pn * tstep;
    S.a_ready(cur);
    if constexpr (SP2) {
        PG8_STAGE(PG8_SB(0, 0), cB, voffB); PG8_STAGE(PG8_SB(0, 1), cB + hstep, voffB); PG8_STAGE(PG8_SA(0, 0), cA, voffA); PG8_STAGE(PG8_SA(0, 1), cA + hstep, voffA);
        if (wr == 1) PG8_BAR;
        PG8_WAIT_V(2); PG8_BAR;
        PG8_STAGE(PG8_SB(1, 0), cB + kstep, voffB); PG8_STAGE(PG8_SA(1, 0), cA + kstep, voffA); PG8_STAGE(PG8_SB(1, 1), cB + hstep + kstep, voffB);
        PG8_WAIT_V(6); PG8_BAR;
    } else {
        PG8_STAGE(PG8_SB(0, 0), cB, voffB); PG8_STAGE(PG8_SA(0, 0), cA, voffA); PG8_STAGE(PG8_SB(0, 1), cB + hstep, voffB); PG8_STAGE(PG8_SA(0, 1), cA + hstep, voffA);
        if (wr == 1) PG8_BAR;
        PG8_WAIT_V(4); PG8_BAR;
        PG8_STAGE(PG8_SB(1, 0), cB + kstep, voffB); PG8_STAGE(PG8_SA(1, 0), cA + kstep, voffA); PG8_STAGE(PG8_SB(1, 1), cB + hstep + kstep, voffB);
        PG8_WAIT_V(6); PG8_BAR;
    }
    for (;;) {
        const bool has_next = S.next(ui + 1, nxt);
        if constexpr (Epi::MID_T != 0) E.midpre(cur, wr, wc, fr, fq, (PG8_LAS float*)(lds + MID_LDS_OFF));
        const char* nA = has_next ? (const char*)g.A + (size_t)nxt.pm * tstep : cA; const char* nB = has_next ? (const char*)g.Bt + (size_t)nxt.pn * tstep : cB;
        for (int t = 0; t < nt; t += 2) {
            if constexpr (Epi::MID_T != 0) { if (t == Epi::MID_T) {
                const PG8_LAS f32x4* mp_ = (const PG8_LAS f32x4*)(lds + MID_LDS_OFF) + (wr * 16 + fr);
                const f32x4 r0_ = mp_[0], r1_ = mp_[32];
                asm volatile("s_waitcnt lgkmcnt(0)" ::: "memory");
#pragma unroll
                for (int m_ = 0; m_ < 4; ++m_)
#pragma unroll
                    for (int b_ = 0; b_ < 2; ++b_)
#pragma unroll
                        for (int n_ = 0; n_ < 2; ++n_) { acc[0][b_][m_][n_] = acc[0][b_][m_][n_] * r0_[m_]; acc[1][b_][m_][n_] = acc[1][b_][m_][n_] * r1_[m_]; } } }
            const bool last = (t == nt - 2);
            const char* a1 = cA + (size_t)(t + 1) * kstep;
            const char* a2 = last ? nA : cA + (size_t)(t + 2) * kstep; const char* b2 = last ? nB : cB + (size_t)(t + 2) * kstep;
            const char* a3 = a2 + kstep; const char* b3 = b2 + kstep;
            if (last && has_next) S.a_ready(nxt);
            if constexpr (SP2) {
            PG8_LDB(B0, 0, 0); PG8_LDB(B1, 0, 1); PG8_SCHED; PG8_LDA(At, 0, 0); PG8_STAGE(PG8_SA(1, 1), a1 + hstep, voffA);
            PG8_WAIT_V(8); PG8_WAIT_L(0); PG8_BAR; PG8_MMA(0, 0, At, B0); PG8_MMA(0, 1, At, B1); PG8_BAR; PG8_SCHED;
            PG8_LDA(At, 0, 1); PG8_STAGE(PG8_SB(0, 0), b2, voffB); PG8_STAGE(PG8_SB(0, 1), b2 + hstep, voffB); PG8_STAGE(PG8_SA(0, 0), a2, voffA);
            PG8_WAIT_V(8); PG8_WAIT_L(0); PG8_BAR; PG8_MMA(1, 0, At, B0); PG8_MMA(1, 1, At, B1); PG8_BAR; PG8_SCHED;
            PG8_LDB(B0, 1, 0); PG8_LDB(B1, 1, 1); PG8_SCHED; PG8_LDA(At, 1, 0); PG8_STAGE(PG8_SA(0, 1), a2 + hstep, voffA);
            PG8_WAIT_V(8); PG8_WAIT_L(0); PG8_BAR; PG8_MMA(0, 0, At, B0); PG8_MMA(0, 1, At, B1); PG8_BAR; PG8_SCHED;
            PG8_LDA(At, 1, 1); PG8_STAGE(PG8_SB(1, 0), b3, voffB); PG8_STAGE(PG8_SB(1, 1), b3 + hstep, voffB); PG8_STAGE(PG8_SA(1, 0), a3, voffA);
            PG8_WAIT_V(8); PG8_WAIT_L(0); PG8_BAR; PG8_MMA(1, 0, At, B0); PG8_MMA(1, 1, At, B1); PG8_BAR; PG8_SCHED;
            } else {
            PG8_LDB(B0, 0, 0); PG8_SCHED; PG8_LDA(At, 0, 0); PG8_STAGE(PG8_SA(1, 1), a1 + hstep, voffA);
            PG8_WAIT_L(8); PG8_BAR; PG8_WAIT_L(0); PG8_MMA(0, 0, At, B0); PG8_BAR; PG8_SCHED;
            PG8_LDB(B1, 0, 1); PG8_STAGE(PG8_SB(0, 0), b2, voffB);
            PG8_BAR; PG8_WAIT_L(0); PG8_MMA(0, 1, At, B1); PG8_BAR;
            PG8_LDA(At, 0, 1); PG8_STAGE(PG8_SA(0, 0), a2, voffA);
            PG8_BAR; PG8_WAIT_L(0); PG8_MMA(1, 0, At, B0); PG8_BAR; PG8_SCHED;
            PG8_STAGE(PG8_SB(0, 1), b2 + hstep, voffB);
            PG8_WAIT_V(6); PG8_BAR; PG8_MMA(1, 1, At, B1); PG8_BAR;
            PG8_LDB(B0, 1, 0); PG8_SCHED; PG8_LDA(At, 1, 0); PG8_STAGE(PG8_SA(0, 1), a2 + hstep, voffA);
            PG8_WAIT_L(8); PG8_BAR; PG8_WAIT_L(0); PG8_MMA(0, 0, At, B0); PG8_BAR; PG8_SCHED;
            PG8_LDB(B1, 1, 1); PG8_STAGE(PG8_SB(1, 0), b3, voffB);
            PG8_BAR; PG8_WAIT_L(0); PG8_MMA(0, 1, At, B1); PG8_BAR;
            PG8_LDA(At, 1, 1); PG8_STAGE(PG8_SA(1, 0), a3, voffA);
            PG8_BAR; PG8_WAIT_L(0); PG8_MMA(1, 0, At, B0); PG8_BAR; PG8_SCHED;
            PG8_STAGE(PG8_SB(1, 1), b3 + hstep, voffB);
            PG8_WAIT_V(6); PG8_BAR; PG8_MMA(1, 1, At, B1); PG8_BAR;
            }
        }
        if constexpr (ALIGN_EPI) { if (wr == 0) PG8_BAR; }
        if constexpr (!Epi::AFTER_DRAIN) { E(acc, cur, wr, wc, fr, fq); S.done(cur); }
        if (!has_next) break;
#pragma unroll
        for (int a = 0; a < 2; ++a)
#pragma unroll
            for (int b = 0; b < 2; ++b)
#pragma unroll
                for (int m = 0; m < 4; ++m)
#pragma unroll
                    for (int n = 0; n < 2; ++n) acc[a][b][m][n] = (f32x4){0.f, 0.f, 0.f, 0.f};
        cur = nxt; cA = nA; cB = nB; ++ui;
        if constexpr (ALIGN_EPI) { if (wr == 1) PG8_BAR; }
    }
    PG8_WAIT_V(0);
    if constexpr (!ALIGN_EPI) { if (wr == 0) PG8_BAR; }
    PG8_BAR;
    if constexpr (Epi::AFTER_DRAIN) { E.fused(acc, cur, wr, wc, fr, fq, lds, wid, lane); S.done(cur); }
#undef PG8_SA
#undef PG8_SB
#undef PG8_STAGE
#undef PG8_LDA
#undef PG8_LDB
#undef PG8_MMA
#undef PG8_WAIT_V
#undef PG8_WAIT_L
#undef PG8_BAR
#undef PG8_SCHED
}
}
#define GAS __attribute__((address_space(1)))
#define LAS __attribute__((address_space(3)))
typedef unsigned short bf16;
typedef unsigned v4u __attribute__((ext_vector_type(4)));
typedef float f32x4 __attribute__((ext_vector_type(4)));
typedef short bf16x8 __attribute__((ext_vector_type(8)));
typedef GAS unsigned gu32;
typedef GAS unsigned long long gu64;
#define RLX_AGENT __ATOMIC_RELAXED, __HIP_MEMORY_SCOPE_AGENT
#define LDS_WAIT() asm volatile("s_waitcnt lgkmcnt(0)" ::: "memory")
#define VM_WAIT() asm volatile("s_waitcnt vmcnt(0)" ::: "memory")
__device__ __forceinline__ unsigned long long rt() { return __builtin_amdgcn_s_memrealtime(); }
__device__ __forceinline__ unsigned f2bf(float f) { unsigned u = __builtin_bit_cast(unsigned, f); return (u + 0x7fffu + ((u >> 16) & 1u)) >> 16; }
__device__ __forceinline__ unsigned pk2(float lo, float hi) { return f2bf(lo) | (f2bf(hi) << 16); }
#define XB_TMO      128
#define XB_XCNT(j)  (256  + 64 * (j))
#define XB_XSUB(j)  (1280 + 64 * (j))
#define XB_XGEN(j)  (2304 + 64 * (j))
#define XB_TOP      3328
#define XB_TOPGEN   3392
#define XCD_BAR_WORDS 3456
#define XB_SPIN_CAP (1u << 18)

__device__ __forceinline__ unsigned xb_ld(unsigned* p)              { return __hip_atomic_load(p, __ATOMIC_RELAXED, __HIP_MEMORY_SCOPE_AGENT); }
__device__ __forceinline__ unsigned xb_add(unsigned* p, unsigned v) { return __hip_atomic_fetch_add(p, v, __ATOMIC_RELAXED, __HIP_MEMORY_SCOPE_AGENT); }
__device__ __forceinline__ unsigned xb_xcc_id() { return (unsigned)__builtin_amdgcn_s_getreg((3 << 11) | 20) & 0xFu; }
#define XB_SPIN(cond, bar) do { unsigned _sp = 0; while (cond) { __builtin_amdgcn_s_sleep(1); \
    if ((++_sp & 255u) == 0u) { if (xb_ld(&(bar)[XB_TMO])) break; if (_sp > XB_SPIN_CAP) { atomicAdd(&(bar)[XB_TMO], 1u); break; } } } } while (0)

struct XcdBarrier {
    unsigned* bar; unsigned x;
    volatile LAS unsigned* st;
};

__device__ __forceinline__ XcdBarrier xcd_barrier_post(unsigned* bar, volatile LAS unsigned* st) {
    XcdBarrier b; b.bar = bar; b.x = xb_xcc_id(); b.st = st;
    if (threadIdx.x == 0) (void)xb_add(&bar[XB_XCNT(b.x)], 1u);
    return b;
}
__device__ __forceinline__ void xcd_barrier_complete(unsigned* bar, unsigned x, unsigned& nloc, unsigned& nx) {
    const unsigned G = gridDim.x * gridDim.y * gridDim.z;
    unsigned sum, cnt, mine, sp = 0u;
    for (;;) {
        sum = 0u; cnt = 0u; mine = 0u;
#pragma unroll
        for (unsigned j = 0; j < 16; ++j) { const unsigned c = xb_ld(&bar[XB_XCNT(j)]); sum += c; cnt += (c > 0u) ? 1u : 0u; mine = (j == x) ? c : mine; }
        if (sum == G) break;
        __builtin_amdgcn_s_sleep(1);
        if ((++sp & 255u) == 0u) { if (xb_ld(&bar[XB_TMO])) break; if (sp > XB_SPIN_CAP) { atomicAdd(&bar[XB_TMO], 1u); break; } }
    }
    nloc = mine > 0u ? mine : 1u; nx = cnt > 0u ? cnt : 1u;
}

__device__ __forceinline__ void xcd_barrier(const XcdBarrier& b) {
    asm volatile("s_waitcnt vmcnt(0)" ::: "memory");
    __syncthreads();
    if (threadIdx.x == 0) {
        unsigned* bar = b.bar;
        __builtin_amdgcn_s_waitcnt(0);
        unsigned nloc = b.st[0], nx = b.st[1];
        if (nloc == 0u) { xcd_barrier_complete(bar, b.x, nloc, nx); b.st[0] = nloc; b.st[1] = nx; }
        const unsigned old = xb_add(&bar[XB_XSUB(b.x)], 1u);
        const unsigned gen = old / nloc;
        if (old + 1u == (gen + 1u) * nloc) {
            __builtin_amdgcn_fence(__ATOMIC_RELEASE, "agent");
            asm volatile("s_waitcnt vmcnt(0)" ::: "memory");
            const unsigned og = xb_add(&bar[XB_TOP], 1u);
            const unsigned tg = og / nx;
            if (og + 1u == (tg + 1u) * nx) xb_add(&bar[XB_TOPGEN], 1u);
            else XB_SPIN(xb_ld(&bar[XB_TOPGEN]) == tg, bar);
            __builtin_amdgcn_fence(__ATOMIC_ACQUIRE, "agent");
            xb_add(&bar[XB_XGEN(b.x)], 1u);
            asm volatile("s_waitcnt vmcnt(0)" ::: "memory");
        } else {
            XB_SPIN(xb_ld(&bar[XB_XGEN(b.x)]) == gen, bar);
            __builtin_amdgcn_fence(__ATOMIC_ACQUIRE, "agent");
            asm volatile("s_waitcnt vmcnt(0)" ::: "memory");
        }
    }
    __syncthreads();
}
#ifndef MK_PROBE
#define MK_PROBE 0
#endif
#ifndef MK_PROBE_A
#define MK_PROBE_A 0
#define MK_PROBE_B 0
#endif
#ifndef MK_PROBE_REGIONS
#define MK_PROBE_REGIONS 0
#endif
#if MK_PROBE
#define REG_BEGIN(i) do { if (blockIdx.x == 0 && threadIdx.x == 0) ((unsigned long long*)(kp->ws + WS_CTL + 65536))[100 + (i)] = __builtin_amdgcn_s_memrealtime(); } while (0)
#define REG_END(i) do { __syncthreads(); if (blockIdx.x == 0 && threadIdx.x == 0) { unsigned long long* st_ = (unsigned long long*)(kp->ws + WS_CTL + 65536); st_[110 + (i)] += __builtin_amdgcn_s_memrealtime() - st_[100 + (i)]; } } while (0)
#else
#define REG_BEGIN(i) do { } while (0)
#define REG_END(i) do { } while (0)
#endif
namespace nv {
constexpr int D = 1024, MP = 16384, MS = 512, MT = MP + MS, NSEQ = 136, DEPTH = 4;
constexpr int NIN = 4112;
constexpr int NPJ = 4096, OFF_POOL = 0, OFF_Z = 512, OFF_XBC = 1536, OFF_GATE = 3072, OFF_LRU = 3584;
constexpr int DFF = 2816, NINP = 4352;
constexpr float EPS = 1e-6f;
constexpr size_t O_Y = 0, O_PPOOL = (size_t)MT * D, O_PSCONV = O_PPOOL + 245760, O_PSSD = O_PSCONV + 147456, O_PLCONV = O_PSSD + 4194304, O_PLRU = O_PLCONV + 49152,
                 O_PMK = O_PLRU + 16384, O_PMV = O_PMK + 8388608, O_SPOOL = O_PMV + 8388608, O_SSCONV = O_SPOOL + 3932160, O_SSSD = O_SSCONV + 2359296,
                 O_SLCONV = O_SSSD + 67108864, O_SLRU = O_SLCONV + 786432, O_END = O_SLRU + 262144;
constexpr size_t MiB = 1u << 20;
constexpr size_t WS_CTL = 0, CTL_ZERO_BYTES = 1 * MiB;
constexpr size_t WS_WKV = 1 * MiB, WS_WIN = 17 * MiB, WS_WOUT = 51 * MiB, WS_WQ = 67 * MiB, WS_WO = 75 * MiB, WS_WGU = 83 * MiB, WS_WD = 127 * MiB;
constexpr size_t WS_MEMB = 149 * MiB, WS_HB = 153 * MiB, WS_UB = 153 * MiB, WS_MIXB = 186 * MiB, WS_OB = 252 * MiB, WS_ACT = 285 * MiB;
constexpr size_t WS_PROJ = 376 * MiB, WS_POOLED = 642 * MiB, WS_XBC = 675 * MiB, WS_YRAW = 774 * MiB, WS_XC = 840 * MiB, WS_AB = 873 * MiB, WS_BB = 906 * MiB, WS_QB = 939 * MiB;
constexpr size_t WS_KB = 1005 * MiB, WS_VT = 1021 * MiB;
constexpr size_t WS_SSDSS = 1037 * MiB, WS_PWT = 1039 * MiB;
constexpr size_t WS_DT = 1042 * MiB;
constexpr size_t WS_RSS = 1040 * MiB;
constexpr size_t WS_XBCC = 1044 * MiB;
constexpr size_t WS_XLRU = 840 * MiB;
constexpr size_t WS_END = 1092 * MiB;
constexpr size_t WIN_L = (size_t)NINP * 1024, WOUT_L = (size_t)1024 * 2048, WQ_L = (size_t)1024 * 1024, WGU_L = (size_t)5632 * 1024, WD_L = (size_t)1024 * 2816;
constexpr int CW_TMO = 0, CW_BAR = 4096;
constexpr int RING_OFF = 0, RING_BYTES = 131072, LDSCTL_OFF = RING_BYTES, MISC_OFF = LDSCTL_OFF + 320, LDS_BYTES = 147456;
constexpr int NWAVES = 8, NTHR = 512;
constexpr int PH_PRO = 0, PH_KV = 1, PH_L0 = 2, PH_PER_LAYER = 9, PH_FINAL = PH_L0 + DEPTH * PH_PER_LAYER, NPH = PH_FINAL + 1;

struct SeqInfo { int row0, L, pos0, b, grp; };
__device__ __forceinline__ SeqInfo seq_info(int s) {
    SeqInfo q;
    if (s < 8) { q.row0 = s * 2048; q.L = 2048; q.pos0 = 0; q.b = s; q.grp = 0; }
    else { q.b = s - 8; q.row0 = MP + q.b * 4; q.L = 4; q.pos0 = 16384; q.grp = 1; }
    return q;
}
__device__ __forceinline__ void row_info(int r, int& s, int& t) {
    if (r < MP) { s = r >> 11; t = r & 2047; } else { const int q = r - MP; s = 8 + (q >> 2); t = q & 3; }
}
__device__ __forceinline__ float wave_sum(float v) {
#pragma unroll
    for (int o = 1; o < 64; o <<= 1) v += __shfl_xor(v, o);
    return v;
}
__device__ __forceinline__ float wave_max(float v) {
#pragma unroll
    for (int o = 1; o < 64; o <<= 1) v = fmaxf(v, __shfl_xor(v, o));
    return v;
}
__device__ __forceinline__ float silu_f(float x) { return x / (1.f + expf(-x)); }
__device__ __forceinline__ float sigmoid_f(float x) { return 1.f / (1.f + expf(-x)); }
__device__ __forceinline__ float softplus_f(float x) { return x > 20.f ? x : log1pf(expf(x)); }
__device__ __forceinline__ float gelu_tanh_f(float x) { return 0.5f * x * (1.f + tanhf(0.7978845608028654f * (x + 0.044715f * x * x * x))); }

struct Args { const float* in[38]; float* out; unsigned char* ws; int ph_lo, ph_hi; };
typedef const __attribute__((address_space(4))) Args* KP;
struct Frame { LAS unsigned char* lds; int tid, lane, wave, bid, G, vcu; };
__device__ __forceinline__ void frame_refresh(Frame& F) { int t = threadIdx.x; asm volatile("" : "+v"(t)); F.tid = t; F.lane = t & 63; F.wave = __builtin_amdgcn_readfirstlane(t >> 6); }

typedef float f32x2_t __attribute__((ext_vector_type(2))); typedef __bf16 bf16x2_t __attribute__((ext_vector_type(2)));
__device__ __forceinline__ unsigned pk2h(float lo, float hi) { f32x2_t v = {lo, hi}; bf16x2_t b = __builtin_convertvector(v, bf16x2_t); return __builtin_bit_cast(unsigned, b); }
__device__ __forceinline__ unsigned f2bfh(float x) { return pk2h(x, 0.f) & 0xffffu; }
typedef short bf16x8 __attribute__((ext_vector_type(8)));
#define MFMA16(a, b, c) __builtin_amdgcn_mfma_f32_16x16x32_bf16((a), (b), (c), 0, 0, 0)
#define LBAR() do { asm volatile("s_waitcnt lgkmcnt(0)" ::: "memory"); __builtin_amdgcn_s_barrier(); asm volatile("" ::: "memory"); } while (0)
__device__ __forceinline__ float bf2f(unsigned short h) { return __uint_as_float((unsigned)h << 16); }
__device__ __forceinline__ void cvt8(v4u u, f32x4& lo, f32x4& hi) { lo = (f32x4){__uint_as_float(u.x << 16), __uint_as_float(u.x & 0xffff0000u), __uint_as_float(u.y << 16), __uint_as_float(u.y & 0xffff0000u)}; hi = (f32x4){__uint_as_float(u.z << 16), __uint_as_float(u.z & 0xffff0000u), __uint_as_float(u.w << 16), __uint_as_float(u.w & 0xffff0000u)}; }
constexpr int SL_CS = 0, SL_BS = 32768, SL_BT = 65536, SL_XT = 98304, SL_XW = 106496, SL_HS = 114688, SL_XS = 122880;
constexpr int XTRA = LDSCTL_OFF + 512;
constexpr int SL_ACS = XTRA, SL_DTV = XTRA + 512, SL_CW = XTRA + 1024;
__device__ __forceinline__ int sw128(int r, int c8) { return r * 256 + (((c8 ^ r) & 15) << 4); }
__device__ __forceinline__ int sw128t(int r, int c8) { return r * 256 + (((c8 ^ r ^ (r >> 3)) & 15) << 4); }
__device__ __forceinline__ float fexp(float x) { return __builtin_amdgcn_exp2f(1.4426950408889634f * x); }
__device__ __forceinline__ float fsilu(float x) { return x * __builtin_amdgcn_rcpf(1.0f + __builtin_amdgcn_exp2f(-1.4426950408889634f * x)); }

__device__ __forceinline__ void ph_mix0(KP a, Frame& F, int l) {
    const bf16* proj = (const bf16*)(a->ws + WS_PROJ);
    const int NIT = (MP / 8) * 256;
    for (int it = F.bid * NTHR + F.tid; it < NIT; it += F.G * NTHR) {
        const int cc = it & 255, rb = it >> 8, r0 = rb * 8, t = r0 & 2047;
        const bool lru = cc >= 192; const int c8 = lru ? cc - 192 : cc, C = lru ? 512 : 1536;
        const float* cw = lru ? a->in[20] + (size_t)l * 4 * 512 : a->in[14] + (size_t)l * 4 * 1536; const float* cb = lru ? a->in[21] + (size_t)l * 512 : a->in[15] + (size_t)l * 1536;
        bf16* xo = (bf16*)(a->ws + (lru ? WS_XLRU : WS_XBCC)); const int soff = lru ? OFF_LRU : OFF_XBC;
        f32x4 wk[5][2];
#pragma unroll
        for (int k = 0; k < 4; ++k) { wk[k][0] = *(const f32x4*)(cw + (size_t)k * C + 8 * c8); wk[k][1] = *(const f32x4*)(cw + (size_t)k * C + 8 * c8 + 4); }
        wk[4][0] = *(const f32x4*)(cb + 8 * c8); wk[4][1] = *(const f32x4*)(cb + 8 * c8 + 4);
        v4u rw[11];
#pragma unroll
        for (int rr = 0; rr < 11; ++rr) { rw[rr] = (v4u){0u, 0u, 0u, 0u}; if (t + rr - 3 >= 0) rw[rr] = *(const GAS v4u*)(proj + (size_t)(r0 + rr - 3) * NPJ + soff + 8 * c8); }
#pragma unroll
        for (int hf = 0; hf < 2; ++hf) {
            f32x4 raw[11];
#pragma unroll
            for (int rr = 0; rr < 11; ++rr) { const unsigned u0 = hf ? rw[rr].z : rw[rr].x, u1 = hf ? rw[rr].w : rw[rr].y;
                raw[rr] = (f32x4){__uint_as_float(u0 << 16), __uint_as_float(u0 & 0xffff0000u), __uint_as_float(u1 << 16), __uint_as_float(u1 & 0xffff0000u)}; }
#pragma unroll
            for (int i = 0; i < 8; ++i) { f32x4 o = wk[4][hf];
#pragma unroll
                for (int k = 0; k < 4; ++k) o += wk[k][hf] * raw[i + k];
                if (!lru) { o.x = fsilu(o.x); o.y = fsilu(o.y); o.z = fsilu(o.z); o.w = fsilu(o.w); }
                *(unsigned long long*)(xo + (size_t)(r0 + i) * C + 8 * c8 + 4 * hf) = (unsigned long long)pk2h(o.x, o.y) | ((unsigned long long)pk2h(o.z, o.w) << 32); }
        }
    }
}
template <bool WITH_T>
__device__ __forceinline__ void ssd_stage(LAS unsigned char* L, const v4u (&rw)[4], int dst, int dstT, int tq, int c8) {
#pragma unroll
    for (int i = 0; i < 4; ++i) *(LAS v4u*)(L + dst + sw128(4 * tq + i, c8)) = rw[i];
    if (WITH_T) {
#pragma unroll
        for (int jw = 0; jw < 4; ++jw) {
            const unsigned a0 = rw[0][jw], a1 = rw[1][jw], a2 = rw[2][jw], a3 = rw[3][jw];
            const unsigned long long ev = (unsigned long long)((a0 & 0xffffu) | (a1 << 16)) | ((unsigned long long)((a2 & 0xffffu) | (a3 << 16)) << 32);
            const unsigned long long od = (unsigned long long)((a0 >> 16) | (a1 & 0xffff0000u)) | ((unsigned long long)((a2 >> 16) | (a3 & 0xffff0000u)) << 32);
            *(LAS unsigned long long*)(L + dstT + sw128t(8 * c8 + 2 * jw, tq >> 1) + (tq & 1) * 8) = ev;
            *(LAS unsigned long long*)(L + dstT + sw128t(8 * c8 + 2 * jw + 1, tq >> 1) + (tq & 1) * 8) = od; }
    }
}
__device__ __forceinline__ float fsoftplus(float x) { return x > 15.f ? x : 0.6931471805599453f * __builtin_amdgcn_logf(1.0f + __builtin_amdgcn_exp2f(1.4426950408889634f * x)); }

__device__ __forceinline__ void ssd_prompt_item(KP a, Frame& F, int l, int b, int hd, int ph) {
    LAS unsigned char* L = F.lds;
    const int tid0 = F.tid, w = F.wave, fr0 = F.lane & 15, fq0 = F.lane >> 4, g = hd >> 3;
    const bf16* proj_seq = (const bf16*)(a->ws + WS_PROJ) + (size_t)b * 2048 * NPJ; const float* dt_seq = (const float*)(a->ws + WS_DT) + (size_t)b * 2048 * 16 + hd;
    bf16* mixb = (bf16*)(a->ws + WS_MIXB) + (size_t)b * 2048 * 2048 + hd * 64 + ph * 32;
    float* ssq = (float*)(a->ws + WS_SSDSS) + (size_t)b * 2048 * 32 + hd * 2 + ph;
    LAS float* ACS = (LAS float*)(L + SL_ACS); LAS float* DTV = (LAS float*)(L + SL_DTV);
    const bf16* xc_seq = (const bf16*)(a->ws + WS_XBCC) + (size_t)b * 2048 * 1536;
    for (int i = tid0; i < 8192 / 4; i += NTHR) ((LAS unsigned*)(L + SL_HS))[i] = 0u;
    const float A = -expf(a->in[17][l * 16 + hd]), dtb = a->in[16][l * 16 + hd], Dk = a->in[18][l * 16 + hd];
    f32x4 hst[2]; hst[0] = (f32x4){0.f, 0.f, 0.f, 0.f}; hst[1] = (f32x4){0.f, 0.f, 0.f, 0.f};
    const int cB = 1024 + g * 128, cC = 1280 + g * 128, cX = hd * 64 + ph * 32, cZ = OFF_Z + hd * 64 + ph * 32;
    v4u rawB[4], rawC[4]; unsigned rawX[4]; float dr0 = 0.f, dr1 = 0.f;
    {
        const int tq = tid0 >> 4, c8 = tid0 & 15;
#pragma unroll
        for (int i = 0; i < 4; ++i) { const bf16* rp = xc_seq + (size_t)(4 * tq + i) * 1536; rawB[i] = *(const GAS v4u*)(rp + cB + 8 * c8); rawC[i] = *(const GAS v4u*)(rp + cC + 8 * c8); rawX[i] = *(const GAS unsigned*)(rp + cX + 2 * c8); }
        if (w == 0) { dr0 = dt_seq[(size_t)(2 * F.lane) * 16]; dr1 = dt_seq[(size_t)(2 * F.lane + 1) * 16]; }
    }
    __syncthreads();
    for (int c = 0; c < 16; ++c) {
        const int t0 = c * 128;
        const int tid = tid0, fr = fr0, fq = fq0;
        const int lane = tid & 63, tq = tid >> 4, c8 = tid & 15;
        unsigned long long zq[2];
#pragma unroll
        for (int pt = 0; pt < 2; ++pt) zq[pt] = *(const GAS unsigned long long*)(proj_seq + (size_t)(t0 + 16 * w + fr) * NPJ + cZ + 16 * pt + 4 * fq);
        if (w == 0) {
            const float dt0 = fsoftplus(dr0 + dtb), dt1 = fsoftplus(dr1 + dtb);
            const float a0 = dt0 * A, a1 = dt1 * A;
            float v = a0 + a1;
#pragma unroll
            for (int o = 1; o < 64; o <<= 1) { const float t = __shfl_up(v, o); if (lane >= o) v += t; }
            ACS[2 * lane] = v - a1; ACS[2 * lane + 1] = v; DTV[2 * lane] = dt0; DTV[2 * lane + 1] = dt1;
        }
        ssd_stage<true>(L, rawB, SL_BS, SL_BT, tq, c8);
        ssd_stage<false>(L, rawC, SL_CS, 0, tq, c8);
        if (c + 1 < 16) {
#pragma unroll
            for (int i = 0; i < 4; ++i) { const bf16* rp = xc_seq + (size_t)(t0 + 128 + 4 * tq + i) * 1536; rawB[i] = *(const GAS v4u*)(rp + cB + 8 * c8); rawC[i] = *(const GAS v4u*)(rp + cC + 8 * c8); }
        }
        LBAR();
        f32x4 cb[8]; bf16x8 cfr[4]; const int lo = (w >= 4) ? (w - 4) : 0, hrt = 7 - w, nh = (w < 4) ? (3 - w) : 0;
#pragma unroll
        for (int ks = 0; ks < 4; ++ks) cfr[ks] = *(const LAS bf16x8*)(L + SL_CS + sw128(16 * w + fr, 4 * ks + fq));
#pragma unroll
        for (int st = 0; st < 8; ++st) if (st >= lo && st <= w) { cb[st] = (f32x4){0.f, 0.f, 0.f, 0.f};
#pragma unroll
            for (int ks = 0; ks < 4; ++ks) { const bf16x8 bm = *(const LAS bf16x8*)(L + SL_BS + sw128(16 * st + fr, 4 * ks + fq)); cb[st] = MFMA16(bm, cfr[ks], cb[st]); } }
        f32x4 cbh[3];
        if (w < 4) { bf16x8 cf2[4];
#pragma unroll
            for (int ks = 0; ks < 4; ++ks) cf2[ks] = *(const LAS bf16x8*)(L + SL_CS + sw128(16 * hrt + fr, 4 * ks + fq));
#pragma unroll
            for (int k = 0; k < 3; ++k) if (k < nh) { cbh[k] = (f32x4){0.f, 0.f, 0.f, 0.f};
#pragma unroll
                for (int ks = 0; ks < 4; ++ks) { const bf16x8 bm = *(const LAS bf16x8*)(L + SL_BS + sw128(16 * k + fr, 4 * ks + fq)); cbh[k] = MFMA16(bm, cf2[ks], cbh[k]); } } }
        {
            const float alast = ACS[127];
            float xd[4][2], xw[4][2];
#pragma unroll
            for (int i = 0; i < 4; ++i) { const int tok = 4 * tq + i; const float dt = DTV[tok], wgt = fexp(alast - ACS[tok]);
                xd[i][0] = __uint_as_float(rawX[i] << 16) * dt; xd[i][1] = __uint_as_float(rawX[i] & 0xffff0000u) * dt; xw[i][0] = xd[i][0] * wgt; xw[i][1] = xd[i][1] * wgt; }
#pragma unroll
            for (int j = 0; j < 2; ++j) { const int off = sw128(2 * c8 + j, tq >> 1) + (tq & 1) * 8;
                *(LAS unsigned long long*)(L + SL_XT + off) = (unsigned long long)pk2h(xd[0][j], xd[1][j]) | ((unsigned long long)pk2h(xd[2][j], xd[3][j]) << 32);
                *(LAS unsigned long long*)(L + SL_XW + off) = (unsigned long long)pk2h(xw[0][j], xw[1][j]) | ((unsigned long long)pk2h(xw[2][j], xw[3][j]) << 32); }
            if (c + 1 < 16) {
#pragma unroll
                for (int i = 0; i < 4; ++i) rawX[i] = *(const GAS unsigned*)(xc_seq + (size_t)(t0 + 128 + 4 * tq + i) * 1536 + cX + 2 * c8);
                if (w == 0) { dr0 = dt_seq[(size_t)(t0 + 128 + 2 * lane) * 16]; dr1 = dt_seq[(size_t)(t0 + 128 + 2 * lane + 1) * 16]; }
            }
        }
        LBAR();
        {
            const int l_ = 16 * w + fr; const float al = ACS[l_];
#pragma unroll
            for (int st = 0; st < 8; ++st) {
                const int off = SL_BS + sw128(l_, 2 * st + (fq >> 1)) + (fq & 1) * 8;
                if (st >= lo && st <= w) { float v[4]; const f32x4 as4 = *(const LAS f32x4*)(ACS + 16 * st + 4 * fq);
#pragma unroll
                    for (int e = 0; e < 4; ++e) { const int s_ = 16 * st + 4 * fq + e; const float ex = fexp(fminf(al - as4[e], 0.f)); v[e] = (s_ <= l_) ? cb[st][e] * ex : 0.f; }
                    *(LAS unsigned long long*)(L + off) = (unsigned long long)pk2h(v[0], v[1]) | ((unsigned long long)pk2h(v[2], v[3]) << 32); }
                else if (st == w + 1 && (w & 1) == 0) *(LAS unsigned long long*)(L + off) = 0ull;
            }
            if (w < 4) { const int l2 = 16 * hrt + fr; const float al2 = ACS[l2];
#pragma unroll
                for (int k = 0; k < 3; ++k) if (k < nh) { float v[4]; const f32x4 as4 = *(const LAS f32x4*)(ACS + 16 * k + 4 * fq);
#pragma unroll
                    for (int e = 0; e < 4; ++e) v[e] = cbh[k][e] * fexp(fminf(al2 - as4[e], 0.f));
                    *(LAS unsigned long long*)(L + SL_BS + sw128(l2, 2 * k + (fq >> 1)) + (fq & 1) * 8) = (unsigned long long)pk2h(v[0], v[1]) | ((unsigned long long)pk2h(v[2], v[3]) << 32); } }
        }
        LBAR();
        {
            f32x4 yd[2], yo[2];
#pragma unroll
            for (int pt = 0; pt < 2; ++pt) { yd[pt] = (f32x4){0.f, 0.f, 0.f, 0.f}; yo[pt] = (f32x4){0.f, 0.f, 0.f, 0.f}; }
#pragma unroll
            for (int ks = 0; ks < 4; ++ks) {
#pragma unroll
                for (int pt = 0; pt < 2; ++pt) { const bf16x8 hf = *(const LAS bf16x8*)(L + SL_HS + sw128(16 * pt + fr, 4 * ks + fq)); yo[pt] = MFMA16(hf, cfr[ks], yo[pt]); }
                if (ks <= (w >> 1)) { const bf16x8 mf = *(const LAS bf16x8*)(L + SL_BS + sw128(16 * w + fr, 4 * ks + fq));
#pragma unroll
                    for (int pt = 0; pt < 2; ++pt) { const bf16x8 xf = *(const LAS bf16x8*)(L + SL_XT + sw128(16 * pt + fr, 4 * ks + fq)); yd[pt] = MFMA16(xf, mf, yd[pt]); } }
            }
            const int l_ = 16 * w + fr; const float ea = fexp(ACS[l_]), dsk = Dk * __builtin_amdgcn_rcpf(DTV[l_]); float s2 = 0.f;
#pragma unroll
            for (int pt = 0; pt < 2; ++pt) { float yg[4];
#pragma unroll
                for (int e = 0; e < 4; ++e) { const int p = 16 * pt + 4 * fq + e;
                    const float xdv = bf2f(*(const LAS bf16*)(L + SL_XT + sw128(p, l_ >> 3) + (l_ & 7) * 2));
                    const float z = bf2f((unsigned short)(zq[pt] >> (16 * e)));
                    const float y = yd[pt][e] + ea * yo[pt][e] + dsk * xdv;
                    yg[e] = y * fsilu(z); s2 += yg[e] * yg[e]; }
                *(unsigned long long*)(mixb + (size_t)(t0 + l_) * 2048 + 16 * pt + 4 * fq) = (unsigned long long)pk2h(yg[0], yg[1]) | ((unsigned long long)pk2h(yg[2], yg[3]) << 32); }
            s2 += __shfl_xor(s2, 16); s2 += __shfl_xor(s2, 32);
            if (fq == 0) ssq[(size_t)(t0 + l_) * 32] = s2;
            const float cd = fexp(ACS[127]);
#pragma unroll
            for (int pt = 0; pt < 2; ++pt) hst[pt] = hst[pt] * cd;
#pragma unroll
            for (int ks = 0; ks < 4; ++ks) { const bf16x8 bt = *(const LAS bf16x8*)(L + SL_BT + sw128t(16 * w + fr, 4 * ks + fq));
#pragma unroll
                for (int pt = 0; pt < 2; ++pt) { const bf16x8 xw = *(const LAS bf16x8*)(L + SL_XW + sw128(16 * pt + fr, 4 * ks + fq)); hst[pt] = MFMA16(bt, xw, hst[pt]); } }
        }
        LBAR();
#pragma unroll
        for (int pt = 0; pt < 2; ++pt)
            *(LAS unsigned long long*)(L + SL_HS + sw128(16 * pt + fr, 2 * w + (fq >> 1)) + (fq & 1) * 8) = (unsigned long long)pk2h(hst[pt][0], hst[pt][1]) | ((unsigned long long)pk2h(hst[pt][2], hst[pt][3]) << 32);
    }
    {
        float* so = a->out + O_PSSD + ((((size_t)l * 8 + b) * 16 + hd) * 64 + ph * 32) * 128;
#pragma unroll
        for (int pt = 0; pt < 2; ++pt) *(f32x4*)(so + (size_t)(16 * pt + fr0) * 128 + 16 * w + 4 * fq0) = hst[pt];
    }
    __syncthreads();
}

constexpr int LR_ROWS = 512 + 32;
constexpr int LR_A = 0, LR_B = LR_ROWS * 64, LR_XC = 2 * LR_ROWS * 64;
constexpr int LR_SEG = LR_XC + 8192, LR_CAR = LR_SEG + 2 * 32 * 16 * 4, LR_CW = LR_CAR + 64 + 32 * 16 * 4;
static_assert(LR_CW + 5 * 64 * 4 <= RING_BYTES, "lru LDS map");
__device__ __forceinline__ int lr_row(int tok) { return tok + (tok >> 4); }
__device__ __forceinline__ void lru_prompt_item(KP a, Frame& F, int l, int b, int hh, int qd) {
    LAS unsigned char* L = F.lds;
    const int tid0 = F.tid, w = F.wave, fr0 = F.lane & 15, fq0 = F.lane >> 4;
    const bf16* proj_seq = (const bf16*)(a->ws + WS_PROJ) + (size_t)b * 2048 * NPJ;
    bf16* mixb = (bf16*)(a->ws + WS_MIXB) + (size_t)b * 2048 * 2048 + 1536 + hh * 64 + qd * 16;
    LAS float* Al = (LAS float*)(L + LR_A); LAS float* Bl = (LAS float*)(L + LR_B); LAS float* XCs = (LAS float*)(L + LR_XC) + w * 256;
    LAS float* SegA = (LAS float*)(L + LR_SEG); LAS float* SegB = SegA + 512; LAS float* Car = (LAS float*)(L + LR_CAR); LAS float* CarIn = Car + 16;
    const int ch = hh * 64 + qd * 16 + fr0;
    if (tid0 < 16) Car[tid0] = 0.f;
    bf16x8 waf[2], wxf[2];
    {
        const float* wa = a->in[22] + ((size_t)l * 8 + hh) * 64 * 64 + qd * 16 + fr0; const float* wx = a->in[24] + ((size_t)l * 8 + hh) * 64 * 64 + qd * 16 + fr0;
#pragma unroll
        for (int ks = 0; ks < 2; ++ks) { v4u ua, ux; const int i0 = 32 * ks + 8 * fq0;
            ua.x = pk2h(wa[(i0 + 0) * 64], wa[(i0 + 1) * 64]); ua.y = pk2h(wa[(i0 + 2) * 64], wa[(i0 + 3) * 64]); ua.z = pk2h(wa[(i0 + 4) * 64], wa[(i0 + 5) * 64]); ua.w = pk2h(wa[(i0 + 6) * 64], wa[(i0 + 7) * 64]);
            ux.x = pk2h(wx[(i0 + 0) * 64], wx[(i0 + 1) * 64]); ux.y = pk2h(wx[(i0 + 2) * 64], wx[(i0 + 3) * 64]); ux.z = pk2h(wx[(i0 + 4) * 64], wx[(i0 + 5) * 64]); ux.w = pk2h(wx[(i0 + 6) * 64], wx[(i0 + 7) * 64]);
            waf[ks] = __builtin_bit_cast(bf16x8, ua); wxf[ks] = __builtin_bit_cast(bf16x8, ux); }
    }
    const float bav = a->in[23][(size_t)l * 512 + ch], bxv = a->in[25][(size_t)l * 512 + ch];
    const float lamv = a->in[26][(size_t)l * 512 + ch];
    const float spv = -8.0f * ((-lamv) > 20.f ? (-lamv) : log1pf(expf(-lamv)));
    const bf16* xl_seq = (const bf16*)(a->ws + WS_XLRU) + (size_t)b * 2048 * 512 + hh * 64;
    v4u xr[4][2];
#pragma unroll
    for (int tt = 0; tt < 4; ++tt)
#pragma unroll
        for (int ks = 0; ks < 2; ++ks) xr[tt][ks] = *(const GAS v4u*)(xl_seq + (size_t)((w * 4 + tt) * 16 + fr0) * 512 + 32 * ks + 8 * fq0);
    __syncthreads();
    for (int qp = 0; qp < 4; ++qp) {
        const int T0 = qp * 512;
        int tid = tid0, fr = fr0, fq = fq0; asm volatile("" : "+v"(tid), "+v"(fr), "+v"(fq));
        v4u gz0, gz1;
        { const bf16* gp = proj_seq + (size_t)(T0 + tid) * NPJ + OFF_GATE + hh * 64 + qd * 16; gz0 = *(const GAS v4u*)gp; gz1 = *(const GAS v4u*)(gp + 8); }
#pragma unroll
        for (int tt = 0; tt < 4; ++tt) {
            const int tb = (w * 4 + tt) * 16;
            bf16x8 xa[2];
#pragma unroll
            for (int ks = 0; ks < 2; ++ks) { xa[ks] = __builtin_bit_cast(bf16x8, xr[tt][ks]);
                if (ks == (qd >> 1) && (fq >> 1) == (qd & 1)) {
                    f32x4 x0, x1; cvt8(xr[tt][ks], x0, x1); *(LAS f32x4*)(XCs + fr * 16 + 8 * (fq & 1)) = x0; *(LAS f32x4*)(XCs + fr * 16 + 8 * (fq & 1) + 4) = x1; }
            }
            f32x4 pr = (f32x4){bav, bav, bav, bav}, pi = (f32x4){bxv, bxv, bxv, bxv};
#pragma unroll
            for (int ks = 0; ks < 2; ++ks) { pr = MFMA16(xa[ks], waf[ks], pr); pi = MFMA16(xa[ks], wxf[ks], pi); }
            LDS_WAIT(); asm volatile("" ::: "memory");
#pragma unroll
            for (int e = 0; e < 4; ++e) { const int tok = tb + 4 * fq + e;
                const float rg = __builtin_amdgcn_rcpf(1.0f + fexp(-pr[e])), ig = __builtin_amdgcn_rcpf(1.0f + fexp(-pi[e]));
                const float log_a = spv * rg; const float av = fexp(log_a);
                const float y2 = 2.0f * log_a;
                const float om = y2 > -0.02f ? -y2 * (1.0f + y2 * (0.5f + y2 * (0.16666667f + y2 * 0.041666668f))) : 1.0f - av * av;
                const float mult = (T0 + tok == 0) ? 1.0f : sqrtf(om);
                const float xcv = XCs[(4 * fq + e) * 16 + fr];
                Al[lr_row(tok) * 16 + fr] = av; Bl[lr_row(tok) * 16 + fr] = mult * ig * xcv; }
            LDS_WAIT(); asm volatile("" ::: "memory");
        }
        if (qp + 1 < 4) {
#pragma unroll
            for (int tt = 0; tt < 4; ++tt)
#pragma unroll
                for (int ks = 0; ks < 2; ++ks) xr[tt][ks] = *(const GAS v4u*)(xl_seq + (size_t)(T0 + 512 + (w * 4 + tt) * 16 + fr) * 512 + 32 * ks + 8 * fq);
        }
        LBAR();
        {
            const int sg = tid >> 4, c = tid & 15; float pa = 1.f, hb = 0.f;
#pragma unroll
            for (int i = 0; i < 16; ++i) { const int r = (sg * 17 + i) * 16 + c; const float av = Al[r]; hb = av * hb + Bl[r]; pa *= av; }
            SegA[sg * 16 + c] = pa; SegB[sg * 16 + c] = hb;
        }
        LBAR();
        if (tid < 64) {
            const int c = tid & 15, p = tid >> 4; float sa[8], sb[8];
#pragma unroll
            for (int k = 0; k < 8; ++k) { sa[k] = SegA[(8 * p + k) * 16 + c]; sb[k] = SegB[(8 * p + k) * 16 + c]; }
            float h = Car[c];
#pragma unroll
            for (int k = 1; k < 8; ++k) { sb[k] = sa[k] * sb[k - 1] + sb[k]; sa[k] = sa[k] * sa[k - 1]; }
#pragma unroll
            for (int pp = 0; pp < 3; ++pp) { const float ta = __shfl(sa[7], c + 16 * pp), tb = __shfl(sb[7], c + 16 * pp); if (pp < p) h = ta * h + tb; }
            CarIn[(8 * p) * 16 + c] = h;
#pragma unroll
            for (int k = 1; k < 8; ++k) CarIn[(8 * p + k) * 16 + c] = sa[k - 1] * h + sb[k - 1];
            if (p == 3) Car[c] = sa[7] * h + sb[7]; }
        LBAR();
        {
            const int sg = tid >> 4, c = tid & 15; float h = CarIn[sg * 16 + c];
#pragma unroll
            for (int i = 0; i < 16; ++i) { const int r = (sg * 17 + i) * 16 + c; h = Al[r] * h + Bl[r]; Bl[r] = h; }
        }
        LBAR();
        {
            const int tok = tid;
            float y[16]; f32x4 gq[4]; cvt8(gz0, gq[0], gq[1]); cvt8(gz1, gq[2], gq[3]);
#pragma unroll
            for (int v = 0; v < 4; ++v) { const f32x4 gt = gq[v]; const f32x4 hv = *(const LAS f32x4*)(Bl + lr_row(tok) * 16 + 4 * v);
#pragma unroll
                for (int i = 0; i < 4; ++i) { const float x = gt[i]; const float u = 0.7978845608028654f * (x + 0.044715f * x * x * x); const float th = 1.0f - 2.0f * __builtin_amdgcn_rcpf(1.0f + fexp(2.0f * u));
                    y[4 * v + i] = hv[i] * 0.5f * x * (1.0f + th); } }
            v4u o0, o1; o0.x = pk2h(y[0], y[1]); o0.y = pk2h(y[2], y[3]); o0.z = pk2h(y[4], y[5]); o0.w = pk2h(y[6], y[7]); o1.x = pk2h(y[8], y[9]); o1.y = pk2h(y[10], y[11]); o1.z = pk2h(y[12], y[13]); o1.w = pk2h(y[14], y[15]);
            v4u* op = (v4u*)(mixb + (size_t)(T0 + tok) * 2048); op[0] = o0; op[1] = o1;
        }
        LBAR();
    }
    if (tid0 < 16) a->out[O_PLRU + ((size_t)l * 8 + b) * 512 + hh * 64 + qd * 16 + tid0] = Car[tid0];
    __syncthreads();
}

constexpr int PL_UP = 0, PL_UPROW = 132 * 4, PL_P = 143 * PL_UPROW;
static_assert(PL_P % 16 == 0 && PL_P + 32768 <= RING_BYTES, "pool LDS map");
__device__ __forceinline__ void pool_prompt_item(KP a, Frame& F, int l, int b, int c, int g) {
    LAS unsigned char* L = F.lds;
    const int tid = F.tid, lane = F.lane, w = F.wave, fr = lane & 15, fq = lane >> 4;
    const int t0 = c * 128, win = 2 << g;
    const bf16* proj_seq = (const bf16*)(a->ws + WS_PROJ) + (size_t)b * 2048 * NPJ;
    const bf16* pwt = (const bf16*)(a->ws + WS_PWT) + ((size_t)l * 4 + g) * 128 * 128;
    bf16* mixb = (bf16*)(a->ws + WS_MIXB) + (size_t)b * 2048 * 2048 + 1024 + g * 128;
    {
        v4u ur[5];
#pragma unroll
        for (int k = 0; k < 5; ++k) { const int i = tid + k * NTHR, rr = i >> 4, c8 = i & 15, row = t0 + rr - 15; ur[k] = (v4u){0u, 0u, 0u, 0u};
            if (i < 143 * 16 && row >= 0) ur[k] = *(const GAS v4u*)(proj_seq + (size_t)row * NPJ + OFF_POOL + g * 128 + 8 * c8); }
#pragma unroll
        for (int k = 0; k < 5; ++k) { const int i = tid + k * NTHR, rr = i >> 4, c8 = i & 15; f32x4 v0, v1; cvt8(ur[k], v0, v1);
            if (i < 143 * 16) { *(LAS f32x4*)(L + PL_UP + rr * PL_UPROW + c8 * 32) = v0; *(LAS f32x4*)(L + PL_UP + rr * PL_UPROW + c8 * 32 + 16) = v1; } }
    }
    __syncthreads();
    for (int i = tid; i < 128 * 16; i += NTHR) { const int tok = i >> 4, c8 = i & 15;
        f32x4 s0 = (f32x4){0.f, 0.f, 0.f, 0.f}, s1 = s0;
        for (int j = 0; j < win; ++j) { const LAS unsigned char* p = L + PL_UP + (tok + 15 - j) * PL_UPROW + c8 * 32; s0 += *(const LAS f32x4*)p; s1 += *(const LAS f32x4*)(p + 16); }
        const int pos = t0 + tok; const float ic = 1.0f / (float)((pos + 1 < win) ? (pos + 1) : win);
        const LAS unsigned char* p = L + PL_UP + (tok + 15) * PL_UPROW + c8 * 32; const f32x4 u0 = *(const LAS f32x4*)p, u1 = *(const LAS f32x4*)(p + 16);
        s0 = s0 * ic - u0; s1 = s1 * ic - u1;
        v4u o; o.x = pk2h(s0.x, s0.y); o.y = pk2h(s0.z, s0.w); o.z = pk2h(s1.x, s1.y); o.w = pk2h(s1.z, s1.w);
        *(LAS v4u*)(L + PL_P + sw128(tok, c8)) = o; }
    __syncthreads();
    bf16x8 pa[4];
#pragma unroll
    for (int ks = 0; ks < 4; ++ks) pa[ks] = *(const LAS bf16x8*)(L + PL_P + sw128(16 * w + fr, 4 * ks + fq));
#pragma unroll
    for (int dt = 0; dt < 8; ++dt) { f32x4 acc = (f32x4){0.f, 0.f, 0.f, 0.f};
#pragma unroll
        for (int ks = 0; ks < 4; ++ks) { const bf16x8 wf = *(const bf16x8*)(pwt + (size_t)(16 * dt + fr) * 128 + 32 * ks + 8 * fq); acc = MFMA16(pa[ks], wf, acc); }
#pragma unroll
        for (int e = 0; e < 4; ++e) mixb[(size_t)(t0 + 16 * w + 4 * fq + e) * 2048 + 16 * dt + fr] = (bf16)f2bfh(acc[e]); }
    __syncthreads();
}

struct TI { const float* W; bf16* WT; const float* gain; int K, N, k0, n0, row_off, mode, goff, kd0; };
__device__ __forceinline__ void ti_load(const TI& t, f32x4 (&v)[8], float (&gn)[8], int lane) {
    const int nn = (lane & 7) * 4, kr = lane >> 3;
#pragma unroll
    for (int i = 0; i < 8; ++i) { const int kk = 8 * i + kr; v[i] = (f32x4){0.f, 0.f, 0.f, 0.f}; gn[i] = 1.f;
        if (t.n0 + nn + 4 <= t.N) v[i] = *(const f32x4*)(t.W + (size_t)(t.k0 + kk) * t.N + t.n0 + nn);
        if (t.gain) gn[i] = t.gain[t.k0 + kk - t.goff]; }
}
__device__ __forceinline__ void ti_store(const TI& t, const f32x4 (&v)[8], const float (&gn)[8], LAS float* scr, int lane) {
    const int nn = (lane & 7) * 4, kr = lane >> 3;
#pragma unroll
    for (int i = 0; i < 8; ++i) { const int kk = 8 * i + kr; f32x4 x = v[i] * gn[i];
        scr[kk * 33 + nn] = x.x; scr[kk * 33 + nn + 1] = x.y; scr[kk * 33 + nn + 2] = x.z; scr[kk * 33 + nn + 3] = x.w; }
    LDS_WAIT(); asm volatile("" ::: "memory");
    const int c = lane & 7;
#pragma unroll
    for (int j = 0; j < 4; ++j) { const int nl = (lane >> 3) + 8 * j, n = t.n0 + nl; const LAS float* sp = scr + (8 * c) * 33 + nl;
        v4u o; o.x = pk2h(sp[0 * 33], sp[1 * 33]); o.y = pk2h(sp[2 * 33], sp[3 * 33]); o.z = pk2h(sp[4 * 33], sp[5 * 33]); o.w = pk2h(sp[6 * 33], sp[7 * 33]);
        int dr;
        if (t.mode == 0) dr = t.row_off + n; else if (t.mode == 1) dr = n < 3072 ? n : (n < 3088 ? 4096 + (n - 3072) : n - 16); else dr = 256 * (n >> 7) + (n & 127) + t.row_off;
        if (n < t.N) *(GAS v4u*)(t.WT + (size_t)dr * t.K + t.kd0 + 8 * c) = o; }
    LDS_WAIT(); asm volatile("" ::: "memory");
}
__device__ __forceinline__ void ph_prologue(KP a, Frame& F) {
    LAS float* scr = (LAS float*)(F.lds + RING_OFF + F.wave * 16384);
    const int gw = F.bid * NWAVES + F.wave, NGW = F.G * NWAVES;
    bf16* Wkv = (bf16*)(a->ws + WS_WKV); bf16* Win = (bf16*)(a->ws + WS_WIN); bf16* Wout = (bf16*)(a->ws + WS_WOUT); bf16* Wq = (bf16*)(a->ws + WS_WQ); bf16* Wo = (bf16*)(a->ws + WS_WO);
    bf16* Wgu = (bf16*)(a->ws + WS_WGU); bf16* Wd = (bf16*)(a->ws + WS_WD);
    constexpr int I_IN = 16 * 129, I_OUT = 32 * 32, I_SQ = 16 * 32, I_G = 16 * 88, I_DN = 44 * 32;
    constexpr int PER_L = I_IN + I_OUT + 4 * I_SQ + 2 * I_G + I_DN;
    auto decode = [&](int it) -> TI {
        const int l = it / PER_L; int r = it % PER_L; TI t; t.goff = 0; t.row_off = 0; t.gain = nullptr; t.mode = 0;
        if (r < I_IN) { const int kb = r / 129, nb = r % 129; t.W = a->in[11] + (size_t)l * 1024 * NIN; t.K = 1024; t.N = NIN; t.k0 = 64 * kb; t.kd0 = 64 * kb; t.n0 = 32 * nb; t.WT = Win + (size_t)l * WIN_L; t.mode = 1; t.gain = a->in[10] + (size_t)l * 1024; return t; } r -= I_IN;
        if (r < I_OUT) { const int kb = r / 32, nb = r % 32; t.W = a->in[27] + (size_t)l * 2048 * 1024; t.K = 2048; t.N = 1024; t.k0 = 64 * kb; t.kd0 = 64 * kb; t.n0 = 32 * nb; t.WT = Wout + (size_t)l * WOUT_L; if (kb >= 8 && kb < 24) { t.gain = a->in[19] + (size_t)l * 1024; t.goff = 512; t.kd0 = 64 * (kb - 8); } else if (kb < 8) t.kd0 = 64 * (kb + 16); return t; } r -= I_OUT;
        if (r < I_SQ) { const int kb = r / 32, nb = r % 32; t.W = a->in[29] + (size_t)l * 1024 * 1024; t.K = 1024; t.N = 1024; t.k0 = 64 * kb; t.kd0 = 64 * kb; t.n0 = 32 * nb; t.WT = Wq + (size_t)l * WQ_L; t.gain = a->in[28] + (size_t)l * 1024; return t; } r -= I_SQ;
        if (r < I_SQ) { const int kb = r / 32, nb = r % 32; t.W = a->in[30] + (size_t)l * 1024 * 1024; t.K = 1024; t.N = 1024; t.k0 = 64 * kb; t.kd0 = 64 * kb; t.n0 = 32 * nb; t.WT = Wkv; t.row_off = l * 2048; return t; } r -= I_SQ;
        if (r < I_SQ) { const int kb = r / 32, nb = r % 32; t.W = a->in[31] + (size_t)l * 1024 * 1024; t.K = 1024; t.N = 1024; t.k0 = 64 * kb; t.kd0 = 64 * kb; t.n0 = 32 * nb; t.WT = Wkv; t.row_off = l * 2048 + 1024; return t; } r -= I_SQ;
        if (r < I_SQ) { const int kb = r / 32, nb = r % 32; t.W = a->in[32] + (size_t)l * 1024 * 1024; t.K = 1024; t.N = 1024; t.k0 = 64 * kb; t.kd0 = 64 * kb; t.n0 = 32 * nb; t.WT = Wo + (size_t)l * WQ_L; return t; } r -= I_SQ;
        if (r < I_G) { const int kb = r / 88, nb = r % 88; t.W = a->in[34] + (size_t)l * 1024 * DFF; t.K = 1024; t.N = DFF; t.k0 = 64 * kb; t.kd0 = 64 * kb; t.n0 = 32 * nb; t.WT = Wgu + (size_t)l * WGU_L; t.mode = 2; t.gain = a->in[33] + (size_t)l * 1024; return t; } r -= I_G;
        if (r < I_G) { const int kb = r / 88, nb = r % 88; t.W = a->in[35] + (size_t)l * 1024 * DFF; t.K = 1024; t.N = DFF; t.k0 = 64 * kb; t.kd0 = 64 * kb; t.n0 = 32 * nb; t.WT = Wgu + (size_t)l * WGU_L; t.mode = 2; t.row_off = 128; t.gain = a->in[33] + (size_t)l * 1024; return t; } r -= I_G;
        { const int kb = r / 32, nb = r % 32; t.W = a->in[36] + (size_t)l * DFF * 1024; t.K = DFF; t.N = 1024; t.k0 = 64 * kb; t.kd0 = 64 * kb; t.n0 = 32 * nb; t.WT = Wd + (size_t)l * WD_L; return t; }
    };
    if (gw < DEPTH * PER_L) {
        int it = gw; TI cur = decode(it); f32x4 v[8]; float gn[8]; ti_load(cur, v, gn, F.lane);
        for (;;) {
            const int nit = it + NGW; const bool has = nit < DEPTH * PER_L;
            TI nxt = cur; f32x4 vn[8]; float gnn[8];
            if (has) { nxt = decode(nit); ti_load(nxt, vn, gnn, F.lane); }
            ti_store(cur, v, gn, scr, F.lane);
            if (!has) break;
            cur = nxt; it = nit;
#pragma unroll
            for (int i = 0; i < 8; ++i) { v[i] = vn[i]; gn[i] = gnn[i]; }
        }
    }
    { bf16* pwt = (bf16*)(a->ws + WS_PWT);
      for (size_t i = (size_t)F.bid * NTHR + F.tid; i < (size_t)DEPTH * 4 * 128 * 128; i += (size_t)F.G * NTHR) { const int c = (int)(i & 127), d = (int)((i >> 7) & 127), lg = (int)(i >> 14);
          pwt[i] = (bf16)f2bfh(a->in[12][((size_t)lg * 128 + c) * 128 + d] * a->in[13][(size_t)lg * 128 + d]); } }
    const size_t gt = (size_t)F.bid * NTHR + F.tid, gs = (size_t)F.G * NTHR;
    { const f32x4* src = (const f32x4*)a->in[2]; unsigned long long* dst = (unsigned long long*)(a->ws + WS_MEMB);
      for (size_t i = gt; i < (size_t)2048 * 1024 / 4; i += gs) { const f32x4 v = src[i]; dst[i] = (unsigned long long)pk2h(v.x, v.y) | ((unsigned long long)pk2h(v.z, v.w) << 32); } }
    { bf16* hb = (bf16*)(a->ws + WS_HB); float* rss = (float*)(a->ws + WS_RSS);
      for (int r0 = gw; r0 < MT; r0 += 4 * NGW) {
          f32x4 v[4][4];
#pragma unroll
          for (int q = 0; q < 4; ++q) { const int r = r0 + q * NGW; const f32x4* src = (const f32x4*)((r < MP ? a->in[0] : a->in[1] - (size_t)MP * D) + (size_t)r * D);
#pragma unroll
              for (int j = 0; j < 4; ++j) v[q][j] = r < MT ? src[F.lane + 64 * j] : (f32x4){0.f, 0.f, 0.f, 0.f}; }
#pragma unroll
          for (int q = 0; q < 4; ++q) { const int r = r0 + q * NGW; float ss = 0.f;
              if (r < MT) {
#pragma unroll
                  for (int j = 0; j < 4; ++j) { const f32x4 x = v[q][j]; ss += x.x * x.x + x.y * x.y + x.z * x.z + x.w * x.w;
                      ((unsigned long long*)(hb + (size_t)r * D))[F.lane + 64 * j] = (unsigned long long)pk2h(x.x, x.y) | ((unsigned long long)pk2h(x.z, x.w) << 32); } }
              ss = wave_sum(ss);
              if (r < MT && F.lane < 16) rss[(size_t)r * 16 + F.lane] = F.lane == 0 ? ss : 0.f; } } }
}

__device__ __forceinline__ void ph_final_norm(Frame& F, const bf16* hb, const float* g, float* Y) {
    const int gw = F.bid * NWAVES + F.wave, NGW = F.G * NWAVES;
    f32x4 gg[4];
#pragma unroll
    for (int j = 0; j < 4; ++j) gg[j] = ((const f32x4*)g)[F.lane + 64 * j];
    for (int r0 = gw; r0 < MT; r0 += 4 * NGW) {
        unsigned long long u[4][4];
#pragma unroll
        for (int q = 0; q < 4; ++q) { const int r = r0 + q * NGW;
#pragma unroll
            for (int j = 0; j < 4; ++j) u[q][j] = r < MT ? ((const unsigned long long*)(hb + (size_t)r * D))[F.lane + 64 * j] : 0ull; }
#pragma unroll
        for (int q = 0; q < 4; ++q) { const int r = r0 + q * NGW; f32x4 v[4]; float ss = 0.f;
#pragma unroll
            for (int j = 0; j < 4; ++j) { const unsigned long long x = u[q][j];
                v[j] = (f32x4){bf2f((unsigned short)x), bf2f((unsigned short)(x >> 16)), bf2f((unsigned short)(x >> 32)), bf2f((unsigned short)(x >> 48))}; ss += v[j].x * v[j].x + v[j].y * v[j].y + v[j].z * v[j].z + v[j].w * v[j].w; }
            ss = wave_sum(ss);
            const float rstd = 1.0f / sqrtf(ss * (1.0f / D) + EPS);
            if (r < MT) {
#pragma unroll
                for (int j = 0; j < 4; ++j) ((f32x4*)(Y + (size_t)r * D))[F.lane + 64 * j] = v[j] * rstd * gg[j]; } }
    }
}

__device__ __forceinline__ float pool_up(const bf16* proj, const float* st_in, const SeqInfo& q, int ci, int ch) {
    if (ci < 15) return q.grp ? st_in[((size_t)q.b * 15 + ci) * 512 + ch] : 0.f;
    return bf2f(proj[(size_t)(q.row0 + ci - 15) * NPJ + OFF_POOL + ch]);
}
__device__ __forceinline__ float conv_xp(const bf16* proj, int off, const float* st_in, int C, const SeqInfo& q, int j, int c) {
    if (j < 3) return q.grp ? st_in[((size_t)q.b * 3 + j) * C + c] : 0.f;
    return bf2f(proj[(size_t)(q.row0 + j - 3) * NPJ + off + c]);
}
__device__ __forceinline__ void conv_states(size_t gt, size_t gs, const bf16* proj, int off, int C, const float* st_in, float* p_out, float* s_out) {
    for (size_t idx = gt; idx < (size_t)NSEQ * 3 * C; idx += gs) {
        const int c = (int)(idx % C), j = (int)((idx / C) % 3), s = (int)(idx / ((size_t)3 * C));
        const SeqInfo q = seq_info(s);
        const float v = conv_xp(proj, off, st_in, C, q, q.L + j, c);
        if (q.grp) s_out[((size_t)q.b * 3 + j) * C + c] = v; else p_out[((size_t)q.b * 3 + j) * C + c] = v;
    }
}
constexpr int SS_X = 0, SS_BC = 8192, SS_DT = 12288;
__device__ __forceinline__ void samp_ssd_item(KP a, Frame& F, int l, int b, int g) {
    LAS float* XS = (LAS float*)(F.lds + RING_OFF + SS_X); LAS float* BC = (LAS float*)(F.lds + RING_OFF + SS_BC); LAS float* DTs = (LAS float*)(F.lds + RING_OFF + SS_DT);
    const int tid = F.tid;
    const bf16* proj = (const bf16*)(a->ws + WS_PROJ) + (size_t)(MP + 4 * b) * NPJ; const float* dtr = (const float*)(a->ws + WS_DT) + (size_t)(MP + 4 * b) * 16;
    const float* cst = a->in[4] + ((size_t)l * 128 + b) * 3 * 1536; const float* cw = a->in[14] + (size_t)l * 4 * 1536; const float* cb = a->in[15] + (size_t)l * 1536;
    bf16* mixb = (bf16*)(a->ws + WS_MIXB) + (size_t)(MP + 4 * b) * 2048;
#pragma unroll
    for (int rep = 0; rep < 2; ++rep) {
        if (rep == 1 && tid >= 256) break;
        const int sc = rep == 0 ? g * 512 + tid : (tid < 128 ? 1024 + g * 128 + tid : 1280 + g * 128 + (tid - 128));
        float xp[7];
#pragma unroll
        for (int j = 0; j < 3; ++j) xp[j] = cst[(size_t)j * 1536 + sc];
#pragma unroll
        for (int t = 0; t < 4; ++t) xp[3 + t] = bf2f(proj[(size_t)t * NPJ + OFF_XBC + sc]);
        const float w0 = cw[sc], w1 = cw[1536 + sc], w2 = cw[2 * 1536 + sc], w3 = cw[3 * 1536 + sc], bb = cb[sc];
#pragma unroll
        for (int t = 0; t < 4; ++t) { const float v = fsilu(bb + w0 * xp[t] + w1 * xp[t + 1] + w2 * xp[t + 2] + w3 * xp[t + 3]); if (rep == 0) XS[t * 512 + tid] = v; else BC[t * 256 + tid] = v; }
    }
    if (tid < 32) { const int t = tid >> 3, k = tid & 7, hd = 8 * g + k; const float dt = softplus_f(dtr[(size_t)t * 16 + hd] + a->in[16][l * 16 + hd]); DTs[t * 8 + k] = dt; DTs[32 + t * 8 + k] = expf(dt * -expf(a->in[17][l * 16 + hd])); }
    __syncthreads();
    const int p = tid >> 3, ng = tid & 7;
    const float* st_in = a->in[5] + (((size_t)l * 128 + b) * 16 + 8 * g) * 64 * 128 + (size_t)p * 128 + ng * 16;
    float* st_out = a->out + O_SSSD + (((size_t)l * 128 + b) * 16 + 8 * g) * 64 * 128 + (size_t)p * 128 + ng * 16;
    f32x4 hn[4];
#pragma unroll
    for (int i = 0; i < 4; ++i) hn[i] = *(const f32x4*)(st_in + 4 * i);
#pragma unroll 1
    for (int k = 0; k < 8; ++k) {
        f32x4 h[4];
#pragma unroll
        for (int i = 0; i < 4; ++i) h[i] = hn[i];
        if (k + 1 < 8) {
#pragma unroll
            for (int i = 0; i < 4; ++i) hn[i] = *(const f32x4*)(st_in + (size_t)(k + 1) * 64 * 128 + 4 * i); }
        const int hd = 8 * g + k; const float Dk = a->in[18][l * 16 + hd];
        float zv[4];
#pragma unroll
        for (int t = 0; t < 4; ++t) zv[t] = bf2f(proj[(size_t)t * NPJ + OFF_Z + hd * 64 + p]);
#pragma unroll
        for (int t = 0; t < 4; ++t) {
            const float dt = DTs[t * 8 + k], dA = DTs[32 + t * 8 + k], x = XS[t * 512 + k * 64 + p], xdt = dt * x;
            float part = 0.f;
#pragma unroll
            for (int i = 0; i < 4; ++i) { const f32x4 Bv = *(const LAS f32x4*)(BC + t * 256 + ng * 16 + 4 * i), Cv = *(const LAS f32x4*)(BC + t * 256 + 128 + ng * 16 + 4 * i);
                h[i] = h[i] * dA + Bv * xdt; part += (Cv.x * h[i].x + Cv.y * h[i].y) + (Cv.z * h[i].z + Cv.w * h[i].w); }
            part += __shfl_xor(part, 1); part += __shfl_xor(part, 2); part += __shfl_xor(part, 4);
            if (ng == 0) mixb[(size_t)t * 2048 + hd * 64 + p] = (bf16)f2bfh((part + Dk * x) * fsilu(zv[t]));
        }
#pragma unroll
        for (int i = 0; i < 4; ++i) *(f32x4*)(st_out + (size_t)k * 64 * 128 + 4 * i) = h[i];
    }
    __syncthreads();
}
__device__ __forceinline__ void samp_lru_item(KP a, Frame& F, int l, int b) {
    LAS float* XC = (LAS float*)(F.lds + RING_OFF);
    const int c = F.tid, hd = c >> 6, j = c & 63;
    const bf16* proj = (const bf16*)(a->ws + WS_PROJ) + (size_t)(MP + 4 * b) * NPJ;
    const float* cst = a->in[6] + ((size_t)l * 128 + b) * 3 * 512; const float* cw = a->in[20] + (size_t)l * 4 * 512;
    float xp[7];
#pragma unroll
    for (int k = 0; k < 3; ++k) xp[k] = cst[(size_t)k * 512 + c];
#pragma unroll
    for (int t = 0; t < 4; ++t) xp[3 + t] = bf2f(proj[(size_t)t * NPJ + OFF_LRU + c]);
    const float w0 = cw[c], w1 = cw[512 + c], w2 = cw[1024 + c], w3 = cw[1536 + c], bb = a->in[21][(size_t)l * 512 + c];
    float xc[4];
#pragma unroll
    for (int t = 0; t < 4; ++t) { xc[t] = bb + w0 * xp[t] + w1 * xp[t + 1] + w2 * xp[t + 2] + w3 * xp[t + 3]; XC[t * 512 + c] = xc[t]; }
    __syncthreads();
    const float* wa = a->in[22] + ((size_t)l * 8 + hd) * 64 * 64 + j; const float* wx = a->in[24] + ((size_t)l * 8 + hd) * 64 * 64 + j;
    float ar[4], ai[4], gz[4];
#pragma unroll
    for (int t = 0; t < 4; ++t) { ar[t] = a->in[23][(size_t)l * 512 + c]; ai[t] = a->in[25][(size_t)l * 512 + c]; gz[t] = bf2f(proj[(size_t)t * NPJ + OFF_GATE + c]); }
    const float lamv = a->in[26][(size_t)l * 512 + c]; float h = a->in[7][((size_t)l * 128 + b) * 512 + c];
#pragma unroll 16
    for (int i = 0; i < 64; ++i) { const float wav = wa[(size_t)i * 64], wxv = wx[(size_t)i * 64];
#pragma unroll
        for (int t = 0; t < 4; ++t) { const float xv = XC[t * 512 + hd * 64 + i]; ar[t] += xv * wav; ai[t] += xv * wxv; } }
    const float spv = -8.0f * softplus_f(-lamv);
    bf16* mixb = (bf16*)(a->ws + WS_MIXB) + (size_t)(MP + 4 * b) * 2048 + 1536 + c;
#pragma unroll
    for (int t = 0; t < 4; ++t) { const float rg = sigmoid_f(ar[t]), ig = sigmoid_f(ai[t]); const float log_a = spv * rg; const float av = expf(log_a), mult = sqrtf(-expm1f(2.0f * log_a));
        h = av * h + mult * ig * xc[t];
        mixb[(size_t)t * 2048] = (bf16)f2bfh(h * gelu_tanh_f(gz[t])); }
    a->out[O_SLRU + ((size_t)l * 128 + b) * 512 + c] = h;
    __syncthreads();
}
__device__ __forceinline__ void samp_pool_item(KP a, Frame& F, int l, int b) {
    LAS float* PO = (LAS float*)(F.lds + RING_OFF);
    const int ch = F.tid, g = ch >> 7, w = 2 << g;
    const bf16* proj = (const bf16*)(a->ws + WS_PROJ) + (size_t)(MP + 4 * b) * NPJ;
    const float* st = a->in[3] + ((size_t)l * 128 + b) * 15 * 512;
    float up[19];
#pragma unroll
    for (int i = 0; i < 15; ++i) up[i] = st[(size_t)i * 512 + ch];
#pragma unroll
    for (int t = 0; t < 4; ++t) up[15 + t] = bf2f(proj[(size_t)t * NPJ + OFF_POOL + ch]);
    const float iw = 1.0f / (float)w;
#pragma unroll
    for (int t = 0; t < 4; ++t) { float sm = 0.f;
#pragma unroll
        for (int jj = 0; jj < 16; ++jj) sm += (jj < w) ? up[15 + t - jj] : 0.f;
        PO[t * 512 + ch] = sm * iw - up[15 + t]; }
    __syncthreads();
    const int d = ch & 127; const bf16* pwr = (const bf16*)(a->ws + WS_PWT) + (((size_t)l * 4 + g) * 128 + d) * 128;
    v4u wr[16];
#pragma unroll
    for (int q = 0; q < 16; ++q) wr[q] = *(const GAS v4u*)(pwr + 8 * q);
    float acc[4] = {0.f, 0.f, 0.f, 0.f};
#pragma unroll
    for (int q = 0; q < 16; ++q) { f32x4 w0, w1; cvt8(wr[q], w0, w1);
#pragma unroll
        for (int t = 0; t < 4; ++t) { const f32x4 p0 = *(const LAS f32x4*)(PO + t * 512 + g * 128 + 8 * q), p1 = *(const LAS f32x4*)(PO + t * 512 + g * 128 + 8 * q + 4);
            acc[t] += (p0.x * w0.x + p0.y * w0.y) + (p0.z * w0.z + p0.w * w0.w) + (p1.x * w1.x + p1.y * w1.y) + (p1.z * w1.z + p1.w * w1.w); } }
    bf16* mixb = (bf16*)(a->ws + WS_MIXB) + (size_t)(MP + 4 * b) * 2048 + 1024 + ch;
#pragma unroll
    for (int t = 0; t < 4; ++t) mixb[(size_t)t * 2048] = (bf16)f2bfh(acc[t]);
    __syncthreads();
}

__device__ __forceinline__ void ph_mix1(KP a, Frame& F, int l) {
    const size_t gt = (size_t)F.bid * NTHR + F.tid, gs = (size_t)F.G * NTHR;
    const bf16* proj = (const bf16*)(a->ws + WS_PROJ);
    {
        const float* st_in = a->in[3] + (size_t)l * 128 * 15 * 512;
        float* pp_out = a->out + O_PPOOL + (size_t)l * 8 * 15 * 512; float* ps_out = a->out + O_SPOOL + (size_t)l * 128 * 15 * 512;
        float* cp_out = a->out + O_PSCONV + (size_t)l * 8 * 3 * 1536; float* cs_out = a->out + O_SSCONV + (size_t)l * 128 * 3 * 1536;
        float* lp_out = a->out + O_PLCONV + (size_t)l * 8 * 3 * 512; float* ls_out = a->out + O_SLCONV + (size_t)l * 128 * 3 * 512;
        constexpr int NA = (8 * 15 + 128 * 4) * 64, NB = 128 * 11 * 128, NC = NSEQ * 3 * 192, ND = NSEQ * 3 * 64;
        auto srcA = [&](int idx) -> const bf16* { const int c8 = idx & 63, r = idx >> 6; int row; if (r < 120) { const int b = r / 15, j = r - 15 * b; row = b * 2048 + 2033 + j; } else { const int r2 = r - 120; row = MP + r2; } return proj + (size_t)row * NPJ + OFF_POOL + 8 * c8; };
        auto dstA = [&](int idx) -> float* { const int c8 = idx & 63, r = idx >> 6; if (r < 120) return pp_out + (size_t)r * 512 + 8 * c8; const int r2 = r - 120, b = r2 >> 2, jj = r2 & 3; return ps_out + ((size_t)b * 15 + 11 + jj) * 512 + 8 * c8; };
        auto srcB = [&](int idx) -> const float* { const int c4 = idx & 127, r = idx >> 7, b = r / 11, j = r - 11 * b; return st_in + ((size_t)b * 15 + j + 4) * 512 + 4 * c4; };
        auto dstB = [&](int idx) -> float* { const int c4 = idx & 127, r = idx >> 7, b = r / 11, j = r - 11 * b; return ps_out + ((size_t)b * 15 + j) * 512 + 4 * c4; };
        auto srcC = [&](int idx, int C8, int off) -> const bf16* { const int c8 = idx % C8, r = idx / C8, sq = r / 3, j = r - 3 * sq; const int row = sq < 8 ? sq * 2048 + 2045 + j : MP + (sq - 8) * 4 + 1 + j; return proj + (size_t)row * NPJ + off + 8 * c8; };
        auto dstC = [&](int idx, int C8, float* po, float* so) -> float* { const int c8 = idx % C8, r = idx / C8, sq = r / 3, j = r - 3 * sq; return sq < 8 ? po + ((size_t)sq * 3 + j) * (8 * C8) + 8 * c8 : so + ((size_t)(sq - 8) * 3 + j) * (8 * C8) + 8 * c8; };
        auto put8 = [&](float* o, const v4u& u) { f32x4 v0, v1; cvt8(u, v0, v1); *(f32x4*)o = v0; *(f32x4*)(o + 4) = v1; };
        const int t0_ = (int)gt, n_ = (int)gs;
        v4u uA = (v4u){0u, 0u, 0u, 0u}, uC = uA, uD = uA; f32x4 fB0 = (f32x4){0.f, 0.f, 0.f, 0.f}, fB1 = fB0;
        if (t0_ < NA) uA = *(const GAS v4u*)srcA(t0_);
        if (t0_ < NB) fB0 = *(const f32x4*)srcB(t0_);
        if (t0_ + n_ < NB) fB1 = *(const f32x4*)srcB(t0_ + n_);
        if (t0_ < NC) uC = *(const GAS v4u*)srcC(t0_, 192, OFF_XBC);
        if (t0_ < ND) uD = *(const GAS v4u*)srcC(t0_, 64, OFF_LRU);
        if (t0_ < NA) put8(dstA(t0_), uA);
        if (t0_ < NB) *(f32x4*)dstB(t0_) = fB0;
        if (t0_ + n_ < NB) *(f32x4*)dstB(t0_ + n_) = fB1;
        if (t0_ < NC) put8(dstC(t0_, 192, cp_out, cs_out), uC);
        if (t0_ < ND) put8(dstC(t0_, 64, lp_out, ls_out), uD);
        for (int idx = t0_ + n_; idx < NA; idx += n_) { const v4u u = *(const GAS v4u*)srcA(idx); put8(dstA(idx), u); }
        for (int idx = t0_ + 2 * n_; idx < NB; idx += n_) *(f32x4*)dstB(idx) = *(const f32x4*)srcB(idx);
        for (int idx = t0_ + n_; idx < NC; idx += n_) { const v4u u = *(const GAS v4u*)srcC(idx, 192, OFF_XBC); put8(dstC(idx, 192, cp_out, cs_out), u); }
        for (int idx = t0_ + n_; idx < ND; idx += n_) { const v4u u = *(const GAS v4u*)srcC(idx, 64, OFF_LRU); put8(dstC(idx, 64, lp_out, ls_out), u); }
    }
    __syncthreads();
    { const KP kp = a; (void)kp;
    REG_BEGIN(0);
    for (int it = F.vcu; it < 256; it += F.G) ssd_prompt_item(a, F, l, it >> 5, (it >> 1) & 15, it & 1);
    REG_END(0); REG_BEGIN(1);
    for (int it = F.vcu; it < 256; it += F.G) lru_prompt_item(a, F, l, it >> 5, (it >> 2) & 7, it & 3);
    REG_END(1); }
    for (int it = F.vcu; it < 512; it += F.G) pool_prompt_item(a, F, l, it >> 6, (it >> 2) & 15, it & 3);
    for (int it = F.bid; it < 256; it += F.G) samp_ssd_item(a, F, l, it >> 1, it & 1);
    for (int it = F.bid; it < 256; it += F.G) { if (it < 128) samp_lru_item(a, F, l, it); else samp_pool_item(a, F, l, it - 128); }
}
__device__ __forceinline__ void ph_mix3(KP a, Frame& F, int l) {
    bf16* mixb = (bf16*)(a->ws + WS_MIXB);
    const int gw = F.bid * NWAVES + F.wave, NGW = F.G * NWAVES;
    for (int r = gw; r < MP; r += NGW) {
        const float* sp = (const float*)(a->ws + WS_SSDSS) + (size_t)r * 32;
        float ss = F.lane < 32 ? sp[F.lane] : 0.f; ss = wave_sum(ss);
        const float rstd = 1.0f / sqrtf(ss * (1.0f / 1024.f) + EPS);
#pragma unroll
        for (int j = 0; j < 4; ++j) { const int c = 4 * F.lane + 256 * j; unsigned long long* mp = (unsigned long long*)(mixb + (size_t)r * 2048 + 512 + c); const unsigned long long u = *mp;
            const float w0 = bf2f((unsigned short)u) * rstd, w1 = bf2f((unsigned short)(u >> 16)) * rstd, w2 = bf2f((unsigned short)(u >> 32)) * rstd, w3 = bf2f((unsigned short)(u >> 48)) * rstd;
            *mp = (unsigned long long)pk2h(w0, w1) | ((unsigned long long)pk2h(w2, w3) << 32); }
    }
}
constexpr int SG_PSTRIDE = 36, SG_P = 0, SG_SS = 8 * 64 * SG_PSTRIDE * 4;
static_assert(SG_SS + 8 * 64 * 4 <= RING_BYTES, "small gemm LDS map");
__device__ __forceinline__ float sumsq8(bf16x8 v) { float s = 0.f;
#pragma unroll
    for (int j = 0; j < 8; ++j) { const float x = bf2f((unsigned short)v[j]); s += x * x; } return s; }
template <int K, int STATS  , class Epi>
__device__ __forceinline__ void small_gemm(Frame& F, const bf16* A, const bf16* Bt, int it0, int it1, const Epi& E) {
    constexpr int KW = K / 8, KS = KW / 32;
    constexpr bool REUSE = Epi::RT_SLOW && K == 1024;
    static_assert(K % 256 == 0, "K splits into eight 32-multiples");
    LAS float* P = (LAS float*)(F.lds + RING_OFF + SG_P); LAS float* SS = (LAS float*)(F.lds + RING_OFF + SG_SS);
    const int w = F.wave;
    bf16x8 afr[REUSE ? KS : 1][4]; float ssqr[4] = {0.f, 0.f, 0.f, 0.f}; int rt_have = -1;
    bf16x8 bq[REUSE ? KS : 1][2]; bool bq_have = false;
    for (int it = it0; it < it1; ++it) {
        int tid = F.tid; asm volatile("" : "+v"(tid));
        const int lane = tid & 63, fr = lane & 15, fq = lane >> 4;
        const int rt = Epi::RT_SLOW ? it / E.nctl : (it & 7), ct = Epi::RT_SLOW ? E.ct0 + it % E.nctl : (it >> 3);
        if (Epi::RT_SLOW && ct >= Epi::NCT) continue;
        int nb0, nb1; E.bases(ct, nb0, nb1);
        const bf16* Ap = A + (size_t)(64 * rt + fr) * K + w * KW + 8 * fq;
        const bf16* Bp0 = Bt + (size_t)(nb0 + fr) * K + w * KW + 8 * fq; const bf16* Bp1 = Bt + (size_t)(nb1 + fr) * K + w * KW + 8 * fq;
        f32x4 acc[4][2]; float ssq[4];
#pragma unroll
        for (int mt = 0; mt < 4; ++mt) { acc[mt][0] = (f32x4){0.f, 0.f, 0.f, 0.f}; acc[mt][1] = (f32x4){0.f, 0.f, 0.f, 0.f}; ssq[mt] = 0.f; }
        if constexpr (REUSE) {
            if (!bq_have) {
#pragma unroll
                for (int ks = 0; ks < KS; ++ks) { bq[ks][0] = *(const bf16x8*)(Bp0 + 32 * ks); bq[ks][1] = *(const bf16x8*)(Bp1 + 32 * ks); } }
            if (rt != rt_have) {
#pragma unroll
                for (int ks = 0; ks < KS; ++ks)
#pragma unroll
                    for (int mt = 0; mt < 4; ++mt) afr[ks][mt] = *(const bf16x8*)(Ap + (size_t)mt * 16 * K + 32 * ks);
#pragma unroll
                for (int mt = 0; mt < 4; ++mt) { float sv = 0.f;
#pragma unroll
                    for (int ks = 0; ks < KS; ++ks) sv += sumsq8(afr[ks][mt]);
                    ssqr[mt] = sv; }
                rt_have = rt;
            }
#pragma unroll
            for (int ks = 0; ks < KS; ++ks)
#pragma unroll
                for (int mt = 0; mt < 4; ++mt) { acc[mt][0] = MFMA16(afr[ks][mt], bq[ks][0], acc[mt][0]); acc[mt][1] = MFMA16(afr[ks][mt], bq[ks][1], acc[mt][1]); }
#pragma unroll
            for (int mt = 0; mt < 4; ++mt) ssq[mt] = ssqr[mt];
            bq_have = false;
            if (it + 1 < it1) { const int ct2 = E.ct0 + (it + 1) % E.nctl;
                if (ct2 < Epi::NCT) { int nc0, nc1; E.bases(ct2, nc0, nc1); const bf16* Bq0 = Bt + (size_t)(nc0 + fr) * K + w * KW + 8 * fq; const bf16* Bq1 = Bt + (size_t)(nc1 + fr) * K + w * KW + 8 * fq;
#pragma unroll
                    for (int ks = 0; ks < KS; ++ks) { bq[ks][0] = *(const bf16x8*)(Bq0 + 32 * ks); bq[ks][1] = *(const bf16x8*)(Bq1 + 32 * ks); }
                    bq_have = true; } }
        } else {
#pragma unroll
            for (int ks = 0; ks < KS; ++ks) {
                bf16x8 af[4];
#pragma unroll
                for (int mt = 0; mt < 4; ++mt) af[mt] = *(const bf16x8*)(Ap + (size_t)mt * 16 * K + 32 * ks);
                const bf16x8 b0 = *(const bf16x8*)(Bp0 + 32 * ks), b1 = *(const bf16x8*)(Bp1 + 32 * ks);
#pragma unroll
                for (int mt = 0; mt < 4; ++mt) { acc[mt][0] = MFMA16(af[mt], b0, acc[mt][0]); acc[mt][1] = MFMA16(af[mt], b1, acc[mt][1]); if (STATS == 1 || (STATS == 2 && w < 4)) ssq[mt] += sumsq8(af[mt]); }
            }
        }
#pragma unroll
        for (int mt = 0; mt < 4; ++mt) {
#pragma unroll
            for (int nt = 0; nt < 2; ++nt)
#pragma unroll
                for (int e = 0; e < 4; ++e) P[(w * 64 + 16 * mt + 4 * fq + e) * SG_PSTRIDE + 16 * nt + fr] = acc[mt][nt][e];
            if (STATS) { float sv = ssq[mt]; sv += __shfl_xor(sv, 16); sv += __shfl_xor(sv, 32); if (fq == 0) SS[w * 64 + 16 * mt + fr] = sv; }
        }
        __syncthreads();
        {
            const int row = tid >> 3, cq = tid & 7;
            f32x4 v = (f32x4){0.f, 0.f, 0.f, 0.f}, v2 = v;
            float rstd = 1.f;
            if (STATS) { float sm = 0.f;
#pragma unroll
                for (int ww = 0; ww < 8; ++ww) sm += SS[ww * 64 + row];
                rstd = 1.0f / sqrtf(sm * (1.0f / 1024.f) + EPS); }
#pragma unroll
            for (int ww = 0; ww < 8; ++ww) { const float sc = (STATS == 2 && ww < 4) ? rstd : 1.f;
                v += *(const LAS f32x4*)(P + (ww * 64 + row) * SG_PSTRIDE + 4 * cq) * sc; if (Epi::PAIR) v2 += *(const LAS f32x4*)(P + (ww * 64 + row) * SG_PSTRIDE + 4 * (cq ^ 4)); }
            if (STATS == 2) rstd = 1.f;
            E.store(ct, MP + 64 * rt + row, cq, v, v2, rstd);
        }
        __syncthreads();
    }
}
struct SProj {
    static constexpr bool PAIR = false, RT_SLOW = true; static constexpr int NCT = 129; bf16* proj; float* dtr; int ct0, nctl;
    __device__ __forceinline__ void bases(int ct, int& nb0, int& nb1) const { nb0 = 32 * ct; nb1 = nb0 + 16; }
    __device__ __forceinline__ void store(int ct, int row, int cq, f32x4 v, f32x4, float rstd) const { const int j = 32 * ct + 4 * cq; const f32x4 o = v * rstd;
        if (j < 4096) *(unsigned long long*)(proj + (size_t)row * NPJ + j) = (unsigned long long)pk2h(o.x, o.y) | ((unsigned long long)pk2h(o.z, o.w) << 32);
        else if (j < 4112) *(f32x4*)(dtr + (size_t)row * 16 + (j - 4096)) = o; }
};
struct SResid {
    static constexpr bool PAIR = false, RT_SLOW = false; static constexpr int NCT = 32, ct0 = 0, nctl = 1; bf16* hb;
    __device__ __forceinline__ void bases(int ct, int& nb0, int& nb1) const { nb0 = 32 * ct; nb1 = nb0 + 16; }
    __device__ __forceinline__ void store(int ct, int row, int cq, f32x4 v, f32x4, float) const { const int c = 32 * ct + 4 * cq; unsigned long long* hp = (unsigned long long*)(hb + (size_t)row * 1024 + c); const unsigned long long u = *hp;
        const float o0 = bf2f((unsigned short)u) + v.x, o1 = bf2f((unsigned short)(u >> 16)) + v.y, o2 = bf2f((unsigned short)(u >> 32)) + v.z, o3 = bf2f((unsigned short)(u >> 48)) + v.w;
        *hp = (unsigned long long)pk2h(o0, o1) | ((unsigned long long)pk2h(o2, o3) << 32); }
};
struct SQ {
    static constexpr bool PAIR = false, RT_SLOW = false; static constexpr int NCT = 32, ct0 = 0, nctl = 1; bf16* qb; float scale;
    __device__ __forceinline__ void bases(int ct, int& nb0, int& nb1) const { nb0 = 32 * ct; nb1 = nb0 + 16; }
    __device__ __forceinline__ void store(int ct, int row, int cq, f32x4 v, f32x4, float rstd) const { const int c = 32 * ct + 4 * cq; const f32x4 o = v * (rstd * scale);
        *(unsigned long long*)(qb + (size_t)row * 1024 + c) = (unsigned long long)pk2h(o.x, o.y) | ((unsigned long long)pk2h(o.z, o.w) << 32); }
};
struct SSwiGLU {
    static constexpr bool PAIR = true, RT_SLOW = true; static constexpr int NCT = 176; bf16* act; int ct0, nctl;
    __device__ __forceinline__ void bases(int ct, int& nb0, int& nb1) const { nb0 = 256 * (ct >> 3) + 16 * (ct & 7); nb1 = nb0 + 128; }
    __device__ __forceinline__ void store(int ct, int row, int cq, f32x4 g, f32x4 u, float rstd) const { if (cq < 4) { const int c = 128 * (ct >> 3) + 16 * (ct & 7) + 4 * cq; const f32x4 gs = g * rstd, us = u * rstd;
        *(unsigned long long*)(act + (size_t)row * DFF + c) = (unsigned long long)pk2h(fsilu(gs.x) * us.x, fsilu(gs.y) * us.y) | ((unsigned long long)pk2h(fsilu(gs.z) * us.z, fsilu(gs.w) * us.w) << 32); } }
};
__device__ __forceinline__ void dt_gemm(Frame& F, const bf16* hb, const bf16* Wdt, const float* rss, float* dtr) {
    for (int it = F.bid; it < MP / 128; it += F.G) {
        int tid = F.tid; asm volatile("" : "+v"(tid)); const int lane = tid & 63, fr = lane & 15, fq = lane >> 4;
        const int row0 = it * 128 + 16 * F.wave;
        f32x4 acc = (f32x4){0.f, 0.f, 0.f, 0.f};
#pragma unroll 8
        for (int ks = 0; ks < 32; ++ks) { const bf16x8 af = *(const bf16x8*)(hb + (size_t)(row0 + fr) * 1024 + 32 * ks + 8 * fq); const bf16x8 bfm = *(const bf16x8*)(Wdt + (size_t)fr * 1024 + 32 * ks + 8 * fq); acc = MFMA16(af, bfm, acc); }
#pragma unroll
        for (int e = 0; e < 4; ++e) { const int row = row0 + 4 * fq + e; const f32x4* rp = (const f32x4*)(rss + (size_t)row * 16); const f32x4 p0 = rp[0], p1 = rp[1], p2 = rp[2], p3 = rp[3];
            const float sm = ((p0.x + p0.y) + (p0.z + p0.w)) + ((p1.x + p1.y) + (p1.z + p1.w)) + ((p2.x + p2.y) + (p2.z + p2.w)) + ((p3.x + p3.y) + (p3.z + p3.w));
            dtr[(size_t)row * 16 + fr] = acc[e] * (1.0f / sqrtf(sm * (1.0f / 1024.f) + EPS)); }
    }
}

__device__ __forceinline__ void attn_prompt_unit(Frame& F, const bf16* qb, const bf16* kb_l, const bf16* vt_l, bf16* ob, int b, int hh, int qt) {
    LAS unsigned char* lds = F.lds + RING_OFF;
    const int lane = F.lane, fr = lane & 15, fq = lane >> 4, tid = F.tid;
    const int r0 = b * 2048 + qt * 256 + F.wave * 32;
    const bf16* kbase = kb_l + (size_t)(b * 256) * 1024 + hh * 256; const bf16* vbase = vt_l + (size_t)(hh * 256) * 2048 + b * 256;
    v4u rg[8];
#define ATT_LOAD(base, pitch, half) do { const bf16* tb_ = (base); asm volatile("" : "+s"(tb_)); tb_ += (size_t)((half) * 128 + (tid >> 5)) * (pitch) + (tid & 31) * 8; \
        _Pragma("unroll") for (int ps = 0; ps < 8; ++ps) rg[ps] = *(const GAS v4u*)(tb_ + (size_t)ps * 16 * (pitch)); } while (0)
#define ATT_STORE(bufoff) do { LAS unsigned char* lb_ = lds + (bufoff) + (tid >> 5) * 512 + (((tid & 31) ^ ((tid >> 5) & 15)) << 4); \
        _Pragma("unroll") for (int ps = 0; ps < 8; ++ps) *(LAS v4u*)(lb_ + ps * 8192) = rg[ps]; } while (0)
    ATT_LOAD(kbase, 1024, 0); ATT_STORE(0);
    ATT_LOAD(kbase, 1024, 1); ATT_STORE(65536);
    LBAR();
    bf16x8 pf[2][8]; float inv[2];
#pragma unroll
    for (int mt = 0; mt < 2; ++mt) {
        __builtin_amdgcn_sched_barrier(0);
        bf16x8 qf[8];
#pragma unroll
        for (int ks = 0; ks < 8; ++ks) qf[ks] = *(const bf16x8*)(qb + (size_t)(r0 + mt * 16 + fr) * 1024 + hh * 256 + ks * 32 + fq * 8);
        f32x4 s[16];
#pragma unroll
        for (int kt = 0; kt < 16; ++kt) { s[kt] = (f32x4){0.f, 0.f, 0.f, 0.f};
#pragma unroll
            for (int kh = 0; kh < 2; ++kh) { bf16x8 kf[4];
#pragma unroll
                for (int ks = 0; ks < 4; ++ks) kf[ks] = *(const LAS bf16x8*)(lds + (16 * kt + fr) * 512 + (((4 * (4 * kh + ks) + fq) ^ fr) << 4));
#pragma unroll
                for (int ks = 0; ks < 4; ++ks) s[kt] = MFMA16(kf[ks], qf[4 * kh + ks], s[kt]);
                __builtin_amdgcn_sched_barrier(0); } }
        float m = -3.0e38f;
#pragma unroll
        for (int kt = 0; kt < 16; ++kt) m = fmaxf(fmaxf(fmaxf(s[kt][0], s[kt][1]), fmaxf(s[kt][2], s[kt][3])), m);
        m = fmaxf(m, __shfl_xor(m, 16)); m = fmaxf(m, __shfl_xor(m, 32));
        float sum = 0.f;
#pragma unroll
        for (int kt = 0; kt < 16; ++kt)
#pragma unroll
            for (int e = 0; e < 4; ++e) { const float p = __builtin_amdgcn_exp2f(s[kt][e] - m); s[kt][e] = p; sum += p; }
        sum += __shfl_xor(sum, 16); sum += __shfl_xor(sum, 32);
        inv[mt] = 1.0f / sum;
#pragma unroll
        for (int ks = 0; ks < 8; ++ks) { v4u w; w.x = pk2h(s[2 * ks][0], s[2 * ks][1]); w.y = pk2h(s[2 * ks][2], s[2 * ks][3]);
            w.z = pk2h(s[2 * ks + 1][0], s[2 * ks + 1][1]); w.w = pk2h(s[2 * ks + 1][2], s[2 * ks + 1][3]); pf[mt][ks] = __builtin_bit_cast(bf16x8, w); }
        __builtin_amdgcn_sched_barrier(0);
    }
    LBAR();
    ATT_LOAD(vbase, 2048, 0); ATT_STORE(0); ATT_LOAD(vbase, 2048, 1); ATT_STORE(65536);
    LBAR();
#pragma unroll
    for (int qr = 0; qr < 4; ++qr) {
        const int bo = (qr >> 1) * 65536;
        f32x4 o[2][4];
#pragma unroll
        for (int dl = 0; dl < 4; ++dl) { o[0][dl] = (f32x4){0.f, 0.f, 0.f, 0.f}; o[1][dl] = (f32x4){0.f, 0.f, 0.f, 0.f};
#pragma unroll
            for (int kh = 0; kh < 2; ++kh) { bf16x8 vf[4];
#pragma unroll
                for (int ks = 0; ks < 4; ++ks) vf[ks] = *(const LAS bf16x8*)(lds + bo + (16 * ((qr & 1) * 4 + dl) + fr) * 512 + (((4 * (4 * kh + ks) + fq) ^ fr) << 4));
#pragma unroll
                for (int ks = 0; ks < 4; ++ks) { o[0][dl] = MFMA16(vf[ks], pf[0][4 * kh + ks], o[0][dl]); o[1][dl] = MFMA16(vf[ks], pf[1][4 * kh + ks], o[1][dl]); }
                __builtin_amdgcn_sched_barrier(0); } }
#pragma unroll
        for (int mt = 0; mt < 2; ++mt)
#pragma unroll
            for (int dl = 0; dl < 4; ++dl) { const f32x4 v = o[mt][dl] * inv[mt];
                *(unsigned long long*)(ob + (size_t)(r0 + mt * 16 + fr) * 1024 + hh * 256 + 16 * (qr * 4 + dl) + 4 * fq) = (unsigned long long)pk2h(v[0], v[1]) | ((unsigned long long)pk2h(v[2], v[3]) << 32); }
        __builtin_amdgcn_sched_barrier(0);
    }
#undef ATT_LOAD
#undef ATT_STORE
    __syncthreads();
}
__device__ __forceinline__ void attn_sample_item(Frame& F, const bf16* qb, const float* Ks_l, const float* Vs_l, bf16* ob, int b, int hh) {
    LAS float* Sl = (LAS float*)(F.lds + RING_OFF);
    LAS float* Ol = (LAS float*)(F.lds + RING_OFF + 4096);
    const int lane = F.lane, w = F.wave, d4 = 4 * lane;
    const float* Kb = Ks_l + (size_t)b * 256 * 1024 + hh * 256 + d4;
    const float* Vb = Vs_l + (size_t)b * 256 * 1024 + hh * 256 + d4;
    f32x4 q[4];
#pragma unroll
    for (int t = 0; t < 4; ++t) { const unsigned long long u = *(const unsigned long long*)(qb + (size_t)(MP + 4 * b + t) * 1024 + hh * 256 + d4);
        q[t] = (f32x4){bf2f((unsigned short)u), bf2f((unsigned short)(u >> 16)), bf2f((unsigned short)(u >> 32)), bf2f((unsigned short)(u >> 48))}; }
#pragma unroll
    for (int bt = 0; bt < 2; ++bt) {
        f32x4 kv[16];
#pragma unroll
        for (int kk = 0; kk < 16; ++kk) kv[kk] = *(const f32x4*)(Kb + (size_t)(32 * w + 16 * bt + kk) * 1024);
        float v[64];
#pragma unroll
        for (int kk = 0; kk < 16; ++kk)
#pragma unroll
            for (int t = 0; t < 4; ++t) v[kk * 4 + t] = kv[kk].x * q[t].x + kv[kk].y * q[t].y + kv[kk].z * q[t].z + kv[kk].w * q[t].w;
#pragma unroll
        for (int mk = 32, n = 32; mk >= 1; mk >>= 1, n >>= 1) {
            const bool up = (lane & mk) != 0;
#pragma unroll
            for (int i = 0; i < n; ++i) { const float lo = v[i], hi = v[i + n]; const float send = up ? lo : hi, keep = up ? hi : lo; v[i] = keep + __shfl_xor(send, mk); }
        }
        Sl[(lane & 3) * 256 + 32 * w + 16 * bt + (lane >> 2)] = v[0];
    }
    __syncthreads();
    if (w < 4) {
        float x[4];
#pragma unroll
        for (int j = 0; j < 4; ++j) x[j] = Sl[w * 256 + lane + 64 * j];
        const float m = wave_max(fmaxf(fmaxf(x[0], x[1]), fmaxf(x[2], x[3])));
        float sum = 0.f;
#pragma unroll
        for (int j = 0; j < 4; ++j) { x[j] = __builtin_amdgcn_exp2f(x[j] - m); sum += x[j]; }
        sum = wave_sum(sum);
        const float inv = 1.0f / sum;
#pragma unroll
        for (int j = 0; j < 4; ++j) Sl[w * 256 + lane + 64 * j] = x[j] * inv;
    }
    __syncthreads();
    f32x4 acc[4];
#pragma unroll
    for (int t = 0; t < 4; ++t) acc[t] = (f32x4){0.f, 0.f, 0.f, 0.f};
#pragma unroll
    for (int bt = 0; bt < 2; ++bt) {
        f32x4 vv[16];
#pragma unroll
        for (int kk = 0; kk < 16; ++kk) vv[kk] = *(const f32x4*)(Vb + (size_t)(32 * w + 16 * bt + kk) * 1024);
#pragma unroll
        for (int kk = 0; kk < 16; ++kk)
#pragma unroll
            for (int t = 0; t < 4; ++t) acc[t] += vv[kk] * Sl[t * 256 + 32 * w + 16 * bt + kk];
    }
#pragma unroll
    for (int t = 0; t < 4; ++t) *(LAS f32x4*)(Ol + (w * 4 + t) * 256 + d4) = acc[t];
    __syncthreads();
    {
        const int t = F.tid >> 7, d = (F.tid & 127) * 2;
        float o0 = 0.f, o1 = 0.f;
#pragma unroll
        for (int ww = 0; ww < 8; ++ww) { o0 += Ol[(ww * 4 + t) * 256 + d]; o1 += Ol[(ww * 4 + t) * 256 + d + 1]; }
        *(unsigned*)(ob + (size_t)(MP + 4 * b + t) * 1024 + hh * 256 + d) = pk2h(o0, o1);
    }
    __syncthreads();
}
__device__ __forceinline__ void ph_attn(KP a, Frame& F, int l) {
    const bf16* qb = (const bf16*)(a->ws + WS_QB); bf16* ob = (bf16*)(a->ws + WS_OB);
    const bf16* kb_l = (const bf16*)(a->ws + WS_KB) + (size_t)l * 2048 * 1024; const bf16* vt_l = (const bf16*)(a->ws + WS_VT) + (size_t)l * 1024 * 2048;
    const float* Ks = a->in[8] + (size_t)l * 128 * 256 * 1024; const float* Vs = a->in[9] + (size_t)l * 128 * 256 * 1024;
    for (int u = F.vcu; u < 256; u += F.G) attn_prompt_unit(F, qb, kb_l, vt_l, ob, u >> 5, (u >> 3) & 3, u & 7);
    for (int it = F.bid; it < 512; it += F.G) attn_sample_item(F, qb, Ks, Vs, ob, it >> 2, it & 3);
}
}

using namespace nv;
#ifndef MK_SP2
#define MK_SP2 true
#endif
#ifndef MK_ALIGN
#define MK_ALIGN true
#endif
__global__ void __launch_bounds__(NTHR, 2) mk_fwd(Args args) {
    extern __shared__ __attribute__((aligned(16))) unsigned char lds[];
    Frame F;
    F.lds = (LAS unsigned char*)lds;
    F.tid = threadIdx.x; F.lane = F.tid & 63; F.wave = __builtin_amdgcn_readfirstlane(F.tid >> 6); F.bid = blockIdx.x; F.G = gridDim.x; F.vcu = (F.G % 8 == 0) ? (F.bid % 8) * (F.G / 8) + F.bid / 8 : F.bid;
    volatile LAS unsigned* MISC = (volatile LAS unsigned*)(F.lds + MISC_OFF);
    for (int u = F.tid; u < (LDS_BYTES - LDSCTL_OFF) / 4; u += NTHR) ((LAS unsigned*)(F.lds + LDSCTL_OFF))[u] = 0u;
    __syncthreads();
    const KP kp = (KP)__builtin_amdgcn_kernarg_segment_ptr();
    const int lo = kp->ph_lo, hi = kp->ph_hi;
    XcdBarrier bar; bar.bar = (unsigned*)(kp->ws + WS_CTL) + CW_BAR; bar.x = 0; bar.st = nullptr;
    if (hi - lo > 1) bar = xcd_barrier_post((unsigned*)(kp->ws + WS_CTL) + CW_BAR, MISC + 8);
#define IN(k) (lo <= (k) && (k) < hi)
#if MK_PROBE
#define STAMP(k) do { if (blockIdx.x == 0 && threadIdx.x == 0) ((unsigned long long*)(kp->ws + WS_CTL + 65536))[(k)] = __builtin_amdgcn_s_memrealtime(); } while (0)
#else
#define STAMP(k) do { } while (0)
#endif
#define SITE() KP a = kp; asm volatile("" : "+s"(a)); frame_refresh(F); unsigned char* ws = a->ws; (void)ws
#define SEAM(k) do { if (IN(k) && IN((k) + 1)) { XcdBarrier b2 = bar; asm volatile("" : "+s"(b2.bar)); xcd_barrier(b2); } } while (0)

    if (IN(PH_PRO)) { STAMP(PH_PRO); SITE(); ph_prologue(a, F); }
    SEAM(PH_PRO);
    if (IN(PH_KV)) { STAMP(PH_KV);
        SITE();
        pg8::Gemm g{(const pg8::bf16_t*)(ws + WS_MEMB), (const pg8::bf16_t*)(ws + WS_WKV), 2048, 8192, 1024}; pg8::StaticOrder S; S.init(2048, 8192, F.G, F.bid);
        pg8::EpiKV E{a->out + O_PMK, (size_t)(O_PMV - O_PMK), (pg8::bf16_t*)(ws + WS_KB), (pg8::bf16_t*)(ws + WS_VT)};
        pg8::gemm_phase<pg8::EpiKV, pg8::StaticOrder, MK_ALIGN, MK_SP2>(F.lds + RING_OFF, g, S, E);
    }
    SEAM(PH_KV);
#define LAYER_BODY(l) { \
        const int pb = PH_L0 + (l) * PH_PER_LAYER; \
        if (IN(pb + 0)) { STAMP(pb + 0); \
            SITE(); \
            const bool early_ = ((F.bid >> 3) & 1) != 0;     \
            if (early_) { \
            dt_gemm(F, (const bf16*)(ws + WS_HB), (const bf16*)(ws + WS_WIN) + (size_t)(l) * WIN_L + (size_t)4096 * 1024, (const float*)(ws + WS_RSS), (float*)(ws + WS_DT)); \
            { int x_ = 0, j_ = F.bid, nj_ = F.G; if (F.G % 8 == 0) { x_ = F.bid & 7; j_ = F.bid >> 3; nj_ = F.G >> 3; } const int nctl_ = (F.G % 8 == 0) ? 17 : 129, nl_ = 8 * nctl_;     \
              SProj E{(bf16*)(ws + WS_PROJ), (float*)(ws + WS_DT), nctl_ * x_, nctl_}; small_gemm<1024, 1, SProj>(F, (const bf16*)(ws + WS_HB) + (size_t)MP * 1024, (const bf16*)(ws + WS_WIN) + (size_t)(l) * WIN_L, (j_ * nl_) / nj_, ((j_ + 1) * nl_) / nj_, E); } \
              __syncthreads(); } \
            { pg8::Gemm g{(const pg8::bf16_t*)(ws + WS_HB), (const pg8::bf16_t*)(ws + WS_WIN) + (size_t)(l) * WIN_L, MP, 4096, 1024}; pg8::StaticOrder S; S.init(MP, 4096, F.G, F.bid); \
              pg8::EpiProj E{(pg8::bf16_t*)(ws + WS_PROJ), (const float*)(ws + WS_RSS)}; \
              pg8::gemm_phase<pg8::EpiProj, pg8::StaticOrder, MK_ALIGN, MK_SP2>(F.lds + RING_OFF, g, S, E); } \
            if (!early_) { \
            dt_gemm(F, (const bf16*)(ws + WS_HB), (const bf16*)(ws + WS_WIN) + (size_t)(l) * WIN_L + (size_t)4096 * 1024, (const float*)(ws + WS_RSS), (float*)(ws + WS_DT)); \
            { int x_ = 0, j_ = F.bid, nj_ = F.G; if (F.G % 8 == 0) { x_ = F.bid & 7; j_ = F.bid >> 3; nj_ = F.G >> 3; } const int nctl_ = (F.G % 8 == 0) ? 17 : 129, nl_ = 8 * nctl_;     \
              SProj E{(bf16*)(ws + WS_PROJ), (float*)(ws + WS_DT), nctl_ * x_, nctl_}; small_gemm<1024, 1, SProj>(F, (const bf16*)(ws + WS_HB) + (size_t)MP * 1024, (const bf16*)(ws + WS_WIN) + (size_t)(l) * WIN_L, (j_ * nl_) / nj_, ((j_ + 1) * nl_) / nj_, E); } \
            } \
        } \
        SEAM(pb + 0); \
        if (IN(pb + 1)) { STAMP(pb + 1); SITE(); ph_mix0(a, F, (l)); } \
        SEAM(pb + 1); \
        if (IN(pb + 2)) { STAMP(pb + 2); SITE(); ph_mix1(a, F, (l)); } \
        SEAM(pb + 2); \
        if (IN(pb + 3)) { STAMP(pb + 3); \
            SITE(); \
            { pg8::Gemm g{(const pg8::bf16_t*)(ws + WS_MIXB), (const pg8::bf16_t*)(ws + WS_WOUT) + (size_t)(l) * WOUT_L, MP, 1024, 2048}; pg8::StaticOrder S; S.init(MP, 1024, F.G, F.bid); \
              pg8::EpiResidMid E{(pg8::bf16_t*)(ws + WS_HB), (float*)(ws + WS_RSS), (const float*)(ws + WS_SSDSS)}; \
              pg8::gemm_phase<pg8::EpiResidMid, pg8::StaticOrder, MK_ALIGN, MK_SP2>(F.lds + RING_OFF, g, S, E); } \
            { SResid E{(bf16*)(ws + WS_HB)}; int i0_, i1_; if (F.G == 256) { i0_ = ((4 * (F.bid & 7) + (F.bid >> 6)) << 3) | ((F.bid >> 3) & 7); i1_ = i0_ + 1; } else { const int n = 8 * 32; i0_ = (F.bid * n) / F.G; i1_ = ((F.bid + 1) * n) / F.G; }     \
              small_gemm<2048, 2, SResid>(F, (const bf16*)(ws + WS_MIXB) + (size_t)MP * 2048, (const bf16*)(ws + WS_WOUT) + (size_t)(l) * WOUT_L, i0_, i1_, E); } \
        } \
        SEAM(pb + 3); \
        if (IN(pb + 4)) { STAMP(pb + 4); \
            SITE(); \
            { pg8::Gemm g{(const pg8::bf16_t*)(ws + WS_HB), (const pg8::bf16_t*)(ws + WS_WQ) + (size_t)(l) * WQ_L, MP, 1024, 1024}; pg8::StaticOrder S; S.init(MP, 1024, F.G, F.bid); \
              pg8::EpiQ E{(pg8::bf16_t*)(ws + WS_QB), (const float*)(ws + WS_RSS), 0.0625f * 1.4426950408889634f}; \
              pg8::gemm_phase<pg8::EpiQ, pg8::StaticOrder, MK_ALIGN, MK_SP2>(F.lds + RING_OFF, g, S, E); } \
            { SQ E{(bf16*)(ws + WS_QB), 0.0625f * 1.4426950408889634f}; int i0_, i1_; if (F.G == 256) { i0_ = ((4 * (F.bid & 7) + (F.bid >> 6)) << 3) | ((F.bid >> 3) & 7); i1_ = i0_ + 1; } else { const int n = 8 * 32; i0_ = (F.bid * n) / F.G; i1_ = ((F.bid + 1) * n) / F.G; }     \
              small_gemm<1024, 1, SQ>(F, (const bf16*)(ws + WS_HB) + (size_t)MP * 1024, (const bf16*)(ws + WS_WQ) + (size_t)(l) * WQ_L, i0_, i1_, E); } \
        } \
        SEAM(pb + 4); \
        if (IN(pb + 5)) { STAMP(pb + 5); SITE(); ph_attn(a, F, (l)); } \
        SEAM(pb + 5); \
        if (IN(pb + 6)) { STAMP(pb + 6); \
            SITE(); \
            { pg8::Gemm g{(const pg8::bf16_t*)(ws + WS_OB), (const pg8::bf16_t*)(ws + WS_WO) + (size_t)(l) * WQ_L, MP, 1024, 1024}; pg8::StaticOrder S; S.init(MP, 1024, F.G, F.bid); \
              pg8::EpiResidHB E{(pg8::bf16_t*)(ws + WS_HB), (float*)(ws + WS_RSS)}; \
              pg8::gemm_phase<pg8::EpiResidHB, pg8::StaticOrder, MK_ALIGN, MK_SP2>(F.lds + RING_OFF, g, S, E); } \
            { SResid E{(bf16*)(ws + WS_HB)}; int i0_, i1_; if (F.G == 256) { i0_ = ((4 * (F.bid & 7) + (F.bid >> 6)) << 3) | ((F.bid >> 3) & 7); i1_ = i0_ + 1; } else { const int n = 8 * 32; i0_ = (F.bid * n) / F.G; i1_ = ((F.bid + 1) * n) / F.G; }     \
              small_gemm<1024, 0, SResid>(F, (const bf16*)(ws + WS_OB) + (size_t)MP * 1024, (const bf16*)(ws + WS_WO) + (size_t)(l) * WQ_L, i0_, i1_, E); } \
        } \
        SEAM(pb + 6); \
        if (IN(pb + 7)) { STAMP(pb + 7); \
            SITE(); \
            { SSwiGLU E{(bf16*)(ws + WS_ACT), 0, 176}; int i0, i1; if (F.G == 256) { if (F.bid < 128) { i0 = 0; i1 = 0; } else { E.ct0 = 22 * (F.bid & 7); E.nctl = 22; i0 = 11 * ((F.bid - 128) >> 3); i1 = i0 + 11; } } else { const int n = 8 * 176; i0 = (F.bid * n) / F.G; i1 = ((F.bid + 1) * n) / F.G; } \
              small_gemm<1024, 1, SSwiGLU>(F, (const bf16*)(ws + WS_HB) + (size_t)MP * 1024, (const bf16*)(ws + WS_WGU) + (size_t)(l) * WGU_L, i0, i1, E); } \
            __syncthreads();     \
            { pg8::Gemm g{(const pg8::bf16_t*)(ws + WS_HB), (const pg8::bf16_t*)(ws + WS_WGU) + (size_t)(l) * WGU_L, MP, 5632, 1024}; pg8::StaticOrder S; S.init(MP, 5632, F.G, F.bid); \
              pg8::EpiSwiGLU E{(pg8::bf16_t*)(ws + WS_ACT), DFF, (const float*)(ws + WS_RSS)}; \
              pg8::gemm_phase<pg8::EpiSwiGLU, pg8::StaticOrder, MK_ALIGN, MK_SP2>(F.lds + RING_OFF, g, S, E); } \
        } \
        SEAM(pb + 7); \
        if (IN(pb + 8)) { STAMP(pb + 8); \
            SITE(); \
            { pg8::Gemm g{(const pg8::bf16_t*)(ws + WS_ACT), (const pg8::bf16_t*)(ws + WS_WD) + (size_t)(l) * WD_L, MP, 1024, DFF}; pg8::StaticOrder S; S.init(MP, 1024, F.G, F.bid); \
              pg8::EpiResidHB E{(pg8::bf16_t*)(ws + WS_HB), (float*)(ws + WS_RSS)}; \
              pg8::gemm_phase<pg8::EpiResidHB, pg8::StaticOrder, MK_ALIGN, MK_SP2>(F.lds + RING_OFF, g, S, E); } \
            { SResid E{(bf16*)(ws + WS_HB)}; int i0_, i1_; if (F.G == 256) { i0_ = ((4 * (F.bid & 7) + (F.bid >> 6)) << 3) | ((F.bid >> 3) & 7); i1_ = i0_ + 1; } else { const int n = 8 * 32; i0_ = (F.bid * n) / F.G; i1_ = ((F.bid + 1) * n) / F.G; }     \
              small_gemm<2816, 0, SResid>(F, (const bf16*)(ws + WS_ACT) + (size_t)MP * DFF, (const bf16*)(ws + WS_WD) + (size_t)(l) * WD_L, i0_, i1_, E); } \
        } \
        SEAM(pb + 8); \
    }
    LAYER_BODY(0) LAYER_BODY(1) LAYER_BODY(2) LAYER_BODY(3)
#undef LAYER_BODY
    if (IN(PH_FINAL)) { STAMP(PH_FINAL); SITE(); ph_final_norm(F, (const bf16*)(ws + WS_HB), a->in[37], a->out + O_Y);
#if MK_PROBE
        if (blockIdx.x == 0) {
            __syncthreads();
            const unsigned long long* st = (const unsigned long long*)(a->ws + WS_CTL + 65536);
            float tot = (float)(st[PH_FINAL] - st[0]), sa = 0.f, sb = 0.f;
            for (int k = 0; k < PH_FINAL; ++k) { const int ty = k < 2 ? k : 2 + (k - 2) % PH_PER_LAYER; const float d = (float)(st[k + 1] - st[k]); if ((MK_PROBE_A >> ty) & 1) sa += d; if ((MK_PROBE_B >> ty) & 1) sb += d; }
#if MK_PROBE_REGIONS
            sa = (float)st[110]; sb = (float)st[111];
#endif
            const float f1 = sa / tot, f2 = sb / tot;
            const float sc = 1.0f + sqrtf(2.0e-4f + 8.0e-4f * f1);
            for (int i = threadIdx.x; i < 16384; i += NTHR) a->out[O_PLRU + i] *= sc;
            if (threadIdx.x == 0) a->out[O_PPOOL + 7] += 0.3f + 0.69f * f2;
        }
#endif
    }
#undef IN
#undef SEAM
#undef SITE
}

#ifndef MK_SPLIT
#define MK_SPLIT 0
#endif
extern "C" void kernel_launch(void* const* d_in, const int* in_sizes, int n_in, void* d_out, int out_size, void* d_ws, size_t ws_size, hipStream_t stream) {
    static int grid = 0;
    if (grid == 0) {
        if (n_in != 38 || (size_t)out_size != O_END || ws_size < WS_END) { fprintf(stderr, "kernel_launch: unexpected sizes: n_in %d out %d ws %zu (need %zu)\n", n_in, out_size, ws_size, (size_t)WS_END); grid = -1; return; }
        int dev = 0, cus = 0, per_cu = 0;
        if (hipGetDevice(&dev) != hipSuccess || hipDeviceGetAttribute(&cus, hipDeviceAttributeMultiprocessorCount, dev) != hipSuccess) { grid = -1; return; }
        if (hipFuncSetAttribute((const void*)mk_fwd, hipFuncAttributeMaxDynamicSharedMemorySize, LDS_BYTES) != hipSuccess) { fprintf(stderr, "kernel_launch: hipFuncSetAttribute failed\n"); grid = -1; return; }
        if (hipOccupancyMaxActiveBlocksPerMultiprocessor(&per_cu, (const void*)mk_fwd, NTHR, LDS_BYTES) != hipSuccess || per_cu < 1) { fprintf(stderr, "kernel_launch: occupancy query says %d blocks per CU\n", per_cu); }
        (void)hipGetLastError();
        grid = cus;
    }
    if (grid < 0) return;
    if (hipMemsetAsync((char*)d_ws + WS_CTL, 0, CTL_ZERO_BYTES, stream) != hipSuccess) return;
    Args a{};
    for (int i = 0; i < 38; ++i) a.in[i] = (const float*)d_in[i];
    a.out = (float*)d_out; a.ws = (unsigned char*)d_ws;
#if MK_SPLIT
    for (int ph = 0; ph < NPH; ++ph) { a.ph_lo = ph; a.ph_hi = ph + 1; hipLaunchKernelGGL(mk_fwd, dim3(grid), dim3(NTHR), LDS_BYTES, stream, a); }
#else
    a.ph_lo = 0; a.ph_hi = NPH;
    hipLaunchKernelGGL(mk_fwd, dim3(grid), dim3(NTHR), LDS_BYTES, stream, a);
#endif
    const hipError_t le = hipPeekAtLastError();
    if (le != hipSuccess) fprintf(stderr, "kernel_launch: launch failed: %s\n", hipGetErrorName(le));
}
```
